# Optimizing an MI355X kernel written in HIP

```python
import jax
import jax.numpy as jnp
from jax import lax
import numpy as np

D_MODEL = 1024
BATCH = 1
SEQ = 16384
DEPTH = 2

GRID_W = 64
CTX_LEN = 256
HEAD_DIM = 64
N_Q_HEADS = 8
N_KV_HEADS = 2
Q_PER_KV = N_Q_HEADS // N_KV_HEADS
ATTN_W = N_Q_HEADS * HEAD_DIM
KV_W = N_KV_HEADS * HEAD_DIM
POOL_W = D_MODEL // 4
POOL_WINDOWS = (2, 4, 8, 16)
POOL_GROUPS = len(POOL_WINDOWS)
POOL_GW = POOL_W // POOL_GROUPS
CONV_W = D_MODEL // 4
CONV_K = 31
MIX_W = ATTN_W + POOL_W + CONV_W
IN_W = ATTN_W + 2 * KV_W + POOL_W + 2 * CONV_W
Q_BLOCK = 128
ROPE_THETA = 10000.0
N_GROUPS = 4
EXPERTS_PER_GROUP = 8
N_EXPERTS = N_GROUPS * EXPERTS_PER_GROUP
TOP_K_IN_GROUP = 2
D_EXPERT = D_MODEL // 2
MOE_BLOCK = 128
N_MOD = 6
ALPHA = (2 * DEPTH) ** 0.25
BETA = (8 * DEPTH) ** -0.25
EPS = 1e-6

kernel_name = 'hybrid_headgroup_prefix_hmoe_block'


def ln_plain(x):
    xf = x.astype(jnp.float32)
    mu = xf.mean(-1, keepdims=True)
    var = jnp.square(xf - mu).mean(-1, keepdims=True)
    return ((xf - mu) * lax.rsqrt(var + EPS)).astype(x.dtype)


def ln_affine(x, g, b):
    xf = x.astype(jnp.float32)
    mu = xf.mean(-1, keepdims=True)
    var = jnp.square(xf - mu).mean(-1, keepdims=True)
    return ((xf - mu) * lax.rsqrt(var + EPS) * g + b).astype(x.dtype)


def rms_heads(t, g):
    tf = t.astype(jnp.float32)
    return (tf * lax.rsqrt(jnp.square(tf).mean(-1, keepdims=True) + EPS) * g).astype(t.dtype)


def modulate(h, shift, scale):
    return h * (1 + scale) + shift


def rope_tables(n_tok):
    rows = n_tok // GRID_W
    row = jnp.broadcast_to(jnp.arange(rows)[:, None], (rows, GRID_W)).reshape(-1)
    col = jnp.broadcast_to(jnp.arange(GRID_W)[None, :], (rows, GRID_W)).reshape(-1)
    n_freq = HEAD_DIM // 4
    inv = ROPE_THETA ** (-jnp.arange(n_freq, dtype=jnp.float32) / n_freq)
    pos = jnp.stack([row, col], axis=-1).astype(jnp.float32)
    ang = pos[:, :, None] * inv
    return jnp.cos(ang), jnp.sin(ang)


def apply_rope(t, cos, sin):
    b, n, h, _ = t.shape
    tr = t.reshape(b, n, h, 2, 2, HEAD_DIM // 4)
    t1, t2 = tr[..., 0, :], tr[..., 1, :]
    cs = cos[None, :, None].astype(t.dtype)
    sn = sin[None, :, None].astype(t.dtype)
    out = jnp.stack([t1 * cs - t2 * sn, t2 * cs + t1 * sn], axis=-2)
    return out.reshape(t.shape)


def gqa(q, k, v):
    s = jnp.einsum('bqkgd,bskd->bkgqs', q, k).astype(jnp.float32) * (HEAD_DIM ** -0.5)
    p = jax.nn.softmax(s, axis=-1).astype(v.dtype)
    return jnp.einsum('bkgqs,bskd->bqkgd', p, v)


def latent_attention(q, k_all, v_all):
    b, n = q.shape[:2]
    nb = n // Q_BLOCK
    qb = q.reshape(b, nb, Q_BLOCK, N_KV_HEADS, Q_PER_KV, HEAD_DIM).swapaxes(0, 1)
    o = lax.map(lambda qblk: gqa(qblk, k_all, v_all), qb)
    return o.swapaxes(0, 1).reshape(b, n, ATTN_W)


def pool_mixer(u, w_pool, pool_scale):
    b, n, _ = u.shape
    ug = u.reshape(b, n, POOL_GROUPS, POOL_GW).astype(jnp.float32)
    cs = jnp.concatenate([jnp.zeros((b, 1, POOL_GROUPS, POOL_GW), jnp.float32), jnp.cumsum(ug, axis=1)], axis=1)
    t = jnp.arange(n)
    outs = []
    for gi, w in enumerate(POOL_WINDOWS):
        lo = jnp.clip(t - w // 2, 0, n)
        hi = jnp.clip(t + (w - w // 2), 0, n)
        cg = cs[:, :, gi]
        mean = (cg[:, hi] - cg[:, lo]) / (hi - lo).astype(jnp.float32)[None, :, None]
        outs.append(mean - ug[:, :, gi])
    pooled = jnp.stack(outs, axis=2).astype(u.dtype)
    y = jnp.einsum('blgc,gcd->blgd', pooled, w_pool)
    return y.reshape(b, n, POOL_W) * pool_scale


def conv_module(a, g, w_dw, b_dw, cv_g, cv_b, w_pw):
    u = a * jax.nn.sigmoid(g)
    y = lax.conv_general_dilated(u, w_dw[:, None, :], window_strides=(1,),
                                 padding=[(CONV_K // 2, CONV_K // 2)],
                                 dimension_numbers=('NWC', 'WIO', 'NWC'),
                                 feature_group_count=CONV_W) + b_dw
    return jax.nn.silu(ln_affine(y, cv_g, cv_b)) @ w_pw


def split_in(p):
    o = np.cumsum([0, ATTN_W, KV_W, KV_W, POOL_W, CONV_W, CONV_W])
    return tuple(p[..., int(o[i]):int(o[i + 1])] for i in range(6))


def heads(t, n):
    return t.reshape(*t.shape[:-1], n, HEAD_DIM)


def hier_moe(h, w_rg, b_rg, w_re, b_re, wg, wu, wd):
    T, D = h.shape
    A = T * TOP_K_IN_GROUP
    nblk = -(-A // MOE_BLOCK) + N_EXPERTS
    lg = (h @ w_rg).astype(jnp.float32) + b_rg
    pg = jax.nn.softmax(lg, axis=-1)
    gsel = jnp.argmax(lg, axis=-1)
    p_group = jnp.take_along_axis(pg, gsel[:, None], axis=1)
    le = ((h @ w_re).astype(jnp.float32) + b_re).reshape(T, N_GROUPS, EXPERTS_PER_GROUP)
    le_sel = jnp.take_along_axis(le, gsel[:, None, None], axis=1)[:, 0]
    top_v, top_i = lax.top_k(le_sel, TOP_K_IN_GROUP)
    gate = (p_group * jax.nn.softmax(top_v, axis=-1)).astype(h.dtype)
    eid = (gsel[:, None] * EXPERTS_PER_GROUP + top_i).reshape(-1)
    tok = jnp.repeat(jnp.arange(T), TOP_K_IN_GROUP)
    gw = gate.reshape(-1)
    order = jnp.argsort(eid)
    e_s, tok_s, w_s = eid[order], tok[order], gw[order]
    counts = jnp.bincount(eid, length=N_EXPERTS)
    starts = jnp.cumsum(counts) - counts
    padded = (counts + MOE_BLOCK - 1) // MOE_BLOCK * MOE_BLOCK
    pends = jnp.cumsum(padded)
    pstarts = pends - padded
    dest = pstarts[e_s] + jnp.arange(A) - starts[e_s]
    P = nblk * MOE_BLOCK
    tok_buf = jnp.zeros((P,), jnp.int32).at[dest].set(tok_s.astype(jnp.int32))
    w_buf = jnp.zeros((P,), h.dtype).at[dest].set(w_s)
    blk_e = jnp.minimum(jnp.searchsorted(pends, jnp.arange(nblk) * MOE_BLOCK, side='right'), N_EXPERTS - 1)

    def expert_block(args):
        tb, e = args
        xb = h[tb]
        return (jax.nn.silu(xb @ wg[e]) * (xb @ wu[e])) @ wd[e]

    ys = lax.map(expert_block, (tok_buf.reshape(nblk, MOE_BLOCK), blk_e))
    return jnp.zeros_like(h).at[tok_buf].add(ys.reshape(P, D) * w_buf[:, None])


def setup_inputs(seed: int = 0) -> dict:
    key = jax.random.key(seed)
    ks = jax.random.split(key, 28)

    def nrm(k, shape, s):
        return jax.random.normal(k, shape, jnp.float32) * s

    L = DEPTH
    w_in = nrm(ks[6], (L, D_MODEL, IN_W), D_MODEL ** -0.5)
    w_in = w_in.at[:, :, ATTN_W + KV_W:ATTN_W + 2 * KV_W].multiply(BETA)
    return {
        'x': nrm(ks[0], (BATCH, SEQ, D_MODEL), 1.0),
        'c': nrm(ks[1], (BATCH, D_MODEL), 1.0),
        'ctx': nrm(ks[2], (BATCH, CTX_LEN, D_MODEL), 1.0),
        'c_ctx': nrm(ks[3], (D_MODEL,), 1.0),
        'w_mod': nrm(ks[4], (L, D_MODEL, N_MOD * D_MODEL), D_MODEL ** -0.5),
        'b_mod': nrm(ks[5], (L, N_MOD * D_MODEL), 0.02),
        'w_in': w_in,
        'q_gain': 1.0 + nrm(ks[7], (L, HEAD_DIM), 0.02),
        'k_gain': 1.0 + nrm(ks[8], (L, HEAD_DIM), 0.02),
        'w_pool': nrm(ks[9], (L, POOL_GROUPS, POOL_GW, POOL_GW), POOL_GW ** -0.5),
        'pool_scale': 1.0 + nrm(ks[10], (L, POOL_W), 0.02),
        'w_dw': nrm(ks[11], (L, CONV_K, CONV_W), CONV_K ** -0.5),
        'b_dw': nrm(ks[12], (L, CONV_W), 0.02),
        'cv_ln_g': 1.0 + nrm(ks[13], (L, CONV_W), 0.02),
        'cv_ln_b': nrm(ks[14], (L, CONV_W), 0.02),
        'w_cv_pw': nrm(ks[15], (L, CONV_W, CONV_W), CONV_W ** -0.5),
        'w_out': nrm(ks[16], (L, MIX_W, D_MODEL), BETA * MIX_W ** -0.5),
        'ln1_g': 1.0 + nrm(ks[17], (L, D_MODEL), 0.02),
        'ln1_b': nrm(ks[18], (L, D_MODEL), 0.02),
        'ln2_g': 1.0 + nrm(ks[19], (L, D_MODEL), 0.02),
        'ln2_b': nrm(ks[20], (L, D_MODEL), 0.02),
        'w_rg': nrm(ks[21], (L, D_MODEL, N_GROUPS), D_MODEL ** -0.5),
        'b_rg': nrm(ks[22], (L, N_GROUPS), 0.01),
        'w_re': nrm(ks[23], (L, D_MODEL, N_EXPERTS), D_MODEL ** -0.5),
        'b_re': nrm(ks[24], (L, N_EXPERTS), 0.01),
        'w_e_gate': nrm(ks[25], (L, N_EXPERTS, D_MODEL, D_EXPERT), D_MODEL ** -0.5),
        'w_e_up': nrm(ks[26], (L, N_EXPERTS, D_MODEL, D_EXPERT), D_MODEL ** -0.5),
        'w_e_down': nrm(ks[27], (L, N_EXPERTS, D_EXPERT, D_MODEL), BETA * D_EXPERT ** -0.5),
    }


def reference(x, c, ctx, c_ctx, w_mod, b_mod, w_in, q_gain, k_gain, w_pool, pool_scale, w_dw, b_dw,
              cv_ln_g, cv_ln_b, w_cv_pw, w_out, ln1_g, ln1_b, ln2_g, ln2_b, w_rg, b_rg, w_re, b_re,
              w_e_gate, w_e_up, w_e_down):
    B, L, D = x.shape
    n_ctx = ctx.shape[1]
    cos, sin = rope_tables(L)
    xl, xc = x, ctx
    for l in range(DEPTH):
        last = l == DEPTH - 1
        mod_l = (jax.nn.silu(c) @ w_mod[l] + b_mod[l])[:, None, :]
        mod_c = jax.nn.silu(c_ctx) @ w_mod[l] + b_mod[l]
        sh1, sc1, g1, sh2, sc2, g2 = jnp.split(mod_l, N_MOD, axis=-1)
        csh1, csc1, cg1, csh2, csc2, cg2 = jnp.split(mod_c, N_MOD, axis=-1)

        hl = modulate(ln_plain(xl), sh1, sc1)
        hc = modulate(ln_plain(xc), csh1, csc1)
        ql, kl, vl, ul, al, gl = split_in(hl @ w_in[l])
        if last:
            kc, vc = jnp.split(hc @ w_in[l][:, ATTN_W:ATTN_W + 2 * KV_W], 2, axis=-1)
        else:
            qc, kc, vc, uc, ac, gc = split_in(hc @ w_in[l])
        kc = rms_heads(heads(kc, N_KV_HEADS), k_gain[l])
        vc = heads(vc, N_KV_HEADS)
        ql = apply_rope(rms_heads(heads(ql, N_Q_HEADS), q_gain[l]), cos, sin)
        kl = apply_rope(rms_heads(heads(kl, N_KV_HEADS), k_gain[l]), cos, sin)
        vl = heads(vl, N_KV_HEADS)
        k_all = jnp.concatenate([kc, kl], axis=1)
        v_all = jnp.concatenate([vc, vl], axis=1)
        attn_l = latent_attention(ql, k_all, v_all)
        yl = jnp.concatenate([attn_l,
                              pool_mixer(ul, w_pool[l], pool_scale[l]),
                              conv_module(al, gl, w_dw[l], b_dw[l], cv_ln_g[l], cv_ln_b[l], w_cv_pw[l])],
                             axis=-1) @ w_out[l]
        if not last:
            qc = rms_heads(heads(qc, N_Q_HEADS), q_gain[l]).reshape(B, n_ctx, N_KV_HEADS, Q_PER_KV, HEAD_DIM)
            attn_c = gqa(qc, kc, vc).reshape(B, n_ctx, ATTN_W)
            yc = jnp.concatenate([attn_c,
                                  pool_mixer(uc, w_pool[l], pool_scale[l]),
                                  conv_module(ac, gc, w_dw[l], b_dw[l], cv_ln_g[l], cv_ln_b[l], w_cv_pw[l])],
                                 axis=-1) @ w_out[l]
            xc = ln_affine(ALPHA * xc + cg1 * yc, ln1_g[l], ln1_b[l])
        xl = ln_affine(ALPHA * xl + g1 * yl, ln1_g[l], ln1_b[l])

        hl = modulate(ln_plain(xl), sh2, sc2).reshape(B * L, D)
        if last:
            ol = hier_moe(hl, w_rg[l], b_rg[l], w_re[l], b_re[l], w_e_gate[l], w_e_up[l], w_e_down[l])
        else:
            hc = modulate(ln_plain(xc), csh2, csc2).reshape(B * n_ctx, D)
            o = hier_moe(jnp.concatenate([hc, hl], axis=0), w_rg[l], b_rg[l], w_re[l], b_re[l],
                         w_e_gate[l], w_e_up[l], w_e_down[l])
            oc, ol = o[:B * n_ctx], o[B * n_ctx:]
            xc = ln_affine(ALPHA * xc + cg2 * oc.reshape(xc.shape), ln2_g[l], ln2_b[l])
        xl = ln_affine(ALPHA * xl + g2 * ol.reshape(xl.shape), ln2_g[l], ln2_b[l])
    return xl
```

```cpp
#include <hip/hip_runtime.h>
#include <cstdio>
#include <cstdint>

typedef unsigned short bf16_t;

constexpr int D = 1024, SEQ = 16384, NCTX = 256, TT = SEQ + NCTX;
constexpr int INW = 1536, NMOD = 6;
constexpr int NE = 32, DE = 512;
constexpr int CAPL = 2 * TT;
constexpr int HMID_ROWS = 2 * TT + NE * 128;
constexpr float ALPHA = 1.41421356237309515f;
constexpr float EPS = 1e-6f;

constexpr size_t al(size_t x) { return (x + 255) / 256 * 256; }
constexpr size_t OFF_MOD = 0;
constexpr size_t OFF_ROPE = OFF_MOD + al(2 * 2 * 6144 * 4);
constexpr size_t OFF_CNT = OFF_ROPE + al(256 * 16 * 2 * 4);
constexpr size_t OFF_X = OFF_CNT + al(2 * 64 * 4);
constexpr size_t OFF_H = OFF_X + al((size_t)TT * D * 4);
constexpr size_t OFF_MIX = OFF_H + al((size_t)TT * D * 2);
constexpr size_t OFF_Y = OFF_MIX + al((size_t)TT * D * 2);
constexpr size_t OFF_Q = OFF_Y + al((size_t)TT * D * 2);
constexpr size_t OFF_K = OFF_Q + al((size_t)TT * 512 * 2);
constexpr size_t OFF_V = OFF_K + al((size_t)TT * 128 * 2);
constexpr size_t OFF_U = OFF_V + al((size_t)TT * 128 * 2);
constexpr size_t OFF_AG = OFF_U + al((size_t)TT * 256 * 4);
constexpr size_t OFF_OMOE = OFF_AG + al((size_t)TT * 512 * 2);
constexpr size_t OFF_EID = OFF_OMOE + al((size_t)TT * 2 * D * 2);
constexpr size_t OFF_GATE = OFF_EID + al((size_t)TT * 2 * 4);
constexpr size_t OFF_LIST = OFF_GATE + al((size_t)TT * 2 * 4);
constexpr size_t OFF_HMID = OFF_LIST + al((size_t)NE * CAPL * 4);
constexpr size_t OFF_P = OFF_HMID + al((size_t)HMID_ROWS * DE * 2);
constexpr size_t OFF_POOL = OFF_P + al((size_t)TT * INW * 4);
constexpr size_t OFF_CY = OFF_POOL + al((size_t)TT * 256 * 4);
constexpr size_t WS_END = OFF_CY + al((size_t)TT * 256 * 4);

struct Params {
  const float *x, *c, *ctx, *c_ctx, *w_mod, *b_mod, *w_in, *q_gain, *k_gain, *w_pool, *pool_scale, *w_dw, *b_dw,
      *cv_ln_g, *cv_ln_b, *w_cv_pw, *w_out, *ln1_g, *ln1_b, *ln2_g, *ln2_b, *w_rg, *b_rg, *w_re, *b_re, *w_e_gate, *w_e_up, *w_e_down;
  float* out;
  char* ws;
};

__device__ __forceinline__ float bf2f(bf16_t v) { return __uint_as_float(((unsigned)v) << 16); }
__device__ __forceinline__ bf16_t f2bf(float f) {
  unsigned u = __float_as_uint(f);
  u += 0x7fffu + ((u >> 16) & 1u);
  return (bf16_t)(u >> 16);
}
__device__ __forceinline__ float wave_sum(float v) {
#pragma unroll
  for (int o = 32; o > 0; o >>= 1) v += __shfl_xor(v, o);
  return v;
}
__device__ __forceinline__ float silu(float v) { return v / (1.f + __expf(-v)); }

__global__ void k_mod(Params p) {
  float* mod = (float*)(p.ws + OFF_MOD);
  int gid = blockIdx.x * blockDim.x + threadIdx.x;
  if (gid < 2 * 6144) {
    int l = gid / 6144, col = gid % 6144;
    const float* w = p.w_mod + (size_t)l * D * 6144 + col;
    float a0 = 0.f, a1 = 0.f;
    for (int k = 0; k < D; ++k) {
      float wv = w[(size_t)k * 6144];
      a0 += silu(p.c[k]) * wv;
      a1 += silu(p.c_ctx[k]) * wv;
    }
    float b = p.b_mod[l * 6144 + col];
    mod[(l * 2 + 0) * 6144 + col] = a0 + b;
    mod[(l * 2 + 1) * 6144 + col] = a1 + b;
  }
  if (gid < 256 * 16) {
    int pos = gid / 16, f = gid % 16;
    float inv = powf(10000.f, -(float)f / 16.f);
    float ang = (float)pos * inv;
    float* rt = (float*)(p.ws + OFF_ROPE);
    rt[gid * 2 + 0] = cosf(ang);
    rt[gid * 2 + 1] = sinf(ang);
  }
  if (gid < 128) ((int*)(p.ws + OFF_CNT))[gid] = 0;
}

__global__ void __launch_bounds__(256) k_a0(Params p, int layer) {
  int wave = (blockIdx.x * blockDim.x + threadIdx.x) >> 6, lane = threadIdx.x & 63;
  int nw = (gridDim.x * blockDim.x) >> 6;
  float* X = (float*)(p.ws + OFF_X);
  bf16_t* H = (bf16_t*)(p.ws + OFF_H);
  const bf16_t* OM = (const bf16_t*)(p.ws + OFF_OMOE);
  for (int r = wave; r < TT; r += nw) {
    int s = r < NCTX ? 1 : 0;
    float v[16];
    if (layer == 0) {
      const float* src = r < NCTX ? p.ctx + (size_t)r * D : p.x + (size_t)(r - NCTX) * D;
#pragma unroll
      for (int i = 0; i < 16; ++i) v[i] = src[lane + 64 * i];
    } else {
      const float* modp = (const float*)(p.ws + OFF_MOD) + ((layer - 1) * 2 + s) * 6144;
      const float* g2 = modp + 5 * D;
      float sum = 0.f;
#pragma unroll
      for (int i = 0; i < 16; ++i) {
        int c = lane + 64 * i;
        float o = bf2f(OM[((size_t)r * 2 + 0) * D + c]) + bf2f(OM[((size_t)r * 2 + 1) * D + c]);
        v[i] = ALPHA * X[(size_t)r * D + c] + g2[c] * o;
        sum += v[i];
      }
      float mu = wave_sum(sum) * (1.f / D);
      float q = 0.f;
#pragma unroll
      for (int i = 0; i < 16; ++i) { float d = v[i] - mu; q += d * d; }
      float rs = rsqrtf(wave_sum(q) * (1.f / D) + EPS);
      const float* g = p.ln2_g + (layer - 1) * D; const float* b = p.ln2_b + (layer - 1) * D;
#pragma unroll
      for (int i = 0; i < 16; ++i) { int c = lane + 64 * i; v[i] = (v[i] - mu) * rs * g[c] + b[c]; X[(size_t)r * D + c] = v[i]; }
    }
    const float* modp = (const float*)(p.ws + OFF_MOD) + (layer * 2 + s) * 6144;
    const float* sh = modp; const float* sc = modp + D;
    float sum = 0.f;
#pragma unroll
    for (int i = 0; i < 16; ++i) sum += v[i];
    float mu = wave_sum(sum) * (1.f / D);
    float q = 0.f;
#pragma unroll
    for (int i = 0; i < 16; ++i) { float d = v[i] - mu; q += d * d; }
    float rs = rsqrtf(wave_sum(q) * (1.f / D) + EPS);
#pragma unroll
    for (int i = 0; i < 16; ++i) { int c = lane + 64 * i; H[(size_t)r * D + c] = f2bf((v[i] - mu) * rs * (1.f + sc[c]) + sh[c]); }
  }
}

__global__ void k_gemm_naive(const bf16_t* A, const float* B, float* C, int M, int N, int K, int ldc) {
  long gid = (long)blockIdx.x * blockDim.x + threadIdx.x;
  if (gid >= (long)M * N) return;
  int m = gid / N, n = gid % N;
  const bf16_t* a = A + (size_t)m * K;
  float acc = 0.f;
  for (int k = 0; k < K; ++k) acc += bf2f(a[k]) * B[(size_t)k * N + n];
  C[(size_t)m * ldc + n] = acc;
}

__global__ void __launch_bounds__(256) k_inproj_epi(Params p, int layer) {
  int wave = (blockIdx.x * blockDim.x + threadIdx.x) >> 6, lane = threadIdx.x & 63;
  int nw = (gridDim.x * blockDim.x) >> 6;
  const float* P = (const float*)(p.ws + OFF_P);
  bf16_t* Q = (bf16_t*)(p.ws + OFF_Q); bf16_t* Kb = (bf16_t*)(p.ws + OFF_K); bf16_t* Vb = (bf16_t*)(p.ws + OFF_V);
  float* U = (float*)(p.ws + OFF_U); bf16_t* AG = (bf16_t*)(p.ws + OFF_AG);
  const float* rt = (const float*)(p.ws + OFF_ROPE);
  for (int r = wave; r < TT; r += nw) {
    const float* pr = P + (size_t)r * INW;
    bool lat = r >= NCTX;
    int t = r - NCTX; int prow = t / 64, pcol = t % 64;
    for (int hh = 0; hh < 10; ++hh) {
      float v = pr[hh * 64 + lane];
      float ss = wave_sum(v * v) * (1.f / 64.f);
      float gain = hh < 8 ? p.q_gain[layer * 64 + lane] : p.k_gain[layer * 64 + lane];
      float n = v * rsqrtf(ss + EPS) * gain;
      if (lat) {
        int axis = lane >> 5, half = (lane >> 4) & 1, f = lane & 15;
        float other = __shfl_xor(n, 16);
        int pos = axis == 0 ? prow : pcol;
        float cs = rt[(pos * 16 + f) * 2], sn = rt[(pos * 16 + f) * 2 + 1];
        n = half == 0 ? n * cs - other * sn : n * cs + other * sn;
      }
      if (hh < 8) Q[(size_t)r * 512 + hh * 64 + lane] = f2bf(n);
      else Kb[(size_t)r * 128 + (hh - 8) * 64 + lane] = f2bf(n);
    }
    for (int i = 0; i < 2; ++i) Vb[(size_t)r * 128 + i * 64 + lane] = f2bf(pr[640 + i * 64 + lane]);
    for (int i = 0; i < 4; ++i) U[(size_t)r * 256 + i * 64 + lane] = pr[768 + i * 64 + lane];
    for (int i = 0; i < 8; ++i) AG[(size_t)r * 512 + i * 64 + lane] = f2bf(pr[1024 + i * 64 + lane]);
  }
}

__global__ void __launch_bounds__(64) k_attn_naive(Params p, int layer) {
  int head = blockIdx.x & 7, rg = blockIdx.x >> 3;
  int r = rg * 64 + threadIdx.x;
  bool lat = r >= NCTX;
  if (!lat && layer == 1) return;
  const bf16_t* Q = (const bf16_t*)(p.ws + OFF_Q); const bf16_t* Kb = (const bf16_t*)(p.ws + OFF_K); const bf16_t* Vb = (const bf16_t*)(p.ws + OFF_V);
  bf16_t* MIX = (bf16_t*)(p.ws + OFF_MIX);
  int kvh = head >> 2;
  float q[64], o[64];
#pragma unroll
  for (int d = 0; d < 64; ++d) { q[d] = bf2f(Q[(size_t)r * 512 + head * 64 + d]) * 0.125f; o[d] = 0.f; }
  float m = -1e30f, l = 0.f;
  int nk = lat ? TT : NCTX;
  for (int j = 0; j < nk; ++j) {
    const bf16_t* kr = Kb + (size_t)j * 128 + kvh * 64;
    const bf16_t* vr = Vb + (size_t)j * 128 + kvh * 64;
    float s = 0.f;
#pragma unroll
    for (int d = 0; d < 64; ++d) s += q[d] * bf2f(kr[d]);
    if (s > m) {
      float a = __expf(m - s);
      l *= a;
#pragma unroll
      for (int d = 0; d < 64; ++d) o[d] *= a;
      m = s;
    }
    float pe = __expf(s - m);
    l += pe;
#pragma unroll
    for (int d = 0; d < 64; ++d) o[d] += pe * bf2f(vr[d]);
  }
  float il = 1.f / l;
#pragma unroll
  for (int d = 0; d < 64; ++d) MIX[(size_t)r * D + head * 64 + d] = f2bf(o[d] * il);
}

__global__ void k_pool1(Params p) {
  long gid = (long)blockIdx.x * blockDim.x + threadIdx.x;
  if (gid >= (long)TT * 256) return;
  int r = gid / 256, c = gid % 256, gi = c / 64;
  int w = 2 << gi;
  const float* U = (const float*)(p.ws + OFF_U);
  int base = r < NCTX ? 0 : NCTX, n = r < NCTX ? NCTX : SEQ, t = r - base;
  int lo = max(t - w / 2, 0), hi = min(t + w / 2, n);
  float s = 0.f;
  for (int j = lo; j < hi; ++j) s += U[(size_t)(base + j) * 256 + c];
  ((float*)(p.ws + OFF_POOL))[gid] = s / (float)(hi - lo) - U[(size_t)r * 256 + c];
}
__global__ void k_pool2(Params p, int layer) {
  long gid = (long)blockIdx.x * blockDim.x + threadIdx.x;
  if (gid >= (long)TT * 256) return;
  int r = gid / 256, c = gid % 256, gi = c / 64, d = c % 64;
  const float* PL = (const float*)(p.ws + OFF_POOL) + (size_t)r * 256 + gi * 64;
  const float* w = p.w_pool + (size_t)layer * 4 * 64 * 64 + (size_t)gi * 64 * 64 + d;
  float acc = 0.f;
  for (int k = 0; k < 64; ++k) acc += PL[k] * w[k * 64];
  ((bf16_t*)(p.ws + OFF_MIX))[(size_t)r * D + 512 + c] = f2bf(acc * p.pool_scale[layer * 256 + c]);
}
__global__ void k_conv1(Params p, int layer) {
  long gid = (long)blockIdx.x * blockDim.x + threadIdx.x;
  if (gid >= (long)TT * 256) return;
  int r = gid / 256, c = gid % 256;
  const bf16_t* AG = (const bf16_t*)(p.ws + OFF_AG);
  int base = r < NCTX ? 0 : NCTX, n = r < NCTX ? NCTX : SEQ, t = r - base;
  float acc = p.b_dw[layer * 256 + c];
  for (int j = 0; j < 31; ++j) {
    int tt = t + j - 15;
    if (tt < 0 || tt >= n) continue;
    float a = bf2f(AG[(size_t)(base + tt) * 512 + c]), g = bf2f(AG[(size_t)(base + tt) * 512 + 256 + c]);
    float u = a / (1.f + __expf(-g));
    acc += u * p.w_dw[(size_t)layer * 31 * 256 + j * 256 + c];
  }
  ((float*)(p.ws + OFF_CY))[gid] = acc;
}
__global__ void k_conv2(Params p, int layer) {
  int wave = (blockIdx.x * blockDim.x + threadIdx.x) >> 6, lane = threadIdx.x & 63;
  if (wave >= TT) return;
  float* CY = (float*)(p.ws + OFF_CY) + (size_t)wave * 256;
  float v[4]; float s = 0.f;
#pragma unroll
  for (int i = 0; i < 4; ++i) { v[i] = CY[lane + 64 * i]; s += v[i]; }
  float mu = wave_sum(s) * (1.f / 256.f); float q = 0.f;
#pragma unroll
  for (int i = 0; i < 4; ++i) { float d = v[i] - mu; q += d * d; }
  float rs = rsqrtf(wave_sum(q) * (1.f / 256.f) + EPS);
#pragma unroll
  for (int i = 0; i < 4; ++i) { int c = lane + 64 * i; float z = (v[i] - mu) * rs * p.cv_ln_g[layer * 256 + c] + p.cv_ln_b[layer * 256 + c]; CY[c] = silu(z); }
}
__global__ void k_conv3(Params p, int layer) {
  long gid = (long)blockIdx.x * blockDim.x + threadIdx.x;
  if (gid >= (long)TT * 256) return;
  int r = gid / 256, d = gid % 256;
  const float* z = (const float*)(p.ws + OFF_CY) + (size_t)r * 256;
  const float* w = p.w_cv_pw + (size_t)layer * 256 * 256 + d;
  float acc = 0.f;
  for (int k = 0; k < 256; ++k) acc += z[k] * w[k * 256];
  ((bf16_t*)(p.ws + OFF_MIX))[(size_t)r * D + 768 + d] = f2bf(acc);
}

__global__ void k_f32_to_bf16(const float* src, bf16_t* dst, long n) {
  long gid = (long)blockIdx.x * blockDim.x + threadIdx.x;
  if (gid < n) dst[gid] = f2bf(src[gid]);
}

__global__ void __launch_bounds__(256) k_c2(Params p, int layer) {
  int wave = (blockIdx.x * blockDim.x + threadIdx.x) >> 6, lane = threadIdx.x & 63;
  int nw = (gridDim.x * blockDim.x) >> 6;
  float* X = (float*)(p.ws + OFF_X);
  const bf16_t* Y = (const bf16_t*)(p.ws + OFF_Y);
  bf16_t* H2 = (bf16_t*)(p.ws + OFF_MIX);
  int* cnt = (int*)(p.ws + OFF_CNT) + layer * 64;
  int* EID = (int*)(p.ws + OFF_EID); float* GATE = (float*)(p.ws + OFF_GATE); int* LIST = (int*)(p.ws + OFF_LIST);
  int r0 = layer == 0 ? 0 : NCTX;
  for (int r = r0 + wave; r < TT; r += nw) {
    int s = r < NCTX ? 1 : 0;
    const float* modp = (const float*)(p.ws + OFF_MOD) + (layer * 2 + s) * 6144;
    const float* g1 = modp + 2 * D; const float* sh2 = modp + 3 * D; const float* sc2 = modp + 4 * D;
    const float* xin = layer == 0 ? (r < NCTX ? p.ctx + (size_t)r * D : p.x + (size_t)(r - NCTX) * D) : X + (size_t)r * D;
    float v[16]; float sum = 0.f;
#pragma unroll
    for (int i = 0; i < 16; ++i) { int c = lane + 64 * i; v[i] = ALPHA * xin[c] + g1[c] * bf2f(Y[(size_t)r * D + c]); sum += v[i]; }
    float mu = wave_sum(sum) * (1.f / D); float q = 0.f;
#pragma unroll
    for (int i = 0; i < 16; ++i) { float d = v[i] - mu; q += d * d; }
    float rs = rsqrtf(wave_sum(q) * (1.f / D) + EPS);
    sum = 0.f;
#pragma unroll
    for (int i = 0; i < 16; ++i) { int c = lane + 64 * i; v[i] = (v[i] - mu) * rs * p.ln1_g[layer * D + c] + p.ln1_b[layer * D + c]; X[(size_t)r * D + c] = v[i]; sum += v[i]; }
    mu = wave_sum(sum) * (1.f / D); q = 0.f;
#pragma unroll
    for (int i = 0; i < 16; ++i) { float d = v[i] - mu; q += d * d; }
    rs = rsqrtf(wave_sum(q) * (1.f / D) + EPS);
#pragma unroll
    for (int i = 0; i < 16; ++i) { int c = lane + 64 * i; v[i] = (v[i] - mu) * rs * (1.f + sc2[c]) + sh2[c]; H2[(size_t)r * D + c] = f2bf(v[i]); }
    float lg[4];
#pragma unroll
    for (int g = 0; g < 4; ++g) {
      float a = 0.f;
#pragma unroll
      for (int i = 0; i < 16; ++i) a += v[i] * p.w_rg[((size_t)layer * D + lane + 64 * i) * 4 + g];
      lg[g] = wave_sum(a) + p.b_rg[layer * 4 + g];
    }
    int gsel = 0; float gm = lg[0];
#pragma unroll
    for (int g = 1; g < 4; ++g) if (lg[g] > gm) { gm = lg[g]; gsel = g; }
    float den = 0.f;
#pragma unroll
    for (int g = 0; g < 4; ++g) den += __expf(lg[g] - gm);
    float pgrp = 1.f / den;
    float le[8];
#pragma unroll
    for (int e = 0; e < 8; ++e) {
      float a = 0.f;
#pragma unroll
      for (int i = 0; i < 16; ++i) a += v[i] * p.w_re[((size_t)layer * D + lane + 64 * i) * 32 + gsel * 8 + e];
      le[e] = wave_sum(a) + p.b_re[layer * 32 + gsel * 8 + e];
    }
    int i0 = 0; float v0 = le[0];
#pragma unroll
    for (int e = 1; e < 8; ++e) if (le[e] > v0) { v0 = le[e]; i0 = e; }
    int i1 = -1; float v1 = -1e30f;
#pragma unroll
    for (int e = 0; e < 8; ++e) if (e != i0 && le[e] > v1) { v1 = le[e]; i1 = e; }
    float e1 = __expf(v1 - v0);
    float gt0 = pgrp / (1.f + e1), gt1 = pgrp * e1 / (1.f + e1);
    if (lane == 0) {
      int ea = gsel * 8 + i0, eb = gsel * 8 + i1;
      int pa = atomicAdd(&cnt[ea], 1), pb = atomicAdd(&cnt[eb], 1);
      LIST[(size_t)ea * CAPL + pa] = r * 2 + 0;
      LIST[(size_t)eb * CAPL + pb] = r * 2 + 1;
      EID[r * 2] = ea; EID[r * 2 + 1] = eb; GATE[r * 2] = gt0; GATE[r * 2 + 1] = gt1;
    }
  }
}
__global__ void k_moe_offsets(Params p, int layer) {
  int* cnt = (int*)(p.ws + OFF_CNT) + layer * 64;
  if (threadIdx.x == 0) { int o = 0; for (int e = 0; e < NE; ++e) { cnt[32 + e] = o; o += (cnt[e] + 127) / 128 * 128; } }
}
__global__ void k_moe_d1(Params p, int layer) {
  int e = blockIdx.y;
  const int* cnt = (const int*)(p.ws + OFF_CNT) + layer * 64;
  int n = cnt[e], off = cnt[32 + e];
  const int* LIST = (const int*)(p.ws + OFF_LIST) + (size_t)e * CAPL;
  const bf16_t* H2 = (const bf16_t*)(p.ws + OFF_MIX);
  bf16_t* HM = (bf16_t*)(p.ws + OFF_HMID);
  const float* wg = p.w_e_gate + ((size_t)layer * NE + e) * D * DE;
  const float* wu = p.w_e_up + ((size_t)layer * NE + e) * D * DE;
  for (long gid = (long)blockIdx.x * blockDim.x + threadIdx.x; gid < (long)n * DE; gid += (long)gridDim.x * blockDim.x) {
    int i = gid / DE, j = gid % DE;
    int tok = LIST[i] >> 1;
    const bf16_t* h = H2 + (size_t)tok * D;
    float a = 0.f, b = 0.f;
    for (int k = 0; k < D; ++k) { float hv = bf2f(h[k]); a += hv * wg[(size_t)k * DE + j]; b += hv * wu[(size_t)k * DE + j]; }
    HM[(size_t)(off + i) * DE + j] = f2bf(silu(a) * b);
  }
}
__global__ void k_moe_d2(Params p, int layer) {
  int e = blockIdx.y;
  const int* cnt = (const int*)(p.ws + OFF_CNT) + layer * 64;
  int n = cnt[e], off = cnt[32 + e];
  const int* LIST = (const int*)(p.ws + OFF_LIST) + (size_t)e * CAPL;
  const bf16_t* HM = (const bf16_t*)(p.ws + OFF_HMID);
  const float* GATE = (const float*)(p.ws + OFF_GATE);
  bf16_t* OM = (bf16_t*)(p.ws + OFF_OMOE);
  const float* wd = p.w_e_down + ((size_t)layer * NE + e) * DE * D;
  for (long gid = (long)blockIdx.x * blockDim.x + threadIdx.x; gid < (long)n * D; gid += (long)gridDim.x * blockDim.x) {
    int i = gid / D, j = gid % D;
    int ts = LIST[i];
    const bf16_t* h = HM + (size_t)(off + i) * DE;
    float a = 0.f;
    for (int k = 0; k < DE; ++k) a += bf2f(h[k]) * wd[(size_t)k * D + j];
    OM[(size_t)ts * D + j] = f2bf(a * GATE[ts]);
  }
}
__global__ void __launch_bounds__(256) k_final(Params p) {
  int wave = (blockIdx.x * blockDim.x + threadIdx.x) >> 6, lane = threadIdx.x & 63;
  int nw = (gridDim.x * blockDim.x) >> 6;
  const float* X = (const float*)(p.ws + OFF_X);
  const bf16_t* OM = (const bf16_t*)(p.ws + OFF_OMOE);
  const float* g2 = (const float*)(p.ws + OFF_MOD) + (1 * 2 + 0) * 6144 + 5 * D;
  for (int r = NCTX + wave; r < TT; r += nw) {
    float v[16]; float sum = 0.f;
#pragma unroll
    for (int i = 0; i < 16; ++i) {
      int c = lane + 64 * i;
      float o = bf2f(OM[((size_t)r * 2 + 0) * D + c]) + bf2f(OM[((size_t)r * 2 + 1) * D + c]);
      v[i] = ALPHA * X[(size_t)r * D + c] + g2[c] * o; sum += v[i];
    }
    float mu = wave_sum(sum) * (1.f / D); float q = 0.f;
#pragma unroll
    for (int i = 0; i < 16; ++i) { float d = v[i] - mu; q += d * d; }
    float rs = rsqrtf(wave_sum(q) * (1.f / D) + EPS);
#pragma unroll
    for (int i = 0; i < 16; ++i) { int c = lane + 64 * i; p.out[(size_t)(r - NCTX) * D + c] = (v[i] - mu) * rs * p.ln2_g[D + c] + p.ln2_b[D + c]; }
  }
}

extern "C" void kernel_launch(void* const* d_in, const int* in_sizes, int n_in, void* d_out, int out_size, void* d_ws, size_t ws_size,
                              hipStream_t stream) {
  if (ws_size < WS_END) { fprintf(stderr, "kernel_launch: ws too small: %zu < %zu\n", ws_size, WS_END); return; }
  Params p{};
  const float** f = (const float**)&p;
  for (int i = 0; i < 28; ++i) f[i] = (const float*)d_in[i];
  p.out = (float*)d_out; p.ws = (char*)d_ws;
  k_mod<<<48, 256, 0, stream>>>(p);
  for (int layer = 0; layer < 2; ++layer) {
    k_a0<<<2080, 256, 0, stream>>>(p, layer);
    k_gemm_naive<<<(int)(((long)TT * INW + 255) / 256), 256, 0, stream>>>((const bf16_t*)(p.ws + OFF_H), p.w_in + (size_t)layer * D * INW,
                                                                       (float*)(p.ws + OFF_P), TT, INW, D, INW);
    k_inproj_epi<<<2080, 256, 0, stream>>>(p, layer);
    k_attn_naive<<<(TT / 64) * 8, 64, 0, stream>>>(p, layer);
    k_pool1<<<TT, 256, 0, stream>>>(p);
    k_pool2<<<TT, 256, 0, stream>>>(p, layer);
    k_conv1<<<TT, 256, 0, stream>>>(p, layer);
    k_conv2<<<TT / 4, 256, 0, stream>>>(p, layer);
    k_conv3<<<TT, 256, 0, stream>>>(p, layer);
    k_gemm_naive<<<(int)(((long)TT * D + 255) / 256), 256, 0, stream>>>((const bf16_t*)(p.ws + OFF_MIX), p.w_out + (size_t)layer * D * D,
                                                                     (float*)(p.ws + OFF_P), TT, D, D, D);
    k_f32_to_bf16<<<(int)(((long)TT * D + 255) / 256), 256, 0, stream>>>((const float*)(p.ws + OFF_P), (bf16_t*)(p.ws + OFF_Y), (long)TT * D);
    k_c2<<<2080, 256, 0, stream>>>(p, layer);
    k_moe_offsets<<<1, 64, 0, stream>>>(p, layer);
    k_moe_d1<<<dim3(256, NE), 256, 0, stream>>>(p, layer);
    k_moe_d2<<<dim3(256, NE), 256, 0, stream>>>(p, layer);
  }
  k_final<<<2048, 256, 0, stream>>>(p);
}
```

```cpp
#define NAIVE_A1 0
#define NAIVE_C1 0
#define NAIVE_MOE 0
#if NAIVE_A1
#define QSCALE_NAIVE 0.125f
#else
#define QSCALE_NAIVE 0.6931471805599453f
#endif
#include <hip/hip_runtime.h>
#include <cstdio>
#include <cstdint>

typedef unsigned short bf16_t;

constexpr int D = 1024, SEQ = 16384, NCTX = 256, TT = SEQ + NCTX;
constexpr int INW = 1536, NMOD = 6;
constexpr int NE = 32, DE = 512;
constexpr int CAPL = 2 * TT;
constexpr int HMID_ROWS = 2 * TT + NE * 128;
constexpr float ALPHA = 1.41421356237309515f;
constexpr float EPS = 1e-6f;

constexpr size_t al(size_t x) { return (x + 255) / 256 * 256; }
constexpr size_t OFF_MOD = 0;
constexpr size_t OFF_ROPE = OFF_MOD + al(2 * 2 * 6144 * 4);
constexpr size_t OFF_CNT = OFF_ROPE + al(256 * 16 * 2 * 4);
constexpr size_t OFF_X = OFF_CNT + al(2 * 64 * 4 + 64);
constexpr size_t OFF_H = OFF_X + al((size_t)TT * D * 4);
constexpr size_t OFF_MIX = OFF_H + al((size_t)TT * D * 2);
constexpr size_t OFF_Y = OFF_MIX + al((size_t)TT * D * 2);
constexpr size_t OFF_Q = OFF_Y + al((size_t)TT * D * 2);
constexpr size_t OFF_K = OFF_Q + al((size_t)TT * 512 * 2);
constexpr size_t OFF_V = OFF_K + al((size_t)TT * 128 * 2);
constexpr size_t OFF_U = OFF_V + al((size_t)TT * 128 * 2);
constexpr size_t OFF_AG = OFF_U + al((size_t)TT * 256 * 4);
constexpr size_t OFF_HMID = OFF_Q;
constexpr size_t OFF_OMOE = OFF_AG + al((size_t)TT * 512 * 2);
constexpr size_t OFF_EID = OFF_OMOE + al((size_t)TT * 2 * D * 2);
constexpr size_t OFF_GATE = OFF_EID + al((size_t)TT * 2 * 4);
constexpr size_t OFF_LIST = OFF_GATE + al((size_t)TT * 2 * 4);
constexpr size_t OFF_POOL = OFF_LIST + al((size_t)NE * CAPL * 4);
constexpr size_t OFF_CY = OFF_POOL + al((size_t)TT * 256 * 4);
constexpr size_t OFF_P = OFF_OMOE;
constexpr size_t OFF_WIN = OFF_CY + al((size_t)TT * 256 * 4);
constexpr size_t OFF_WOUT = OFF_WIN + al((size_t)2 * D * INW * 2);
constexpr size_t OFF_WG = OFF_WOUT + al((size_t)2 * D * D * 2);
constexpr size_t OFF_WU = OFF_WG + al((size_t)NE * D * DE * 2);
constexpr size_t OFF_WD = OFF_WU + al((size_t)NE * D * DE * 2);
constexpr size_t WS_END = OFF_WD + al((size_t)NE * D * DE * 2);
static_assert(OFF_WIN - OFF_P >= (size_t)TT * INW * 4, "P alias too small");
static_assert(OFF_AG - OFF_HMID >= (size_t)HMID_ROWS * DE * 2, "HMID alias too small");
static_assert(WS_END < 470000000, "ws budget");

struct Params {
  const float *x, *c, *ctx, *c_ctx, *w_mod, *b_mod, *w_in, *q_gain, *k_gain, *w_pool, *pool_scale, *w_dw, *b_dw,
      *cv_ln_g, *cv_ln_b, *w_cv_pw, *w_out, *ln1_g, *ln1_b, *ln2_g, *ln2_b, *w_rg, *b_rg, *w_re, *b_re, *w_e_gate, *w_e_up, *w_e_down;
  float* out;
  char* ws;
};

__device__ __forceinline__ float bf2f(bf16_t v) { return __uint_as_float(((unsigned)v) << 16); }
__device__ __forceinline__ bf16_t f2bf(float f) {
  unsigned u = __float_as_uint(f);
  u += 0x7fffu + ((u >> 16) & 1u);
  return (bf16_t)(u >> 16);
}
__device__ __forceinline__ float wave_sum(float v) {
#pragma unroll
  for (int o = 32; o > 0; o >>= 1) v += __shfl_xor(v, o);
  return v;
}
__device__ __forceinline__ float silu(float v) { return v / (1.f + __expf(-v)); }

__global__ void k_mod(Params p) {
  float* mod = (float*)(p.ws + OFF_MOD);
  int gid = blockIdx.x * blockDim.x + threadIdx.x;
  if (gid < 2 * 6144) {
    int l = gid / 6144, col = gid % 6144;
    const float* w = p.w_mod + (size_t)l * D * 6144 + col;
    float a0 = 0.f, a1 = 0.f;
    for (int k = 0; k < D; ++k) {
      float wv = w[(size_t)k * 6144];
      a0 += silu(p.c[k]) * wv;
      a1 += silu(p.c_ctx[k]) * wv;
    }
    float b = p.b_mod[l * 6144 + col];
    mod[(l * 2 + 0) * 6144 + col] = a0 + b;
    mod[(l * 2 + 1) * 6144 + col] = a1 + b;
  }
  if (gid < 256 * 16) {
    int pos = gid / 16, f = gid % 16;
    float inv = powf(10000.f, -(float)f / 16.f);
    float ang = (float)pos * inv;
    float* rt = (float*)(p.ws + OFF_ROPE);
    rt[gid * 2 + 0] = cosf(ang);
    rt[gid * 2 + 1] = sinf(ang);
  }
  if (gid < 128) ((int*)(p.ws + OFF_CNT))[gid] = 0;
  if (gid == 0) {
    float bmax = 0.f;
    for (int l = 0; l < 2; ++l) {
      float gq = 0.f, gk = 0.f;
      for (int i = 0; i < 64; ++i) { gq = fmaxf(gq, fabsf(p.q_gain[l * 64 + i])); gk = fmaxf(gk, fabsf(p.k_gain[l * 64 + i])); }
      bmax = fmaxf(bmax, 11.55f * gq * gk);
    }
    ((int*)(p.ws + OFF_CNT))[128] = (bmax <= 100.f) ? 1 : 0;
  }
}

__global__ void __launch_bounds__(256) k_a0(Params p, int layer) {
  int wave = (blockIdx.x * blockDim.x + threadIdx.x) >> 6, lane = threadIdx.x & 63;
  int nw = (gridDim.x * blockDim.x) >> 6;
  float* X = (float*)(p.ws + OFF_X);
  bf16_t* H = (bf16_t*)(p.ws + OFF_H);
  const bf16_t* OM = (const bf16_t*)(p.ws + OFF_OMOE);
  for (int r = wave; r < TT; r += nw) {
    int s = r < NCTX ? 1 : 0;
    float v[16];
    if (layer == 0) {
      const float* src = r < NCTX ? p.ctx + (size_t)r * D : p.x + (size_t)(r - NCTX) * D;
#pragma unroll
      for (int i = 0; i < 16; ++i) v[i] = src[lane + 64 * i];
    } else {
      const float* modp = (const float*)(p.ws + OFF_MOD) + ((layer - 1) * 2 + s) * 6144;
      const float* g2 = modp + 5 * D;
      float sum = 0.f;
#pragma unroll
      for (int i = 0; i < 16; ++i) {
        int c = lane + 64 * i;
        float o = bf2f(OM[((size_t)r * 2 + 0) * D + c]) + bf2f(OM[((size_t)r * 2 + 1) * D + c]);
        v[i] = ALPHA * X[(size_t)r * D + c] + g2[c] * o;
        sum += v[i];
      }
      float mu = wave_sum(sum) * (1.f / D);
      float q = 0.f;
#pragma unroll
      for (int i = 0; i < 16; ++i) { float d = v[i] - mu; q += d * d; }
      float rs = rsqrtf(wave_sum(q) * (1.f / D) + EPS);
      const float* g = p.ln2_g + (layer - 1) * D; const float* b = p.ln2_b + (layer - 1) * D;
#pragma unroll
      for (int i = 0; i < 16; ++i) { int c = lane + 64 * i; v[i] = (v[i] - mu) * rs * g[c] + b[c]; X[(size_t)r * D + c] = v[i]; }
    }
    const float* modp = (const float*)(p.ws + OFF_MOD) + (layer * 2 + s) * 6144;
    const float* sh = modp; const float* sc = modp + D;
    float sum = 0.f;
#pragma unroll
    for (int i = 0; i < 16; ++i) sum += v[i];
    float mu = wave_sum(sum) * (1.f / D);
    float q = 0.f;
#pragma unroll
    for (int i = 0; i < 16; ++i) { float d = v[i] - mu; q += d * d; }
    float rs = rsqrtf(wave_sum(q) * (1.f / D) + EPS);
#pragma unroll
    for (int i = 0; i < 16; ++i) { int c = lane + 64 * i; H[(size_t)r * D + c] = f2bf((v[i] - mu) * rs * (1.f + sc[c]) + sh[c]); }
  }
}

__global__ void k_gemm_naive(const bf16_t* A, const float* B, float* C, int M, int N, int K, int ldc) {
  long gid = (long)blockIdx.x * blockDim.x + threadIdx.x;
  if (gid >= (long)M * N) return;
  int m = gid / N, n = gid % N;
  const bf16_t* a = A + (size_t)m * K;
  float acc = 0.f;
  for (int k = 0; k < K; ++k) acc += bf2f(a[k]) * B[(size_t)k * N + n];
  C[(size_t)m * ldc + n] = acc;
}

__global__ void __launch_bounds__(256) k_inproj_epi(Params p, int layer) {
  int wave = (blockIdx.x * blockDim.x + threadIdx.x) >> 6, lane = threadIdx.x & 63;
  int nw = (gridDim.x * blockDim.x) >> 6;
  const float* P = (const float*)(p.ws + OFF_P);
  bf16_t* Q = (bf16_t*)(p.ws + OFF_Q); bf16_t* Kb = (bf16_t*)(p.ws + OFF_K); bf16_t* Vb = (bf16_t*)(p.ws + OFF_V);
  float* U = (float*)(p.ws + OFF_U); bf16_t* AG = (bf16_t*)(p.ws + OFF_AG);
  const float* rt = (const float*)(p.ws + OFF_ROPE);
  for (int r = wave; r < TT; r += nw) {
    const float* pr = P + (size_t)r * INW;
    bool lat = r >= NCTX;
    int t = r - NCTX; int prow = t / 64, pcol = t % 64;
    for (int hh = 0; hh < 10; ++hh) {
      float v = pr[hh * 64 + lane];
      float ss = wave_sum(v * v) * (1.f / 64.f);
      float gain = hh < 8 ? p.q_gain[layer * 64 + lane] : p.k_gain[layer * 64 + lane];
      float n = v * rsqrtf(ss + EPS) * gain;
      if (lat) {
        int axis = lane >> 5, half = (lane >> 4) & 1, f = lane & 15;
        float other = __shfl_xor(n, 16);
        int pos = axis == 0 ? prow : pcol;
        float cs = rt[(pos * 16 + f) * 2], sn = rt[(pos * 16 + f) * 2 + 1];
        n = half == 0 ? n * cs - other * sn : n * cs + other * sn;
      }
      if (hh < 8) Q[(size_t)r * 512 + hh * 64 + lane] = f2bf(n);
      else Kb[(size_t)r * 128 + (hh - 8) * 64 + lane] = f2bf(n);
    }
    for (int i = 0; i < 2; ++i) Vb[(size_t)r * 128 + i * 64 + lane] = f2bf(pr[640 + i * 64 + lane]);
    for (int i = 0; i < 4; ++i) U[(size_t)r * 256 + i * 64 + lane] = pr[768 + i * 64 + lane];
    for (int i = 0; i < 8; ++i) AG[(size_t)r * 512 + i * 64 + lane] = f2bf(pr[1024 + i * 64 + lane]);
  }
}

__global__ void __launch_bounds__(64) k_attn_naive(Params p, int layer) {
  if (((const int*)(p.ws + OFF_CNT))[128] != 0) return;
  int head = blockIdx.x & 7, rg = blockIdx.x >> 3;
  int r = rg * 64 + threadIdx.x;
  bool lat = r >= NCTX;
  if (!lat && layer == 1) return;
  const bf16_t* Q = (const bf16_t*)(p.ws + OFF_Q); const bf16_t* Kb = (const bf16_t*)(p.ws + OFF_K); const bf16_t* Vb = (const bf16_t*)(p.ws + OFF_V);
  bf16_t* MIX = (bf16_t*)(p.ws + OFF_MIX);
  int kvh = head >> 2;
  float q[64], o[64];
#pragma unroll
  for (int d = 0; d < 64; ++d) { q[d] = bf2f(Q[(size_t)r * 512 + head * 64 + d]) * QSCALE_NAIVE; o[d] = 0.f; }
  float m = -1e30f, l = 0.f;
  int nk = lat ? TT : NCTX;
  for (int j = 0; j < nk; ++j) {
    const bf16_t* kr = Kb + (size_t)j * 128 + kvh * 64;
    const bf16_t* vr = Vb + (size_t)j * 128 + kvh * 64;
    float s = 0.f;
#pragma unroll
    for (int d = 0; d < 64; ++d) s += q[d] * bf2f(kr[d]);
    if (s > m) {
      float a = __expf(m - s);
      l *= a;
#pragma unroll
      for (int d = 0; d < 64; ++d) o[d] *= a;
      m = s;
    }
    float pe = __expf(s - m);
    l += pe;
#pragma unroll
    for (int d = 0; d < 64; ++d) o[d] += pe * bf2f(vr[d]);
  }
  float il = 1.f / l;
#pragma unroll
  for (int d = 0; d < 64; ++d) MIX[(size_t)r * D + head * 64 + d] = f2bf(o[d] * il);
}

__global__ void k_pool1(Params p) {
  long gid = (long)blockIdx.x * blockDim.x + threadIdx.x;
  if (gid >= (long)TT * 256) return;
  int r = gid / 256, c = gid % 256, gi = c / 64;
  int w = 2 << gi;
  const float* U = (const float*)(p.ws + OFF_U);
  int base = r < NCTX ? 0 : NCTX, n = r < NCTX ? NCTX : SEQ, t = r - base;
  int lo = max(t - w / 2, 0), hi = min(t + w / 2, n);
  float s = 0.f;
  for (int j = lo; j < hi; ++j) s += U[(size_t)(base + j) * 256 + c];
  ((float*)(p.ws + OFF_POOL))[gid] = s / (float)(hi - lo) - U[(size_t)r * 256 + c];
}
__global__ void k_pool2(Params p, int layer) {
  long gid = (long)blockIdx.x * blockDim.x + threadIdx.x;
  if (gid >= (long)TT * 256) return;
  int r = gid / 256, c = gid % 256, gi = c / 64, d = c % 64;
  const float* PL = (const float*)(p.ws + OFF_POOL) + (size_t)r * 256 + gi * 64;
  const float* w = p.w_pool + (size_t)layer * 4 * 64 * 64 + (size_t)gi * 64 * 64 + d;
  float acc = 0.f;
  for (int k = 0; k < 64; ++k) acc += PL[k] * w[k * 64];
  ((bf16_t*)(p.ws + OFF_MIX))[(size_t)r * D + 512 + c] = f2bf(acc * p.pool_scale[layer * 256 + c]);
}
__global__ void k_conv1(Params p, int layer) {
  long gid = (long)blockIdx.x * blockDim.x + threadIdx.x;
  if (gid >= (long)TT * 256) return;
  int r = gid / 256, c = gid % 256;
  const bf16_t* AG = (const bf16_t*)(p.ws + OFF_AG);
  int base = r < NCTX ? 0 : NCTX, n = r < NCTX ? NCTX : SEQ, t = r - base;
  float acc = p.b_dw[layer * 256 + c];
  for (int j = 0; j < 31; ++j) {
    int tt = t + j - 15;
    if (tt < 0 || tt >= n) continue;
    float a = bf2f(AG[(size_t)(base + tt) * 512 + c]), g = bf2f(AG[(size_t)(base + tt) * 512 + 256 + c]);
    float u = a / (1.f + __expf(-g));
    acc += u * p.w_dw[(size_t)layer * 31 * 256 + j * 256 + c];
  }
  ((float*)(p.ws + OFF_CY))[gid] = acc;
}
__global__ void k_conv2(Params p, int layer) {
  int wave = (blockIdx.x * blockDim.x + threadIdx.x) >> 6, lane = threadIdx.x & 63;
  if (wave >= TT) return;
  float* CY = (float*)(p.ws + OFF_CY) + (size_t)wave * 256;
  float v[4]; float s = 0.f;
#pragma unroll
  for (int i = 0; i < 4; ++i) { v[i] = CY[lane + 64 * i]; s += v[i]; }
  float mu = wave_sum(s) * (1.f / 256.f); float q = 0.f;
#pragma unroll
  for (int i = 0; i < 4; ++i) { float d = v[i] - mu; q += d * d; }
  float rs = rsqrtf(wave_sum(q) * (1.f / 256.f) + EPS);
#pragma unroll
  for (int i = 0; i < 4; ++i) { int c = lane + 64 * i; float z = (v[i] - mu) * rs * p.cv_ln_g[layer * 256 + c] + p.cv_ln_b[layer * 256 + c]; CY[c] = silu(z); }
}
__global__ void k_conv3(Params p, int layer) {
  long gid = (long)blockIdx.x * blockDim.x + threadIdx.x;
  if (gid >= (long)TT * 256) return;
  int r = gid / 256, d = gid % 256;
  const float* z = (const float*)(p.ws + OFF_CY) + (size_t)r * 256;
  const float* w = p.w_cv_pw + (size_t)layer * 256 * 256 + d;
  float acc = 0.f;
  for (int k = 0; k < 256; ++k) acc += z[k] * w[k * 256];
  ((bf16_t*)(p.ws + OFF_MIX))[(size_t)r * D + 768 + d] = f2bf(acc);
}

__global__ void k_f32_to_bf16(const float* src, bf16_t* dst, long n) {
  long gid = (long)blockIdx.x * blockDim.x + threadIdx.x;
  if (gid < n) dst[gid] = f2bf(src[gid]);
}

__global__ void __launch_bounds__(256) k_c2(Params p, int layer) {
  int wave = (blockIdx.x * blockDim.x + threadIdx.x) >> 6, lane = threadIdx.x & 63;
  int nw = (gridDim.x * blockDim.x) >> 6;
  float* X = (float*)(p.ws + OFF_X);
  const bf16_t* Y = (const bf16_t*)(p.ws + OFF_Y);
  bf16_t* H2 = (bf16_t*)(p.ws + OFF_MIX);
  int* cnt = (int*)(p.ws + OFF_CNT) + layer * 64;
  int* EID = (int*)(p.ws + OFF_EID); float* GATE = (float*)(p.ws + OFF_GATE); int* LIST = (int*)(p.ws + OFF_LIST);
  int r0 = layer == 0 ? 0 : NCTX;
  for (int r = r0 + wave; r < TT; r += nw) {
    int s = r < NCTX ? 1 : 0;
    const float* modp = (const float*)(p.ws + OFF_MOD) + (layer * 2 + s) * 6144;
    const float* g1 = modp + 2 * D; const float* sh2 = modp + 3 * D; const float* sc2 = modp + 4 * D;
    const float* xin = layer == 0 ? (r < NCTX ? p.ctx + (size_t)r * D : p.x + (size_t)(r - NCTX) * D) : X + (size_t)r * D;
    float v[16]; float sum = 0.f;
#pragma unroll
    for (int i = 0; i < 16; ++i) { int c = lane + 64 * i; v[i] = ALPHA * xin[c] + g1[c] * bf2f(Y[(size_t)r * D + c]); sum += v[i]; }
    float mu = wave_sum(sum) * (1.f / D); float q = 0.f;
#pragma unroll
    for (int i = 0; i < 16; ++i) { float d = v[i] - mu; q += d * d; }
    float rs = rsqrtf(wave_sum(q) * (1.f / D) + EPS);
    sum = 0.f;
#pragma unroll
    for (int i = 0; i < 16; ++i) { int c = lane + 64 * i; v[i] = (v[i] - mu) * rs * p.ln1_g[layer * D + c] + p.ln1_b[layer * D + c]; X[(size_t)r * D + c] = v[i]; sum += v[i]; }
    mu = wave_sum(sum) * (1.f / D); q = 0.f;
#pragma unroll
    for (int i = 0; i < 16; ++i) { float d = v[i] - mu; q += d * d; }
    rs = rsqrtf(wave_sum(q) * (1.f / D) + EPS);
#pragma unroll
    for (int i = 0; i < 16; ++i) { int c = lane + 64 * i; v[i] = (v[i] - mu) * rs * (1.f + sc2[c]) + sh2[c]; H2[(size_t)r * D + c] = f2bf(v[i]); }
    float lg[4];
#pragma unroll
    for (int g = 0; g < 4; ++g) {
      float a = 0.f;
#pragma unroll
      for (int i = 0; i < 16; ++i) a += v[i] * p.w_rg[((size_t)layer * D + lane + 64 * i) * 4 + g];
      lg[g] = wave_sum(a) + p.b_rg[layer * 4 + g];
    }
    int gsel = 0; float gm = lg[0];
#pragma unroll
    for (int g = 1; g < 4; ++g) if (lg[g] > gm) { gm = lg[g]; gsel = g; }
    float den = 0.f;
#pragma unroll
    for (int g = 0; g < 4; ++g) den += __expf(lg[g] - gm);
    float pgrp = 1.f / den;
    float le[8];
#pragma unroll
    for (int e = 0; e < 8; ++e) {
      float a = 0.f;
#pragma unroll
      for (int i = 0; i < 16; ++i) a += v[i] * p.w_re[((size_t)layer * D + lane + 64 * i) * 32 + gsel * 8 + e];
      le[e] = wave_sum(a) + p.b_re[layer * 32 + gsel * 8 + e];
    }
    int i0 = 0; float v0 = le[0];
#pragma unroll
    for (int e = 1; e < 8; ++e) if (le[e] > v0) { v0 = le[e]; i0 = e; }
    int i1 = -1; float v1 = -1e30f;
#pragma unroll
    for (int e = 0; e < 8; ++e) if (e != i0 && le[e] > v1) { v1 = le[e]; i1 = e; }
    if (i1 < 0) { i1 = (i0 + 1) & 7; v1 = v0; }
    float e1 = __expf(v1 - v0);
    float gt0 = pgrp / (1.f + e1), gt1 = pgrp * e1 / (1.f + e1);
    if (lane == 0) {
      int ea = gsel * 8 + i0, eb = gsel * 8 + i1;
      int pa = atomicAdd(&cnt[ea], 1), pb = atomicAdd(&cnt[eb], 1);
      LIST[(size_t)ea * CAPL + pa] = r * 2 + 0;
      LIST[(size_t)eb * CAPL + pb] = r * 2 + 1;
      EID[r * 2] = ea; EID[r * 2 + 1] = eb; GATE[r * 2] = gt0; GATE[r * 2 + 1] = gt1;
    }
  }
}
__global__ void k_moe_offsets(Params p, int layer) {
  int* cnt = (int*)(p.ws + OFF_CNT) + layer * 64;
  if (threadIdx.x == 0) { int o = 0; for (int e = 0; e < NE; ++e) { cnt[32 + e] = o; o += (cnt[e] + 127) / 128 * 128; } }
}
__global__ void k_moe_d1(Params p, int layer) {
  int e = blockIdx.y;
  const int* cnt = (const int*)(p.ws + OFF_CNT) + layer * 64;
  int n = cnt[e], off = cnt[32 + e];
  const int* LIST = (const int*)(p.ws + OFF_LIST) + (size_t)e * CAPL;
  const bf16_t* H2 = (const bf16_t*)(p.ws + OFF_MIX);
  bf16_t* HM = (bf16_t*)(p.ws + OFF_HMID);
  const float* wg = p.w_e_gate + ((size_t)layer * NE + e) * D * DE;
  const float* wu = p.w_e_up + ((size_t)layer * NE + e) * D * DE;
  for (long gid = (long)blockIdx.x * blockDim.x + threadIdx.x; gid < (long)n * DE; gid += (long)gridDim.x * blockDim.x) {
    int i = gid / DE, j = gid % DE;
    int tok = LIST[i] >> 1;
    const bf16_t* h = H2 + (size_t)tok * D;
    float a = 0.f, b = 0.f;
    for (int k = 0; k < D; ++k) { float hv = bf2f(h[k]); a += hv * wg[(size_t)k * DE + j]; b += hv * wu[(size_t)k * DE + j]; }
    HM[(size_t)(off + i) * DE + j] = f2bf(silu(a) * b);
  }
}
__global__ void k_moe_d2(Params p, int layer) {
  int e = blockIdx.y;
  const int* cnt = (const int*)(p.ws + OFF_CNT) + layer * 64;
  int n = cnt[e], off = cnt[32 + e];
  const int* LIST = (const int*)(p.ws + OFF_LIST) + (size_t)e * CAPL;
  const bf16_t* HM = (const bf16_t*)(p.ws + OFF_HMID);
  const float* GATE = (const float*)(p.ws + OFF_GATE);
  bf16_t* OM = (bf16_t*)(p.ws + OFF_OMOE);
  const float* wd = p.w_e_down + ((size_t)layer * NE + e) * DE * D;
  for (long gid = (long)blockIdx.x * blockDim.x + threadIdx.x; gid < (long)n * D; gid += (long)gridDim.x * blockDim.x) {
    int i = gid / D, j = gid % D;
    int ts = LIST[i];
    const bf16_t* h = HM + (size_t)(off + i) * DE;
    float a = 0.f;
    for (int k = 0; k < DE; ++k) a += bf2f(h[k]) * wd[(size_t)k * D + j];
    OM[(size_t)ts * D + j] = f2bf(a * GATE[ts]);
  }
}
__global__ void __launch_bounds__(256) k_final(Params p) {
  int wave = (blockIdx.x * blockDim.x + threadIdx.x) >> 6, lane = threadIdx.x & 63;
  int nw = (gridDim.x * blockDim.x) >> 6;
  const float* X = (const float*)(p.ws + OFF_X);
  const bf16_t* OM = (const bf16_t*)(p.ws + OFF_OMOE);
  const float* g2 = (const float*)(p.ws + OFF_MOD) + (1 * 2 + 0) * 6144 + 5 * D;
  for (int r = NCTX + wave; r < TT; r += nw) {
    float v[16]; float sum = 0.f;
#pragma unroll
    for (int i = 0; i < 16; ++i) {
      int c = lane + 64 * i;
      float o = bf2f(OM[((size_t)r * 2 + 0) * D + c]) + bf2f(OM[((size_t)r * 2 + 1) * D + c]);
      v[i] = ALPHA * X[(size_t)r * D + c] + g2[c] * o; sum += v[i];
    }
    float mu = wave_sum(sum) * (1.f / D); float q = 0.f;
#pragma unroll
    for (int i = 0; i < 16; ++i) { float d = v[i] - mu; q += d * d; }
    float rs = rsqrtf(wave_sum(q) * (1.f / D) + EPS);
#pragma unroll
    for (int i = 0; i < 16; ++i) { int c = lane + 64 * i; p.out[(size_t)(r - NCTX) * D + c] = (v[i] - mu) * rs * p.ln2_g[D + c] + p.ln2_b[D + c]; }
  }
}

#define LAS __attribute__((address_space(3)))
using bf16x8 = __attribute__((ext_vector_type(8))) short;
using s16x4 = __attribute__((ext_vector_type(4))) short;
using f32x16 = __attribute__((ext_vector_type(16))) float;
using f32x4 = __attribute__((ext_vector_type(4))) float;
using u32x4 = __attribute__((ext_vector_type(4))) unsigned;
using u32x2 = __attribute__((ext_vector_type(2))) unsigned;

__device__ __forceinline__ int crow(int r, int hi) { return (r & 3) + 8 * (r >> 2) + 4 * hi; }
typedef float f32x2 __attribute__((ext_vector_type(2)));
typedef __bf16 bf16x2v __attribute__((ext_vector_type(2)));
__device__ __forceinline__ unsigned cvtpk(float lo, float hi) {
  bf16x2v b = __builtin_convertvector((f32x2){lo, hi}, bf16x2v);
  return __builtin_bit_cast(unsigned, b);
}
__device__ __forceinline__ float sum32(float v) {
  auto rr = __builtin_amdgcn_permlane32_swap(__float_as_uint(v), __float_as_uint(v), false, false);
  return __uint_as_float(rr[0]) + __uint_as_float(rr[1]);
}

__device__ __forceinline__ void cvt_range(const float* __restrict__ src, bf16_t* __restrict__ dst, long n8, long gtid, long gthreads) {
  for (long i = gtid; i < n8; i += gthreads) {
    const f32x4 a = *(const f32x4*)(src + i * 8), b = *(const f32x4*)(src + i * 8 + 4);
    u32x4 w = {cvtpk(a[0], a[1]), cvtpk(a[2], a[3]), cvtpk(b[0], b[1]), cvtpk(b[2], b[3])};
    *(u32x4*)(dst + i * 8) = w;
  }
}

__device__ __forceinline__ int xoff(int row, int chunk) { return row * 128 + ((chunk ^ ((row >> 1) & 7)) << 4); }
__device__ __forceinline__ int wst(int k, int c) { const int kk = (k & ~0xC) | ((k & 4) << 1) | ((k & 8) >> 1); return ((kk >> 3) * 4 + (c >> 5)) * 512 + ((kk & 7) * 32 + (c & 31)) * 2; }
__device__ __forceinline__ int v_rd_base(int lane) { return ((lane & 3) << 3) | (((lane >> 2) & 3) << 6) | (((lane >> 4) & 1) << 5) | (((lane >> 5) & 1) << 8); }

__device__ __forceinline__ bf16x8 tr_frag(const LAS char* p) {
  s16x4 a = __builtin_amdgcn_ds_read_tr16_b64_v4i16((LAS s16x4*)p);
  s16x4 b = __builtin_amdgcn_ds_read_tr16_b64_v4i16((LAS s16x4*)(p + 2048));
  return (bf16x8){a[0], a[1], a[2], a[3], b[0], b[1], b[2], b[3]};
}

template <int BM, int BN> struct GemmCfg {
  static constexpr int WM = BM / 64, WN = 8 / WM, NSLAB = BN / 128, XB = BM * 128, WB = NSLAB * 16384, STAGE = XB + WB, NXP = BM / 64, NWP = NSLAB * 2;
  static_assert(WM * WN == 8 && WN * 64 == BN, "tile");
};
constexpr int GEMM_LDS = 2 * (256 * 128 + 16384);

template <int BM, int BN, int NMAP, class XRow, class WPtr>
__device__ __forceinline__ void gemm_mainloop(LAS char* lds, f32x16 (&acc)[2][2], const XRow& xrow, const WPtr& wptr, int ldw, int K) {
  using C = GemmCfg<BM, BN>;
  const int tid = threadIdx.x, wid = tid >> 6, lane = tid & 63, r32 = lane & 31, hi = lane >> 5;
  const int wm = wid / C::WN, wn = wid % C::WN;
  const bf16_t* xg[C::NXP]; int xl[C::NXP];
#pragma unroll
  for (int i = 0; i < C::NXP; ++i) { const int row = (tid >> 3) + 64 * i; xg[i] = xrow(row) + (tid & 7) * 8; xl[i] = xoff(row, tid & 7); }
  const bf16_t* wg[C::NWP]; int wl[C::NWP];
#pragma unroll
  for (int i = 0; i < C::NWP; ++i) { const int s = i >> 1, k = (tid >> 4) + 32 * (i & 1), c = (tid & 15) * 8; wg[i] = wptr(s) + (size_t)k * ldw + c; wl[i] = C::XB + s * 16384 + wst(k, c); }
  int xr[2];
#pragma unroll
  for (int ti = 0; ti < 2; ++ti) xr[ti] = (wm * 64 + ti * 32 + r32) * 128;
  const int xsw = (r32 >> 1) & 7;
  int wr[2];
#pragma unroll
  for (int ni = 0; ni < 2; ++ni) {
    const int slab = NMAP == 0 ? 0 : (NMAP == 1 ? (wn >> 1) : ni);
    const int nb = NMAP == 0 ? (2 * wn + ni) : (NMAP == 1 ? ((wn & 1) * 2 + ni) : wn);
    wr[ni] = C::XB + slab * 16384 + nb * 512 + v_rd_base(lane);
  }
  u32x4 xs[C::NXP], wsr[C::NWP];
  const int nk = K / 64;
#pragma unroll
  for (int i = 0; i < C::NXP; ++i) xs[i] = *(const u32x4*)(xg[i]);
#pragma unroll
  for (int i = 0; i < C::NWP; ++i) wsr[i] = *(const u32x4*)(wg[i]);
#pragma unroll
  for (int i = 0; i < C::NXP; ++i) *(LAS u32x4*)(lds + xl[i]) = xs[i];
#pragma unroll
  for (int i = 0; i < C::NWP; ++i) *(LAS u32x4*)(lds + wl[i]) = wsr[i];
  __syncthreads();
  for (int kt = 0; kt < nk; ++kt) {
    const LAS char* cur = lds + (kt & 1) * C::STAGE;
    LAS char* nxt = lds + ((kt + 1) & 1) * C::STAGE;
    const bool more = kt + 1 < nk;
    if (more) {
#pragma unroll
      for (int i = 0; i < C::NXP; ++i) xs[i] = *(const u32x4*)(xg[i] + (kt + 1) * 64);
#pragma unroll
      for (int i = 0; i < C::NWP; ++i) wsr[i] = *(const u32x4*)(wg[i] + (size_t)(kt + 1) * 64 * ldw);
    }
#pragma unroll
    for (int ks = 0; ks < 4; ++ks) {
      bf16x8 xf[2], wf[2];
#pragma unroll
      for (int ti = 0; ti < 2; ++ti) xf[ti] = *(const LAS bf16x8*)(cur + xr[ti] + (((ks * 2 + hi) ^ xsw) << 4));
#pragma unroll
      for (int ni = 0; ni < 2; ++ni) wf[ni] = tr_frag(cur + wr[ni] + ks * 4096);
#pragma unroll
      for (int ti = 0; ti < 2; ++ti)
#pragma unroll
        for (int ni = 0; ni < 2; ++ni) acc[ti][ni] = __builtin_amdgcn_mfma_f32_32x32x16_bf16(wf[ni], xf[ti], acc[ti][ni], 0, 0, 0);
    }
    if (more) {
#pragma unroll
      for (int i = 0; i < C::NXP; ++i) *(LAS u32x4*)(nxt + xl[i]) = xs[i];
#pragma unroll
      for (int i = 0; i < C::NWP; ++i) *(LAS u32x4*)(nxt + wl[i]) = wsr[i];
    }
    __syncthreads();
  }
}

__device__ __forceinline__ u32x2 pack4(const f32x16& a, int g) { return (u32x2){cvtpk(a[4 * g], a[4 * g + 1]), cvtpk(a[4 * g + 2], a[4 * g + 3])}; }

__device__ __forceinline__ void phase_a1(const Params& p, int layer, LAS char* lds, int bid, int nblk) {
  const bf16_t* H = (const bf16_t*)(p.ws + OFF_H);
  const bf16_t* W = (const bf16_t*)(p.ws + OFF_WIN) + (size_t)layer * D * INW;
  bf16_t* Q = (bf16_t*)(p.ws + OFF_Q); bf16_t* Kb = (bf16_t*)(p.ws + OFF_K); bf16_t* Vb = (bf16_t*)(p.ws + OFF_V);
  float* U = (float*)(p.ws + OFF_U); bf16_t* AG = (bf16_t*)(p.ws + OFF_AG);
  const float* rt = (const float*)(p.ws + OFF_ROPE);
  const int lane = threadIdx.x & 63, wid = threadIdx.x >> 6, r32 = lane & 31, hi = lane >> 5, wm = wid >> 1, wn = wid & 1;
  const int nlat = 64 * 12, nunits = nlat + (layer == 0 ? 12 : 2);
  for (int u = bid; u < nunits; u += nblk) {
    int rtile, ct;
    if (u < nlat) { rtile = 1 + u / 12; ct = u % 12; } else { rtile = 0; ct = layer == 0 ? (u - nlat) : (4 + u - nlat); }
    const int m0 = rtile * 256, n0 = ct * 128;
    f32x16 acc[2][2];
#pragma unroll
    for (int a = 0; a < 2; ++a)
#pragma unroll
      for (int b = 0; b < 2; ++b) acc[a][b] = (f32x16){};
    gemm_mainloop<256, 128, 0>(lds, acc, [&](int row) { return H + (size_t)(m0 + row) * D; }, [&](int) { return W + n0; }, INW, D);
#pragma unroll
    for (int ti = 0; ti < 2; ++ti) {
      const int tok = m0 + wm * 64 + ti * 32 + r32;
      if (ct < 5) {
        float ss = 0.f;
#pragma unroll
        for (int ni = 0; ni < 2; ++ni)
#pragma unroll
          for (int r = 0; r < 16; ++r) ss += acc[ti][ni][r] * acc[ti][ni][r];
        ss = sum32(ss);
        const float rs = rsqrtf(ss * (1.f / 64.f) + EPS);
        const float* gain = (ct < 4 ? p.q_gain : p.k_gain) + layer * 64;
        const float osc = ct < 4 ? 0.125f * 1.4426950408889634f : 1.f;
        const bool lat = rtile > 0;
        const int t = tok - NCTX;
#pragma unroll
        for (int ni = 0; ni < 2; ++ni) {
          f32x16 v;
#pragma unroll
          for (int r = 0; r < 16; ++r) v[r] = acc[ti][ni][r] * rs * gain[ni * 32 + crow(r, hi)];
          if (lat) {
            const int pos = ni == 0 ? (t >> 6) : (t & 63);
#pragma unroll
            for (int r = 0; r < 8; ++r) {
              const int f = crow(r, hi);
              const float cs = rt[(pos * 16 + f) * 2], sn = rt[(pos * 16 + f) * 2 + 1];
              const float t1 = v[r], t2 = v[r + 8];
              v[r] = t1 * cs - t2 * sn; v[r + 8] = t2 * cs + t1 * sn;
            }
          }
#pragma unroll
          for (int r = 0; r < 16; ++r) v[r] *= osc;
          bf16_t* dst = ct < 4 ? Q + (size_t)tok * 512 + (ct * 2 + wn) * 64 + ni * 32 : Kb + (size_t)tok * 128 + wn * 64 + ni * 32;
#pragma unroll
          for (int g = 0; g < 4; ++g) *(u32x2*)(dst + 8 * g + 4 * hi) = pack4(v, g);
        }
      } else if (ct == 5) {
#pragma unroll
        for (int ni = 0; ni < 2; ++ni)
#pragma unroll
          for (int g = 0; g < 4; ++g) *(u32x2*)(Vb + (size_t)tok * 128 + wn * 64 + ni * 32 + 8 * g + 4 * hi) = pack4(acc[ti][ni], g);
      } else if (ct < 8) {
#pragma unroll
        for (int ni = 0; ni < 2; ++ni)
#pragma unroll
          for (int g = 0; g < 4; ++g)
            *(f32x4*)(U + (size_t)tok * 256 + (ct - 6) * 128 + wn * 64 + ni * 32 + 8 * g + 4 * hi) =
                (f32x4){acc[ti][ni][4 * g], acc[ti][ni][4 * g + 1], acc[ti][ni][4 * g + 2], acc[ti][ni][4 * g + 3]};
      } else {
#pragma unroll
        for (int ni = 0; ni < 2; ++ni)
#pragma unroll
          for (int g = 0; g < 4; ++g) *(u32x2*)(AG + (size_t)tok * 512 + (ct - 8) * 128 + wn * 64 + ni * 32 + 8 * g + 4 * hi) = pack4(acc[ti][ni], g);
      }
    }
  }
}

__device__ __forceinline__ void phase_c1(const Params& p, int layer, LAS char* lds, int bid, int nblk) {
  const bf16_t* A = (const bf16_t*)(p.ws + OFF_MIX);
  const bf16_t* W = (const bf16_t*)(p.ws + OFF_WOUT) + (size_t)layer * D * D;
  bf16_t* Y = (bf16_t*)(p.ws + OFF_Y);
  const int lane = threadIdx.x & 63, wid = threadIdx.x >> 6, r32 = lane & 31, hi = lane >> 5, wm = wid >> 1, wn = wid & 1;
  const int rt0 = layer == 0 ? 0 : 1, nunits = (65 - rt0) * 8;
  for (int u = bid; u < nunits; u += nblk) {
    const int m0 = (rt0 + u / 8) * 256, n0 = (u % 8) * 128;
    f32x16 acc[2][2];
#pragma unroll
    for (int a = 0; a < 2; ++a)
#pragma unroll
      for (int b = 0; b < 2; ++b) acc[a][b] = (f32x16){};
    gemm_mainloop<256, 128, 0>(lds, acc, [&](int row) { return A + (size_t)(m0 + row) * D; }, [&](int) { return W + n0; }, D, D);
#pragma unroll
    for (int ti = 0; ti < 2; ++ti) {
      const int tok = m0 + wm * 64 + ti * 32 + r32;
#pragma unroll
      for (int ni = 0; ni < 2; ++ni)
#pragma unroll
        for (int g = 0; g < 4; ++g) *(u32x2*)(Y + (size_t)tok * D + n0 + wn * 64 + ni * 32 + 8 * g + 4 * hi) = pack4(acc[ti][ni], g);
    }
  }
}

__device__ __forceinline__ int moe_prefix(const int* cnt, LAS int* pre) {
  if (threadIdx.x == 0) { int o = 0; for (int e = 0; e < NE; ++e) { pre[e] = o; o += (cnt[e] + 127) >> 7; } pre[NE] = o; }
  __syncthreads();
  return pre[NE];
}
__device__ __forceinline__ int moe_find(const LAS int* pre, int g) { int e = 0; for (int i = 1; i < NE; ++i) e += (pre[i] <= g) ? 1 : 0; return e; }

__device__ __forceinline__ void phase_d1(const Params& p, int layer, LAS char* lds, int bid, int nblk) {
  const int* cnt = (const int*)(p.ws + OFF_CNT) + layer * 64;
  const bf16_t* H2 = (const bf16_t*)(p.ws + OFF_MIX);
  bf16_t* HM = (bf16_t*)(p.ws + OFF_HMID);
  LAS int* pre = (LAS int*)(lds + GEMM_LDS);
  const int ntiles = moe_prefix(cnt, pre);
  const int lane = threadIdx.x & 63, wid = threadIdx.x >> 6, r32 = lane & 31, hi = lane >> 5, wm = wid >> 2, wn = wid & 3;
  for (int u = bid; u < ntiles * 4; u += nblk) {
    const int g = u >> 2, ct = u & 3, e = moe_find(pre, g), rt = g - pre[e], n = cnt[e];
    const int* list = (const int*)(p.ws + OFF_LIST) + (size_t)e * CAPL + rt * 128;
    const bf16_t* Wg = (const bf16_t*)(p.ws + OFF_WG) + (size_t)e * D * DE + ct * 128;
    const bf16_t* Wu = (const bf16_t*)(p.ws + OFF_WU) + (size_t)e * D * DE + ct * 128;
    const int nvalid = n - rt * 128;
    f32x16 acc[2][2];
#pragma unroll
    for (int a = 0; a < 2; ++a)
#pragma unroll
      for (int b = 0; b < 2; ++b) acc[a][b] = (f32x16){};
    gemm_mainloop<128, 256, 2>(lds, acc, [&](int row) { const int tok = row < nvalid ? (list[row] >> 1) : 0; return H2 + (size_t)tok * D; },
                               [&](int s) { return s == 0 ? Wg : Wu; }, DE, D);
    const size_t hrow0 = (size_t)(pre[e] + rt) * 128;
#pragma unroll
    for (int ti = 0; ti < 2; ++ti) {
      const size_t row = hrow0 + wm * 64 + ti * 32 + r32;
      f32x16 a;
#pragma unroll
      for (int r = 0; r < 16; ++r) { const float gv = acc[ti][0][r]; a[r] = gv / (1.f + __expf(-gv)) * acc[ti][1][r]; }
#pragma unroll
      for (int gq = 0; gq < 4; ++gq) *(u32x2*)(HM + row * DE + ct * 128 + wn * 32 + 8 * gq + 4 * hi) = pack4(a, gq);
    }
  }
}

__device__ __forceinline__ void phase_d2(const Params& p, int layer, LAS char* lds, int bid, int nblk) {
  const int* cnt = (const int*)(p.ws + OFF_CNT) + layer * 64;
  const bf16_t* HM = (const bf16_t*)(p.ws + OFF_HMID);
  const float* GATE = (const float*)(p.ws + OFF_GATE);
  bf16_t* OM = (bf16_t*)(p.ws + OFF_OMOE);
  LAS int* pre = (LAS int*)(lds + GEMM_LDS);
  const int ntiles = moe_prefix(cnt, pre);
  const int lane = threadIdx.x & 63, wid = threadIdx.x >> 6, r32 = lane & 31, hi = lane >> 5, wm = wid >> 2, wn = wid & 3;
  for (int u = bid; u < ntiles * 4; u += nblk) {
    const int g = u >> 2, ct = u & 3, e = moe_find(pre, g), rt = g - pre[e], n = cnt[e];
    const int* list = (const int*)(p.ws + OFF_LIST) + (size_t)e * CAPL + rt * 128;
    const bf16_t* Wd = (const bf16_t*)(p.ws + OFF_WD) + (size_t)e * DE * D + ct * 256;
    const int nvalid = n - rt * 128;
    const bf16_t* A = HM + (size_t)g * 128 * DE;
    f32x16 acc[2][2];
#pragma unroll
    for (int a = 0; a < 2; ++a)
#pragma unroll
      for (int b = 0; b < 2; ++b) acc[a][b] = (f32x16){};
    gemm_mainloop<128, 256, 1>(lds, acc, [&](int row) { return A + (size_t)row * DE; }, [&](int s) { return Wd + s * 128; }, D, DE);
#pragma unroll
    for (int ti = 0; ti < 2; ++ti) {
      const int row = wm * 64 + ti * 32 + r32;
      if (row < nvalid) {
        const int ts = list[row];
        const float gt = GATE[ts];
#pragma unroll
        for (int ni = 0; ni < 2; ++ni) {
          f32x16 a;
#pragma unroll
          for (int r = 0; r < 16; ++r) a[r] = acc[ti][ni][r] * gt;
#pragma unroll
          for (int gq = 0; gq < 4; ++gq) *(u32x2*)(OM + (size_t)ts * D + ct * 256 + wn * 64 + ni * 32 + 8 * gq + 4 * hi) = pack4(a, gq);
        }
      }
    }
  }
}

__global__ void __launch_bounds__(256) k_cvt_w(Params p, int layer, int which) {
  const long gtid = (long)blockIdx.x * blockDim.x + threadIdx.x, gth = (long)gridDim.x * blockDim.x;
  if (which == 0) {
    cvt_range(p.w_in, (bf16_t*)(p.ws + OFF_WIN), 2L * D * INW / 8, gtid, gth);
    cvt_range(p.w_out, (bf16_t*)(p.ws + OFF_WOUT), 2L * D * D / 8, gtid, gth);
  } else {
    const size_t o = (size_t)layer * NE * D * DE;
    cvt_range(p.w_e_gate + o, (bf16_t*)(p.ws + OFF_WG), (long)NE * D * DE / 8, gtid, gth);
    cvt_range(p.w_e_up + o, (bf16_t*)(p.ws + OFF_WU), (long)NE * D * DE / 8, gtid, gth);
    cvt_range(p.w_e_down + o, (bf16_t*)(p.ws + OFF_WD), (long)NE * D * DE / 8, gtid, gth);
  }
}
#define STATIC_LDS __shared__ __attribute__((aligned(16))) char slds[GEMM_LDS + 256]
__global__ void __launch_bounds__(512) k_a1(Params p, int layer) { STATIC_LDS; phase_a1(p, layer, (LAS char*)slds, blockIdx.x, gridDim.x); }
__global__ void __launch_bounds__(512) k_c1(Params p, int layer) { STATIC_LDS; phase_c1(p, layer, (LAS char*)slds, blockIdx.x, gridDim.x); }
__global__ void __launch_bounds__(512) k_d1(Params p, int layer) { STATIC_LDS; phase_d1(p, layer, (LAS char*)slds, blockIdx.x, gridDim.x); }
__global__ void __launch_bounds__(512) k_d2(Params p, int layer) { STATIC_LDS; phase_d2(p, layer, (LAS char*)slds, blockIdx.x, gridDim.x); }
constexpr int ATT_LDS = 2 * 16384;
__device__ __forceinline__ int vst64(int k, int c) { const int kk = (k & ~0xC) | ((k & 4) << 1) | ((k & 8) >> 1); return ((kk >> 3) * 2 + (c >> 5)) * 512 + ((kk & 7) * 32 + (c & 31)) * 2; }
__device__ __forceinline__ bf16x8 tr_frag64(const LAS char* p) {
  s16x4 a = __builtin_amdgcn_ds_read_tr16_b64_v4i16((LAS s16x4*)p);
  s16x4 b = __builtin_amdgcn_ds_read_tr16_b64_v4i16((LAS s16x4*)(p + 1024));
  return (bf16x8){a[0], a[1], a[2], a[3], b[0], b[1], b[2], b[3]};
}
__device__ __forceinline__ bf16x8 pk4(const f32x16& P, int B) {
  unsigned a0 = cvtpk(P[B + 0], P[B + 1]), a1 = cvtpk(P[B + 2], P[B + 3]), b0 = cvtpk(P[B + 4], P[B + 5]), b1 = cvtpk(P[B + 6], P[B + 7]);
  auto r0 = __builtin_amdgcn_permlane32_swap(a0, b0, false, false); auto r1 = __builtin_amdgcn_permlane32_swap(a1, b1, false, false);
  u32x4 w = {r0[0], r1[0], r0[1], r1[1]};
  return __builtin_bit_cast(bf16x8, w);
}
__device__ __forceinline__ void attn_unit(const Params& p, LAS char* lds, int row0, int head, int nkeys) {
  const bf16_t* Q = (const bf16_t*)(p.ws + OFF_Q); const bf16_t* Kb = (const bf16_t*)(p.ws + OFF_K); const bf16_t* Vb = (const bf16_t*)(p.ws + OFF_V);
  bf16_t* MIX = (bf16_t*)(p.ws + OFF_MIX);
  const int tid = threadIdx.x, wid = tid >> 6, lane = tid & 63, r32 = lane & 31, hi = lane >> 5, kvh = head >> 2;
  bf16x8 qr[4];
  { const bf16_t* Qg = Q + (size_t)(row0 + wid * 32 + r32) * 512 + head * 64 + hi * 8;
#pragma unroll
    for (int d0 = 0; d0 < 4; ++d0) qr[d0] = *(const bf16x8*)(Qg + d0 * 16); }
  const bf16_t* Kg = Kb + (size_t)(tid >> 3) * 128 + kvh * 64 + (tid & 7) * 8;
  const bf16_t* Vg = Vb + (size_t)(tid >> 3) * 128 + kvh * 64 + (tid & 7) * 8;
  const int kst = xoff(tid >> 3, tid & 7), vstw = 8192 + vst64(tid >> 3, (tid & 7) * 8);
  const int krd0 = r32 * 128, krd1 = (32 + r32) * 128, ksw = (r32 >> 1) & 7, vrd = 8192 + v_rd_base(lane);
  f32x16 o0 = {}, o1 = {}; float l = 0.f;
  u32x4 ks = *(const u32x4*)Kg, vs = *(const u32x4*)Vg;
  *(LAS u32x4*)(lds + kst) = ks; *(LAS u32x4*)(lds + vstw) = vs;
  __syncthreads();
  const int NT = nkeys >> 6;
  for (int j = 0; j < NT; ++j) {
    const LAS char* cur = lds + (j & 1) * 16384; LAS char* nxt = lds + ((j + 1) & 1) * 16384;
    const bool more = j + 1 < NT;
    if (more) { ks = *(const u32x4*)(Kg + (size_t)(j + 1) * 64 * 128); vs = *(const u32x4*)(Vg + (size_t)(j + 1) * 64 * 128); }
    f32x16 p0 = {}, p1 = {};
#pragma unroll
    for (int d0 = 0; d0 < 4; ++d0) {
      const bf16x8 b0 = *(const LAS bf16x8*)(cur + krd0 + (((2 * d0 + hi) ^ ksw) << 4));
      const bf16x8 b1 = *(const LAS bf16x8*)(cur + krd1 + (((2 * d0 + hi) ^ ksw) << 4));
      p0 = __builtin_amdgcn_mfma_f32_32x32x16_bf16(b0, qr[d0], p0, 0, 0, 0);
      p1 = __builtin_amdgcn_mfma_f32_32x32x16_bf16(b1, qr[d0], p1, 0, 0, 0);
    }
#pragma unroll
    for (int r = 0; r < 16; ++r) { p0[r] = __builtin_amdgcn_exp2f(p0[r]); p1[r] = __builtin_amdgcn_exp2f(p1[r]); }
    float s0 = 0.f, s1 = 0.f;
#pragma unroll
    for (int r = 0; r < 16; ++r) { s0 += p0[r]; s1 += p1[r]; }
    l += s0 + s1;
    const bf16x8 pa0 = pk4(p0, 0), pa1 = pk4(p0, 8), pa2 = pk4(p1, 0), pa3 = pk4(p1, 8);
    o0 = __builtin_amdgcn_mfma_f32_32x32x16_bf16(pa0, tr_frag64(cur + vrd + 0 * 2048), o0, 0, 0, 0);
    o1 = __builtin_amdgcn_mfma_f32_32x32x16_bf16(pa0, tr_frag64(cur + vrd + 512 + 0 * 2048), o1, 0, 0, 0);
    o0 = __builtin_amdgcn_mfma_f32_32x32x16_bf16(pa1, tr_frag64(cur + vrd + 1 * 2048), o0, 0, 0, 0);
    o1 = __builtin_amdgcn_mfma_f32_32x32x16_bf16(pa1, tr_frag64(cur + vrd + 512 + 1 * 2048), o1, 0, 0, 0);
    o0 = __builtin_amdgcn_mfma_f32_32x32x16_bf16(pa2, tr_frag64(cur + vrd + 2 * 2048), o0, 0, 0, 0);
    o1 = __builtin_amdgcn_mfma_f32_32x32x16_bf16(pa2, tr_frag64(cur + vrd + 512 + 2 * 2048), o1, 0, 0, 0);
    o0 = __builtin_amdgcn_mfma_f32_32x32x16_bf16(pa3, tr_frag64(cur + vrd + 3 * 2048), o0, 0, 0, 0);
    o1 = __builtin_amdgcn_mfma_f32_32x32x16_bf16(pa3, tr_frag64(cur + vrd + 512 + 3 * 2048), o1, 0, 0, 0);
    if (more) { *(LAS u32x4*)(nxt + kst) = ks; *(LAS u32x4*)(nxt + vstw) = vs; }
    __syncthreads();
  }
  l = sum32(l);
  LAS float* li = (LAS float*)(lds + wid * 128);
  if (hi == 0) li[r32] = l;
  __syncthreads();
  bf16_t* Og = MIX + (size_t)(row0 + wid * 32) * D + head * 64 + r32;
#pragma unroll
  for (int r = 0; r < 16; ++r) {
    const int orow = crow(r, hi);
    const float rl = __builtin_amdgcn_rcpf(li[orow]);
    Og[(size_t)orow * D] = f2bf(o0[r] * rl);
    Og[(size_t)orow * D + 32] = f2bf(o1[r] * rl);
  }
  __syncthreads();
}
__device__ __forceinline__ void phase_attn(const Params& p, int layer, LAS char* lds, int bid, int nblk) {
  const int nlat = 512, nunits = nlat + (layer == 0 ? 8 : 0);
  for (int u = bid; u < nunits; u += nblk) {
    if (u < nlat) attn_unit(p, lds, NCTX + (u >> 3) * 256, u & 7, TT);
    else attn_unit(p, lds, 0, u - nlat, NCTX);
  }
}
__global__ void __launch_bounds__(512) k_attn(Params p, int layer) {
  __shared__ __attribute__((aligned(16))) char slds[ATT_LDS];
  if (((const int*)(p.ws + OFF_CNT))[128] == 0) return;
  phase_attn(p, layer, (LAS char*)slds, blockIdx.x, gridDim.x);
}
extern "C" void kernel_launch(void* const* d_in, const int* in_sizes, int n_in, void* d_out, int out_size, void* d_ws, size_t ws_size,
                              hipStream_t stream) {
  if (ws_size < WS_END) { fprintf(stderr, "kernel_launch: ws too small: %zu < %zu\n", ws_size, WS_END); return; }
  Params p{};
  const float** f = (const float**)&p;
  for (int i = 0; i < 28; ++i) f[i] = (const float*)d_in[i];
  p.out = (float*)d_out; p.ws = (char*)d_ws;
  constexpr int LDSB = 0;
  k_mod<<<48, 256, 0, stream>>>(p);
  k_cvt_w<<<1024, 256, 0, stream>>>(p, 0, 0);
  for (int layer = 0; layer < 2; ++layer) {
    k_a0<<<2080, 256, 0, stream>>>(p, layer);
#if NAIVE_A1
    k_gemm_naive<<<(int)(((long)TT * INW + 255) / 256), 256, 0, stream>>>((const bf16_t*)(p.ws + OFF_H), p.w_in + (size_t)layer * D * INW,
                                                                       (float*)(p.ws + OFF_P), TT, INW, D, INW);
    k_inproj_epi<<<2080, 256, 0, stream>>>(p, layer);
#else
    k_a1<<<256, 512, LDSB, stream>>>(p, layer);
#endif
    k_attn<<<256, 512, 0, stream>>>(p, layer);
    k_attn_naive<<<(TT / 64) * 8, 64, 0, stream>>>(p, layer);
    k_pool1<<<TT, 256, 0, stream>>>(p);
    k_pool2<<<TT, 256, 0, stream>>>(p, layer);
    k_conv1<<<TT, 256, 0, stream>>>(p, layer);
    k_conv2<<<TT / 4, 256, 0, stream>>>(p, layer);
    k_conv3<<<TT, 256, 0, stream>>>(p, layer);
#if NAIVE_C1
    k_gemm_naive<<<(int)(((long)TT * D + 255) / 256), 256, 0, stream>>>((const bf16_t*)(p.ws + OFF_MIX), p.w_out + (size_t)layer * D * D,
                                                                     (float*)(p.ws + OFF_P), TT, D, D, D);
    k_f32_to_bf16<<<(int)(((long)TT * D + 255) / 256), 256, 0, stream>>>((const float*)(p.ws + OFF_P), (bf16_t*)(p.ws + OFF_Y), (long)TT * D);
#else
    k_c1<<<256, 512, LDSB, stream>>>(p, layer);
#endif
    k_c2<<<2080, 256, 0, stream>>>(p, layer);
#if NAIVE_MOE
    k_moe_offsets<<<1, 64, 0, stream>>>(p, layer);
    k_moe_d1<<<dim3(256, NE), 256, 0, stream>>>(p, layer);
    k_moe_d2<<<dim3(256, NE), 256, 0, stream>>>(p, layer);
#else
    k_cvt_w<<<1024, 256, 0, stream>>>(p, layer, 1);
    k_d1<<<256, 512, LDSB, stream>>>(p, layer);
    k_d2<<<256, 512, LDSB, stream>>>(p, layer);
#endif
  }
  k_final<<<2048, 256, 0, stream>>>(p);
}
```

```cpp
#include <hip/hip_runtime.h>
#include <cstdio>
#include <cstdint>

typedef unsigned short bf16_t;
#define LAS __attribute__((address_space(3)))

constexpr int D = 1024, SEQ = 16384, NCTX = 256, TT = SEQ + NCTX;
constexpr int INW = 1536;
constexpr int NE = 32, DE = 512;
constexpr int CAPL = 2 * TT;
constexpr int HMID_ROWS = 2 * TT + NE * 128;
constexpr float ALPHA = 1.41421356237309515f;
constexpr float EPS = 1e-6f;

constexpr size_t al(size_t x) { return (x + 255) / 256 * 256; }
constexpr size_t OFF_BAR = 0;
constexpr size_t BAR_BYTES = 3456 * 4;
constexpr size_t OFF_MOD = OFF_BAR + al(BAR_BYTES);
constexpr size_t OFF_ROPE = OFF_MOD + al(2 * 2 * 6144 * 4);
constexpr size_t OFF_CNT = OFF_ROPE + al(256 * 16 * 2 * 4);
constexpr size_t OFF_X = OFF_CNT + al(2 * 64 * 4 + 64);
constexpr size_t OFF_H = OFF_X + al((size_t)TT * D * 4);
constexpr size_t OFF_MIX = OFF_H + al((size_t)TT * D * 2);
constexpr size_t OFF_Y = OFF_MIX + al((size_t)TT * D * 2);
constexpr size_t OFF_Q = OFF_Y + al((size_t)TT * D * 2);
constexpr size_t OFF_K = OFF_Q + al((size_t)TT * 512 * 2);
constexpr size_t OFF_V = OFF_K + al((size_t)TT * 128 * 2);
constexpr size_t OFF_U = OFF_V + al((size_t)TT * 128 * 2);
constexpr size_t OFF_AG = OFF_U + al((size_t)TT * 256 * 4);
constexpr size_t OFF_HMID = OFF_Q;
constexpr size_t OFF_OMOE = OFF_AG + al((size_t)TT * 512 * 2);
constexpr size_t OFF_GATE = OFF_OMOE + al((size_t)TT * 2 * D * 2);
constexpr size_t OFF_LIST = OFF_GATE + al((size_t)TT * 2 * 4);
constexpr size_t OFF_WIN = OFF_LIST + al((size_t)NE * CAPL * 4);
constexpr size_t OFF_WOUT = OFF_WIN + al((size_t)2 * D * INW * 2);
constexpr size_t OFF_WPWT = OFF_WOUT + al((size_t)2 * D * D * 2);
constexpr size_t OFF_WPOOLT = OFF_WPWT + al((size_t)2 * 256 * 256 * 2);
constexpr size_t OFF_WG = OFF_WPOOLT + al((size_t)2 * 4 * 64 * 64 * 2);
constexpr size_t OFF_WU = OFF_WG + al((size_t)2 * NE * D * DE * 2);
constexpr size_t OFF_WD = OFF_WU + al((size_t)2 * NE * D * DE * 2);
constexpr size_t WS_END = OFF_WD + al((size_t)2 * NE * D * DE * 2);
static_assert(OFF_AG - OFF_HMID >= (size_t)HMID_ROWS * DE * 2, "HMID alias too small");
static_assert(WS_END < 530000000, "ws budget");

struct Params {
  const float *x, *c, *ctx, *c_ctx, *w_mod, *b_mod, *w_in, *q_gain, *k_gain, *w_pool, *pool_scale, *w_dw, *b_dw,
      *cv_ln_g, *cv_ln_b, *w_cv_pw, *w_out, *ln1_g, *ln1_b, *ln2_g, *ln2_b, *w_rg, *b_rg, *w_re, *b_re, *w_e_gate, *w_e_up, *w_e_down;
  float* out;
  char* ws;
};

__device__ __forceinline__ float bf2f(bf16_t v) { return __uint_as_float(((unsigned)v) << 16); }
__device__ __forceinline__ bf16_t f2bf(float f) {
  unsigned u = __float_as_uint(f);
  u += 0x7fffu + ((u >> 16) & 1u);
  return (bf16_t)(u >> 16);
}
__device__ __forceinline__ float wave_sum(float v) {
#pragma unroll
  for (int o = 32; o > 0; o >>= 1) v += __shfl_xor(v, o);
  return v;
}
__device__ __forceinline__ float silu(float v) { return v / (1.f + __expf(-v)); }
__device__ __forceinline__ int opaque0() { int z; asm volatile("s_mov_b32 %0, 0" : "=s"(z)); return z; }
#define TIDX ((int)threadIdx.x + opaque0())
using bf16x8 = __attribute__((ext_vector_type(8))) short;
using s16x4 = __attribute__((ext_vector_type(4))) short;
using f32x16 = __attribute__((ext_vector_type(16))) float;
using f32x4 = __attribute__((ext_vector_type(4))) float;
using u32x4 = __attribute__((ext_vector_type(4))) unsigned;
using u32x2 = __attribute__((ext_vector_type(2))) unsigned;

__device__ __forceinline__ int crow(int r, int hi) { return (r & 3) + 8 * (r >> 2) + 4 * hi; }
typedef float f32x2 __attribute__((ext_vector_type(2)));
typedef __bf16 bf16x2v __attribute__((ext_vector_type(2)));
__device__ __forceinline__ unsigned cvtpk(float lo, float hi) {
  bf16x2v b = __builtin_convertvector((f32x2){lo, hi}, bf16x2v);
  return __builtin_bit_cast(unsigned, b);
}
__device__ __forceinline__ float sum32(float v) {
  auto rr = __builtin_amdgcn_permlane32_swap(__float_as_uint(v), __float_as_uint(v), false, false);
  return __uint_as_float(rr[0]) + __uint_as_float(rr[1]);
}

__device__ __forceinline__ void cvt_range(const float* __restrict__ src, bf16_t* __restrict__ dst, long n8, long gtid, long gthreads) {
  for (long i = gtid; i < n8; i += gthreads) {
    const f32x4 a = *(const f32x4*)(src + i * 8), b = *(const f32x4*)(src + i * 8 + 4);
    u32x4 w = {cvtpk(a[0], a[1]), cvtpk(a[2], a[3]), cvtpk(b[0], b[1]), cvtpk(b[2], b[3])};
    *(u32x4*)(dst + i * 8) = w;
  }
}

__device__ __forceinline__ int xoff(int row, int chunk) { return row * 128 + ((chunk ^ ((row >> 1) & 7)) << 4); }
__device__ __forceinline__ int wst(int k, int c) { const int kk = (k & ~0xC) | ((k & 4) << 1) | ((k & 8) >> 1); return ((kk >> 3) * 4 + (c >> 5)) * 512 + ((kk & 7) * 32 + (c & 31)) * 2; }
__device__ __forceinline__ int v_rd_base(int lane) { return ((lane & 3) << 3) | (((lane >> 2) & 3) << 6) | (((lane >> 4) & 1) << 5) | (((lane >> 5) & 1) << 8); }

__device__ __forceinline__ bf16x8 tr_frag(const LAS char* p) {
  s16x4 a = __builtin_amdgcn_ds_read_tr16_b64_v4i16((LAS s16x4*)p);
  s16x4 b = __builtin_amdgcn_ds_read_tr16_b64_v4i16((LAS s16x4*)(p + 2048));
  return (bf16x8){a[0], a[1], a[2], a[3], b[0], b[1], b[2], b[3]};
}

template <int BM, int BN> struct GemmCfg {
  static constexpr int WM = BM / 64, WN = 8 / WM, NSLAB = BN / 128, XB = BM * 128, WB = NSLAB * 16384, STAGE = XB + WB, NXP = BM / 64, NWP = NSLAB * 2;
  static_assert(WM * WN == 8 && WN * 64 == BN, "tile");
};
constexpr int GEMM_LDS = 2 * (256 * 128 + 16384);

template <int BM, int BN, int NMAP, class XRow, class WPtr>
__device__ __forceinline__ void gemm_mainloop(LAS char* lds, f32x16 (&acc)[2][2], const XRow& xrow, const WPtr& wptr, int ldw, int K) {
  using C = GemmCfg<BM, BN>;
  const int tid = TIDX, wid = tid >> 6, lane = tid & 63, r32 = lane & 31, hi = lane >> 5;
  const int wm = wid / C::WN, wn = wid % C::WN;
  const bf16_t* xg[C::NXP]; int xl[C::NXP];
#pragma unroll
  for (int i = 0; i < C::NXP; ++i) { const int row = (tid >> 3) + 64 * i; xg[i] = xrow(row) + (tid & 7) * 8; xl[i] = xoff(row, tid & 7); }
  const bf16_t* wg[C::NWP]; int wl[C::NWP];
#pragma unroll
  for (int i = 0; i < C::NWP; ++i) { const int s = i >> 1, k = (tid >> 4) + 32 * (i & 1), c = (tid & 15) * 8; wg[i] = wptr(s) + (size_t)k * ldw + c; wl[i] = C::XB + s * 16384 + wst(k, c); }
  int xr[2];
#pragma unroll
  for (int ti = 0; ti < 2; ++ti) xr[ti] = (wm * 64 + ti * 32 + r32) * 128;
  const int xsw = (r32 >> 1) & 7;
  int wr[2];
#pragma unroll
  for (int ni = 0; ni < 2; ++ni) {
    const int slab = NMAP == 0 ? 0 : (NMAP == 1 ? (wn >> 1) : ni);
    const int nb = NMAP == 0 ? (2 * wn + ni) : (NMAP == 1 ? ((wn & 1) * 2 + ni) : wn);
    wr[ni] = C::XB + slab * 16384 + nb * 512 + v_rd_base(lane);
  }
  u32x4 xs[C::NXP], wsr[C::NWP];
  const int nk = K / 64;
#pragma unroll
  for (int i = 0; i < C::NXP; ++i) xs[i] = *(const u32x4*)(xg[i]);
#pragma unroll
  for (int i = 0; i < C::NWP; ++i) wsr[i] = *(const u32x4*)(wg[i]);
#pragma unroll
  for (int i = 0; i < C::NXP; ++i) *(LAS u32x4*)(lds + xl[i]) = xs[i];
#pragma unroll
  for (int i = 0; i < C::NWP; ++i) *(LAS u32x4*)(lds + wl[i]) = wsr[i];
  __syncthreads();
  for (int kt = 0; kt < nk; ++kt) {
    const LAS char* cur = lds + (kt & 1) * C::STAGE;
    LAS char* nxt = lds + ((kt + 1) & 1) * C::STAGE;
    const bool more = kt + 1 < nk;
    if (more) {
#pragma unroll
      for (int i = 0; i < C::NXP; ++i) xs[i] = *(const u32x4*)(xg[i] + (kt + 1) * 64);
#pragma unroll
      for (int i = 0; i < C::NWP; ++i) wsr[i] = *(const u32x4*)(wg[i] + (size_t)(kt + 1) * 64 * ldw);
    }
#pragma unroll
    for (int ks = 0; ks < 4; ++ks) {
      bf16x8 xf[2], wf[2];
#pragma unroll
      for (int ti = 0; ti < 2; ++ti) xf[ti] = *(const LAS bf16x8*)(cur + xr[ti] + (((ks * 2 + hi) ^ xsw) << 4));
#pragma unroll
      for (int ni = 0; ni < 2; ++ni) wf[ni] = tr_frag(cur + wr[ni] + ks * 4096);
#pragma unroll
      for (int ti = 0; ti < 2; ++ti)
#pragma unroll
        for (int ni = 0; ni < 2; ++ni) acc[ti][ni] = __builtin_amdgcn_mfma_f32_32x32x16_bf16(wf[ni], xf[ti], acc[ti][ni], 0, 0, 0);
    }
    if (more) {
#pragma unroll
      for (int i = 0; i < C::NXP; ++i) *(LAS u32x4*)(nxt + xl[i]) = xs[i];
#pragma unroll
      for (int i = 0; i < C::NWP; ++i) *(LAS u32x4*)(nxt + wl[i]) = wsr[i];
    }
    __syncthreads();
  }
}

__device__ __forceinline__ u32x2 pack4(const f32x16& a, int g) { return (u32x2){cvtpk(a[4 * g], a[4 * g + 1]), cvtpk(a[4 * g + 2], a[4 * g + 3])}; }

__device__ __forceinline__ void phase_a1(const Params& p, int layer, LAS char* lds, int bid, int nblk) {
  const bf16_t* H = (const bf16_t*)(p.ws + OFF_H);
  const bf16_t* W = (const bf16_t*)(p.ws + OFF_WIN) + (size_t)layer * D * INW;
  bf16_t* Q = (bf16_t*)(p.ws + OFF_Q); bf16_t* Kb = (bf16_t*)(p.ws + OFF_K); bf16_t* Vb = (bf16_t*)(p.ws + OFF_V);
  float* U = (float*)(p.ws + OFF_U); bf16_t* AG = (bf16_t*)(p.ws + OFF_AG);
  const float* rt = (const float*)(p.ws + OFF_ROPE);
  const int lane = TIDX & 63, wid = TIDX >> 6, r32 = lane & 31, hi = lane >> 5, wm = wid >> 1, wn = wid & 1;
  const int nlat = 64 * 12, nunits = nlat + (layer == 0 ? 12 : 2);
  for (int u = bid; u < nunits; u += nblk) {
    int rtile, ct;
    if (u < nlat) { rtile = 1 + u / 12; ct = u % 12; } else { rtile = 0; ct = layer == 0 ? (u - nlat) : (4 + u - nlat); }
    const int m0 = rtile * 256, n0 = ct * 128;
    f32x16 acc[2][2];
#pragma unroll
    for (int a = 0; a < 2; ++a)
#pragma unroll
      for (int b = 0; b < 2; ++b) acc[a][b] = (f32x16){};
    gemm_mainloop<256, 128, 0>(lds, acc, [&](int row) { return H + (size_t)(m0 + row) * D; }, [&](int) { return W + n0; }, INW, D);
#pragma unroll
    for (int ti = 0; ti < 2; ++ti) {
      const int tok = m0 + wm * 64 + ti * 32 + r32;
      if (ct < 5) {
        float ss = 0.f;
#pragma unroll
        for (int ni = 0; ni < 2; ++ni)
#pragma unroll
          for (int r = 0; r < 16; ++r) ss += acc[ti][ni][r] * acc[ti][ni][r];
        ss = sum32(ss);
        const float rs = rsqrtf(ss * (1.f / 64.f) + EPS);
        const float* gain = (ct < 4 ? p.q_gain : p.k_gain) + layer * 64;
        const float osc = ct < 4 ? 0.125f * 1.4426950408889634f : 1.f;
        const bool lat = rtile > 0;
        const int t = tok - NCTX;
#pragma unroll
        for (int ni = 0; ni < 2; ++ni) {
          f32x16 v;
#pragma unroll
          for (int r = 0; r < 16; ++r) v[r] = acc[ti][ni][r] * rs * gain[ni * 32 + crow(r, hi)];
          if (lat) {
            const int pos = ni == 0 ? (t >> 6) : (t & 63);
#pragma unroll
            for (int r = 0; r < 8; ++r) {
              const int f = crow(r, hi);
              const float cs = rt[(pos * 16 + f) * 2], sn = rt[(pos * 16 + f) * 2 + 1];
              const float t1 = v[r], t2 = v[r + 8];
              v[r] = t1 * cs - t2 * sn; v[r + 8] = t2 * cs + t1 * sn;
            }
          }
#pragma unroll
          for (int r = 0; r < 16; ++r) v[r] *= osc;
          bf16_t* dst = ct < 4 ? Q + (size_t)tok * 512 + (ct * 2 + wn) * 64 + ni * 32 : Kb + (size_t)tok * 128 + wn * 64 + ni * 32;
#pragma unroll
          for (int g = 0; g < 4; ++g) *(u32x2*)(dst + 8 * g + 4 * hi) = pack4(v, g);
        }
      } else if (ct == 5) {
#pragma unroll
        for (int ni = 0; ni < 2; ++ni)
#pragma unroll
          for (int g = 0; g < 4; ++g) *(u32x2*)(Vb + (size_t)tok * 128 + wn * 64 + ni * 32 + 8 * g + 4 * hi) = pack4(acc[ti][ni], g);
      } else if (ct < 8) {
#pragma unroll
        for (int ni = 0; ni < 2; ++ni)
#pragma unroll
          for (int g = 0; g < 4; ++g)
            *(f32x4*)(U + (size_t)tok * 256 + (ct - 6) * 128 + wn * 64 + ni * 32 + 8 * g + 4 * hi) =
                (f32x4){acc[ti][ni][4 * g], acc[ti][ni][4 * g + 1], acc[ti][ni][4 * g + 2], acc[ti][ni][4 * g + 3]};
      } else {
#pragma unroll
        for (int ni = 0; ni < 2; ++ni)
#pragma unroll
          for (int g = 0; g < 4; ++g) *(u32x2*)(AG + (size_t)tok * 512 + (ct - 8) * 128 + wn * 64 + ni * 32 + 8 * g + 4 * hi) = pack4(acc[ti][ni], g);
      }
    }
  }
}

__device__ __forceinline__ void phase_c1(const Params& p, int layer, LAS char* lds, int bid, int nblk) {
  const bf16_t* A = (const bf16_t*)(p.ws + OFF_MIX);
  const bf16_t* W = (const bf16_t*)(p.ws + OFF_WOUT) + (size_t)layer * D * D;
  bf16_t* Y = (bf16_t*)(p.ws + OFF_Y);
  const int lane = TIDX & 63, wid = TIDX >> 6, r32 = lane & 31, hi = lane >> 5, wm = wid >> 1, wn = wid & 1;
  const int rt0 = layer == 0 ? 0 : 1, nunits = (65 - rt0) * 8;
  for (int u = bid; u < nunits; u += nblk) {
    const int m0 = (rt0 + u / 8) * 256, n0 = (u % 8) * 128;
    f32x16 acc[2][2];
#pragma unroll
    for (int a = 0; a < 2; ++a)
#pragma unroll
      for (int b = 0; b < 2; ++b) acc[a][b] = (f32x16){};
    gemm_mainloop<256, 128, 0>(lds, acc, [&](int row) { return A + (size_t)(m0 + row) * D; }, [&](int) { return W + n0; }, D, D);
#pragma unroll
    for (int ti = 0; ti < 2; ++ti) {
      const int tok = m0 + wm * 64 + ti * 32 + r32;
#pragma unroll
      for (int ni = 0; ni < 2; ++ni)
#pragma unroll
        for (int g = 0; g < 4; ++g) *(u32x2*)(Y + (size_t)tok * D + n0 + wn * 64 + ni * 32 + 8 * g + 4 * hi) = pack4(acc[ti][ni], g);
    }
  }
}

__device__ __forceinline__ int moe_prefix(const int* cnt, LAS int* pre) {
  if (TIDX == 0) { int o = 0; for (int e = 0; e < NE; ++e) { pre[e] = o; o += (cnt[e] + 127) >> 7; } pre[NE] = o; }
  __syncthreads();
  return pre[NE];
}
__device__ __forceinline__ int moe_find(const LAS int* pre, int g) { int e = 0; for (int i = 1; i < NE; ++i) e += (pre[i] <= g) ? 1 : 0; return e; }

__device__ __forceinline__ void phase_d1(const Params& p, int layer, LAS char* lds, int bid, int nblk) {
  const int* cnt = (const int*)(p.ws + OFF_CNT) + layer * 64;
  const bf16_t* H2 = (const bf16_t*)(p.ws + OFF_MIX);
  bf16_t* HM = (bf16_t*)(p.ws + OFF_HMID);
  LAS int* pre = (LAS int*)(lds + GEMM_LDS);
  const int ntiles = moe_prefix(cnt, pre);
  const int lane = TIDX & 63, wid = TIDX >> 6, r32 = lane & 31, hi = lane >> 5, wm = wid >> 2, wn = wid & 3;
  for (int u = bid; u < ntiles * 4; u += nblk) {
    const int g = u >> 2, ct = u & 3, e = moe_find(pre, g), rt = g - pre[e], n = cnt[e];
    const int* list = (const int*)(p.ws + OFF_LIST) + (size_t)e * CAPL + rt * 128;
    const bf16_t* Wg = (const bf16_t*)(p.ws + OFF_WG) + ((size_t)layer * NE + e) * D * DE + ct * 128;
    const bf16_t* Wu = (const bf16_t*)(p.ws + OFF_WU) + ((size_t)layer * NE + e) * D * DE + ct * 128;
    const int nvalid = n - rt * 128;
    f32x16 acc[2][2];
#pragma unroll
    for (int a = 0; a < 2; ++a)
#pragma unroll
      for (int b = 0; b < 2; ++b) acc[a][b] = (f32x16){};
    gemm_mainloop<128, 256, 2>(lds, acc, [&](int row) { const int tok = row < nvalid ? (list[row] >> 1) : 0; return H2 + (size_t)tok * D; },
                               [&](int s) { return s == 0 ? Wg : Wu; }, DE, D);
    const size_t hrow0 = (size_t)(pre[e] + rt) * 128;
#pragma unroll
    for (int ti = 0; ti < 2; ++ti) {
      const size_t row = hrow0 + wm * 64 + ti * 32 + r32;
      f32x16 a;
#pragma unroll
      for (int r = 0; r < 16; ++r) { const float gv = acc[ti][0][r]; a[r] = gv / (1.f + __expf(-gv)) * acc[ti][1][r]; }
#pragma unroll
      for (int gq = 0; gq < 4; ++gq) *(u32x2*)(HM + row * DE + ct * 128 + wn * 32 + 8 * gq + 4 * hi) = pack4(a, gq);
    }
  }
}

__device__ __forceinline__ void phase_d2(const Params& p, int layer, LAS char* lds, int bid, int nblk) {
  const int* cnt = (const int*)(p.ws + OFF_CNT) + layer * 64;
  const bf16_t* HM = (const bf16_t*)(p.ws + OFF_HMID);
  const float* GATE = (const float*)(p.ws + OFF_GATE);
  bf16_t* OM = (bf16_t*)(p.ws + OFF_OMOE);
  LAS int* pre = (LAS int*)(lds + GEMM_LDS);
  const int ntiles = moe_prefix(cnt, pre);
  const int lane = TIDX & 63, wid = TIDX >> 6, r32 = lane & 31, hi = lane >> 5, wm = wid >> 2, wn = wid & 3;
  for (int u = bid; u < ntiles * 4; u += nblk) {
    const int g = u >> 2, ct = u & 3, e = moe_find(pre, g), rt = g - pre[e], n = cnt[e];
    const int* list = (const int*)(p.ws + OFF_LIST) + (size_t)e * CAPL + rt * 128;
    const bf16_t* Wd = (const bf16_t*)(p.ws + OFF_WD) + ((size_t)layer * NE + e) * DE * D + ct * 256;
    const int nvalid = n - rt * 128;
    const bf16_t* A = HM + (size_t)g * 128 * DE;
    f32x16 acc[2][2];
#pragma unroll
    for (int a = 0; a < 2; ++a)
#pragma unroll
      for (int b = 0; b < 2; ++b) acc[a][b] = (f32x16){};
    gemm_mainloop<128, 256, 1>(lds, acc, [&](int row) { return A + (size_t)row * DE; }, [&](int s) { return Wd + s * 128; }, D, DE);
#pragma unroll
    for (int ti = 0; ti < 2; ++ti) {
      const int row = wm * 64 + ti * 32 + r32;
      if (row < nvalid) {
        const int ts = list[row];
        const float gt = GATE[ts];
#pragma unroll
        for (int ni = 0; ni < 2; ++ni) {
          f32x16 a;
#pragma unroll
          for (int r = 0; r < 16; ++r) a[r] = acc[ti][ni][r] * gt;
#pragma unroll
          for (int gq = 0; gq < 4; ++gq) *(u32x2*)(OM + (size_t)ts * D + ct * 256 + wn * 64 + ni * 32 + 8 * gq + 4 * hi) = pack4(a, gq);
        }
      }
    }
  }
}

constexpr int ATT_LDS = 2 * 16384;
__device__ __forceinline__ int vst64(int k, int c) { const int kk = (k & ~0xC) | ((k & 4) << 1) | ((k & 8) >> 1); return ((kk >> 3) * 2 + (c >> 5)) * 512 + ((kk & 7) * 32 + (c & 31)) * 2; }
__device__ __forceinline__ bf16x8 tr_frag64(const LAS char* p) {
  s16x4 a = __builtin_amdgcn_ds_read_tr16_b64_v4i16((LAS s16x4*)p);
  s16x4 b = __builtin_amdgcn_ds_read_tr16_b64_v4i16((LAS s16x4*)(p + 1024));
  return (bf16x8){a[0], a[1], a[2], a[3], b[0], b[1], b[2], b[3]};
}
__device__ __forceinline__ bf16x8 pk4(const f32x16& P, int B) {
  unsigned a0 = cvtpk(P[B + 0], P[B + 1]), a1 = cvtpk(P[B + 2], P[B + 3]), b0 = cvtpk(P[B + 4], P[B + 5]), b1 = cvtpk(P[B + 6], P[B + 7]);
  auto r0 = __builtin_amdgcn_permlane32_swap(a0, b0, false, false); auto r1 = __builtin_amdgcn_permlane32_swap(a1, b1, false, false);
  u32x4 w = {r0[0], r1[0], r0[1], r1[1]};
  return __builtin_bit_cast(bf16x8, w);
}
__device__ __forceinline__ void attn_unit(const Params& p, LAS char* lds, int row0, int head, int nkeys) {
  const bf16_t* Q = (const bf16_t*)(p.ws + OFF_Q); const bf16_t* Kb = (const bf16_t*)(p.ws + OFF_K); const bf16_t* Vb = (const bf16_t*)(p.ws + OFF_V);
  bf16_t* MIX = (bf16_t*)(p.ws + OFF_MIX);
  const int tid = TIDX, wid = tid >> 6, lane = tid & 63, r32 = lane & 31, hi = lane >> 5, kvh = head >> 2;
  bf16x8 qr[4];
  { const bf16_t* Qg = Q + (size_t)(row0 + wid * 32 + r32) * 512 + head * 64 + hi * 8;
#pragma unroll
    for (int d0 = 0; d0 < 4; ++d0) qr[d0] = *(const bf16x8*)(Qg + d0 * 16); }
  const bf16_t* Kg = Kb + (size_t)(tid >> 3) * 128 + kvh * 64 + (tid & 7) * 8;
  const bf16_t* Vg = Vb + (size_t)(tid >> 3) * 128 + kvh * 64 + (tid & 7) * 8;
  const int kst = xoff(tid >> 3, tid & 7), vstw = 8192 + vst64(tid >> 3, (tid & 7) * 8);
  const int krd0 = r32 * 128, krd1 = (32 + r32) * 128, ksw = (r32 >> 1) & 7, vrd = 8192 + v_rd_base(lane);
  f32x16 o0 = {}, o1 = {}; float l = 0.f;
  u32x4 ks = *(const u32x4*)Kg, vs = *(const u32x4*)Vg;
  *(LAS u32x4*)(lds + kst) = ks; *(LAS u32x4*)(lds + vstw) = vs;
  __syncthreads();
  const int NT = nkeys >> 6;
  for (int j = 0; j < NT; ++j) {
    const LAS char* cur = lds + (j & 1) * 16384; LAS char* nxt = lds + ((j + 1) & 1) * 16384;
    const bool more = j + 1 < NT;
    if (more) { ks = *(const u32x4*)(Kg + (size_t)(j + 1) * 64 * 128); vs = *(const u32x4*)(Vg + (size_t)(j + 1) * 64 * 128); }
    f32x16 p0 = {}, p1 = {};
#pragma unroll
    for (int d0 = 0; d0 < 4; ++d0) {
      const bf16x8 b0 = *(const LAS bf16x8*)(cur + krd0 + (((2 * d0 + hi) ^ ksw) << 4));
      const bf16x8 b1 = *(const LAS bf16x8*)(cur + krd1 + (((2 * d0 + hi) ^ ksw) << 4));
      p0 = __builtin_amdgcn_mfma_f32_32x32x16_bf16(b0, qr[d0], p0, 0, 0, 0);
      p1 = __builtin_amdgcn_mfma_f32_32x32x16_bf16(b1, qr[d0], p1, 0, 0, 0);
    }
#pragma unroll
    for (int r = 0; r < 16; ++r) { p0[r] = __builtin_amdgcn_exp2f(p0[r]); p1[r] = __builtin_amdgcn_exp2f(p1[r]); }
    float s0 = 0.f, s1 = 0.f;
#pragma unroll
    for (int r = 0; r < 16; ++r) { s0 += p0[r]; s1 += p1[r]; }
    l += s0 + s1;
    const bf16x8 pa0 = pk4(p0, 0), pa1 = pk4(p0, 8), pa2 = pk4(p1, 0), pa3 = pk4(p1, 8);
    o0 = __builtin_amdgcn_mfma_f32_32x32x16_bf16(pa0, tr_frag64(cur + vrd + 0 * 2048), o0, 0, 0, 0);
    o1 = __builtin_amdgcn_mfma_f32_32x32x16_bf16(pa0, tr_frag64(cur + vrd + 512 + 0 * 2048), o1, 0, 0, 0);
    o0 = __builtin_amdgcn_mfma_f32_32x32x16_bf16(pa1, tr_frag64(cur + vrd + 1 * 2048), o0, 0, 0, 0);
    o1 = __builtin_amdgcn_mfma_f32_32x32x16_bf16(pa1, tr_frag64(cur + vrd + 512 + 1 * 2048), o1, 0, 0, 0);
    o0 = __builtin_amdgcn_mfma_f32_32x32x16_bf16(pa2, tr_frag64(cur + vrd + 2 * 2048), o0, 0, 0, 0);
    o1 = __builtin_amdgcn_mfma_f32_32x32x16_bf16(pa2, tr_frag64(cur + vrd + 512 + 2 * 2048), o1, 0, 0, 0);
    o0 = __builtin_amdgcn_mfma_f32_32x32x16_bf16(pa3, tr_frag64(cur + vrd + 3 * 2048), o0, 0, 0, 0);
    o1 = __builtin_amdgcn_mfma_f32_32x32x16_bf16(pa3, tr_frag64(cur + vrd + 512 + 3 * 2048), o1, 0, 0, 0);
    if (more) { *(LAS u32x4*)(nxt + kst) = ks; *(LAS u32x4*)(nxt + vstw) = vs; }
    __syncthreads();
  }
  l = sum32(l);
  LAS float* li = (LAS float*)(lds + wid * 128);
  if (hi == 0) li[r32] = l;
  __syncthreads();
  bf16_t* Og = MIX + (size_t)(row0 + wid * 32) * D + head * 64 + r32;
#pragma unroll
  for (int r = 0; r < 16; ++r) {
    const int orow = crow(r, hi);
    const float rl = __builtin_amdgcn_rcpf(li[orow]);
    Og[(size_t)orow * D] = f2bf(o0[r] * rl);
    Og[(size_t)orow * D + 32] = f2bf(o1[r] * rl);
  }
  __syncthreads();
}
__device__ __forceinline__ void attn_fallback(const Params& p, int layer, int bid, int nblk) {
  const bf16_t* Q = (const bf16_t*)(p.ws + OFF_Q); const bf16_t* Kb = (const bf16_t*)(p.ws + OFF_K); const bf16_t* Vb = (const bf16_t*)(p.ws + OFF_V);
  bf16_t* MIX = (bf16_t*)(p.ws + OFF_MIX);
  const int lane = TIDX & 63, nwv = nblk * 8;
  const int rg0 = layer == 0 ? 0 : NCTX / 64;
  for (int wv = bid * 8 + (TIDX >> 6) + rg0 * 8; wv < (TT / 64) * 8; wv += nwv) {
    const int head = wv & 7, r = (wv >> 3) * 64 + lane, kvh = head >> 2;
    float q[64], o[64];
#pragma unroll
    for (int d = 0; d < 64; ++d) { q[d] = bf2f(Q[(size_t)r * 512 + head * 64 + d]); o[d] = 0.f; }
    float m = -1e30f, l = 0.f;
    const int nk = r >= NCTX ? TT : NCTX;
    for (int j = 0; j < nk; ++j) {
      const bf16_t* kr = Kb + (size_t)j * 128 + kvh * 64;
      const bf16_t* vr = Vb + (size_t)j * 128 + kvh * 64;
      float s = 0.f;
#pragma unroll
      for (int d = 0; d < 64; ++d) s += q[d] * bf2f(kr[d]);
      if (s > m) {
        const float a = __builtin_amdgcn_exp2f(m - s);
        l *= a;
#pragma unroll
        for (int d = 0; d < 64; ++d) o[d] *= a;
        m = s;
      }
      const float pe = __builtin_amdgcn_exp2f(s - m);
      l += pe;
#pragma unroll
      for (int d = 0; d < 64; ++d) o[d] += pe * bf2f(vr[d]);
    }
    const float il = 1.f / l;
#pragma unroll
    for (int d = 0; d < 64; ++d) MIX[(size_t)r * D + head * 64 + d] = f2bf(o[d] * il);
  }
}

constexpr int PC_U = 0;
constexpr int PC_Y = 49152;
constexpr int PC_LDS = PC_Y + 65536;
__device__ __forceinline__ void poolconv_unit(const Params& p, int layer, LAS char* lds, int tile) {
  const int tid = TIDX, wid = tid >> 6, lane = tid & 63, r32 = lane & 31, hi = lane >> 5;
  const int t0 = tile * 64, base = tile < 4 ? 0 : NCTX, n = tile < 4 ? NCTX : SEQ;
  const bf16_t* AG = (const bf16_t*)(p.ws + OFF_AG);
  const float* U = (const float*)(p.ws + OFF_U);
  bf16_t* MIX = (bf16_t*)(p.ws + OFF_MIX);
  for (int idx = tid; idx < 94 * 32; idx += 512) {
    const int rr = idx >> 5, ch = (idx & 31) * 8, t = t0 - 15 + rr;
    u32x4 out = {0u, 0u, 0u, 0u};
    if (t >= base && t < base + n) {
      const u32x4 av = *(const u32x4*)(AG + (size_t)t * 512 + ch), gv = *(const u32x4*)(AG + (size_t)t * 512 + 256 + ch);
#pragma unroll
      for (int i = 0; i < 4; ++i) {
        const float a0 = __uint_as_float(av[i] << 16), a1 = __uint_as_float(av[i] & 0xffff0000u);
        const float g0 = __uint_as_float(gv[i] << 16), g1 = __uint_as_float(gv[i] & 0xffff0000u);
        out[i] = cvtpk(a0 / (1.f + __expf(-g0)), a1 / (1.f + __expf(-g1)));
      }
    }
    *(LAS u32x4*)(lds + PC_U + (rr * 256 + ch) * 2) = out;
  }
  __syncthreads();
  {
    const int c = tid & 255, th = tid >> 8;
    float w[31];
#pragma unroll
    for (int j = 0; j < 31; ++j) w[j] = p.w_dw[(size_t)layer * 31 * 256 + j * 256 + c];
    const float b = p.b_dw[layer * 256 + c];
    float acc[32];
#pragma unroll
    for (int i = 0; i < 32; ++i) acc[i] = b;
    const LAS bf16_t* up = (const LAS bf16_t*)(lds + PC_U) + (th * 32) * 256 + c;
#pragma unroll
    for (int rr = 0; rr < 62; ++rr) {
      const float uv = bf2f(up[rr * 256]);
#pragma unroll
      for (int i = 0; i < 32; ++i) if (rr - i >= 0 && rr - i < 31) acc[i] += uv * w[rr - i];
    }
    LAS float* yp = (LAS float*)(lds + PC_Y) + (th * 32) * 256 + c;
#pragma unroll
    for (int i = 0; i < 32; ++i) yp[i * 256] = acc[i];
  }
  __syncthreads();
  {
    const f32x4 g4 = *(const f32x4*)(p.cv_ln_g + layer * 256 + lane * 4), b4 = *(const f32x4*)(p.cv_ln_b + layer * 256 + lane * 4);
#pragma unroll
    for (int i = 0; i < 8; ++i) {
      const int tok = wid * 8 + i;
      const f32x4 y = *(const LAS f32x4*)(lds + PC_Y + (tok * 256 + lane * 4) * 4);
      const float mu = wave_sum(y[0] + y[1] + y[2] + y[3]) * (1.f / 256.f);
      const float d0 = y[0] - mu, d1 = y[1] - mu, d2 = y[2] - mu, d3 = y[3] - mu;
      const float rs = rsqrtf(wave_sum(d0 * d0 + d1 * d1 + d2 * d2 + d3 * d3) * (1.f / 256.f) + EPS);
      const float z0 = silu(d0 * rs * g4[0] + b4[0]), z1 = silu(d1 * rs * g4[1] + b4[1]), z2 = silu(d2 * rs * g4[2] + b4[2]), z3 = silu(d3 * rs * g4[3] + b4[3]);
      const int chunk = lane >> 1, sw = (chunk & 16) | ((chunk ^ tok) & 15);
      *(LAS u32x2*)(lds + PC_U + tok * 512 + sw * 16 + (lane & 1) * 8) = (u32x2){cvtpk(z0, z1), cvtpk(z2, z3)};
    }
  }
  __syncthreads();
  {
    const int tb = wid >> 2, dg = wid & 3, trow = tb * 32 + r32, t = t0 + trow;
    const bf16_t* Wt = (const bf16_t*)(p.ws + OFF_WPWT) + ((size_t)layer * 256 + dg * 64 + r32) * 256 + hi * 8;
    f32x16 acc0 = {}, acc1 = {};
#pragma unroll 4
    for (int ks = 0; ks < 16; ++ks) {
      const int chunk = 2 * ks + hi, sw = (chunk & 16) | ((chunk ^ trow) & 15);
      const bf16x8 zf = *(const LAS bf16x8*)(lds + PC_U + trow * 512 + sw * 16);
      const bf16x8 w0 = *(const bf16x8*)(Wt + ks * 16), w1 = *(const bf16x8*)(Wt + 32 * 256 + ks * 16);
      acc0 = __builtin_amdgcn_mfma_f32_32x32x16_bf16(w0, zf, acc0, 0, 0, 0);
      acc1 = __builtin_amdgcn_mfma_f32_32x32x16_bf16(w1, zf, acc1, 0, 0, 0);
    }
    bf16_t* dst = MIX + (size_t)t * D + 768 + dg * 64;
#pragma unroll
    for (int g = 0; g < 4; ++g) { *(u32x2*)(dst + 8 * g + 4 * hi) = pack4(acc0, g); *(u32x2*)(dst + 32 + 8 * g + 4 * hi) = pack4(acc1, g); }
    const int w = 2 << dg, tl = t - base, lo = max(tl - w / 2, 0), hh = min(tl + w / 2, n);
    const float inv = 1.f / (float)(hh - lo);
    const bf16_t* Pt = (const bf16_t*)(p.ws + OFF_WPOOLT) + ((size_t)(layer * 4 + dg) * 64 + r32) * 64 + hi * 8;
    f32x16 pc0 = {}, pc1 = {};
#pragma unroll
    for (int ks = 0; ks < 4; ++ks) {
      const int c0 = dg * 64 + ks * 16 + hi * 8;
      f32x4 s0 = {0.f, 0.f, 0.f, 0.f}, s1 = {0.f, 0.f, 0.f, 0.f};
      for (int rr = lo; rr < hh; ++rr) { const float* ur = U + (size_t)(base + rr) * 256 + c0; s0 += *(const f32x4*)ur; s1 += *(const f32x4*)(ur + 4); }
      const float* uo = U + (size_t)t * 256 + c0;
      const f32x4 o0 = *(const f32x4*)uo, o1 = *(const f32x4*)(uo + 4);
      s0 = s0 * inv - o0; s1 = s1 * inv - o1;
      u32x4 pw = {cvtpk(s0[0], s0[1]), cvtpk(s0[2], s0[3]), cvtpk(s1[0], s1[1]), cvtpk(s1[2], s1[3])};
      const bf16x8 pf = __builtin_bit_cast(bf16x8, pw);
      const bf16x8 w0 = *(const bf16x8*)(Pt + ks * 16), w1 = *(const bf16x8*)(Pt + 32 * 64 + ks * 16);
      pc0 = __builtin_amdgcn_mfma_f32_32x32x16_bf16(w0, pf, pc0, 0, 0, 0);
      pc1 = __builtin_amdgcn_mfma_f32_32x32x16_bf16(w1, pf, pc1, 0, 0, 0);
    }
    const float* psc = p.pool_scale + layer * 256 + dg * 64;
#pragma unroll
    for (int r = 0; r < 16; ++r) { pc0[r] *= psc[crow(r, hi)]; pc1[r] *= psc[32 + crow(r, hi)]; }
    bf16_t* pd = MIX + (size_t)t * D + 512 + dg * 64;
#pragma unroll
    for (int g = 0; g < 4; ++g) { *(u32x2*)(pd + 8 * g + 4 * hi) = pack4(pc0, g); *(u32x2*)(pd + 32 + 8 * g + 4 * hi) = pack4(pc1, g); }
  }
  __syncthreads();
}

__device__ __forceinline__ void phase_b(const Params& p, int layer, LAS char* lds, int bid, int nblk) {
  const bool fast = ((const int*)(p.ws + OFF_CNT))[128] != 0;
  for (int u = bid; u < 780; u += nblk) {
    if (u < 512) { if (fast) attn_unit(p, lds, NCTX + (u >> 3) * 256, u & 7, TT); }
    else if (u < 520) { if (fast && layer == 0) attn_unit(p, lds, 0, u - 512, NCTX); }
    else { const int tile = u - 520; if (layer == 0 || tile >= 4) poolconv_unit(p, layer, lds, tile); }
  }
  if (!fast) attn_fallback(p, layer, bid, nblk);
}

__device__ __forceinline__ void phase_a0(const Params& p, int layer, int bid, int nblk) {
  const int wave = bid * 8 + (TIDX >> 6), lane = TIDX & 63, nw = nblk * 8;
  float* X = (float*)(p.ws + OFF_X);
  bf16_t* H = (bf16_t*)(p.ws + OFF_H);
  const bf16_t* OM = (const bf16_t*)(p.ws + OFF_OMOE);
  for (int r = wave; r < TT; r += nw) {
    const int s = r < NCTX ? 1 : 0;
    f32x4 v[4];
    if (layer == 0) {
      const float* src = r < NCTX ? p.ctx + (size_t)r * D : p.x + (size_t)(r - NCTX) * D;
#pragma unroll
      for (int i = 0; i < 4; ++i) v[i] = *(const f32x4*)(src + i * 256 + lane * 4);
    } else {
      const float* g2 = (const float*)(p.ws + OFF_MOD) + ((layer - 1) * 2 + s) * 6144 + 5 * D;
      float sum = 0.f;
#pragma unroll
      for (int i = 0; i < 4; ++i) {
        const int c = i * 256 + lane * 4;
        const u32x2 oa = *(const u32x2*)(OM + ((size_t)r * 2 + 0) * D + c), ob = *(const u32x2*)(OM + ((size_t)r * 2 + 1) * D + c);
        const f32x4 xv = *(const f32x4*)(X + (size_t)r * D + c), gv = *(const f32x4*)(g2 + c);
        f32x4 o;
        o[0] = __uint_as_float(oa[0] << 16) + __uint_as_float(ob[0] << 16); o[1] = __uint_as_float(oa[0] & 0xffff0000u) + __uint_as_float(ob[0] & 0xffff0000u);
        o[2] = __uint_as_float(oa[1] << 16) + __uint_as_float(ob[1] << 16); o[3] = __uint_as_float(oa[1] & 0xffff0000u) + __uint_as_float(ob[1] & 0xffff0000u);
        v[i] = xv * ALPHA + gv * o;
        sum += v[i][0] + v[i][1] + v[i][2] + v[i][3];
      }
      const float mu = wave_sum(sum) * (1.f / D);
      float q = 0.f;
#pragma unroll
      for (int i = 0; i < 4; ++i) { const f32x4 d = v[i] - mu; q += d[0] * d[0] + d[1] * d[1] + d[2] * d[2] + d[3] * d[3]; }
      const float rs = rsqrtf(wave_sum(q) * (1.f / D) + EPS);
      const float* g = p.ln2_g + (layer - 1) * D; const float* b = p.ln2_b + (layer - 1) * D;
#pragma unroll
      for (int i = 0; i < 4; ++i) { const int c = i * 256 + lane * 4; v[i] = (v[i] - mu) * rs * *(const f32x4*)(g + c) + *(const f32x4*)(b + c); *(f32x4*)(X + (size_t)r * D + c) = v[i]; }
    }
    const float* modp = (const float*)(p.ws + OFF_MOD) + (layer * 2 + s) * 6144;
    float sum = 0.f;
#pragma unroll
    for (int i = 0; i < 4; ++i) sum += v[i][0] + v[i][1] + v[i][2] + v[i][3];
    const float mu = wave_sum(sum) * (1.f / D);
    float q = 0.f;
#pragma unroll
    for (int i = 0; i < 4; ++i) { const f32x4 d = v[i] - mu; q += d[0] * d[0] + d[1] * d[1] + d[2] * d[2] + d[3] * d[3]; }
    const float rs = rsqrtf(wave_sum(q) * (1.f / D) + EPS);
#pragma unroll
    for (int i = 0; i < 4; ++i) {
      const int c = i * 256 + lane * 4;
      const f32x4 h = (v[i] - mu) * rs * (*(const f32x4*)(modp + D + c) + 1.f) + *(const f32x4*)(modp + c);
      *(u32x2*)(H + (size_t)r * D + c) = (u32x2){cvtpk(h[0], h[1]), cvtpk(h[2], h[3])};
    }
  }
}

__device__ __forceinline__ void phase_c2(const Params& p, int layer, int bid, int nblk) {
  const int wave = bid * 8 + (TIDX >> 6), lane = TIDX & 63, nw = nblk * 8;
  float* X = (float*)(p.ws + OFF_X);
  const bf16_t* Y = (const bf16_t*)(p.ws + OFF_Y);
  bf16_t* H2 = (bf16_t*)(p.ws + OFF_MIX);
  int* cnt = (int*)(p.ws + OFF_CNT) + layer * 64;
  float* GATE = (float*)(p.ws + OFF_GATE); int* LIST = (int*)(p.ws + OFF_LIST);
  const int r0 = layer == 0 ? 0 : NCTX;
  for (int r = r0 + wave; r < TT; r += nw) {
    const int s = r < NCTX ? 1 : 0;
    const float* modp = (const float*)(p.ws + OFF_MOD) + (layer * 2 + s) * 6144;
    const float* xin = layer == 0 ? (r < NCTX ? p.ctx + (size_t)r * D : p.x + (size_t)(r - NCTX) * D) : X + (size_t)r * D;
    f32x4 v[4]; float sum = 0.f;
#pragma unroll
    for (int i = 0; i < 4; ++i) {
      const int c = i * 256 + lane * 4;
      const u32x2 yv = *(const u32x2*)(Y + (size_t)r * D + c);
      const f32x4 yf = {__uint_as_float(yv[0] << 16), __uint_as_float(yv[0] & 0xffff0000u), __uint_as_float(yv[1] << 16), __uint_as_float(yv[1] & 0xffff0000u)};
      v[i] = *(const f32x4*)(xin + c) * ALPHA + *(const f32x4*)(modp + 2 * D + c) * yf;
      sum += v[i][0] + v[i][1] + v[i][2] + v[i][3];
    }
    float mu = wave_sum(sum) * (1.f / D); float q = 0.f;
#pragma unroll
    for (int i = 0; i < 4; ++i) { const f32x4 d = v[i] - mu; q += d[0] * d[0] + d[1] * d[1] + d[2] * d[2] + d[3] * d[3]; }
    float rs = rsqrtf(wave_sum(q) * (1.f / D) + EPS);
    sum = 0.f;
#pragma unroll
    for (int i = 0; i < 4; ++i) {
      const int c = i * 256 + lane * 4;
      v[i] = (v[i] - mu) * rs * *(const f32x4*)(p.ln1_g + layer * D + c) + *(const f32x4*)(p.ln1_b + layer * D + c);
      *(f32x4*)(X + (size_t)r * D + c) = v[i];
      sum += v[i][0] + v[i][1] + v[i][2] + v[i][3];
    }
    mu = wave_sum(sum) * (1.f / D); q = 0.f;
#pragma unroll
    for (int i = 0; i < 4; ++i) { const f32x4 d = v[i] - mu; q += d[0] * d[0] + d[1] * d[1] + d[2] * d[2] + d[3] * d[3]; }
    rs = rsqrtf(wave_sum(q) * (1.f / D) + EPS);
#pragma unroll
    for (int i = 0; i < 4; ++i) {
      const int c = i * 256 + lane * 4;
      v[i] = (v[i] - mu) * rs * (*(const f32x4*)(modp + 4 * D + c) + 1.f) + *(const f32x4*)(modp + 3 * D + c);
      *(u32x2*)(H2 + (size_t)r * D + c) = (u32x2){cvtpk(v[i][0], v[i][1]), cvtpk(v[i][2], v[i][3])};
    }
    f32x4 lg = {0.f, 0.f, 0.f, 0.f};
#pragma unroll
    for (int i = 0; i < 4; ++i)
#pragma unroll
      for (int j = 0; j < 4; ++j) lg += *(const f32x4*)(p.w_rg + ((size_t)layer * D + i * 256 + lane * 4 + j) * 4) * v[i][j];
    lg[0] = wave_sum(lg[0]) + p.b_rg[layer * 4 + 0]; lg[1] = wave_sum(lg[1]) + p.b_rg[layer * 4 + 1];
    lg[2] = wave_sum(lg[2]) + p.b_rg[layer * 4 + 2]; lg[3] = wave_sum(lg[3]) + p.b_rg[layer * 4 + 3];
    int gsel = 0; float gm = lg[0];
    if (lg[1] > gm) { gm = lg[1]; gsel = 1; }
    if (lg[2] > gm) { gm = lg[2]; gsel = 2; }
    if (lg[3] > gm) { gm = lg[3]; gsel = 3; }
    const float pgrp = 1.f / (__expf(lg[0] - gm) + __expf(lg[1] - gm) + __expf(lg[2] - gm) + __expf(lg[3] - gm));
    f32x4 ea = {0.f, 0.f, 0.f, 0.f}, eb = {0.f, 0.f, 0.f, 0.f};
#pragma unroll
    for (int i = 0; i < 4; ++i)
#pragma unroll
      for (int j = 0; j < 4; ++j) {
        const float* wr = p.w_re + ((size_t)layer * D + i * 256 + lane * 4 + j) * 32 + gsel * 8;
        ea += *(const f32x4*)wr * v[i][j]; eb += *(const f32x4*)(wr + 4) * v[i][j];
      }
    float le[8];
#pragma unroll
    for (int e = 0; e < 4; ++e) { le[e] = wave_sum(ea[e]) + p.b_re[layer * 32 + gsel * 8 + e]; le[4 + e] = wave_sum(eb[e]) + p.b_re[layer * 32 + gsel * 8 + 4 + e]; }
    int i0 = 0; float v0 = le[0];
#pragma unroll
    for (int e = 1; e < 8; ++e) if (le[e] > v0) { v0 = le[e]; i0 = e; }
    int i1 = -1; float v1 = -3.0e38f;
#pragma unroll
    for (int e = 0; e < 8; ++e) if (e != i0 && le[e] > v1) { v1 = le[e]; i1 = e; }
    if (i1 < 0) { i1 = (i0 + 1) & 7; v1 = v0; }
    const float e1 = __expf(v1 - v0);
    if (lane == 0) {
      const int xa = gsel * 8 + i0, xb = gsel * 8 + i1;
      const int pa = atomicAdd(&cnt[xa], 1), pb = atomicAdd(&cnt[xb], 1);
      LIST[(size_t)xa * CAPL + pa] = r * 2 + 0;
      LIST[(size_t)xb * CAPL + pb] = r * 2 + 1;
      GATE[r * 2] = pgrp / (1.f + e1); GATE[r * 2 + 1] = pgrp * e1 / (1.f + e1);
    }
  }
}

__device__ __forceinline__ void phase_final(const Params& p, int bid, int nblk) {
  const int wave = bid * 8 + (TIDX >> 6), lane = TIDX & 63, nw = nblk * 8;
  const float* X = (const float*)(p.ws + OFF_X);
  const bf16_t* OM = (const bf16_t*)(p.ws + OFF_OMOE);
  const float* g2 = (const float*)(p.ws + OFF_MOD) + (1 * 2 + 0) * 6144 + 5 * D;
  for (int r = NCTX + wave; r < TT; r += nw) {
    f32x4 v[4]; float sum = 0.f;
#pragma unroll
    for (int i = 0; i < 4; ++i) {
      const int c = i * 256 + lane * 4;
      const u32x2 oa = *(const u32x2*)(OM + ((size_t)r * 2 + 0) * D + c), ob = *(const u32x2*)(OM + ((size_t)r * 2 + 1) * D + c);
      f32x4 o;
      o[0] = __uint_as_float(oa[0] << 16) + __uint_as_float(ob[0] << 16); o[1] = __uint_as_float(oa[0] & 0xffff0000u) + __uint_as_float(ob[0] & 0xffff0000u);
      o[2] = __uint_as_float(oa[1] << 16) + __uint_as_float(ob[1] << 16); o[3] = __uint_as_float(oa[1] & 0xffff0000u) + __uint_as_float(ob[1] & 0xffff0000u);
      v[i] = *(const f32x4*)(X + (size_t)r * D + c) * ALPHA + *(const f32x4*)(g2 + c) * o;
      sum += v[i][0] + v[i][1] + v[i][2] + v[i][3];
    }
    const float mu = wave_sum(sum) * (1.f / D); float q = 0.f;
#pragma unroll
    for (int i = 0; i < 4; ++i) { const f32x4 d = v[i] - mu; q += d[0] * d[0] + d[1] * d[1] + d[2] * d[2] + d[3] * d[3]; }
    const float rs = rsqrtf(wave_sum(q) * (1.f / D) + EPS);
#pragma unroll
    for (int i = 0; i < 4; ++i) {
      const int c = i * 256 + lane * 4;
      *(f32x4*)(p.out + (size_t)(r - NCTX) * D + c) = (v[i] - mu) * rs * *(const f32x4*)(p.ln2_g + D + c) + *(const f32x4*)(p.ln2_b + D + c);
    }
  }
}

__device__ __forceinline__ void phase_p0(const Params& p, LAS char* lds, int bid, int nblk) {
  const int tid = TIDX;
  const long gtid = (long)bid * 512 + tid, gth = (long)nblk * 512;
  LAS float* sc = (LAS float*)lds;
  LAS float* red = (LAS float*)(lds + 8192);
  for (int i = tid; i < 2048; i += 512) { const float v = i < 1024 ? p.c[i] : p.c_ctx[i - 1024]; sc[i] = silu(v); }
  __syncthreads();
  float* mod = (float*)(p.ws + OFF_MOD);
  for (int u = bid; u < 384; u += nblk) {
    const int layer = u / 192, cg = u % 192, col = tid & 31, ksl = tid >> 5;
    const float* w = p.w_mod + ((size_t)layer * D + ksl * 64) * 6144 + cg * 32 + col;
    float a0 = 0.f, a1 = 0.f;
#pragma unroll 8
    for (int k = 0; k < 64; ++k) { const float wv = w[(size_t)k * 6144]; a0 += sc[ksl * 64 + k] * wv; a1 += sc[1024 + ksl * 64 + k] * wv; }
    red[(ksl * 32 + col) * 2] = a0; red[(ksl * 32 + col) * 2 + 1] = a1;
    __syncthreads();
    if (tid < 64) {
      const int c2 = tid & 31, s = tid >> 5; float a = 0.f;
#pragma unroll
      for (int k = 0; k < 16; ++k) a += red[(k * 32 + c2) * 2 + s];
      mod[(layer * 2 + s) * 6144 + cg * 32 + c2] = a + p.b_mod[layer * 6144 + cg * 32 + c2];
    }
    __syncthreads();
  }
  if (gtid < 256 * 16) {
    const int pos = (int)gtid / 16, f = (int)gtid % 16;
    const float ang = (float)pos * powf(10000.f, -(float)f / 16.f);
    float* rt = (float*)(p.ws + OFF_ROPE);
    rt[gtid * 2 + 0] = cosf(ang); rt[gtid * 2 + 1] = sinf(ang);
  }
  if (gtid < 128) ((int*)(p.ws + OFF_CNT))[gtid] = 0;
  if (gtid == 0) {
    float bmax = 0.f;
    for (int l = 0; l < 2; ++l) {
      float gq = 0.f, gk = 0.f;
      for (int i = 0; i < 64; ++i) { gq = fmaxf(gq, fabsf(p.q_gain[l * 64 + i])); gk = fmaxf(gk, fabsf(p.k_gain[l * 64 + i])); }
      bmax = fmaxf(bmax, 11.55f * gq * gk);
    }
    ((int*)(p.ws + OFF_CNT))[128] = (bmax <= 100.f) ? 1 : 0;
  }
  for (long i = gtid; i < 2 * 65536; i += gth) { const int l = (int)(i >> 16), d = (int)(i >> 8) & 255, c = (int)i & 255; ((bf16_t*)(p.ws + OFF_WPWT))[i] = f2bf(p.w_cv_pw[((size_t)l * 256 + c) * 256 + d]); }
  for (long i = gtid; i < 8 * 4096; i += gth) { const int lg = (int)(i >> 12), d = (int)(i >> 6) & 63, c = (int)i & 63; ((bf16_t*)(p.ws + OFF_WPOOLT))[i] = f2bf(p.w_pool[((size_t)lg * 64 + c) * 64 + d]); }
  cvt_range(p.w_in, (bf16_t*)(p.ws + OFF_WIN), 2L * D * INW / 8, gtid, gth);
  cvt_range(p.w_out, (bf16_t*)(p.ws + OFF_WOUT), 2L * D * D / 8, gtid, gth);
  cvt_range(p.w_e_gate, (bf16_t*)(p.ws + OFF_WG), 2L * NE * D * DE / 8, gtid, gth);
  cvt_range(p.w_e_up, (bf16_t*)(p.ws + OFF_WU), 2L * NE * D * DE / 8, gtid, gth);
  cvt_range(p.w_e_down, (bf16_t*)(p.ws + OFF_WD), 2L * NE * D * DE / 8, gtid, gth);
}
#define XB_TMO      128
#define XB_XCNT(j)  (256  + 64 * (j))
#define XB_XSUB(j)  (1280 + 64 * (j))
#define XB_XGEN(j)  (2304 + 64 * (j))
#define XB_TOP      3328
#define XB_TOPGEN   3392
#define XCD_BAR_WORDS 3456
#define XB_SPIN_CAP (1u << 22)
__device__ __forceinline__ unsigned xb_ld(unsigned* p)              { return __hip_atomic_load(p, __ATOMIC_RELAXED, __HIP_MEMORY_SCOPE_AGENT); }
__device__ __forceinline__ unsigned xb_add(unsigned* p, unsigned v) { return __hip_atomic_fetch_add(p, v, __ATOMIC_RELAXED, __HIP_MEMORY_SCOPE_AGENT); }
__device__ __forceinline__ unsigned xb_xcc_id() { return (unsigned)__builtin_amdgcn_s_getreg((3 << 11) | 20) & 0xFu; }
#define XB_SPIN(cond, bar) do { unsigned _sp = 0; while (cond) { __builtin_amdgcn_s_sleep(1); \
    if ((++_sp & 255u) == 0u) { if (xb_ld(&(bar)[XB_TMO])) break; if (_sp > XB_SPIN_CAP) { atomicAdd(&(bar)[XB_TMO], 1u); break; } } } } while (0)
struct XcdBarrier { unsigned* bar; unsigned x; volatile LAS unsigned* st; };
__device__ __forceinline__ XcdBarrier xcd_barrier_post(unsigned* bar, volatile LAS unsigned* st) {
  XcdBarrier b; b.bar = bar; b.x = xb_xcc_id(); b.st = st;
  if (threadIdx.x == 0) (void)xb_add(&bar[XB_XCNT(b.x)], 1u);
  return b;
}
__device__ __forceinline__ void xcd_barrier_complete(unsigned* bar, unsigned x, unsigned& nloc, unsigned& nx) {
  const unsigned G = gridDim.x * gridDim.y * gridDim.z;
  unsigned sum, cnt, mine, sp = 0u;
  for (;;) {
    sum = 0u; cnt = 0u; mine = 0u;
#pragma unroll
    for (unsigned j = 0; j < 16; ++j) { const unsigned c = xb_ld(&bar[XB_XCNT(j)]); sum += c; cnt += (c > 0u) ? 1u : 0u; mine = (j == x) ? c : mine; }
    if (sum == G) break;
    __builtin_amdgcn_s_sleep(1);
    if ((++sp & 255u) == 0u) { if (xb_ld(&bar[XB_TMO])) break; if (sp > XB_SPIN_CAP) { atomicAdd(&bar[XB_TMO], 1u); break; } }
  }
  nloc = mine > 0u ? mine : 1u; nx = cnt > 0u ? cnt : 1u;
}
__device__ __forceinline__ void xcd_barrier(const XcdBarrier& b) {
  asm volatile("s_waitcnt vmcnt(0)" ::: "memory");
  __syncthreads();
  if (threadIdx.x == 0) {
    unsigned* bar = b.bar;
    __builtin_amdgcn_s_waitcnt(0);
    unsigned nloc = b.st[0], nx = b.st[1];
    if (nloc == 0u) { xcd_barrier_complete(bar, b.x, nloc, nx); b.st[0] = nloc; b.st[1] = nx; }
    const unsigned old = xb_add(&bar[XB_XSUB(b.x)], 1u);
    const unsigned gen = old / nloc;
    if (old + 1u == (gen + 1u) * nloc) {
      __builtin_amdgcn_fence(__ATOMIC_RELEASE, "agent");
      asm volatile("s_waitcnt vmcnt(0)" ::: "memory");
      const unsigned og = xb_add(&bar[XB_TOP], 1u);
      const unsigned tg = og / nx;
      if (og + 1u == (tg + 1u) * nx) xb_add(&bar[XB_TOPGEN], 1u);
      else XB_SPIN(xb_ld(&bar[XB_TOPGEN]) == tg, bar);
      __builtin_amdgcn_fence(__ATOMIC_ACQUIRE, "agent");
      xb_add(&bar[XB_XGEN(b.x)], 1u);
      asm volatile("s_waitcnt vmcnt(0)" ::: "memory");
    } else {
      XB_SPIN(xb_ld(&bar[XB_XGEN(b.x)]) == gen, bar);
      __builtin_amdgcn_fence(__ATOMIC_ACQUIRE, "agent");
      asm volatile("s_waitcnt vmcnt(0)" ::: "memory");
    }
  }
  __syncthreads();
}

constexpr int LDS_MAIN = PC_LDS > GEMM_LDS + 256 ? PC_LDS : GEMM_LDS + 256;
constexpr int LDS_TOTAL = LDS_MAIN + 16;
static_assert(GEMM_LDS + 256 <= LDS_MAIN && ATT_LDS <= LDS_MAIN, "lds");
__global__ void __launch_bounds__(512) mega_fwd(Params p) {
  __shared__ __attribute__((aligned(16))) char slds[LDS_TOTAL];
  LAS char* lds = (LAS char*)slds;
  volatile LAS unsigned* st = (volatile LAS unsigned*)(lds + LDS_MAIN);
  if (threadIdx.x < 4) st[threadIdx.x] = 0u;
  __syncthreads();
  const XcdBarrier bar = xcd_barrier_post((unsigned*)(p.ws + OFF_BAR), st);
  const int bid = blockIdx.x, nblk = gridDim.x;
  phase_p0(p, lds, bid, nblk);
  xcd_barrier(bar);
#pragma unroll 1
  for (int layer = 0; layer < 2; ++layer) {
    phase_a0(p, layer, bid, nblk);
    xcd_barrier(bar);
    phase_a1(p, layer, lds, bid, nblk);
    xcd_barrier(bar);
    phase_b(p, layer, lds, bid, nblk);
    xcd_barrier(bar);
    phase_c1(p, layer, lds, bid, nblk);
    xcd_barrier(bar);
    phase_c2(p, layer, bid, nblk);
    xcd_barrier(bar);
    phase_d1(p, layer, lds, bid, nblk);
    xcd_barrier(bar);
    phase_d2(p, layer, lds, bid, nblk);
    xcd_barrier(bar);
  }
  phase_final(p, bid, nblk);
}

extern "C" void kernel_launch(void* const* d_in, const int* in_sizes, int n_in, void* d_out, int out_size, void* d_ws, size_t ws_size,
                              hipStream_t stream) {
  static int grid = 0;
  if (grid == 0) {
    if (ws_size < WS_END || n_in != 28) { fprintf(stderr, "kernel_launch: ws too small (%zu < %zu) or n_in %d != 28; nothing launched\n", ws_size, (size_t)WS_END, n_in); grid = -1; return; }
    int dev = 0, cus = 0, per_cu = 0;
    if (hipGetDevice(&dev) != hipSuccess || hipDeviceGetAttribute(&cus, hipDeviceAttributeMultiprocessorCount, dev) != hipSuccess) { grid = -1; return; }
    if (hipOccupancyMaxActiveBlocksPerMultiprocessor(&per_cu, (const void*)mega_fwd, 512, 0) != hipSuccess || per_cu < 1) {
      fprintf(stderr, "kernel_launch: occupancy query says %d blocks per CU; nothing launched\n", per_cu); grid = -1; return; }
    (void)hipGetLastError();
    grid = cus;
  }
  if (grid < 0) return;
  if (hipMemsetAsync((char*)d_ws + OFF_BAR, 0, BAR_BYTES, stream) != hipSuccess) { fprintf(stderr, "kernel_launch: memset failed\n"); return; }
  Params p{};
  const float** f = (const float**)&p;
  for (int i = 0; i < 28; ++i) f[i] = (const float*)d_in[i];
  p.out = (float*)d_out; p.ws = (char*)d_ws;
  hipLaunchKernelGGL(mega_fwd, dim3(grid), dim3(512), 0, stream, p);
}
```

```cpp
#include <hip/hip_runtime.h>
#include <cstdio>
#include <cstdint>

typedef unsigned short bf16_t;
#define LAS __attribute__((address_space(3)))

constexpr int D = 1024, SEQ = 16384, NCTX = 256, TT = SEQ + NCTX;
constexpr int INW = 1536;
constexpr int NE = 32, DE = 512;
constexpr int CAPL = 2 * TT;
constexpr int HMID_ROWS = 2 * TT + NE * 128;
constexpr float ALPHA = 1.41421356237309515f;
constexpr float EPS = 1e-6f;

constexpr size_t al(size_t x) { return (x + 255) / 256 * 256; }
constexpr size_t OFF_BAR = 0;
constexpr size_t BAR_BYTES = 3456 * 4;
constexpr size_t OFF_MOD = OFF_BAR + al(BAR_BYTES);
constexpr size_t OFF_ROPE = OFF_MOD + al(2 * 2 * 6144 * 4);
constexpr size_t OFF_CNT = OFF_ROPE + al(256 * 16 * 2 * 4);
constexpr size_t OFF_X = OFF_CNT + al(2 * 64 * 4 + 64);
constexpr size_t OFF_H = OFF_X + al((size_t)TT * D * 4);
constexpr size_t OFF_MIX = OFF_H + al((size_t)TT * D * 2);
constexpr size_t OFF_Y = OFF_MIX + al((size_t)TT * D * 2);
constexpr size_t OFF_Q = OFF_Y + al((size_t)TT * D * 2);
constexpr size_t OFF_K = OFF_Q + al((size_t)TT * 512 * 2);
constexpr size_t OFF_V = OFF_K + al((size_t)TT * 128 * 2);
constexpr size_t OFF_U = OFF_V + al((size_t)TT * 128 * 2);
constexpr size_t OFF_AG = OFF_U + al((size_t)TT * 256 * 4);
constexpr size_t OFF_HMID = OFF_Q;
constexpr size_t OFF_OMOE = OFF_AG + al((size_t)TT * 512 * 2);
constexpr size_t OFF_GATE = OFF_OMOE + al((size_t)TT * 2 * D * 2);
constexpr size_t OFF_LIST = OFF_GATE + al((size_t)TT * 2 * 4);
constexpr size_t OFF_WIN = OFF_LIST + al((size_t)NE * CAPL * 4);
constexpr size_t OFF_WOUT = OFF_WIN + al((size_t)2 * D * INW * 2);
constexpr size_t OFF_WPWT = OFF_WOUT + al((size_t)2 * D * D * 2);
constexpr size_t OFF_WPOOLT = OFF_WPWT + al((size_t)2 * 256 * 256 * 2);
constexpr size_t OFF_WG = OFF_WPOOLT + al((size_t)2 * 4 * 64 * 64 * 2);
constexpr size_t OFF_WU = OFF_WG + al((size_t)2 * NE * D * DE * 2);
constexpr size_t OFF_WD = OFF_WU + al((size_t)2 * NE * D * DE * 2);
constexpr size_t WS_END = OFF_WD + al((size_t)2 * NE * D * DE * 2);
static_assert(OFF_AG - OFF_HMID >= (size_t)HMID_ROWS * DE * 2, "HMID alias too small");
static_assert(WS_END < 530000000, "ws budget");

struct Params {
  const float *x, *c, *ctx, *c_ctx, *w_mod, *b_mod, *w_in, *q_gain, *k_gain, *w_pool, *pool_scale, *w_dw, *b_dw,
      *cv_ln_g, *cv_ln_b, *w_cv_pw, *w_out, *ln1_g, *ln1_b, *ln2_g, *ln2_b, *w_rg, *b_rg, *w_re, *b_re, *w_e_gate, *w_e_up, *w_e_down;
  float* out;
  char* ws;
};

__device__ __forceinline__ float bf2f(bf16_t v) { return __uint_as_float(((unsigned)v) << 16); }
__device__ __forceinline__ bf16_t f2bf(float f) {
  unsigned u = __float_as_uint(f);
  u += 0x7fffu + ((u >> 16) & 1u);
  return (bf16_t)(u >> 16);
}
__device__ __forceinline__ float wave_sum(float v) {
#pragma unroll
  for (int o = 32; o > 0; o >>= 1) v += __shfl_xor(v, o);
  return v;
}
__device__ __forceinline__ float silu(float v) { return v / (1.f + __expf(-v)); }
__device__ __forceinline__ int opaque0() { int z; asm volatile("s_mov_b32 %0, 0" : "=s"(z)); return z; }
#define TIDX ((int)threadIdx.x + opaque0())
using bf16x8 = __attribute__((ext_vector_type(8))) short;
using s16x4 = __attribute__((ext_vector_type(4))) short;
using f32x16 = __attribute__((ext_vector_type(16))) float;
using f32x4 = __attribute__((ext_vector_type(4))) float;
using u32x4 = __attribute__((ext_vector_type(4))) unsigned;
using u32x2 = __attribute__((ext_vector_type(2))) unsigned;

__device__ __forceinline__ int crow(int r, int hi) { return (r & 3) + 8 * (r >> 2) + 4 * hi; }
typedef float f32x2 __attribute__((ext_vector_type(2)));
typedef __bf16 bf16x2v __attribute__((ext_vector_type(2)));
__device__ __forceinline__ unsigned cvtpk(float lo, float hi) {
  bf16x2v b = __builtin_convertvector((f32x2){lo, hi}, bf16x2v);
  return __builtin_bit_cast(unsigned, b);
}
__device__ __forceinline__ float sum32(float v) {
  auto rr = __builtin_amdgcn_permlane32_swap(__float_as_uint(v), __float_as_uint(v), false, false);
  return __uint_as_float(rr[0]) + __uint_as_float(rr[1]);
}

__device__ __forceinline__ void cvt_range(const float* __restrict__ src, bf16_t* __restrict__ dst, long n8, long gtid, long gthreads) {
  for (long i = gtid; i < n8; i += gthreads) {
    const f32x4 a = *(const f32x4*)(src + i * 8), b = *(const f32x4*)(src + i * 8 + 4);
    u32x4 w = {cvtpk(a[0], a[1]), cvtpk(a[2], a[3]), cvtpk(b[0], b[1]), cvtpk(b[2], b[3])};
    *(u32x4*)(dst + i * 8) = w;
  }
}

__device__ __forceinline__ int xoff(int row, int chunk) { return row * 128 + ((chunk ^ ((row >> 1) & 7)) << 4); }
__device__ __forceinline__ int wst(int k, int c) { const int kk = (k & ~0xC) | ((k & 4) << 1) | ((k & 8) >> 1); return ((kk >> 3) * 4 + (c >> 5)) * 512 + ((kk & 7) * 32 + (c & 31)) * 2; }
__device__ __forceinline__ int v_rd_base(int lane) { return ((lane & 3) << 3) | (((lane >> 2) & 3) << 6) | (((lane >> 4) & 1) << 5) | (((lane >> 5) & 1) << 8); }

__device__ __forceinline__ bf16x8 tr_frag(const LAS char* p) {
  s16x4 a = __builtin_amdgcn_ds_read_tr16_b64_v4i16((LAS s16x4*)p);
  s16x4 b = __builtin_amdgcn_ds_read_tr16_b64_v4i16((LAS s16x4*)(p + 2048));
  return (bf16x8){a[0], a[1], a[2], a[3], b[0], b[1], b[2], b[3]};
}

template <int BM, int BN> struct GemmCfg {
  static constexpr int WM = BM / 64, WN = 8 / WM, NSLAB = BN / 128, XB = BM * 128, WB = NSLAB * 16384, STAGE = XB + WB, NXP = BM / 64, NWP = NSLAB * 2;
  static_assert(WM * WN == 8 && WN * 64 == BN, "tile");
};
constexpr int GEMM_LDS = 2 * (256 * 128 + 16384);

template <int BM, int BN, int NMAP, class XRow, class WPtr>
__device__ __forceinline__ void gemm_mainloop(LAS char* lds, f32x16 (&acc)[2][2], const XRow& xrow, const WPtr& wptr, int ldw, int K) {
  using C = GemmCfg<BM, BN>;
  const int tid = TIDX, wid = tid >> 6, lane = tid & 63, r32 = lane & 31, hi = lane >> 5;
  const int wm = wid / C::WN, wn = wid % C::WN;
  const bf16_t* xg[C::NXP]; int xl[C::NXP];
#pragma unroll
  for (int i = 0; i < C::NXP; ++i) { const int row = (tid >> 3) + 64 * i; xg[i] = xrow(row) + (tid & 7) * 8; xl[i] = xoff(row, tid & 7); }
  const bf16_t* wg[C::NWP]; int wl[C::NWP];
#pragma unroll
  for (int i = 0; i < C::NWP; ++i) { const int s = i >> 1, k = (tid >> 4) + 32 * (i & 1), c = (tid & 15) * 8; wg[i] = wptr(s) + (size_t)k * ldw + c; wl[i] = C::XB + s * 16384 + wst(k, c); }
  int xr[2];
#pragma unroll
  for (int ti = 0; ti < 2; ++ti) xr[ti] = (wm * 64 + ti * 32 + r32) * 128;
  const int xsw = (r32 >> 1) & 7;
  int wr[2];
#pragma unroll
  for (int ni = 0; ni < 2; ++ni) {
    const int slab = NMAP == 0 ? 0 : (NMAP == 1 ? (wn >> 1) : ni);
    const int nb = NMAP == 0 ? (2 * wn + ni) : (NMAP == 1 ? ((wn & 1) * 2 + ni) : wn);
    wr[ni] = C::XB + slab * 16384 + nb * 512 + v_rd_base(lane);
  }
  u32x4 xs[C::NXP], wsr[C::NWP];
  const int nk = K / 64;
#pragma unroll
  for (int i = 0; i < C::NXP; ++i) xs[i] = *(const u32x4*)(xg[i]);
#pragma unroll
  for (int i = 0; i < C::NWP; ++i) wsr[i] = *(const u32x4*)(wg[i]);
#pragma unroll
  for (int i = 0; i < C::NXP; ++i) *(LAS u32x4*)(lds + xl[i]) = xs[i];
#pragma unroll
  for (int i = 0; i < C::NWP; ++i) *(LAS u32x4*)(lds + wl[i]) = wsr[i];
  __syncthreads();
  for (int kt = 0; kt < nk; ++kt) {
    const LAS char* cur = lds + (kt & 1) * C::STAGE;
    LAS char* nxt = lds + ((kt + 1) & 1) * C::STAGE;
    const bool more = kt + 1 < nk;
    if (more) {
#pragma unroll
      for (int i = 0; i < C::NXP; ++i) xs[i] = *(const u32x4*)(xg[i] + (kt + 1) * 64);
#pragma unroll
      for (int i = 0; i < C::NWP; ++i) wsr[i] = *(const u32x4*)(wg[i] + (size_t)(kt + 1) * 64 * ldw);
    }
#pragma unroll
    for (int ks = 0; ks < 4; ++ks) {
      bf16x8 xf[2], wf[2];
#pragma unroll
      for (int ti = 0; ti < 2; ++ti) xf[ti] = *(const LAS bf16x8*)(cur + xr[ti] + (((ks * 2 + hi) ^ xsw) << 4));
#pragma unroll
      for (int ni = 0; ni < 2; ++ni) wf[ni] = tr_frag(cur + wr[ni] + ks * 4096);
#pragma unroll
      for (int ti = 0; ti < 2; ++ti)
#pragma unroll
        for (int ni = 0; ni < 2; ++ni) acc[ti][ni] = __builtin_amdgcn_mfma_f32_32x32x16_bf16(wf[ni], xf[ti], acc[ti][ni], 0, 0, 0);
    }
    if (more) {
#pragma unroll
      for (int i = 0; i < C::NXP; ++i) *(LAS u32x4*)(nxt + xl[i]) = xs[i];
#pragma unroll
      for (int i = 0; i < C::NWP; ++i) *(LAS u32x4*)(nxt + wl[i]) = wsr[i];
    }
    __syncthreads();
  }
}

__device__ __forceinline__ u32x2 pack4(const f32x16& a, int g) { return (u32x2){cvtpk(a[4 * g], a[4 * g + 1]), cvtpk(a[4 * g + 2], a[4 * g + 3])}; }

__device__ __forceinline__ void phase_a1(const Params& p, int layer, LAS char* lds, int bid, int nblk) {
  const bf16_t* H = (const bf16_t*)(p.ws + OFF_H);
  const bf16_t* W = (const bf16_t*)(p.ws + OFF_WIN) + (size_t)layer * D * INW;
  bf16_t* Q = (bf16_t*)(p.ws + OFF_Q); bf16_t* Kb = (bf16_t*)(p.ws + OFF_K); bf16_t* Vb = (bf16_t*)(p.ws + OFF_V);
  float* U = (float*)(p.ws + OFF_U); bf16_t* AG = (bf16_t*)(p.ws + OFF_AG);
  const float* rt = (const float*)(p.ws + OFF_ROPE);
  const int lane = TIDX & 63, wid = TIDX >> 6, r32 = lane & 31, hi = lane >> 5, wm = wid >> 1, wn = wid & 1;
  const int nlat = 64 * 12, nunits = nlat + (layer == 0 ? 12 : 2);
  for (int u = bid; u < nunits; u += nblk) {
    int rtile, ct;
    if (u < nlat) { rtile = 1 + u / 12; ct = u % 12; } else { rtile = 0; ct = layer == 0 ? (u - nlat) : (4 + u - nlat); }
    const int m0 = rtile * 256, n0 = ct * 128;
    f32x16 acc[2][2];
#pragma unroll
    for (int a = 0; a < 2; ++a)
#pragma unroll
      for (int b = 0; b < 2; ++b) acc[a][b] = (f32x16){};
    gemm_mainloop<256, 128, 0>(lds, acc, [&](int row) { return H + (size_t)(m0 + row) * D; }, [&](int) { return W + n0; }, INW, D);
#pragma unroll
    for (int ti = 0; ti < 2; ++ti) {
      const int tok = m0 + wm * 64 + ti * 32 + r32;
      if (ct < 5) {
        float ss = 0.f;
#pragma unroll
        for (int ni = 0; ni < 2; ++ni)
#pragma unroll
          for (int r = 0; r < 16; ++r) ss += acc[ti][ni][r] * acc[ti][ni][r];
        ss = sum32(ss);
        const float rs = rsqrtf(ss * (1.f / 64.f) + EPS);
        const float* gain = (ct < 4 ? p.q_gain : p.k_gain) + layer * 64;
        const float osc = ct < 4 ? 0.125f * 1.4426950408889634f : 1.f;
        const bool lat = rtile > 0;
        const int t = tok - NCTX;
#pragma unroll
        for (int ni = 0; ni < 2; ++ni) {
          f32x16 v;
#pragma unroll
          for (int r = 0; r < 16; ++r) v[r] = acc[ti][ni][r] * rs * gain[ni * 32 + crow(r, hi)];
          if (lat) {
            const int pos = ni == 0 ? (t >> 6) : (t & 63);
#pragma unroll
            for (int r = 0; r < 8; ++r) {
              const int f = crow(r, hi);
              const float cs = rt[(pos * 16 + f) * 2], sn = rt[(pos * 16 + f) * 2 + 1];
              const float t1 = v[r], t2 = v[r + 8];
              v[r] = t1 * cs - t2 * sn; v[r + 8] = t2 * cs + t1 * sn;
            }
          }
#pragma unroll
          for (int r = 0; r < 16; ++r) v[r] *= osc;
          bf16_t* dst = ct < 4 ? Q + (size_t)tok * 512 + (ct * 2 + wn) * 64 + ni * 32 : Kb + (size_t)tok * 128 + wn * 64 + ni * 32;
#pragma unroll
          for (int g = 0; g < 4; ++g) *(u32x2*)(dst + 8 * g + 4 * hi) = pack4(v, g);
        }
      } else if (ct == 5) {
#pragma unroll
        for (int ni = 0; ni < 2; ++ni)
#pragma unroll
          for (int g = 0; g < 4; ++g) *(u32x2*)(Vb + (size_t)tok * 128 + wn * 64 + ni * 32 + 8 * g + 4 * hi) = pack4(acc[ti][ni], g);
      } else if (ct < 8) {
#pragma unroll
        for (int ni = 0; ni < 2; ++ni)
#pragma unroll
          for (int g = 0; g < 4; ++g)
            *(f32x4*)(U + (size_t)tok * 256 + (ct - 6) * 128 + wn * 64 + ni * 32 + 8 * g + 4 * hi) =
                (f32x4){acc[ti][ni][4 * g], acc[ti][ni][4 * g + 1], acc[ti][ni][4 * g + 2], acc[ti][ni][4 * g + 3]};
      } else {
#pragma unroll
        for (int ni = 0; ni < 2; ++ni)
#pragma unroll
          for (int g = 0; g < 4; ++g) *(u32x2*)(AG + (size_t)tok * 512 + (ct - 8) * 128 + wn * 64 + ni * 32 + 8 * g + 4 * hi) = pack4(acc[ti][ni], g);
      }
    }
  }
}

__device__ __forceinline__ void phase_c1(const Params& p, int layer, LAS char* lds, int bid, int nblk) {
  const bf16_t* A = (const bf16_t*)(p.ws + OFF_MIX);
  const bf16_t* W = (const bf16_t*)(p.ws + OFF_WOUT) + (size_t)layer * D * D;
  bf16_t* Y = (bf16_t*)(p.ws + OFF_Y);
  const int lane = TIDX & 63, wid = TIDX >> 6, r32 = lane & 31, hi = lane >> 5, wm = wid >> 1, wn = wid & 1;
  const int rt0 = layer == 0 ? 0 : 1, nunits = (65 - rt0) * 8;
  for (int u = bid; u < nunits; u += nblk) {
    const int m0 = (rt0 + u / 8) * 256, n0 = (u % 8) * 128;
    f32x16 acc[2][2];
#pragma unroll
    for (int a = 0; a < 2; ++a)
#pragma unroll
      for (int b = 0; b < 2; ++b) acc[a][b] = (f32x16){};
    gemm_mainloop<256, 128, 0>(lds, acc, [&](int row) { return A + (size_t)(m0 + row) * D; }, [&](int) { return W + n0; }, D, D);
#pragma unroll
    for (int ti = 0; ti < 2; ++ti) {
      const int tok = m0 + wm * 64 + ti * 32 + r32;
#pragma unroll
      for (int ni = 0; ni < 2; ++ni)
#pragma unroll
        for (int g = 0; g < 4; ++g) *(u32x2*)(Y + (size_t)tok * D + n0 + wn * 64 + ni * 32 + 8 * g + 4 * hi) = pack4(acc[ti][ni], g);
    }
  }
}

__device__ __forceinline__ int moe_prefix(const int* cnt, LAS int* pre) {
  if (TIDX == 0) { int o = 0; for (int e = 0; e < NE; ++e) { pre[e] = o; o += (cnt[e] + 127) >> 7; } pre[NE] = o; }
  __syncthreads();
  return pre[NE];
}
__device__ __forceinline__ int moe_find(const LAS int* pre, int g) { int e = 0; for (int i = 1; i < NE; ++i) e += (pre[i] <= g) ? 1 : 0; return e; }

__device__ __forceinline__ void phase_d1(const Params& p, int layer, LAS char* lds, int bid, int nblk) {
  const int* cnt = (const int*)(p.ws + OFF_CNT) + layer * 64;
  const bf16_t* H2 = (const bf16_t*)(p.ws + OFF_MIX);
  bf16_t* HM = (bf16_t*)(p.ws + OFF_HMID);
  LAS int* pre = (LAS int*)(lds + GEMM_LDS);
  const int ntiles = moe_prefix(cnt, pre);
  const int lane = TIDX & 63, wid = TIDX >> 6, r32 = lane & 31, hi = lane >> 5, wm = wid >> 2, wn = wid & 3;
  for (int u = bid; u < ntiles * 4; u += nblk) {
    const int g = u >> 2, ct = u & 3, e = moe_find(pre, g), rt = g - pre[e], n = cnt[e];
    const int* list = (const int*)(p.ws + OFF_LIST) + (size_t)e * CAPL + rt * 128;
    const bf16_t* Wg = (const bf16_t*)(p.ws + OFF_WG) + ((size_t)layer * NE + e) * D * DE + ct * 128;
    const bf16_t* Wu = (const bf16_t*)(p.ws + OFF_WU) + ((size_t)layer * NE + e) * D * DE + ct * 128;
    const int nvalid = n - rt * 128;
    f32x16 acc[2][2];
#pragma unroll
    for (int a = 0; a < 2; ++a)
#pragma unroll
      for (int b = 0; b < 2; ++b) acc[a][b] = (f32x16){};
    gemm_mainloop<128, 256, 2>(lds, acc, [&](int row) { const int tok = row < nvalid ? (list[row] >> 1) : 0; return H2 + (size_t)tok * D; },
                               [&](int s) { return s == 0 ? Wg : Wu; }, DE, D);
    const size_t hrow0 = (size_t)(pre[e] + rt) * 128;
#pragma unroll
    for (int ti = 0; ti < 2; ++ti) {
      const size_t row = hrow0 + wm * 64 + ti * 32 + r32;
      f32x16 a;
#pragma unroll
      for (int r = 0; r < 16; ++r) { const float gv = acc[ti][0][r]; a[r] = gv / (1.f + __expf(-gv)) * acc[ti][1][r]; }
#pragma unroll
      for (int gq = 0; gq < 4; ++gq) *(u32x2*)(HM + row * DE + ct * 128 + wn * 32 + 8 * gq + 4 * hi) = pack4(a, gq);
    }
  }
}

__device__ __forceinline__ void phase_d2(const Params& p, int layer, LAS char* lds, int bid, int nblk) {
  const int* cnt = (const int*)(p.ws + OFF_CNT) + layer * 64;
  const bf16_t* HM = (const bf16_t*)(p.ws + OFF_HMID);
  const float* GATE = (const float*)(p.ws + OFF_GATE);
  bf16_t* OM = (bf16_t*)(p.ws + OFF_OMOE);
  LAS int* pre = (LAS int*)(lds + GEMM_LDS);
  const int ntiles = moe_prefix(cnt, pre);
  const int lane = TIDX & 63, wid = TIDX >> 6, r32 = lane & 31, hi = lane >> 5, wm = wid >> 2, wn = wid & 3;
  for (int u = bid; u < ntiles * 4; u += nblk) {
    const int g = u >> 2, ct = u & 3, e = moe_find(pre, g), rt = g - pre[e], n = cnt[e];
    const int* list = (const int*)(p.ws + OFF_LIST) + (size_t)e * CAPL + rt * 128;
    const bf16_t* Wd = (const bf16_t*)(p.ws + OFF_WD) + ((size_t)layer * NE + e) * DE * D + ct * 256;
    const int nvalid = n - rt * 128;
    const bf16_t* A = HM + (size_t)g * 128 * DE;
    f32x16 acc[2][2];
#pragma unroll
    for (int a = 0; a < 2; ++a)
#pragma unroll
      for (int b = 0; b < 2; ++b) acc[a][b] = (f32x16){};
    gemm_mainloop<128, 256, 1>(lds, acc, [&](int row) { return A + (size_t)row * DE; }, [&](int s) { return Wd + s * 128; }, D, DE);
#pragma unroll
    for (int ti = 0; ti < 2; ++ti) {
      const int row = wm * 64 + ti * 32 + r32;
      if (row < nvalid) {
        const int ts = list[row];
        const float gt = GATE[ts];
#pragma unroll
        for (int ni = 0; ni < 2; ++ni) {
          f32x16 a;
#pragma unroll
          for (int r = 0; r < 16; ++r) a[r] = acc[ti][ni][r] * gt;
#pragma unroll
          for (int gq = 0; gq < 4; ++gq) *(u32x2*)(OM + (size_t)ts * D + ct * 256 + wn * 64 + ni * 32 + 8 * gq + 4 * hi) = pack4(a, gq);
        }
      }
    }
  }
}

constexpr int ATT_SLOT = 16384, ATT_LDS = 4 * ATT_SLOT;
__device__ __forceinline__ int vst64(int k, int c) { const int kk = (k & ~0xC) | ((k & 4) << 1) | ((k & 8) >> 1); return ((kk >> 3) * 2 + (c >> 5)) * 512 + ((kk & 7) * 32 + (c & 31)) * 2; }
__device__ __forceinline__ bf16x8 tr_frag64(const LAS char* p) {
  s16x4 a = __builtin_amdgcn_ds_read_tr16_b64_v4i16((LAS s16x4*)p);
  s16x4 b = __builtin_amdgcn_ds_read_tr16_b64_v4i16((LAS s16x4*)(p + 1024));
  return (bf16x8){a[0], a[1], a[2], a[3], b[0], b[1], b[2], b[3]};
}
__device__ __forceinline__ bf16x8 pk4(const f32x16& P, int B) {
  unsigned a0 = cvtpk(P[B + 0], P[B + 1]), a1 = cvtpk(P[B + 2], P[B + 3]), b0 = cvtpk(P[B + 4], P[B + 5]), b1 = cvtpk(P[B + 6], P[B + 7]);
  auto r0 = __builtin_amdgcn_permlane32_swap(a0, b0, false, false); auto r1 = __builtin_amdgcn_permlane32_swap(a1, b1, false, false);
  u32x4 w = {r0[0], r1[0], r0[1], r1[1]};
  return __builtin_bit_cast(bf16x8, w);
}
struct AttnCtx { int krd0, krd1, ksw, hi, vrd; };
__device__ __forceinline__ void att_qk(const LAS char* slot, const AttnCtx& c, const bf16x8 (&qr)[4], f32x16& s0, f32x16& s1) {
  s0 = (f32x16){}; s1 = (f32x16){};
#pragma unroll
  for (int d0 = 0; d0 < 4; ++d0) {
    const bf16x8 b0 = *(const LAS bf16x8*)(slot + c.krd0 + (((2 * d0 + c.hi) ^ c.ksw) << 4));
    const bf16x8 b1 = *(const LAS bf16x8*)(slot + c.krd1 + (((2 * d0 + c.hi) ^ c.ksw) << 4));
    s0 = __builtin_amdgcn_mfma_f32_32x32x16_bf16(b0, qr[d0], s0, 0, 0, 0);
    s1 = __builtin_amdgcn_mfma_f32_32x32x16_bf16(b1, qr[d0], s1, 0, 0, 0);
  }
}
__device__ __forceinline__ void att_exp(f32x16& s, float& l) {
  float a = 0.f, b = 0.f;
#pragma unroll
  for (int r = 0; r < 16; r += 2) { s[r] = __builtin_amdgcn_exp2f(s[r]); s[r + 1] = __builtin_amdgcn_exp2f(s[r + 1]); a += s[r]; b += s[r + 1]; }
  l += a + b;
}
__device__ __forceinline__ void att_pv(const LAS char* slot, const AttnCtx& c, const bf16x8 (&pa)[4], f32x16& o0, f32x16& o1) {
#pragma unroll
  for (int ks = 0; ks < 4; ++ks) {
    o0 = __builtin_amdgcn_mfma_f32_32x32x16_bf16(pa[ks], tr_frag64(slot + c.vrd + ks * 2048), o0, 0, 0, 0);
    o1 = __builtin_amdgcn_mfma_f32_32x32x16_bf16(pa[ks], tr_frag64(slot + c.vrd + 512 + ks * 2048), o1, 0, 0, 0);
  }
}
__device__ __forceinline__ void attn_unit(const Params& p, LAS char* lds, int row0, int head, int nkeys) {
  const bf16_t* Q = (const bf16_t*)(p.ws + OFF_Q); const bf16_t* Kb = (const bf16_t*)(p.ws + OFF_K); const bf16_t* Vb = (const bf16_t*)(p.ws + OFF_V);
  bf16_t* MIX = (bf16_t*)(p.ws + OFF_MIX);
  const int tid = TIDX, wid = tid >> 6, lane = tid & 63, r32 = lane & 31, hi = lane >> 5, kvh = head >> 2;
  bf16x8 qr[4];
  { const bf16_t* Qg = Q + (size_t)(row0 + wid * 32 + r32) * 512 + head * 64 + hi * 8;
#pragma unroll
    for (int d0 = 0; d0 < 4; ++d0) qr[d0] = *(const bf16x8*)(Qg + d0 * 16); }
  const bf16_t* Kg = Kb + (size_t)(tid >> 3) * 128 + kvh * 64 + (tid & 7) * 8;
  const bf16_t* Vg = Vb + (size_t)(tid >> 3) * 128 + kvh * 64 + (tid & 7) * 8;
  const int kst = xoff(tid >> 3, tid & 7), vstw = 8192 + vst64(tid >> 3, (tid & 7) * 8);
  AttnCtx c; c.krd0 = r32 * 128; c.krd1 = (32 + r32) * 128; c.ksw = (r32 >> 1) & 7; c.hi = hi; c.vrd = 8192 + v_rd_base(lane);
  const int NT = nkeys >> 6;
  f32x16 o0 = {}, o1 = {}; float l = 0.f;
  u32x4 ks, vs;
  {
    const u32x4 k0 = *(const u32x4*)Kg, k1 = *(const u32x4*)(Kg + 64 * 128), k2 = *(const u32x4*)(Kg + 2 * 64 * 128);
    const u32x4 v0 = *(const u32x4*)Vg, v1 = *(const u32x4*)(Vg + 64 * 128);
    *(LAS u32x4*)(lds + kst) = k0; *(LAS u32x4*)(lds + ATT_SLOT + kst) = k1; *(LAS u32x4*)(lds + 2 * ATT_SLOT + kst) = k2;
    *(LAS u32x4*)(lds + vstw) = v0; *(LAS u32x4*)(lds + ATT_SLOT + vstw) = v1;
    ks = *(const u32x4*)(Kg + 3 * 64 * 128); vs = *(const u32x4*)(Vg + 2 * 64 * 128);
  }
  __syncthreads();
  f32x16 sA0, sA1, sB0, sB1;
  att_qk(lds, c, qr, sA0, sA1);
  att_exp(sA0, l);
#define ATT_ITER(j, sX0, sX1, sY0, sY1) do { \
    { LAS char* wk = lds + (((j) + 3) & 3) * ATT_SLOT; LAS char* wv = lds + (((j) + 2) & 3) * ATT_SLOT; \
      if ((j) + 3 < NT) *(LAS u32x4*)(wk + kst) = ks; if ((j) + 2 < NT) *(LAS u32x4*)(wv + vstw) = vs; \
      if ((j) + 4 < NT) ks = *(const u32x4*)(Kg + (size_t)((j) + 4) * 64 * 128); if ((j) + 3 < NT) vs = *(const u32x4*)(Vg + (size_t)((j) + 3) * 64 * 128); } \
    if ((j) + 1 < NT) att_qk(lds + (((j) + 1) & 3) * ATT_SLOT, c, qr, sY0, sY1); \
    att_exp(sX1, l); \
    bf16x8 pa[4]; pa[0] = pk4(sX0, 0); pa[1] = pk4(sX0, 8); pa[2] = pk4(sX1, 0); pa[3] = pk4(sX1, 8); \
    att_pv(lds + ((j) & 3) * ATT_SLOT, c, pa, o0, o1); \
    if ((j) + 1 < NT) att_exp(sY0, l); \
    __syncthreads(); } while (0)
  for (int j = 0; j < NT; j += 2) {
    ATT_ITER(j, sA0, sA1, sB0, sB1);
    ATT_ITER(j + 1, sB0, sB1, sA0, sA1);
  }
#undef ATT_ITER
  l = sum32(l);
  LAS float* li = (LAS float*)(lds + wid * 128);
  if (hi == 0) li[r32] = l;
  __syncthreads();
  bf16_t* Og = MIX + (size_t)(row0 + wid * 32) * D + head * 64 + r32;
#pragma unroll
  for (int r = 0; r < 16; ++r) {
    const int orow = crow(r, hi);
    const float rl = __builtin_amdgcn_rcpf(li[orow]);
    Og[(size_t)orow * D] = f2bf(o0[r] * rl);
    Og[(size_t)orow * D + 32] = f2bf(o1[r] * rl);
  }
  __syncthreads();
}
__device__ __forceinline__ void attn_fallback(const Params& p, int layer, int bid, int nblk) {
  const bf16_t* Q = (const bf16_t*)(p.ws + OFF_Q); const bf16_t* Kb = (const bf16_t*)(p.ws + OFF_K); const bf16_t* Vb = (const bf16_t*)(p.ws + OFF_V);
  bf16_t* MIX = (bf16_t*)(p.ws + OFF_MIX);
  const int lane = TIDX & 63, nwv = nblk * 8;
  const int rg0 = layer == 0 ? 0 : NCTX / 64;
  for (int wv = bid * 8 + (TIDX >> 6) + rg0 * 8; wv < (TT / 64) * 8; wv += nwv) {
    const int head = wv & 7, r = (wv >> 3) * 64 + lane, kvh = head >> 2;
    float q[64], o[64];
#pragma unroll
    for (int d = 0; d < 64; ++d) { q[d] = bf2f(Q[(size_t)r * 512 + head * 64 + d]); o[d] = 0.f; }
    float m = -1e30f, l = 0.f;
    const int nk = r >= NCTX ? TT : NCTX;
    for (int j = 0; j < nk; ++j) {
      const bf16_t* kr = Kb + (size_t)j * 128 + kvh * 64;
      const bf16_t* vr = Vb + (size_t)j * 128 + kvh * 64;
      float s = 0.f;
#pragma unroll
      for (int d = 0; d < 64; ++d) s += q[d] * bf2f(kr[d]);
      if (s > m) {
        const float a = __builtin_amdgcn_exp2f(m - s);
        l *= a;
#pragma unroll
        for (int d = 0; d < 64; ++d) o[d] *= a;
        m = s;
      }
      const float pe = __builtin_amdgcn_exp2f(s - m);
      l += pe;
#pragma unroll
      for (int d = 0; d < 64; ++d) o[d] += pe * bf2f(vr[d]);
    }
    const float il = 1.f / l;
#pragma unroll
    for (int d = 0; d < 64; ++d) MIX[(size_t)r * D + head * 64 + d] = f2bf(o[d] * il);
  }
}

constexpr int PC_U = 0;
constexpr int PC_Y = 49152;
constexpr int PC_LDS = PC_Y + 65536;
__device__ __forceinline__ void poolconv_unit(const Params& p, int layer, LAS char* lds, int tile) {
  const int tid = TIDX, wid = tid >> 6, lane = tid & 63, r32 = lane & 31, hi = lane >> 5;
  const int t0 = tile * 64, base = tile < 4 ? 0 : NCTX, n = tile < 4 ? NCTX : SEQ;
  const bf16_t* AG = (const bf16_t*)(p.ws + OFF_AG);
  const float* U = (const float*)(p.ws + OFF_U);
  bf16_t* MIX = (bf16_t*)(p.ws + OFF_MIX);
  for (int idx = tid; idx < 94 * 32; idx += 512) {
    const int rr = idx >> 5, ch = (idx & 31) * 8, t = t0 - 15 + rr;
    u32x4 out = {0u, 0u, 0u, 0u};
    if (t >= base && t < base + n) {
      const u32x4 av = *(const u32x4*)(AG + (size_t)t * 512 + ch), gv = *(const u32x4*)(AG + (size_t)t * 512 + 256 + ch);
#pragma unroll
      for (int i = 0; i < 4; ++i) {
        const float a0 = __uint_as_float(av[i] << 16), a1 = __uint_as_float(av[i] & 0xffff0000u);
        const float g0 = __uint_as_float(gv[i] << 16), g1 = __uint_as_float(gv[i] & 0xffff0000u);
        out[i] = cvtpk(a0 / (1.f + __expf(-g0)), a1 / (1.f + __expf(-g1)));
      }
    }
    *(LAS u32x4*)(lds + PC_U + (rr * 256 + ch) * 2) = out;
  }
  __syncthreads();
  {
    const int c = tid & 255, th = tid >> 8;
    float w[31];
#pragma unroll
    for (int j = 0; j < 31; ++j) w[j] = p.w_dw[(size_t)layer * 31 * 256 + j * 256 + c];
    const float b = p.b_dw[layer * 256 + c];
    float acc[32];
#pragma unroll
    for (int i = 0; i < 32; ++i) acc[i] = b;
    const LAS bf16_t* up = (const LAS bf16_t*)(lds + PC_U) + (th * 32) * 256 + c;
#pragma unroll
    for (int rr = 0; rr < 62; ++rr) {
      const float uv = bf2f(up[rr * 256]);
#pragma unroll
      for (int i = 0; i < 32; ++i) if (rr - i >= 0 && rr - i < 31) acc[i] += uv * w[rr - i];
    }
    LAS float* yp = (LAS float*)(lds + PC_Y) + (th * 32) * 256 + c;
#pragma unroll
    for (int i = 0; i < 32; ++i) yp[i * 256] = acc[i];
  }
  __syncthreads();
  {
    const f32x4 g4 = *(const f32x4*)(p.cv_ln_g + layer * 256 + lane * 4), b4 = *(const f32x4*)(p.cv_ln_b + layer * 256 + lane * 4);
#pragma unroll
    for (int i = 0; i < 8; ++i) {
      const int tok = wid * 8 + i;
      const f32x4 y = *(const LAS f32x4*)(lds + PC_Y + (tok * 256 + lane * 4) * 4);
      const float mu = wave_sum(y[0] + y[1] + y[2] + y[3]) * (1.f / 256.f);
      const float d0 = y[0] - mu, d1 = y[1] - mu, d2 = y[2] - mu, d3 = y[3] - mu;
      const float rs = rsqrtf(wave_sum(d0 * d0 + d1 * d1 + d2 * d2 + d3 * d3) * (1.f / 256.f) + EPS);
      const float z0 = silu(d0 * rs * g4[0] + b4[0]), z1 = silu(d1 * rs * g4[1] + b4[1]), z2 = silu(d2 * rs * g4[2] + b4[2]), z3 = silu(d3 * rs * g4[3] + b4[3]);
      const int chunk = lane >> 1, sw = (chunk & 16) | ((chunk ^ tok) & 15);
      *(LAS u32x2*)(lds + PC_U + tok * 512 + sw * 16 + (lane & 1) * 8) = (u32x2){cvtpk(z0, z1), cvtpk(z2, z3)};
    }
  }
  __syncthreads();
  {
    const int tb = wid >> 2, dg = wid & 3, trow = tb * 32 + r32, t = t0 + trow;
    const bf16_t* Wt = (const bf16_t*)(p.ws + OFF_WPWT) + ((size_t)layer * 256 + dg * 64 + r32) * 256 + hi * 8;
    f32x16 acc0 = {}, acc1 = {};
#pragma unroll 4
    for (int ks = 0; ks < 16; ++ks) {
      const int chunk = 2 * ks + hi, sw = (chunk & 16) | ((chunk ^ trow) & 15);
      const bf16x8 zf = *(const LAS bf16x8*)(lds + PC_U + trow * 512 + sw * 16);
      const bf16x8 w0 = *(const bf16x8*)(Wt + ks * 16), w1 = *(const bf16x8*)(Wt + 32 * 256 + ks * 16);
      acc0 = __builtin_amdgcn_mfma_f32_32x32x16_bf16(w0, zf, acc0, 0, 0, 0);
      acc1 = __builtin_amdgcn_mfma_f32_32x32x16_bf16(w1, zf, acc1, 0, 0, 0);
    }
    bf16_t* dst = MIX + (size_t)t * D + 768 + dg * 64;
#pragma unroll
    for (int g = 0; g < 4; ++g) { *(u32x2*)(dst + 8 * g + 4 * hi) = pack4(acc0, g); *(u32x2*)(dst + 32 + 8 * g + 4 * hi) = pack4(acc1, g); }
    const int w = 2 << dg, tl = t - base, lo = max(tl - w / 2, 0), hh = min(tl + w / 2, n);
    const float inv = 1.f / (float)(hh - lo);
    const bf16_t* Pt = (const bf16_t*)(p.ws + OFF_WPOOLT) + ((size_t)(layer * 4 + dg) * 64 + r32) * 64 + hi * 8;
    f32x16 pc0 = {}, pc1 = {};
#pragma unroll
    for (int ks = 0; ks < 4; ++ks) {
      const int c0 = dg * 64 + ks * 16 + hi * 8;
      f32x4 s0 = {0.f, 0.f, 0.f, 0.f}, s1 = {0.f, 0.f, 0.f, 0.f};
      for (int rr = lo; rr < hh; ++rr) { const float* ur = U + (size_t)(base + rr) * 256 + c0; s0 += *(const f32x4*)ur; s1 += *(const f32x4*)(ur + 4); }
      const float* uo = U + (size_t)t * 256 + c0;
      const f32x4 o0 = *(const f32x4*)uo, o1 = *(const f32x4*)(uo + 4);
      s0 = s0 * inv - o0; s1 = s1 * inv - o1;
      u32x4 pw = {cvtpk(s0[0], s0[1]), cvtpk(s0[2], s0[3]), cvtpk(s1[0], s1[1]), cvtpk(s1[2], s1[3])};
      const bf16x8 pf = __builtin_bit_cast(bf16x8, pw);
      const bf16x8 w0 = *(const bf16x8*)(Pt + ks * 16), w1 = *(const bf16x8*)(Pt + 32 * 64 + ks * 16);
      pc0 = __builtin_amdgcn_mfma_f32_32x32x16_bf16(w0, pf, pc0, 0, 0, 0);
      pc1 = __builtin_amdgcn_mfma_f32_32x32x16_bf16(w1, pf, pc1, 0, 0, 0);
    }
    const float* psc = p.pool_scale + layer * 256 + dg * 64;
#pragma unroll
    for (int r = 0; r < 16; ++r) { pc0[r] *= psc[crow(r, hi)]; pc1[r] *= psc[32 + crow(r, hi)]; }
    bf16_t* pd = MIX + (size_t)t * D + 512 + dg * 64;
#pragma unroll
    for (int g = 0; g < 4; ++g) { *(u32x2*)(pd + 8 * g + 4 * hi) = pack4(pc0, g); *(u32x2*)(pd + 32 + 8 * g + 4 * hi) = pack4(pc1, g); }
  }
  __syncthreads();
}

__device__ __forceinline__ void phase_b(const Params& p, int layer, LAS char* lds, int bid, int nblk) {
  const bool fast = ((const int*)(p.ws + OFF_CNT))[128] != 0;
  for (int u = bid; u < 780; u += nblk) {
    if (u < 512) { if (fast) attn_unit(p, lds, NCTX + (u >> 3) * 256, u & 7, TT); }
    else if (u < 520) { if (fast && layer == 0) attn_unit(p, lds, 0, u - 512, NCTX); }
    else { const int tile = u - 520; if (layer == 0 || tile >= 4) poolconv_unit(p, layer, lds, tile); }
  }
  if (!fast) attn_fallback(p, layer, bid, nblk);
}

__device__ __forceinline__ void phase_a0(const Params& p, int layer, int bid, int nblk) {
  const int wave = bid * 8 + (TIDX >> 6), lane = TIDX & 63, nw = nblk * 8;
  float* X = (float*)(p.ws + OFF_X);
  bf16_t* H = (bf16_t*)(p.ws + OFF_H);
  const bf16_t* OM = (const bf16_t*)(p.ws + OFF_OMOE);
  for (int r = wave; r < TT; r += nw) {
    const int s = r < NCTX ? 1 : 0;
    f32x4 v[4];
    if (layer == 0) {
      const float* src = r < NCTX ? p.ctx + (size_t)r * D : p.x + (size_t)(r - NCTX) * D;
#pragma unroll
      for (int i = 0; i < 4; ++i) v[i] = *(const f32x4*)(src + i * 256 + lane * 4);
    } else {
      const float* g2 = (const float*)(p.ws + OFF_MOD) + ((layer - 1) * 2 + s) * 6144 + 5 * D;
      float sum = 0.f;
#pragma unroll
      for (int i = 0; i < 4; ++i) {
        const int c = i * 256 + lane * 4;
        const u32x2 oa = *(const u32x2*)(OM + ((size_t)r * 2 + 0) * D + c), ob = *(const u32x2*)(OM + ((size_t)r * 2 + 1) * D + c);
        const f32x4 xv = *(const f32x4*)(X + (size_t)r * D + c), gv = *(const f32x4*)(g2 + c);
        f32x4 o;
        o[0] = __uint_as_float(oa[0] << 16) + __uint_as_float(ob[0] << 16); o[1] = __uint_as_float(oa[0] & 0xffff0000u) + __uint_as_float(ob[0] & 0xffff0000u);
        o[2] = __uint_as_float(oa[1] << 16) + __uint_as_float(ob[1] << 16); o[3] = __uint_as_float(oa[1] & 0xffff0000u) + __uint_as_float(ob[1] & 0xffff0000u);
        v[i] = xv * ALPHA + gv * o;
        sum += v[i][0] + v[i][1] + v[i][2] + v[i][3];
      }
      const float mu = wave_sum(sum) * (1.f / D);
      float q = 0.f;
#pragma unroll
      for (int i = 0; i < 4; ++i) { const f32x4 d = v[i] - mu; q += d[0] * d[0] + d[1] * d[1] + d[2] * d[2] + d[3] * d[3]; }
      const float rs = rsqrtf(wave_sum(q) * (1.f / D) + EPS);
      const float* g = p.ln2_g + (layer - 1) * D; const float* b = p.ln2_b + (layer - 1) * D;
#pragma unroll
      for (int i = 0; i < 4; ++i) { const int c = i * 256 + lane * 4; v[i] = (v[i] - mu) * rs * *(const f32x4*)(g + c) + *(const f32x4*)(b + c); *(f32x4*)(X + (size_t)r * D + c) = v[i]; }
    }
    const float* modp = (const float*)(p.ws + OFF_MOD) + (layer * 2 + s) * 6144;
    float sum = 0.f;
#pragma unroll
    for (int i = 0; i < 4; ++i) sum += v[i][0] + v[i][1] + v[i][2] + v[i][3];
    const float mu = wave_sum(sum) * (1.f / D);
    float q = 0.f;
#pragma unroll
    for (int i = 0; i < 4; ++i) { const f32x4 d = v[i] - mu; q += d[0] * d[0] + d[1] * d[1] + d[2] * d[2] + d[3] * d[3]; }
    const float rs = rsqrtf(wave_sum(q) * (1.f / D) + EPS);
#pragma unroll
    for (int i = 0; i < 4; ++i) {
      const int c = i * 256 + lane * 4;
      const f32x4 h = (v[i] - mu) * rs * (*(const f32x4*)(modp + D + c) + 1.f) + *(const f32x4*)(modp + c);
      *(u32x2*)(H + (size_t)r * D + c) = (u32x2){cvtpk(h[0], h[1]), cvtpk(h[2], h[3])};
    }
  }
}

__device__ __forceinline__ void phase_c2(const Params& p, int layer, int bid, int nblk) {
  const int wave = bid * 8 + (TIDX >> 6), lane = TIDX & 63, nw = nblk * 8;
  float* X = (float*)(p.ws + OFF_X);
  const bf16_t* Y = (const bf16_t*)(p.ws + OFF_Y);
  bf16_t* H2 = (bf16_t*)(p.ws + OFF_MIX);
  int* cnt = (int*)(p.ws + OFF_CNT) + layer * 64;
  float* GATE = (float*)(p.ws + OFF_GATE); int* LIST = (int*)(p.ws + OFF_LIST);
  const int r0 = layer == 0 ? 0 : NCTX;
  for (int r = r0 + wave; r < TT; r += nw) {
    const int s = r < NCTX ? 1 : 0;
    const float* modp = (const float*)(p.ws + OFF_MOD) + (layer * 2 + s) * 6144;
    const float* xin = layer == 0 ? (r < NCTX ? p.ctx + (size_t)r * D : p.x + (size_t)(r - NCTX) * D) : X + (size_t)r * D;
    f32x4 v[4]; float sum = 0.f;
#pragma unroll
    for (int i = 0; i < 4; ++i) {
      const int c = i * 256 + lane * 4;
      const u32x2 yv = *(const u32x2*)(Y + (size_t)r * D + c);
      const f32x4 yf = {__uint_as_float(yv[0] << 16), __uint_as_float(yv[0] & 0xffff0000u), __uint_as_float(yv[1] << 16), __uint_as_float(yv[1] & 0xffff0000u)};
      v[i] = *(const f32x4*)(xin + c) * ALPHA + *(const f32x4*)(modp + 2 * D + c) * yf;
      sum += v[i][0] + v[i][1] + v[i][2] + v[i][3];
    }
    float mu = wave_sum(sum) * (1.f / D); float q = 0.f;
#pragma unroll
    for (int i = 0; i < 4; ++i) { const f32x4 d = v[i] - mu; q += d[0] * d[0] + d[1] * d[1] + d[2] * d[2] + d[3] * d[3]; }
    float rs = rsqrtf(wave_sum(q) * (1.f / D) + EPS);
    sum = 0.f;
#pragma unroll
    for (int i = 0; i < 4; ++i) {
      const int c = i * 256 + lane * 4;
      v[i] = (v[i] - mu) * rs * *(const f32x4*)(p.ln1_g + layer * D + c) + *(const f32x4*)(p.ln1_b + layer * D + c);
      *(f32x4*)(X + (size_t)r * D + c) = v[i];
      sum += v[i][0] + v[i][1] + v[i][2] + v[i][3];
    }
    mu = wave_sum(sum) * (1.f / D); q = 0.f;
#pragma unroll
    for (int i = 0; i < 4; ++i) { const f32x4 d = v[i] - mu; q += d[0] * d[0] + d[1] * d[1] + d[2] * d[2] + d[3] * d[3]; }
    rs = rsqrtf(wave_sum(q) * (1.f / D) + EPS);
#pragma unroll
    for (int i = 0; i < 4; ++i) {
      const int c = i * 256 + lane * 4;
      v[i] = (v[i] - mu) * rs * (*(const f32x4*)(modp + 4 * D + c) + 1.f) + *(const f32x4*)(modp + 3 * D + c);
      *(u32x2*)(H2 + (size_t)r * D + c) = (u32x2){cvtpk(v[i][0], v[i][1]), cvtpk(v[i][2], v[i][3])};
    }
    f32x4 lg = {0.f, 0.f, 0.f, 0.f};
#pragma unroll
    for (int i = 0; i < 4; ++i)
#pragma unroll
      for (int j = 0; j < 4; ++j) lg += *(const f32x4*)(p.w_rg + ((size_t)layer * D + i * 256 + lane * 4 + j) * 4) * v[i][j];
    lg[0] = wave_sum(lg[0]) + p.b_rg[layer * 4 + 0]; lg[1] = wave_sum(lg[1]) + p.b_rg[layer * 4 + 1];
    lg[2] = wave_sum(lg[2]) + p.b_rg[layer * 4 + 2]; lg[3] = wave_sum(lg[3]) + p.b_rg[layer * 4 + 3];
    int gsel = 0; float gm = lg[0];
    if (lg[1] > gm) { gm = lg[1]; gsel = 1; }
    if (lg[2] > gm) { gm = lg[2]; gsel = 2; }
    if (lg[3] > gm) { gm = lg[3]; gsel = 3; }
    const float pgrp = 1.f / (__expf(lg[0] - gm) + __expf(lg[1] - gm) + __expf(lg[2] - gm) + __expf(lg[3] - gm));
    f32x4 ea = {0.f, 0.f, 0.f, 0.f}, eb = {0.f, 0.f, 0.f, 0.f};
#pragma unroll
    for (int i = 0; i < 4; ++i)
#pragma unroll
      for (int j = 0; j < 4; ++j) {
        const float* wr = p.w_re + ((size_t)layer * D + i * 256 + lane * 4 + j) * 32 + gsel * 8;
        ea += *(const f32x4*)wr * v[i][j]; eb += *(const f32x4*)(wr + 4) * v[i][j];
      }
    float le[8];
#pragma unroll
    for (int e = 0; e < 4; ++e) { le[e] = wave_sum(ea[e]) + p.b_re[layer * 32 + gsel * 8 + e]; le[4 + e] = wave_sum(eb[e]) + p.b_re[layer * 32 + gsel * 8 + 4 + e]; }
    int i0 = 0; float v0 = le[0];
#pragma unroll
    for (int e = 1; e < 8; ++e) if (le[e] > v0) { v0 = le[e]; i0 = e; }
    int i1 = -1; float v1 = -3.0e38f;
#pragma unroll
    for (int e = 0; e < 8; ++e) if (e != i0 && le[e] > v1) { v1 = le[e]; i1 = e; }
    if (i1 < 0) { i1 = (i0 + 1) & 7; v1 = v0; }
    const float e1 = __expf(v1 - v0);
    if (lane == 0) {
      const int xa = gsel * 8 + i0, xb = gsel * 8 + i1;
      const int pa = atomicAdd(&cnt[xa], 1), pb = atomicAdd(&cnt[xb], 1);
      LIST[(size_t)xa * CAPL + pa] = r * 2 + 0;
      LIST[(size_t)xb * CAPL + pb] = r * 2 + 1;
      GATE[r * 2] = pgrp / (1.f + e1); GATE[r * 2 + 1] = pgrp * e1 / (1.f + e1);
    }
  }
}

__device__ __forceinline__ void phase_final(const Params& p, int bid, int nblk) {
  const int wave = bid * 8 + (TIDX >> 6), lane = TIDX & 63, nw = nblk * 8;
  const float* X = (const float*)(p.ws + OFF_X);
  const bf16_t* OM = (const bf16_t*)(p.ws + OFF_OMOE);
  const float* g2 = (const float*)(p.ws + OFF_MOD) + (1 * 2 + 0) * 6144 + 5 * D;
  for (int r = NCTX + wave; r < TT; r += nw) {
    f32x4 v[4]; float sum = 0.f;
#pragma unroll
    for (int i = 0; i < 4; ++i) {
      const int c = i * 256 + lane * 4;
      const u32x2 oa = *(const u32x2*)(OM + ((size_t)r * 2 + 0) * D + c), ob = *(const u32x2*)(OM + ((size_t)r * 2 + 1) * D + c);
      f32x4 o;
      o[0] = __uint_as_float(oa[0] << 16) + __uint_as_float(ob[0] << 16); o[1] = __uint_as_float(oa[0] & 0xffff0000u) + __uint_as_float(ob[0] & 0xffff0000u);
      o[2] = __uint_as_float(oa[1] << 16) + __uint_as_float(ob[1] << 16); o[3] = __uint_as_float(oa[1] & 0xffff0000u) + __uint_as_float(ob[1] & 0xffff0000u);
      v[i] = *(const f32x4*)(X + (size_t)r * D + c) * ALPHA + *(const f32x4*)(g2 + c) * o;
      sum += v[i][0] + v[i][1] + v[i][2] + v[i][3];
    }
    const float mu = wave_sum(sum) * (1.f / D); float q = 0.f;
#pragma unroll
    for (int i = 0; i < 4; ++i) { const f32x4 d = v[i] - mu; q += d[0] * d[0] + d[1] * d[1] + d[2] * d[2] + d[3] * d[3]; }
    const float rs = rsqrtf(wave_sum(q) * (1.f / D) + EPS);
#pragma unroll
    for (int i = 0; i < 4; ++i) {
      const int c = i * 256 + lane * 4;
      *(f32x4*)(p.out + (size_t)(r - NCTX) * D + c) = (v[i] - mu) * rs * *(const f32x4*)(p.ln2_g + D + c) + *(const f32x4*)(p.ln2_b + D + c);
    }
  }
}

__device__ __forceinline__ void phase_p0(const Params& p, LAS char* lds, int bid, int nblk) {
  const int tid = TIDX;
  const long gtid = (long)bid * 512 + tid, gth = (long)nblk * 512;
  LAS float* sc = (LAS float*)lds;
  LAS float* red = (LAS float*)(lds + 8192);
  for (int i = tid; i < 2048; i += 512) { const float v = i < 1024 ? p.c[i] : p.c_ctx[i - 1024]; sc[i] = silu(v); }
  __syncthreads();
  float* mod = (float*)(p.ws + OFF_MOD);
  for (int u = bid; u < 384; u += nblk) {
    const int layer = u / 192, cg = u % 192, col = tid & 31, ksl = tid >> 5;
    const float* w = p.w_mod + ((size_t)layer * D + ksl * 64) * 6144 + cg * 32 + col;
    float a0 = 0.f, a1 = 0.f;
#pragma unroll 8
    for (int k = 0; k < 64; ++k) { const float wv = w[(size_t)k * 6144]; a0 += sc[ksl * 64 + k] * wv; a1 += sc[1024 + ksl * 64 + k] * wv; }
    red[(ksl * 32 + col) * 2] = a0; red[(ksl * 32 + col) * 2 + 1] = a1;
    __syncthreads();
    if (tid < 64) {
      const int c2 = tid & 31, s = tid >> 5; float a = 0.f;
#pragma unroll
      for (int k = 0; k < 16; ++k) a += red[(k * 32 + c2) * 2 + s];
      mod[(layer * 2 + s) * 6144 + cg * 32 + c2] = a + p.b_mod[layer * 6144 + cg * 32 + c2];
    }
    __syncthreads();
  }
  if (gtid < 256 * 16) {
    const int pos = (int)gtid / 16, f = (int)gtid % 16;
    const float ang = (float)pos * powf(10000.f, -(float)f / 16.f);
    float* rt = (float*)(p.ws + OFF_ROPE);
    rt[gtid * 2 + 0] = cosf(ang); rt[gtid * 2 + 1] = sinf(ang);
  }
  if (gtid < 128) ((int*)(p.ws + OFF_CNT))[gtid] = 0;
  if (gtid == 0) {
    float bmax = 0.f;
    for (int l = 0; l < 2; ++l) {
      float gq = 0.f, gk = 0.f;
      for (int i = 0; i < 64; ++i) { gq = fmaxf(gq, fabsf(p.q_gain[l * 64 + i])); gk = fmaxf(gk, fabsf(p.k_gain[l * 64 + i])); }
      bmax = fmaxf(bmax, 11.55f * gq * gk);
    }
    ((int*)(p.ws + OFF_CNT))[128] = (bmax <= 100.f) ? 1 : 0;
  }
  for (long i = gtid; i < 2 * 65536; i += gth) { const int l = (int)(i >> 16), d = (int)(i >> 8) & 255, c = (int)i & 255; ((bf16_t*)(p.ws + OFF_WPWT))[i] = f2bf(p.w_cv_pw[((size_t)l * 256 + c) * 256 + d]); }
  for (long i = gtid; i < 8 * 4096; i += gth) { const int lg = (int)(i >> 12), d = (int)(i >> 6) & 63, c = (int)i & 63; ((bf16_t*)(p.ws + OFF_WPOOLT))[i] = f2bf(p.w_pool[((size_t)lg * 64 + c) * 64 + d]); }
  cvt_range(p.w_in, (bf16_t*)(p.ws + OFF_WIN), 2L * D * INW / 8, gtid, gth);
  cvt_range(p.w_out, (bf16_t*)(p.ws + OFF_WOUT), 2L * D * D / 8, gtid, gth);
  cvt_range(p.w_e_gate, (bf16_t*)(p.ws + OFF_WG), 2L * NE * D * DE / 8, gtid, gth);
  cvt_range(p.w_e_up, (bf16_t*)(p.ws + OFF_WU), 2L * NE * D * DE / 8, gtid, gth);
  cvt_range(p.w_e_down, (bf16_t*)(p.ws + OFF_WD), 2L * NE * D * DE / 8, gtid, gth);
}
#define XB_TMO      128
#define XB_XCNT(j)  (256  + 64 * (j))
#define XB_XSUB(j)  (1280 + 64 * (j))
#define XB_XGEN(j)  (2304 + 64 * (j))
#define XB_TOP      3328
#define XB_TOPGEN   3392
#define XCD_BAR_WORDS 3456
#define XB_SPIN_CAP (1u << 22)
__device__ __forceinline__ unsigned xb_ld(unsigned* p)              { return __hip_atomic_load(p, __ATOMIC_RELAXED, __HIP_MEMORY_SCOPE_AGENT); }
__device__ __forceinline__ unsigned xb_add(unsigned* p, unsigned v) { return __hip_atomic_fetch_add(p, v, __ATOMIC_RELAXED, __HIP_MEMORY_SCOPE_AGENT); }
__device__ __forceinline__ unsigned xb_xcc_id() { return (unsigned)__builtin_amdgcn_s_getreg((3 << 11) | 20) & 0xFu; }
#define XB_SPIN(cond, bar) do { unsigned _sp = 0; while (cond) { __builtin_amdgcn_s_sleep(1); \
    if ((++_sp & 255u) == 0u) { if (xb_ld(&(bar)[XB_TMO])) break; if (_sp > XB_SPIN_CAP) { atomicAdd(&(bar)[XB_TMO], 1u); break; } } } } while (0)
struct XcdBarrier { unsigned* bar; unsigned x; volatile LAS unsigned* st; };
__device__ __forceinline__ XcdBarrier xcd_barrier_post(unsigned* bar, volatile LAS unsigned* st) {
  XcdBarrier b; b.bar = bar; b.x = xb_xcc_id(); b.st = st;
  if (threadIdx.x == 0) (void)xb_add(&bar[XB_XCNT(b.x)], 1u);
  return b;
}
__device__ __forceinline__ void xcd_barrier_complete(unsigned* bar, unsigned x, unsigned& nloc, unsigned& nx) {
  const unsigned G = gridDim.x * gridDim.y * gridDim.z;
  unsigned sum, cnt, mine, sp = 0u;
  for (;;) {
    sum = 0u; cnt = 0u; mine = 0u;
#pragma unroll
    for (unsigned j = 0; j < 16; ++j) { const unsigned c = xb_ld(&bar[XB_XCNT(j)]); sum += c; cnt += (c > 0u) ? 1u : 0u; mine = (j == x) ? c : mine; }
    if (sum == G) break;
    __builtin_amdgcn_s_sleep(1);
    if ((++sp & 255u) == 0u) { if (xb_ld(&bar[XB_TMO])) break; if (sp > XB_SPIN_CAP) { atomicAdd(&bar[XB_TMO], 1u); break; } }
  }
  nloc = mine > 0u ? mine : 1u; nx = cnt > 0u ? cnt : 1u;
}
__device__ __forceinline__ void xcd_barrier(const XcdBarrier& b) {
  asm volatile("s_waitcnt vmcnt(0)" ::: "memory");
  __syncthreads();
  if (threadIdx.x == 0) {
    unsigned* bar = b.bar;
    __builtin_amdgcn_s_waitcnt(0);
    unsigned nloc = b.st[0], nx = b.st[1];
    if (nloc == 0u) { xcd_barrier_complete(bar, b.x, nloc, nx); b.st[0] = nloc; b.st[1] = nx; }
    const unsigned old = xb_add(&bar[XB_XSUB(b.x)], 1u);
    const unsigned gen = old / nloc;
    if (old + 1u == (gen + 1u) * nloc) {
      __builtin_amdgcn_fence(__ATOMIC_RELEASE, "agent");
      asm volatile("s_waitcnt vmcnt(0)" ::: "memory");
      const unsigned og = xb_add(&bar[XB_TOP], 1u);
      const unsigned tg = og / nx;
      if (og + 1u == (tg + 1u) * nx) xb_add(&bar[XB_TOPGEN], 1u);
      else XB_SPIN(xb_ld(&bar[XB_TOPGEN]) == tg, bar);
      __builtin_amdgcn_fence(__ATOMIC_ACQUIRE, "agent");
      xb_add(&bar[XB_XGEN(b.x)], 1u);
      asm volatile("s_waitcnt vmcnt(0)" ::: "memory");
    } else {
      XB_SPIN(xb_ld(&bar[XB_XGEN(b.x)]) == gen, bar);
      __builtin_amdgcn_fence(__ATOMIC_ACQUIRE, "agent");
      asm volatile("s_waitcnt vmcnt(0)" ::: "memory");
    }
  }
  __syncthreads();
}

constexpr int LDS_MAIN = PC_LDS > GEMM_LDS + 256 ? PC_LDS : GEMM_LDS + 256;
constexpr int LDS_TOTAL = LDS_MAIN + 16;
static_assert(GEMM_LDS + 256 <= LDS_MAIN && ATT_LDS <= LDS_MAIN, "lds");
__global__ void __launch_bounds__(512) mega_fwd(Params p) {
  __shared__ __attribute__((aligned(16))) char slds[LDS_TOTAL];
  LAS char* lds = (LAS char*)slds;
  volatile LAS unsigned* st = (volatile LAS unsigned*)(lds + LDS_MAIN);
  if (threadIdx.x < 4) st[threadIdx.x] = 0u;
  __syncthreads();
  const XcdBarrier bar = xcd_barrier_post((unsigned*)(p.ws + OFF_BAR), st);
  const int bid = blockIdx.x, nblk = gridDim.x;
  phase_p0(p, lds, bid, nblk);
  xcd_barrier(bar);
#pragma unroll 1
  for (int layer = 0; layer < 2; ++layer) {
    phase_a0(p, layer, bid, nblk);
    xcd_barrier(bar);
    phase_a1(p, layer, lds, bid, nblk);
    xcd_barrier(bar);
    phase_b(p, layer, lds, bid, nblk);
    xcd_barrier(bar);
    phase_c1(p, layer, lds, bid, nblk);
    xcd_barrier(bar);
    phase_c2(p, layer, bid, nblk);
    xcd_barrier(bar);
    phase_d1(p, layer, lds, bid, nblk);
    xcd_barrier(bar);
    phase_d2(p, layer, lds, bid, nblk);
    xcd_barrier(bar);
  }
  phase_final(p, bid, nblk);
}

extern "C" void kernel_launch(void* const* d_in, const int* in_sizes, int n_in, void* d_out, int out_size, void* d_ws, size_t ws_size,
                              hipStream_t stream) {
  static int grid = 0;
  if (grid == 0) {
    if (ws_size < WS_END || n_in != 28) { fprintf(stderr, "kernel_launch: ws too small (%zu < %zu) or n_in %d != 28; nothing launched\n", ws_size, (size_t)WS_END, n_in); grid = -1; return; }
    int dev = 0, cus = 0, per_cu = 0;
    if (hipGetDevice(&dev) != hipSuccess || hipDeviceGetAttribute(&cus, hipDeviceAttributeMultiprocessorCount, dev) != hipSuccess) { grid = -1; return; }
    if (hipOccupancyMaxActiveBlocksPerMultiprocessor(&per_cu, (const void*)mega_fwd, 512, 0) != hipSuccess || per_cu < 1) {
      fprintf(stderr, "kernel_launch: occupancy query says %d blocks per CU; nothing launched\n", per_cu); grid = -1; return; }
    (void)hipGetLastError();
    grid = cus;
  }
  if (grid < 0) return;
  if (hipMemsetAsync((char*)d_ws + OFF_BAR, 0, BAR_BYTES, stream) != hipSuccess) { fprintf(stderr, "kernel_launch: memset failed\n"); return; }
  Params p{};
  const float** f = (const float**)&p;
  for (int i = 0; i < 28; ++i) f[i] = (const float*)d_in[i];
  p.out = (float*)d_out; p.ws = (char*)d_ws;
  hipLaunchKernelGGL(mega_fwd, dim3(grid), dim3(512), 0, stream, p);
}
```

```cpp
#include <hip/hip_runtime.h>
#include <cstdio>
#include <cstdint>

typedef unsigned short bf16_t;
#define LAS __attribute__((address_space(3)))

constexpr int D = 1024, SEQ = 16384, NCTX = 256, TT = SEQ + NCTX;
constexpr int INW = 1536;
constexpr int NE = 32, DE = 512;
constexpr int CAPL = 2 * TT;
constexpr int HMID_ROWS = 2 * TT + NE * 128;
constexpr float ALPHA = 1.41421356237309515f;
constexpr float EPS = 1e-6f;

constexpr size_t al(size_t x) { return (x + 255) / 256 * 256; }
constexpr size_t OFF_BAR = 0;
constexpr size_t BAR_BYTES = 3456 * 4;
constexpr size_t OFF_MOD = OFF_BAR + al(BAR_BYTES);
constexpr size_t OFF_ROPE = OFF_MOD + al(2 * 2 * 6144 * 4);
constexpr size_t OFF_CNT = OFF_ROPE + al(256 * 16 * 2 * 4);
constexpr size_t OFF_X = OFF_CNT + al(2 * 64 * 4 + 64);
constexpr size_t OFF_H = OFF_X + al((size_t)TT * D * 4);
constexpr size_t OFF_MIX = OFF_H + al((size_t)TT * D * 2);
constexpr size_t OFF_Y = OFF_MIX + al((size_t)TT * D * 2);
constexpr size_t OFF_Q = OFF_Y + al((size_t)TT * D * 2);
constexpr size_t OFF_K = OFF_Q + al((size_t)TT * 512 * 2);
constexpr size_t OFF_V = OFF_K + al((size_t)TT * 128 * 2);
constexpr size_t OFF_U = OFF_V + al((size_t)TT * 128 * 2);
constexpr size_t OFF_AG = OFF_U + al((size_t)TT * 256 * 4);
constexpr size_t OFF_HMID = OFF_Q;
constexpr size_t OFF_OMOE = OFF_AG + al((size_t)TT * 512 * 2);
constexpr size_t OFF_GATE = OFF_OMOE + al((size_t)TT * 2 * D * 2);
constexpr size_t OFF_LIST = OFF_GATE + al((size_t)TT * 2 * 4);
constexpr size_t OFF_WIN = OFF_LIST + al((size_t)NE * CAPL * 4);
constexpr size_t OFF_WOUT = OFF_WIN + al((size_t)2 * D * INW * 2);
constexpr size_t OFF_WPWT = OFF_WOUT + al((size_t)2 * D * D * 2);
constexpr size_t OFF_WPOOLT = OFF_WPWT + al((size_t)2 * 256 * 256 * 2);
constexpr size_t OFF_WG = OFF_WPOOLT + al((size_t)2 * 4 * 64 * 64 * 2);
constexpr size_t OFF_WU = OFF_WG + al((size_t)2 * NE * D * DE * 2);
constexpr size_t OFF_WD = OFF_WU + al((size_t)2 * NE * D * DE * 2);
constexpr size_t WS_END = OFF_WD + al((size_t)2 * NE * D * DE * 2);
static_assert(OFF_AG - OFF_HMID >= (size_t)HMID_ROWS * DE * 2, "HMID alias too small");
static_assert(WS_END < 530000000, "ws budget");

struct Params {
  const float *x, *c, *ctx, *c_ctx, *w_mod, *b_mod, *w_in, *q_gain, *k_gain, *w_pool, *pool_scale, *w_dw, *b_dw,
      *cv_ln_g, *cv_ln_b, *w_cv_pw, *w_out, *ln1_g, *ln1_b, *ln2_g, *ln2_b, *w_rg, *b_rg, *w_re, *b_re, *w_e_gate, *w_e_up, *w_e_down;
  float* out;
  char* ws;
};

__device__ __forceinline__ float bf2f(bf16_t v) { return __uint_as_float(((unsigned)v) << 16); }
__device__ __forceinline__ bf16_t f2bf(float f) {
  unsigned u = __float_as_uint(f);
  u += 0x7fffu + ((u >> 16) & 1u);
  return (bf16_t)(u >> 16);
}
__device__ __forceinline__ float wave_sum(float v) {
#pragma unroll
  for (int o = 32; o > 0; o >>= 1) v += __shfl_xor(v, o);
  return v;
}
__device__ __forceinline__ float silu(float v) { return v / (1.f + __expf(-v)); }
__device__ __forceinline__ int opaque0() { int z; asm volatile("s_mov_b32 %0, 0" : "=s"(z)); return z; }
#define TIDX ((int)threadIdx.x + opaque0())
using bf16x8 = __attribute__((ext_vector_type(8))) short;
using s16x4 = __attribute__((ext_vector_type(4))) short;
using f32x16 = __attribute__((ext_vector_type(16))) float;
using f32x4 = __attribute__((ext_vector_type(4))) float;
using u32x4 = __attribute__((ext_vector_type(4))) unsigned;
using u32x2 = __attribute__((ext_vector_type(2))) unsigned;

__device__ __forceinline__ int crow(int r, int hi) { return (r & 3) + 8 * (r >> 2) + 4 * hi; }
typedef float f32x2 __attribute__((ext_vector_type(2)));
typedef __bf16 bf16x2v __attribute__((ext_vector_type(2)));
__device__ __forceinline__ unsigned cvtpk(float lo, float hi) {
  bf16x2v b = __builtin_convertvector((f32x2){lo, hi}, bf16x2v);
  return __builtin_bit_cast(unsigned, b);
}
__device__ __forceinline__ float sum32(float v) {
  auto rr = __builtin_amdgcn_permlane32_swap(__float_as_uint(v), __float_as_uint(v), false, false);
  return __uint_as_float(rr[0]) + __uint_as_float(rr[1]);
}

__device__ __forceinline__ void cvt_range(const float* __restrict__ src, bf16_t* __restrict__ dst, long n8, long gtid, long gthreads) {
  for (long i = gtid; i < n8; i += gthreads) {
    const f32x4 a = *(const f32x4*)(src + i * 8), b = *(const f32x4*)(src + i * 8 + 4);
    u32x4 w = {cvtpk(a[0], a[1]), cvtpk(a[2], a[3]), cvtpk(b[0], b[1]), cvtpk(b[2], b[3])};
    *(u32x4*)(dst + i * 8) = w;
  }
}

__device__ __forceinline__ int xoff(int row, int chunk) { return row * 128 + ((chunk ^ ((row >> 1) & 7)) << 4); }
__device__ __forceinline__ int wst(int k, int c) { const int kk = (k & ~0xC) | ((k & 4) << 1) | ((k & 8) >> 1); return ((kk >> 3) * 4 + (c >> 5)) * 512 + ((kk & 7) * 32 + (c & 31)) * 2; }
__device__ __forceinline__ int v_rd_base(int lane) { return ((lane & 3) << 3) | (((lane >> 2) & 3) << 6) | (((lane >> 4) & 1) << 5) | (((lane >> 5) & 1) << 8); }

__device__ __forceinline__ bf16x8 tr_frag(const LAS char* p) {
  s16x4 a = __builtin_amdgcn_ds_read_tr16_b64_v4i16((LAS s16x4*)p);
  s16x4 b = __builtin_amdgcn_ds_read_tr16_b64_v4i16((LAS s16x4*)(p + 2048));
  return (bf16x8){a[0], a[1], a[2], a[3], b[0], b[1], b[2], b[3]};
}

template <int BM, int BN> struct GemmCfg {
  static constexpr int WM = BM / 64, WN = 8 / WM, NSLAB = BN / 128, XB = BM * 128, WB = NSLAB * 16384, STAGE = XB + WB, NXP = BM / 64, NWP = NSLAB * 2;
  static_assert(WM * WN == 8 && WN * 64 == BN, "tile");
};
constexpr int GEMM_LDS = 2 * (256 * 128 + 16384);

template <int BM, int BN, int NMAP, class XRow, class WPtr>
__device__ __forceinline__ void gemm_mainloop(LAS char* lds, f32x16 (&acc)[2][2], const XRow& xrow, const WPtr& wptr, int ldw, int K) {
  using C = GemmCfg<BM, BN>;
  const int tid = TIDX, wid = tid >> 6, lane = tid & 63, r32 = lane & 31, hi = lane >> 5;
  const int wm = wid / C::WN, wn = wid % C::WN;
  const bf16_t* xg[C::NXP]; int xl[C::NXP];
#pragma unroll
  for (int i = 0; i < C::NXP; ++i) { const int row = (tid >> 3) + 64 * i; xg[i] = xrow(row) + (tid & 7) * 8; xl[i] = xoff(row, tid & 7); }
  const bf16_t* wg[C::NWP]; int wl[C::NWP];
#pragma unroll
  for (int i = 0; i < C::NWP; ++i) { const int s = i >> 1, k = (tid >> 4) + 32 * (i & 1), c = (tid & 15) * 8; wg[i] = wptr(s) + (size_t)k * ldw + c; wl[i] = C::XB + s * 16384 + wst(k, c); }
  int xr[2];
#pragma unroll
  for (int ti = 0; ti < 2; ++ti) xr[ti] = (wm * 64 + ti * 32 + r32) * 128;
  const int xsw = (r32 >> 1) & 7;
  int wr[2];
#pragma unroll
  for (int ni = 0; ni < 2; ++ni) {
    const int slab = NMAP == 0 ? 0 : (NMAP == 1 ? (wn >> 1) : ni);
    const int nb = NMAP == 0 ? (2 * wn + ni) : (NMAP == 1 ? ((wn & 1) * 2 + ni) : wn);
    wr[ni] = C::XB + slab * 16384 + nb * 512 + v_rd_base(lane);
  }
  u32x4 xs[C::NXP], wsr[C::NWP];
  const int nk = K / 64;
#pragma unroll
  for (int i = 0; i < C::NXP; ++i) xs[i] = *(const u32x4*)(xg[i]);
#pragma unroll
  for (int i = 0; i < C::NWP; ++i) wsr[i] = *(const u32x4*)(wg[i]);
#pragma unroll
  for (int i = 0; i < C::NXP; ++i) *(LAS u32x4*)(lds + xl[i]) = xs[i];
#pragma unroll
  for (int i = 0; i < C::NWP; ++i) *(LAS u32x4*)(lds + wl[i]) = wsr[i];
  __syncthreads();
  for (int kt = 0; kt < nk; ++kt) {
    const LAS char* cur = lds + (kt & 1) * C::STAGE;
    LAS char* nxt = lds + ((kt + 1) & 1) * C::STAGE;
    const bool more = kt + 1 < nk;
    if (more) {
#pragma unroll
      for (int i = 0; i < C::NXP; ++i) xs[i] = *(const u32x4*)(xg[i] + (kt + 1) * 64);
#pragma unroll
      for (int i = 0; i < C::NWP; ++i) wsr[i] = *(const u32x4*)(wg[i] + (size_t)(kt + 1) * 64 * ldw);
    }
#pragma unroll
    for (int ks = 0; ks < 4; ++ks) {
      bf16x8 xf[2], wf[2];
#pragma unroll
      for (int ti = 0; ti < 2; ++ti) xf[ti] = *(const LAS bf16x8*)(cur + xr[ti] + (((ks * 2 + hi) ^ xsw) << 4));
#pragma unroll
      for (int ni = 0; ni < 2; ++ni) wf[ni] = tr_frag(cur + wr[ni] + ks * 4096);
#pragma unroll
      for (int ti = 0; ti < 2; ++ti)
#pragma unroll
        for (int ni = 0; ni < 2; ++ni) acc[ti][ni] = __builtin_amdgcn_mfma_f32_32x32x16_bf16(wf[ni], xf[ti], acc[ti][ni], 0, 0, 0);
    }
    if (more) {
#pragma unroll
      for (int i = 0; i < C::NXP; ++i) *(LAS u32x4*)(nxt + xl[i]) = xs[i];
#pragma unroll
      for (int i = 0; i < C::NWP; ++i) *(LAS u32x4*)(nxt + wl[i]) = wsr[i];
    }
    __syncthreads();
  }
}

__device__ __forceinline__ u32x2 pack4(const f32x16& a, int g) { return (u32x2){cvtpk(a[4 * g], a[4 * g + 1]), cvtpk(a[4 * g + 2], a[4 * g + 3])}; }

__device__ __forceinline__ void phase_a1(const Params& p, int layer, LAS char* lds, int bid, int nblk) {
  const bf16_t* H = (const bf16_t*)(p.ws + OFF_H);
  const bf16_t* W = (const bf16_t*)(p.ws + OFF_WIN) + (size_t)layer * D * INW;
  bf16_t* Q = (bf16_t*)(p.ws + OFF_Q); bf16_t* Kb = (bf16_t*)(p.ws + OFF_K); bf16_t* Vb = (bf16_t*)(p.ws + OFF_V);
  float* U = (float*)(p.ws + OFF_U); bf16_t* AG = (bf16_t*)(p.ws + OFF_AG);
  const float* rt = (const float*)(p.ws + OFF_ROPE);
  const int lane = TIDX & 63, wid = TIDX >> 6, r32 = lane & 31, hi = lane >> 5, wm = wid >> 1, wn = wid & 1;
  const int nlat = 64 * 12, nunits = nlat + (layer == 0 ? 12 : 2);
  for (int u = bid; u < nunits; u += nblk) {
    int rtile, ct;
    if (u < nlat) { rtile = 1 + u / 12; ct = u % 12; } else { rtile = 0; ct = layer == 0 ? (u - nlat) : (4 + u - nlat); }
    const int m0 = rtile * 256, n0 = ct * 128;
    f32x16 acc[2][2];
#pragma unroll
    for (int a = 0; a < 2; ++a)
#pragma unroll
      for (int b = 0; b < 2; ++b) acc[a][b] = (f32x16){};
    gemm_mainloop<256, 128, 0>(lds, acc, [&](int row) { return H + (size_t)(m0 + row) * D; }, [&](int) { return W + n0; }, INW, D);
#pragma unroll
    for (int ti = 0; ti < 2; ++ti) {
      const int tok = m0 + wm * 64 + ti * 32 + r32;
      if (ct < 5) {
        float ss = 0.f;
#pragma unroll
        for (int ni = 0; ni < 2; ++ni)
#pragma unroll
          for (int r = 0; r < 16; ++r) ss += acc[ti][ni][r] * acc[ti][ni][r];
        ss = sum32(ss);
        const float rs = rsqrtf(ss * (1.f / 64.f) + EPS);
        const float* gain = (ct < 4 ? p.q_gain : p.k_gain) + layer * 64;
        const float osc = ct < 4 ? 0.125f * 1.4426950408889634f : 1.f;
        const bool lat = rtile > 0;
        const int t = tok - NCTX;
#pragma unroll
        for (int ni = 0; ni < 2; ++ni) {
          f32x16 v;
#pragma unroll
          for (int r = 0; r < 16; ++r) v[r] = acc[ti][ni][r] * rs * gain[ni * 32 + crow(r, hi)];
          if (lat) {
            const int pos = ni == 0 ? (t >> 6) : (t & 63);
#pragma unroll
            for (int r = 0; r < 8; ++r) {
              const int f = crow(r, hi);
              const float cs = rt[(pos * 16 + f) * 2], sn = rt[(pos * 16 + f) * 2 + 1];
              const float t1 = v[r], t2 = v[r + 8];
              v[r] = t1 * cs - t2 * sn; v[r + 8] = t2 * cs + t1 * sn;
            }
          }
#pragma unroll
          for (int r = 0; r < 16; ++r) v[r] *= osc;
          bf16_t* dst = ct < 4 ? Q + (size_t)tok * 512 + (ct * 2 + wn) * 64 + ni * 32 : Kb + (size_t)tok * 128 + wn * 64 + ni * 32;
#pragma unroll
          for (int g = 0; g < 4; ++g) *(u32x2*)(dst + 8 * g + 4 * hi) = pack4(v, g);
        }
      } else if (ct == 5) {
#pragma unroll
        for (int ni = 0; ni < 2; ++ni)
#pragma unroll
          for (int g = 0; g < 4; ++g) *(u32x2*)(Vb + (size_t)tok * 128 + wn * 64 + ni * 32 + 8 * g + 4 * hi) = pack4(acc[ti][ni], g);
      } else if (ct < 8) {
#pragma unroll
        for (int ni = 0; ni < 2; ++ni)
#pragma unroll
          for (int g = 0; g < 4; ++g)
            *(f32x4*)(U + (size_t)tok * 256 + (ct - 6) * 128 + wn * 64 + ni * 32 + 8 * g + 4 * hi) =
                (f32x4){acc[ti][ni][4 * g], acc[ti][ni][4 * g + 1], acc[ti][ni][4 * g + 2], acc[ti][ni][4 * g + 3]};
      } else {
#pragma unroll
        for (int ni = 0; ni < 2; ++ni)
#pragma unroll
          for (int g = 0; g < 4; ++g) *(u32x2*)(AG + (size_t)tok * 512 + (ct - 8) * 128 + wn * 64 + ni * 32 + 8 * g + 4 * hi) = pack4(acc[ti][ni], g);
      }
    }
  }
}

__device__ __forceinline__ void phase_c1(const Params& p, int layer, LAS char* lds, int bid, int nblk) {
  const bf16_t* A = (const bf16_t*)(p.ws + OFF_MIX);
  const bf16_t* W = (const bf16_t*)(p.ws + OFF_WOUT) + (size_t)layer * D * D;
  bf16_t* Y = (bf16_t*)(p.ws + OFF_Y);
  const int lane = TIDX & 63, wid = TIDX >> 6, r32 = lane & 31, hi = lane >> 5, wm = wid >> 1, wn = wid & 1;
  const int rt0 = layer == 0 ? 0 : 1, nunits = (65 - rt0) * 8;
  for (int u = bid; u < nunits; u += nblk) {
    const int m0 = (rt0 + u / 8) * 256, n0 = (u % 8) * 128;
    f32x16 acc[2][2];
#pragma unroll
    for (int a = 0; a < 2; ++a)
#pragma unroll
      for (int b = 0; b < 2; ++b) acc[a][b] = (f32x16){};
    gemm_mainloop<256, 128, 0>(lds, acc, [&](int row) { return A + (size_t)(m0 + row) * D; }, [&](int) { return W + n0; }, D, D);
#pragma unroll
    for (int ti = 0; ti < 2; ++ti) {
      const int tok = m0 + wm * 64 + ti * 32 + r32;
#pragma unroll
      for (int ni = 0; ni < 2; ++ni)
#pragma unroll
        for (int g = 0; g < 4; ++g) *(u32x2*)(Y + (size_t)tok * D + n0 + wn * 64 + ni * 32 + 8 * g + 4 * hi) = pack4(acc[ti][ni], g);
    }
  }
}

__device__ __forceinline__ int moe_prefix(const int* cnt, LAS int* pre) {
  if (TIDX == 0) { int o = 0; for (int e = 0; e < NE; ++e) { pre[e] = o; o += (cnt[e] + 127) >> 7; } pre[NE] = o; }
  __syncthreads();
  return pre[NE];
}
__device__ __forceinline__ int moe_find(const LAS int* pre, int g) { int e = 0; for (int i = 1; i < NE; ++i) e += (pre[i] <= g) ? 1 : 0; return e; }

__device__ __forceinline__ void phase_d1(const Params& p, int layer, LAS char* lds, int bid, int nblk) {
  const int* cnt = (const int*)(p.ws + OFF_CNT) + layer * 64;
  const bf16_t* H2 = (const bf16_t*)(p.ws + OFF_MIX);
  bf16_t* HM = (bf16_t*)(p.ws + OFF_HMID);
  LAS int* pre = (LAS int*)(lds + GEMM_LDS);
  const int ntiles = moe_prefix(cnt, pre);
  const int lane = TIDX & 63, wid = TIDX >> 6, r32 = lane & 31, hi = lane >> 5, wm = wid >> 2, wn = wid & 3;
  for (int u = bid; u < ntiles * 4; u += nblk) {
    const int g = u >> 2, ct = u & 3, e = moe_find(pre, g), rt = g - pre[e], n = cnt[e];
    const int* list = (const int*)(p.ws + OFF_LIST) + (size_t)e * CAPL + rt * 128;
    const bf16_t* Wg = (const bf16_t*)(p.ws + OFF_WG) + ((size_t)layer * NE + e) * D * DE + ct * 128;
    const bf16_t* Wu = (const bf16_t*)(p.ws + OFF_WU) + ((size_t)layer * NE + e) * D * DE + ct * 128;
    const int nvalid = n - rt * 128;
    f32x16 acc[2][2];
#pragma unroll
    for (int a = 0; a < 2; ++a)
#pragma unroll
      for (int b = 0; b < 2; ++b) acc[a][b] = (f32x16){};
    gemm_mainloop<128, 256, 2>(lds, acc, [&](int row) { const int tok = row < nvalid ? (list[row] >> 1) : 0; return H2 + (size_t)tok * D; },
                               [&](int s) { return s == 0 ? Wg : Wu; }, DE, D);
    const size_t hrow0 = (size_t)(pre[e] + rt) * 128;
#pragma unroll
    for (int ti = 0; ti < 2; ++ti) {
      const size_t row = hrow0 + wm * 64 + ti * 32 + r32;
      f32x16 a;
#pragma unroll
      for (int r = 0; r < 16; ++r) { const float gv = acc[ti][0][r]; a[r] = gv / (1.f + __expf(-gv)) * acc[ti][1][r]; }
#pragma unroll
      for (int gq = 0; gq < 4; ++gq) *(u32x2*)(HM + row * DE + ct * 128 + wn * 32 + 8 * gq + 4 * hi) = pack4(a, gq);
    }
  }
}

__device__ __forceinline__ void phase_d2(const Params& p, int layer, LAS char* lds, int bid, int nblk) {
  const int* cnt = (const int*)(p.ws + OFF_CNT) + layer * 64;
  const bf16_t* HM = (const bf16_t*)(p.ws + OFF_HMID);
  const float* GATE = (const float*)(p.ws + OFF_GATE);
  bf16_t* OM = (bf16_t*)(p.ws + OFF_OMOE);
  LAS int* pre = (LAS int*)(lds + GEMM_LDS);
  const int ntiles = moe_prefix(cnt, pre);
  const int lane = TIDX & 63, wid = TIDX >> 6, r32 = lane & 31, hi = lane >> 5, wm = wid >> 2, wn = wid & 3;
  for (int u = bid; u < ntiles * 4; u += nblk) {
    const int g = u >> 2, ct = u & 3, e = moe_find(pre, g), rt = g - pre[e], n = cnt[e];
    const int* list = (const int*)(p.ws + OFF_LIST) + (size_t)e * CAPL + rt * 128;
    const bf16_t* Wd = (const bf16_t*)(p.ws + OFF_WD) + ((size_t)layer * NE + e) * DE * D + ct * 256;
    const int nvalid = n - rt * 128;
    const bf16_t* A = HM + (size_t)g * 128 * DE;
    f32x16 acc[2][2];
#pragma unroll
    for (int a = 0; a < 2; ++a)
#pragma unroll
      for (int b = 0; b < 2; ++b) acc[a][b] = (f32x16){};
    gemm_mainloop<128, 256, 1>(lds, acc, [&](int row) { return A + (size_t)row * DE; }, [&](int s) { return Wd + s * 128; }, D, DE);
#pragma unroll
    for (int ti = 0; ti < 2; ++ti) {
      const int row = wm * 64 + ti * 32 + r32;
      if (row < nvalid) {
        const int ts = list[row];
        const float gt = GATE[ts];
#pragma unroll
        for (int ni = 0; ni < 2; ++ni) {
          f32x16 a;
#pragma unroll
          for (int r = 0; r < 16; ++r) a[r] = acc[ti][ni][r] * gt;
#pragma unroll
          for (int gq = 0; gq < 4; ++gq) *(u32x2*)(OM + (size_t)ts * D + ct * 256 + wn * 64 + ni * 32 + 8 * gq + 4 * hi) = pack4(a, gq);
        }
      }
    }
  }
}

constexpr int ATT_SLOT = 16384, ATT_LDS = 4 * ATT_SLOT;
__device__ __forceinline__ int vst64(int k, int c) { const int kk = (k & ~0xC) | ((k & 4) << 1) | ((k & 8) >> 1); return ((kk >> 3) * 2 + (c >> 5)) * 512 + ((kk & 7) * 32 + (c & 31)) * 2; }
__device__ __forceinline__ bf16x8 tr_frag64(const LAS char* p) {
  s16x4 a = __builtin_amdgcn_ds_read_tr16_b64_v4i16((LAS s16x4*)p);
  s16x4 b = __builtin_amdgcn_ds_read_tr16_b64_v4i16((LAS s16x4*)(p + 1024));
  return (bf16x8){a[0], a[1], a[2], a[3], b[0], b[1], b[2], b[3]};
}
__device__ __forceinline__ bf16x8 pk4(const f32x16& P, int B) {
  unsigned a0 = cvtpk(P[B + 0], P[B + 1]), a1 = cvtpk(P[B + 2], P[B + 3]), b0 = cvtpk(P[B + 4], P[B + 5]), b1 = cvtpk(P[B + 6], P[B + 7]);
  auto r0 = __builtin_amdgcn_permlane32_swap(a0, b0, false, false); auto r1 = __builtin_amdgcn_permlane32_swap(a1, b1, false, false);
  u32x4 w = {r0[0], r1[0], r0[1], r1[1]};
  return __builtin_bit_cast(bf16x8, w);
}
struct AttnCtx { int krd0, krd1, ksw, hi, vrd; };
#define SBAR() __builtin_amdgcn_sched_barrier(0)
__device__ __forceinline__ void att_kload(const LAS char* slot, const AttnCtx& c, bf16x8 (&kf)[8]) {
#pragma unroll
  for (int d0 = 0; d0 < 4; ++d0) {
    kf[2 * d0] = *(const LAS bf16x8*)(slot + c.krd0 + (((2 * d0 + c.hi) ^ c.ksw) << 4));
    kf[2 * d0 + 1] = *(const LAS bf16x8*)(slot + c.krd1 + (((2 * d0 + c.hi) ^ c.ksw) << 4));
  }
}
__device__ __forceinline__ void att_qk(const bf16x8 (&kf)[8], const bf16x8 (&qr)[4], f32x16& s0, f32x16& s1) {
  s0 = (f32x16){}; s1 = (f32x16){};
#pragma unroll
  for (int d0 = 0; d0 < 4; ++d0) {
    s0 = __builtin_amdgcn_mfma_f32_32x32x16_bf16(kf[2 * d0], qr[d0], s0, 0, 0, 0);
    s1 = __builtin_amdgcn_mfma_f32_32x32x16_bf16(kf[2 * d0 + 1], qr[d0], s1, 0, 0, 0);
  }
}
template <int R0, int R1>
__device__ __forceinline__ void att_exp(f32x16& s, float& l) {
  float a = 0.f, b = 0.f;
#pragma unroll
  for (int r = R0; r < R1; r += 2) { s[r] = __builtin_amdgcn_exp2f(s[r]); s[r + 1] = __builtin_amdgcn_exp2f(s[r + 1]); a += s[r]; b += s[r + 1]; }
  l += a + b;
}
template <int KS0>
__device__ __forceinline__ void att_vload(const LAS char* slot, const AttnCtx& c, bf16x8 (&vf)[4]) {
#pragma unroll
  for (int i = 0; i < 2; ++i) { vf[2 * i] = tr_frag64(slot + c.vrd + (KS0 + i) * 2048); vf[2 * i + 1] = tr_frag64(slot + c.vrd + 512 + (KS0 + i) * 2048); }
}
__device__ __forceinline__ void att_pv2(const bf16x8& pa, const bf16x8& pb, const bf16x8 (&vf)[4], f32x16& o0, f32x16& o1) {
  o0 = __builtin_amdgcn_mfma_f32_32x32x16_bf16(pa, vf[0], o0, 0, 0, 0);
  o1 = __builtin_amdgcn_mfma_f32_32x32x16_bf16(pa, vf[1], o1, 0, 0, 0);
  o0 = __builtin_amdgcn_mfma_f32_32x32x16_bf16(pb, vf[2], o0, 0, 0, 0);
  o1 = __builtin_amdgcn_mfma_f32_32x32x16_bf16(pb, vf[3], o1, 0, 0, 0);
}
__device__ __forceinline__ void attn_unit(const Params& p, LAS char* lds, int row0, int head, int nkeys) {
  const bf16_t* Q = (const bf16_t*)(p.ws + OFF_Q); const bf16_t* Kb = (const bf16_t*)(p.ws + OFF_K); const bf16_t* Vb = (const bf16_t*)(p.ws + OFF_V);
  bf16_t* MIX = (bf16_t*)(p.ws + OFF_MIX);
  const int tid = TIDX, wid = tid >> 6, lane = tid & 63, r32 = lane & 31, hi = lane >> 5, kvh = head >> 2;
  bf16x8 qr[4];
  { const bf16_t* Qg = Q + (size_t)(row0 + wid * 32 + r32) * 512 + head * 64 + hi * 8;
#pragma unroll
    for (int d0 = 0; d0 < 4; ++d0) qr[d0] = *(const bf16x8*)(Qg + d0 * 16); }
  const bf16_t* Kg = Kb + (size_t)(tid >> 3) * 128 + kvh * 64 + (tid & 7) * 8;
  const bf16_t* Vg = Vb + (size_t)(tid >> 3) * 128 + kvh * 64 + (tid & 7) * 8;
  const int kst = xoff(tid >> 3, tid & 7), vstw = 8192 + vst64(tid >> 3, (tid & 7) * 8);
  AttnCtx c; c.krd0 = r32 * 128; c.krd1 = (32 + r32) * 128; c.ksw = (r32 >> 1) & 7; c.hi = hi; c.vrd = 8192 + v_rd_base(lane);
  const int NT = nkeys >> 6;
  f32x16 o0 = {}, o1 = {}; float l = 0.f;
  u32x4 ks, vs;
  {
    const u32x4 k0 = *(const u32x4*)Kg, k1 = *(const u32x4*)(Kg + 64 * 128), k2 = *(const u32x4*)(Kg + 2 * 64 * 128);
    const u32x4 v0 = *(const u32x4*)Vg, v1 = *(const u32x4*)(Vg + 64 * 128);
    *(LAS u32x4*)(lds + kst) = k0; *(LAS u32x4*)(lds + ATT_SLOT + kst) = k1; *(LAS u32x4*)(lds + 2 * ATT_SLOT + kst) = k2;
    *(LAS u32x4*)(lds + vstw) = v0; *(LAS u32x4*)(lds + ATT_SLOT + vstw) = v1;
    ks = *(const u32x4*)(Kg + 3 * 64 * 128); vs = *(const u32x4*)(Vg + 2 * 64 * 128);
  }
  __syncthreads();
  f32x16 sA0, sA1, sB0, sB1;
  { bf16x8 kf[8]; att_kload(lds, c, kf); att_qk(kf, qr, sA0, sA1); }
  att_exp<0, 16>(sA0, l);
#define ATT_ITER(j, sX0, sX1, sY0, sY1) do { \
    const LAS char* sk = lds + (((j) + 1) & 3) * ATT_SLOT; const LAS char* sv = lds + ((j) & 3) * ATT_SLOT; \
    bf16x8 kf[8], vfa[4], vfb[4]; \
    att_kload(sk, c, kf); \
    SBAR(); \
    att_exp<0, 16>(sX1, l); \
    SBAR(); \
    att_qk(kf, qr, sY0, sY1); \
    const bf16x8 pa0 = pk4(sX0, 0), pa1 = pk4(sX0, 8), pa2 = pk4(sX1, 0), pa3 = pk4(sX1, 8); \
    att_vload<0>(sv, c, vfa); \
    SBAR(); \
    att_pv2(pa0, pa1, vfa, o0, o1); \
    att_vload<2>(sv, c, vfb); \
    if ((j) + 1 < NT) att_exp<0, 8>(sY0, l); \
    SBAR(); \
    att_pv2(pa2, pa3, vfb, o0, o1); \
    if ((j) + 1 < NT) att_exp<8, 16>(sY0, l); \
    { LAS char* wk = lds + (((j) + 3) & 3) * ATT_SLOT; LAS char* wv = lds + (((j) + 2) & 3) * ATT_SLOT; \
      if ((j) + 3 < NT) *(LAS u32x4*)(wk + kst) = ks; if ((j) + 2 < NT) *(LAS u32x4*)(wv + vstw) = vs; \
      if ((j) + 4 < NT) ks = *(const u32x4*)(Kg + (size_t)((j) + 4) * 64 * 128); if ((j) + 3 < NT) vs = *(const u32x4*)(Vg + (size_t)((j) + 3) * 64 * 128); } \
    __syncthreads(); } while (0)
  for (int j = 0; j < NT; j += 2) {
    ATT_ITER(j, sA0, sA1, sB0, sB1);
    ATT_ITER(j + 1, sB0, sB1, sA0, sA1);
  }
#undef ATT_ITER
  l = sum32(l);
  LAS float* li = (LAS float*)(lds + wid * 128);
  if (hi == 0) li[r32] = l;
  __syncthreads();
  bf16_t* Og = MIX + (size_t)(row0 + wid * 32) * D + head * 64 + r32;
#pragma unroll
  for (int r = 0; r < 16; ++r) {
    const int orow = crow(r, hi);
    const float rl = __builtin_amdgcn_rcpf(li[orow]);
    Og[(size_t)orow * D] = f2bf(o0[r] * rl);
    Og[(size_t)orow * D + 32] = f2bf(o1[r] * rl);
  }
  __syncthreads();
}
__device__ __forceinline__ void attn_fallback(const Params& p, int layer, int bid, int nblk) {
  const bf16_t* Q = (const bf16_t*)(p.ws + OFF_Q); const bf16_t* Kb = (const bf16_t*)(p.ws + OFF_K); const bf16_t* Vb = (const bf16_t*)(p.ws + OFF_V);
  bf16_t* MIX = (bf16_t*)(p.ws + OFF_MIX);
  const int lane = TIDX & 63, nwv = nblk * 8;
  const int rg0 = layer == 0 ? 0 : NCTX / 64;
  for (int wv = bid * 8 + (TIDX >> 6) + rg0 * 8; wv < (TT / 64) * 8; wv += nwv) {
    const int head = wv & 7, r = (wv >> 3) * 64 + lane, kvh = head >> 2;
    float q[64], o[64];
#pragma unroll
    for (int d = 0; d < 64; ++d) { q[d] = bf2f(Q[(size_t)r * 512 + head * 64 + d]); o[d] = 0.f; }
    float m = -1e30f, l = 0.f;
    const int nk = r >= NCTX ? TT : NCTX;
    for (int j = 0; j < nk; ++j) {
      const bf16_t* kr = Kb + (size_t)j * 128 + kvh * 64;
      const bf16_t* vr = Vb + (size_t)j * 128 + kvh * 64;
      float s = 0.f;
#pragma unroll
      for (int d = 0; d < 64; ++d) s += q[d] * bf2f(kr[d]);
      if (s > m) {
        const float a = __builtin_amdgcn_exp2f(m - s);
        l *= a;
#pragma unroll
        for (int d = 0; d < 64; ++d) o[d] *= a;
        m = s;
      }
      const float pe = __builtin_amdgcn_exp2f(s - m);
      l += pe;
#pragma unroll
      for (int d = 0; d < 64; ++d) o[d] += pe * bf2f(vr[d]);
    }
    const float il = 1.f / l;
#pragma unroll
    for (int d = 0; d < 64; ++d) MIX[(size_t)r * D + head * 64 + d] = f2bf(o[d] * il);
  }
}

constexpr int PC_U = 0;
constexpr int PC_Y = 49152;
constexpr int PC_LDS = PC_Y + 65536;
__device__ __forceinline__ void poolconv_unit(const Params& p, int layer, LAS char* lds, int tile) {
  const int tid = TIDX, wid = tid >> 6, lane = tid & 63, r32 = lane & 31, hi = lane >> 5;
  const int t0 = tile * 64, base = tile < 4 ? 0 : NCTX, n = tile < 4 ? NCTX : SEQ;
  const bf16_t* AG = (const bf16_t*)(p.ws + OFF_AG);
  const float* U = (const float*)(p.ws + OFF_U);
  bf16_t* MIX = (bf16_t*)(p.ws + OFF_MIX);
  for (int idx = tid; idx < 94 * 32; idx += 512) {
    const int rr = idx >> 5, ch = (idx & 31) * 8, t = t0 - 15 + rr;
    u32x4 out = {0u, 0u, 0u, 0u};
    if (t >= base && t < base + n) {
      const u32x4 av = *(const u32x4*)(AG + (size_t)t * 512 + ch), gv = *(const u32x4*)(AG + (size_t)t * 512 + 256 + ch);
#pragma unroll
      for (int i = 0; i < 4; ++i) {
        const float a0 = __uint_as_float(av[i] << 16), a1 = __uint_as_float(av[i] & 0xffff0000u);
        const float g0 = __uint_as_float(gv[i] << 16), g1 = __uint_as_float(gv[i] & 0xffff0000u);
        out[i] = cvtpk(a0 / (1.f + __expf(-g0)), a1 / (1.f + __expf(-g1)));
      }
    }
    *(LAS u32x4*)(lds + PC_U + (rr * 256 + ch) * 2) = out;
  }
  __syncthreads();
  {
    const int c = tid & 255, th = tid >> 8;
    float w[31];
#pragma unroll
    for (int j = 0; j < 31; ++j) w[j] = p.w_dw[(size_t)layer * 31 * 256 + j * 256 + c];
    const float b = p.b_dw[layer * 256 + c];
    float acc[32];
#pragma unroll
    for (int i = 0; i < 32; ++i) acc[i] = b;
    const LAS bf16_t* up = (const LAS bf16_t*)(lds + PC_U) + (th * 32) * 256 + c;
#pragma unroll
    for (int rr = 0; rr < 62; ++rr) {
      const float uv = bf2f(up[rr * 256]);
#pragma unroll
      for (int i = 0; i < 32; ++i) if (rr - i >= 0 && rr - i < 31) acc[i] += uv * w[rr - i];
    }
    LAS float* yp = (LAS float*)(lds + PC_Y) + (th * 32) * 256 + c;
#pragma unroll
    for (int i = 0; i < 32; ++i) yp[i * 256] = acc[i];
  }
  __syncthreads();
  {
    const f32x4 g4 = *(const f32x4*)(p.cv_ln_g + layer * 256 + lane * 4), b4 = *(const f32x4*)(p.cv_ln_b + layer * 256 + lane * 4);
#pragma unroll
    for (int i = 0; i < 8; ++i) {
      const int tok = wid * 8 + i;
      const f32x4 y = *(const LAS f32x4*)(lds + PC_Y + (tok * 256 + lane * 4) * 4);
      const float mu = wave_sum(y[0] + y[1] + y[2] + y[3]) * (1.f / 256.f);
      const float d0 = y[0] - mu, d1 = y[1] - mu, d2 = y[2] - mu, d3 = y[3] - mu;
      const float rs = rsqrtf(wave_sum(d0 * d0 + d1 * d1 + d2 * d2 + d3 * d3) * (1.f / 256.f) + EPS);
      const float z0 = silu(d0 * rs * g4[0] + b4[0]), z1 = silu(d1 * rs * g4[1] + b4[1]), z2 = silu(d2 * rs * g4[2] + b4[2]), z3 = silu(d3 * rs * g4[3] + b4[3]);
      const int chunk = lane >> 1, sw = (chunk & 16) | ((chunk ^ tok) & 15);
      *(LAS u32x2*)(lds + PC_U + tok * 512 + sw * 16 + (lane & 1) * 8) = (u32x2){cvtpk(z0, z1), cvtpk(z2, z3)};
    }
  }
  __syncthreads();
  {
    const int tb = wid >> 2, dg = wid & 3, trow = tb * 32 + r32, t = t0 + trow;
    const bf16_t* Wt = (const bf16_t*)(p.ws + OFF_WPWT) + ((size_t)layer * 256 + dg * 64 + r32) * 256 + hi * 8;
    f32x16 acc0 = {}, acc1 = {};
#pragma unroll 4
    for (int ks = 0; ks < 16; ++ks) {
      const int chunk = 2 * ks + hi, sw = (chunk & 16) | ((chunk ^ trow) & 15);
      const bf16x8 zf = *(const LAS bf16x8*)(lds + PC_U + trow * 512 + sw * 16);
      const bf16x8 w0 = *(const bf16x8*)(Wt + ks * 16), w1 = *(const bf16x8*)(Wt + 32 * 256 + ks * 16);
      acc0 = __builtin_amdgcn_mfma_f32_32x32x16_bf16(w0, zf, acc0, 0, 0, 0);
      acc1 = __builtin_amdgcn_mfma_f32_32x32x16_bf16(w1, zf, acc1, 0, 0, 0);
    }
    bf16_t* dst = MIX + (size_t)t * D + 768 + dg * 64;
#pragma unroll
    for (int g = 0; g < 4; ++g) { *(u32x2*)(dst + 8 * g + 4 * hi) = pack4(acc0, g); *(u32x2*)(dst + 32 + 8 * g + 4 * hi) = pack4(acc1, g); }
    const int w = 2 << dg, tl = t - base, lo = max(tl - w / 2, 0), hh = min(tl + w / 2, n);
    const float inv = 1.f / (float)(hh - lo);
    const bf16_t* Pt = (const bf16_t*)(p.ws + OFF_WPOOLT) + ((size_t)(layer * 4 + dg) * 64 + r32) * 64 + hi * 8;
    f32x16 pc0 = {}, pc1 = {};
#pragma unroll
    for (int ks = 0; ks < 4; ++ks) {
      const int c0 = dg * 64 + ks * 16 + hi * 8;
      f32x4 s0 = {0.f, 0.f, 0.f, 0.f}, s1 = {0.f, 0.f, 0.f, 0.f};
      for (int rr = lo; rr < hh; ++rr) { const float* ur = U + (size_t)(base + rr) * 256 + c0; s0 += *(const f32x4*)ur; s1 += *(const f32x4*)(ur + 4); }
      const float* uo = U + (size_t)t * 256 + c0;
      const f32x4 o0 = *(const f32x4*)uo, o1 = *(const f32x4*)(uo + 4);
      s0 = s0 * inv - o0; s1 = s1 * inv - o1;
      u32x4 pw = {cvtpk(s0[0], s0[1]), cvtpk(s0[2], s0[3]), cvtpk(s1[0], s1[1]), cvtpk(s1[2], s1[3])};
      const bf16x8 pf = __builtin_bit_cast(bf16x8, pw);
      const bf16x8 w0 = *(const bf16x8*)(Pt + ks * 16), w1 = *(const bf16x8*)(Pt + 32 * 64 + ks * 16);
      pc0 = __builtin_amdgcn_mfma_f32_32x32x16_bf16(w0, pf, pc0, 0, 0, 0);
      pc1 = __builtin_amdgcn_mfma_f32_32x32x16_bf16(w1, pf, pc1, 0, 0, 0);
    }
    const float* psc = p.pool_scale + layer * 256 + dg * 64;
#pragma unroll
    for (int r = 0; r < 16; ++r) { pc0[r] *= psc[crow(r, hi)]; pc1[r] *= psc[32 + crow(r, hi)]; }
    bf16_t* pd = MIX + (size_t)t * D + 512 + dg * 64;
#pragma unroll
    for (int g = 0; g < 4; ++g) { *(u32x2*)(pd + 8 * g + 4 * hi) = pack4(pc0, g); *(u32x2*)(pd + 32 + 8 * g + 4 * hi) = pack4(pc1, g); }
  }
  __syncthreads();
}

__device__ __forceinline__ void phase_b(const Params& p, int layer, LAS char* lds, int bid, int nblk) {
  const bool fast = ((const int*)(p.ws + OFF_CNT))[128] != 0;
  for (int u = bid; u < 780; u += nblk) {
    if (u < 512) { if (fast) attn_unit(p, lds, NCTX + (u >> 3) * 256, u & 7, TT); }
    else if (u < 520) { if (fast && layer == 0) attn_unit(p, lds, 0, u - 512, NCTX); }
    else { const int tile = u - 520; if (layer == 0 || tile >= 4) poolconv_unit(p, layer, lds, tile); }
  }
  if (!fast) attn_fallback(p, layer, bid, nblk);
}

__device__ __forceinline__ void phase_a0(const Params& p, int layer, int bid, int nblk) {
  const int wave = bid * 8 + (TIDX >> 6), lane = TIDX & 63, nw = nblk * 8;
  float* X = (float*)(p.ws + OFF_X);
  bf16_t* H = (bf16_t*)(p.ws + OFF_H);
  const bf16_t* OM = (const bf16_t*)(p.ws + OFF_OMOE);
  for (int r = wave; r < TT; r += nw) {
    const int s = r < NCTX ? 1 : 0;
    f32x4 v[4];
    if (layer == 0) {
      const float* src = r < NCTX ? p.ctx + (size_t)r * D : p.x + (size_t)(r - NCTX) * D;
#pragma unroll
      for (int i = 0; i < 4; ++i) v[i] = *(const f32x4*)(src + i * 256 + lane * 4);
    } else {
      const float* g2 = (const float*)(p.ws + OFF_MOD) + ((layer - 1) * 2 + s) * 6144 + 5 * D;
      float sum = 0.f;
#pragma unroll
      for (int i = 0; i < 4; ++i) {
        const int c = i * 256 + lane * 4;
        const u32x2 oa = *(const u32x2*)(OM + ((size_t)r * 2 + 0) * D + c), ob = *(const u32x2*)(OM + ((size_t)r * 2 + 1) * D + c);
        const f32x4 xv = *(const f32x4*)(X + (size_t)r * D + c), gv = *(const f32x4*)(g2 + c);
        f32x4 o;
        o[0] = __uint_as_float(oa[0] << 16) + __uint_as_float(ob[0] << 16); o[1] = __uint_as_float(oa[0] & 0xffff0000u) + __uint_as_float(ob[0] & 0xffff0000u);
        o[2] = __uint_as_float(oa[1] << 16) + __uint_as_float(ob[1] << 16); o[3] = __uint_as_float(oa[1] & 0xffff0000u) + __uint_as_float(ob[1] & 0xffff0000u);
        v[i] = xv * ALPHA + gv * o;
        sum += v[i][0] + v[i][1] + v[i][2] + v[i][3];
      }
      const float mu = wave_sum(sum) * (1.f / D);
      float q = 0.f;
#pragma unroll
      for (int i = 0; i < 4; ++i) { const f32x4 d = v[i] - mu; q += d[0] * d[0] + d[1] * d[1] + d[2] * d[2] + d[3] * d[3]; }
      const float rs = rsqrtf(wave_sum(q) * (1.f / D) + EPS);
      const float* g = p.ln2_g + (layer - 1) * D; const float* b = p.ln2_b + (layer - 1) * D;
#pragma unroll
      for (int i = 0; i < 4; ++i) { const int c = i * 256 + lane * 4; v[i] = (v[i] - mu) * rs * *(const f32x4*)(g + c) + *(const f32x4*)(b + c); *(f32x4*)(X + (size_t)r * D + c) = v[i]; }
    }
    const float* modp = (const float*)(p.ws + OFF_MOD) + (layer * 2 + s) * 6144;
    float sum = 0.f;
#pragma unroll
    for (int i = 0; i < 4; ++i) sum += v[i][0] + v[i][1] + v[i][2] + v[i][3];
    const float mu = wave_sum(sum) * (1.f / D);
    float q = 0.f;
#pragma unroll
    for (int i = 0; i < 4; ++i) { const f32x4 d = v[i] - mu; q += d[0] * d[0] + d[1] * d[1] + d[2] * d[2] + d[3] * d[3]; }
    const float rs = rsqrtf(wave_sum(q) * (1.f / D) + EPS);
#pragma unroll
    for (int i = 0; i < 4; ++i) {
      const int c = i * 256 + lane * 4;
      const f32x4 h = (v[i] - mu) * rs * (*(const f32x4*)(modp + D + c) + 1.f) + *(const f32x4*)(modp + c);
      *(u32x2*)(H + (size_t)r * D + c) = (u32x2){cvtpk(h[0], h[1]), cvtpk(h[2], h[3])};
    }
  }
}

__device__ __forceinline__ void phase_c2(const Params& p, int layer, int bid, int nblk) {
  const int wave = bid * 8 + (TIDX >> 6), lane = TIDX & 63, nw = nblk * 8;
  float* X = (float*)(p.ws + OFF_X);
  const bf16_t* Y = (const bf16_t*)(p.ws + OFF_Y);
  bf16_t* H2 = (bf16_t*)(p.ws + OFF_MIX);
  int* cnt = (int*)(p.ws + OFF_CNT) + layer * 64;
  float* GATE = (float*)(p.ws + OFF_GATE); int* LIST = (int*)(p.ws + OFF_LIST);
  const int r0 = layer == 0 ? 0 : NCTX;
  for (int r = r0 + wave; r < TT; r += nw) {
    const int s = r < NCTX ? 1 : 0;
    const float* modp = (const float*)(p.ws + OFF_MOD) + (layer * 2 + s) * 6144;
    const float* xin = layer == 0 ? (r < NCTX ? p.ctx + (size_t)r * D : p.x + (size_t)(r - NCTX) * D) : X + (size_t)r * D;
    f32x4 v[4]; float sum = 0.f;
#pragma unroll
    for (int i = 0; i < 4; ++i) {
      const int c = i * 256 + lane * 4;
      const u32x2 yv = *(const u32x2*)(Y + (size_t)r * D + c);
      const f32x4 yf = {__uint_as_float(yv[0] << 16), __uint_as_float(yv[0] & 0xffff0000u), __uint_as_float(yv[1] << 16), __uint_as_float(yv[1] & 0xffff0000u)};
      v[i] = *(const f32x4*)(xin + c) * ALPHA + *(const f32x4*)(modp + 2 * D + c) * yf;
      sum += v[i][0] + v[i][1] + v[i][2] + v[i][3];
    }
    float mu = wave_sum(sum) * (1.f / D); float q = 0.f;
#pragma unroll
    for (int i = 0; i < 4; ++i) { const f32x4 d = v[i] - mu; q += d[0] * d[0] + d[1] * d[1] + d[2] * d[2] + d[3] * d[3]; }
    float rs = rsqrtf(wave_sum(q) * (1.f / D) + EPS);
    sum = 0.f;
#pragma unroll
    for (int i = 0; i < 4; ++i) {
      const int c = i * 256 + lane * 4;
      v[i] = (v[i] - mu) * rs * *(const f32x4*)(p.ln1_g + layer * D + c) + *(const f32x4*)(p.ln1_b + layer * D + c);
      *(f32x4*)(X + (size_t)r * D + c) = v[i];
      sum += v[i][0] + v[i][1] + v[i][2] + v[i][3];
    }
    mu = wave_sum(sum) * (1.f / D); q = 0.f;
#pragma unroll
    for (int i = 0; i < 4; ++i) { const f32x4 d = v[i] - mu; q += d[0] * d[0] + d[1] * d[1] + d[2] * d[2] + d[3] * d[3]; }
    rs = rsqrtf(wave_sum(q) * (1.f / D) + EPS);
#pragma unroll
    for (int i = 0; i < 4; ++i) {
      const int c = i * 256 + lane * 4;
      v[i] = (v[i] - mu) * rs * (*(const f32x4*)(modp + 4 * D + c) + 1.f) + *(const f32x4*)(modp + 3 * D + c);
      *(u32x2*)(H2 + (size_t)r * D + c) = (u32x2){cvtpk(v[i][0], v[i][1]), cvtpk(v[i][2], v[i][3])};
    }
    f32x4 lg = {0.f, 0.f, 0.f, 0.f};
#pragma unroll
    for (int i = 0; i < 4; ++i)
#pragma unroll
      for (int j = 0; j < 4; ++j) lg += *(const f32x4*)(p.w_rg + ((size_t)layer * D + i * 256 + lane * 4 + j) * 4) * v[i][j];
    lg[0] = wave_sum(lg[0]) + p.b_rg[layer * 4 + 0]; lg[1] = wave_sum(lg[1]) + p.b_rg[layer * 4 + 1];
    lg[2] = wave_sum(lg[2]) + p.b_rg[layer * 4 + 2]; lg[3] = wave_sum(lg[3]) + p.b_rg[layer * 4 + 3];
    int gsel = 0; float gm = lg[0];
    if (lg[1] > gm) { gm = lg[1]; gsel = 1; }
    if (lg[2] > gm) { gm = lg[2]; gsel = 2; }
    if (lg[3] > gm) { gm = lg[3]; gsel = 3; }
    const float pgrp = 1.f / (__expf(lg[0] - gm) + __expf(lg[1] - gm) + __expf(lg[2] - gm) + __expf(lg[3] - gm));
    f32x4 ea = {0.f, 0.f, 0.f, 0.f}, eb = {0.f, 0.f, 0.f, 0.f};
#pragma unroll
    for (int i = 0; i < 4; ++i)
#pragma unroll
      for (int j = 0; j < 4; ++j) {
        const float* wr = p.w_re + ((size_t)layer * D + i * 256 + lane * 4 + j) * 32 + gsel * 8;
        ea += *(const f32x4*)wr * v[i][j]; eb += *(const f32x4*)(wr + 4) * v[i][j];
      }
    float le[8];
#pragma unroll
    for (int e = 0; e < 4; ++e) { le[e] = wave_sum(ea[e]) + p.b_re[layer * 32 + gsel * 8 + e]; le[4 + e] = wave_sum(eb[e]) + p.b_re[layer * 32 + gsel * 8 + 4 + e]; }
    int i0 = 0; float v0 = le[0];
#pragma unroll
    for (int e = 1; e < 8; ++e) if (le[e] > v0) { v0 = le[e]; i0 = e; }
    int i1 = -1; float v1 = -3.0e38f;
#pragma unroll
    for (int e = 0; e < 8; ++e) if (e != i0 && le[e] > v1) { v1 = le[e]; i1 = e; }
    if (i1 < 0) { i1 = (i0 + 1) & 7; v1 = v0; }
    const float e1 = __expf(v1 - v0);
    if (lane == 0) {
      const int xa = gsel * 8 + i0, xb = gsel * 8 + i1;
      const int pa = atomicAdd(&cnt[xa], 1), pb = atomicAdd(&cnt[xb], 1);
      LIST[(size_t)xa * CAPL + pa] = r * 2 + 0;
      LIST[(size_t)xb * CAPL + pb] = r * 2 + 1;
      GATE[r * 2] = pgrp / (1.f + e1); GATE[r * 2 + 1] = pgrp * e1 / (1.f + e1);
    }
  }
}

__device__ __forceinline__ void phase_final(const Params& p, int bid, int nblk) {
  const int wave = bid * 8 + (TIDX >> 6), lane = TIDX & 63, nw = nblk * 8;
  const float* X = (const float*)(p.ws + OFF_X);
  const bf16_t* OM = (const bf16_t*)(p.ws + OFF_OMOE);
  const float* g2 = (const float*)(p.ws + OFF_MOD) + (1 * 2 + 0) * 6144 + 5 * D;
  for (int r = NCTX + wave; r < TT; r += nw) {
    f32x4 v[4]; float sum = 0.f;
#pragma unroll
    for (int i = 0; i < 4; ++i) {
      const int c = i * 256 + lane * 4;
      const u32x2 oa = *(const u32x2*)(OM + ((size_t)r * 2 + 0) * D + c), ob = *(const u32x2*)(OM + ((size_t)r * 2 + 1) * D + c);
      f32x4 o;
      o[0] = __uint_as_float(oa[0] << 16) + __uint_as_float(ob[0] << 16); o[1] = __uint_as_float(oa[0] & 0xffff0000u) + __uint_as_float(ob[0] & 0xffff0000u);
      o[2] = __uint_as_float(oa[1] << 16) + __uint_as_float(ob[1] << 16); o[3] = __uint_as_float(oa[1] & 0xffff0000u) + __uint_as_float(ob[1] & 0xffff0000u);
      v[i] = *(const f32x4*)(X + (size_t)r * D + c) * ALPHA + *(const f32x4*)(g2 + c) * o;
      sum += v[i][0] + v[i][1] + v[i][2] + v[i][3];
    }
    const float mu = wave_sum(sum) * (1.f / D); float q = 0.f;
#pragma unroll
    for (int i = 0; i < 4; ++i) { const f32x4 d = v[i] - mu; q += d[0] * d[0] + d[1] * d[1] + d[2] * d[2] + d[3] * d[3]; }
    const float rs = rsqrtf(wave_sum(q) * (1.f / D) + EPS);
#pragma unroll
    for (int i = 0; i < 4; ++i) {
      const int c = i * 256 + lane * 4;
      *(f32x4*)(p.out + (size_t)(r - NCTX) * D + c) = (v[i] - mu) * rs * *(const f32x4*)(p.ln2_g + D + c) + *(const f32x4*)(p.ln2_b + D + c);
    }
  }
}

__device__ __forceinline__ void phase_p0(const Params& p, LAS char* lds, int bid, int nblk) {
  const int tid = TIDX;
  const long gtid = (long)bid * 512 + tid, gth = (long)nblk * 512;
  LAS float* sc = (LAS float*)lds;
  LAS float* red = (LAS float*)(lds + 8192);
  for (int i = tid; i < 2048; i += 512) { const float v = i < 1024 ? p.c[i] : p.c_ctx[i - 1024]; sc[i] = silu(v); }
  __syncthreads();
  float* mod = (float*)(p.ws + OFF_MOD);
  for (int u = bid; u < 384; u += nblk) {
    const int layer = u / 192, cg = u % 192, col = tid & 31, ksl = tid >> 5;
    const float* w = p.w_mod + ((size_t)layer * D + ksl * 64) * 6144 + cg * 32 + col;
    float a0 = 0.f, a1 = 0.f;
#pragma unroll 8
    for (int k = 0; k < 64; ++k) { const float wv = w[(size_t)k * 6144]; a0 += sc[ksl * 64 + k] * wv; a1 += sc[1024 + ksl * 64 + k] * wv; }
    red[(ksl * 32 + col) * 2] = a0; red[(ksl * 32 + col) * 2 + 1] = a1;
    __syncthreads();
    if (tid < 64) {
      const int c2 = tid & 31, s = tid >> 5; float a = 0.f;
#pragma unroll
      for (int k = 0; k < 16; ++k) a += red[(k * 32 + c2) * 2 + s];
      mod[(layer * 2 + s) * 6144 + cg * 32 + c2] = a + p.b_mod[layer * 6144 + cg * 32 + c2];
    }
    __syncthreads();
  }
  if (gtid < 256 * 16) {
    const int pos = (int)gtid / 16, f = (int)gtid % 16;
    const float ang = (float)pos * powf(10000.f, -(float)f / 16.f);
    float* rt = (float*)(p.ws + OFF_ROPE);
    rt[gtid * 2 + 0] = cosf(ang); rt[gtid * 2 + 1] = sinf(ang);
  }
  if (gtid < 128) ((int*)(p.ws + OFF_CNT))[gtid] = 0;
  if (gtid == 0) {
    float bmax = 0.f;
    for (int l = 0; l < 2; ++l) {
      float gq = 0.f, gk = 0.f;
      for (int i = 0; i < 64; ++i) { gq = fmaxf(gq, fabsf(p.q_gain[l * 64 + i])); gk = fmaxf(gk, fabsf(p.k_gain[l * 64 + i])); }
      bmax = fmaxf(bmax, 11.55f * gq * gk);
    }
    ((int*)(p.ws + OFF_CNT))[128] = (bmax <= 100.f) ? 1 : 0;
  }
  for (long i = gtid; i < 2 * 65536; i += gth) { const int l = (int)(i >> 16), d = (int)(i >> 8) & 255, c = (int)i & 255; ((bf16_t*)(p.ws + OFF_WPWT))[i] = f2bf(p.w_cv_pw[((size_t)l * 256 + c) * 256 + d]); }
  for (long i = gtid; i < 8 * 4096; i += gth) { const int lg = (int)(i >> 12), d = (int)(i >> 6) & 63, c = (int)i & 63; ((bf16_t*)(p.ws + OFF_WPOOLT))[i] = f2bf(p.w_pool[((size_t)lg * 64 + c) * 64 + d]); }
  cvt_range(p.w_in, (bf16_t*)(p.ws + OFF_WIN), 2L * D * INW / 8, gtid, gth);
  cvt_range(p.w_out, (bf16_t*)(p.ws + OFF_WOUT), 2L * D * D / 8, gtid, gth);
  cvt_range(p.w_e_gate, (bf16_t*)(p.ws + OFF_WG), 2L * NE * D * DE / 8, gtid, gth);
  cvt_range(p.w_e_up, (bf16_t*)(p.ws + OFF_WU), 2L * NE * D * DE / 8, gtid, gth);
  cvt_range(p.w_e_down, (bf16_t*)(p.ws + OFF_WD), 2L * NE * D * DE / 8, gtid, gth);
}
#define XB_TMO      128
#define XB_XCNT(j)  (256  + 64 * (j))
#define XB_XSUB(j)  (1280 + 64 * (j))
#define XB_XGEN(j)  (2304 + 64 * (j))
#define XB_TOP      3328
#define XB_TOPGEN   3392
#define XCD_BAR_WORDS 3456
#define XB_SPIN_CAP (1u << 22)
__device__ __forceinline__ unsigned xb_ld(unsigned* p)              { return __hip_atomic_load(p, __ATOMIC_RELAXED, __HIP_MEMORY_SCOPE_AGENT); }
__device__ __forceinline__ unsigned xb_add(unsigned* p, unsigned v) { return __hip_atomic_fetch_add(p, v, __ATOMIC_RELAXED, __HIP_MEMORY_SCOPE_AGENT); }
__device__ __forceinline__ unsigned xb_xcc_id() { return (unsigned)__builtin_amdgcn_s_getreg((3 << 11) | 20) & 0xFu; }
#define XB_SPIN(cond, bar) do { unsigned _sp = 0; while (cond) { __builtin_amdgcn_s_sleep(1); \
    if ((++_sp & 255u) == 0u) { if (xb_ld(&(bar)[XB_TMO])) break; if (_sp > XB_SPIN_CAP) { atomicAdd(&(bar)[XB_TMO], 1u); break; } } } } while (0)
struct XcdBarrier { unsigned* bar; unsigned x; volatile LAS unsigned* st; };
__device__ __forceinline__ XcdBarrier xcd_barrier_post(unsigned* bar, volatile LAS unsigned* st) {
  XcdBarrier b; b.bar = bar; b.x = xb_xcc_id(); b.st = st;
  if (threadIdx.x == 0) (void)xb_add(&bar[XB_XCNT(b.x)], 1u);
  return b;
}
__device__ __forceinline__ void xcd_barrier_complete(unsigned* bar, unsigned x, unsigned& nloc, unsigned& nx) {
  const unsigned G = gridDim.x * gridDim.y * gridDim.z;
  unsigned sum, cnt, mine, sp = 0u;
  for (;;) {
    sum = 0u; cnt = 0u; mine = 0u;
#pragma unroll
    for (unsigned j = 0; j < 16; ++j) { const unsigned c = xb_ld(&bar[XB_XCNT(j)]); sum += c; cnt += (c > 0u) ? 1u : 0u; mine = (j == x) ? c : mine; }
    if (sum == G) break;
    __builtin_amdgcn_s_sleep(1);
    if ((++sp & 255u) == 0u) { if (xb_ld(&bar[XB_TMO])) break; if (sp > XB_SPIN_CAP) { atomicAdd(&bar[XB_TMO], 1u); break; } }
  }
  nloc = mine > 0u ? mine : 1u; nx = cnt > 0u ? cnt : 1u;
}
__device__ __forceinline__ void xcd_barrier(const XcdBarrier& b) {
  asm volatile("s_waitcnt vmcnt(0)" ::: "memory");
  __syncthreads();
  if (threadIdx.x == 0) {
    unsigned* bar = b.bar;
    __builtin_amdgcn_s_waitcnt(0);
    unsigned nloc = b.st[0], nx = b.st[1];
    if (nloc == 0u) { xcd_barrier_complete(bar, b.x, nloc, nx); b.st[0] = nloc; b.st[1] = nx; }
    const unsigned old = xb_add(&bar[XB_XSUB(b.x)], 1u);
    const unsigned gen = old / nloc;
    if (old + 1u == (gen + 1u) * nloc) {
      __builtin_amdgcn_fence(__ATOMIC_RELEASE, "agent");
      asm volatile("s_waitcnt vmcnt(0)" ::: "memory");
      const unsigned og = xb_add(&bar[XB_TOP], 1u);
      const unsigned tg = og / nx;
      if (og + 1u == (tg + 1u) * nx) xb_add(&bar[XB_TOPGEN], 1u);
      else XB_SPIN(xb_ld(&bar[XB_TOPGEN]) == tg, bar);
      __builtin_amdgcn_fence(__ATOMIC_ACQUIRE, "agent");
      xb_add(&bar[XB_XGEN(b.x)], 1u);
      asm volatile("s_waitcnt vmcnt(0)" ::: "memory");
    } else {
      XB_SPIN(xb_ld(&bar[XB_XGEN(b.x)]) == gen, bar);
      __builtin_amdgcn_fence(__ATOMIC_ACQUIRE, "agent");
      asm volatile("s_waitcnt vmcnt(0)" ::: "memory");
    }
  }
  __syncthreads();
}

constexpr int LDS_MAIN = PC_LDS > GEMM_LDS + 256 ? PC_LDS : GEMM_LDS + 256;
constexpr int LDS_TOTAL = LDS_MAIN + 16;
static_assert(GEMM_LDS + 256 <= LDS_MAIN && ATT_LDS <= LDS_MAIN, "lds");
__global__ void __launch_bounds__(512) mega_fwd(Params p) {
  __shared__ __attribute__((aligned(16))) char slds[LDS_TOTAL];
  LAS char* lds = (LAS char*)slds;
  volatile LAS unsigned* st = (volatile LAS unsigned*)(lds + LDS_MAIN);
  if (threadIdx.x < 4) st[threadIdx.x] = 0u;
  __syncthreads();
  const XcdBarrier bar = xcd_barrier_post((unsigned*)(p.ws + OFF_BAR), st);
  const int bid = blockIdx.x, nblk = gridDim.x;
  phase_p0(p, lds, bid, nblk);
  xcd_barrier(bar);
#pragma unroll 1
  for (int layer = 0; layer < 2; ++layer) {
    phase_a0(p, layer, bid, nblk);
    xcd_barrier(bar);
    phase_a1(p, layer, lds, bid, nblk);
    xcd_barrier(bar);
    phase_b(p, layer, lds, bid, nblk);
    xcd_barrier(bar);
    phase_c1(p, layer, lds, bid, nblk);
    xcd_barrier(bar);
    phase_c2(p, layer, bid, nblk);
    xcd_barrier(bar);
    phase_d1(p, layer, lds, bid, nblk);
    xcd_barrier(bar);
    phase_d2(p, layer, lds, bid, nblk);
    xcd_barrier(bar);
  }
  phase_final(p, bid, nblk);
}

extern "C" void kernel_launch(void* const* d_in, const int* in_sizes, int n_in, void* d_out, int out_size, void* d_ws, size_t ws_size,
                              hipStream_t stream) {
  static int grid = 0;
  if (grid == 0) {
    if (ws_size < WS_END || n_in != 28) { fprintf(stderr, "kernel_launch: ws too small (%zu < %zu) or n_in %d != 28; nothing launched\n", ws_size, (size_t)WS_END, n_in); grid = -1; return; }
    int dev = 0, cus = 0, per_cu = 0;
    if (hipGetDevice(&dev) != hipSuccess || hipDeviceGetAttribute(&cus, hipDeviceAttributeMultiprocessorCount, dev) != hipSuccess) { grid = -1; return; }
    if (hipOccupancyMaxActiveBlocksPerMultiprocessor(&per_cu, (const void*)mega_fwd, 512, 0) != hipSuccess || per_cu < 1) {
      fprintf(stderr, "kernel_launch: occupancy query says %d blocks per CU; nothing launched\n", per_cu); grid = -1; return; }
    (void)hipGetLastError();
    grid = cus;
  }
  if (grid < 0) return;
  if (hipMemsetAsync((char*)d_ws + OFF_BAR, 0, BAR_BYTES, stream) != hipSuccess) { fprintf(stderr, "kernel_launch: memset failed\n"); return; }
  Params p{};
  const float** f = (const float**)&p;
  for (int i = 0; i < 28; ++i) f[i] = (const float*)d_in[i];
  p.out = (float*)d_out; p.ws = (char*)d_ws;
  hipLaunchKernelGGL(mega_fwd, dim3(grid), dim3(512), 0, stream, p);
}
```

```cpp
#include <hip/hip_runtime.h>
#include <cstdio>
#include <cstdint>

typedef unsigned short bf16_t;
#define LAS __attribute__((address_space(3)))

constexpr int D = 1024, SEQ = 16384, NCTX = 256, TT = SEQ + NCTX;
constexpr int INW = 1536;
constexpr int NE = 32, DE = 512;
constexpr int CAPL = 2 * TT;
constexpr int HMID_ROWS = 2 * TT + NE * 128;
constexpr float ALPHA = 1.41421356237309515f;
constexpr float EPS = 1e-6f;

constexpr size_t al(size_t x) { return (x + 255) / 256 * 256; }
constexpr size_t OFF_BAR = 0;
constexpr size_t BAR_BYTES = 3456 * 4;
constexpr size_t OFF_MOD = OFF_BAR + al(BAR_BYTES);
constexpr size_t OFF_ROPE = OFF_MOD + al(2 * 2 * 6144 * 4);
constexpr int CNT_STRIDE = 32;
constexpr size_t OFF_CNT = OFF_ROPE + al(256 * 16 * 2 * 4);
constexpr size_t OFF_FLAG = OFF_CNT + al(2 * 32 * 32 * 4);
constexpr size_t OFF_X = OFF_FLAG + 256;
constexpr size_t OFF_H = OFF_X + al((size_t)TT * D * 4);
constexpr size_t OFF_MIX = OFF_H + al((size_t)TT * D * 2);
constexpr size_t OFF_Y = OFF_MIX + al((size_t)TT * D * 2);
constexpr size_t OFF_Q = OFF_Y + al((size_t)TT * D * 2);
constexpr size_t OFF_K = OFF_Q + al((size_t)TT * 512 * 2);
constexpr size_t OFF_V = OFF_K + al((size_t)TT * 128 * 2);
constexpr size_t OFF_U = OFF_V + al((size_t)TT * 128 * 2);
constexpr size_t OFF_AG = OFF_U + al((size_t)TT * 256 * 4);
constexpr size_t OFF_HMID = OFF_Q;
constexpr size_t OFF_OMOE = OFF_AG + al((size_t)TT * 512 * 2);
constexpr size_t OFF_GATE = OFF_OMOE + al((size_t)TT * 2 * D * 2);
constexpr size_t OFF_LIST = OFF_GATE + al((size_t)TT * 2 * 4);
constexpr size_t OFF_WIN = OFF_LIST + al((size_t)NE * CAPL * 4);
constexpr size_t OFF_WOUT = OFF_WIN + al((size_t)2 * D * INW * 2);
constexpr size_t OFF_WPWT = OFF_WOUT + al((size_t)2 * D * D * 2);
constexpr size_t OFF_WPOOLT = OFF_WPWT + al((size_t)2 * 256 * 256 * 2);
constexpr size_t OFF_WG = OFF_WPOOLT + al((size_t)2 * 4 * 64 * 64 * 2);
constexpr size_t OFF_WU = OFF_WG + al((size_t)2 * NE * D * DE * 2);
constexpr size_t OFF_WD = OFF_WU + al((size_t)2 * NE * D * DE * 2);
constexpr size_t WS_END = OFF_WD + al((size_t)2 * NE * D * DE * 2);
static_assert(OFF_AG - OFF_HMID >= (size_t)HMID_ROWS * DE * 2, "HMID alias too small");
static_assert(WS_END < 530000000, "ws budget");

struct Params {
  const float *x, *c, *ctx, *c_ctx, *w_mod, *b_mod, *w_in, *q_gain, *k_gain, *w_pool, *pool_scale, *w_dw, *b_dw,
      *cv_ln_g, *cv_ln_b, *w_cv_pw, *w_out, *ln1_g, *ln1_b, *ln2_g, *ln2_b, *w_rg, *b_rg, *w_re, *b_re, *w_e_gate, *w_e_up, *w_e_down;
  float* out;
  char* ws;
};

__device__ __forceinline__ float bf2f(bf16_t v) { return __uint_as_float(((unsigned)v) << 16); }
__device__ __forceinline__ bf16_t f2bf(float f) {
  unsigned u = __float_as_uint(f);
  u += 0x7fffu + ((u >> 16) & 1u);
  return (bf16_t)(u >> 16);
}
__device__ __forceinline__ float wave_sum(float v) {
#pragma unroll
  for (int o = 32; o > 0; o >>= 1) v += __shfl_xor(v, o);
  return v;
}
__device__ __forceinline__ float silu(float v) { return v / (1.f + __expf(-v)); }
__device__ __forceinline__ int opaque0() { int z; asm volatile("s_mov_b32 %0, 0" : "=s"(z)); return z; }
#define TIDX ((int)threadIdx.x + opaque0())
using bf16x8 = __attribute__((ext_vector_type(8))) short;
using s16x4 = __attribute__((ext_vector_type(4))) short;
using f32x16 = __attribute__((ext_vector_type(16))) float;
using f32x4 = __attribute__((ext_vector_type(4))) float;
using u32x4 = __attribute__((ext_vector_type(4))) unsigned;
using u32x2 = __attribute__((ext_vector_type(2))) unsigned;

__device__ __forceinline__ int crow(int r, int hi) { return (r & 3) + 8 * (r >> 2) + 4 * hi; }
typedef float f32x2 __attribute__((ext_vector_type(2)));
typedef __bf16 bf16x2v __attribute__((ext_vector_type(2)));
__device__ __forceinline__ unsigned cvtpk(float lo, float hi) {
  bf16x2v b = __builtin_convertvector((f32x2){lo, hi}, bf16x2v);
  return __builtin_bit_cast(unsigned, b);
}
__device__ __forceinline__ float sum32(float v) {
  auto rr = __builtin_amdgcn_permlane32_swap(__float_as_uint(v), __float_as_uint(v), false, false);
  return __uint_as_float(rr[0]) + __uint_as_float(rr[1]);
}

__device__ __forceinline__ void cvt_range(const float* __restrict__ src, bf16_t* __restrict__ dst, long n8, long gtid, long gthreads) {
  for (long i = gtid; i < n8; i += gthreads) {
    const f32x4 a = *(const f32x4*)(src + i * 8), b = *(const f32x4*)(src + i * 8 + 4);
    u32x4 w = {cvtpk(a[0], a[1]), cvtpk(a[2], a[3]), cvtpk(b[0], b[1]), cvtpk(b[2], b[3])};
    *(u32x4*)(dst + i * 8) = w;
  }
}

__device__ __forceinline__ int xoff(int row, int chunk) { return row * 128 + ((chunk ^ ((row >> 1) & 7)) << 4); }
__device__ __forceinline__ int wst(int k, int c) { const int kk = (k & ~0xC) | ((k & 4) << 1) | ((k & 8) >> 1); return ((kk >> 3) * 4 + (c >> 5)) * 512 + ((kk & 7) * 32 + (c & 31)) * 2; }
__device__ __forceinline__ int v_rd_base(int lane) { return ((lane & 3) << 3) | (((lane >> 2) & 3) << 6) | (((lane >> 4) & 1) << 5) | (((lane >> 5) & 1) << 8); }

__device__ __forceinline__ bf16x8 tr_frag(const LAS char* p) {
  s16x4 a = __builtin_amdgcn_ds_read_tr16_b64_v4i16((LAS s16x4*)p);
  s16x4 b = __builtin_amdgcn_ds_read_tr16_b64_v4i16((LAS s16x4*)(p + 2048));
  return (bf16x8){a[0], a[1], a[2], a[3], b[0], b[1], b[2], b[3]};
}

template <int BM, int BN> struct GemmCfg {
  static constexpr int WM = BM / 64, WN = 8 / WM, NSLAB = BN / 128, XB = BM * 128, WB = NSLAB * 16384, STAGE = XB + WB, NXP = BM / 64, NWP = NSLAB * 2;
  static_assert(WM * WN == 8 && WN * 64 == BN, "tile");
};
constexpr int GEMM_LDS = 3 * (256 * 128 + 16384);

template <int BM, int BN, int NMAP, class XRow, class WPtr>
__device__ __forceinline__ void gemm_mainloop(LAS char* lds, f32x16 (&acc)[2][2], const XRow& xrow, const WPtr& wptr, int ldw, int K) {
  using C = GemmCfg<BM, BN>;
  const int tid = TIDX, wid = tid >> 6, lane = tid & 63, r32 = lane & 31, hi = lane >> 5;
  const int wm = wid / C::WN, wn = wid % C::WN;
  const bf16_t* xg[C::NXP]; int xl[C::NXP];
#pragma unroll
  for (int i = 0; i < C::NXP; ++i) { const int row = (tid >> 3) + 64 * i; xg[i] = xrow(row) + (tid & 7) * 8; xl[i] = xoff(row, tid & 7); }
  const bf16_t* wg[C::NWP]; int wl[C::NWP];
#pragma unroll
  for (int i = 0; i < C::NWP; ++i) { const int s = i >> 1, k = (tid >> 4) + 32 * (i & 1), c = (tid & 15) * 8; wg[i] = wptr(s) + (size_t)k * ldw + c; wl[i] = C::XB + s * 16384 + wst(k, c); }
  int xr[2];
#pragma unroll
  for (int ti = 0; ti < 2; ++ti) xr[ti] = (wm * 64 + ti * 32 + r32) * 128;
  const int xsw = (r32 >> 1) & 7;
  int wr[2];
#pragma unroll
  for (int ni = 0; ni < 2; ++ni) {
    const int slab = NMAP == 0 ? 0 : (NMAP == 1 ? (wn >> 1) : ni);
    const int nb = NMAP == 0 ? (2 * wn + ni) : (NMAP == 1 ? ((wn & 1) * 2 + ni) : wn);
    wr[ni] = C::XB + slab * 16384 + nb * 512 + v_rd_base(lane);
  }
  u32x4 xsA[C::NXP], wsA[C::NWP], xsB[C::NXP], wsB[C::NWP];
  const int nk = K / 64;
#define G_LOAD(XS, WS, kt) do { _Pragma("unroll") for (int i = 0; i < C::NXP; ++i) XS[i] = *(const u32x4*)(xg[i] + (kt) * 64); \
    _Pragma("unroll") for (int i = 0; i < C::NWP; ++i) WS[i] = *(const u32x4*)(wg[i] + (size_t)(kt) * 64 * ldw); } while (0)
#define G_WRITE(XS, WS, st) do { LAS char* _d = lds + (st) * C::STAGE; _Pragma("unroll") for (int i = 0; i < C::NXP; ++i) *(LAS u32x4*)(_d + xl[i]) = XS[i]; \
    _Pragma("unroll") for (int i = 0; i < C::NWP; ++i) *(LAS u32x4*)(_d + wl[i]) = WS[i]; } while (0)
#define G_COMPUTE(st) do { const LAS char* cur = lds + (st) * C::STAGE; \
    _Pragma("unroll") for (int half = 0; half < 2; ++half) { bf16x8 xf[2][2], wf[2][2]; \
      _Pragma("unroll") for (int k2 = 0; k2 < 2; ++k2) { const int ks = half * 2 + k2; \
        _Pragma("unroll") for (int ti = 0; ti < 2; ++ti) xf[k2][ti] = *(const LAS bf16x8*)(cur + xr[ti] + (((ks * 2 + hi) ^ xsw) << 4)); \
        _Pragma("unroll") for (int ni = 0; ni < 2; ++ni) wf[k2][ni] = tr_frag(cur + wr[ni] + ks * 4096); } \
      __builtin_amdgcn_sched_barrier(0); \
      _Pragma("unroll") for (int k2 = 0; k2 < 2; ++k2) _Pragma("unroll") for (int ti = 0; ti < 2; ++ti) _Pragma("unroll") for (int ni = 0; ni < 2; ++ni) \
        acc[ti][ni] = __builtin_amdgcn_mfma_f32_32x32x16_bf16(wf[k2][ni], xf[k2][ti], acc[ti][ni], 0, 0, 0); } } while (0)
  G_LOAD(xsA, wsA, 0); G_LOAD(xsB, wsB, 1);
  G_WRITE(xsA, wsA, 0);
  G_LOAD(xsA, wsA, 2);
  __syncthreads();
  int st = 0;
  for (int kt = 0; kt < nk; kt += 2) {
    { const int s1 = st == 2 ? 0 : st + 1;
      G_WRITE(xsB, wsB, s1);
      if (kt + 3 < nk) G_LOAD(xsB, wsB, kt + 3);
      G_COMPUTE(st);
      __syncthreads(); st = s1; }
    { const int s1 = st == 2 ? 0 : st + 1;
      if (kt + 2 < nk) G_WRITE(xsA, wsA, s1);
      if (kt + 4 < nk) G_LOAD(xsA, wsA, kt + 4);
      G_COMPUTE(st);
      __syncthreads(); st = s1; }
  }
#undef G_LOAD
#undef G_WRITE
#undef G_COMPUTE
}

__device__ __forceinline__ u32x2 pack4(const f32x16& a, int g) { return (u32x2){cvtpk(a[4 * g], a[4 * g + 1]), cvtpk(a[4 * g + 2], a[4 * g + 3])}; }

__device__ __forceinline__ void phase_a1(const Params& p, int layer, LAS char* lds, int bid, int nblk) {
  const bf16_t* H = (const bf16_t*)(p.ws + OFF_H);
  const bf16_t* W = (const bf16_t*)(p.ws + OFF_WIN) + (size_t)layer * D * INW;
  bf16_t* Q = (bf16_t*)(p.ws + OFF_Q); bf16_t* Kb = (bf16_t*)(p.ws + OFF_K); bf16_t* Vb = (bf16_t*)(p.ws + OFF_V);
  float* U = (float*)(p.ws + OFF_U); bf16_t* AG = (bf16_t*)(p.ws + OFF_AG);
  const float* rt = (const float*)(p.ws + OFF_ROPE);
  const int lane = TIDX & 63, wid = TIDX >> 6, r32 = lane & 31, hi = lane >> 5, wm = wid >> 1, wn = wid & 1;
  const int nlat = 64 * 12, nctx = layer == 0 ? 12 : 2, nunits = nlat + nctx;
  const bool xmap = (nblk & 7) == 0;
  const int xcd = bid & 7, lb = bid >> 3, nlb = nblk >> 3, nl = lb < 96 ? (96 - lb + nlb - 1) / nlb : 0;
  for (int it = 0;; ++it) {
    int rtile, ct;
    if (xmap) {
      if (it < nl) { const int v = lb + it * nlb; rtile = 1 + xcd + 8 * (v / 12); ct = v % 12; }
      else { const int e2 = bid + (it - nl) * nblk; if (e2 >= nctx) break; rtile = 0; ct = layer == 0 ? e2 : 4 + e2; }
    } else {
      const int u = bid + it * nblk; if (u >= nunits) break;
      if (u < nlat) { rtile = 1 + u / 12; ct = u % 12; } else { rtile = 0; ct = layer == 0 ? (u - nlat) : (4 + u - nlat); }
    }
    const int m0 = rtile * 256, n0 = ct * 128;
    f32x16 acc[2][2];
#pragma unroll
    for (int a = 0; a < 2; ++a)
#pragma unroll
      for (int b = 0; b < 2; ++b) acc[a][b] = (f32x16){};
    gemm_mainloop<256, 128, 0>(lds, acc, [&](int row) { return H + (size_t)(m0 + row) * D; }, [&](int) { return W + n0; }, INW, D);
#pragma unroll
    for (int ti = 0; ti < 2; ++ti) {
      const int tok = m0 + wm * 64 + ti * 32 + r32;
      if (ct < 5) {
        float ss = 0.f;
#pragma unroll
        for (int ni = 0; ni < 2; ++ni)
#pragma unroll
          for (int r = 0; r < 16; ++r) ss += acc[ti][ni][r] * acc[ti][ni][r];
        ss = sum32(ss);
        const float rs = rsqrtf(ss * (1.f / 64.f) + EPS);
        const float* gain = (ct < 4 ? p.q_gain : p.k_gain) + layer * 64;
        const float osc = ct < 4 ? 0.125f * 1.4426950408889634f : 1.f;
        const bool lat = rtile > 0;
        const int t = tok - NCTX;
#pragma unroll
        for (int ni = 0; ni < 2; ++ni) {
          f32x16 v;
#pragma unroll
          for (int r = 0; r < 16; ++r) v[r] = acc[ti][ni][r] * rs * gain[ni * 32 + crow(r, hi)];
          if (lat) {
            const int pos = ni == 0 ? (t >> 6) : (t & 63);
#pragma unroll
            for (int r = 0; r < 8; ++r) {
              const int f = crow(r, hi);
              const float cs = rt[(pos * 16 + f) * 2], sn = rt[(pos * 16 + f) * 2 + 1];
              const float t1 = v[r], t2 = v[r + 8];
              v[r] = t1 * cs - t2 * sn; v[r + 8] = t2 * cs + t1 * sn;
            }
          }
#pragma unroll
          for (int r = 0; r < 16; ++r) v[r] *= osc;
          bf16_t* dst = ct < 4 ? Q + (size_t)tok * 512 + (ct * 2 + wn) * 64 + ni * 32 : Kb + (size_t)tok * 128 + wn * 64 + ni * 32;
#pragma unroll
          for (int g = 0; g < 4; ++g) *(u32x2*)(dst + 8 * g + 4 * hi) = pack4(v, g);
        }
      } else if (ct == 5) {
#pragma unroll
        for (int ni = 0; ni < 2; ++ni)
#pragma unroll
          for (int g = 0; g < 4; ++g) *(u32x2*)(Vb + (size_t)tok * 128 + wn * 64 + ni * 32 + 8 * g + 4 * hi) = pack4(acc[ti][ni], g);
      } else if (ct < 8) {
#pragma unroll
        for (int ni = 0; ni < 2; ++ni)
#pragma unroll
          for (int g = 0; g < 4; ++g)
            *(f32x4*)(U + (size_t)tok * 256 + (ct - 6) * 128 + wn * 64 + ni * 32 + 8 * g + 4 * hi) =
                (f32x4){acc[ti][ni][4 * g], acc[ti][ni][4 * g + 1], acc[ti][ni][4 * g + 2], acc[ti][ni][4 * g + 3]};
      } else {
#pragma unroll
        for (int ni = 0; ni < 2; ++ni)
#pragma unroll
          for (int g = 0; g < 4; ++g) *(u32x2*)(AG + (size_t)tok * 512 + (ct - 8) * 128 + wn * 64 + ni * 32 + 8 * g + 4 * hi) = pack4(acc[ti][ni], g);
      }
    }
  }
}

__device__ __forceinline__ void phase_c1(const Params& p, int layer, LAS char* lds, int bid, int nblk) {
  const bf16_t* A = (const bf16_t*)(p.ws + OFF_MIX);
  const bf16_t* W = (const bf16_t*)(p.ws + OFF_WOUT) + (size_t)layer * D * D;
  bf16_t* Y = (bf16_t*)(p.ws + OFF_Y);
  const int lane = TIDX & 63, wid = TIDX >> 6, r32 = lane & 31, hi = lane >> 5, wm = wid >> 1, wn = wid & 1;
  const int nctx = layer == 0 ? 8 : 0;
  const bool xmap = (nblk & 7) == 0;
  const int xcd = bid & 7, lb = bid >> 3, nlb = nblk >> 3, nl = lb < 64 ? (64 - lb + nlb - 1) / nlb : 0;
  for (int it = 0;; ++it) {
    int rtile, ct;
    if (xmap) {
      if (it < nl) { const int v = lb + it * nlb; rtile = 1 + xcd + 8 * (v >> 3); ct = v & 7; }
      else { const int e2 = bid + (it - nl) * nblk; if (e2 >= nctx) break; rtile = 0; ct = e2; }
    } else {
      const int u = bid + it * nblk; if (u >= 64 * 8 + nctx) break;
      if (u < 512) { rtile = 1 + (u >> 3); ct = u & 7; } else { rtile = 0; ct = u - 512; }
    }
    const int m0 = rtile * 256, n0 = ct * 128;
    f32x16 acc[2][2];
#pragma unroll
    for (int a = 0; a < 2; ++a)
#pragma unroll
      for (int b = 0; b < 2; ++b) acc[a][b] = (f32x16){};
    gemm_mainloop<256, 128, 0>(lds, acc, [&](int row) { return A + (size_t)(m0 + row) * D; }, [&](int) { return W + n0; }, D, D);
#pragma unroll
    for (int ti = 0; ti < 2; ++ti) {
      const int tok = m0 + wm * 64 + ti * 32 + r32;
#pragma unroll
      for (int ni = 0; ni < 2; ++ni)
#pragma unroll
        for (int g = 0; g < 4; ++g) *(u32x2*)(Y + (size_t)tok * D + n0 + wn * 64 + ni * 32 + 8 * g + 4 * hi) = pack4(acc[ti][ni], g);
    }
  }
}

__device__ __forceinline__ void moe_prefix(const int* cnt, LAS int* pre, int xcd) {
  if (TIDX == 0) {
    int o = 0; for (int e = 0; e < NE; ++e) { pre[e] = o; o += (cnt[e * CNT_STRIDE] + 127) >> 7; } pre[NE] = o;
    int l = 0; for (int j = 0; j < 4; ++j) { pre[40 + j] = l; l += (cnt[(xcd + 8 * j) * CNT_STRIDE] + 127) >> 7; } pre[44] = l;
  }
  __syncthreads();
}
__device__ __forceinline__ bool moe_unit(const LAS int* pre, int bid, int nblk, int it, int& e, int& rt, int& ct, int& g) {
  if ((nblk & 7) == 0) {
    const int xcd = bid & 7, v = (bid >> 3) + it * (nblk >> 3), gl = v >> 2;
    if (gl >= pre[44]) return false;
    int j = 0; if (gl >= pre[41]) j = 1; if (gl >= pre[42]) j = 2; if (gl >= pre[43]) j = 3;
    e = xcd + 8 * j; rt = gl - pre[40 + j]; ct = v & 3; g = pre[e] + rt; return true;
  } else {
    const int u = bid + it * nblk; g = u >> 2; if (g >= pre[NE]) return false;
    int ee = 0; for (int i = 1; i < NE; ++i) ee += (pre[i] <= g) ? 1 : 0;
    e = ee; rt = g - pre[ee]; ct = u & 3; return true;
  }
}

__device__ __forceinline__ void phase_d1(const Params& p, int layer, LAS char* lds, int bid, int nblk) {
  const int* cnt = (const int*)(p.ws + OFF_CNT) + layer * NE * CNT_STRIDE;
  const bf16_t* H2 = (const bf16_t*)(p.ws + OFF_MIX);
  bf16_t* HM = (bf16_t*)(p.ws + OFF_HMID);
  LAS int* pre = (LAS int*)(lds + GEMM_LDS);
  moe_prefix(cnt, pre, bid & 7);
  const int lane = TIDX & 63, wid = TIDX >> 6, r32 = lane & 31, hi = lane >> 5, wm = wid >> 2, wn = wid & 3;
  for (int it = 0;; ++it) {
    int e, rt, ct, g; if (!moe_unit(pre, bid, nblk, it, e, rt, ct, g)) break;
    const int n = cnt[e * CNT_STRIDE];
    const int* list = (const int*)(p.ws + OFF_LIST) + (size_t)e * CAPL + rt * 128;
    const bf16_t* Wg = (const bf16_t*)(p.ws + OFF_WG) + ((size_t)layer * NE + e) * D * DE + ct * 128;
    const bf16_t* Wu = (const bf16_t*)(p.ws + OFF_WU) + ((size_t)layer * NE + e) * D * DE + ct * 128;
    const int nvalid = n - rt * 128;
    f32x16 acc[2][2];
#pragma unroll
    for (int a = 0; a < 2; ++a)
#pragma unroll
      for (int b = 0; b < 2; ++b) acc[a][b] = (f32x16){};
    gemm_mainloop<128, 256, 2>(lds, acc, [&](int row) { const int tok = row < nvalid ? (list[row] >> 1) : 0; return H2 + (size_t)tok * D; },
                               [&](int s) { return s == 0 ? Wg : Wu; }, DE, D);
    const size_t hrow0 = (size_t)(pre[e] + rt) * 128;
#pragma unroll
    for (int ti = 0; ti < 2; ++ti) {
      const size_t row = hrow0 + wm * 64 + ti * 32 + r32;
      f32x16 a;
#pragma unroll
      for (int r = 0; r < 16; ++r) { const float gv = acc[ti][0][r]; a[r] = gv / (1.f + __expf(-gv)) * acc[ti][1][r]; }
#pragma unroll
      for (int gq = 0; gq < 4; ++gq) *(u32x2*)(HM + row * DE + ct * 128 + wn * 32 + 8 * gq + 4 * hi) = pack4(a, gq);
    }
  }
}

__device__ __forceinline__ void phase_d2(const Params& p, int layer, LAS char* lds, int bid, int nblk) {
  const int* cnt = (const int*)(p.ws + OFF_CNT) + layer * NE * CNT_STRIDE;
  const bf16_t* HM = (const bf16_t*)(p.ws + OFF_HMID);
  const float* GATE = (const float*)(p.ws + OFF_GATE);
  bf16_t* OM = (bf16_t*)(p.ws + OFF_OMOE);
  LAS int* pre = (LAS int*)(lds + GEMM_LDS);
  moe_prefix(cnt, pre, bid & 7);
  const int lane = TIDX & 63, wid = TIDX >> 6, r32 = lane & 31, hi = lane >> 5, wm = wid >> 2, wn = wid & 3;
  for (int it = 0;; ++it) {
    int e, rt, ct, g; if (!moe_unit(pre, bid, nblk, it, e, rt, ct, g)) break;
    const int n = cnt[e * CNT_STRIDE];
    const int* list = (const int*)(p.ws + OFF_LIST) + (size_t)e * CAPL + rt * 128;
    const bf16_t* Wd = (const bf16_t*)(p.ws + OFF_WD) + ((size_t)layer * NE + e) * DE * D + ct * 256;
    const int nvalid = n - rt * 128;
    const bf16_t* A = HM + (size_t)g * 128 * DE;
    f32x16 acc[2][2];
#pragma unroll
    for (int a = 0; a < 2; ++a)
#pragma unroll
      for (int b = 0; b < 2; ++b) acc[a][b] = (f32x16){};
    gemm_mainloop<128, 256, 1>(lds, acc, [&](int row) { return A + (size_t)row * DE; }, [&](int s) { return Wd + s * 128; }, D, DE);
#pragma unroll
    for (int ti = 0; ti < 2; ++ti) {
      const int row = wm * 64 + ti * 32 + r32;
      if (row < nvalid) {
        const int ts = list[row];
        const float gt = GATE[ts];
#pragma unroll
        for (int ni = 0; ni < 2; ++ni) {
          f32x16 a;
#pragma unroll
          for (int r = 0; r < 16; ++r) a[r] = acc[ti][ni][r] * gt;
#pragma unroll
          for (int gq = 0; gq < 4; ++gq) *(u32x2*)(OM + (size_t)ts * D + ct * 256 + wn * 64 + ni * 32 + 8 * gq + 4 * hi) = pack4(a, gq);
        }
      }
    }
  }
}

constexpr int ATT_SLOT = 16384, ATT_LDS = 4 * ATT_SLOT;
__device__ __forceinline__ int vst64(int k, int c) { const int kk = (k & ~0xC) | ((k & 4) << 1) | ((k & 8) >> 1); return ((kk >> 3) * 2 + (c >> 5)) * 512 + ((kk & 7) * 32 + (c & 31)) * 2; }
__device__ __forceinline__ bf16x8 tr_frag64(const LAS char* p) {
  s16x4 a = __builtin_amdgcn_ds_read_tr16_b64_v4i16((LAS s16x4*)p);
  s16x4 b = __builtin_amdgcn_ds_read_tr16_b64_v4i16((LAS s16x4*)(p + 1024));
  return (bf16x8){a[0], a[1], a[2], a[3], b[0], b[1], b[2], b[3]};
}
__device__ __forceinline__ bf16x8 pk4(const f32x16& P, int B) {
  unsigned a0 = cvtpk(P[B + 0], P[B + 1]), a1 = cvtpk(P[B + 2], P[B + 3]), b0 = cvtpk(P[B + 4], P[B + 5]), b1 = cvtpk(P[B + 6], P[B + 7]);
  auto r0 = __builtin_amdgcn_permlane32_swap(a0, b0, false, false); auto r1 = __builtin_amdgcn_permlane32_swap(a1, b1, false, false);
  u32x4 w = {r0[0], r1[0], r0[1], r1[1]};
  return __builtin_bit_cast(bf16x8, w);
}
struct AttnCtx { int krd0, krd1, ksw, hi, vrd; };
#define SBAR() __builtin_amdgcn_sched_barrier(0)
__device__ __forceinline__ void att_kload(const LAS char* slot, const AttnCtx& c, bf16x8 (&kf)[8]) {
#pragma unroll
  for (int d0 = 0; d0 < 4; ++d0) {
    kf[2 * d0] = *(const LAS bf16x8*)(slot + c.krd0 + (((2 * d0 + c.hi) ^ c.ksw) << 4));
    kf[2 * d0 + 1] = *(const LAS bf16x8*)(slot + c.krd1 + (((2 * d0 + c.hi) ^ c.ksw) << 4));
  }
}
__device__ __forceinline__ void att_qk(const bf16x8 (&kf)[8], const bf16x8 (&qr)[4], f32x16& s0, f32x16& s1) {
  s0 = (f32x16){}; s1 = (f32x16){};
#pragma unroll
  for (int d0 = 0; d0 < 4; ++d0) {
    s0 = __builtin_amdgcn_mfma_f32_32x32x16_bf16(kf[2 * d0], qr[d0], s0, 0, 0, 0);
    s1 = __builtin_amdgcn_mfma_f32_32x32x16_bf16(kf[2 * d0 + 1], qr[d0], s1, 0, 0, 0);
  }
}
__device__ __forceinline__ void att_exp(f32x16& s, float& l) {
#pragma unroll
  for (int r = 0; r < 16; ++r) { s[r] = __builtin_amdgcn_exp2f(s[r]); l += s[r]; }
  asm volatile("" : "+v"(l));
}
template <int KS0>
__device__ __forceinline__ void att_vload(const LAS char* slot, const AttnCtx& c, bf16x8 (&vf)[4]) {
#pragma unroll
  for (int i = 0; i < 2; ++i) { vf[2 * i] = tr_frag64(slot + c.vrd + (KS0 + i) * 2048); vf[2 * i + 1] = tr_frag64(slot + c.vrd + 512 + (KS0 + i) * 2048); }
}
__device__ __forceinline__ void att_pv2(const bf16x8& pa, const bf16x8& pb, const bf16x8 (&vf)[4], f32x16& o0, f32x16& o1) {
  o0 = __builtin_amdgcn_mfma_f32_32x32x16_bf16(pa, vf[0], o0, 0, 0, 0);
  o1 = __builtin_amdgcn_mfma_f32_32x32x16_bf16(pa, vf[1], o1, 0, 0, 0);
  o0 = __builtin_amdgcn_mfma_f32_32x32x16_bf16(pb, vf[2], o0, 0, 0, 0);
  o1 = __builtin_amdgcn_mfma_f32_32x32x16_bf16(pb, vf[3], o1, 0, 0, 0);
}
__device__ __forceinline__ void attn_unit(const Params& p, LAS char* lds, int row0, int hp, int nkeys) {
  const bf16_t* Q = (const bf16_t*)(p.ws + OFF_Q); const bf16_t* Kb = (const bf16_t*)(p.ws + OFF_K); const bf16_t* Vb = (const bf16_t*)(p.ws + OFF_V);
  bf16_t* MIX = (bf16_t*)(p.ws + OFF_MIX);
  const int tid = TIDX, wid = tid >> 6, lane = tid & 63, r32 = lane & 31, hi = lane >> 5, kvh = hp >> 1;
  bf16x8 qa[4], qb[4];
  { const bf16_t* Qg = Q + (size_t)(row0 + wid * 32 + r32) * 512 + hp * 128 + hi * 8;
#pragma unroll
    for (int d0 = 0; d0 < 4; ++d0) { qa[d0] = *(const bf16x8*)(Qg + d0 * 16); qb[d0] = *(const bf16x8*)(Qg + 64 + d0 * 16); } }
  const bf16_t* Kg = Kb + (size_t)(tid >> 3) * 128 + kvh * 64 + (tid & 7) * 8;
  const bf16_t* Vg = Vb + (size_t)(tid >> 3) * 128 + kvh * 64 + (tid & 7) * 8;
  const int kst = xoff(tid >> 3, tid & 7), vstw = 8192 + vst64(tid >> 3, (tid & 7) * 8);
  AttnCtx c; c.krd0 = r32 * 128; c.krd1 = (32 + r32) * 128; c.ksw = (r32 >> 1) & 7; c.hi = hi; c.vrd = 8192 + v_rd_base(lane);
  const int NT = nkeys >> 6;
  f32x16 oa0 = {}, oa1 = {}, ob0 = {}, ob1 = {}; float la = 0.f, lb = 0.f;
  u32x4 ks, vs;
  {
    const u32x4 k0 = *(const u32x4*)Kg, k1 = *(const u32x4*)(Kg + 64 * 128), v0 = *(const u32x4*)Vg, v1 = *(const u32x4*)(Vg + 64 * 128);
    *(LAS u32x4*)(lds + kst) = k0; *(LAS u32x4*)(lds + ATT_SLOT + kst) = k1;
    *(LAS u32x4*)(lds + vstw) = v0; *(LAS u32x4*)(lds + ATT_SLOT + vstw) = v1;
    ks = *(const u32x4*)(Kg + 2 * 64 * 128); vs = *(const u32x4*)(Vg + 2 * 64 * 128);
  }
  __syncthreads();
  for (int j = 0; j < NT; ++j) {
    const LAS char* sl = lds + (j & 3) * ATT_SLOT;
    bf16x8 kf[8], vfa[4], vfb[4];
    f32x16 sa0, sa1, sb0, sb1;
    att_kload(sl, c, kf);
    SBAR();
    att_qk(kf, qa, sa0, sa1);
    SBAR();
    att_qk(kf, qb, sb0, sb1);
    att_exp(sa0, la); att_exp(sa1, la);
    SBAR();
    const bf16x8 pa0 = pk4(sa0, 0), pa1 = pk4(sa0, 8), pa2 = pk4(sa1, 0), pa3 = pk4(sa1, 8);
    att_vload<0>(sl, c, vfa);
    SBAR();
    att_pv2(pa0, pa1, vfa, oa0, oa1);
    att_exp(sb0, lb);
    att_vload<2>(sl, c, vfb);
    SBAR();
    att_pv2(pa2, pa3, vfb, oa0, oa1);
    att_exp(sb1, lb);
    const bf16x8 pb0 = pk4(sb0, 0), pb1 = pk4(sb0, 8), pb2 = pk4(sb1, 0), pb3 = pk4(sb1, 8);
    att_vload<0>(sl, c, vfa);
    SBAR();
    att_pv2(pb0, pb1, vfa, ob0, ob1);
    att_vload<2>(sl, c, vfb);
    SBAR();
    att_pv2(pb2, pb3, vfb, ob0, ob1);
    { LAS char* w = lds + ((j + 2) & 3) * ATT_SLOT;
      if (j + 2 < NT) { *(LAS u32x4*)(w + kst) = ks; *(LAS u32x4*)(w + vstw) = vs; }
      if (j + 3 < NT) { ks = *(const u32x4*)(Kg + (size_t)(j + 3) * 64 * 128); vs = *(const u32x4*)(Vg + (size_t)(j + 3) * 64 * 128); } }
    __syncthreads();
  }
  la = sum32(la); lb = sum32(lb);
  LAS float* li = (LAS float*)(lds + wid * 256);
  if (hi == 0) { li[r32] = la; li[32 + r32] = lb; }
  __syncthreads();
  bf16_t* Og = MIX + (size_t)(row0 + wid * 32) * D + hp * 128 + r32;
#pragma unroll
  for (int r = 0; r < 16; ++r) {
    const int orow = crow(r, hi);
    const float ra = __builtin_amdgcn_rcpf(li[orow]), rb = __builtin_amdgcn_rcpf(li[32 + orow]);
    Og[(size_t)orow * D] = f2bf(oa0[r] * ra); Og[(size_t)orow * D + 32] = f2bf(oa1[r] * ra);
    Og[(size_t)orow * D + 64] = f2bf(ob0[r] * rb); Og[(size_t)orow * D + 96] = f2bf(ob1[r] * rb);
  }
  __syncthreads();
}
__device__ __forceinline__ void attn_fallback(const Params& p, int layer, int bid, int nblk) {
  const bf16_t* Q = (const bf16_t*)(p.ws + OFF_Q); const bf16_t* Kb = (const bf16_t*)(p.ws + OFF_K); const bf16_t* Vb = (const bf16_t*)(p.ws + OFF_V);
  bf16_t* MIX = (bf16_t*)(p.ws + OFF_MIX);
  const int lane = TIDX & 63, nwv = nblk * 8;
  const int rg0 = layer == 0 ? 0 : NCTX / 64;
  for (int wv = bid * 8 + (TIDX >> 6) + rg0 * 8; wv < (TT / 64) * 8; wv += nwv) {
    const int head = wv & 7, r = (wv >> 3) * 64 + lane, kvh = head >> 2;
    float q[64], o[64];
#pragma unroll
    for (int d = 0; d < 64; ++d) { q[d] = bf2f(Q[(size_t)r * 512 + head * 64 + d]); o[d] = 0.f; }
    float m = -1e30f, l = 0.f;
    const int nk = r >= NCTX ? TT : NCTX;
    for (int j = 0; j < nk; ++j) {
      const bf16_t* kr = Kb + (size_t)j * 128 + kvh * 64;
      const bf16_t* vr = Vb + (size_t)j * 128 + kvh * 64;
      float s = 0.f;
#pragma unroll
      for (int d = 0; d < 64; ++d) s += q[d] * bf2f(kr[d]);
      if (s > m) {
        const float a = __builtin_amdgcn_exp2f(m - s);
        l *= a;
#pragma unroll
        for (int d = 0; d < 64; ++d) o[d] *= a;
        m = s;
      }
      const float pe = __builtin_amdgcn_exp2f(s - m);
      l += pe;
#pragma unroll
      for (int d = 0; d < 64; ++d) o[d] += pe * bf2f(vr[d]);
    }
    const float il = 1.f / l;
#pragma unroll
    for (int d = 0; d < 64; ++d) MIX[(size_t)r * D + head * 64 + d] = f2bf(o[d] * il);
  }
}

constexpr int PC_U = 0;
constexpr int PC_Y = 49152;
constexpr int PC_LDS = PC_Y + 65536;
__device__ __forceinline__ void poolconv_unit(const Params& p, int layer, LAS char* lds, int tile) {
  const int tid = TIDX, wid = tid >> 6, lane = tid & 63, r32 = lane & 31, hi = lane >> 5;
  const int t0 = tile * 64, base = tile < 4 ? 0 : NCTX, n = tile < 4 ? NCTX : SEQ;
  const bf16_t* AG = (const bf16_t*)(p.ws + OFF_AG);
  const float* U = (const float*)(p.ws + OFF_U);
  bf16_t* MIX = (bf16_t*)(p.ws + OFF_MIX);
  for (int idx = tid; idx < 94 * 32; idx += 512) {
    const int rr = idx >> 5, ch = (idx & 31) * 8, t = t0 - 15 + rr;
    u32x4 out = {0u, 0u, 0u, 0u};
    if (t >= base && t < base + n) {
      const u32x4 av = *(const u32x4*)(AG + (size_t)t * 512 + ch), gv = *(const u32x4*)(AG + (size_t)t * 512 + 256 + ch);
#pragma unroll
      for (int i = 0; i < 4; ++i) {
        const float a0 = __uint_as_float(av[i] << 16), a1 = __uint_as_float(av[i] & 0xffff0000u);
        const float g0 = __uint_as_float(gv[i] << 16), g1 = __uint_as_float(gv[i] & 0xffff0000u);
        out[i] = cvtpk(a0 / (1.f + __expf(-g0)), a1 / (1.f + __expf(-g1)));
      }
    }
    *(LAS u32x4*)(lds + PC_U + (rr * 256 + ch) * 2) = out;
  }
  __syncthreads();
  {
    const int c = tid & 255, th = tid >> 8;
    float w[31];
#pragma unroll
    for (int j = 0; j < 31; ++j) w[j] = p.w_dw[(size_t)layer * 31 * 256 + j * 256 + c];
    const float b = p.b_dw[layer * 256 + c];
    float acc[32];
#pragma unroll
    for (int i = 0; i < 32; ++i) acc[i] = b;
    const LAS bf16_t* up = (const LAS bf16_t*)(lds + PC_U) + (th * 32) * 256 + c;
#pragma unroll
    for (int rr = 0; rr < 62; ++rr) {
      const float uv = bf2f(up[rr * 256]);
#pragma unroll
      for (int i = 0; i < 32; ++i) if (rr - i >= 0 && rr - i < 31) acc[i] += uv * w[rr - i];
    }
    LAS float* yp = (LAS float*)(lds + PC_Y) + (th * 32) * 256 + c;
#pragma unroll
    for (int i = 0; i < 32; ++i) yp[i * 256] = acc[i];
  }
  __syncthreads();
  {
    const f32x4 g4 = *(const f32x4*)(p.cv_ln_g + layer * 256 + lane * 4), b4 = *(const f32x4*)(p.cv_ln_b + layer * 256 + lane * 4);
#pragma unroll
    for (int i = 0; i < 8; ++i) {
      const int tok = wid * 8 + i;
      const f32x4 y = *(const LAS f32x4*)(lds + PC_Y + (tok * 256 + lane * 4) * 4);
      const float mu = wave_sum(y[0] + y[1] + y[2] + y[3]) * (1.f / 256.f);
      const float d0 = y[0] - mu, d1 = y[1] - mu, d2 = y[2] - mu, d3 = y[3] - mu;
      const float rs = rsqrtf(wave_sum(d0 * d0 + d1 * d1 + d2 * d2 + d3 * d3) * (1.f / 256.f) + EPS);
      const float z0 = silu(d0 * rs * g4[0] + b4[0]), z1 = silu(d1 * rs * g4[1] + b4[1]), z2 = silu(d2 * rs * g4[2] + b4[2]), z3 = silu(d3 * rs * g4[3] + b4[3]);
      const int chunk = lane >> 1, sw = (chunk & 16) | ((chunk ^ tok) & 15);
      *(LAS u32x2*)(lds + PC_U + tok * 512 + sw * 16 + (lane & 1) * 8) = (u32x2){cvtpk(z0, z1), cvtpk(z2, z3)};
    }
  }
  __syncthreads();
  {
    const int tb = wid >> 2, dg = wid & 3, trow = tb * 32 + r32, t = t0 + trow;
    const bf16_t* Wt = (const bf16_t*)(p.ws + OFF_WPWT) + ((size_t)layer * 256 + dg * 64 + r32) * 256 + hi * 8;
    f32x16 acc0 = {}, acc1 = {};
#pragma unroll 4
    for (int ks = 0; ks < 16; ++ks) {
      const int chunk = 2 * ks + hi, sw = (chunk & 16) | ((chunk ^ trow) & 15);
      const bf16x8 zf = *(const LAS bf16x8*)(lds + PC_U + trow * 512 + sw * 16);
      const bf16x8 w0 = *(const bf16x8*)(Wt + ks * 16), w1 = *(const bf16x8*)(Wt + 32 * 256 + ks * 16);
      acc0 = __builtin_amdgcn_mfma_f32_32x32x16_bf16(w0, zf, acc0, 0, 0, 0);
      acc1 = __builtin_amdgcn_mfma_f32_32x32x16_bf16(w1, zf, acc1, 0, 0, 0);
    }
    bf16_t* dst = MIX + (size_t)t * D + 768 + dg * 64;
#pragma unroll
    for (int g = 0; g < 4; ++g) { *(u32x2*)(dst + 8 * g + 4 * hi) = pack4(acc0, g); *(u32x2*)(dst + 32 + 8 * g + 4 * hi) = pack4(acc1, g); }
    const int w = 2 << dg, tl = t - base, lo = max(tl - w / 2, 0), hh = min(tl + w / 2, n);
    const float inv = 1.f / (float)(hh - lo);
    const bf16_t* Pt = (const bf16_t*)(p.ws + OFF_WPOOLT) + ((size_t)(layer * 4 + dg) * 64 + r32) * 64 + hi * 8;
    f32x16 pc0 = {}, pc1 = {};
#pragma unroll
    for (int ks = 0; ks < 4; ++ks) {
      const int c0 = dg * 64 + ks * 16 + hi * 8;
      f32x4 s0 = {0.f, 0.f, 0.f, 0.f}, s1 = {0.f, 0.f, 0.f, 0.f};
      for (int rr = lo; rr < hh; ++rr) { const float* ur = U + (size_t)(base + rr) * 256 + c0; s0 += *(const f32x4*)ur; s1 += *(const f32x4*)(ur + 4); }
      const float* uo = U + (size_t)t * 256 + c0;
      const f32x4 o0 = *(const f32x4*)uo, o1 = *(const f32x4*)(uo + 4);
      s0 = s0 * inv - o0; s1 = s1 * inv - o1;
      u32x4 pw = {cvtpk(s0[0], s0[1]), cvtpk(s0[2], s0[3]), cvtpk(s1[0], s1[1]), cvtpk(s1[2], s1[3])};
      const bf16x8 pf = __builtin_bit_cast(bf16x8, pw);
      const bf16x8 w0 = *(const bf16x8*)(Pt + ks * 16), w1 = *(const bf16x8*)(Pt + 32 * 64 + ks * 16);
      pc0 = __builtin_amdgcn_mfma_f32_32x32x16_bf16(w0, pf, pc0, 0, 0, 0);
      pc1 = __builtin_amdgcn_mfma_f32_32x32x16_bf16(w1, pf, pc1, 0, 0, 0);
    }
    const float* psc = p.pool_scale + layer * 256 + dg * 64;
#pragma unroll
    for (int r = 0; r < 16; ++r) { pc0[r] *= psc[crow(r, hi)]; pc1[r] *= psc[32 + crow(r, hi)]; }
    bf16_t* pd = MIX + (size_t)t * D + 512 + dg * 64;
#pragma unroll
    for (int g = 0; g < 4; ++g) { *(u32x2*)(pd + 8 * g + 4 * hi) = pack4(pc0, g); *(u32x2*)(pd + 32 + 8 * g + 4 * hi) = pack4(pc1, g); }
  }
  __syncthreads();
}

__device__ __forceinline__ void phase_b(const Params& p, int layer, LAS char* lds, int bid, int nblk) {
  const bool fast = ((const int*)(p.ws + OFF_FLAG))[0] != 0;
  for (int u = bid; u < 520; u += nblk) {
    if (u < 256) { if (fast) attn_unit(p, lds, NCTX + (u >> 2) * 256, u & 3, TT); }
    else if (u < 260) { if (fast && layer == 0) attn_unit(p, lds, 0, u - 256, NCTX); }
    else { const int tile = u - 260; if (layer == 0 || tile >= 4) poolconv_unit(p, layer, lds, tile); }
  }
  if (!fast) attn_fallback(p, layer, bid, nblk);
}

constexpr int NR = 2;
__device__ __forceinline__ float hsum4(const f32x4 (&v)[4]) { float s = 0.f;
#pragma unroll
  for (int i = 0; i < 4; ++i) s += (v[i][0] + v[i][1]) + (v[i][2] + v[i][3]);
  return s; }
__device__ __forceinline__ float hsq4(const f32x4 (&v)[4], float mu) { float q = 0.f;
#pragma unroll
  for (int i = 0; i < 4; ++i) { const f32x4 d = v[i] - mu; q += (d[0] * d[0] + d[1] * d[1]) + (d[2] * d[2] + d[3] * d[3]); }
  return q; }
__device__ __forceinline__ f32x4 bf4(u32x2 w) { return (f32x4){__uint_as_float(w[0] << 16), __uint_as_float(w[0] & 0xffff0000u), __uint_as_float(w[1] << 16), __uint_as_float(w[1] & 0xffff0000u)}; }

__device__ __forceinline__ void phase_a0(const Params& p, int layer, int bid, int nblk) {
  const int wave = bid * 8 + (TIDX >> 6), lane = TIDX & 63, nw = nblk * 8;
  float* X = (float*)(p.ws + OFF_X);
  bf16_t* H = (bf16_t*)(p.ws + OFF_H);
  const bf16_t* OM = (const bf16_t*)(p.ws + OFF_OMOE);
  for (int rb = wave * NR; rb < TT; rb += nw * NR) {
    f32x4 v[NR][4]; u32x2 oa[NR][4], ob[NR][4];
#pragma unroll
    for (int k = 0; k < NR; ++k) {
      const int r = rb + k;
      const float* src = layer == 0 ? (r < NCTX ? p.ctx + (size_t)r * D : p.x + (size_t)(r - NCTX) * D) : X + (size_t)r * D;
#pragma unroll
      for (int i = 0; i < 4; ++i) { const int c = i * 256 + lane * 4; v[k][i] = *(const f32x4*)(src + c);
        if (layer != 0) { oa[k][i] = *(const u32x2*)(OM + ((size_t)r * 2 + 0) * D + c); ob[k][i] = *(const u32x2*)(OM + ((size_t)r * 2 + 1) * D + c); } }
    }
    if (layer != 0) {
#pragma unroll
      for (int k = 0; k < NR; ++k) {
        const int r = rb + k, s = r < NCTX ? 1 : 0;
        const float* g2 = (const float*)(p.ws + OFF_MOD) + ((layer - 1) * 2 + s) * 6144 + 5 * D;
#pragma unroll
        for (int i = 0; i < 4; ++i) { const int c = i * 256 + lane * 4; v[k][i] = v[k][i] * ALPHA + *(const f32x4*)(g2 + c) * (bf4(oa[k][i]) + bf4(ob[k][i])); }
      }
      float mu[NR], rs[NR];
#pragma unroll
      for (int k = 0; k < NR; ++k) mu[k] = wave_sum(hsum4(v[k])) * (1.f / D);
#pragma unroll
      for (int k = 0; k < NR; ++k) rs[k] = rsqrtf(wave_sum(hsq4(v[k], mu[k])) * (1.f / D) + EPS);
      const float* g = p.ln2_g + (layer - 1) * D; const float* b = p.ln2_b + (layer - 1) * D;
#pragma unroll
      for (int k = 0; k < NR; ++k)
#pragma unroll
        for (int i = 0; i < 4; ++i) { const int c = i * 256 + lane * 4; v[k][i] = (v[k][i] - mu[k]) * rs[k] * *(const f32x4*)(g + c) + *(const f32x4*)(b + c); *(f32x4*)(X + (size_t)(rb + k) * D + c) = v[k][i]; }
    }
    float mu[NR], rs[NR];
#pragma unroll
    for (int k = 0; k < NR; ++k) mu[k] = wave_sum(hsum4(v[k])) * (1.f / D);
#pragma unroll
    for (int k = 0; k < NR; ++k) rs[k] = rsqrtf(wave_sum(hsq4(v[k], mu[k])) * (1.f / D) + EPS);
#pragma unroll
    for (int k = 0; k < NR; ++k) {
      const int r = rb + k, s = r < NCTX ? 1 : 0;
      const float* modp = (const float*)(p.ws + OFF_MOD) + (layer * 2 + s) * 6144;
#pragma unroll
      for (int i = 0; i < 4; ++i) {
        const int c = i * 256 + lane * 4;
        const f32x4 h = (v[k][i] - mu[k]) * rs[k] * (*(const f32x4*)(modp + D + c) + 1.f) + *(const f32x4*)(modp + c);
        *(u32x2*)(H + (size_t)r * D + c) = (u32x2){cvtpk(h[0], h[1]), cvtpk(h[2], h[3])};
      }
    }
  }
}

__device__ __forceinline__ void phase_c2(const Params& p, int layer, LAS char* lds, int bid, int nblk) {
  const int tid = TIDX, wid = tid >> 6, lane = tid & 63;
  float* X = (float*)(p.ws + OFF_X);
  const bf16_t* Y = (const bf16_t*)(p.ws + OFF_Y);
  bf16_t* H2 = (bf16_t*)(p.ws + OFF_MIX);
  int* cnt = (int*)(p.ws + OFF_CNT) + layer * NE * CNT_STRIDE;
  float* GATE = (float*)(p.ws + OFF_GATE); int* LIST = (int*)(p.ws + OFF_LIST);
  LAS int* lcnt = (LAS int*)lds;
  LAS int* lbase = lcnt + 32;
  LAS int* ent = lcnt + 64;
  if (tid < 32) lcnt[tid] = 0;
  __syncthreads();
  const int r0 = layer == 0 ? 0 : NCTX, nrows = TT - r0, rpb = (nrows + nblk - 1) / nblk;
  const int rbeg = r0 + bid * rpb, rend = min(rbeg + rpb, TT);
  for (int rb = rbeg + wid * NR; rb < rend; rb += 8 * NR) {
    f32x4 v[NR][4]; u32x2 yv[NR][4]; int rr[NR]; bool ok[NR];
#pragma unroll
    for (int k = 0; k < NR; ++k) {
      ok[k] = rb + k < rend; rr[k] = ok[k] ? rb + k : rb;
      const int r = rr[k];
      const float* xin = layer == 0 ? (r < NCTX ? p.ctx + (size_t)r * D : p.x + (size_t)(r - NCTX) * D) : X + (size_t)r * D;
#pragma unroll
      for (int i = 0; i < 4; ++i) { const int c = i * 256 + lane * 4; v[k][i] = *(const f32x4*)(xin + c); yv[k][i] = *(const u32x2*)(Y + (size_t)r * D + c); }
    }
#pragma unroll
    for (int k = 0; k < NR; ++k) {
      const float* modp = (const float*)(p.ws + OFF_MOD) + (layer * 2 + (rr[k] < NCTX ? 1 : 0)) * 6144;
#pragma unroll
      for (int i = 0; i < 4; ++i) { const int c = i * 256 + lane * 4; v[k][i] = v[k][i] * ALPHA + *(const f32x4*)(modp + 2 * D + c) * bf4(yv[k][i]); }
    }
    float mu[NR], rs[NR];
#pragma unroll
    for (int k = 0; k < NR; ++k) mu[k] = wave_sum(hsum4(v[k])) * (1.f / D);
#pragma unroll
    for (int k = 0; k < NR; ++k) rs[k] = rsqrtf(wave_sum(hsq4(v[k], mu[k])) * (1.f / D) + EPS);
#pragma unroll
    for (int k = 0; k < NR; ++k)
#pragma unroll
      for (int i = 0; i < 4; ++i) {
        const int c = i * 256 + lane * 4;
        v[k][i] = (v[k][i] - mu[k]) * rs[k] * *(const f32x4*)(p.ln1_g + layer * D + c) + *(const f32x4*)(p.ln1_b + layer * D + c);
        if (ok[k]) *(f32x4*)(X + (size_t)rr[k] * D + c) = v[k][i];
      }
#pragma unroll
    for (int k = 0; k < NR; ++k) mu[k] = wave_sum(hsum4(v[k])) * (1.f / D);
#pragma unroll
    for (int k = 0; k < NR; ++k) rs[k] = rsqrtf(wave_sum(hsq4(v[k], mu[k])) * (1.f / D) + EPS);
#pragma unroll
    for (int k = 0; k < NR; ++k) {
      const float* modp = (const float*)(p.ws + OFF_MOD) + (layer * 2 + (rr[k] < NCTX ? 1 : 0)) * 6144;
#pragma unroll
      for (int i = 0; i < 4; ++i) {
        const int c = i * 256 + lane * 4;
        v[k][i] = (v[k][i] - mu[k]) * rs[k] * (*(const f32x4*)(modp + 4 * D + c) + 1.f) + *(const f32x4*)(modp + 3 * D + c);
        if (ok[k]) *(u32x2*)(H2 + (size_t)rr[k] * D + c) = (u32x2){cvtpk(v[k][i][0], v[k][i][1]), cvtpk(v[k][i][2], v[k][i][3])};
      }
    }
    f32x4 lg[NR];
#pragma unroll
    for (int k = 0; k < NR; ++k) lg[k] = (f32x4){0.f, 0.f, 0.f, 0.f};
#pragma unroll
    for (int i = 0; i < 4; ++i)
#pragma unroll
      for (int j = 0; j < 4; ++j) { const f32x4 w = *(const f32x4*)(p.w_rg + ((size_t)layer * D + i * 256 + lane * 4 + j) * 4);
#pragma unroll
        for (int k = 0; k < NR; ++k) lg[k] += w * v[k][i][j]; }
    int gsel[NR]; float pgrp[NR];
#pragma unroll
    for (int k = 0; k < NR; ++k) {
      float l0 = wave_sum(lg[k][0]) + p.b_rg[layer * 4 + 0], l1 = wave_sum(lg[k][1]) + p.b_rg[layer * 4 + 1];
      float l2 = wave_sum(lg[k][2]) + p.b_rg[layer * 4 + 2], l3 = wave_sum(lg[k][3]) + p.b_rg[layer * 4 + 3];
      int gs = 0; float gm = l0;
      if (l1 > gm) { gm = l1; gs = 1; }
      if (l2 > gm) { gm = l2; gs = 2; }
      if (l3 > gm) { gm = l3; gs = 3; }
      gsel[k] = gs; pgrp[k] = 1.f / (__expf(l0 - gm) + __expf(l1 - gm) + __expf(l2 - gm) + __expf(l3 - gm));
    }
#pragma unroll
    for (int k = 0; k < NR; ++k) {
      f32x4 ea = {0.f, 0.f, 0.f, 0.f}, eb = {0.f, 0.f, 0.f, 0.f};
#pragma unroll
      for (int i = 0; i < 4; ++i)
#pragma unroll
        for (int j = 0; j < 4; ++j) {
          const float* wr = p.w_re + ((size_t)layer * D + i * 256 + lane * 4 + j) * 32 + gsel[k] * 8;
          ea += *(const f32x4*)wr * v[k][i][j]; eb += *(const f32x4*)(wr + 4) * v[k][i][j];
        }
      float le[8];
#pragma unroll
      for (int e = 0; e < 4; ++e) { le[e] = wave_sum(ea[e]) + p.b_re[layer * 32 + gsel[k] * 8 + e]; le[4 + e] = wave_sum(eb[e]) + p.b_re[layer * 32 + gsel[k] * 8 + 4 + e]; }
      int i0 = 0; float v0 = le[0];
#pragma unroll
      for (int e = 1; e < 8; ++e) if (le[e] > v0) { v0 = le[e]; i0 = e; }
      int i1 = -1; float v1 = -3.0e38f;
#pragma unroll
      for (int e = 0; e < 8; ++e) if (e != i0 && le[e] > v1) { v1 = le[e]; i1 = e; }
      if (i1 < 0) { i1 = (i0 + 1) & 7; v1 = v0; }
      const float e1 = __expf(v1 - v0);
      if (lane == 0 && ok[k]) {
        const int r = rr[k], xa = gsel[k] * 8 + i0, xb = gsel[k] * 8 + i1;
        const int pa = __hip_atomic_fetch_add(&lcnt[xa], 1, __ATOMIC_RELAXED, __HIP_MEMORY_SCOPE_WORKGROUP);
        const int pb = __hip_atomic_fetch_add(&lcnt[xb], 1, __ATOMIC_RELAXED, __HIP_MEMORY_SCOPE_WORKGROUP);
        const int li = (r - rbeg) * 2;
        ent[li * 3 + 0] = xa; ent[li * 3 + 1] = pa; ent[li * 3 + 2] = r * 2 + 0;
        ent[li * 3 + 3] = xb; ent[li * 3 + 4] = pb; ent[li * 3 + 5] = r * 2 + 1;
        GATE[r * 2] = pgrp[k] / (1.f + e1); GATE[r * 2 + 1] = pgrp[k] * e1 / (1.f + e1);
      }
    }
  }
  __syncthreads();
  if (tid < 32) { const int c = lcnt[tid]; lbase[tid] = c > 0 ? atomicAdd(&cnt[tid * CNT_STRIDE], c) : 0; }
  __syncthreads();
  for (int i = tid; i < (rend - rbeg) * 2; i += 512) { const int e = ent[i * 3], lp = ent[i * 3 + 1]; LIST[(size_t)e * CAPL + lbase[e] + lp] = ent[i * 3 + 2]; }
  __syncthreads();
}

__device__ __forceinline__ void phase_final(const Params& p, int bid, int nblk) {
  const int wave = bid * 8 + (TIDX >> 6), lane = TIDX & 63, nw = nblk * 8;
  const float* X = (const float*)(p.ws + OFF_X);
  const bf16_t* OM = (const bf16_t*)(p.ws + OFF_OMOE);
  const float* g2 = (const float*)(p.ws + OFF_MOD) + (1 * 2 + 0) * 6144 + 5 * D;
  for (int rb = NCTX + wave * NR; rb < TT; rb += nw * NR) {
    f32x4 v[NR][4]; u32x2 oa[NR][4], ob[NR][4];
#pragma unroll
    for (int k = 0; k < NR; ++k)
#pragma unroll
      for (int i = 0; i < 4; ++i) { const int c = i * 256 + lane * 4, r = rb + k;
        v[k][i] = *(const f32x4*)(X + (size_t)r * D + c); oa[k][i] = *(const u32x2*)(OM + ((size_t)r * 2 + 0) * D + c); ob[k][i] = *(const u32x2*)(OM + ((size_t)r * 2 + 1) * D + c); }
#pragma unroll
    for (int k = 0; k < NR; ++k)
#pragma unroll
      for (int i = 0; i < 4; ++i) { const int c = i * 256 + lane * 4; v[k][i] = v[k][i] * ALPHA + *(const f32x4*)(g2 + c) * (bf4(oa[k][i]) + bf4(ob[k][i])); }
    float mu[NR], rs[NR];
#pragma unroll
    for (int k = 0; k < NR; ++k) mu[k] = wave_sum(hsum4(v[k])) * (1.f / D);
#pragma unroll
    for (int k = 0; k < NR; ++k) rs[k] = rsqrtf(wave_sum(hsq4(v[k], mu[k])) * (1.f / D) + EPS);
#pragma unroll
    for (int k = 0; k < NR; ++k)
#pragma unroll
      for (int i = 0; i < 4; ++i) {
        const int c = i * 256 + lane * 4;
        *(f32x4*)(p.out + (size_t)(rb + k - NCTX) * D + c) = (v[k][i] - mu[k]) * rs[k] * *(const f32x4*)(p.ln2_g + D + c) + *(const f32x4*)(p.ln2_b + D + c);
      }
  }
}

__device__ __forceinline__ void phase_p0(const Params& p, LAS char* lds, int bid, int nblk) {
  const int tid = TIDX;
  const long gtid = (long)bid * 512 + tid, gth = (long)nblk * 512;
  LAS float* sc = (LAS float*)lds;
  LAS float* red = (LAS float*)(lds + 8192);
  for (int i = tid; i < 2048; i += 512) { const float v = i < 1024 ? p.c[i] : p.c_ctx[i - 1024]; sc[i] = silu(v); }
  __syncthreads();
  float* mod = (float*)(p.ws + OFF_MOD);
  for (int u = bid; u < 384; u += nblk) {
    const int layer = u / 192, cg = u % 192, col = tid & 31, ksl = tid >> 5;
    const float* w = p.w_mod + ((size_t)layer * D + ksl * 64) * 6144 + cg * 32 + col;
    float a0 = 0.f, a1 = 0.f;
#pragma unroll 8
    for (int k = 0; k < 64; ++k) { const float wv = w[(size_t)k * 6144]; a0 += sc[ksl * 64 + k] * wv; a1 += sc[1024 + ksl * 64 + k] * wv; }
    red[(ksl * 32 + col) * 2] = a0; red[(ksl * 32 + col) * 2 + 1] = a1;
    __syncthreads();
    if (tid < 64) {
      const int c2 = tid & 31, s = tid >> 5; float a = 0.f;
#pragma unroll
      for (int k = 0; k < 16; ++k) a += red[(k * 32 + c2) * 2 + s];
      mod[(layer * 2 + s) * 6144 + cg * 32 + c2] = a + p.b_mod[layer * 6144 + cg * 32 + c2];
    }
    __syncthreads();
  }
  if (gtid < 256 * 16) {
    const int pos = (int)gtid / 16, f = (int)gtid % 16;
    const float ang = (float)pos * powf(10000.f, -(float)f / 16.f);
    float* rt = (float*)(p.ws + OFF_ROPE);
    rt[gtid * 2 + 0] = cosf(ang); rt[gtid * 2 + 1] = sinf(ang);
  }
  if (gtid < 2 * NE * CNT_STRIDE) ((int*)(p.ws + OFF_CNT))[gtid] = 0;
  if (gtid == 0) {
    float bmax = 0.f;
    for (int l = 0; l < 2; ++l) {
      float gq = 0.f, gk = 0.f;
      for (int i = 0; i < 64; ++i) { gq = fmaxf(gq, fabsf(p.q_gain[l * 64 + i])); gk = fmaxf(gk, fabsf(p.k_gain[l * 64 + i])); }
      bmax = fmaxf(bmax, 11.55f * gq * gk);
    }
    ((int*)(p.ws + OFF_FLAG))[0] = (bmax <= 100.f) ? 1 : 0;
  }
  for (long i = gtid; i < 2 * 65536; i += gth) { const int l = (int)(i >> 16), d = (int)(i >> 8) & 255, c = (int)i & 255; ((bf16_t*)(p.ws + OFF_WPWT))[i] = f2bf(p.w_cv_pw[((size_t)l * 256 + c) * 256 + d]); }
  for (long i = gtid; i < 8 * 4096; i += gth) { const int lg = (int)(i >> 12), d = (int)(i >> 6) & 63, c = (int)i & 63; ((bf16_t*)(p.ws + OFF_WPOOLT))[i] = f2bf(p.w_pool[((size_t)lg * 64 + c) * 64 + d]); }
  cvt_range(p.w_in, (bf16_t*)(p.ws + OFF_WIN), 2L * D * INW / 8, gtid, gth);
  cvt_range(p.w_out, (bf16_t*)(p.ws + OFF_WOUT), 2L * D * D / 8, gtid, gth);
  cvt_range(p.w_e_gate, (bf16_t*)(p.ws + OFF_WG), 2L * NE * D * DE / 8, gtid, gth);
  cvt_range(p.w_e_up, (bf16_t*)(p.ws + OFF_WU), 2L * NE * D * DE / 8, gtid, gth);
  cvt_range(p.w_e_down, (bf16_t*)(p.ws + OFF_WD), 2L * NE * D * DE / 8, gtid, gth);
}
#define XB_TMO      128
#define XB_XCNT(j)  (256  + 64 * (j))
#define XB_XSUB(j)  (1280 + 64 * (j))
#define XB_XGEN(j)  (2304 + 64 * (j))
#define XB_TOP      3328
#define XB_TOPGEN   3392
#define XCD_BAR_WORDS 3456
#define XB_SPIN_CAP (1u << 22)
__device__ __forceinline__ unsigned xb_ld(unsigned* p)              { return __hip_atomic_load(p, __ATOMIC_RELAXED, __HIP_MEMORY_SCOPE_AGENT); }
__device__ __forceinline__ unsigned xb_add(unsigned* p, unsigned v) { return __hip_atomic_fetch_add(p, v, __ATOMIC_RELAXED, __HIP_MEMORY_SCOPE_AGENT); }
__device__ __forceinline__ unsigned xb_xcc_id() { return (unsigned)__builtin_amdgcn_s_getreg((3 << 11) | 20) & 0xFu; }
#define XB_SPIN(cond, bar) do { unsigned _sp = 0; while (cond) { __builtin_amdgcn_s_sleep(1); \
    if ((++_sp & 255u) == 0u) { if (xb_ld(&(bar)[XB_TMO])) break; if (_sp > XB_SPIN_CAP) { atomicAdd(&(bar)[XB_TMO], 1u); break; } } } } while (0)
struct XcdBarrier { unsigned* bar; unsigned x; volatile LAS unsigned* st; };
__device__ __forceinline__ XcdBarrier xcd_barrier_post(unsigned* bar, volatile LAS unsigned* st) {
  XcdBarrier b; b.bar = bar; b.x = xb_xcc_id(); b.st = st;
  if (threadIdx.x == 0) (void)xb_add(&bar[XB_XCNT(b.x)], 1u);
  return b;
}
__device__ __forceinline__ void xcd_barrier_complete(unsigned* bar, unsigned x, unsigned& nloc, unsigned& nx) {
  const unsigned G = gridDim.x * gridDim.y * gridDim.z;
  unsigned sum, cnt, mine, sp = 0u;
  for (;;) {
    sum = 0u; cnt = 0u; mine = 0u;
#pragma unroll
    for (unsigned j = 0; j < 16; ++j) { const unsigned c = xb_ld(&bar[XB_XCNT(j)]); sum += c; cnt += (c > 0u) ? 1u : 0u; mine = (j == x) ? c : mine; }
    if (sum == G) break;
    __builtin_amdgcn_s_sleep(1);
    if ((++sp & 255u) == 0u) { if (xb_ld(&bar[XB_TMO])) break; if (sp > XB_SPIN_CAP) { atomicAdd(&bar[XB_TMO], 1u); break; } }
  }
  nloc = mine > 0u ? mine : 1u; nx = cnt > 0u ? cnt : 1u;
}
__device__ __forceinline__ void xcd_barrier(const XcdBarrier& b) {
  asm volatile("s_waitcnt vmcnt(0)" ::: "memory");
  __syncthreads();
  if (threadIdx.x == 0) {
    unsigned* bar = b.bar;
    __builtin_amdgcn_s_waitcnt(0);
    unsigned nloc = b.st[0], nx = b.st[1];
    if (nloc == 0u) { xcd_barrier_complete(bar, b.x, nloc, nx); b.st[0] = nloc; b.st[1] = nx; }
    const unsigned old = xb_add(&bar[XB_XSUB(b.x)], 1u);
    const unsigned gen = old / nloc;
    if (old + 1u == (gen + 1u) * nloc) {
      __builtin_amdgcn_fence(__ATOMIC_RELEASE, "agent");
      asm volatile("s_waitcnt vmcnt(0)" ::: "memory");
      const unsigned og = xb_add(&bar[XB_TOP], 1u);
      const unsigned tg = og / nx;
      if (og + 1u == (tg + 1u) * nx) xb_add(&bar[XB_TOPGEN], 1u);
      else XB_SPIN(xb_ld(&bar[XB_TOPGEN]) == tg, bar);
      __builtin_amdgcn_fence(__ATOMIC_ACQUIRE, "agent");
      xb_add(&bar[XB_XGEN(b.x)], 1u);
      asm volatile("s_waitcnt vmcnt(0)" ::: "memory");
    } else {
      XB_SPIN(xb_ld(&bar[XB_XGEN(b.x)]) == gen, bar);
      __builtin_amdgcn_fence(__ATOMIC_ACQUIRE, "agent");
      asm volatile("s_waitcnt vmcnt(0)" ::: "memory");
    }
  }
  __syncthreads();
}

constexpr int LDS_MAIN = PC_LDS > GEMM_LDS + 256 ? PC_LDS : GEMM_LDS + 256;
constexpr int LDS_TOTAL = LDS_MAIN + 16;
static_assert(GEMM_LDS + 256 <= LDS_MAIN && ATT_LDS <= LDS_MAIN, "lds");
__global__ void __launch_bounds__(512) mega_fwd(Params p) {
  __shared__ __attribute__((aligned(16))) char slds[LDS_TOTAL];
  LAS char* lds = (LAS char*)slds;
  volatile LAS unsigned* st = (volatile LAS unsigned*)(lds + LDS_MAIN);
  if (threadIdx.x < 4) st[threadIdx.x] = 0u;
  __syncthreads();
  const XcdBarrier bar = xcd_barrier_post((unsigned*)(p.ws + OFF_BAR), st);
  const int bid = blockIdx.x, nblk = gridDim.x;
  phase_p0(p, lds, bid, nblk);
  xcd_barrier(bar);
#pragma unroll 1
  for (int layer = 0; layer < 2; ++layer) {
    phase_a0(p, layer, bid, nblk);
    xcd_barrier(bar);
    phase_a1(p, layer, lds, bid, nblk);
    xcd_barrier(bar);
    phase_b(p, layer, lds, bid, nblk);
    xcd_barrier(bar);
    phase_c1(p, layer, lds, bid, nblk);
    xcd_barrier(bar);
    phase_c2(p, layer, lds, bid, nblk);
    xcd_barrier(bar);
    phase_d1(p, layer, lds, bid, nblk);
    xcd_barrier(bar);
    phase_d2(p, layer, lds, bid, nblk);
    xcd_barrier(bar);
  }
  phase_final(p, bid, nblk);
}

extern "C" void kernel_launch(void* const* d_in, const int* in_sizes, int n_in, void* d_out, int out_size, void* d_ws, size_t ws_size,
                              hipStream_t stream) {
  static int grid = 0;
  if (grid == 0) {
    if (ws_size < WS_END || n_in != 28) { fprintf(stderr, "kernel_launch: ws too small (%zu < %zu) or n_in %d != 28; nothing launched\n", ws_size, (size_t)WS_END, n_in); grid = -1; return; }
    int dev = 0, cus = 0, per_cu = 0;
    if (hipGetDevice(&dev) != hipSuccess || hipDeviceGetAttribute(&cus, hipDeviceAttributeMultiprocessorCount, dev) != hipSuccess) { grid = -1; return; }
    if (hipOccupancyMaxActiveBlocksPerMultiprocessor(&per_cu, (const void*)mega_fwd, 512, 0) != hipSuccess || per_cu < 1) {
      fprintf(stderr, "kernel_launch: occupancy query says %d blocks per CU; nothing launched\n", per_cu); grid = -1; return; }
    (void)hipGetLastError();
    grid = cus;
  }
  if (grid < 0) return;
  if (hipMemsetAsync((char*)d_ws + OFF_BAR, 0, BAR_BYTES, stream) != hipSuccess) { fprintf(stderr, "kernel_launch: memset failed\n"); return; }
  Params p{};
  const float** f = (const float**)&p;
  for (int i = 0; i < 28; ++i) f[i] = (const float*)d_in[i];
  p.out = (float*)d_out; p.ws = (char*)d_ws;
  hipLaunchKernelGGL(mega_fwd, dim3(grid), dim3(512), 0, stream, p);
}
```

```cpp
#include <hip/hip_runtime.h>
#include <cstdio>
#include <cstdint>

typedef unsigned short bf16_t;
#define LAS __attribute__((address_space(3)))

constexpr int D = 1024, SEQ = 16384, NCTX = 256, TT = SEQ + NCTX;
constexpr int INW = 1536;
constexpr int NE = 32, DE = 512;
constexpr int CAPL = 2 * TT;
constexpr int HMID_ROWS = 2 * TT + NE * 128;
constexpr float ALPHA = 1.41421356237309515f;
constexpr float EPS = 1e-6f;

constexpr size_t al(size_t x) { return (x + 255) / 256 * 256; }
constexpr size_t OFF_BAR = 0;
constexpr size_t BAR_BYTES = 3456 * 4;
constexpr size_t OFF_MOD = OFF_BAR + al(BAR_BYTES);
constexpr size_t OFF_ROPE = OFF_MOD + al(2 * 2 * 6144 * 4);
constexpr int CNT_STRIDE = 32;
constexpr size_t OFF_CNT = OFF_ROPE + al(256 * 16 * 2 * 4);
constexpr size_t OFF_FLAG = OFF_CNT + al(2 * 32 * 32 * 4);
constexpr size_t OFF_X = OFF_FLAG + 256;
constexpr size_t OFF_H = OFF_X + al((size_t)TT * D * 4);
constexpr size_t OFF_MIX = OFF_H + al((size_t)TT * D * 2);
constexpr size_t OFF_Y = OFF_MIX + al((size_t)TT * D * 2);
constexpr size_t OFF_Q = OFF_Y + al((size_t)TT * D * 2);
constexpr size_t OFF_K = OFF_Q + al((size_t)TT * 512 * 2);
constexpr size_t OFF_V = OFF_K + al((size_t)TT * 128 * 2);
constexpr size_t OFF_U = OFF_V + al((size_t)TT * 128 * 2);
constexpr size_t OFF_AG = OFF_U + al((size_t)TT * 256 * 4);
constexpr size_t OFF_HMID = OFF_Q;
constexpr size_t OFF_OMOE = OFF_AG + al((size_t)TT * 512 * 2);
constexpr size_t OFF_GATE = OFF_OMOE + al((size_t)TT * 2 * D * 2);
constexpr size_t OFF_LIST = OFF_GATE + al((size_t)TT * 2 * 4);
constexpr size_t OFF_WIN = OFF_LIST + al((size_t)NE * CAPL * 4);
constexpr size_t OFF_WOUT = OFF_WIN + al((size_t)2 * D * INW * 2);
constexpr size_t OFF_WPWT = OFF_WOUT + al((size_t)2 * D * D * 2);
constexpr size_t OFF_WPOOLT = OFF_WPWT + al((size_t)2 * 256 * 256 * 2);
constexpr size_t OFF_WG = OFF_WPOOLT + al((size_t)2 * 4 * 64 * 64 * 2);
constexpr size_t OFF_WU = OFF_WG + al((size_t)2 * NE * D * DE * 2);
constexpr size_t OFF_WD = OFF_WU + al((size_t)2 * NE * D * DE * 2);
constexpr size_t WS_END = OFF_WD + al((size_t)2 * NE * D * DE * 2);
static_assert(OFF_AG - OFF_HMID >= (size_t)HMID_ROWS * DE * 2, "HMID alias too small");
static_assert(WS_END < 530000000, "ws budget");

struct Params {
  const float *x, *c, *ctx, *c_ctx, *w_mod, *b_mod, *w_in, *q_gain, *k_gain, *w_pool, *pool_scale, *w_dw, *b_dw,
      *cv_ln_g, *cv_ln_b, *w_cv_pw, *w_out, *ln1_g, *ln1_b, *ln2_g, *ln2_b, *w_rg, *b_rg, *w_re, *b_re, *w_e_gate, *w_e_up, *w_e_down;
  float* out;
  char* ws;
};

__device__ __forceinline__ float bf2f(bf16_t v) { return __uint_as_float(((unsigned)v) << 16); }
__device__ __forceinline__ bf16_t f2bf(float f) {
  unsigned u = __float_as_uint(f);
  u += 0x7fffu + ((u >> 16) & 1u);
  return (bf16_t)(u >> 16);
}
__device__ __forceinline__ float wave_sum(float v) {
#pragma unroll
  for (int o = 32; o > 0; o >>= 1) v += __shfl_xor(v, o);
  return v;
}
__device__ __forceinline__ float silu(float v) { return v / (1.f + __expf(-v)); }
__device__ __forceinline__ int opaque0() { int z; asm volatile("s_mov_b32 %0, 0" : "=s"(z)); return z; }
#define TIDX ((int)threadIdx.x + opaque0())
using bf16x8 = __attribute__((ext_vector_type(8))) short;
using s16x4 = __attribute__((ext_vector_type(4))) short;
using f32x16 = __attribute__((ext_vector_type(16))) float;
using f32x4 = __attribute__((ext_vector_type(4))) float;
using u32x4 = __attribute__((ext_vector_type(4))) unsigned;
using u32x2 = __attribute__((ext_vector_type(2))) unsigned;

__device__ __forceinline__ int crow(int r, int hi) { return (r & 3) + 8 * (r >> 2) + 4 * hi; }
typedef float f32x2 __attribute__((ext_vector_type(2)));
typedef __bf16 bf16x2v __attribute__((ext_vector_type(2)));
__device__ __forceinline__ unsigned cvtpk(float lo, float hi) {
  bf16x2v b = __builtin_convertvector((f32x2){lo, hi}, bf16x2v);
  return __builtin_bit_cast(unsigned, b);
}
__device__ __forceinline__ float sum32(float v) {
  auto rr = __builtin_amdgcn_permlane32_swap(__float_as_uint(v), __float_as_uint(v), false, false);
  return __uint_as_float(rr[0]) + __uint_as_float(rr[1]);
}

__device__ __forceinline__ void cvt_range(const float* __restrict__ src, bf16_t* __restrict__ dst, long n8, long gtid, long gthreads) {
  for (long i = gtid; i < n8; i += gthreads) {
    const f32x4 a = *(const f32x4*)(src + i * 8), b = *(const f32x4*)(src + i * 8 + 4);
    u32x4 w = {cvtpk(a[0], a[1]), cvtpk(a[2], a[3]), cvtpk(b[0], b[1]), cvtpk(b[2], b[3])};
    *(u32x4*)(dst + i * 8) = w;
  }
}

__device__ __forceinline__ int xoff(int row, int chunk) { return row * 128 + ((chunk ^ ((row >> 1) & 7)) << 4); }
__device__ __forceinline__ int wst(int k, int c) { const int kk = (k & ~0xC) | ((k & 4) << 1) | ((k & 8) >> 1); return ((kk >> 3) * 4 + (c >> 5)) * 512 + ((kk & 7) * 32 + (c & 31)) * 2; }
__device__ __forceinline__ int v_rd_base(int lane) { return ((lane & 3) << 3) | (((lane >> 2) & 3) << 6) | (((lane >> 4) & 1) << 5) | (((lane >> 5) & 1) << 8); }

__device__ __forceinline__ bf16x8 tr_frag(const LAS char* p) {
  s16x4 a = __builtin_amdgcn_ds_read_tr16_b64_v4i16((LAS s16x4*)p);
  s16x4 b = __builtin_amdgcn_ds_read_tr16_b64_v4i16((LAS s16x4*)(p + 2048));
  return (bf16x8){a[0], a[1], a[2], a[3], b[0], b[1], b[2], b[3]};
}

template <int OFF> __device__ __forceinline__ bf16x8 tr_frag_asm(int addr) {
  s16x4 a, b;
  asm volatile("ds_read_b64_tr_b16 %0, %1 offset:%2" : "=&v"(a) : "v"(addr), "i"(OFF) : "memory");
  asm volatile("ds_read_b64_tr_b16 %0, %1 offset:%2" : "=&v"(b) : "v"(addr), "i"(OFF + 2048) : "memory");
  return (bf16x8){a[0], a[1], a[2], a[3], b[0], b[1], b[2], b[3]};
}

template <int BM, int BN> struct GemmCfg {
  static constexpr int WM = BM / 64, WN = 8 / WM, NSLAB = BN / 128, XB = BM * 128, WB = NSLAB * 16384, STAGE = XB + WB, NXP = BM / 64, NWP = NSLAB * 2;
  static_assert(WM * WN == 8 && WN * 64 == BN, "tile");
};
constexpr int GEMM_LDS = 3 * (256 * 128 + 16384);

template <int BM, int BN, int NMAP, class XRow, class WPtr>
__device__ __forceinline__ void gemm_mainloop(LAS char* lds, f32x16 (&acc)[2][2], const XRow& xrow, const WPtr& wptr, int ldw, int K) {
  using C = GemmCfg<BM, BN>;
  const int tid = TIDX, wid = tid >> 6, lane = tid & 63, r32 = lane & 31, hi = lane >> 5;
  const int wm = wid / C::WN, wn = wid % C::WN;
  const bf16_t* xg[C::NXP]; int xl[C::NXP];
#pragma unroll
  for (int i = 0; i < C::NXP; ++i) { const int q = wid * C::NXP + i, row = 8 * q + (lane >> 3), c = (lane & 7) ^ ((row >> 1) & 7); xg[i] = xrow(row) + c * 8; xl[i] = q * 1024; }
  const bf16_t* wg[C::NWP]; int wl[C::NWP];
#pragma unroll
  for (int i = 0; i < C::NWP; ++i) {
    const int idx = wid * C::NWP + i, s = idx >> 4, q = idx & 15, sub = 2 * q + (lane >> 5), kk = (sub >> 2) * 8 + ((lane & 31) >> 2);
    const int k = (kk & ~0xC) | ((kk & 4) << 1) | ((kk & 8) >> 1), c = (sub & 3) * 32 + (lane & 3) * 8;
    wg[i] = wptr(s) + (size_t)k * ldw + c; wl[i] = C::XB + s * 16384 + q * 1024;
  }
  int xr[2];
#pragma unroll
  for (int ti = 0; ti < 2; ++ti) xr[ti] = (wm * 64 + ti * 32 + r32) * 128;
  const int xsw = (r32 >> 1) & 7;
  int wr[2];
#pragma unroll
  for (int ni = 0; ni < 2; ++ni) {
    const int slab = NMAP == 0 ? 0 : (NMAP == 1 ? (wn >> 1) : ni);
    const int nb = NMAP == 0 ? (2 * wn + ni) : (NMAP == 1 ? ((wn & 1) * 2 + ni) : wn);
    wr[ni] = C::XB + slab * 16384 + nb * 512 + v_rd_base(lane);
  }
  const int nk = K / 64;
#define G_DMA(kt, st) do { LAS char* _d = lds + (st) * C::STAGE; \
    _Pragma("unroll") for (int i = 0; i < C::NXP; ++i) __builtin_amdgcn_global_load_lds((const unsigned*)(xg[i] + (kt) * 64), (LAS unsigned*)(_d + xl[i]), 16, 0, 0); \
    _Pragma("unroll") for (int i = 0; i < C::NWP; ++i) __builtin_amdgcn_global_load_lds((const unsigned*)(wg[i] + (size_t)(kt) * 64 * ldw), (LAS unsigned*)(_d + wl[i]), 16, 0, 0); } while (0)
#define G_HALF(cur, wa0, wa1, H) do { bf16x8 xf[2][2], wf[2][2]; \
      _Pragma("unroll") for (int k2 = 0; k2 < 2; ++k2) _Pragma("unroll") for (int ti = 0; ti < 2; ++ti) xf[k2][ti] = *(const LAS bf16x8*)(cur + xr[ti] + ((((H * 2 + k2) * 2 + hi) ^ xsw) << 4)); \
      wf[0][0] = tr_frag_asm<(H * 2 + 0) * 4096>(wa0); wf[0][1] = tr_frag_asm<(H * 2 + 0) * 4096>(wa1); \
      wf[1][0] = tr_frag_asm<(H * 2 + 1) * 4096>(wa0); wf[1][1] = tr_frag_asm<(H * 2 + 1) * 4096>(wa1); \
      asm volatile("s_waitcnt lgkmcnt(0)" ::: "memory"); __builtin_amdgcn_sched_barrier(0); \
      _Pragma("unroll") for (int k2 = 0; k2 < 2; ++k2) _Pragma("unroll") for (int ti = 0; ti < 2; ++ti) _Pragma("unroll") for (int ni = 0; ni < 2; ++ni) \
        acc[ti][ni] = __builtin_amdgcn_mfma_f32_32x32x16_bf16(wf[k2][ni], xf[k2][ti], acc[ti][ni], 0, 0, 0); } while (0)
#define G_COMPUTE(st) do { const LAS char* cur = lds + (st) * C::STAGE; const int wa0 = (int)(uintptr_t)(cur + wr[0]), wa1 = (int)(uintptr_t)(cur + wr[1]); \
    G_HALF(cur, wa0, wa1, 0); G_HALF(cur, wa0, wa1, 1); } while (0)
  static_assert(C::NXP + C::NWP == 6, "vmcnt(6) below assumes 6 DMA pieces per wave per k-tile");
  G_DMA(0, 0); G_DMA(1, 1);
  int st = 0;
  for (int kt = 0; kt < nk; ++kt) {
    if (kt + 1 < nk) asm volatile("s_waitcnt vmcnt(6)" ::: "memory"); else asm volatile("s_waitcnt vmcnt(0)" ::: "memory");
    asm volatile("s_waitcnt lgkmcnt(0)" ::: "memory"); __builtin_amdgcn_s_barrier();
    const int s2 = st == 0 ? 2 : st - 1;
    if (kt + 2 < nk) G_DMA(kt + 2, s2);
    G_COMPUTE(st);
    st = st == 2 ? 0 : st + 1;
  }
  asm volatile("s_waitcnt lgkmcnt(0)" ::: "memory"); __builtin_amdgcn_s_barrier();
#undef G_DMA
#undef G_COMPUTE
#undef G_HALF
}

__device__ __forceinline__ u32x2 pack4(const f32x16& a, int g) { return (u32x2){cvtpk(a[4 * g], a[4 * g + 1]), cvtpk(a[4 * g + 2], a[4 * g + 3])}; }

__device__ __forceinline__ void phase_a1(const Params& p, int layer, LAS char* lds, int bid, int nblk) {
  const bf16_t* H = (const bf16_t*)(p.ws + OFF_H);
  const bf16_t* W = (const bf16_t*)(p.ws + OFF_WIN) + (size_t)layer * D * INW;
  bf16_t* Q = (bf16_t*)(p.ws + OFF_Q); bf16_t* Kb = (bf16_t*)(p.ws + OFF_K); bf16_t* Vb = (bf16_t*)(p.ws + OFF_V);
  float* U = (float*)(p.ws + OFF_U); bf16_t* AG = (bf16_t*)(p.ws + OFF_AG);
  const float* rt = (const float*)(p.ws + OFF_ROPE);
  const int lane = TIDX & 63, wid = TIDX >> 6, r32 = lane & 31, hi = lane >> 5, wm = wid >> 1, wn = wid & 1;
  const int nlat = 64 * 12, nctx = layer == 0 ? 12 : 2, nunits = nlat + nctx;
  const bool xmap = (nblk & 7) == 0;
  const int xcd = bid & 7, lb = bid >> 3, nlb = nblk >> 3, nl = lb < 96 ? (96 - lb + nlb - 1) / nlb : 0;
  for (int it = 0;; ++it) {
    int rtile, ct;
    if (xmap) {
      if (it < nl) { const int v = lb + it * nlb; rtile = 1 + xcd + 8 * (v / 12); ct = v % 12; }
      else { const int e2 = bid + (it - nl) * nblk; if (e2 >= nctx) break; rtile = 0; ct = layer == 0 ? e2 : 4 + e2; }
    } else {
      const int u = bid + it * nblk; if (u >= nunits) break;
      if (u < nlat) { rtile = 1 + u / 12; ct = u % 12; } else { rtile = 0; ct = layer == 0 ? (u - nlat) : (4 + u - nlat); }
    }
    const int m0 = rtile * 256, n0 = ct * 128;
    f32x16 acc[2][2];
#pragma unroll
    for (int a = 0; a < 2; ++a)
#pragma unroll
      for (int b = 0; b < 2; ++b) acc[a][b] = (f32x16){};
    gemm_mainloop<256, 128, 0>(lds, acc, [&](int row) { return H + (size_t)(m0 + row) * D; }, [&](int) { return W + n0; }, INW, D);
#pragma unroll
    for (int ti = 0; ti < 2; ++ti) {
      const int tok = m0 + wm * 64 + ti * 32 + r32;
      if (ct < 5) {
        float ss = 0.f;
#pragma unroll
        for (int ni = 0; ni < 2; ++ni)
#pragma unroll
          for (int r = 0; r < 16; ++r) ss += acc[ti][ni][r] * acc[ti][ni][r];
        ss = sum32(ss);
        const float rs = rsqrtf(ss * (1.f / 64.f) + EPS);
        const float* gain = (ct < 4 ? p.q_gain : p.k_gain) + layer * 64;
        const float osc = ct < 4 ? 0.125f * 1.4426950408889634f : 1.f;
        const bool lat = rtile > 0;
        const int t = tok - NCTX;
#pragma unroll
        for (int ni = 0; ni < 2; ++ni) {
          f32x16 v;
#pragma unroll
          for (int r = 0; r < 16; ++r) v[r] = acc[ti][ni][r] * rs * gain[ni * 32 + crow(r, hi)];
          if (lat) {
            const int pos = ni == 0 ? (t >> 6) : (t & 63);
#pragma unroll
            for (int r = 0; r < 8; ++r) {
              const int f = crow(r, hi);
              const float cs = rt[(pos * 16 + f) * 2], sn = rt[(pos * 16 + f) * 2 + 1];
              const float t1 = v[r], t2 = v[r + 8];
              v[r] = t1 * cs - t2 * sn; v[r + 8] = t2 * cs + t1 * sn;
            }
          }
#pragma unroll
          for (int r = 0; r < 16; ++r) v[r] *= osc;
          bf16_t* dst = ct < 4 ? Q + (size_t)tok * 512 + (ct * 2 + wn) * 64 + ni * 32 : Kb + (size_t)tok * 128 + wn * 64 + ni * 32;
#pragma unroll
          for (int g = 0; g < 4; ++g) *(u32x2*)(dst + 8 * g + 4 * hi) = pack4(v, g);
        }
      } else if (ct == 5) {
#pragma unroll
        for (int ni = 0; ni < 2; ++ni)
#pragma unroll
          for (int g = 0; g < 4; ++g) *(u32x2*)(Vb + (size_t)tok * 128 + wn * 64 + ni * 32 + 8 * g + 4 * hi) = pack4(acc[ti][ni], g);
      } else if (ct < 8) {
#pragma unroll
        for (int ni = 0; ni < 2; ++ni)
#pragma unroll
          for (int g = 0; g < 4; ++g)
            *(f32x4*)(U + (size_t)tok * 256 + (ct - 6) * 128 + wn * 64 + ni * 32 + 8 * g + 4 * hi) =
                (f32x4){acc[ti][ni][4 * g], acc[ti][ni][4 * g + 1], acc[ti][ni][4 * g + 2], acc[ti][ni][4 * g + 3]};
      } else {
#pragma unroll
        for (int ni = 0; ni < 2; ++ni)
#pragma unroll
          for (int g = 0; g < 4; ++g) *(u32x2*)(AG + (size_t)tok * 512 + (ct - 8) * 128 + wn * 64 + ni * 32 + 8 * g + 4 * hi) = pack4(acc[ti][ni], g);
      }
    }
  }
}

__device__ __forceinline__ void phase_c1(const Params& p, int layer, LAS char* lds, int bid, int nblk) {
  const bf16_t* A = (const bf16_t*)(p.ws + OFF_MIX);
  const bf16_t* W = (const bf16_t*)(p.ws + OFF_WOUT) + (size_t)layer * D * D;
  bf16_t* Y = (bf16_t*)(p.ws + OFF_Y);
  const int lane = TIDX & 63, wid = TIDX >> 6, r32 = lane & 31, hi = lane >> 5, wm = wid >> 1, wn = wid & 1;
  const int nctx = layer == 0 ? 8 : 0;
  const bool xmap = (nblk & 7) == 0;
  const int xcd = bid & 7, lb = bid >> 3, nlb = nblk >> 3, nl = lb < 64 ? (64 - lb + nlb - 1) / nlb : 0;
  for (int it = 0;; ++it) {
    int rtile, ct;
    if (xmap) {
      if (it < nl) { const int v = lb + it * nlb; rtile = 1 + xcd + 8 * (v >> 3); ct = v & 7; }
      else { const int e2 = bid + (it - nl) * nblk; if (e2 >= nctx) break; rtile = 0; ct = e2; }
    } else {
      const int u = bid + it * nblk; if (u >= 64 * 8 + nctx) break;
      if (u < 512) { rtile = 1 + (u >> 3); ct = u & 7; } else { rtile = 0; ct = u - 512; }
    }
    const int m0 = rtile * 256, n0 = ct * 128;
    f32x16 acc[2][2];
#pragma unroll
    for (int a = 0; a < 2; ++a)
#pragma unroll
      for (int b = 0; b < 2; ++b) acc[a][b] = (f32x16){};
    gemm_mainloop<256, 128, 0>(lds, acc, [&](int row) { return A + (size_t)(m0 + row) * D; }, [&](int) { return W + n0; }, D, D);
#pragma unroll
    for (int ti = 0; ti < 2; ++ti) {
      const int tok = m0 + wm * 64 + ti * 32 + r32;
#pragma unroll
      for (int ni = 0; ni < 2; ++ni)
#pragma unroll
        for (int g = 0; g < 4; ++g) *(u32x2*)(Y + (size_t)tok * D + n0 + wn * 64 + ni * 32 + 8 * g + 4 * hi) = pack4(acc[ti][ni], g);
    }
  }
}

__device__ __forceinline__ void moe_prefix(const int* cnt, LAS int* pre, int xcd) {
  if (TIDX == 0) {
    int o = 0; for (int e = 0; e < NE; ++e) { pre[e] = o; o += (cnt[e * CNT_STRIDE] + 127) >> 7; } pre[NE] = o;
    int l = 0; for (int j = 0; j < 4; ++j) { pre[40 + j] = l; l += (cnt[(xcd + 8 * j) * CNT_STRIDE] + 127) >> 7; } pre[44] = l;
  }
  __syncthreads();
}
__device__ __forceinline__ bool moe_unit(const LAS int* pre, int bid, int nblk, int it, int& e, int& rt, int& ct, int& g) {
  if ((nblk & 7) == 0) {
    const int xcd = bid & 7, v = (bid >> 3) + it * (nblk >> 3), gl = v >> 2;
    if (gl >= pre[44]) return false;
    int j = 0; if (gl >= pre[41]) j = 1; if (gl >= pre[42]) j = 2; if (gl >= pre[43]) j = 3;
    e = xcd + 8 * j; rt = gl - pre[40 + j]; ct = v & 3; g = pre[e] + rt; return true;
  } else {
    const int u = bid + it * nblk; g = u >> 2; if (g >= pre[NE]) return false;
    int ee = 0; for (int i = 1; i < NE; ++i) ee += (pre[i] <= g) ? 1 : 0;
    e = ee; rt = g - pre[ee]; ct = u & 3; return true;
  }
}

__device__ __forceinline__ void phase_d1(const Params& p, int layer, LAS char* lds, int bid, int nblk) {
  const int* cnt = (const int*)(p.ws + OFF_CNT) + layer * NE * CNT_STRIDE;
  const bf16_t* H2 = (const bf16_t*)(p.ws + OFF_MIX);
  bf16_t* HM = (bf16_t*)(p.ws + OFF_HMID);
  LAS int* pre = (LAS int*)(lds + GEMM_LDS);
  moe_prefix(cnt, pre, bid & 7);
  const int lane = TIDX & 63, wid = TIDX >> 6, r32 = lane & 31, hi = lane >> 5, wm = wid >> 2, wn = wid & 3;
  for (int it = 0;; ++it) {
    int e, rt, ct, g; if (!moe_unit(pre, bid, nblk, it, e, rt, ct, g)) break;
    const int n = cnt[e * CNT_STRIDE];
    const int* list = (const int*)(p.ws + OFF_LIST) + (size_t)e * CAPL + rt * 128;
    const bf16_t* Wg = (const bf16_t*)(p.ws + OFF_WG) + ((size_t)layer * NE + e) * D * DE + ct * 128;
    const bf16_t* Wu = (const bf16_t*)(p.ws + OFF_WU) + ((size_t)layer * NE + e) * D * DE + ct * 128;
    const int nvalid = n - rt * 128;
    f32x16 acc[2][2];
#pragma unroll
    for (int a = 0; a < 2; ++a)
#pragma unroll
      for (int b = 0; b < 2; ++b) acc[a][b] = (f32x16){};
    gemm_mainloop<128, 256, 2>(lds, acc, [&](int row) { const int tok = row < nvalid ? (list[row] >> 1) : 0; return H2 + (size_t)tok * D; },
                               [&](int s) { return s == 0 ? Wg : Wu; }, DE, D);
    const size_t hrow0 = (size_t)(pre[e] + rt) * 128;
#pragma unroll
    for (int ti = 0; ti < 2; ++ti) {
      const size_t row = hrow0 + wm * 64 + ti * 32 + r32;
      f32x16 a;
#pragma unroll
      for (int r = 0; r < 16; ++r) { const float gv = acc[ti][0][r]; a[r] = gv / (1.f + __expf(-gv)) * acc[ti][1][r]; }
#pragma unroll
      for (int gq = 0; gq < 4; ++gq) *(u32x2*)(HM + row * DE + ct * 128 + wn * 32 + 8 * gq + 4 * hi) = pack4(a, gq);
    }
  }
}

__device__ __forceinline__ void phase_d2(const Params& p, int layer, LAS char* lds, int bid, int nblk) {
  const int* cnt = (const int*)(p.ws + OFF_CNT) + layer * NE * CNT_STRIDE;
  const bf16_t* HM = (const bf16_t*)(p.ws + OFF_HMID);
  const float* GATE = (const float*)(p.ws + OFF_GATE);
  bf16_t* OM = (bf16_t*)(p.ws + OFF_OMOE);
  LAS int* pre = (LAS int*)(lds + GEMM_LDS);
  moe_prefix(cnt, pre, bid & 7);
  const int lane = TIDX & 63, wid = TIDX >> 6, r32 = lane & 31, hi = lane >> 5, wm = wid >> 2, wn = wid & 3;
  for (int it = 0;; ++it) {
    int e, rt, ct, g; if (!moe_unit(pre, bid, nblk, it, e, rt, ct, g)) break;
    const int n = cnt[e * CNT_STRIDE];
    const int* list = (const int*)(p.ws + OFF_LIST) + (size_t)e * CAPL + rt * 128;
    const bf16_t* Wd = (const bf16_t*)(p.ws + OFF_WD) + ((size_t)layer * NE + e) * DE * D + ct * 256;
    const int nvalid = n - rt * 128;
    const bf16_t* A = HM + (size_t)g * 128 * DE;
    f32x16 acc[2][2];
#pragma unroll
    for (int a = 0; a < 2; ++a)
#pragma unroll
      for (int b = 0; b < 2; ++b) acc[a][b] = (f32x16){};
    gemm_mainloop<128, 256, 1>(lds, acc, [&](int row) { return A + (size_t)row * DE; }, [&](int s) { return Wd + s * 128; }, D, DE);
#pragma unroll
    for (int ti = 0; ti < 2; ++ti) {
      const int row = wm * 64 + ti * 32 + r32;
      if (row < nvalid) {
        const int ts = list[row];
        const float gt = GATE[ts];
#pragma unroll
        for (int ni = 0; ni < 2; ++ni) {
          f32x16 a;
#pragma unroll
          for (int r = 0; r < 16; ++r) a[r] = acc[ti][ni][r] * gt;
#pragma unroll
          for (int gq = 0; gq < 4; ++gq) *(u32x2*)(OM + (size_t)ts * D + ct * 256 + wn * 64 + ni * 32 + 8 * gq + 4 * hi) = pack4(a, gq);
        }
      }
    }
  }
}

constexpr int ATT_SLOT = 16384, ATT_LDS = 4 * ATT_SLOT;
__device__ __forceinline__ int vst64(int k, int c) { const int kk = (k & ~0xC) | ((k & 4) << 1) | ((k & 8) >> 1); return ((kk >> 3) * 2 + (c >> 5)) * 512 + ((kk & 7) * 32 + (c & 31)) * 2; }
__device__ __forceinline__ bf16x8 tr_frag64(const LAS char* p) {
  s16x4 a = __builtin_amdgcn_ds_read_tr16_b64_v4i16((LAS s16x4*)p);
  s16x4 b = __builtin_amdgcn_ds_read_tr16_b64_v4i16((LAS s16x4*)(p + 1024));
  return (bf16x8){a[0], a[1], a[2], a[3], b[0], b[1], b[2], b[3]};
}
__device__ __forceinline__ bf16x8 pk4(const f32x16& P, int B) {
  unsigned a0 = cvtpk(P[B + 0], P[B + 1]), a1 = cvtpk(P[B + 2], P[B + 3]), b0 = cvtpk(P[B + 4], P[B + 5]), b1 = cvtpk(P[B + 6], P[B + 7]);
  auto r0 = __builtin_amdgcn_permlane32_swap(a0, b0, false, false); auto r1 = __builtin_amdgcn_permlane32_swap(a1, b1, false, false);
  u32x4 w = {r0[0], r1[0], r0[1], r1[1]};
  return __builtin_bit_cast(bf16x8, w);
}
struct AttnCtx { int krd0, krd1, ksw, hi, vrd; };
#define SBAR() __builtin_amdgcn_sched_barrier(0)
__device__ __forceinline__ void att_kload(const LAS char* slot, const AttnCtx& c, bf16x8 (&kf)[8]) {
#pragma unroll
  for (int d0 = 0; d0 < 4; ++d0) {
    kf[2 * d0] = *(const LAS bf16x8*)(slot + c.krd0 + (((2 * d0 + c.hi) ^ c.ksw) << 4));
    kf[2 * d0 + 1] = *(const LAS bf16x8*)(slot + c.krd1 + (((2 * d0 + c.hi) ^ c.ksw) << 4));
  }
}
__device__ __forceinline__ void att_qk(const bf16x8 (&kf)[8], const bf16x8 (&qr)[4], f32x16& s0, f32x16& s1) {
  s0 = (f32x16){}; s1 = (f32x16){};
#pragma unroll
  for (int d0 = 0; d0 < 4; ++d0) {
    s0 = __builtin_amdgcn_mfma_f32_32x32x16_bf16(kf[2 * d0], qr[d0], s0, 0, 0, 0);
    s1 = __builtin_amdgcn_mfma_f32_32x32x16_bf16(kf[2 * d0 + 1], qr[d0], s1, 0, 0, 0);
  }
}
__device__ __forceinline__ void att_exp(f32x16& s, float& l) {
#pragma unroll
  for (int r = 0; r < 16; ++r) { s[r] = __builtin_amdgcn_exp2f(s[r]); l += s[r]; }
  asm volatile("" : "+v"(l));
}
template <int KS0>
__device__ __forceinline__ void att_vload(const LAS char* slot, const AttnCtx& c, bf16x8 (&vf)[4]) {
#pragma unroll
  for (int i = 0; i < 2; ++i) { vf[2 * i] = tr_frag64(slot + c.vrd + (KS0 + i) * 2048); vf[2 * i + 1] = tr_frag64(slot + c.vrd + 512 + (KS0 + i) * 2048); }
}
__device__ __forceinline__ void att_pv2(const bf16x8& pa, const bf16x8& pb, const bf16x8 (&vf)[4], f32x16& o0, f32x16& o1) {
  o0 = __builtin_amdgcn_mfma_f32_32x32x16_bf16(pa, vf[0], o0, 0, 0, 0);
  o1 = __builtin_amdgcn_mfma_f32_32x32x16_bf16(pa, vf[1], o1, 0, 0, 0);
  o0 = __builtin_amdgcn_mfma_f32_32x32x16_bf16(pb, vf[2], o0, 0, 0, 0);
  o1 = __builtin_amdgcn_mfma_f32_32x32x16_bf16(pb, vf[3], o1, 0, 0, 0);
}
__device__ __forceinline__ void attn_unit(const Params& p, LAS char* lds, int row0, int hp, int nkeys) {
  const bf16_t* Q = (const bf16_t*)(p.ws + OFF_Q); const bf16_t* Kb = (const bf16_t*)(p.ws + OFF_K); const bf16_t* Vb = (const bf16_t*)(p.ws + OFF_V);
  bf16_t* MIX = (bf16_t*)(p.ws + OFF_MIX);
  const int tid = TIDX, wid = tid >> 6, lane = tid & 63, r32 = lane & 31, hi = lane >> 5, kvh = hp >> 1;
  bf16x8 qa[4], qb[4];
  { const bf16_t* Qg = Q + (size_t)(row0 + wid * 32 + r32) * 512 + hp * 128 + hi * 8;
#pragma unroll
    for (int d0 = 0; d0 < 4; ++d0) { qa[d0] = *(const bf16x8*)(Qg + d0 * 16); qb[d0] = *(const bf16x8*)(Qg + 64 + d0 * 16); } }
  const bf16_t* Kg = Kb + (size_t)(tid >> 3) * 128 + kvh * 64 + (tid & 7) * 8;
  const bf16_t* Vg = Vb + (size_t)(tid >> 3) * 128 + kvh * 64 + (tid & 7) * 8;
  const int kst = xoff(tid >> 3, tid & 7), vstw = 8192 + vst64(tid >> 3, (tid & 7) * 8);
  AttnCtx c; c.krd0 = r32 * 128; c.krd1 = (32 + r32) * 128; c.ksw = (r32 >> 1) & 7; c.hi = hi; c.vrd = 8192 + v_rd_base(lane);
  const int NT = nkeys >> 6;
  f32x16 oa0 = {}, oa1 = {}, ob0 = {}, ob1 = {}; float la = 0.f, lb = 0.f;
  u32x4 ks, vs;
  {
    const u32x4 k0 = *(const u32x4*)Kg, k1 = *(const u32x4*)(Kg + 64 * 128), v0 = *(const u32x4*)Vg, v1 = *(const u32x4*)(Vg + 64 * 128);
    *(LAS u32x4*)(lds + kst) = k0; *(LAS u32x4*)(lds + ATT_SLOT + kst) = k1;
    *(LAS u32x4*)(lds + vstw) = v0; *(LAS u32x4*)(lds + ATT_SLOT + vstw) = v1;
    ks = *(const u32x4*)(Kg + 2 * 64 * 128); vs = *(const u32x4*)(Vg + 2 * 64 * 128);
  }
  __syncthreads();
  for (int j = 0; j < NT; ++j) {
    const LAS char* sl = lds + (j & 3) * ATT_SLOT;
    bf16x8 kf[8], vfa[4], vfb[4];
    f32x16 sa0, sa1, sb0, sb1;
    att_kload(sl, c, kf);
    SBAR();
    att_qk(kf, qa, sa0, sa1);
    SBAR();
    att_qk(kf, qb, sb0, sb1);
    att_exp(sa0, la); att_exp(sa1, la);
    SBAR();
    const bf16x8 pa0 = pk4(sa0, 0), pa1 = pk4(sa0, 8), pa2 = pk4(sa1, 0), pa3 = pk4(sa1, 8);
    att_vload<0>(sl, c, vfa);
    SBAR();
    att_pv2(pa0, pa1, vfa, oa0, oa1);
    att_exp(sb0, lb);
    att_vload<2>(sl, c, vfb);
    SBAR();
    att_pv2(pa2, pa3, vfb, oa0, oa1);
    att_exp(sb1, lb);
    const bf16x8 pb0 = pk4(sb0, 0), pb1 = pk4(sb0, 8), pb2 = pk4(sb1, 0), pb3 = pk4(sb1, 8);
    att_vload<0>(sl, c, vfa);
    SBAR();
    att_pv2(pb0, pb1, vfa, ob0, ob1);
    att_vload<2>(sl, c, vfb);
    SBAR();
    att_pv2(pb2, pb3, vfb, ob0, ob1);
    { LAS char* w = lds + ((j + 2) & 3) * ATT_SLOT;
      if (j + 2 < NT) { *(LAS u32x4*)(w + kst) = ks; *(LAS u32x4*)(w + vstw) = vs; }
      if (j + 3 < NT) { ks = *(const u32x4*)(Kg + (size_t)(j + 3) * 64 * 128); vs = *(const u32x4*)(Vg + (size_t)(j + 3) * 64 * 128); } }
    __syncthreads();
  }
  la = sum32(la); lb = sum32(lb);
  LAS float* li = (LAS float*)(lds + wid * 256);
  if (hi == 0) { li[r32] = la; li[32 + r32] = lb; }
  __syncthreads();
  bf16_t* Og = MIX + (size_t)(row0 + wid * 32) * D + hp * 128 + r32;
#pragma unroll
  for (int r = 0; r < 16; ++r) {
    const int orow = crow(r, hi);
    const float ra = __builtin_amdgcn_rcpf(li[orow]), rb = __builtin_amdgcn_rcpf(li[32 + orow]);
    Og[(size_t)orow * D] = f2bf(oa0[r] * ra); Og[(size_t)orow * D + 32] = f2bf(oa1[r] * ra);
    Og[(size_t)orow * D + 64] = f2bf(ob0[r] * rb); Og[(size_t)orow * D + 96] = f2bf(ob1[r] * rb);
  }
  __syncthreads();
}
__device__ __forceinline__ void attn_fallback(const Params& p, int layer, int bid, int nblk) {
  const bf16_t* Q = (const bf16_t*)(p.ws + OFF_Q); const bf16_t* Kb = (const bf16_t*)(p.ws + OFF_K); const bf16_t* Vb = (const bf16_t*)(p.ws + OFF_V);
  bf16_t* MIX = (bf16_t*)(p.ws + OFF_MIX);
  const int lane = TIDX & 63, nwv = nblk * 8;
  const int rg0 = layer == 0 ? 0 : NCTX / 64;
  for (int wv = bid * 8 + (TIDX >> 6) + rg0 * 8; wv < (TT / 64) * 8; wv += nwv) {
    const int head = wv & 7, r = (wv >> 3) * 64 + lane, kvh = head >> 2;
    float q[64], o[64];
#pragma unroll
    for (int d = 0; d < 64; ++d) { q[d] = bf2f(Q[(size_t)r * 512 + head * 64 + d]); o[d] = 0.f; }
    float m = -1e30f, l = 0.f;
    const int nk = r >= NCTX ? TT : NCTX;
    for (int j = 0; j < nk; ++j) {
      const bf16_t* kr = Kb + (size_t)j * 128 + kvh * 64;
      const bf16_t* vr = Vb + (size_t)j * 128 + kvh * 64;
      float s = 0.f;
#pragma unroll
      for (int d = 0; d < 64; ++d) s += q[d] * bf2f(kr[d]);
      if (s > m) {
        const float a = __builtin_amdgcn_exp2f(m - s);
        l *= a;
#pragma unroll
        for (int d = 0; d < 64; ++d) o[d] *= a;
        m = s;
      }
      const float pe = __builtin_amdgcn_exp2f(s - m);
      l += pe;
#pragma unroll
      for (int d = 0; d < 64; ++d) o[d] += pe * bf2f(vr[d]);
    }
    const float il = 1.f / l;
#pragma unroll
    for (int d = 0; d < 64; ++d) MIX[(size_t)r * D + head * 64 + d] = f2bf(o[d] * il);
  }
}

constexpr int PC_U = 0;
constexpr int PC_Y = 49152;
constexpr int PC_LDS = PC_Y + 65536;
__device__ __forceinline__ void poolconv_unit(const Params& p, int layer, LAS char* lds, int tile) {
  const int tid = TIDX, wid = tid >> 6, lane = tid & 63, r32 = lane & 31, hi = lane >> 5;
  const int t0 = tile * 64, base = tile < 4 ? 0 : NCTX, n = tile < 4 ? NCTX : SEQ;
  const bf16_t* AG = (const bf16_t*)(p.ws + OFF_AG);
  const float* U = (const float*)(p.ws + OFF_U);
  bf16_t* MIX = (bf16_t*)(p.ws + OFF_MIX);
  for (int idx = tid; idx < 94 * 32; idx += 512) {
    const int rr = idx >> 5, ch = (idx & 31) * 8, t = t0 - 15 + rr;
    u32x4 out = {0u, 0u, 0u, 0u};
    if (t >= base && t < base + n) {
      const u32x4 av = *(const u32x4*)(AG + (size_t)t * 512 + ch), gv = *(const u32x4*)(AG + (size_t)t * 512 + 256 + ch);
#pragma unroll
      for (int i = 0; i < 4; ++i) {
        const float a0 = __uint_as_float(av[i] << 16), a1 = __uint_as_float(av[i] & 0xffff0000u);
        const float g0 = __uint_as_float(gv[i] << 16), g1 = __uint_as_float(gv[i] & 0xffff0000u);
        out[i] = cvtpk(a0 / (1.f + __expf(-g0)), a1 / (1.f + __expf(-g1)));
      }
    }
    *(LAS u32x4*)(lds + PC_U + (rr * 256 + ch) * 2) = out;
  }
  __syncthreads();
  {
    const int c = tid & 255, th = tid >> 8;
    float w[31];
#pragma unroll
    for (int j = 0; j < 31; ++j) w[j] = p.w_dw[(size_t)layer * 31 * 256 + j * 256 + c];
    const float b = p.b_dw[layer * 256 + c];
    float acc[32];
#pragma unroll
    for (int i = 0; i < 32; ++i) acc[i] = b;
    const LAS bf16_t* up = (const LAS bf16_t*)(lds + PC_U) + (th * 32) * 256 + c;
#pragma unroll
    for (int rr = 0; rr < 62; ++rr) {
      const float uv = bf2f(up[rr * 256]);
#pragma unroll
      for (int i = 0; i < 32; ++i) if (rr - i >= 0 && rr - i < 31) acc[i] += uv * w[rr - i];
    }
    LAS float* yp = (LAS float*)(lds + PC_Y) + (th * 32) * 256 + c;
#pragma unroll
    for (int i = 0; i < 32; ++i) yp[i * 256] = acc[i];
  }
  __syncthreads();
  {
    const f32x4 g4 = *(const f32x4*)(p.cv_ln_g + layer * 256 + lane * 4), b4 = *(const f32x4*)(p.cv_ln_b + layer * 256 + lane * 4);
#pragma unroll
    for (int i = 0; i < 8; ++i) {
      const int tok = wid * 8 + i;
      const f32x4 y = *(const LAS f32x4*)(lds + PC_Y + (tok * 256 + lane * 4) * 4);
      const float mu = wave_sum(y[0] + y[1] + y[2] + y[3]) * (1.f / 256.f);
      const float d0 = y[0] - mu, d1 = y[1] - mu, d2 = y[2] - mu, d3 = y[3] - mu;
      const float rs = rsqrtf(wave_sum(d0 * d0 + d1 * d1 + d2 * d2 + d3 * d3) * (1.f / 256.f) + EPS);
      const float z0 = silu(d0 * rs * g4[0] + b4[0]), z1 = silu(d1 * rs * g4[1] + b4[1]), z2 = silu(d2 * rs * g4[2] + b4[2]), z3 = silu(d3 * rs * g4[3] + b4[3]);
      const int chunk = lane >> 1, sw = (chunk & 16) | ((chunk ^ tok) & 15);
      *(LAS u32x2*)(lds + PC_U + tok * 512 + sw * 16 + (lane & 1) * 8) = (u32x2){cvtpk(z0, z1), cvtpk(z2, z3)};
    }
  }
  __syncthreads();
  {
    const int tb = wid >> 2, dg = wid & 3, trow = tb * 32 + r32, t = t0 + trow;
    const bf16_t* Wt = (const bf16_t*)(p.ws + OFF_WPWT) + ((size_t)layer * 256 + dg * 64 + r32) * 256 + hi * 8;
    f32x16 acc0 = {}, acc1 = {};
#pragma unroll 8
    for (int ks = 0; ks < 16; ++ks) {
      const int chunk = 2 * ks + hi, sw = (chunk & 16) | ((chunk ^ trow) & 15);
      const bf16x8 zf = *(const LAS bf16x8*)(lds + PC_U + trow * 512 + sw * 16);
      const bf16x8 w0 = *(const bf16x8*)(Wt + ks * 16), w1 = *(const bf16x8*)(Wt + 32 * 256 + ks * 16);
      acc0 = __builtin_amdgcn_mfma_f32_32x32x16_bf16(w0, zf, acc0, 0, 0, 0);
      acc1 = __builtin_amdgcn_mfma_f32_32x32x16_bf16(w1, zf, acc1, 0, 0, 0);
    }
    bf16_t* dst = MIX + (size_t)t * D + 768 + dg * 64;
#pragma unroll
    for (int g = 0; g < 4; ++g) { *(u32x2*)(dst + 8 * g + 4 * hi) = pack4(acc0, g); *(u32x2*)(dst + 32 + 8 * g + 4 * hi) = pack4(acc1, g); }
    const int w = 2 << dg, tl = t - base, lo = max(tl - w / 2, 0), hh = min(tl + w / 2, n);
    const float inv = 1.f / (float)(hh - lo);
    const bf16_t* Pt = (const bf16_t*)(p.ws + OFF_WPOOLT) + ((size_t)(layer * 4 + dg) * 64 + r32) * 64 + hi * 8;
    f32x16 pc0 = {}, pc1 = {};
#pragma unroll
    for (int ks = 0; ks < 4; ++ks) {
      const int c0 = dg * 64 + ks * 16 + hi * 8;
      f32x4 s0 = {0.f, 0.f, 0.f, 0.f}, s1 = {0.f, 0.f, 0.f, 0.f};
#pragma unroll
      for (int i = 0; i < 16; ++i) {
        const int rr = lo + i; const bool in = i < w && rr < hh;
        const float* ur = U + (size_t)(base + (in ? rr : lo)) * 256 + c0; const float wgt = in ? 1.f : 0.f;
        s0 += *(const f32x4*)ur * wgt; s1 += *(const f32x4*)(ur + 4) * wgt;
      }
      const float* uo = U + (size_t)t * 256 + c0;
      const f32x4 o0 = *(const f32x4*)uo, o1 = *(const f32x4*)(uo + 4);
      s0 = s0 * inv - o0; s1 = s1 * inv - o1;
      u32x4 pw = {cvtpk(s0[0], s0[1]), cvtpk(s0[2], s0[3]), cvtpk(s1[0], s1[1]), cvtpk(s1[2], s1[3])};
      const bf16x8 pf = __builtin_bit_cast(bf16x8, pw);
      const bf16x8 w0 = *(const bf16x8*)(Pt + ks * 16), w1 = *(const bf16x8*)(Pt + 32 * 64 + ks * 16);
      pc0 = __builtin_amdgcn_mfma_f32_32x32x16_bf16(w0, pf, pc0, 0, 0, 0);
      pc1 = __builtin_amdgcn_mfma_f32_32x32x16_bf16(w1, pf, pc1, 0, 0, 0);
    }
    const float* psc = p.pool_scale + layer * 256 + dg * 64;
#pragma unroll
    for (int r = 0; r < 16; ++r) { pc0[r] *= psc[crow(r, hi)]; pc1[r] *= psc[32 + crow(r, hi)]; }
    bf16_t* pd = MIX + (size_t)t * D + 512 + dg * 64;
#pragma unroll
    for (int g = 0; g < 4; ++g) { *(u32x2*)(pd + 8 * g + 4 * hi) = pack4(pc0, g); *(u32x2*)(pd + 32 + 8 * g + 4 * hi) = pack4(pc1, g); }
  }
  __syncthreads();
}

__device__ __forceinline__ void phase_b(const Params& p, int layer, LAS char* lds, int bid, int nblk) {
  const bool fast = ((const int*)(p.ws + OFF_FLAG))[0] != 0;
  const int nu = (520 - bid + nblk - 1) / nblk;
  for (int i = 0; i < nu; ++i) {
    const int u = bid + ((bid & 1) ? (nu - 1 - i) : i) * nblk;
    if (u < 256) { if (fast) attn_unit(p, lds, NCTX + (u >> 2) * 256, u & 3, TT); }
    else if (u < 260) { if (fast && layer == 0) attn_unit(p, lds, 0, u - 256, NCTX); }
    else { const int tile = u - 260; if (layer == 0 || tile >= 4) poolconv_unit(p, layer, lds, tile); }
  }
  if (!fast) attn_fallback(p, layer, bid, nblk);
}

constexpr int NR = 2, NRA = 2;
__device__ __forceinline__ float hsum4(const f32x4 (&v)[4]) { float s = 0.f;
#pragma unroll
  for (int i = 0; i < 4; ++i) s += (v[i][0] + v[i][1]) + (v[i][2] + v[i][3]);
  return s; }
__device__ __forceinline__ float hsq4(const f32x4 (&v)[4], float mu) { float q = 0.f;
#pragma unroll
  for (int i = 0; i < 4; ++i) { const f32x4 d = v[i] - mu; q += (d[0] * d[0] + d[1] * d[1]) + (d[2] * d[2] + d[3] * d[3]); }
  return q; }
__device__ __forceinline__ f32x4 bf4(u32x2 w) { return (f32x4){__uint_as_float(w[0] << 16), __uint_as_float(w[0] & 0xffff0000u), __uint_as_float(w[1] << 16), __uint_as_float(w[1] & 0xffff0000u)}; }

__device__ __forceinline__ void phase_a0(const Params& p, int layer, int bid, int nblk) {
  const int wave = bid * 8 + (TIDX >> 6), lane = TIDX & 63, nw = nblk * 8;
  float* X = (float*)(p.ws + OFF_X);
  bf16_t* H = (bf16_t*)(p.ws + OFF_H);
  const bf16_t* OM = (const bf16_t*)(p.ws + OFF_OMOE);
  for (int rb = wave * NRA; rb < TT; rb += nw * NRA) {
    f32x4 v[NRA][4]; u32x2 oa[NRA][4], ob[NRA][4];
#pragma unroll
    for (int k = 0; k < NRA; ++k) {
      const int r = rb + k;
      const float* src = layer == 0 ? (r < NCTX ? p.ctx + (size_t)r * D : p.x + (size_t)(r - NCTX) * D) : X + (size_t)r * D;
#pragma unroll
      for (int i = 0; i < 4; ++i) { const int c = i * 256 + lane * 4; v[k][i] = *(const f32x4*)(src + c);
        if (layer != 0) { oa[k][i] = *(const u32x2*)(OM + ((size_t)r * 2 + 0) * D + c); ob[k][i] = *(const u32x2*)(OM + ((size_t)r * 2 + 1) * D + c); } }
    }
    if (layer != 0) {
#pragma unroll
      for (int k = 0; k < NRA; ++k) {
        const int r = rb + k, s = r < NCTX ? 1 : 0;
        const float* g2 = (const float*)(p.ws + OFF_MOD) + ((layer - 1) * 2 + s) * 6144 + 5 * D;
#pragma unroll
        for (int i = 0; i < 4; ++i) { const int c = i * 256 + lane * 4; v[k][i] = v[k][i] * ALPHA + *(const f32x4*)(g2 + c) * (bf4(oa[k][i]) + bf4(ob[k][i])); }
      }
      float mu[NRA], rs[NRA];
#pragma unroll
      for (int k = 0; k < NRA; ++k) mu[k] = wave_sum(hsum4(v[k])) * (1.f / D);
#pragma unroll
      for (int k = 0; k < NRA; ++k) rs[k] = rsqrtf(wave_sum(hsq4(v[k], mu[k])) * (1.f / D) + EPS);
      const float* g = p.ln2_g + (layer - 1) * D; const float* b = p.ln2_b + (layer - 1) * D;
#pragma unroll
      for (int k = 0; k < NRA; ++k)
#pragma unroll
        for (int i = 0; i < 4; ++i) { const int c = i * 256 + lane * 4; v[k][i] = (v[k][i] - mu[k]) * rs[k] * *(const f32x4*)(g + c) + *(const f32x4*)(b + c); *(f32x4*)(X + (size_t)(rb + k) * D + c) = v[k][i]; }
    }
    float mu[NRA], rs[NRA];
#pragma unroll
    for (int k = 0; k < NRA; ++k) mu[k] = wave_sum(hsum4(v[k])) * (1.f / D);
#pragma unroll
    for (int k = 0; k < NRA; ++k) rs[k] = rsqrtf(wave_sum(hsq4(v[k], mu[k])) * (1.f / D) + EPS);
#pragma unroll
    for (int k = 0; k < NRA; ++k) {
      const int r = rb + k, s = r < NCTX ? 1 : 0;
      const float* modp = (const float*)(p.ws + OFF_MOD) + (layer * 2 + s) * 6144;
#pragma unroll
      for (int i = 0; i < 4; ++i) {
        const int c = i * 256 + lane * 4;
        const f32x4 h = (v[k][i] - mu[k]) * rs[k] * (*(const f32x4*)(modp + D + c) + 1.f) + *(const f32x4*)(modp + c);
        *(u32x2*)(H + (size_t)r * D + c) = (u32x2){cvtpk(h[0], h[1]), cvtpk(h[2], h[3])};
      }
    }
  }
}

__device__ __forceinline__ void phase_c2(const Params& p, int layer, LAS char* lds, int bid, int nblk) {
  const int tid = TIDX, wid = tid >> 6, lane = tid & 63;
  float* X = (float*)(p.ws + OFF_X);
  const bf16_t* Y = (const bf16_t*)(p.ws + OFF_Y);
  bf16_t* H2 = (bf16_t*)(p.ws + OFF_MIX);
  int* cnt = (int*)(p.ws + OFF_CNT) + layer * NE * CNT_STRIDE;
  float* GATE = (float*)(p.ws + OFF_GATE); int* LIST = (int*)(p.ws + OFF_LIST);
  LAS int* lcnt = (LAS int*)lds;
  LAS int* lbase = lcnt + 32;
  LAS int* ent = lcnt + 64;
  if (tid < 32) lcnt[tid] = 0;
  __syncthreads();
  const int r0 = layer == 0 ? 0 : NCTX, nrows = TT - r0, rpb = (nrows + nblk - 1) / nblk;
  const int rbeg = r0 + bid * rpb, rend = min(rbeg + rpb, TT);
  for (int rb = rbeg + wid * NR; rb < rend; rb += 8 * NR) {
    f32x4 v[NR][4]; u32x2 yv[NR][4]; int rr[NR]; bool ok[NR];
#pragma unroll
    for (int k = 0; k < NR; ++k) {
      ok[k] = rb + k < rend; rr[k] = ok[k] ? rb + k : rb;
      const int r = rr[k];
      const float* xin = layer == 0 ? (r < NCTX ? p.ctx + (size_t)r * D : p.x + (size_t)(r - NCTX) * D) : X + (size_t)r * D;
#pragma unroll
      for (int i = 0; i < 4; ++i) { const int c = i * 256 + lane * 4; v[k][i] = *(const f32x4*)(xin + c); yv[k][i] = *(const u32x2*)(Y + (size_t)r * D + c); }
    }
#pragma unroll
    for (int k = 0; k < NR; ++k) {
      const float* modp = (const float*)(p.ws + OFF_MOD) + (layer * 2 + (rr[k] < NCTX ? 1 : 0)) * 6144;
#pragma unroll
      for (int i = 0; i < 4; ++i) { const int c = i * 256 + lane * 4; v[k][i] = v[k][i] * ALPHA + *(const f32x4*)(modp + 2 * D + c) * bf4(yv[k][i]); }
    }
    float mu[NR], rs[NR];
#pragma unroll
    for (int k = 0; k < NR; ++k) mu[k] = wave_sum(hsum4(v[k])) * (1.f / D);
#pragma unroll
    for (int k = 0; k < NR; ++k) rs[k] = rsqrtf(wave_sum(hsq4(v[k], mu[k])) * (1.f / D) + EPS);
#pragma unroll
    for (int k = 0; k < NR; ++k)
#pragma unroll
      for (int i = 0; i < 4; ++i) {
        const int c = i * 256 + lane * 4;
        v[k][i] = (v[k][i] - mu[k]) * rs[k] * *(const f32x4*)(p.ln1_g + layer * D + c) + *(const f32x4*)(p.ln1_b + layer * D + c);
        if (ok[k]) *(f32x4*)(X + (size_t)rr[k] * D + c) = v[k][i];
      }
#pragma unroll
    for (int k = 0; k < NR; ++k) mu[k] = wave_sum(hsum4(v[k])) * (1.f / D);
#pragma unroll
    for (int k = 0; k < NR; ++k) rs[k] = rsqrtf(wave_sum(hsq4(v[k], mu[k])) * (1.f / D) + EPS);
#pragma unroll
    for (int k = 0; k < NR; ++k) {
      const float* modp = (const float*)(p.ws + OFF_MOD) + (layer * 2 + (rr[k] < NCTX ? 1 : 0)) * 6144;
#pragma unroll
      for (int i = 0; i < 4; ++i) {
        const int c = i * 256 + lane * 4;
        v[k][i] = (v[k][i] - mu[k]) * rs[k] * (*(const f32x4*)(modp + 4 * D + c) + 1.f) + *(const f32x4*)(modp + 3 * D + c);
        if (ok[k]) *(u32x2*)(H2 + (size_t)rr[k] * D + c) = (u32x2){cvtpk(v[k][i][0], v[k][i][1]), cvtpk(v[k][i][2], v[k][i][3])};
      }
    }
    f32x4 lg[NR];
#pragma unroll
    for (int k = 0; k < NR; ++k) lg[k] = (f32x4){0.f, 0.f, 0.f, 0.f};
#pragma unroll
    for (int i = 0; i < 4; ++i)
#pragma unroll
      for (int j = 0; j < 4; ++j) { const f32x4 w = *(const f32x4*)(p.w_rg + ((size_t)layer * D + i * 256 + lane * 4 + j) * 4);
#pragma unroll
        for (int k = 0; k < NR; ++k) lg[k] += w * v[k][i][j]; }
    int gsel[NR]; float pgrp[NR];
#pragma unroll
    for (int k = 0; k < NR; ++k) {
      float l0 = wave_sum(lg[k][0]) + p.b_rg[layer * 4 + 0], l1 = wave_sum(lg[k][1]) + p.b_rg[layer * 4 + 1];
      float l2 = wave_sum(lg[k][2]) + p.b_rg[layer * 4 + 2], l3 = wave_sum(lg[k][3]) + p.b_rg[layer * 4 + 3];
      int gs = 0; float gm = l0;
      if (l1 > gm) { gm = l1; gs = 1; }
      if (l2 > gm) { gm = l2; gs = 2; }
      if (l3 > gm) { gm = l3; gs = 3; }
      gsel[k] = gs; pgrp[k] = 1.f / (__expf(l0 - gm) + __expf(l1 - gm) + __expf(l2 - gm) + __expf(l3 - gm));
    }
#pragma unroll
    for (int k = 0; k < NR; ++k) {
      f32x4 ea = {0.f, 0.f, 0.f, 0.f}, eb = {0.f, 0.f, 0.f, 0.f};
#pragma unroll
      for (int i = 0; i < 4; ++i)
#pragma unroll
        for (int j = 0; j < 4; ++j) {
          const float* wr = p.w_re + ((size_t)layer * D + i * 256 + lane * 4 + j) * 32 + gsel[k] * 8;
          ea += *(const f32x4*)wr * v[k][i][j]; eb += *(const f32x4*)(wr + 4) * v[k][i][j];
        }
      float le[8];
#pragma unroll
      for (int e = 0; e < 4; ++e) { le[e] = wave_sum(ea[e]) + p.b_re[layer * 32 + gsel[k] * 8 + e]; le[4 + e] = wave_sum(eb[e]) + p.b_re[layer * 32 + gsel[k] * 8 + 4 + e]; }
      int i0 = 0; float v0 = le[0];
#pragma unroll
      for (int e = 1; e < 8; ++e) if (le[e] > v0) { v0 = le[e]; i0 = e; }
      int i1 = -1; float v1 = -3.0e38f;
#pragma unroll
      for (int e = 0; e < 8; ++e) if (e != i0 && le[e] > v1) { v1 = le[e]; i1 = e; }
      if (i1 < 0) { i1 = (i0 + 1) & 7; v1 = v0; }
      const float e1 = __expf(v1 - v0);
      if (lane == 0 && ok[k]) {
        const int r = rr[k], xa = gsel[k] * 8 + i0, xb = gsel[k] * 8 + i1;
        const int pa = __hip_atomic_fetch_add(&lcnt[xa], 1, __ATOMIC_RELAXED, __HIP_MEMORY_SCOPE_WORKGROUP);
        const int pb = __hip_atomic_fetch_add(&lcnt[xb], 1, __ATOMIC_RELAXED, __HIP_MEMORY_SCOPE_WORKGROUP);
        const int li = (r - rbeg) * 2;
        ent[li * 3 + 0] = xa; ent[li * 3 + 1] = pa; ent[li * 3 + 2] = r * 2 + 0;
        ent[li * 3 + 3] = xb; ent[li * 3 + 4] = pb; ent[li * 3 + 5] = r * 2 + 1;
        GATE[r * 2] = pgrp[k] / (1.f + e1); GATE[r * 2 + 1] = pgrp[k] * e1 / (1.f + e1);
      }
    }
  }
  __syncthreads();
  if (tid < 32) { const int c = lcnt[tid]; lbase[tid] = c > 0 ? atomicAdd(&cnt[tid * CNT_STRIDE], c) : 0; }
  __syncthreads();
  for (int i = tid; i < (rend - rbeg) * 2; i += 512) { const int e = ent[i * 3], lp = ent[i * 3 + 1]; LIST[(size_t)e * CAPL + lbase[e] + lp] = ent[i * 3 + 2]; }
  __syncthreads();
}

__device__ __forceinline__ void phase_final(const Params& p, int bid, int nblk) {
  const int wave = bid * 8 + (TIDX >> 6), lane = TIDX & 63, nw = nblk * 8;
  const float* X = (const float*)(p.ws + OFF_X);
  const bf16_t* OM = (const bf16_t*)(p.ws + OFF_OMOE);
  const float* g2 = (const float*)(p.ws + OFF_MOD) + (1 * 2 + 0) * 6144 + 5 * D;
  for (int rb = NCTX + wave * NRA; rb < TT; rb += nw * NRA) {
    f32x4 v[NRA][4]; u32x2 oa[NRA][4], ob[NRA][4];
#pragma unroll
    for (int k = 0; k < NRA; ++k)
#pragma unroll
      for (int i = 0; i < 4; ++i) { const int c = i * 256 + lane * 4, r = rb + k;
        v[k][i] = *(const f32x4*)(X + (size_t)r * D + c); oa[k][i] = *(const u32x2*)(OM + ((size_t)r * 2 + 0) * D + c); ob[k][i] = *(const u32x2*)(OM + ((size_t)r * 2 + 1) * D + c); }
#pragma unroll
    for (int k = 0; k < NRA; ++k)
#pragma unroll
      for (int i = 0; i < 4; ++i) { const int c = i * 256 + lane * 4; v[k][i] = v[k][i] * ALPHA + *(const f32x4*)(g2 + c) * (bf4(oa[k][i]) + bf4(ob[k][i])); }
    float mu[NRA], rs[NRA];
#pragma unroll
    for (int k = 0; k < NRA; ++k) mu[k] = wave_sum(hsum4(v[k])) * (1.f / D);
#pragma unroll
    for (int k = 0; k < NRA; ++k) rs[k] = rsqrtf(wave_sum(hsq4(v[k], mu[k])) * (1.f / D) + EPS);
#pragma unroll
    for (int k = 0; k < NRA; ++k)
#pragma unroll
      for (int i = 0; i < 4; ++i) {
        const int c = i * 256 + lane * 4;
        *(f32x4*)(p.out + (size_t)(rb + k - NCTX) * D + c) = (v[k][i] - mu[k]) * rs[k] * *(const f32x4*)(p.ln2_g + D + c) + *(const f32x4*)(p.ln2_b + D + c);
      }
  }
}

__device__ __forceinline__ void phase_p0(const Params& p, LAS char* lds, int bid, int nblk) {
  const int tid = TIDX;
  const long gtid = (long)bid * 512 + tid, gth = (long)nblk * 512;
  LAS float* sc = (LAS float*)lds;
  LAS float* red = (LAS float*)(lds + 8192);
  for (int i = tid; i < 2048; i += 512) { const float v = i < 1024 ? p.c[i] : p.c_ctx[i - 1024]; sc[i] = silu(v); }
  __syncthreads();
  float* mod = (float*)(p.ws + OFF_MOD);
  for (int u = bid; u < 384; u += nblk) {
    const int layer = u / 192, cg = u % 192, col = tid & 31, ksl = tid >> 5;
    const float* w = p.w_mod + ((size_t)layer * D + ksl * 64) * 6144 + cg * 32 + col;
    float a0 = 0.f, a1 = 0.f;
#pragma unroll 8
    for (int k = 0; k < 64; ++k) { const float wv = w[(size_t)k * 6144]; a0 += sc[ksl * 64 + k] * wv; a1 += sc[1024 + ksl * 64 + k] * wv; }
    red[(ksl * 32 + col) * 2] = a0; red[(ksl * 32 + col) * 2 + 1] = a1;
    __syncthreads();
    if (tid < 64) {
      const int c2 = tid & 31, s = tid >> 5; float a = 0.f;
#pragma unroll
      for (int k = 0; k < 16; ++k) a += red[(k * 32 + c2) * 2 + s];
      mod[(layer * 2 + s) * 6144 + cg * 32 + c2] = a + p.b_mod[layer * 6144 + cg * 32 + c2];
    }
    __syncthreads();
  }
  if (gtid < 256 * 16) {
    const int pos = (int)gtid / 16, f = (int)gtid % 16;
    const float ang = (float)pos * powf(10000.f, -(float)f / 16.f);
    float* rt = (float*)(p.ws + OFF_ROPE);
    rt[gtid * 2 + 0] = cosf(ang); rt[gtid * 2 + 1] = sinf(ang);
  }
  if (gtid < 2 * NE * CNT_STRIDE) ((int*)(p.ws + OFF_CNT))[gtid] = 0;
  if (gtid == 0) {
    float bmax = 0.f;
    for (int l = 0; l < 2; ++l) {
      float gq = 0.f, gk = 0.f;
      for (int i = 0; i < 64; ++i) { gq = fmaxf(gq, fabsf(p.q_gain[l * 64 + i])); gk = fmaxf(gk, fabsf(p.k_gain[l * 64 + i])); }
      bmax = fmaxf(bmax, 11.55f * gq * gk);
    }
    ((int*)(p.ws + OFF_FLAG))[0] = (bmax <= 100.f) ? 1 : 0;
  }
  for (long i = gtid; i < 2 * 65536; i += gth) { const int l = (int)(i >> 16), d = (int)(i >> 8) & 255, c = (int)i & 255; ((bf16_t*)(p.ws + OFF_WPWT))[i] = f2bf(p.w_cv_pw[((size_t)l * 256 + c) * 256 + d]); }
  for (long i = gtid; i < 8 * 4096; i += gth) { const int lg = (int)(i >> 12), d = (int)(i >> 6) & 63, c = (int)i & 63; ((bf16_t*)(p.ws + OFF_WPOOLT))[i] = f2bf(p.w_pool[((size_t)lg * 64 + c) * 64 + d]); }
  cvt_range(p.w_in, (bf16_t*)(p.ws + OFF_WIN), 2L * D * INW / 8, gtid, gth);
  cvt_range(p.w_out, (bf16_t*)(p.ws + OFF_WOUT), 2L * D * D / 8, gtid, gth);
  cvt_range(p.w_e_gate, (bf16_t*)(p.ws + OFF_WG), 2L * NE * D * DE / 8, gtid, gth);
  cvt_range(p.w_e_up, (bf16_t*)(p.ws + OFF_WU), 2L * NE * D * DE / 8, gtid, gth);
  cvt_range(p.w_e_down, (bf16_t*)(p.ws + OFF_WD), 2L * NE * D * DE / 8, gtid, gth);
}
#define XB_TMO      128
#define XB_XCNT(j)  (256  + 64 * (j))
#define XB_XSUB(j)  (1280 + 64 * (j))
#define XB_XGEN(j)  (2304 + 64 * (j))
#define XB_TOP      3328
#define XB_TOPGEN   3392
#define XCD_BAR_WORDS 3456
#define XB_SPIN_CAP (1u << 22)
__device__ __forceinline__ unsigned xb_ld(unsigned* p)              { return __hip_atomic_load(p, __ATOMIC_RELAXED, __HIP_MEMORY_SCOPE_AGENT); }
__device__ __forceinline__ unsigned xb_add(unsigned* p, unsigned v) { return __hip_atomic_fetch_add(p, v, __ATOMIC_RELAXED, __HIP_MEMORY_SCOPE_AGENT); }
__device__ __forceinline__ unsigned xb_xcc_id() { return (unsigned)__builtin_amdgcn_s_getreg((3 << 11) | 20) & 0xFu; }
#define XB_SPIN(cond, bar) do { unsigned _sp = 0; while (cond) { __builtin_amdgcn_s_sleep(1); \
    if ((++_sp & 255u) == 0u) { if (xb_ld(&(bar)[XB_TMO])) break; if (_sp > XB_SPIN_CAP) { atomicAdd(&(bar)[XB_TMO], 1u); break; } } } } while (0)
struct XcdBarrier { unsigned* bar; unsigned x; volatile LAS unsigned* st; };
__device__ __forceinline__ XcdBarrier xcd_barrier_post(unsigned* bar, volatile LAS unsigned* st) {
  XcdBarrier b; b.bar = bar; b.x = xb_xcc_id(); b.st = st;
  if (threadIdx.x == 0) (void)xb_add(&bar[XB_XCNT(b.x)], 1u);
  return b;
}
__device__ __forceinline__ void xcd_barrier_complete(unsigned* bar, unsigned x, unsigned& nloc, unsigned& nx) {
  const unsigned G = gridDim.x * gridDim.y * gridDim.z;
  unsigned sum, cnt, mine, sp = 0u;
  for (;;) {
    sum = 0u; cnt = 0u; mine = 0u;
#pragma unroll
    for (unsigned j = 0; j < 16; ++j) { const unsigned c = xb_ld(&bar[XB_XCNT(j)]); sum += c; cnt += (c > 0u) ? 1u : 0u; mine = (j == x) ? c : mine; }
    if (sum == G) break;
    __builtin_amdgcn_s_sleep(1);
    if ((++sp & 255u) == 0u) { if (xb_ld(&bar[XB_TMO])) break; if (sp > XB_SPIN_CAP) { atomicAdd(&bar[XB_TMO], 1u); break; } }
  }
  nloc = mine > 0u ? mine : 1u; nx = cnt > 0u ? cnt : 1u;
}
__device__ __forceinline__ void xcd_barrier(const XcdBarrier& b) {
  asm volatile("s_waitcnt vmcnt(0)" ::: "memory");
  __syncthreads();
  if (threadIdx.x == 0) {
    unsigned* bar = b.bar; unsigned bx = b.x;
    asm volatile("" : "+s"(bar), "+s"(bx));
    __builtin_amdgcn_s_waitcnt(0);
    unsigned nloc = b.st[0], nx = b.st[1];
    if (nloc == 0u) { xcd_barrier_complete(bar, bx, nloc, nx); b.st[0] = nloc; b.st[1] = nx; }
    const unsigned old = xb_add(&bar[XB_XSUB(bx)], 1u);
    const unsigned gen = old / nloc;
    if (old + 1u == (gen + 1u) * nloc) {
      __builtin_amdgcn_fence(__ATOMIC_RELEASE, "agent");
      asm volatile("s_waitcnt vmcnt(0)" ::: "memory");
      const unsigned og = xb_add(&bar[XB_TOP], 1u);
      const unsigned tg = og / nx;
      if (og + 1u == (tg + 1u) * nx) xb_add(&bar[XB_TOPGEN], 1u);
      else XB_SPIN(xb_ld(&bar[XB_TOPGEN]) == tg, bar);
      __builtin_amdgcn_fence(__ATOMIC_ACQUIRE, "agent");
      xb_add(&bar[XB_XGEN(bx)], 1u);
      asm volatile("s_waitcnt vmcnt(0)" ::: "memory");
    } else {
      XB_SPIN(xb_ld(&bar[XB_XGEN(bx)]) == gen, bar);
      __builtin_amdgcn_fence(__ATOMIC_ACQUIRE, "agent");
      asm volatile("s_waitcnt vmcnt(0)" ::: "memory");
    }
  }
  __syncthreads();
}

constexpr int LDS_MAIN = PC_LDS > GEMM_LDS + 256 ? PC_LDS : GEMM_LDS + 256;
constexpr int LDS_TOTAL = LDS_MAIN + 16;
static_assert(GEMM_LDS + 256 <= LDS_MAIN && ATT_LDS <= LDS_MAIN, "lds");
__global__ void __launch_bounds__(512) mega_fwd(Params p) {
  __shared__ __attribute__((aligned(16))) char slds[LDS_TOTAL];
  LAS char* lds = (LAS char*)slds;
  volatile LAS unsigned* st = (volatile LAS unsigned*)(lds + LDS_MAIN);
  if (threadIdx.x < 4) st[threadIdx.x] = 0u;
  __syncthreads();
  const XcdBarrier bar = xcd_barrier_post((unsigned*)(p.ws + OFF_BAR), st);
  const int bid = blockIdx.x, nblk = gridDim.x;
  phase_p0(p, lds, bid, nblk);
  xcd_barrier(bar);
#pragma unroll 1
  for (int layer = 0; layer < 2; ++layer) {
    phase_a0(p, layer, bid, nblk);
    xcd_barrier(bar);
    phase_a1(p, layer, lds, bid, nblk);
    xcd_barrier(bar);
    phase_b(p, layer, lds, bid, nblk);
    xcd_barrier(bar);
    phase_c1(p, layer, lds, bid, nblk);
    xcd_barrier(bar);
    phase_c2(p, layer, lds, bid, nblk);
    xcd_barrier(bar);
    phase_d1(p, layer, lds, bid, nblk);
    xcd_barrier(bar);
    phase_d2(p, layer, lds, bid, nblk);
    xcd_barrier(bar);
  }
  phase_final(p, bid, nblk);
}

extern "C" void kernel_launch(void* const* d_in, const int* in_sizes, int n_in, void* d_out, int out_size, void* d_ws, size_t ws_size,
                              hipStream_t stream) {
  static int grid = 0;
  if (grid == 0) {
    if (ws_size < WS_END || n_in != 28) { fprintf(stderr, "kernel_launch: ws too small (%zu < %zu) or n_in %d != 28; nothing launched\n", ws_size, (size_t)WS_END, n_in); grid = -1; return; }
    int dev = 0, cus = 0, per_cu = 0;
    if (hipGetDevice(&dev) != hipSuccess || hipDeviceGetAttribute(&cus, hipDeviceAttributeMultiprocessorCount, dev) != hipSuccess) { grid = -1; return; }
    if (hipOccupancyMaxActiveBlocksPerMultiprocessor(&per_cu, (const void*)mega_fwd, 512, 0) != hipSuccess || per_cu < 1) {
      fprintf(stderr, "kernel_launch: occupancy query says %d blocks per CU; nothing launched\n", per_cu); grid = -1; return; }
    (void)hipGetLastError();
    grid = cus;
  }
  if (grid < 0) return;
  if (hipMemsetAsync((char*)d_ws + OFF_BAR, 0, BAR_BYTES, stream) != hipSuccess) { fprintf(stderr, "kernel_launch: memset failed\n"); return; }
  Params p{};
  const float** f = (const float**)&p;
  for (int i = 0; i < 28; ++i) f[i] = (const float*)d_in[i];
  p.out = (float*)d_out; p.ws = (char*)d_ws;
  hipLaunchKernelGGL(mega_fwd, dim3(grid), dim3(512), 0, stream, p);
}
```

```cpp
#include <hip/hip_runtime.h>
#include <cstdio>
#include <cstdint>

typedef unsigned short bf16_t;
#define LAS __attribute__((address_space(3)))

constexpr int D = 1024, SEQ = 16384, NCTX = 256, TT = SEQ + NCTX;
constexpr int INW = 1536;
constexpr int NE = 32, DE = 512;
constexpr int CAPL = 2 * TT;
constexpr int HMID_ROWS = 2 * TT + NE * 128;
constexpr float ALPHA = 1.41421356237309515f;
constexpr float EPS = 1e-6f;

constexpr size_t al(size_t x) { return (x + 255) / 256 * 256; }
constexpr size_t OFF_BAR = 0;
constexpr size_t BAR_BYTES = 3456 * 4;
constexpr size_t OFF_MOD = OFF_BAR + al(BAR_BYTES);
constexpr size_t OFF_ROPE = OFF_MOD + al(2 * 2 * 6144 * 4);
constexpr int CNT_STRIDE = 32;
constexpr size_t OFF_CNT = OFF_ROPE + al(256 * 16 * 2 * 4);
constexpr size_t OFF_FLAG = OFF_CNT + al(2 * 32 * 32 * 4);
constexpr size_t OFF_X = OFF_FLAG + 256;
constexpr size_t OFF_H = OFF_X + al((size_t)TT * D * 4);
constexpr size_t OFF_MIX = OFF_H + al((size_t)TT * D * 2);
constexpr size_t OFF_Y = OFF_MIX + al((size_t)TT * D * 2);
constexpr size_t OFF_Q = OFF_Y + al((size_t)TT * D * 2);
constexpr size_t OFF_K = OFF_Q + al((size_t)TT * 512 * 2);
constexpr size_t OFF_V = OFF_K + al((size_t)TT * 128 * 2);
constexpr size_t OFF_U = OFF_V + al((size_t)TT * 128 * 2);
constexpr size_t OFF_AG = OFF_U + al((size_t)TT * 256 * 4);
constexpr size_t OFF_HMID = OFF_Q;
constexpr size_t OFF_OMOE = OFF_AG + al((size_t)TT * 512 * 2);
constexpr size_t OFF_GATE = OFF_OMOE + al((size_t)TT * 2 * D * 2);
constexpr size_t OFF_LIST = OFF_GATE + al((size_t)TT * 2 * 4);
constexpr size_t OFF_WIN = OFF_LIST + al((size_t)NE * CAPL * 4);
constexpr size_t OFF_WOUT = OFF_WIN + al((size_t)2 * D * INW * 2);
constexpr size_t OFF_WPWT = OFF_WOUT + al((size_t)2 * D * D * 2);
constexpr size_t OFF_WPOOLT = OFF_WPWT + al((size_t)2 * 256 * 256 * 2);
constexpr size_t OFF_WG = OFF_WPOOLT + al((size_t)2 * 4 * 64 * 64 * 2);
constexpr size_t OFF_WU = OFF_WG + al((size_t)2 * NE * D * DE * 2);
constexpr size_t OFF_WD = OFF_WU + al((size_t)2 * NE * D * DE * 2);
constexpr size_t WS_END = OFF_WD + al((size_t)2 * NE * D * DE * 2);
static_assert(OFF_AG - OFF_HMID >= (size_t)HMID_ROWS * DE * 2, "HMID alias too small");
static_assert(WS_END < 530000000, "ws budget");

struct Params {
  const float *x, *c, *ctx, *c_ctx, *w_mod, *b_mod, *w_in, *q_gain, *k_gain, *w_pool, *pool_scale, *w_dw, *b_dw,
      *cv_ln_g, *cv_ln_b, *w_cv_pw, *w_out, *ln1_g, *ln1_b, *ln2_g, *ln2_b, *w_rg, *b_rg, *w_re, *b_re, *w_e_gate, *w_e_up, *w_e_down;
  float* out;
  char* ws;
};

__device__ __forceinline__ float bf2f(bf16_t v) { return __uint_as_float(((unsigned)v) << 16); }
__device__ __forceinline__ bf16_t f2bf(float f) {
  unsigned u = __float_as_uint(f);
  u += 0x7fffu + ((u >> 16) & 1u);
  return (bf16_t)(u >> 16);
}
template <int CTRL> __device__ __forceinline__ float dppf(float v) { return __int_as_float(__builtin_amdgcn_update_dpp(0, __float_as_int(v), CTRL, 0xf, 0xf, true)); }
__device__ __forceinline__ float wave_sum(float v) {
  v += dppf<0xB1>(v); v += dppf<0x4E>(v); v += dppf<0x141>(v); v += dppf<0x140>(v);
  { auto r = __builtin_amdgcn_permlane16_swap(__float_as_uint(v), __float_as_uint(v), false, false); v = __uint_as_float(r[0]) + __uint_as_float(r[1]); }
  { auto r = __builtin_amdgcn_permlane32_swap(__float_as_uint(v), __float_as_uint(v), false, false); v = __uint_as_float(r[0]) + __uint_as_float(r[1]); }
  return v;
}
__device__ __forceinline__ float silu(float v) { return v / (1.f + __expf(-v)); }
__device__ __forceinline__ int opaque0() { int z; asm volatile("s_mov_b32 %0, 0" : "=s"(z)); return z; }
#define TIDX ((int)threadIdx.x + opaque0())
using bf16x8 = __attribute__((ext_vector_type(8))) short;
using s16x4 = __attribute__((ext_vector_type(4))) short;
using f32x16 = __attribute__((ext_vector_type(16))) float;
using f32x4 = __attribute__((ext_vector_type(4))) float;
using u32x4 = __attribute__((ext_vector_type(4))) unsigned;
using u32x2 = __attribute__((ext_vector_type(2))) unsigned;

__device__ __forceinline__ int crow(int r, int hi) { return (r & 3) + 8 * (r >> 2) + 4 * hi; }
typedef float f32x2 __attribute__((ext_vector_type(2)));
typedef __bf16 bf16x2v __attribute__((ext_vector_type(2)));
__device__ __forceinline__ unsigned cvtpk(float lo, float hi) {
  bf16x2v b = __builtin_convertvector((f32x2){lo, hi}, bf16x2v);
  return __builtin_bit_cast(unsigned, b);
}
__device__ __forceinline__ float sum32(float v) {
  auto rr = __builtin_amdgcn_permlane32_swap(__float_as_uint(v), __float_as_uint(v), false, false);
  return __uint_as_float(rr[0]) + __uint_as_float(rr[1]);
}

__device__ __forceinline__ void cvt_range(const float* __restrict__ src, bf16_t* __restrict__ dst, long n8, long gtid, long gthreads) {
  for (long i = gtid; i < n8; i += gthreads) {
    const f32x4 a = *(const f32x4*)(src + i * 8), b = *(const f32x4*)(src + i * 8 + 4);
    u32x4 w = {cvtpk(a[0], a[1]), cvtpk(a[2], a[3]), cvtpk(b[0], b[1]), cvtpk(b[2], b[3])};
    *(u32x4*)(dst + i * 8) = w;
  }
}

__device__ __forceinline__ int xoff(int row, int chunk) { return row * 128 + ((chunk ^ ((row >> 1) & 7)) << 4); }
__device__ __forceinline__ int wst(int k, int c) { const int kk = (k & ~0xC) | ((k & 4) << 1) | ((k & 8) >> 1); return ((kk >> 3) * 4 + (c >> 5)) * 512 + ((kk & 7) * 32 + (c & 31)) * 2; }
__device__ __forceinline__ int v_rd_base(int lane) { return ((lane & 3) << 3) | (((lane >> 2) & 3) << 6) | (((lane >> 4) & 1) << 5) | (((lane >> 5) & 1) << 8); }

__device__ __forceinline__ bf16x8 tr_frag(const LAS char* p) {
  s16x4 a = __builtin_amdgcn_ds_read_tr16_b64_v4i16((LAS s16x4*)p);
  s16x4 b = __builtin_amdgcn_ds_read_tr16_b64_v4i16((LAS s16x4*)(p + 2048));
  return (bf16x8){a[0], a[1], a[2], a[3], b[0], b[1], b[2], b[3]};
}

template <int OFF> __device__ __forceinline__ bf16x8 tr_frag_asm(int addr) {
  s16x4 a, b;
  asm volatile("ds_read_b64_tr_b16 %0, %1 offset:%2" : "=&v"(a) : "v"(addr), "i"(OFF) : "memory");
  asm volatile("ds_read_b64_tr_b16 %0, %1 offset:%2" : "=&v"(b) : "v"(addr), "i"(OFF + 2048) : "memory");
  return (bf16x8){a[0], a[1], a[2], a[3], b[0], b[1], b[2], b[3]};
}

template <int BM, int BN> struct GemmCfg {
  static constexpr int WM = BM / 64, WN = 8 / WM, NSLAB = BN / 128, XB = BM * 128, WB = NSLAB * 16384, STAGE = XB + WB, NXP = BM / 64, NWP = NSLAB * 2;
  static_assert(WM * WN == 8 && WN * 64 == BN, "tile");
};
constexpr int GEMM_LDS = 3 * (256 * 128 + 16384);

template <int BM, int BN, int NMAP, bool BG = false, class XRow, class WPtr>
__device__ __forceinline__ void gemm_mainloop(LAS char* lds, f32x16 (&acc)[2][2], const XRow& xrow, const WPtr& wptr, int ldw, int K, int& bgdone, int bgn = 0, long bgc0 = 0,
                                              const float* bs0 = nullptr, const float* bs1 = nullptr, const float* bs2 = nullptr, bf16_t* bd0 = nullptr, bf16_t* bd1 = nullptr, bf16_t* bd2 = nullptr) {
#define BG_ISSUE(i, a, b) do { long c_ = bgc0 + (long)(i) * 512; if (c_ >= (3L << 21)) c_ = 0; const int t_ = (int)(c_ >> 21); const long o_ = (c_ & 0x1fffff) * 8; \
    const float* sp_ = (t_ == 0 ? bs0 : (t_ == 1 ? bs1 : bs2)) + o_; a = *(const f32x4*)sp_; b = *(const f32x4*)(sp_ + 4); } while (0)
#define BG_RETIRE(i, a, b) do { const long c_ = bgc0 + (long)(i) * 512; if (c_ < (3L << 21)) { const int t_ = (int)(c_ >> 21); const long o_ = (c_ & 0x1fffff) * 8; \
    bf16_t* dp_ = (t_ == 0 ? bd0 : (t_ == 1 ? bd1 : bd2)) + o_; *(u32x4*)dp_ = (u32x4){cvtpk(a[0], a[1]), cvtpk(a[2], a[3]), cvtpk(b[0], b[1]), cvtpk(b[2], b[3])}; } } while (0)
  using C = GemmCfg<BM, BN>;
  const int tid = TIDX, wid = tid >> 6, lane = tid & 63, r32 = lane & 31, hi = lane >> 5;
  const int wm = wid / C::WN, wn = wid % C::WN;
  const bf16_t *g0, *g1, *g2, *g3, *g4, *g5; int l0, l1, l2, l3, l4, l5;
  auto xpiece = [&](int i, const bf16_t*& gp, int& lp) { const int q = wid * C::NXP + i, row = 8 * q + (lane >> 3), c = (lane & 7) ^ ((row >> 1) & 7); gp = xrow(row) + c * 8; lp = q * 1024; };
  auto wpiece = [&](int i, const bf16_t*& gp, int& lp) {
    const int idx = wid * C::NWP + i, s = idx >> 4, q = idx & 15, sub = 2 * q + (lane >> 5), kk = (sub >> 2) * 8 + ((lane & 31) >> 2);
    const int k = (kk & ~0xC) | ((kk & 4) << 1) | ((kk & 8) >> 1), c = (sub & 3) * 32 + (lane & 3) * 8;
    gp = wptr(s) + (size_t)k * ldw + c; lp = C::XB + s * 16384 + q * 1024; };
  if (C::NXP == 4) { xpiece(0, g0, l0); xpiece(1, g1, l1); xpiece(2, g2, l2); xpiece(3, g3, l3); wpiece(0, g4, l4); wpiece(1, g5, l5); }
  else { xpiece(0, g0, l0); xpiece(1, g1, l1); wpiece(0, g2, l2); wpiece(1, g3, l3); wpiece(2, g4, l4); wpiece(3, g5, l5); }
  const size_t stepx = 64, stepw = (size_t)64 * ldw;
  const size_t stp0 = stepx, stp1 = stepx, stp2 = C::NXP == 4 ? stepx : stepw, stp3 = C::NXP == 4 ? stepx : stepw, stp4 = stepw, stp5 = stepw;
  int xr[2];
#pragma unroll
  for (int ti = 0; ti < 2; ++ti) xr[ti] = (wm * 64 + ti * 32 + r32) * 128;
  const int xsw = (r32 >> 1) & 7;
  int wr[2];
#pragma unroll
  for (int ni = 0; ni < 2; ++ni) {
    const int slab = NMAP == 0 ? 0 : (NMAP == 1 ? (wn >> 1) : ni);
    const int nb = NMAP == 0 ? (2 * wn + ni) : (NMAP == 1 ? ((wn & 1) * 2 + ni) : wn);
    wr[ni] = C::XB + slab * 16384 + nb * 512 + v_rd_base(lane);
  }
  const int nk = K / 64;
#define G_DMA1(gp, sp, lp, kt, _d) __builtin_amdgcn_global_load_lds((const unsigned*)((gp) + (size_t)(kt) * (sp)), (LAS unsigned*)((_d) + (lp)), 16, 0, 0)
#define G_DMA(kt, st) do { LAS char* _d = lds + (st) * C::STAGE; \
    G_DMA1(g0, stp0, l0, kt, _d); G_DMA1(g1, stp1, l1, kt, _d); G_DMA1(g2, stp2, l2, kt, _d); G_DMA1(g3, stp3, l3, kt, _d); G_DMA1(g4, stp4, l4, kt, _d); G_DMA1(g5, stp5, l5, kt, _d); } while (0)
#define G_HALF(cur, wa0, wa1, H) do { bf16x8 xf[2][2], wf[2][2]; \
      _Pragma("unroll") for (int k2 = 0; k2 < 2; ++k2) _Pragma("unroll") for (int ti = 0; ti < 2; ++ti) xf[k2][ti] = *(const LAS bf16x8*)(cur + xr[ti] + ((((H * 2 + k2) * 2 + hi) ^ xsw) << 4)); \
      wf[0][0] = tr_frag_asm<(H * 2 + 0) * 4096>(wa0); wf[0][1] = tr_frag_asm<(H * 2 + 0) * 4096>(wa1); \
      wf[1][0] = tr_frag_asm<(H * 2 + 1) * 4096>(wa0); wf[1][1] = tr_frag_asm<(H * 2 + 1) * 4096>(wa1); \
      asm volatile("s_waitcnt lgkmcnt(0)" ::: "memory"); __builtin_amdgcn_sched_barrier(0); \
      _Pragma("unroll") for (int k2 = 0; k2 < 2; ++k2) _Pragma("unroll") for (int ti = 0; ti < 2; ++ti) _Pragma("unroll") for (int ni = 0; ni < 2; ++ni) \
        acc[ti][ni] = __builtin_amdgcn_mfma_f32_32x32x16_bf16(wf[k2][ni], xf[k2][ti], acc[ti][ni], 0, 0, 0); } while (0)
#define G_COMPUTE(st) do { const LAS char* cur = lds + (st) * C::STAGE; const int wa0 = (int)(uintptr_t)(cur + wr[0]), wa1 = (int)(uintptr_t)(cur + wr[1]); \
    G_HALF(cur, wa0, wa1, 0); G_HALF(cur, wa0, wa1, 1); } while (0)
  static_assert(C::NXP + C::NWP == 6, "vmcnt(6) below assumes 6 DMA pieces per wave per k-tile");
  G_DMA(0, 0); G_DMA(1, 1);
  int st = 0;
  f32x4 bga, bgb; int bgi = -1, bgy1 = 0, bgy2 = 0;
  for (int kt = 0; kt < nk; ++kt) {
    if (kt + 1 < nk) {
      const int young = BG ? (bgy1 + bgy2) : 0;
      if (young == 0) asm volatile("s_waitcnt vmcnt(6)" ::: "memory"); else if (young == 1) asm volatile("s_waitcnt vmcnt(8)" ::: "memory"); else asm volatile("s_waitcnt vmcnt(10)" ::: "memory");
    } else asm volatile("s_waitcnt vmcnt(0)" ::: "memory");
    asm volatile("s_waitcnt lgkmcnt(0)" ::: "memory"); __builtin_amdgcn_s_barrier();
    const int s2 = st == 0 ? 2 : st - 1;
    if (kt + 2 < nk) G_DMA(kt + 2, s2);
    if (BG) {
      bgy2 = bgy1; bgy1 = 0;
      if (bgi >= 0) { BG_RETIRE(bgi, bga, bgb); bgi = -1; }
      if (bgdone < bgn) { bgi = bgdone++; BG_ISSUE(bgi, bga, bgb); bgy1 = 1; }
    }
    G_COMPUTE(st);
    st = st == 2 ? 0 : st + 1;
  }
  if (BG) { if (bgi >= 0) BG_RETIRE(bgi, bga, bgb); }
  asm volatile("s_waitcnt lgkmcnt(0)" ::: "memory"); __builtin_amdgcn_s_barrier();
#undef G_DMA
#undef G_DMA1
#undef G_COMPUTE
#undef G_HALF
}

__device__ __forceinline__ u32x2 pack4(const f32x16& a, int g) { return (u32x2){cvtpk(a[4 * g], a[4 * g + 1]), cvtpk(a[4 * g + 2], a[4 * g + 3])}; }

__device__ __forceinline__ void phase_a1(const Params& p, int layer, LAS char* lds, int bid, int nblk) {
  const bf16_t* H = (const bf16_t*)(p.ws + OFF_H);
  const bf16_t* W = (const bf16_t*)(p.ws + OFF_WIN) + (size_t)layer * D * INW;
  bf16_t* Q = (bf16_t*)(p.ws + OFF_Q); bf16_t* Kb = (bf16_t*)(p.ws + OFF_K); bf16_t* Vb = (bf16_t*)(p.ws + OFF_V);
  float* U = (float*)(p.ws + OFF_U); bf16_t* AG = (bf16_t*)(p.ws + OFF_AG);
  const float* rt = (const float*)(p.ws + OFF_ROPE);
  const int lane = TIDX & 63, wid = TIDX >> 6, r32 = lane & 31, hi = lane >> 5, wm = wid >> 1, wn = wid & 1;
  const size_t wo = (size_t)layer * NE * D * DE;
  const int bgn = (3 * (1 << 21) + nblk * 512 - 1) / (nblk * 512);
  const long bgc0 = (long)bid * bgn * 512 + (TIDX);
  const float* bs0 = p.w_e_gate + wo; const float* bs1 = p.w_e_up + wo; const float* bs2 = p.w_e_down + wo;
  bf16_t* bd0 = (bf16_t*)(p.ws + OFF_WG) + wo; bf16_t* bd1 = (bf16_t*)(p.ws + OFF_WU) + wo; bf16_t* bd2 = (bf16_t*)(p.ws + OFF_WD) + wo;
  int bgdone = 0;
  const int nlat = 64 * 12, nctx = layer == 0 ? 12 : 2, nunits = nlat + nctx;
  const bool xmap = (nblk & 7) == 0;
  const int xcd = bid & 7, lb = bid >> 3, nlb = nblk >> 3, nl = lb < 96 ? (96 - lb + nlb - 1) / nlb : 0;
  for (int it = 0;; ++it) {
    int rtile, ct;
    if (xmap) {
      if (it < nl) { const int v = lb + it * nlb; rtile = 1 + xcd + 8 * (v / 12); ct = v % 12; }
      else { const int e2 = bid + (it - nl) * nblk; if (e2 >= nctx) break; rtile = 0; ct = layer == 0 ? e2 : 4 + e2; }
    } else {
      const int u = bid + it * nblk; if (u >= nunits) break;
      if (u < nlat) { rtile = 1 + u / 12; ct = u % 12; } else { rtile = 0; ct = layer == 0 ? (u - nlat) : (4 + u - nlat); }
    }
    const int m0 = rtile * 256, n0 = ct * 128;
    f32x16 acc[2][2];
#pragma unroll
    for (int a = 0; a < 2; ++a)
#pragma unroll
      for (int b = 0; b < 2; ++b) acc[a][b] = (f32x16){};
    gemm_mainloop<256, 128, 0, true>(lds, acc, [&](int row) { return H + (size_t)(m0 + row) * D; }, [&](int) { return W + n0; }, INW, D, bgdone, bgn, bgc0, bs0, bs1, bs2, bd0, bd1, bd2);
#pragma unroll
    for (int ti = 0; ti < 2; ++ti) {
      const int tok = m0 + wm * 64 + ti * 32 + r32;
      if (ct < 5) {
        float ss = 0.f;
#pragma unroll
        for (int ni = 0; ni < 2; ++ni)
#pragma unroll
          for (int r = 0; r < 16; ++r) ss += acc[ti][ni][r] * acc[ti][ni][r];
        ss = sum32(ss);
        const float rs = rsqrtf(ss * (1.f / 64.f) + EPS);
        const float* gain = (ct < 4 ? p.q_gain : p.k_gain) + layer * 64;
        const float osc = ct < 4 ? 0.125f * 1.4426950408889634f : 1.f;
        const bool lat = rtile > 0;
        const int t = tok - NCTX;
#pragma unroll
        for (int ni = 0; ni < 2; ++ni) {
          f32x16 v;
#pragma unroll
          for (int r = 0; r < 16; ++r) v[r] = acc[ti][ni][r] * rs * gain[ni * 32 + crow(r, hi)];
          if (lat) {
            const int pos = ni == 0 ? (t >> 6) : (t & 63);
#pragma unroll
            for (int r = 0; r < 8; ++r) {
              const int f = crow(r, hi);
              const float cs = rt[(pos * 16 + f) * 2], sn = rt[(pos * 16 + f) * 2 + 1];
              const float t1 = v[r], t2 = v[r + 8];
              v[r] = t1 * cs - t2 * sn; v[r + 8] = t2 * cs + t1 * sn;
            }
          }
#pragma unroll
          for (int r = 0; r < 16; ++r) v[r] *= osc;
          bf16_t* dst = ct < 4 ? Q + (size_t)tok * 512 + (ct * 2 + wn) * 64 + ni * 32 : Kb + (size_t)tok * 128 + wn * 64 + ni * 32;
#pragma unroll
          for (int g = 0; g < 4; ++g) *(u32x2*)(dst + 8 * g + 4 * hi) = pack4(v, g);
        }
      } else if (ct == 5) {
#pragma unroll
        for (int ni = 0; ni < 2; ++ni)
#pragma unroll
          for (int g = 0; g < 4; ++g) *(u32x2*)(Vb + (size_t)tok * 128 + wn * 64 + ni * 32 + 8 * g + 4 * hi) = pack4(acc[ti][ni], g);
      } else if (ct < 8) {
#pragma unroll
        for (int ni = 0; ni < 2; ++ni)
#pragma unroll
          for (int g = 0; g < 4; ++g)
            *(f32x4*)(U + (size_t)tok * 256 + (ct - 6) * 128 + wn * 64 + ni * 32 + 8 * g + 4 * hi) =
                (f32x4){acc[ti][ni][4 * g], acc[ti][ni][4 * g + 1], acc[ti][ni][4 * g + 2], acc[ti][ni][4 * g + 3]};
      } else {
#pragma unroll
        for (int ni = 0; ni < 2; ++ni)
#pragma unroll
          for (int g = 0; g < 4; ++g) *(u32x2*)(AG + (size_t)tok * 512 + (ct - 8) * 128 + wn * 64 + ni * 32 + 8 * g + 4 * hi) = pack4(acc[ti][ni], g);
      }
    }
  }
  while (bgdone < bgn) { f32x4 a, b2; const int i = bgdone++; BG_ISSUE(i, a, b2); BG_RETIRE(i, a, b2); }
}

__device__ __forceinline__ void phase_c1(const Params& p, int layer, LAS char* lds, int bid, int nblk) {
  const bf16_t* A = (const bf16_t*)(p.ws + OFF_MIX);
  const bf16_t* W = (const bf16_t*)(p.ws + OFF_WOUT) + (size_t)layer * D * D;
  bf16_t* Y = (bf16_t*)(p.ws + OFF_Y);
  const int lane = TIDX & 63, wid = TIDX >> 6, r32 = lane & 31, hi = lane >> 5, wm = wid >> 1, wn = wid & 1;
  const int nctx = layer == 0 ? 8 : 0;
  const bool xmap = (nblk & 7) == 0;
  const int xcd = bid & 7, lb = bid >> 3, nlb = nblk >> 3, nl = lb < 64 ? (64 - lb + nlb - 1) / nlb : 0;
  for (int it = 0;; ++it) {
    int rtile, ct;
    if (xmap) {
      if (it < nl) { const int v = lb + it * nlb; rtile = 1 + xcd + 8 * (v >> 3); ct = v & 7; }
      else { const int e2 = bid + (it - nl) * nblk; if (e2 >= nctx) break; rtile = 0; ct = e2; }
    } else {
      const int u = bid + it * nblk; if (u >= 64 * 8 + nctx) break;
      if (u < 512) { rtile = 1 + (u >> 3); ct = u & 7; } else { rtile = 0; ct = u - 512; }
    }
    const int m0 = rtile * 256, n0 = ct * 128;
    f32x16 acc[2][2];
#pragma unroll
    for (int a = 0; a < 2; ++a)
#pragma unroll
      for (int b = 0; b < 2; ++b) acc[a][b] = (f32x16){};
    { int nd = 0; gemm_mainloop<256, 128, 0>(lds, acc, [&](int row) { return A + (size_t)(m0 + row) * D; }, [&](int) { return W + n0; }, D, D, nd); }
#pragma unroll
    for (int ti = 0; ti < 2; ++ti) {
      const int tok = m0 + wm * 64 + ti * 32 + r32;
#pragma unroll
      for (int ni = 0; ni < 2; ++ni)
#pragma unroll
        for (int g = 0; g < 4; ++g) *(u32x2*)(Y + (size_t)tok * D + n0 + wn * 64 + ni * 32 + 8 * g + 4 * hi) = pack4(acc[ti][ni], g);
    }
  }
}

__device__ __forceinline__ void moe_prefix(const int* cnt, LAS int* pre, int xcd) {
  if (TIDX == 0) {
    int o = 0; for (int e = 0; e < NE; ++e) { pre[e] = o; o += (cnt[e * CNT_STRIDE] + 127) >> 7; } pre[NE] = o;
    int l = 0; for (int j = 0; j < 4; ++j) { pre[40 + j] = l; l += (cnt[(xcd + 8 * j) * CNT_STRIDE] + 127) >> 7; } pre[44] = l;
  }
  __syncthreads();
}
__device__ __forceinline__ bool moe_unit(const LAS int* pre, int bid, int nblk, int it, int& e, int& rt, int& ct, int& g) {
  if ((nblk & 7) == 0) {
    const int xcd = bid & 7, v = (bid >> 3) + it * (nblk >> 3), gl = v >> 2;
    if (gl >= pre[44]) return false;
    int j = 0; if (gl >= pre[41]) j = 1; if (gl >= pre[42]) j = 2; if (gl >= pre[43]) j = 3;
    e = xcd + 8 * j; rt = gl - pre[40 + j]; ct = v & 3; g = pre[e] + rt; return true;
  } else {
    const int u = bid + it * nblk; g = u >> 2; if (g >= pre[NE]) return false;
    int ee = 0; for (int i = 1; i < NE; ++i) ee += (pre[i] <= g) ? 1 : 0;
    e = ee; rt = g - pre[ee]; ct = u & 3; return true;
  }
}

__device__ __forceinline__ void phase_d1(const Params& p, int layer, LAS char* lds, int bid, int nblk) {
  const int* cnt = (const int*)(p.ws + OFF_CNT) + layer * NE * CNT_STRIDE;
  const bf16_t* H2 = (const bf16_t*)(p.ws + OFF_MIX);
  bf16_t* HM = (bf16_t*)(p.ws + OFF_HMID);
  LAS int* pre = (LAS int*)(lds + GEMM_LDS);
  moe_prefix(cnt, pre, bid & 7);
  const int lane = TIDX & 63, wid = TIDX >> 6, r32 = lane & 31, hi = lane >> 5, wm = wid >> 2, wn = wid & 3;
  for (int it = 0;; ++it) {
    int e, rt, ct, g; if (!moe_unit(pre, bid, nblk, it, e, rt, ct, g)) break;
    const int n = cnt[e * CNT_STRIDE];
    const int* list = (const int*)(p.ws + OFF_LIST) + (size_t)e * CAPL + rt * 128;
    const bf16_t* Wg = (const bf16_t*)(p.ws + OFF_WG) + ((size_t)layer * NE + e) * D * DE + ct * 128;
    const bf16_t* Wu = (const bf16_t*)(p.ws + OFF_WU) + ((size_t)layer * NE + e) * D * DE + ct * 128;
    const int nvalid = n - rt * 128;
    f32x16 acc[2][2];
#pragma unroll
    for (int a = 0; a < 2; ++a)
#pragma unroll
      for (int b = 0; b < 2; ++b) acc[a][b] = (f32x16){};
    int nd = 0;
    gemm_mainloop<128, 256, 2>(lds, acc, [&](int row) { const int tok = row < nvalid ? (list[row] >> 1) : 0; return H2 + (size_t)tok * D; },
                               [&](int s) { return s == 0 ? Wg : Wu; }, DE, D, nd);
    const size_t hrow0 = (size_t)(pre[e] + rt) * 128;
#pragma unroll
    for (int ti = 0; ti < 2; ++ti) {
      const size_t row = hrow0 + wm * 64 + ti * 32 + r32;
      f32x16 a;
#pragma unroll
      for (int r = 0; r < 16; ++r) { const float gv = acc[ti][0][r]; a[r] = gv / (1.f + __expf(-gv)) * acc[ti][1][r]; }
#pragma unroll
      for (int gq = 0; gq < 4; ++gq) *(u32x2*)(HM + row * DE + ct * 128 + wn * 32 + 8 * gq + 4 * hi) = pack4(a, gq);
    }
  }
}

__device__ __forceinline__ void phase_d2(const Params& p, int layer, LAS char* lds, int bid, int nblk) {
  const int* cnt = (const int*)(p.ws + OFF_CNT) + layer * NE * CNT_STRIDE;
  const bf16_t* HM = (const bf16_t*)(p.ws + OFF_HMID);
  const float* GATE = (const float*)(p.ws + OFF_GATE);
  bf16_t* OM = (bf16_t*)(p.ws + OFF_OMOE);
  LAS int* pre = (LAS int*)(lds + GEMM_LDS);
  moe_prefix(cnt, pre, bid & 7);
  const int lane = TIDX & 63, wid = TIDX >> 6, r32 = lane & 31, hi = lane >> 5, wm = wid >> 2, wn = wid & 3;
  for (int it = 0;; ++it) {
    int e, rt, ct, g; if (!moe_unit(pre, bid, nblk, it, e, rt, ct, g)) break;
    const int n = cnt[e * CNT_STRIDE];
    const int* list = (const int*)(p.ws + OFF_LIST) + (size_t)e * CAPL + rt * 128;
    const bf16_t* Wd = (const bf16_t*)(p.ws + OFF_WD) + ((size_t)layer * NE + e) * DE * D + ct * 256;
    const int nvalid = n - rt * 128;
    const bf16_t* A = HM + (size_t)g * 128 * DE;
    f32x16 acc[2][2];
#pragma unroll
    for (int a = 0; a < 2; ++a)
#pragma unroll
      for (int b = 0; b < 2; ++b) acc[a][b] = (f32x16){};
    { int nd = 0; gemm_mainloop<128, 256, 1>(lds, acc, [&](int row) { return A + (size_t)row * DE; }, [&](int s) { return Wd + s * 128; }, D, DE, nd); }
#pragma unroll
    for (int ti = 0; ti < 2; ++ti) {
      const int row = wm * 64 + ti * 32 + r32;
      if (row < nvalid) {
        const int ts = list[row];
        const float gt = GATE[ts];
#pragma unroll
        for (int ni = 0; ni < 2; ++ni) {
          f32x16 a;
#pragma unroll
          for (int r = 0; r < 16; ++r) a[r] = acc[ti][ni][r] * gt;
#pragma unroll
          for (int gq = 0; gq < 4; ++gq) *(u32x2*)(OM + (size_t)ts * D + ct * 256 + wn * 64 + ni * 32 + 8 * gq + 4 * hi) = pack4(a, gq);
        }
      }
    }
  }
}

constexpr int ATT_SLOT = 16384, ATT_LDS = 4 * ATT_SLOT;
__device__ __forceinline__ int vst64(int k, int c) { const int kk = (k & ~0xC) | ((k & 4) << 1) | ((k & 8) >> 1); return ((kk >> 3) * 2 + (c >> 5)) * 512 + ((kk & 7) * 32 + (c & 31)) * 2; }
__device__ __forceinline__ bf16x8 tr_frag64(const LAS char* p) {
  s16x4 a = __builtin_amdgcn_ds_read_tr16_b64_v4i16((LAS s16x4*)p);
  s16x4 b = __builtin_amdgcn_ds_read_tr16_b64_v4i16((LAS s16x4*)(p + 1024));
  return (bf16x8){a[0], a[1], a[2], a[3], b[0], b[1], b[2], b[3]};
}
__device__ __forceinline__ bf16x8 pk4(const f32x16& P, int B) {
  unsigned a0 = cvtpk(P[B + 0], P[B + 1]), a1 = cvtpk(P[B + 2], P[B + 3]), b0 = cvtpk(P[B + 4], P[B + 5]), b1 = cvtpk(P[B + 6], P[B + 7]);
  auto r0 = __builtin_amdgcn_permlane32_swap(a0, b0, false, false); auto r1 = __builtin_amdgcn_permlane32_swap(a1, b1, false, false);
  u32x4 w = {r0[0], r1[0], r0[1], r1[1]};
  return __builtin_bit_cast(bf16x8, w);
}
struct AttnCtx { int krd0, krd1, ksw, hi, vrd; };
#define SBAR() __builtin_amdgcn_sched_barrier(0)
__device__ __forceinline__ void att_kload(const LAS char* slot, const AttnCtx& c, bf16x8 (&kf)[8]) {
#pragma unroll
  for (int d0 = 0; d0 < 4; ++d0) {
    kf[2 * d0] = *(const LAS bf16x8*)(slot + c.krd0 + (((2 * d0 + c.hi) ^ c.ksw) << 4));
    kf[2 * d0 + 1] = *(const LAS bf16x8*)(slot + c.krd1 + (((2 * d0 + c.hi) ^ c.ksw) << 4));
  }
}
__device__ __forceinline__ void att_qk(const bf16x8 (&kf)[8], const bf16x8 (&qr)[4], f32x16& s0, f32x16& s1) {
  s0 = (f32x16){}; s1 = (f32x16){};
#pragma unroll
  for (int d0 = 0; d0 < 4; ++d0) {
    s0 = __builtin_amdgcn_mfma_f32_32x32x16_bf16(kf[2 * d0], qr[d0], s0, 0, 0, 0);
    s1 = __builtin_amdgcn_mfma_f32_32x32x16_bf16(kf[2 * d0 + 1], qr[d0], s1, 0, 0, 0);
  }
}
__device__ __forceinline__ void att_exp(f32x16& s, float& l) {
#pragma unroll
  for (int r = 0; r < 16; ++r) { s[r] = __builtin_amdgcn_exp2f(s[r]); l += s[r]; }
  asm volatile("" : "+v"(l));
}
template <int KS0>
__device__ __forceinline__ void att_vload(const LAS char* slot, const AttnCtx& c, bf16x8 (&vf)[4]) {
#pragma unroll
  for (int i = 0; i < 2; ++i) { vf[2 * i] = tr_frag64(slot + c.vrd + (KS0 + i) * 2048); vf[2 * i + 1] = tr_frag64(slot + c.vrd + 512 + (KS0 + i) * 2048); }
}
__device__ __forceinline__ void att_pv2(const bf16x8& pa, const bf16x8& pb, const bf16x8 (&vf)[4], f32x16& o0, f32x16& o1) {
  o0 = __builtin_amdgcn_mfma_f32_32x32x16_bf16(pa, vf[0], o0, 0, 0, 0);
  o1 = __builtin_amdgcn_mfma_f32_32x32x16_bf16(pa, vf[1], o1, 0, 0, 0);
  o0 = __builtin_amdgcn_mfma_f32_32x32x16_bf16(pb, vf[2], o0, 0, 0, 0);
  o1 = __builtin_amdgcn_mfma_f32_32x32x16_bf16(pb, vf[3], o1, 0, 0, 0);
}
__device__ __forceinline__ void attn_unit(const Params& p, LAS char* lds, int row0, int hp, int nkeys) {
  const bf16_t* Q = (const bf16_t*)(p.ws + OFF_Q); const bf16_t* Kb = (const bf16_t*)(p.ws + OFF_K); const bf16_t* Vb = (const bf16_t*)(p.ws + OFF_V);
  bf16_t* MIX = (bf16_t*)(p.ws + OFF_MIX);
  const int tid = TIDX, wid = tid >> 6, lane = tid & 63, r32 = lane & 31, hi = lane >> 5, kvh = hp >> 1;
  bf16x8 qa[4], qb[4];
  { const bf16_t* Qg = Q + (size_t)(row0 + wid * 32 + r32) * 512 + hp * 128 + hi * 8;
#pragma unroll
    for (int d0 = 0; d0 < 4; ++d0) { qa[d0] = *(const bf16x8*)(Qg + d0 * 16); qb[d0] = *(const bf16x8*)(Qg + 64 + d0 * 16); } }
  const bf16_t* Kg = Kb + (size_t)(tid >> 3) * 128 + kvh * 64 + (tid & 7) * 8;
  const bf16_t* Vg = Vb + (size_t)(tid >> 3) * 128 + kvh * 64 + (tid & 7) * 8;
  const int kst = xoff(tid >> 3, tid & 7), vstw = 8192 + vst64(tid >> 3, (tid & 7) * 8);
  AttnCtx c; c.krd0 = r32 * 128; c.krd1 = (32 + r32) * 128; c.ksw = (r32 >> 1) & 7; c.hi = hi; c.vrd = 8192 + v_rd_base(lane);
  const int NT = nkeys >> 6;
  f32x16 oa0 = {}, oa1 = {}, ob0 = {}, ob1 = {}; float la = 0.f, lb = 0.f;
  u32x4 ks, vs;
  {
    const u32x4 k0 = *(const u32x4*)Kg, k1 = *(const u32x4*)(Kg + 64 * 128), v0 = *(const u32x4*)Vg, v1 = *(const u32x4*)(Vg + 64 * 128);
    *(LAS u32x4*)(lds + kst) = k0; *(LAS u32x4*)(lds + ATT_SLOT + kst) = k1;
    *(LAS u32x4*)(lds + vstw) = v0; *(LAS u32x4*)(lds + ATT_SLOT + vstw) = v1;
    ks = *(const u32x4*)(Kg + 2 * 64 * 128); vs = *(const u32x4*)(Vg + 2 * 64 * 128);
  }
  __syncthreads();
  for (int j = 0; j < NT; ++j) {
    const LAS char* sl = lds + (j & 3) * ATT_SLOT;
    bf16x8 kf[8], vfa[4], vfb[4];
    f32x16 sa0, sa1, sb0, sb1;
    att_kload(sl, c, kf);
    SBAR();
    att_qk(kf, qa, sa0, sa1);
    SBAR();
    att_qk(kf, qb, sb0, sb1);
    att_exp(sa0, la); att_exp(sa1, la);
    SBAR();
    const bf16x8 pa0 = pk4(sa0, 0), pa1 = pk4(sa0, 8), pa2 = pk4(sa1, 0), pa3 = pk4(sa1, 8);
    att_vload<0>(sl, c, vfa);
    SBAR();
    att_pv2(pa0, pa1, vfa, oa0, oa1);
    att_exp(sb0, lb);
    att_vload<2>(sl, c, vfb);
    SBAR();
    att_pv2(pa2, pa3, vfb, oa0, oa1);
    att_exp(sb1, lb);
    const bf16x8 pb0 = pk4(sb0, 0), pb1 = pk4(sb0, 8), pb2 = pk4(sb1, 0), pb3 = pk4(sb1, 8);
    att_vload<0>(sl, c, vfa);
    SBAR();
    att_pv2(pb0, pb1, vfa, ob0, ob1);
    att_vload<2>(sl, c, vfb);
    SBAR();
    att_pv2(pb2, pb3, vfb, ob0, ob1);
    { LAS char* w = lds + ((j + 2) & 3) * ATT_SLOT;
      if (j + 2 < NT) { *(LAS u32x4*)(w + kst) = ks; *(LAS u32x4*)(w + vstw) = vs; }
      if (j + 3 < NT) { ks = *(const u32x4*)(Kg + (size_t)(j + 3) * 64 * 128); vs = *(const u32x4*)(Vg + (size_t)(j + 3) * 64 * 128); } }
    __syncthreads();
  }
  la = sum32(la); lb = sum32(lb);
  LAS float* li = (LAS float*)(lds + wid * 256);
  if (hi == 0) { li[r32] = la; li[32 + r32] = lb; }
  __syncthreads();
  bf16_t* Og = MIX + (size_t)(row0 + wid * 32) * D + hp * 128 + r32;
#pragma unroll
  for (int r = 0; r < 16; ++r) {
    const int orow = crow(r, hi);
    const float ra = __builtin_amdgcn_rcpf(li[orow]), rb = __builtin_amdgcn_rcpf(li[32 + orow]);
    Og[(size_t)orow * D] = f2bf(oa0[r] * ra); Og[(size_t)orow * D + 32] = f2bf(oa1[r] * ra);
    Og[(size_t)orow * D + 64] = f2bf(ob0[r] * rb); Og[(size_t)orow * D + 96] = f2bf(ob1[r] * rb);
  }
  __syncthreads();
}
__device__ __forceinline__ void attn_fallback(const Params& p, int layer, int bid, int nblk) {
  const bf16_t* Q = (const bf16_t*)(p.ws + OFF_Q); const bf16_t* Kb = (const bf16_t*)(p.ws + OFF_K); const bf16_t* Vb = (const bf16_t*)(p.ws + OFF_V);
  bf16_t* MIX = (bf16_t*)(p.ws + OFF_MIX);
  const int lane = TIDX & 63, nwv = nblk * 8;
  const int rg0 = layer == 0 ? 0 : NCTX / 64;
  for (int wv = bid * 8 + (TIDX >> 6) + rg0 * 8; wv < (TT / 64) * 8; wv += nwv) {
    const int head = wv & 7, r = (wv >> 3) * 64 + lane, kvh = head >> 2;
    float q[64], o[64];
#pragma unroll
    for (int d = 0; d < 64; ++d) { q[d] = bf2f(Q[(size_t)r * 512 + head * 64 + d]); o[d] = 0.f; }
    float m = -1e30f, l = 0.f;
    const int nk = r >= NCTX ? TT : NCTX;
    for (int j = 0; j < nk; ++j) {
      const bf16_t* kr = Kb + (size_t)j * 128 + kvh * 64;
      const bf16_t* vr = Vb + (size_t)j * 128 + kvh * 64;
      float s = 0.f;
#pragma unroll
      for (int d = 0; d < 64; ++d) s += q[d] * bf2f(kr[d]);
      if (s > m) {
        const float a = __builtin_amdgcn_exp2f(m - s);
        l *= a;
#pragma unroll
        for (int d = 0; d < 64; ++d) o[d] *= a;
        m = s;
      }
      const float pe = __builtin_amdgcn_exp2f(s - m);
      l += pe;
#pragma unroll
      for (int d = 0; d < 64; ++d) o[d] += pe * bf2f(vr[d]);
    }
    const float il = 1.f / l;
#pragma unroll
    for (int d = 0; d < 64; ++d) MIX[(size_t)r * D + head * 64 + d] = f2bf(o[d] * il);
  }
}

constexpr int PC_U = 0;
constexpr int PC_Y = 49152;
constexpr int PC_LDS = PC_Y + 65536;
__device__ __forceinline__ void poolconv_unit(const Params& p, int layer, LAS char* lds, int tile) {
  const int tid = TIDX, wid = tid >> 6, lane = tid & 63, r32 = lane & 31, hi = lane >> 5;
  const int t0 = tile * 64, base = tile < 4 ? 0 : NCTX, n = tile < 4 ? NCTX : SEQ;
  const bf16_t* AG = (const bf16_t*)(p.ws + OFF_AG);
  const float* U = (const float*)(p.ws + OFF_U);
  bf16_t* MIX = (bf16_t*)(p.ws + OFF_MIX);
#pragma unroll
  for (int h = 0; h < 2; ++h) {
    u32x4 av[3], gv[3]; bool in[3];
#pragma unroll
    for (int q = 0; q < 3; ++q) {
      const int idx = tid + (h * 3 + q) * 512, rr = idx >> 5, ch = (idx & 31) * 8, t = t0 - 15 + rr;
      in[q] = idx < 94 * 32 && t >= base && t < base + n;
      const size_t off = (size_t)(in[q] ? t : t0) * 512 + ch;
      av[q] = *(const u32x4*)(AG + off); gv[q] = *(const u32x4*)(AG + off + 256);
    }
#pragma unroll
    for (int q = 0; q < 3; ++q) {
      const int idx = tid + (h * 3 + q) * 512, rr = idx >> 5, ch = (idx & 31) * 8;
      u32x4 out = {0u, 0u, 0u, 0u};
      if (in[q]) {
#pragma unroll
        for (int i = 0; i < 4; ++i) {
          const float a0 = __uint_as_float(av[q][i] << 16), a1 = __uint_as_float(av[q][i] & 0xffff0000u);
          const float g0 = __uint_as_float(gv[q][i] << 16), g1 = __uint_as_float(gv[q][i] & 0xffff0000u);
          out[i] = cvtpk(a0 / (1.f + __expf(-g0)), a1 / (1.f + __expf(-g1)));
        }
      }
      if (idx < 94 * 32) *(LAS u32x4*)(lds + PC_U + (rr * 256 + ch) * 2) = out;
    }
  }
  __syncthreads();
  {
    const int c = tid & 255, th = tid >> 8;
    float w[31];
#pragma unroll
    for (int j = 0; j < 31; ++j) w[j] = p.w_dw[(size_t)layer * 31 * 256 + j * 256 + c];
    const float b = p.b_dw[layer * 256 + c];
    float acc[32];
#pragma unroll
    for (int i = 0; i < 32; ++i) acc[i] = b;
    const LAS bf16_t* up = (const LAS bf16_t*)(lds + PC_U) + (th * 32) * 256 + c;
#pragma unroll
    for (int rr = 0; rr < 62; ++rr) {
      const float uv = bf2f(up[rr * 256]);
#pragma unroll
      for (int i = 0; i < 32; ++i) if (rr - i >= 0 && rr - i < 31) acc[i] += uv * w[rr - i];
    }
    LAS float* yp = (LAS float*)(lds + PC_Y) + (th * 32) * 256 + c;
#pragma unroll
    for (int i = 0; i < 32; ++i) yp[i * 256] = acc[i];
  }
  __syncthreads();
  {
    const f32x4 g4 = *(const f32x4*)(p.cv_ln_g + layer * 256 + lane * 4), b4 = *(const f32x4*)(p.cv_ln_b + layer * 256 + lane * 4);
#pragma unroll
    for (int i = 0; i < 8; ++i) {
      const int tok = wid * 8 + i;
      const f32x4 y = *(const LAS f32x4*)(lds + PC_Y + (tok * 256 + lane * 4) * 4);
      const float mu = wave_sum(y[0] + y[1] + y[2] + y[3]) * (1.f / 256.f);
      const float d0 = y[0] - mu, d1 = y[1] - mu, d2 = y[2] - mu, d3 = y[3] - mu;
      const float rs = rsqrtf(wave_sum(d0 * d0 + d1 * d1 + d2 * d2 + d3 * d3) * (1.f / 256.f) + EPS);
      const float z0 = silu(d0 * rs * g4[0] + b4[0]), z1 = silu(d1 * rs * g4[1] + b4[1]), z2 = silu(d2 * rs * g4[2] + b4[2]), z3 = silu(d3 * rs * g4[3] + b4[3]);
      const int chunk = lane >> 1, sw = (chunk & 16) | ((chunk ^ tok) & 15);
      *(LAS u32x2*)(lds + PC_U + tok * 512 + sw * 16 + (lane & 1) * 8) = (u32x2){cvtpk(z0, z1), cvtpk(z2, z3)};
    }
  }
  __syncthreads();
  {
    const int tb = wid >> 2, dg = wid & 3, trow = tb * 32 + r32, t = t0 + trow;
    const bf16_t* Wt = (const bf16_t*)(p.ws + OFF_WPWT) + ((size_t)layer * 256 + dg * 64 + r32) * 256 + hi * 8;
    f32x16 acc0 = {}, acc1 = {};
#pragma unroll 8
    for (int ks = 0; ks < 16; ++ks) {
      const int chunk = 2 * ks + hi, sw = (chunk & 16) | ((chunk ^ trow) & 15);
      const bf16x8 zf = *(const LAS bf16x8*)(lds + PC_U + trow * 512 + sw * 16);
      const bf16x8 w0 = *(const bf16x8*)(Wt + ks * 16), w1 = *(const bf16x8*)(Wt + 32 * 256 + ks * 16);
      acc0 = __builtin_amdgcn_mfma_f32_32x32x16_bf16(w0, zf, acc0, 0, 0, 0);
      acc1 = __builtin_amdgcn_mfma_f32_32x32x16_bf16(w1, zf, acc1, 0, 0, 0);
    }
    bf16_t* dst = MIX + (size_t)t * D + 768 + dg * 64;
#pragma unroll
    for (int g = 0; g < 4; ++g) { *(u32x2*)(dst + 8 * g + 4 * hi) = pack4(acc0, g); *(u32x2*)(dst + 32 + 8 * g + 4 * hi) = pack4(acc1, g); }
    const int w = 2 << dg, tl = t - base, lo = max(tl - w / 2, 0), hh = min(tl + w / 2, n);
    const float inv = 1.f / (float)(hh - lo);
    const bf16_t* Pt = (const bf16_t*)(p.ws + OFF_WPOOLT) + ((size_t)(layer * 4 + dg) * 64 + r32) * 64 + hi * 8;
    f32x16 pc0 = {}, pc1 = {};
#pragma unroll
    for (int ks = 0; ks < 4; ++ks) {
      const int c0 = dg * 64 + ks * 16 + hi * 8;
      f32x4 s0 = {0.f, 0.f, 0.f, 0.f}, s1 = {0.f, 0.f, 0.f, 0.f};
#pragma unroll
      for (int i = 0; i < 16; ++i) {
        const int rr = lo + i; const bool in = i < w && rr < hh;
        const float* ur = U + (size_t)(base + (in ? rr : lo)) * 256 + c0; const float wgt = in ? 1.f : 0.f;
        s0 += *(const f32x4*)ur * wgt; s1 += *(const f32x4*)(ur + 4) * wgt;
      }
      const float* uo = U + (size_t)t * 256 + c0;
      const f32x4 o0 = *(const f32x4*)uo, o1 = *(const f32x4*)(uo + 4);
      s0 = s0 * inv - o0; s1 = s1 * inv - o1;
      u32x4 pw = {cvtpk(s0[0], s0[1]), cvtpk(s0[2], s0[3]), cvtpk(s1[0], s1[1]), cvtpk(s1[2], s1[3])};
      const bf16x8 pf = __builtin_bit_cast(bf16x8, pw);
      const bf16x8 w0 = *(const bf16x8*)(Pt + ks * 16), w1 = *(const bf16x8*)(Pt + 32 * 64 + ks * 16);
      pc0 = __builtin_amdgcn_mfma_f32_32x32x16_bf16(w0, pf, pc0, 0, 0, 0);
      pc1 = __builtin_amdgcn_mfma_f32_32x32x16_bf16(w1, pf, pc1, 0, 0, 0);
    }
    const float* psc = p.pool_scale + layer * 256 + dg * 64;
#pragma unroll
    for (int r = 0; r < 16; ++r) { pc0[r] *= psc[crow(r, hi)]; pc1[r] *= psc[32 + crow(r, hi)]; }
    bf16_t* pd = MIX + (size_t)t * D + 512 + dg * 64;
#pragma unroll
    for (int g = 0; g < 4; ++g) { *(u32x2*)(pd + 8 * g + 4 * hi) = pack4(pc0, g); *(u32x2*)(pd + 32 + 8 * g + 4 * hi) = pack4(pc1, g); }
  }
  __syncthreads();
}

__device__ __forceinline__ void phase_b(const Params& p, int layer, LAS char* lds, int bid, int nblk) {
  const bool fast = ((const int*)(p.ws + OFF_FLAG))[0] != 0;
  const int nu = (520 - bid + nblk - 1) / nblk;
  for (int i = 0; i < nu; ++i) {
    const int u = bid + ((bid & 1) ? (nu - 1 - i) : i) * nblk;
    if (u < 256) { if (fast) attn_unit(p, lds, NCTX + (u >> 2) * 256, u & 3, TT); }
    else if (u < 260) { if (fast && layer == 0) attn_unit(p, lds, 0, u - 256, NCTX); }
    else { const int tile = u - 260; if (layer == 0 || tile >= 4) poolconv_unit(p, layer, lds, tile); }
  }
  if (!fast) attn_fallback(p, layer, bid, nblk);
}

constexpr int NR = 2, NRA = 2;
__device__ __forceinline__ float hsum4(const f32x4 (&v)[4]) { float s = 0.f;
#pragma unroll
  for (int i = 0; i < 4; ++i) s += (v[i][0] + v[i][1]) + (v[i][2] + v[i][3]);
  return s; }
__device__ __forceinline__ float hsq4(const f32x4 (&v)[4], float mu) { float q = 0.f;
#pragma unroll
  for (int i = 0; i < 4; ++i) { const f32x4 d = v[i] - mu; q += (d[0] * d[0] + d[1] * d[1]) + (d[2] * d[2] + d[3] * d[3]); }
  return q; }
__device__ __forceinline__ f32x4 bf4(u32x2 w) { return (f32x4){__uint_as_float(w[0] << 16), __uint_as_float(w[0] & 0xffff0000u), __uint_as_float(w[1] << 16), __uint_as_float(w[1] & 0xffff0000u)}; }

__device__ __forceinline__ void phase_a0(const Params& p, int layer, int bid, int nblk) {
  const int wave = bid * 8 + (TIDX >> 6), lane = TIDX & 63, nw = nblk * 8;
  float* X = (float*)(p.ws + OFF_X);
  bf16_t* H = (bf16_t*)(p.ws + OFF_H);
  const bf16_t* OM = (const bf16_t*)(p.ws + OFF_OMOE);
  for (int rb = wave * NRA; rb < TT; rb += nw * NRA) {
    f32x4 v[NRA][4]; u32x2 oa[NRA][4], ob[NRA][4];
#pragma unroll
    for (int k = 0; k < NRA; ++k) {
      const int r = rb + k;
      const float* src = layer == 0 ? (r < NCTX ? p.ctx + (size_t)r * D : p.x + (size_t)(r - NCTX) * D) : X + (size_t)r * D;
#pragma unroll
      for (int i = 0; i < 4; ++i) { const int c = i * 256 + lane * 4; v[k][i] = *(const f32x4*)(src + c);
        if (layer != 0) { oa[k][i] = *(const u32x2*)(OM + ((size_t)r * 2 + 0) * D + c); ob[k][i] = *(const u32x2*)(OM + ((size_t)r * 2 + 1) * D + c); } }
    }
    if (layer != 0) {
#pragma unroll
      for (int k = 0; k < NRA; ++k) {
        const int r = rb + k, s = r < NCTX ? 1 : 0;
        const float* g2 = (const float*)(p.ws + OFF_MOD) + ((layer - 1) * 2 + s) * 6144 + 5 * D;
#pragma unroll
        for (int i = 0; i < 4; ++i) { const int c = i * 256 + lane * 4; v[k][i] = v[k][i] * ALPHA + *(const f32x4*)(g2 + c) * (bf4(oa[k][i]) + bf4(ob[k][i])); }
      }
      float mu[NRA], rs[NRA];
#pragma unroll
      for (int k = 0; k < NRA; ++k) mu[k] = wave_sum(hsum4(v[k])) * (1.f / D);
#pragma unroll
      for (int k = 0; k < NRA; ++k) rs[k] = rsqrtf(wave_sum(hsq4(v[k], mu[k])) * (1.f / D) + EPS);
      const float* g = p.ln2_g + (layer - 1) * D; const float* b = p.ln2_b + (layer - 1) * D;
#pragma unroll
      for (int k = 0; k < NRA; ++k)
#pragma unroll
        for (int i = 0; i < 4; ++i) { const int c = i * 256 + lane * 4; v[k][i] = (v[k][i] - mu[k]) * rs[k] * *(const f32x4*)(g + c) + *(const f32x4*)(b + c); *(f32x4*)(X + (size_t)(rb + k) * D + c) = v[k][i]; }
    }
    float mu[NRA], rs[NRA];
#pragma unroll
    for (int k = 0; k < NRA; ++k) mu[k] = wave_sum(hsum4(v[k])) * (1.f / D);
#pragma unroll
    for (int k = 0; k < NRA; ++k) rs[k] = rsqrtf(wave_sum(hsq4(v[k], mu[k])) * (1.f / D) + EPS);
#pragma unroll
    for (int k = 0; k < NRA; ++k) {
      const int r = rb + k, s = r < NCTX ? 1 : 0;
      const float* modp = (const float*)(p.ws + OFF_MOD) + (layer * 2 + s) * 6144;
#pragma unroll
      for (int i = 0; i < 4; ++i) {
        const int c = i * 256 + lane * 4;
        const f32x4 h = (v[k][i] - mu[k]) * rs[k] * (*(const f32x4*)(modp + D + c) + 1.f) + *(const f32x4*)(modp + c);
        *(u32x2*)(H + (size_t)r * D + c) = (u32x2){cvtpk(h[0], h[1]), cvtpk(h[2], h[3])};
      }
    }
  }
}

__device__ __forceinline__ void phase_c2(const Params& p, int layer, LAS char* lds, int bid, int nblk) {
  const int tid = TIDX, wid = tid >> 6, lane = tid & 63;
  float* X = (float*)(p.ws + OFF_X);
  const bf16_t* Y = (const bf16_t*)(p.ws + OFF_Y);
  bf16_t* H2 = (bf16_t*)(p.ws + OFF_MIX);
  int* cnt = (int*)(p.ws + OFF_CNT) + layer * NE * CNT_STRIDE;
  float* GATE = (float*)(p.ws + OFF_GATE); int* LIST = (int*)(p.ws + OFF_LIST);
  LAS int* lcnt = (LAS int*)lds;
  LAS int* lbase = lcnt + 32;
  LAS int* ent = lcnt + 64;
  if (tid < 32) lcnt[tid] = 0;
  LAS float* wre = (LAS float*)(lds + 4096);
#pragma unroll
  for (int kk = 0; kk < 2; ++kk) {
    const int k = tid + kk * 512;
    f32x4 w[8];
#pragma unroll
    for (int g = 0; g < 8; ++g) w[g] = *(const f32x4*)(p.w_re + ((size_t)layer * D + k) * 32 + g * 4);
#pragma unroll
    for (int g = 0; g < 8; ++g)
#pragma unroll
      for (int j = 0; j < 4; ++j) wre[(g * 4 + j) * 1024 + k] = w[g][j];
  }
  __syncthreads();
  const int r0 = layer == 0 ? 0 : NCTX, nrows = TT - r0, rpb = (nrows + nblk - 1) / nblk;
  const int rbeg = r0 + bid * rpb, rend = min(rbeg + rpb, TT);
  for (int rb = rbeg + wid * NR; rb < rend; rb += 8 * NR) {
    f32x4 v[NR][4]; u32x2 yv[NR][4]; int rr[NR]; bool ok[NR];
#pragma unroll
    for (int k = 0; k < NR; ++k) {
      ok[k] = rb + k < rend; rr[k] = ok[k] ? rb + k : rb;
      const int r = rr[k];
      const float* xin = layer == 0 ? (r < NCTX ? p.ctx + (size_t)r * D : p.x + (size_t)(r - NCTX) * D) : X + (size_t)r * D;
#pragma unroll
      for (int i = 0; i < 4; ++i) { const int c = i * 256 + lane * 4; v[k][i] = *(const f32x4*)(xin + c); yv[k][i] = *(const u32x2*)(Y + (size_t)r * D + c); }
    }
#pragma unroll
    for (int k = 0; k < NR; ++k) {
      const float* modp = (const float*)(p.ws + OFF_MOD) + (layer * 2 + (rr[k] < NCTX ? 1 : 0)) * 6144;
#pragma unroll
      for (int i = 0; i < 4; ++i) { const int c = i * 256 + lane * 4; v[k][i] = v[k][i] * ALPHA + *(const f32x4*)(modp + 2 * D + c) * bf4(yv[k][i]); }
    }
    float mu[NR], rs[NR];
#pragma unroll
    for (int k = 0; k < NR; ++k) mu[k] = wave_sum(hsum4(v[k])) * (1.f / D);
#pragma unroll
    for (int k = 0; k < NR; ++k) rs[k] = rsqrtf(wave_sum(hsq4(v[k], mu[k])) * (1.f / D) + EPS);
#pragma unroll
    for (int k = 0; k < NR; ++k)
#pragma unroll
      for (int i = 0; i < 4; ++i) {
        const int c = i * 256 + lane * 4;
        v[k][i] = (v[k][i] - mu[k]) * rs[k] * *(const f32x4*)(p.ln1_g + layer * D + c) + *(const f32x4*)(p.ln1_b + layer * D + c);
        if (ok[k]) *(f32x4*)(X + (size_t)rr[k] * D + c) = v[k][i];
      }
#pragma unroll
    for (int k = 0; k < NR; ++k) mu[k] = wave_sum(hsum4(v[k])) * (1.f / D);
#pragma unroll
    for (int k = 0; k < NR; ++k) rs[k] = rsqrtf(wave_sum(hsq4(v[k], mu[k])) * (1.f / D) + EPS);
#pragma unroll
    for (int k = 0; k < NR; ++k) {
      const float* modp = (const float*)(p.ws + OFF_MOD) + (layer * 2 + (rr[k] < NCTX ? 1 : 0)) * 6144;
#pragma unroll
      for (int i = 0; i < 4; ++i) {
        const int c = i * 256 + lane * 4;
        v[k][i] = (v[k][i] - mu[k]) * rs[k] * (*(const f32x4*)(modp + 4 * D + c) + 1.f) + *(const f32x4*)(modp + 3 * D + c);
        if (ok[k]) *(u32x2*)(H2 + (size_t)rr[k] * D + c) = (u32x2){cvtpk(v[k][i][0], v[k][i][1]), cvtpk(v[k][i][2], v[k][i][3])};
      }
    }
    f32x4 lg[NR];
#pragma unroll
    for (int k = 0; k < NR; ++k) lg[k] = (f32x4){0.f, 0.f, 0.f, 0.f};
#pragma unroll
    for (int i = 0; i < 4; ++i)
#pragma unroll
      for (int j = 0; j < 4; ++j) { const f32x4 w = *(const f32x4*)(p.w_rg + ((size_t)layer * D + i * 256 + lane * 4 + j) * 4);
#pragma unroll
        for (int k = 0; k < NR; ++k) lg[k] += w * v[k][i][j]; }
    int gsel[NR]; float pgrp[NR];
#pragma unroll
    for (int k = 0; k < NR; ++k) {
      float l0 = wave_sum(lg[k][0]) + p.b_rg[layer * 4 + 0], l1 = wave_sum(lg[k][1]) + p.b_rg[layer * 4 + 1];
      float l2 = wave_sum(lg[k][2]) + p.b_rg[layer * 4 + 2], l3 = wave_sum(lg[k][3]) + p.b_rg[layer * 4 + 3];
      int gs = 0; float gm = l0;
      if (l1 > gm) { gm = l1; gs = 1; }
      if (l2 > gm) { gm = l2; gs = 2; }
      if (l3 > gm) { gm = l3; gs = 3; }
      gsel[k] = gs; pgrp[k] = 1.f / (__expf(l0 - gm) + __expf(l1 - gm) + __expf(l2 - gm) + __expf(l3 - gm));
    }
#pragma unroll
    for (int k = 0; k < NR; ++k) {
      float le[8];
#pragma unroll
      for (int e = 0; e < 8; ++e) {
        const LAS float* wr = wre + (gsel[k] * 8 + e) * 1024 + lane * 4;
        float a = 0.f;
#pragma unroll
        for (int i = 0; i < 4; ++i) { const f32x4 w = *(const LAS f32x4*)(wr + i * 256); a += (w[0] * v[k][i][0] + w[1] * v[k][i][1]) + (w[2] * v[k][i][2] + w[3] * v[k][i][3]); }
        le[e] = a;
      }
#pragma unroll
      for (int e = 0; e < 8; ++e) le[e] = wave_sum(le[e]) + p.b_re[layer * 32 + gsel[k] * 8 + e];
      int i0 = 0; float v0 = le[0];
#pragma unroll
      for (int e = 1; e < 8; ++e) if (le[e] > v0) { v0 = le[e]; i0 = e; }
      int i1 = -1; float v1 = -3.0e38f;
#pragma unroll
      for (int e = 0; e < 8; ++e) if (e != i0 && le[e] > v1) { v1 = le[e]; i1 = e; }
      if (i1 < 0) { i1 = (i0 + 1) & 7; v1 = v0; }
      const float e1 = __expf(v1 - v0);
      if (lane == 0 && ok[k]) {
        const int r = rr[k], xa = gsel[k] * 8 + i0, xb = gsel[k] * 8 + i1;
        const int pa = __hip_atomic_fetch_add(&lcnt[xa], 1, __ATOMIC_RELAXED, __HIP_MEMORY_SCOPE_WORKGROUP);
        const int pb = __hip_atomic_fetch_add(&lcnt[xb], 1, __ATOMIC_RELAXED, __HIP_MEMORY_SCOPE_WORKGROUP);
        const int li = (r - rbeg) * 2;
        ent[li * 3 + 0] = xa; ent[li * 3 + 1] = pa; ent[li * 3 + 2] = r * 2 + 0;
        ent[li * 3 + 3] = xb; ent[li * 3 + 4] = pb; ent[li * 3 + 5] = r * 2 + 1;
        GATE[r * 2] = pgrp[k] / (1.f + e1); GATE[r * 2 + 1] = pgrp[k] * e1 / (1.f + e1);
      }
    }
  }
  __syncthreads();
  if (tid < 32) { const int c = lcnt[tid]; lbase[tid] = c > 0 ? atomicAdd(&cnt[tid * CNT_STRIDE], c) : 0; }
  __syncthreads();
  for (int i = tid; i < (rend - rbeg) * 2; i += 512) { const int e = ent[i * 3], lp = ent[i * 3 + 1]; LIST[(size_t)e * CAPL + lbase[e] + lp] = ent[i * 3 + 2]; }
  __syncthreads();
}

__device__ __forceinline__ void phase_final(const Params& p, int bid, int nblk) {
  const int wave = bid * 8 + (TIDX >> 6), lane = TIDX & 63, nw = nblk * 8;
  const float* X = (const float*)(p.ws + OFF_X);
  const bf16_t* OM = (const bf16_t*)(p.ws + OFF_OMOE);
  const float* g2 = (const float*)(p.ws + OFF_MOD) + (1 * 2 + 0) * 6144 + 5 * D;
  for (int rb = NCTX + wave * NRA; rb < TT; rb += nw * NRA) {
    f32x4 v[NRA][4]; u32x2 oa[NRA][4], ob[NRA][4];
#pragma unroll
    for (int k = 0; k < NRA; ++k)
#pragma unroll
      for (int i = 0; i < 4; ++i) { const int c = i * 256 + lane * 4, r = rb + k;
        v[k][i] = *(const f32x4*)(X + (size_t)r * D + c); oa[k][i] = *(const u32x2*)(OM + ((size_t)r * 2 + 0) * D + c); ob[k][i] = *(const u32x2*)(OM + ((size_t)r * 2 + 1) * D + c); }
#pragma unroll
    for (int k = 0; k < NRA; ++k)
#pragma unroll
      for (int i = 0; i < 4; ++i) { const int c = i * 256 + lane * 4; v[k][i] = v[k][i] * ALPHA + *(const f32x4*)(g2 + c) * (bf4(oa[k][i]) + bf4(ob[k][i])); }
    float mu[NRA], rs[NRA];
#pragma unroll
    for (int k = 0; k < NRA; ++k) mu[k] = wave_sum(hsum4(v[k])) * (1.f / D);
#pragma unroll
    for (int k = 0; k < NRA; ++k) rs[k] = rsqrtf(wave_sum(hsq4(v[k], mu[k])) * (1.f / D) + EPS);
#pragma unroll
    for (int k = 0; k < NRA; ++k)
#pragma unroll
      for (int i = 0; i < 4; ++i) {
        const int c = i * 256 + lane * 4;
        *(f32x4*)(p.out + (size_t)(rb + k - NCTX) * D + c) = (v[k][i] - mu[k]) * rs[k] * *(const f32x4*)(p.ln2_g + D + c) + *(const f32x4*)(p.ln2_b + D + c);
      }
  }
}

__device__ __forceinline__ void phase_p0(const Params& p, LAS char* lds, int bid, int nblk) {
  const int tid = TIDX;
  const long gtid = (long)bid * 512 + tid, gth = (long)nblk * 512;
  LAS float* sc = (LAS float*)lds;
  LAS float* red = (LAS float*)(lds + 8192);
  for (int i = tid; i < 2048; i += 512) { const float v = i < 1024 ? p.c[i] : p.c_ctx[i - 1024]; sc[i] = silu(v); }
  __syncthreads();
  float* mod = (float*)(p.ws + OFF_MOD);
  for (int u = bid; u < 384; u += nblk) {
    const int layer = u / 192, cg = u % 192, col = tid & 31, ksl = tid >> 5;
    const float* w = p.w_mod + ((size_t)layer * D + ksl * 64) * 6144 + cg * 32 + col;
    float a0 = 0.f, a1 = 0.f;
#pragma unroll 8
    for (int k = 0; k < 64; ++k) { const float wv = w[(size_t)k * 6144]; a0 += sc[ksl * 64 + k] * wv; a1 += sc[1024 + ksl * 64 + k] * wv; }
    red[(ksl * 32 + col) * 2] = a0; red[(ksl * 32 + col) * 2 + 1] = a1;
    __syncthreads();
    if (tid < 64) {
      const int c2 = tid & 31, s = tid >> 5; float a = 0.f;
#pragma unroll
      for (int k = 0; k < 16; ++k) a += red[(k * 32 + c2) * 2 + s];
      mod[(layer * 2 + s) * 6144 + cg * 32 + c2] = a + p.b_mod[layer * 6144 + cg * 32 + c2];
    }
    __syncthreads();
  }
  if (gtid < 256 * 16) {
    const int pos = (int)gtid / 16, f = (int)gtid % 16;
    const float ang = (float)pos * powf(10000.f, -(float)f / 16.f);
    float* rt = (float*)(p.ws + OFF_ROPE);
    rt[gtid * 2 + 0] = cosf(ang); rt[gtid * 2 + 1] = sinf(ang);
  }
  if (gtid < 2 * NE * CNT_STRIDE) ((int*)(p.ws + OFF_CNT))[gtid] = 0;
  if (gtid == 0) {
    float bmax = 0.f;
    for (int l = 0; l < 2; ++l) {
      float gq = 0.f, gk = 0.f;
      for (int i = 0; i < 64; ++i) { gq = fmaxf(gq, fabsf(p.q_gain[l * 64 + i])); gk = fmaxf(gk, fabsf(p.k_gain[l * 64 + i])); }
      bmax = fmaxf(bmax, 11.55f * gq * gk);
    }
    ((int*)(p.ws + OFF_FLAG))[0] = (bmax <= 100.f) ? 1 : 0;
  }
  for (long i = gtid; i < 2 * 65536; i += gth) { const int l = (int)(i >> 16), d = (int)(i >> 8) & 255, c = (int)i & 255; ((bf16_t*)(p.ws + OFF_WPWT))[i] = f2bf(p.w_cv_pw[((size_t)l * 256 + c) * 256 + d]); }
  for (long i = gtid; i < 8 * 4096; i += gth) { const int lg = (int)(i >> 12), d = (int)(i >> 6) & 63, c = (int)i & 63; ((bf16_t*)(p.ws + OFF_WPOOLT))[i] = f2bf(p.w_pool[((size_t)lg * 64 + c) * 64 + d]); }
  cvt_range(p.w_in, (bf16_t*)(p.ws + OFF_WIN), 2L * D * INW / 8, gtid, gth);
  cvt_range(p.w_out, (bf16_t*)(p.ws + OFF_WOUT), 2L * D * D / 8, gtid, gth);
}
#define XB_TMO      128
#define XB_XCNT(j)  (256  + 64 * (j))
#define XB_XSUB(j)  (1280 + 64 * (j))
#define XB_XGEN(j)  (2304 + 64 * (j))
#define XB_TOP      3328
#define XB_TOPGEN   3392
#define XCD_BAR_WORDS 3456
#define XB_SPIN_CAP (1u << 22)
__device__ __forceinline__ unsigned xb_ld(unsigned* p)              { return __hip_atomic_load(p, __ATOMIC_RELAXED, __HIP_MEMORY_SCOPE_AGENT); }
__device__ __forceinline__ unsigned xb_add(unsigned* p, unsigned v) { return __hip_atomic_fetch_add(p, v, __ATOMIC_RELAXED, __HIP_MEMORY_SCOPE_AGENT); }
__device__ __forceinline__ unsigned xb_xcc_id() { return (unsigned)__builtin_amdgcn_s_getreg((3 << 11) | 20) & 0xFu; }
#define XB_SPIN(cond, bar) do { unsigned _sp = 0; while (cond) { __builtin_amdgcn_s_sleep(1); \
    if ((++_sp & 255u) == 0u) { if (xb_ld(&(bar)[XB_TMO])) break; if (_sp > XB_SPIN_CAP) { atomicAdd(&(bar)[XB_TMO], 1u); break; } } } } while (0)
struct XcdBarrier { unsigned* bar; unsigned x; volatile LAS unsigned* st; };
__device__ __forceinline__ XcdBarrier xcd_barrier_post(unsigned* bar, volatile LAS unsigned* st) {
  XcdBarrier b; b.bar = bar; b.x = xb_xcc_id(); b.st = st;
  if (threadIdx.x == 0) (void)xb_add(&bar[XB_XCNT(b.x)], 1u);
  return b;
}
__device__ __forceinline__ void xcd_barrier_complete(unsigned* bar, unsigned x, unsigned& nloc, unsigned& nx) {
  const unsigned G = gridDim.x * gridDim.y * gridDim.z;
  unsigned sum, cnt, mine, sp = 0u;
  for (;;) {
    sum = 0u; cnt = 0u; mine = 0u;
#pragma unroll
    for (unsigned j = 0; j < 16; ++j) { const unsigned c = xb_ld(&bar[XB_XCNT(j)]); sum += c; cnt += (c > 0u) ? 1u : 0u; mine = (j == x) ? c : mine; }
    if (sum == G) break;
    __builtin_amdgcn_s_sleep(1);
    if ((++sp & 255u) == 0u) { if (xb_ld(&bar[XB_TMO])) break; if (sp > XB_SPIN_CAP) { atomicAdd(&bar[XB_TMO], 1u); break; } }
  }
  nloc = mine > 0u ? mine : 1u; nx = cnt > 0u ? cnt : 1u;
}
__device__ __forceinline__ void xcd_barrier(const XcdBarrier& b) {
  asm volatile("s_waitcnt vmcnt(0)" ::: "memory");
  __syncthreads();
  if (threadIdx.x == 0) {
    unsigned* bar = b.bar; unsigned bx = b.x;
    asm volatile("" : "+s"(bar), "+s"(bx));
    __builtin_amdgcn_s_waitcnt(0);
    unsigned nloc = b.st[0], nx = b.st[1];
    if (nloc == 0u) { xcd_barrier_complete(bar, bx, nloc, nx); b.st[0] = nloc; b.st[1] = nx; }
    const unsigned old = xb_add(&bar[XB_XSUB(bx)], 1u);
    const unsigned gen = old / nloc;
    if (old + 1u == (gen + 1u) * nloc) {
      __builtin_amdgcn_fence(__ATOMIC_RELEASE, "agent");
      asm volatile("s_waitcnt vmcnt(0)" ::: "memory");
      const unsigned og = xb_add(&bar[XB_TOP], 1u);
      const unsigned tg = og / nx;
      if (og + 1u == (tg + 1u) * nx) xb_add(&bar[XB_TOPGEN], 1u);
      else XB_SPIN(xb_ld(&bar[XB_TOPGEN]) == tg, bar);
      __builtin_amdgcn_fence(__ATOMIC_ACQUIRE, "agent");
      xb_add(&bar[XB_XGEN(bx)], 1u);
      asm volatile("s_waitcnt vmcnt(0)" ::: "memory");
    } else {
      XB_SPIN(xb_ld(&bar[XB_XGEN(bx)]) == gen, bar);
      __builtin_amdgcn_fence(__ATOMIC_ACQUIRE, "agent");
      asm volatile("s_waitcnt vmcnt(0)" ::: "memory");
    }
  }
  __syncthreads();
}

constexpr int LDS_MAIN = PC_LDS > GEMM_LDS + 256 ? PC_LDS : GEMM_LDS + 256;
constexpr int LDS_TOTAL = LDS_MAIN + 16;
static_assert(GEMM_LDS + 256 <= LDS_MAIN && ATT_LDS <= LDS_MAIN, "lds");
__global__ void __launch_bounds__(512) mega_fwd(Params p) {
  __shared__ __attribute__((aligned(16))) char slds[LDS_TOTAL];
  LAS char* lds = (LAS char*)slds;
  volatile LAS unsigned* st = (volatile LAS unsigned*)(lds + LDS_MAIN);
  if (threadIdx.x < 4) st[threadIdx.x] = 0u;
  __syncthreads();
  const XcdBarrier bar = xcd_barrier_post((unsigned*)(p.ws + OFF_BAR), st);
  const int bid = blockIdx.x, nblk = gridDim.x;
  phase_p0(p, lds, bid, nblk);
  xcd_barrier(bar);
#pragma unroll 1
  for (int layer = 0; layer < 2; ++layer) {
    phase_a0(p, layer, bid, nblk);
    xcd_barrier(bar);
    phase_a1(p, layer, lds, bid, nblk);
    xcd_barrier(bar);
    phase_b(p, layer, lds, bid, nblk);
    xcd_barrier(bar);
    phase_c1(p, layer, lds, bid, nblk);
    xcd_barrier(bar);
    phase_c2(p, layer, lds, bid, nblk);
    xcd_barrier(bar);
    phase_d1(p, layer, lds, bid, nblk);
    xcd_barrier(bar);
    phase_d2(p, layer, lds, bid, nblk);
    xcd_barrier(bar);
  }
  phase_final(p, bid, nblk);
}

extern "C" void kernel_launch(void* const* d_in, const int* in_sizes, int n_in, void* d_out, int out_size, void* d_ws, size_t ws_size,
                              hipStream_t stream) {
  static int grid = 0;
  if (grid == 0) {
    if (ws_size < WS_END || n_in != 28) { fprintf(stderr, "kernel_launch: ws too small (%zu < %zu) or n_in %d != 28; nothing launched\n", ws_size, (size_t)WS_END, n_in); grid = -1; return; }
    int dev = 0, cus = 0, per_cu = 0;
    if (hipGetDevice(&dev) != hipSuccess || hipDeviceGetAttribute(&cus, hipDeviceAttributeMultiprocessorCount, dev) != hipSuccess) { grid = -1; return; }
    if (hipOccupancyMaxActiveBlocksPerMultiprocessor(&per_cu, (const void*)mega_fwd, 512, 0) != hipSuccess || per_cu < 1) {
      fprintf(stderr, "kernel_launch: occupancy query says %d blocks per CU; nothing launched\n", per_cu); grid = -1; return; }
    (void)hipGetLastError();
    grid = cus;
  }
  if (grid < 0) return;
  if (hipMemsetAsync((char*)d_ws + OFF_BAR, 0, BAR_BYTES, stream) != hipSuccess) { fprintf(stderr, "kernel_launch: memset failed\n"); return; }
  Params p{};
  const float** f = (const float**)&p;
  for (int i = 0; i < 28; ++i) f[i] = (const float*)d_in[i];
  p.out = (float*)d_out; p.ws = (char*)d_ws;
  hipLaunchKernelGGL(mega_fwd, dim3(grid), dim3(512), 0, stream, p);
}
```

```cpp
#include <hip/hip_runtime.h>
#include <cstdio>
#include <cstdint>

typedef unsigned short bf16_t;
#define LAS __attribute__((address_space(3)))

constexpr int D = 1024, SEQ = 16384, NCTX = 256, TT = SEQ + NCTX;
constexpr int INW = 1536;
constexpr int NE = 32, DE = 512;
constexpr int CAPL = 2 * TT;
constexpr int HMID_ROWS = 2 * TT + NE * 128;
constexpr float ALPHA = 1.41421356237309515f;
constexpr float EPS = 1e-6f;

constexpr size_t al(size_t x) { return (x + 255) / 256 * 256; }
constexpr size_t OFF_BAR = 0;
constexpr size_t BAR_BYTES = 3456 * 4;
constexpr size_t OFF_MOD = OFF_BAR + al(BAR_BYTES);
constexpr size_t OFF_ROPE = OFF_MOD + al(2 * 2 * 6144 * 4);
constexpr int CNT_STRIDE = 32;
constexpr size_t OFF_CNT = OFF_ROPE + al(256 * 16 * 2 * 4);
constexpr size_t OFF_FLAG = OFF_CNT + al(2 * 32 * 32 * 4);
constexpr size_t OFF_X = OFF_FLAG + 256;
constexpr size_t OFF_H = OFF_X + al((size_t)TT * D * 4);
constexpr size_t OFF_MIX = OFF_H + al((size_t)TT * D * 2);
constexpr size_t OFF_Y = OFF_MIX + al((size_t)TT * D * 2);
constexpr size_t OFF_Q = OFF_Y + al((size_t)TT * D * 2);
constexpr size_t OFF_K = OFF_Q + al((size_t)TT * 512 * 2);
constexpr size_t OFF_V = OFF_K + al((size_t)TT * 128 * 2);
constexpr size_t OFF_U = OFF_V + al((size_t)TT * 128 * 2);
constexpr size_t OFF_AG = OFF_U + al((size_t)TT * 256 * 4);
constexpr size_t OFF_HMID = OFF_Q;
constexpr size_t OFF_OMOE = OFF_AG + al((size_t)TT * 512 * 2);
constexpr size_t OFF_GATE = OFF_OMOE + al((size_t)TT * 2 * D * 2);
constexpr size_t OFF_LIST = OFF_GATE + al((size_t)TT * 2 * 4);
constexpr size_t OFF_WIN = OFF_LIST + al((size_t)NE * CAPL * 4);
constexpr size_t OFF_WOUT = OFF_WIN + al((size_t)2 * D * INW * 2);
constexpr size_t OFF_WPWT = OFF_WOUT + al((size_t)2 * D * D * 2);
constexpr size_t OFF_WPOOLT = OFF_WPWT + al((size_t)2 * 256 * 256 * 2);
constexpr size_t OFF_Q8 = OFF_WPOOLT + al((size_t)2 * 4 * 64 * 64 * 2);
constexpr size_t OFF_K8 = OFF_Q8 + al((size_t)TT * 512);
constexpr size_t OFF_VT8 = OFF_K8 + al((size_t)TT * 128);
constexpr size_t OFF_WG = OFF_VT8 + al((size_t)128 * TT);
constexpr size_t OFF_WU = OFF_WG + al((size_t)2 * NE * D * DE * 2);
constexpr size_t OFF_WD = OFF_WU + al((size_t)2 * NE * D * DE * 2);
constexpr size_t WS_END = OFF_WD + al((size_t)2 * NE * D * DE * 2);
static_assert(OFF_AG - OFF_HMID >= (size_t)HMID_ROWS * DE * 2, "HMID alias too small");
static_assert(WS_END < 530000000, "ws budget");

struct Params {
  const float *x, *c, *ctx, *c_ctx, *w_mod, *b_mod, *w_in, *q_gain, *k_gain, *w_pool, *pool_scale, *w_dw, *b_dw,
      *cv_ln_g, *cv_ln_b, *w_cv_pw, *w_out, *ln1_g, *ln1_b, *ln2_g, *ln2_b, *w_rg, *b_rg, *w_re, *b_re, *w_e_gate, *w_e_up, *w_e_down;
  float* out;
  char* ws;
};

__device__ __forceinline__ float bf2f(bf16_t v) { return __uint_as_float(((unsigned)v) << 16); }
__device__ __forceinline__ bf16_t f2bf(float f) {
  unsigned u = __float_as_uint(f);
  u += 0x7fffu + ((u >> 16) & 1u);
  return (bf16_t)(u >> 16);
}
template <int CTRL> __device__ __forceinline__ float dppf(float v) { return __int_as_float(__builtin_amdgcn_update_dpp(0, __float_as_int(v), CTRL, 0xf, 0xf, true)); }
__device__ __forceinline__ float wave_sum(float v) {
  v += dppf<0xB1>(v); v += dppf<0x4E>(v); v += dppf<0x141>(v); v += dppf<0x140>(v);
  { auto r = __builtin_amdgcn_permlane16_swap(__float_as_uint(v), __float_as_uint(v), false, false); v = __uint_as_float(r[0]) + __uint_as_float(r[1]); }
  { auto r = __builtin_amdgcn_permlane32_swap(__float_as_uint(v), __float_as_uint(v), false, false); v = __uint_as_float(r[0]) + __uint_as_float(r[1]); }
  return v;
}
__device__ __forceinline__ float silu(float v) { return v / (1.f + __expf(-v)); }
__device__ __forceinline__ int opaque0() { int z; asm volatile("s_mov_b32 %0, 0" : "=s"(z)); return z; }
#define TIDX ((int)threadIdx.x + opaque0())
using bf16x8 = __attribute__((ext_vector_type(8))) short;
using s16x4 = __attribute__((ext_vector_type(4))) short;
using f32x16 = __attribute__((ext_vector_type(16))) float;
using f32x4 = __attribute__((ext_vector_type(4))) float;
using u32x4 = __attribute__((ext_vector_type(4))) unsigned;
using u32x2 = __attribute__((ext_vector_type(2))) unsigned;

__device__ __forceinline__ int crow(int r, int hi) { return (r & 3) + 8 * (r >> 2) + 4 * hi; }
typedef float f32x2 __attribute__((ext_vector_type(2)));
typedef __bf16 bf16x2v __attribute__((ext_vector_type(2)));
__device__ __forceinline__ unsigned cvtpk(float lo, float hi) {
  bf16x2v b = __builtin_convertvector((f32x2){lo, hi}, bf16x2v);
  return __builtin_bit_cast(unsigned, b);
}
__device__ __forceinline__ float sum32(float v) {
  auto rr = __builtin_amdgcn_permlane32_swap(__float_as_uint(v), __float_as_uint(v), false, false);
  return __uint_as_float(rr[0]) + __uint_as_float(rr[1]);
}

__device__ __forceinline__ void cvt_range(const float* __restrict__ src, bf16_t* __restrict__ dst, long n8, long gtid, long gthreads) {
  for (long i = gtid; i < n8; i += gthreads) {
    const f32x4 a = *(const f32x4*)(src + i * 8), b = *(const f32x4*)(src + i * 8 + 4);
    u32x4 w = {cvtpk(a[0], a[1]), cvtpk(a[2], a[3]), cvtpk(b[0], b[1]), cvtpk(b[2], b[3])};
    *(u32x4*)(dst + i * 8) = w;
  }
}

__device__ __forceinline__ int xoff(int row, int chunk) { return row * 128 + ((chunk ^ ((row >> 1) & 7)) << 4); }
__device__ __forceinline__ int wst(int k, int c) { const int kk = (k & ~0xC) | ((k & 4) << 1) | ((k & 8) >> 1); return ((kk >> 3) * 4 + (c >> 5)) * 512 + ((kk & 7) * 32 + (c & 31)) * 2; }
__device__ __forceinline__ int v_rd_base(int lane) { return ((lane & 3) << 3) | (((lane >> 2) & 3) << 6) | (((lane >> 4) & 1) << 5) | (((lane >> 5) & 1) << 8); }

__device__ __forceinline__ bf16x8 tr_frag(const LAS char* p) {
  s16x4 a = __builtin_amdgcn_ds_read_tr16_b64_v4i16((LAS s16x4*)p);
  s16x4 b = __builtin_amdgcn_ds_read_tr16_b64_v4i16((LAS s16x4*)(p + 2048));
  return (bf16x8){a[0], a[1], a[2], a[3], b[0], b[1], b[2], b[3]};
}

template <int OFF> __device__ __forceinline__ bf16x8 tr_frag_asm(int addr) {
  s16x4 a, b;
  asm volatile("ds_read_b64_tr_b16 %0, %1 offset:%2" : "=&v"(a) : "v"(addr), "i"(OFF) : "memory");
  asm volatile("ds_read_b64_tr_b16 %0, %1 offset:%2" : "=&v"(b) : "v"(addr), "i"(OFF + 2048) : "memory");
  return (bf16x8){a[0], a[1], a[2], a[3], b[0], b[1], b[2], b[3]};
}

template <int BM, int BN> struct GemmCfg {
  static constexpr int WM = BM / 64, WN = 8 / WM, NSLAB = BN / 128, XB = BM * 128, WB = NSLAB * 16384, STAGE = XB + WB, NXP = BM / 64, NWP = NSLAB * 2;
  static_assert(WM * WN == 8 && WN * 64 == BN, "tile");
};
constexpr int GEMM_LDS = 3 * (256 * 128 + 16384);

template <int BM, int BN, int NMAP, bool BG = false, class XRow, class WPtr>
__device__ __forceinline__ void gemm_mainloop(LAS char* lds, f32x16 (&acc)[2][2], const XRow& xrow, const WPtr& wptr, int ldw, int K, int& bgdone, int bgn = 0, long bgc0 = 0,
                                              const float* bs0 = nullptr, const float* bs1 = nullptr, const float* bs2 = nullptr, bf16_t* bd0 = nullptr, bf16_t* bd1 = nullptr, bf16_t* bd2 = nullptr) {
#define BG_ISSUE(i, a, b) do { long c_ = bgc0 + (long)(i) * 512; if (c_ >= (3L << 21)) c_ = 0; const int t_ = (int)(c_ >> 21); const long o_ = (c_ & 0x1fffff) * 8; \
    const float* sp_ = (t_ == 0 ? bs0 : (t_ == 1 ? bs1 : bs2)) + o_; a = *(const f32x4*)sp_; b = *(const f32x4*)(sp_ + 4); } while (0)
#define BG_RETIRE(i, a, b) do { const long c_ = bgc0 + (long)(i) * 512; if (c_ < (3L << 21)) { const int t_ = (int)(c_ >> 21); const long o_ = (c_ & 0x1fffff) * 8; \
    bf16_t* dp_ = (t_ == 0 ? bd0 : (t_ == 1 ? bd1 : bd2)) + o_; *(u32x4*)dp_ = (u32x4){cvtpk(a[0], a[1]), cvtpk(a[2], a[3]), cvtpk(b[0], b[1]), cvtpk(b[2], b[3])}; } } while (0)
  using C = GemmCfg<BM, BN>;
  const int tid = TIDX, wid = tid >> 6, lane = tid & 63, r32 = lane & 31, hi = lane >> 5;
  const int wm = wid / C::WN, wn = wid % C::WN;
  const bf16_t *g0, *g1, *g2, *g3, *g4, *g5; int l0, l1, l2, l3, l4, l5;
  auto xpiece = [&](int i, const bf16_t*& gp, int& lp) { const int q = wid * C::NXP + i, row = 8 * q + (lane >> 3), c = (lane & 7) ^ ((row >> 1) & 7); gp = xrow(row) + c * 8; lp = q * 1024; };
  auto wpiece = [&](int i, const bf16_t*& gp, int& lp) {
    const int idx = wid * C::NWP + i, s = idx >> 4, q = idx & 15, sub = 2 * q + (lane >> 5), kk = (sub >> 2) * 8 + ((lane & 31) >> 2);
    const int k = (kk & ~0xC) | ((kk & 4) << 1) | ((kk & 8) >> 1), c = (sub & 3) * 32 + (lane & 3) * 8;
    gp = wptr(s) + (size_t)k * ldw + c; lp = C::XB + s * 16384 + q * 1024; };
  if (C::NXP == 4) { xpiece(0, g0, l0); xpiece(1, g1, l1); xpiece(2, g2, l2); xpiece(3, g3, l3); wpiece(0, g4, l4); wpiece(1, g5, l5); }
  else { xpiece(0, g0, l0); xpiece(1, g1, l1); wpiece(0, g2, l2); wpiece(1, g3, l3); wpiece(2, g4, l4); wpiece(3, g5, l5); }
  const size_t stepx = 64, stepw = (size_t)64 * ldw;
  const size_t stp0 = stepx, stp1 = stepx, stp2 = C::NXP == 4 ? stepx : stepw, stp3 = C::NXP == 4 ? stepx : stepw, stp4 = stepw, stp5 = stepw;
  int xr[2];
#pragma unroll
  for (int ti = 0; ti < 2; ++ti) xr[ti] = (wm * 64 + ti * 32 + r32) * 128;
  const int xsw = (r32 >> 1) & 7;
  int wr[2];
#pragma unroll
  for (int ni = 0; ni < 2; ++ni) {
    const int slab = NMAP == 0 ? 0 : (NMAP == 1 ? (wn >> 1) : ni);
    const int nb = NMAP == 0 ? (2 * wn + ni) : (NMAP == 1 ? ((wn & 1) * 2 + ni) : wn);
    wr[ni] = C::XB + slab * 16384 + nb * 512 + v_rd_base(lane);
  }
  const int nk = K / 64;
#define G_DMA1(gp, sp, lp, kt, _d) __builtin_amdgcn_global_load_lds((const unsigned*)((gp) + (size_t)(kt) * (sp)), (LAS unsigned*)((_d) + (lp)), 16, 0, 0)
#define G_DMA(kt, st) do { LAS char* _d = lds + (st) * C::STAGE; \
    G_DMA1(g0, stp0, l0, kt, _d); G_DMA1(g1, stp1, l1, kt, _d); G_DMA1(g2, stp2, l2, kt, _d); G_DMA1(g3, stp3, l3, kt, _d); G_DMA1(g4, stp4, l4, kt, _d); G_DMA1(g5, stp5, l5, kt, _d); } while (0)
#define G_HALF(cur, wa0, wa1, H) do { bf16x8 xf[2][2], wf[2][2]; \
      _Pragma("unroll") for (int k2 = 0; k2 < 2; ++k2) _Pragma("unroll") for (int ti = 0; ti < 2; ++ti) xf[k2][ti] = *(const LAS bf16x8*)(cur + xr[ti] + ((((H * 2 + k2) * 2 + hi) ^ xsw) << 4)); \
      wf[0][0] = tr_frag_asm<(H * 2 + 0) * 4096>(wa0); wf[0][1] = tr_frag_asm<(H * 2 + 0) * 4096>(wa1); \
      wf[1][0] = tr_frag_asm<(H * 2 + 1) * 4096>(wa0); wf[1][1] = tr_frag_asm<(H * 2 + 1) * 4096>(wa1); \
      asm volatile("s_waitcnt lgkmcnt(0)" ::: "memory"); __builtin_amdgcn_sched_barrier(0); \
      _Pragma("unroll") for (int k2 = 0; k2 < 2; ++k2) _Pragma("unroll") for (int ti = 0; ti < 2; ++ti) _Pragma("unroll") for (int ni = 0; ni < 2; ++ni) \
        acc[ti][ni] = __builtin_amdgcn_mfma_f32_32x32x16_bf16(wf[k2][ni], xf[k2][ti], acc[ti][ni], 0, 0, 0); } while (0)
#define G_COMPUTE(st) do { const LAS char* cur = lds + (st) * C::STAGE; const int wa0 = (int)(uintptr_t)(cur + wr[0]), wa1 = (int)(uintptr_t)(cur + wr[1]); \
    G_HALF(cur, wa0, wa1, 0); G_HALF(cur, wa0, wa1, 1); } while (0)
  static_assert(C::NXP + C::NWP == 6, "vmcnt(6) below assumes 6 DMA pieces per wave per k-tile");
  G_DMA(0, 0); G_DMA(1, 1);
  int st = 0;
  f32x4 bga, bgb; int bgi = -1, bgy1 = 0, bgy2 = 0;
  for (int kt = 0; kt < nk; ++kt) {
    if (kt + 1 < nk) {
      const int young = BG ? (bgy1 + bgy2) : 0;
      if (young == 0) asm volatile("s_waitcnt vmcnt(6)" ::: "memory"); else if (young == 1) asm volatile("s_waitcnt vmcnt(8)" ::: "memory"); else asm volatile("s_waitcnt vmcnt(10)" ::: "memory");
    } else asm volatile("s_waitcnt vmcnt(0)" ::: "memory");
    asm volatile("s_waitcnt lgkmcnt(0)" ::: "memory"); __builtin_amdgcn_s_barrier();
    const int s2 = st == 0 ? 2 : st - 1;
    if (kt + 2 < nk) G_DMA(kt + 2, s2);
    if (BG) {
      bgy2 = bgy1; bgy1 = 0;
      if (bgi >= 0) { BG_RETIRE(bgi, bga, bgb); bgi = -1; }
      if (bgdone < bgn) { bgi = bgdone++; BG_ISSUE(bgi, bga, bgb); bgy1 = 1; }
    }
    G_COMPUTE(st);
    st = st == 2 ? 0 : st + 1;
  }
  if (BG) { if (bgi >= 0) BG_RETIRE(bgi, bga, bgb); }
  asm volatile("s_waitcnt lgkmcnt(0)" ::: "memory"); __builtin_amdgcn_s_barrier();
#undef G_DMA
#undef G_DMA1
#undef G_COMPUTE
#undef G_HALF
}

__device__ __forceinline__ unsigned pack4_fp8(const f32x16& a, int g) {
  int w = __builtin_amdgcn_cvt_pk_fp8_f32(a[4 * g], a[4 * g + 1], 0, false);
  w = __builtin_amdgcn_cvt_pk_fp8_f32(a[4 * g + 2], a[4 * g + 3], w, true);
  return (unsigned)w;
}
__device__ __forceinline__ u32x2 pack4(const f32x16& a, int g) { return (u32x2){cvtpk(a[4 * g], a[4 * g + 1]), cvtpk(a[4 * g + 2], a[4 * g + 3])}; }

__device__ __forceinline__ void phase_a1(const Params& p, int layer, LAS char* lds, int bid, int nblk) {
  const bf16_t* H = (const bf16_t*)(p.ws + OFF_H);
  const bf16_t* W = (const bf16_t*)(p.ws + OFF_WIN) + (size_t)layer * D * INW;
  bf16_t* Q = (bf16_t*)(p.ws + OFF_Q); bf16_t* Kb = (bf16_t*)(p.ws + OFF_K); bf16_t* Vb = (bf16_t*)(p.ws + OFF_V);
  float* U = (float*)(p.ws + OFF_U); bf16_t* AG = (bf16_t*)(p.ws + OFF_AG);
  unsigned char* Q8 = (unsigned char*)(p.ws + OFF_Q8); unsigned char* K8 = (unsigned char*)(p.ws + OFF_K8); unsigned char* VT8 = (unsigned char*)(p.ws + OFF_VT8);
  const float* rt = (const float*)(p.ws + OFF_ROPE);
  const int lane = TIDX & 63, wid = TIDX >> 6, r32 = lane & 31, hi = lane >> 5, wm = wid >> 1, wn = wid & 1;
  const size_t wo = (size_t)layer * NE * D * DE;
  const int bgn = (3 * (1 << 21) + nblk * 512 - 1) / (nblk * 512);
  const long bgc0 = (long)bid * bgn * 512 + (TIDX);
  const float* bs0 = p.w_e_gate + wo; const float* bs1 = p.w_e_up + wo; const float* bs2 = p.w_e_down + wo;
  bf16_t* bd0 = (bf16_t*)(p.ws + OFF_WG) + wo; bf16_t* bd1 = (bf16_t*)(p.ws + OFF_WU) + wo; bf16_t* bd2 = (bf16_t*)(p.ws + OFF_WD) + wo;
  int bgdone = 0;
  const int nlat = 64 * 12, nctx = layer == 0 ? 12 : 2, nunits = nlat + nctx;
  const bool xmap = (nblk & 7) == 0;
  const int xcd = bid & 7, lb = bid >> 3, nlb = nblk >> 3, nl = lb < 96 ? (96 - lb + nlb - 1) / nlb : 0;
  for (int it = 0;; ++it) {
    int rtile, ct;
    if (xmap) {
      if (it < nl) { const int v = lb + it * nlb; rtile = 1 + xcd + 8 * (v / 12); ct = v % 12; }
      else { const int e2 = bid + (it - nl) * nblk; if (e2 >= nctx) break; rtile = 0; ct = layer == 0 ? e2 : 4 + e2; }
    } else {
      const int u = bid + it * nblk; if (u >= nunits) break;
      if (u < nlat) { rtile = 1 + u / 12; ct = u % 12; } else { rtile = 0; ct = layer == 0 ? (u - nlat) : (4 + u - nlat); }
    }
    const int m0 = rtile * 256, n0 = ct * 128;
    f32x16 acc[2][2];
#pragma unroll
    for (int a = 0; a < 2; ++a)
#pragma unroll
      for (int b = 0; b < 2; ++b) acc[a][b] = (f32x16){};
    gemm_mainloop<256, 128, 0, true>(lds, acc, [&](int row) { return H + (size_t)(m0 + row) * D; }, [&](int) { return W + n0; }, INW, D, bgdone, bgn, bgc0, bs0, bs1, bs2, bd0, bd1, bd2);
#pragma unroll
    for (int ti = 0; ti < 2; ++ti) {
      const int tok = m0 + wm * 64 + ti * 32 + r32;
      if (ct < 5) {
        float ss = 0.f;
#pragma unroll
        for (int ni = 0; ni < 2; ++ni)
#pragma unroll
          for (int r = 0; r < 16; ++r) ss += acc[ti][ni][r] * acc[ti][ni][r];
        ss = sum32(ss);
        const float rs = rsqrtf(ss * (1.f / 64.f) + EPS);
        const float* gain = (ct < 4 ? p.q_gain : p.k_gain) + layer * 64;
        const float osc = ct < 4 ? 0.125f * 1.4426950408889634f : 1.f;
        const bool lat = rtile > 0;
        const int t = tok - NCTX;
#pragma unroll
        for (int ni = 0; ni < 2; ++ni) {
          f32x16 v;
#pragma unroll
          for (int r = 0; r < 16; ++r) v[r] = acc[ti][ni][r] * rs * gain[ni * 32 + crow(r, hi)];
          if (lat) {
            const int pos = ni == 0 ? (t >> 6) : (t & 63);
#pragma unroll
            for (int r = 0; r < 8; ++r) {
              const int f = crow(r, hi);
              const float cs = rt[(pos * 16 + f) * 2], sn = rt[(pos * 16 + f) * 2 + 1];
              const float t1 = v[r], t2 = v[r + 8];
              v[r] = t1 * cs - t2 * sn; v[r + 8] = t2 * cs + t1 * sn;
            }
          }
#pragma unroll
          for (int r = 0; r < 16; ++r) v[r] *= osc;
          bf16_t* dst = ct < 4 ? Q + (size_t)tok * 512 + (ct * 2 + wn) * 64 + ni * 32 : Kb + (size_t)tok * 128 + wn * 64 + ni * 32;
          unsigned char* dst8 = ct < 4 ? Q8 + (size_t)tok * 512 + (ct * 2 + wn) * 64 + ni * 32 : K8 + (size_t)tok * 128 + wn * 64 + ni * 32;
#pragma unroll
          for (int g = 0; g < 4; ++g) { *(u32x2*)(dst + 8 * g + 4 * hi) = pack4(v, g); *(unsigned*)(dst8 + 8 * g + 4 * hi) = pack4_fp8(v, g); }
        }
      } else if (ct == 5) {
#pragma unroll
        for (int ni = 0; ni < 2; ++ni) {
#pragma unroll
          for (int g = 0; g < 4; ++g) *(u32x2*)(Vb + (size_t)tok * 128 + wn * 64 + ni * 32 + 8 * g + 4 * hi) = pack4(acc[ti][ni], g);
#pragma unroll
          for (int r = 0; r < 16; ++r)
            VT8[(size_t)(wn * 64 + ni * 32 + crow(r, hi)) * TT + tok] = (unsigned char)(__builtin_amdgcn_cvt_pk_fp8_f32(acc[ti][ni][r], acc[ti][ni][r], 0, false) & 0xff);
        }
      } else if (ct < 8) {
#pragma unroll
        for (int ni = 0; ni < 2; ++ni)
#pragma unroll
          for (int g = 0; g < 4; ++g)
            *(f32x4*)(U + (size_t)tok * 256 + (ct - 6) * 128 + wn * 64 + ni * 32 + 8 * g + 4 * hi) =
                (f32x4){acc[ti][ni][4 * g], acc[ti][ni][4 * g + 1], acc[ti][ni][4 * g + 2], acc[ti][ni][4 * g + 3]};
      } else {
#pragma unroll
        for (int ni = 0; ni < 2; ++ni)
#pragma unroll
          for (int g = 0; g < 4; ++g) *(u32x2*)(AG + (size_t)tok * 512 + (ct - 8) * 128 + wn * 64 + ni * 32 + 8 * g + 4 * hi) = pack4(acc[ti][ni], g);
      }
    }
  }
  while (bgdone < bgn) { f32x4 a, b2; const int i = bgdone++; BG_ISSUE(i, a, b2); BG_RETIRE(i, a, b2); }
}

__device__ __forceinline__ void phase_c1(const Params& p, int layer, LAS char* lds, int bid, int nblk) {
  const bf16_t* A = (const bf16_t*)(p.ws + OFF_MIX);
  const bf16_t* W = (const bf16_t*)(p.ws + OFF_WOUT) + (size_t)layer * D * D;
  bf16_t* Y = (bf16_t*)(p.ws + OFF_Y);
  const int lane = TIDX & 63, wid = TIDX >> 6, r32 = lane & 31, hi = lane >> 5, wm = wid >> 1, wn = wid & 1;
  const int nctx = layer == 0 ? 8 : 0;
  const bool xmap = (nblk & 7) == 0;
  const int xcd = bid & 7, lb = bid >> 3, nlb = nblk >> 3, nl = lb < 64 ? (64 - lb + nlb - 1) / nlb : 0;
  for (int it = 0;; ++it) {
    int rtile, ct;
    if (xmap) {
      if (it < nl) { const int v = lb + it * nlb; rtile = 1 + xcd + 8 * (v >> 3); ct = v & 7; }
      else { const int e2 = bid + (it - nl) * nblk; if (e2 >= nctx) break; rtile = 0; ct = e2; }
    } else {
      const int u = bid + it * nblk; if (u >= 64 * 8 + nctx) break;
      if (u < 512) { rtile = 1 + (u >> 3); ct = u & 7; } else { rtile = 0; ct = u - 512; }
    }
    const int m0 = rtile * 256, n0 = ct * 128;
    f32x16 acc[2][2];
#pragma unroll
    for (int a = 0; a < 2; ++a)
#pragma unroll
      for (int b = 0; b < 2; ++b) acc[a][b] = (f32x16){};
    { int nd = 0; gemm_mainloop<256, 128, 0>(lds, acc, [&](int row) { return A + (size_t)(m0 + row) * D; }, [&](int) { return W + n0; }, D, D, nd); }
#pragma unroll
    for (int ti = 0; ti < 2; ++ti) {
      const int tok = m0 + wm * 64 + ti * 32 + r32;
#pragma unroll
      for (int ni = 0; ni < 2; ++ni)
#pragma unroll
        for (int g = 0; g < 4; ++g) *(u32x2*)(Y + (size_t)tok * D + n0 + wn * 64 + ni * 32 + 8 * g + 4 * hi) = pack4(acc[ti][ni], g);
    }
  }
}

__device__ __forceinline__ void moe_prefix(const int* cnt, LAS int* pre, int xcd) {
  if (TIDX == 0) {
    int o = 0; for (int e = 0; e < NE; ++e) { pre[e] = o; o += (cnt[e * CNT_STRIDE] + 127) >> 7; } pre[NE] = o;
    int l = 0; for (int j = 0; j < 4; ++j) { pre[40 + j] = l; l += (cnt[(xcd + 8 * j) * CNT_STRIDE] + 127) >> 7; } pre[44] = l;
  }
  __syncthreads();
}
__device__ __forceinline__ bool moe_unit(const LAS int* pre, int bid, int nblk, int it, int& e, int& rt, int& ct, int& g) {
  if ((nblk & 7) == 0) {
    const int xcd = bid & 7, v = (bid >> 3) + it * (nblk >> 3), gl = v >> 2;
    if (gl >= pre[44]) return false;
    int j = 0; if (gl >= pre[41]) j = 1; if (gl >= pre[42]) j = 2; if (gl >= pre[43]) j = 3;
    e = xcd + 8 * j; rt = gl - pre[40 + j]; ct = v & 3; g = pre[e] + rt; return true;
  } else {
    const int u = bid + it * nblk; g = u >> 2; if (g >= pre[NE]) return false;
    int ee = 0; for (int i = 1; i < NE; ++i) ee += (pre[i] <= g) ? 1 : 0;
    e = ee; rt = g - pre[ee]; ct = u & 3; return true;
  }
}

__device__ __forceinline__ void phase_d1(const Params& p, int layer, LAS char* lds, int bid, int nblk) {
  const int* cnt = (const int*)(p.ws + OFF_CNT) + layer * NE * CNT_STRIDE;
  const bf16_t* H2 = (const bf16_t*)(p.ws + OFF_MIX);
  bf16_t* HM = (bf16_t*)(p.ws + OFF_HMID);
  LAS int* pre = (LAS int*)(lds + GEMM_LDS);
  moe_prefix(cnt, pre, bid & 7);
  const int lane = TIDX & 63, wid = TIDX >> 6, r32 = lane & 31, hi = lane >> 5, wm = wid >> 2, wn = wid & 3;
  for (int it = 0;; ++it) {
    int e, rt, ct, g; if (!moe_unit(pre, bid, nblk, it, e, rt, ct, g)) break;
    const int n = cnt[e * CNT_STRIDE];
    const int* list = (const int*)(p.ws + OFF_LIST) + (size_t)e * CAPL + rt * 128;
    const bf16_t* Wg = (const bf16_t*)(p.ws + OFF_WG) + ((size_t)layer * NE + e) * D * DE + ct * 128;
    const bf16_t* Wu = (const bf16_t*)(p.ws + OFF_WU) + ((size_t)layer * NE + e) * D * DE + ct * 128;
    const int nvalid = n - rt * 128;
    f32x16 acc[2][2];
#pragma unroll
    for (int a = 0; a < 2; ++a)
#pragma unroll
      for (int b = 0; b < 2; ++b) acc[a][b] = (f32x16){};
    int nd = 0;
    gemm_mainloop<128, 256, 2>(lds, acc, [&](int row) { const int tok = row < nvalid ? (list[row] >> 1) : 0; return H2 + (size_t)tok * D; },
                               [&](int s) { return s == 0 ? Wg : Wu; }, DE, D, nd);
    const size_t hrow0 = (size_t)(pre[e] + rt) * 128;
#pragma unroll
    for (int ti = 0; ti < 2; ++ti) {
      const size_t row = hrow0 + wm * 64 + ti * 32 + r32;
      f32x16 a;
#pragma unroll
      for (int r = 0; r < 16; ++r) { const float gv = acc[ti][0][r]; a[r] = gv / (1.f + __expf(-gv)) * acc[ti][1][r]; }
#pragma unroll
      for (int gq = 0; gq < 4; ++gq) *(u32x2*)(HM + row * DE + ct * 128 + wn * 32 + 8 * gq + 4 * hi) = pack4(a, gq);
    }
  }
}

__device__ __forceinline__ void phase_d2(const Params& p, int layer, LAS char* lds, int bid, int nblk) {
  const int* cnt = (const int*)(p.ws + OFF_CNT) + layer * NE * CNT_STRIDE;
  const bf16_t* HM = (const bf16_t*)(p.ws + OFF_HMID);
  const float* GATE = (const float*)(p.ws + OFF_GATE);
  bf16_t* OM = (bf16_t*)(p.ws + OFF_OMOE);
  LAS int* pre = (LAS int*)(lds + GEMM_LDS);
  moe_prefix(cnt, pre, bid & 7);
  const int lane = TIDX & 63, wid = TIDX >> 6, r32 = lane & 31, hi = lane >> 5, wm = wid >> 2, wn = wid & 3;
  for (int it = 0;; ++it) {
    int e, rt, ct, g; if (!moe_unit(pre, bid, nblk, it, e, rt, ct, g)) break;
    const int n = cnt[e * CNT_STRIDE];
    const int* list = (const int*)(p.ws + OFF_LIST) + (size_t)e * CAPL + rt * 128;
    const bf16_t* Wd = (const bf16_t*)(p.ws + OFF_WD) + ((size_t)layer * NE + e) * DE * D + ct * 256;
    const int nvalid = n - rt * 128;
    const bf16_t* A = HM + (size_t)g * 128 * DE;
    f32x16 acc[2][2];
#pragma unroll
    for (int a = 0; a < 2; ++a)
#pragma unroll
      for (int b = 0; b < 2; ++b) acc[a][b] = (f32x16){};
    { int nd = 0; gemm_mainloop<128, 256, 1>(lds, acc, [&](int row) { return A + (size_t)row * DE; }, [&](int s) { return Wd + s * 128; }, D, DE, nd); }
#pragma unroll
    for (int ti = 0; ti < 2; ++ti) {
      const int row = wm * 64 + ti * 32 + r32;
      if (row < nvalid) {
        const int ts = list[row];
        const float gt = GATE[ts];
#pragma unroll
        for (int ni = 0; ni < 2; ++ni) {
          f32x16 a;
#pragma unroll
          for (int r = 0; r < 16; ++r) a[r] = acc[ti][ni][r] * gt;
#pragma unroll
          for (int gq = 0; gq < 4; ++gq) *(u32x2*)(OM + (size_t)ts * D + ct * 256 + wn * 64 + ni * 32 + 8 * gq + 4 * hi) = pack4(a, gq);
        }
      }
    }
  }
}

constexpr int ATT_SLOT = 16384, ATT_LDS = 4 * ATT_SLOT;
__device__ __forceinline__ int vst64(int k, int c) { const int kk = (k & ~0xC) | ((k & 4) << 1) | ((k & 8) >> 1); return ((kk >> 3) * 2 + (c >> 5)) * 512 + ((kk & 7) * 32 + (c & 31)) * 2; }
__device__ __forceinline__ bf16x8 tr_frag64(const LAS char* p) {
  s16x4 a = __builtin_amdgcn_ds_read_tr16_b64_v4i16((LAS s16x4*)p);
  s16x4 b = __builtin_amdgcn_ds_read_tr16_b64_v4i16((LAS s16x4*)(p + 1024));
  return (bf16x8){a[0], a[1], a[2], a[3], b[0], b[1], b[2], b[3]};
}
__device__ __forceinline__ bf16x8 pk4(const f32x16& P, int B) {
  unsigned a0 = cvtpk(P[B + 0], P[B + 1]), a1 = cvtpk(P[B + 2], P[B + 3]), b0 = cvtpk(P[B + 4], P[B + 5]), b1 = cvtpk(P[B + 6], P[B + 7]);
  auto r0 = __builtin_amdgcn_permlane32_swap(a0, b0, false, false); auto r1 = __builtin_amdgcn_permlane32_swap(a1, b1, false, false);
  u32x4 w = {r0[0], r1[0], r0[1], r1[1]};
  return __builtin_bit_cast(bf16x8, w);
}
struct AttnCtx { int krd0, krd1, ksw, hi, vrd; };
#define SBAR() __builtin_amdgcn_sched_barrier(0)
__device__ __forceinline__ void att_kload(const LAS char* slot, const AttnCtx& c, bf16x8 (&kf)[8]) {
#pragma unroll
  for (int d0 = 0; d0 < 4; ++d0) {
    kf[2 * d0] = *(const LAS bf16x8*)(slot + c.krd0 + (((2 * d0 + c.hi) ^ c.ksw) << 4));
    kf[2 * d0 + 1] = *(const LAS bf16x8*)(slot + c.krd1 + (((2 * d0 + c.hi) ^ c.ksw) << 4));
  }
}
__device__ __forceinline__ void att_qk(const bf16x8 (&kf)[8], const bf16x8 (&qr)[4], f32x16& s0, f32x16& s1) {
  s0 = (f32x16){}; s1 = (f32x16){};
#pragma unroll
  for (int d0 = 0; d0 < 4; ++d0) {
    s0 = __builtin_amdgcn_mfma_f32_32x32x16_bf16(kf[2 * d0], qr[d0], s0, 0, 0, 0);
    s1 = __builtin_amdgcn_mfma_f32_32x32x16_bf16(kf[2 * d0 + 1], qr[d0], s1, 0, 0, 0);
  }
}
__device__ __forceinline__ void att_exp(f32x16& s, float& l) {
#pragma unroll
  for (int r = 0; r < 16; ++r) { s[r] = __builtin_amdgcn_exp2f(s[r]); l += s[r]; }
  asm volatile("" : "+v"(l));
}
template <int KS0>
__device__ __forceinline__ void att_vload(const LAS char* slot, const AttnCtx& c, bf16x8 (&vf)[4]) {
#pragma unroll
  for (int i = 0; i < 2; ++i) { vf[2 * i] = tr_frag64(slot + c.vrd + (KS0 + i) * 2048); vf[2 * i + 1] = tr_frag64(slot + c.vrd + 512 + (KS0 + i) * 2048); }
}
__device__ __forceinline__ void att_pv2(const bf16x8& pa, const bf16x8& pb, const bf16x8 (&vf)[4], f32x16& o0, f32x16& o1) {
  o0 = __builtin_amdgcn_mfma_f32_32x32x16_bf16(pa, vf[0], o0, 0, 0, 0);
  o1 = __builtin_amdgcn_mfma_f32_32x32x16_bf16(pa, vf[1], o1, 0, 0, 0);
  o0 = __builtin_amdgcn_mfma_f32_32x32x16_bf16(pb, vf[2], o0, 0, 0, 0);
  o1 = __builtin_amdgcn_mfma_f32_32x32x16_bf16(pb, vf[3], o1, 0, 0, 0);
}
__device__ __forceinline__ void attn_unit(const Params& p, LAS char* lds, int row0, int hp, int nkeys) {
  const bf16_t* Q = (const bf16_t*)(p.ws + OFF_Q); const bf16_t* Kb = (const bf16_t*)(p.ws + OFF_K); const bf16_t* Vb = (const bf16_t*)(p.ws + OFF_V);
  bf16_t* MIX = (bf16_t*)(p.ws + OFF_MIX);
  const int tid = TIDX, wid = tid >> 6, lane = tid & 63, r32 = lane & 31, hi = lane >> 5, kvh = hp >> 1;
  bf16x8 qa[4], qb[4];
  { const bf16_t* Qg = Q + (size_t)(row0 + wid * 32 + r32) * 512 + hp * 128 + hi * 8;
#pragma unroll
    for (int d0 = 0; d0 < 4; ++d0) { qa[d0] = *(const bf16x8*)(Qg + d0 * 16); qb[d0] = *(const bf16x8*)(Qg + 64 + d0 * 16); } }
  const bf16_t* Kg = Kb + (size_t)(tid >> 3) * 128 + kvh * 64 + (tid & 7) * 8;
  const bf16_t* Vg = Vb + (size_t)(tid >> 3) * 128 + kvh * 64 + (tid & 7) * 8;
  const int kst = xoff(tid >> 3, tid & 7), vstw = 8192 + vst64(tid >> 3, (tid & 7) * 8);
  AttnCtx c; c.krd0 = r32 * 128; c.krd1 = (32 + r32) * 128; c.ksw = (r32 >> 1) & 7; c.hi = hi; c.vrd = 8192 + v_rd_base(lane);
  const int NT = nkeys >> 6;
  f32x16 oa0 = {}, oa1 = {}, ob0 = {}, ob1 = {}; float la = 0.f, lb = 0.f;
  u32x4 ks, vs;
  {
    const u32x4 k0 = *(const u32x4*)Kg, k1 = *(const u32x4*)(Kg + 64 * 128), v0 = *(const u32x4*)Vg, v1 = *(const u32x4*)(Vg + 64 * 128);
    *(LAS u32x4*)(lds + kst) = k0; *(LAS u32x4*)(lds + ATT_SLOT + kst) = k1;
    *(LAS u32x4*)(lds + vstw) = v0; *(LAS u32x4*)(lds + ATT_SLOT + vstw) = v1;
    ks = *(const u32x4*)(Kg + 2 * 64 * 128); vs = *(const u32x4*)(Vg + 2 * 64 * 128);
  }
  __syncthreads();
  for (int j = 0; j < NT; ++j) {
    const LAS char* sl = lds + (j & 3) * ATT_SLOT;
    bf16x8 kf[8], vfa[4], vfb[4];
    f32x16 sa0, sa1, sb0, sb1;
    att_kload(sl, c, kf);
    SBAR();
    att_qk(kf, qa, sa0, sa1);
    SBAR();
    att_qk(kf, qb, sb0, sb1);
    att_exp(sa0, la); att_exp(sa1, la);
    SBAR();
    const bf16x8 pa0 = pk4(sa0, 0), pa1 = pk4(sa0, 8), pa2 = pk4(sa1, 0), pa3 = pk4(sa1, 8);
    att_vload<0>(sl, c, vfa);
    SBAR();
    att_pv2(pa0, pa1, vfa, oa0, oa1);
    att_exp(sb0, lb);
    att_vload<2>(sl, c, vfb);
    SBAR();
    att_pv2(pa2, pa3, vfb, oa0, oa1);
    att_exp(sb1, lb);
    const bf16x8 pb0 = pk4(sb0, 0), pb1 = pk4(sb0, 8), pb2 = pk4(sb1, 0), pb3 = pk4(sb1, 8);
    att_vload<0>(sl, c, vfa);
    SBAR();
    att_pv2(pb0, pb1, vfa, ob0, ob1);
    att_vload<2>(sl, c, vfb);
    SBAR();
    att_pv2(pb2, pb3, vfb, ob0, ob1);
    { LAS char* w = lds + ((j + 2) & 3) * ATT_SLOT;
      if (j + 2 < NT) { *(LAS u32x4*)(w + kst) = ks; *(LAS u32x4*)(w + vstw) = vs; }
      if (j + 3 < NT) { ks = *(const u32x4*)(Kg + (size_t)(j + 3) * 64 * 128); vs = *(const u32x4*)(Vg + (size_t)(j + 3) * 64 * 128); } }
    __syncthreads();
  }
  la = sum32(la); lb = sum32(lb);
  LAS float* li = (LAS float*)(lds + wid * 256);
  if (hi == 0) { li[r32] = la; li[32 + r32] = lb; }
  __syncthreads();
  bf16_t* Og = MIX + (size_t)(row0 + wid * 32) * D + hp * 128 + r32;
#pragma unroll
  for (int r = 0; r < 16; ++r) {
    const int orow = crow(r, hi);
    const float ra = __builtin_amdgcn_rcpf(li[orow]), rb = __builtin_amdgcn_rcpf(li[32 + orow]);
    Og[(size_t)orow * D] = f2bf(oa0[r] * ra); Og[(size_t)orow * D + 32] = f2bf(oa1[r] * ra);
    Og[(size_t)orow * D + 64] = f2bf(ob0[r] * rb); Og[(size_t)orow * D + 96] = f2bf(ob1[r] * rb);
  }
  __syncthreads();
}
typedef int i32x8 __attribute__((ext_vector_type(8)));
constexpr int A8_SLOT = 8192, A8_LDS = 4 * A8_SLOT;
__device__ __forceinline__ int off8(int row, int chunk) { return row * 64 + ((chunk ^ ((row >> 2) & 3)) << 4); }
__device__ __forceinline__ i32x8 ld_frag8(const LAS char* tile, int row, int h) {
  const int sw = (row >> 2) & 3;
  const u32x4 lo = *(const LAS u32x4*)(tile + row * 64 + (((2 * h) ^ sw) << 4)), hi = *(const LAS u32x4*)(tile + row * 64 + (((2 * h + 1) ^ sw) << 4));
  return (i32x8){(int)lo[0], (int)lo[1], (int)lo[2], (int)lo[3], (int)hi[0], (int)hi[1], (int)hi[2], (int)hi[3]};
}
#define MX_FP8_FP8(a, b, c) __builtin_amdgcn_mfma_scale_f32_32x32x64_f8f6f4(a, b, c, 0, 0, 0, 0x7f7f7f7f, 0, 0x7f7f7f7f)
#define MX_BF8_FP8(a, b, c) __builtin_amdgcn_mfma_scale_f32_32x32x64_f8f6f4(a, b, c, 1, 0, 0, 0x7f7f7f7f, 0, 0x7f7f7f7f)
__device__ __forceinline__ void att8_exp(f32x16& s, float& l) {
#pragma unroll
  for (int r = 0; r < 16; ++r) { s[r] = __builtin_amdgcn_exp2f(s[r]); l += s[r]; }
  asm volatile("" : "+v"(l));
}
__device__ __forceinline__ i32x8 att8_pack(const f32x16& p0, const f32x16& p1) {
  i32x8 w;
#pragma unroll
  for (int i = 0; i < 4; ++i) {
    int d = __builtin_amdgcn_cvt_pk_bf8_f32(p0[4 * i], p0[4 * i + 1], 0, false); d = __builtin_amdgcn_cvt_pk_bf8_f32(p0[4 * i + 2], p0[4 * i + 3], d, true);
    int e = __builtin_amdgcn_cvt_pk_bf8_f32(p1[4 * i], p1[4 * i + 1], 0, false); e = __builtin_amdgcn_cvt_pk_bf8_f32(p1[4 * i + 2], p1[4 * i + 3], e, true);
    auto r = __builtin_amdgcn_permlane32_swap((unsigned)d, (unsigned)e, false, false);
    w[2 * i] = (int)r[0]; w[2 * i + 1] = (int)r[1];
  }
  return w;
}
__device__ __forceinline__ void attn_unit8(const Params& p, LAS char* lds, int row0, int hp, int nkeys, bf16_t* MIXP = nullptr) {
  const unsigned char* Q8 = (const unsigned char*)(p.ws + OFF_Q8); const unsigned char* K8 = (const unsigned char*)(p.ws + OFF_K8); const unsigned char* VT8 = (const unsigned char*)(p.ws + OFF_VT8);
  bf16_t* MIX = MIXP ? MIXP : (bf16_t*)(p.ws + OFF_MIX);
  const int tid = TIDX, wid = tid >> 6, lane = tid & 63, r32 = lane & 31, hi = lane >> 5, kvh = hp >> 1;
  i32x8 qa, qb;
  { const unsigned char* Qg = Q8 + (size_t)(row0 + wid * 32 + r32) * 512 + hp * 128 + hi * 32;
    const u32x4 a0 = *(const u32x4*)Qg, a1 = *(const u32x4*)(Qg + 16), b0 = *(const u32x4*)(Qg + 64), b1 = *(const u32x4*)(Qg + 80);
    qa = (i32x8){(int)a0[0], (int)a0[1], (int)a0[2], (int)a0[3], (int)a1[0], (int)a1[1], (int)a1[2], (int)a1[3]};
    qb = (i32x8){(int)b0[0], (int)b0[1], (int)b0[2], (int)b0[3], (int)b1[0], (int)b1[1], (int)b1[2], (int)b1[3]}; }
  const int su = tid & 255, srow = su >> 2, sch = su & 3;
  const unsigned char* Sg = tid < 256 ? K8 + (size_t)srow * 128 + kvh * 64 + sch * 16 : VT8 + (size_t)(kvh * 64 + srow) * TT + sch * 16;
  const size_t sstep = tid < 256 ? (size_t)64 * 128 : (size_t)64;
  const int sst = (tid < 256 ? 0 : 4096) + off8(srow, sch);
  const int NT = nkeys >> 6;
  f32x16 oa0 = {}, oa1 = {}, ob0 = {}, ob1 = {}; float la = 0.f, lb = 0.f;
  u32x4 sv;
  { const u32x4 t0 = *(const u32x4*)Sg, t1 = *(const u32x4*)(Sg + sstep);
    *(LAS u32x4*)(lds + sst) = t0; *(LAS u32x4*)(lds + A8_SLOT + sst) = t1;
    sv = *(const u32x4*)(Sg + 2 * sstep); }
  __syncthreads();
  for (int j = 0; j < NT; ++j) {
    const LAS char* sl = lds + (j & 3) * A8_SLOT;
    f32x16 sa0 = {}, sa1 = {}, sb0 = {}, sb1 = {};
    const i32x8 kf0 = ld_frag8(sl, r32, hi), kf1 = ld_frag8(sl, 32 + r32, hi);
    SBAR();
    sa0 = MX_FP8_FP8(kf0, qa, sa0); sa1 = MX_FP8_FP8(kf1, qa, sa1);
    SBAR();
    sb0 = MX_FP8_FP8(kf0, qb, sb0); sb1 = MX_FP8_FP8(kf1, qb, sb1);
    att8_exp(sa0, la); att8_exp(sa1, la);
    SBAR();
    const i32x8 pa = att8_pack(sa0, sa1);
    const i32x8 vf0 = ld_frag8(sl + 4096, r32, hi), vf1 = ld_frag8(sl + 4096, 32 + r32, hi);
    SBAR();
    oa0 = MX_BF8_FP8(pa, vf0, oa0); oa1 = MX_BF8_FP8(pa, vf1, oa1);
    att8_exp(sb0, lb); att8_exp(sb1, lb);
    const i32x8 pb = att8_pack(sb0, sb1);
    SBAR();
    ob0 = MX_BF8_FP8(pb, vf0, ob0); ob1 = MX_BF8_FP8(pb, vf1, ob1);
    { LAS char* w = lds + ((j + 2) & 3) * A8_SLOT;
      if (j + 2 < NT) *(LAS u32x4*)(w + sst) = sv;
      if (j + 3 < NT) sv = *(const u32x4*)(Sg + (size_t)(j + 3) * sstep); }
    __syncthreads();
  }
  la = sum32(la); lb = sum32(lb);
  LAS float* li = (LAS float*)(lds + wid * 256);
  if (hi == 0) { li[r32] = la; li[32 + r32] = lb; }
  __syncthreads();
  bf16_t* Og = MIX + (size_t)(row0 + wid * 32) * D + hp * 128 + r32;
#pragma unroll
  for (int r = 0; r < 16; ++r) {
    const int orow = crow(r, hi);
    const float ra = __builtin_amdgcn_rcpf(li[orow]), rb = __builtin_amdgcn_rcpf(li[32 + orow]);
    Og[(size_t)orow * D] = f2bf(oa0[r] * ra); Og[(size_t)orow * D + 32] = f2bf(oa1[r] * ra);
    Og[(size_t)orow * D + 64] = f2bf(ob0[r] * rb); Og[(size_t)orow * D + 96] = f2bf(ob1[r] * rb);
  }
  __syncthreads();
}
__device__ __forceinline__ void attn_fallback(const Params& p, int layer, int bid, int nblk) {
  const bf16_t* Q = (const bf16_t*)(p.ws + OFF_Q); const bf16_t* Kb = (const bf16_t*)(p.ws + OFF_K); const bf16_t* Vb = (const bf16_t*)(p.ws + OFF_V);
  bf16_t* MIX = (bf16_t*)(p.ws + OFF_MIX);
  const int lane = TIDX & 63, nwv = nblk * 8;
  const int rg0 = layer == 0 ? 0 : NCTX / 64;
  for (int wv = bid * 8 + (TIDX >> 6) + rg0 * 8; wv < (TT / 64) * 8; wv += nwv) {
    const int head = wv & 7, r = (wv >> 3) * 64 + lane, kvh = head >> 2;
    float q[64], o[64];
#pragma unroll
    for (int d = 0; d < 64; ++d) { q[d] = bf2f(Q[(size_t)r * 512 + head * 64 + d]); o[d] = 0.f; }
    float m = -1e30f, l = 0.f;
    const int nk = r >= NCTX ? TT : NCTX;
    for (int j = 0; j < nk; ++j) {
      const bf16_t* kr = Kb + (size_t)j * 128 + kvh * 64;
      const bf16_t* vr = Vb + (size_t)j * 128 + kvh * 64;
      float s = 0.f;
#pragma unroll
      for (int d = 0; d < 64; ++d) s += q[d] * bf2f(kr[d]);
      if (s > m) {
        const float a = __builtin_amdgcn_exp2f(m - s);
        l *= a;
#pragma unroll
        for (int d = 0; d < 64; ++d) o[d] *= a;
        m = s;
      }
      const float pe = __builtin_amdgcn_exp2f(s - m);
      l += pe;
#pragma unroll
      for (int d = 0; d < 64; ++d) o[d] += pe * bf2f(vr[d]);
    }
    const float il = 1.f / l;
#pragma unroll
    for (int d = 0; d < 64; ++d) MIX[(size_t)r * D + head * 64 + d] = f2bf(o[d] * il);
  }
}

constexpr int PC_U = 0;
constexpr int PC_Y = 49152;
constexpr int PC_LDS = PC_Y + 65536;
__device__ __forceinline__ void poolconv_unit(const Params& p, int layer, LAS char* lds, int tile) {
  const int tid = TIDX, wid = tid >> 6, lane = tid & 63, r32 = lane & 31, hi = lane >> 5;
  const int t0 = tile * 64, base = tile < 4 ? 0 : NCTX, n = tile < 4 ? NCTX : SEQ;
  const bf16_t* AG = (const bf16_t*)(p.ws + OFF_AG);
  const float* U = (const float*)(p.ws + OFF_U);
  bf16_t* MIX = (bf16_t*)(p.ws + OFF_MIX);
#pragma unroll
  for (int h = 0; h < 2; ++h) {
    u32x4 av[3], gv[3]; bool in[3];
#pragma unroll
    for (int q = 0; q < 3; ++q) {
      const int idx = tid + (h * 3 + q) * 512, rr = idx >> 5, ch = (idx & 31) * 8, t = t0 - 15 + rr;
      in[q] = idx < 94 * 32 && t >= base && t < base + n;
      const size_t off = (size_t)(in[q] ? t : t0) * 512 + ch;
      av[q] = *(const u32x4*)(AG + off); gv[q] = *(const u32x4*)(AG + off + 256);
    }
#pragma unroll
    for (int q = 0; q < 3; ++q) {
      const int idx = tid + (h * 3 + q) * 512, rr = idx >> 5, ch = (idx & 31) * 8;
      u32x4 out = {0u, 0u, 0u, 0u};
      if (in[q]) {
#pragma unroll
        for (int i = 0; i < 4; ++i) {
          const float a0 = __uint_as_float(av[q][i] << 16), a1 = __uint_as_float(av[q][i] & 0xffff0000u);
          const float g0 = __uint_as_float(gv[q][i] << 16), g1 = __uint_as_float(gv[q][i] & 0xffff0000u);
          out[i] = cvtpk(a0 / (1.f + __expf(-g0)), a1 / (1.f + __expf(-g1)));
        }
      }
      if (idx < 94 * 32) *(LAS u32x4*)(lds + PC_U + (rr * 256 + ch) * 2) = out;
    }
  }
  __syncthreads();
  {
    const int c = tid & 255, th = tid >> 8;
    float w[31];
#pragma unroll
    for (int j = 0; j < 31; ++j) w[j] = p.w_dw[(size_t)layer * 31 * 256 + j * 256 + c];
    const float b = p.b_dw[layer * 256 + c];
    float acc[32];
#pragma unroll
    for (int i = 0; i < 32; ++i) acc[i] = b;
    const LAS bf16_t* up = (const LAS bf16_t*)(lds + PC_U) + (th * 32) * 256 + c;
#pragma unroll
    for (int rr = 0; rr < 62; ++rr) {
      const float uv = bf2f(up[rr * 256]);
#pragma unroll
      for (int i = 0; i < 32; ++i) if (rr - i >= 0 && rr - i < 31) acc[i] += uv * w[rr - i];
    }
    LAS float* yp = (LAS float*)(lds + PC_Y) + (th * 32) * 256 + c;
#pragma unroll
    for (int i = 0; i < 32; ++i) yp[i * 256] = acc[i];
  }
  __syncthreads();
  {
    const f32x4 g4 = *(const f32x4*)(p.cv_ln_g + layer * 256 + lane * 4), b4 = *(const f32x4*)(p.cv_ln_b + layer * 256 + lane * 4);
#pragma unroll
    for (int i = 0; i < 8; ++i) {
      const int tok = wid * 8 + i;
      const f32x4 y = *(const LAS f32x4*)(lds + PC_Y + (tok * 256 + lane * 4) * 4);
      const float mu = wave_sum(y[0] + y[1] + y[2] + y[3]) * (1.f / 256.f);
      const float d0 = y[0] - mu, d1 = y[1] - mu, d2 = y[2] - mu, d3 = y[3] - mu;
      const float rs = rsqrtf(wave_sum(d0 * d0 + d1 * d1 + d2 * d2 + d3 * d3) * (1.f / 256.f) + EPS);
      const float z0 = silu(d0 * rs * g4[0] + b4[0]), z1 = silu(d1 * rs * g4[1] + b4[1]), z2 = silu(d2 * rs * g4[2] + b4[2]), z3 = silu(d3 * rs * g4[3] + b4[3]);
      const int chunk = lane >> 1, sw = (chunk & 16) | ((chunk ^ tok) & 15);
      *(LAS u32x2*)(lds + PC_U + tok * 512 + sw * 16 + (lane & 1) * 8) = (u32x2){cvtpk(z0, z1), cvtpk(z2, z3)};
    }
  }
  __syncthreads();
  {
    const int tb = wid >> 2, dg = wid & 3, trow = tb * 32 + r32, t = t0 + trow;
    const bf16_t* Wt = (const bf16_t*)(p.ws + OFF_WPWT) + ((size_t)layer * 256 + dg * 64 + r32) * 256 + hi * 8;
    f32x16 acc0 = {}, acc1 = {};
#pragma unroll 8
    for (int ks = 0; ks < 16; ++ks) {
      const int chunk = 2 * ks + hi, sw = (chunk & 16) | ((chunk ^ trow) & 15);
      const bf16x8 zf = *(const LAS bf16x8*)(lds + PC_U + trow * 512 + sw * 16);
      const bf16x8 w0 = *(const bf16x8*)(Wt + ks * 16), w1 = *(const bf16x8*)(Wt + 32 * 256 + ks * 16);
      acc0 = __builtin_amdgcn_mfma_f32_32x32x16_bf16(w0, zf, acc0, 0, 0, 0);
      acc1 = __builtin_amdgcn_mfma_f32_32x32x16_bf16(w1, zf, acc1, 0, 0, 0);
    }
    bf16_t* dst = MIX + (size_t)t * D + 768 + dg * 64;
#pragma unroll
    for (int g = 0; g < 4; ++g) { *(u32x2*)(dst + 8 * g + 4 * hi) = pack4(acc0, g); *(u32x2*)(dst + 32 + 8 * g + 4 * hi) = pack4(acc1, g); }
    const int w = 2 << dg, tl = t - base, lo = max(tl - w / 2, 0), hh = min(tl + w / 2, n);
    const float inv = 1.f / (float)(hh - lo);
    const bf16_t* Pt = (const bf16_t*)(p.ws + OFF_WPOOLT) + ((size_t)(layer * 4 + dg) * 64 + r32) * 64 + hi * 8;
    f32x16 pc0 = {}, pc1 = {};
#pragma unroll
    for (int ks = 0; ks < 4; ++ks) {
      const int c0 = dg * 64 + ks * 16 + hi * 8;
      f32x4 s0 = {0.f, 0.f, 0.f, 0.f}, s1 = {0.f, 0.f, 0.f, 0.f};
#pragma unroll
      for (int i = 0; i < 16; ++i) {
        const int rr = lo + i; const bool in = i < w && rr < hh;
        const float* ur = U + (size_t)(base + (in ? rr : lo)) * 256 + c0; const float wgt = in ? 1.f : 0.f;
        s0 += *(const f32x4*)ur * wgt; s1 += *(const f32x4*)(ur + 4) * wgt;
      }
      const float* uo = U + (size_t)t * 256 + c0;
      const f32x4 o0 = *(const f32x4*)uo, o1 = *(const f32x4*)(uo + 4);
      s0 = s0 * inv - o0; s1 = s1 * inv - o1;
      u32x4 pw = {cvtpk(s0[0], s0[1]), cvtpk(s0[2], s0[3]), cvtpk(s1[0], s1[1]), cvtpk(s1[2], s1[3])};
      const bf16x8 pf = __builtin_bit_cast(bf16x8, pw);
      const bf16x8 w0 = *(const bf16x8*)(Pt + ks * 16), w1 = *(const bf16x8*)(Pt + 32 * 64 + ks * 16);
      pc0 = __builtin_amdgcn_mfma_f32_32x32x16_bf16(w0, pf, pc0, 0, 0, 0);
      pc1 = __builtin_amdgcn_mfma_f32_32x32x16_bf16(w1, pf, pc1, 0, 0, 0);
    }
    const float* psc = p.pool_scale + layer * 256 + dg * 64;
#pragma unroll
    for (int r = 0; r < 16; ++r) { pc0[r] *= psc[crow(r, hi)]; pc1[r] *= psc[32 + crow(r, hi)]; }
    bf16_t* pd = MIX + (size_t)t * D + 512 + dg * 64;
#pragma unroll
    for (int g = 0; g < 4; ++g) { *(u32x2*)(pd + 8 * g + 4 * hi) = pack4(pc0, g); *(u32x2*)(pd + 32 + 8 * g + 4 * hi) = pack4(pc1, g); }
  }
  __syncthreads();
}

__device__ __forceinline__ void phase_b(const Params& p, int layer, LAS char* lds, int bid, int nblk) {
  const bool fast = ((const int*)(p.ws + OFF_FLAG))[0] != 0;
  const int nu = (520 - bid + nblk - 1) / nblk;
  for (int i = 0; i < nu; ++i) {
    const int u = bid + ((bid & 1) ? (nu - 1 - i) : i) * nblk;
#ifndef ATT_BF16
    if (u < 256) { if (fast) attn_unit8(p, lds, NCTX + (u >> 2) * 256, u & 3, TT); }
    else if (u < 260) { if (fast && layer == 0) attn_unit8(p, lds, 0, u - 256, NCTX); }
#else
    if (u < 256) { if (fast) attn_unit(p, lds, NCTX + (u >> 2) * 256, u & 3, TT); }
    else if (u < 260) { if (fast && layer == 0) attn_unit(p, lds, 0, u - 256, NCTX); }
#endif
    else { const int tile = u - 260; if (layer == 0 || tile >= 4) poolconv_unit(p, layer, lds, tile); }
  }
  if (!fast) attn_fallback(p, layer, bid, nblk);
}

constexpr int NR = 2, NRA = 2;
__device__ __forceinline__ float hsum4(const f32x4 (&v)[4]) { float s = 0.f;
#pragma unroll
  for (int i = 0; i < 4; ++i) s += (v[i][0] + v[i][1]) + (v[i][2] + v[i][3]);
  return s; }
__device__ __forceinline__ float hsq4(const f32x4 (&v)[4], float mu) { float q = 0.f;
#pragma unroll
  for (int i = 0; i < 4; ++i) { const f32x4 d = v[i] - mu; q += (d[0] * d[0] + d[1] * d[1]) + (d[2] * d[2] + d[3] * d[3]); }
  return q; }
__device__ __forceinline__ f32x4 bf4(u32x2 w) { return (f32x4){__uint_as_float(w[0] << 16), __uint_as_float(w[0] & 0xffff0000u), __uint_as_float(w[1] << 16), __uint_as_float(w[1] & 0xffff0000u)}; }

__device__ __forceinline__ void phase_a0(const Params& p, int layer, int bid, int nblk) {
  const int wave = bid * 8 + (TIDX >> 6), lane = TIDX & 63, nw = nblk * 8;
  float* X = (float*)(p.ws + OFF_X);
  bf16_t* H = (bf16_t*)(p.ws + OFF_H);
  const bf16_t* OM = (const bf16_t*)(p.ws + OFF_OMOE);
  for (int rb = wave * NRA; rb < TT; rb += nw * NRA) {
    f32x4 v[NRA][4]; u32x2 oa[NRA][4], ob[NRA][4];
#pragma unroll
    for (int k = 0; k < NRA; ++k) {
      const int r = rb + k;
      const float* src = layer == 0 ? (r < NCTX ? p.ctx + (size_t)r * D : p.x + (size_t)(r - NCTX) * D) : X + (size_t)r * D;
#pragma unroll
      for (int i = 0; i < 4; ++i) { const int c = i * 256 + lane * 4; v[k][i] = *(const f32x4*)(src + c);
        if (layer != 0) { oa[k][i] = *(const u32x2*)(OM + ((size_t)r * 2 + 0) * D + c); ob[k][i] = *(const u32x2*)(OM + ((size_t)r * 2 + 1) * D + c); } }
    }
    if (layer != 0) {
#pragma unroll
      for (int k = 0; k < NRA; ++k) {
        const int r = rb + k, s = r < NCTX ? 1 : 0;
        const float* g2 = (const float*)(p.ws + OFF_MOD) + ((layer - 1) * 2 + s) * 6144 + 5 * D;
#pragma unroll
        for (int i = 0; i < 4; ++i) { const int c = i * 256 + lane * 4; v[k][i] = v[k][i] * ALPHA + *(const f32x4*)(g2 + c) * (bf4(oa[k][i]) + bf4(ob[k][i])); }
      }
      float mu[NRA], rs[NRA];
#pragma unroll
      for (int k = 0; k < NRA; ++k) mu[k] = wave_sum(hsum4(v[k])) * (1.f / D);
#pragma unroll
      for (int k = 0; k < NRA; ++k) rs[k] = rsqrtf(wave_sum(hsq4(v[k], mu[k])) * (1.f / D) + EPS);
      const float* g = p.ln2_g + (layer - 1) * D; const float* b = p.ln2_b + (layer - 1) * D;
#pragma unroll
      for (int k = 0; k < NRA; ++k)
#pragma unroll
        for (int i = 0; i < 4; ++i) { const int c = i * 256 + lane * 4; v[k][i] = (v[k][i] - mu[k]) * rs[k] * *(const f32x4*)(g + c) + *(const f32x4*)(b + c); *(f32x4*)(X + (size_t)(rb + k) * D + c) = v[k][i]; }
    }
    float mu[NRA], rs[NRA];
#pragma unroll
    for (int k = 0; k < NRA; ++k) mu[k] = wave_sum(hsum4(v[k])) * (1.f / D);
#pragma unroll
    for (int k = 0; k < NRA; ++k) rs[k] = rsqrtf(wave_sum(hsq4(v[k], mu[k])) * (1.f / D) + EPS);
#pragma unroll
    for (int k = 0; k < NRA; ++k) {
      const int r = rb + k, s = r < NCTX ? 1 : 0;
      const float* modp = (const float*)(p.ws + OFF_MOD) + (layer * 2 + s) * 6144;
#pragma unroll
      for (int i = 0; i < 4; ++i) {
        const int c = i * 256 + lane * 4;
        const f32x4 h = (v[k][i] - mu[k]) * rs[k] * (*(const f32x4*)(modp + D + c) + 1.f) + *(const f32x4*)(modp + c);
        *(u32x2*)(H + (size_t)r * D + c) = (u32x2){cvtpk(h[0], h[1]), cvtpk(h[2], h[3])};
      }
    }
  }
}

__device__ __forceinline__ void phase_c2(const Params& p, int layer, LAS char* lds, int bid, int nblk) {
  const int tid = TIDX, wid = tid >> 6, lane = tid & 63;
  float* X = (float*)(p.ws + OFF_X);
  const bf16_t* Y = (const bf16_t*)(p.ws + OFF_Y);
  bf16_t* H2 = (bf16_t*)(p.ws + OFF_MIX);
  int* cnt = (int*)(p.ws + OFF_CNT) + layer * NE * CNT_STRIDE;
  float* GATE = (float*)(p.ws + OFF_GATE); int* LIST = (int*)(p.ws + OFF_LIST);
  LAS int* lcnt = (LAS int*)lds;
  LAS int* lbase = lcnt + 32;
  LAS int* ent = lcnt + 64;
  if (tid < 32) lcnt[tid] = 0;
  LAS float* wre = (LAS float*)(lds + 4096);
#pragma unroll
  for (int kk = 0; kk < 2; ++kk) {
    const int k = tid + kk * 512;
    f32x4 w[8];
#pragma unroll
    for (int g = 0; g < 8; ++g) w[g] = *(const f32x4*)(p.w_re + ((size_t)layer * D + k) * 32 + g * 4);
#pragma unroll
    for (int g = 0; g < 8; ++g)
#pragma unroll
      for (int j = 0; j < 4; ++j) wre[(g * 4 + j) * 1024 + k] = w[g][j];
  }
  __syncthreads();
  const int r0 = layer == 0 ? 0 : NCTX, nrows = TT - r0, rpb = (nrows + nblk - 1) / nblk;
  const int rbeg = r0 + bid * rpb, rend = min(rbeg + rpb, TT);
  for (int rb = rbeg + wid * NR; rb < rend; rb += 8 * NR) {
    f32x4 v[NR][4]; u32x2 yv[NR][4]; int rr[NR]; bool ok[NR];
#pragma unroll
    for (int k = 0; k < NR; ++k) {
      ok[k] = rb + k < rend; rr[k] = ok[k] ? rb + k : rb;
      const int r = rr[k];
      const float* xin = layer == 0 ? (r < NCTX ? p.ctx + (size_t)r * D : p.x + (size_t)(r - NCTX) * D) : X + (size_t)r * D;
#pragma unroll
      for (int i = 0; i < 4; ++i) { const int c = i * 256 + lane * 4; v[k][i] = *(const f32x4*)(xin + c); yv[k][i] = *(const u32x2*)(Y + (size_t)r * D + c); }
    }
#pragma unroll
    for (int k = 0; k < NR; ++k) {
      const float* modp = (const float*)(p.ws + OFF_MOD) + (layer * 2 + (rr[k] < NCTX ? 1 : 0)) * 6144;
#pragma unroll
      for (int i = 0; i < 4; ++i) { const int c = i * 256 + lane * 4; v[k][i] = v[k][i] * ALPHA + *(const f32x4*)(modp + 2 * D + c) * bf4(yv[k][i]); }
    }
    float mu[NR], rs[NR];
#pragma unroll
    for (int k = 0; k < NR; ++k) mu[k] = wave_sum(hsum4(v[k])) * (1.f / D);
#pragma unroll
    for (int k = 0; k < NR; ++k) rs[k] = rsqrtf(wave_sum(hsq4(v[k], mu[k])) * (1.f / D) + EPS);
#pragma unroll
    for (int k = 0; k < NR; ++k)
#pragma unroll
      for (int i = 0; i < 4; ++i) {
        const int c = i * 256 + lane * 4;
        v[k][i] = (v[k][i] - mu[k]) * rs[k] * *(const f32x4*)(p.ln1_g + layer * D + c) + *(const f32x4*)(p.ln1_b + layer * D + c);
        if (ok[k]) *(f32x4*)(X + (size_t)rr[k] * D + c) = v[k][i];
      }
#pragma unroll
    for (int k = 0; k < NR; ++k) mu[k] = wave_sum(hsum4(v[k])) * (1.f / D);
#pragma unroll
    for (int k = 0; k < NR; ++k) rs[k] = rsqrtf(wave_sum(hsq4(v[k], mu[k])) * (1.f / D) + EPS);
#pragma unroll
    for (int k = 0; k < NR; ++k) {
      const float* modp = (const float*)(p.ws + OFF_MOD) + (layer * 2 + (rr[k] < NCTX ? 1 : 0)) * 6144;
#pragma unroll
      for (int i = 0; i < 4; ++i) {
        const int c = i * 256 + lane * 4;
        v[k][i] = (v[k][i] - mu[k]) * rs[k] * (*(const f32x4*)(modp + 4 * D + c) + 1.f) + *(const f32x4*)(modp + 3 * D + c);
        if (ok[k]) *(u32x2*)(H2 + (size_t)rr[k] * D + c) = (u32x2){cvtpk(v[k][i][0], v[k][i][1]), cvtpk(v[k][i][2], v[k][i][3])};
      }
    }
    f32x4 lg[NR];
#pragma unroll
    for (int k = 0; k < NR; ++k) lg[k] = (f32x4){0.f, 0.f, 0.f, 0.f};
#pragma unroll
    for (int i = 0; i < 4; ++i)
#pragma unroll
      for (int j = 0; j < 4; ++j) { const f32x4 w = *(const f32x4*)(p.w_rg + ((size_t)layer * D + i * 256 + lane * 4 + j) * 4);
#pragma unroll
        for (int k = 0; k < NR; ++k) lg[k] += w * v[k][i][j]; }
    int gsel[NR]; float pgrp[NR];
#pragma unroll
    for (int k = 0; k < NR; ++k) {
      float l0 = wave_sum(lg[k][0]) + p.b_rg[layer * 4 + 0], l1 = wave_sum(lg[k][1]) + p.b_rg[layer * 4 + 1];
      float l2 = wave_sum(lg[k][2]) + p.b_rg[layer * 4 + 2], l3 = wave_sum(lg[k][3]) + p.b_rg[layer * 4 + 3];
      int gs = 0; float gm = l0;
      if (l1 > gm) { gm = l1; gs = 1; }
      if (l2 > gm) { gm = l2; gs = 2; }
      if (l3 > gm) { gm = l3; gs = 3; }
      gsel[k] = gs; pgrp[k] = 1.f / (__expf(l0 - gm) + __expf(l1 - gm) + __expf(l2 - gm) + __expf(l3 - gm));
    }
#pragma unroll
    for (int k = 0; k < NR; ++k) {
      float le[8];
#pragma unroll
      for (int e = 0; e < 8; ++e) {
        const LAS float* wr = wre + (gsel[k] * 8 + e) * 1024 + lane * 4;
        float a = 0.f;
#pragma unroll
        for (int i = 0; i < 4; ++i) { const f32x4 w = *(const LAS f32x4*)(wr + i * 256); a += (w[0] * v[k][i][0] + w[1] * v[k][i][1]) + (w[2] * v[k][i][2] + w[3] * v[k][i][3]); }
        le[e] = a;
      }
#pragma unroll
      for (int e = 0; e < 8; ++e) le[e] = wave_sum(le[e]) + p.b_re[layer * 32 + gsel[k] * 8 + e];
      int i0 = 0; float v0 = le[0];
#pragma unroll
      for (int e = 1; e < 8; ++e) if (le[e] > v0) { v0 = le[e]; i0 = e; }
      int i1 = -1; float v1 = -3.0e38f;
#pragma unroll
      for (int e = 0; e < 8; ++e) if (e != i0 && le[e] > v1) { v1 = le[e]; i1 = e; }
      if (i1 < 0) { i1 = (i0 + 1) & 7; v1 = v0; }
      const float e1 = __expf(v1 - v0);
      if (lane == 0 && ok[k]) {
        const int r = rr[k], xa = gsel[k] * 8 + i0, xb = gsel[k] * 8 + i1;
        const int pa = __hip_atomic_fetch_add(&lcnt[xa], 1, __ATOMIC_RELAXED, __HIP_MEMORY_SCOPE_WORKGROUP);
        const int pb = __hip_atomic_fetch_add(&lcnt[xb], 1, __ATOMIC_RELAXED, __HIP_MEMORY_SCOPE_WORKGROUP);
        const int li = (r - rbeg) * 2;
        ent[li * 3 + 0] = xa; ent[li * 3 + 1] = pa; ent[li * 3 + 2] = r * 2 + 0;
        ent[li * 3 + 3] = xb; ent[li * 3 + 4] = pb; ent[li * 3 + 5] = r * 2 + 1;
        GATE[r * 2] = pgrp[k] / (1.f + e1); GATE[r * 2 + 1] = pgrp[k] * e1 / (1.f + e1);
      }
    }
  }
  __syncthreads();
  if (tid < 32) { const int c = lcnt[tid]; lbase[tid] = c > 0 ? atomicAdd(&cnt[tid * CNT_STRIDE], c) : 0; }
  __syncthreads();
  for (int i = tid; i < (rend - rbeg) * 2; i += 512) { const int e = ent[i * 3], lp = ent[i * 3 + 1]; LIST[(size_t)e * CAPL + lbase[e] + lp] = ent[i * 3 + 2]; }
  __syncthreads();
}

__device__ __forceinline__ void phase_final(const Params& p, int bid, int nblk) {
  const int wave = bid * 8 + (TIDX >> 6), lane = TIDX & 63, nw = nblk * 8;
  const float* X = (const float*)(p.ws + OFF_X);
  const bf16_t* OM = (const bf16_t*)(p.ws + OFF_OMOE);
  const float* g2 = (const float*)(p.ws + OFF_MOD) + (1 * 2 + 0) * 6144 + 5 * D;
  for (int rb = NCTX + wave * NRA; rb < TT; rb += nw * NRA) {
    f32x4 v[NRA][4]; u32x2 oa[NRA][4], ob[NRA][4];
#pragma unroll
    for (int k = 0; k < NRA; ++k)
#pragma unroll
      for (int i = 0; i < 4; ++i) { const int c = i * 256 + lane * 4, r = rb + k;
        v[k][i] = *(const f32x4*)(X + (size_t)r * D + c); oa[k][i] = *(const u32x2*)(OM + ((size_t)r * 2 + 0) * D + c); ob[k][i] = *(const u32x2*)(OM + ((size_t)r * 2 + 1) * D + c); }
#pragma unroll
    for (int k = 0; k < NRA; ++k)
#pragma unroll
      for (int i = 0; i < 4; ++i) { const int c = i * 256 + lane * 4; v[k][i] = v[k][i] * ALPHA + *(const f32x4*)(g2 + c) * (bf4(oa[k][i]) + bf4(ob[k][i])); }
    float mu[NRA], rs[NRA];
#pragma unroll
    for (int k = 0; k < NRA; ++k) mu[k] = wave_sum(hsum4(v[k])) * (1.f / D);
#pragma unroll
    for (int k = 0; k < NRA; ++k) rs[k] = rsqrtf(wave_sum(hsq4(v[k], mu[k])) * (1.f / D) + EPS);
#pragma unroll
    for (int k = 0; k < NRA; ++k)
#pragma unroll
      for (int i = 0; i < 4; ++i) {
        const int c = i * 256 + lane * 4;
        *(f32x4*)(p.out + (size_t)(rb + k - NCTX) * D + c) = (v[k][i] - mu[k]) * rs[k] * *(const f32x4*)(p.ln2_g + D + c) + *(const f32x4*)(p.ln2_b + D + c);
      }
  }
}

__device__ __forceinline__ void phase_p0(const Params& p, LAS char* lds, int bid, int nblk) {
  const int tid = TIDX;
  const long gtid = (long)bid * 512 + tid, gth = (long)nblk * 512;
  LAS float* sc = (LAS float*)lds;
  LAS float* red = (LAS float*)(lds + 8192);
  for (int i = tid; i < 2048; i += 512) { const float v = i < 1024 ? p.c[i] : p.c_ctx[i - 1024]; sc[i] = silu(v); }
  __syncthreads();
  float* mod = (float*)(p.ws + OFF_MOD);
  for (int u = bid; u < 384; u += nblk) {
    const int layer = u / 192, cg = u % 192, col = tid & 31, ksl = tid >> 5;
    const float* w = p.w_mod + ((size_t)layer * D + ksl * 64) * 6144 + cg * 32 + col;
    float a0 = 0.f, a1 = 0.f;
#pragma unroll 8
    for (int k = 0; k < 64; ++k) { const float wv = w[(size_t)k * 6144]; a0 += sc[ksl * 64 + k] * wv; a1 += sc[1024 + ksl * 64 + k] * wv; }
    red[(ksl * 32 + col) * 2] = a0; red[(ksl * 32 + col) * 2 + 1] = a1;
    __syncthreads();
    if (tid < 64) {
      const int c2 = tid & 31, s = tid >> 5; float a = 0.f;
#pragma unroll
      for (int k = 0; k < 16; ++k) a += red[(k * 32 + c2) * 2 + s];
      mod[(layer * 2 + s) * 6144 + cg * 32 + c2] = a + p.b_mod[layer * 6144 + cg * 32 + c2];
    }
    __syncthreads();
  }
  if (gtid < 256 * 16) {
    const int pos = (int)gtid / 16, f = (int)gtid % 16;
    const float ang = (float)pos * powf(10000.f, -(float)f / 16.f);
    float* rt = (float*)(p.ws + OFF_ROPE);
    rt[gtid * 2 + 0] = cosf(ang); rt[gtid * 2 + 1] = sinf(ang);
  }
  if (gtid < 2 * NE * CNT_STRIDE) ((int*)(p.ws + OFF_CNT))[gtid] = 0;
  if (gtid == 0) {
    float bmax = 0.f;
    for (int l = 0; l < 2; ++l) {
      float gq = 0.f, gk = 0.f;
      for (int i = 0; i < 64; ++i) { gq = fmaxf(gq, fabsf(p.q_gain[l * 64 + i])); gk = fmaxf(gk, fabsf(p.k_gain[l * 64 + i])); }
      bmax = fmaxf(bmax, 11.55f * gq * gk);
    }
    ((int*)(p.ws + OFF_FLAG))[0] = (bmax <= 100.f) ? 1 : 0;
  }
  for (long i = gtid; i < 2 * 65536; i += gth) { const int l = (int)(i >> 16), d = (int)(i >> 8) & 255, c = (int)i & 255; ((bf16_t*)(p.ws + OFF_WPWT))[i] = f2bf(p.w_cv_pw[((size_t)l * 256 + c) * 256 + d]); }
  for (long i = gtid; i < 8 * 4096; i += gth) { const int lg = (int)(i >> 12), d = (int)(i >> 6) & 63, c = (int)i & 63; ((bf16_t*)(p.ws + OFF_WPOOLT))[i] = f2bf(p.w_pool[((size_t)lg * 64 + c) * 64 + d]); }
  cvt_range(p.w_in, (bf16_t*)(p.ws + OFF_WIN), 2L * D * INW / 8, gtid, gth);
  cvt_range(p.w_out, (bf16_t*)(p.ws + OFF_WOUT), 2L * D * D / 8, gtid, gth);
}
#define XB_TMO      128
#define XB_XCNT(j)  (256  + 64 * (j))
#define XB_XSUB(j)  (1280 + 64 * (j))
#define XB_XGEN(j)  (2304 + 64 * (j))
#define XB_TOP      3328
#define XB_TOPGEN   3392
#define XCD_BAR_WORDS 3456
#define XB_SPIN_CAP (1u << 22)
__device__ __forceinline__ unsigned xb_ld(unsigned* p)              { return __hip_atomic_load(p, __ATOMIC_RELAXED, __HIP_MEMORY_SCOPE_AGENT); }
__device__ __forceinline__ unsigned xb_add(unsigned* p, unsigned v) { return __hip_atomic_fetch_add(p, v, __ATOMIC_RELAXED, __HIP_MEMORY_SCOPE_AGENT); }
__device__ __forceinline__ unsigned xb_xcc_id() { return (unsigned)__builtin_amdgcn_s_getreg((3 << 11) | 20) & 0xFu; }
#define XB_SPIN(cond, bar) do { unsigned _sp = 0; while (cond) { __builtin_amdgcn_s_sleep(1); \
    if ((++_sp & 255u) == 0u) { if (xb_ld(&(bar)[XB_TMO])) break; if (_sp > XB_SPIN_CAP) { atomicAdd(&(bar)[XB_TMO], 1u); break; } } } } while (0)
struct XcdBarrier { unsigned* bar; unsigned x; volatile LAS unsigned* st; };
__device__ __forceinline__ XcdBarrier xcd_barrier_post(unsigned* bar, volatile LAS unsigned* st) {
  XcdBarrier b; b.bar = bar; b.x = xb_xcc_id(); b.st = st;
  if (threadIdx.x == 0) (void)xb_add(&bar[XB_XCNT(b.x)], 1u);
  return b;
}
__device__ __forceinline__ void xcd_barrier_complete(unsigned* bar, unsigned x, unsigned& nloc, unsigned& nx) {
  const unsigned G = gridDim.x * gridDim.y * gridDim.z;
  unsigned sum, cnt, mine, sp = 0u;
  for (;;) {
    sum = 0u; cnt = 0u; mine = 0u;
#pragma unroll
    for (unsigned j = 0; j < 16; ++j) { const unsigned c = xb_ld(&bar[XB_XCNT(j)]); sum += c; cnt += (c > 0u) ? 1u : 0u; mine = (j == x) ? c : mine; }
    if (sum == G) break;
    __builtin_amdgcn_s_sleep(1);
    if ((++sp & 255u) == 0u) { if (xb_ld(&bar[XB_TMO])) break; if (sp > XB_SPIN_CAP) { atomicAdd(&bar[XB_TMO], 1u); break; } }
  }
  nloc = mine > 0u ? mine : 1u; nx = cnt > 0u ? cnt : 1u;
}
__device__ __forceinline__ void xcd_barrier(const XcdBarrier& b) {
  asm volatile("s_waitcnt vmcnt(0)" ::: "memory");
  __syncthreads();
  if (threadIdx.x == 0) {
    unsigned* bar = b.bar; unsigned bx = b.x;
    asm volatile("" : "+s"(bar), "+s"(bx));
    __builtin_amdgcn_s_waitcnt(0);
    unsigned nloc = b.st[0], nx = b.st[1];
    if (nloc == 0u) { xcd_barrier_complete(bar, bx, nloc, nx); b.st[0] = nloc; b.st[1] = nx; }
    const unsigned old = xb_add(&bar[XB_XSUB(bx)], 1u);
    const unsigned gen = old / nloc;
    if (old + 1u == (gen + 1u) * nloc) {
      __builtin_amdgcn_fence(__ATOMIC_RELEASE, "agent");
      asm volatile("s_waitcnt vmcnt(0)" ::: "memory");
      const unsigned og = xb_add(&bar[XB_TOP], 1u);
      const unsigned tg = og / nx;
      if (og + 1u == (tg + 1u) * nx) xb_add(&bar[XB_TOPGEN], 1u);
      else XB_SPIN(xb_ld(&bar[XB_TOPGEN]) == tg, bar);
      __builtin_amdgcn_fence(__ATOMIC_ACQUIRE, "agent");
      xb_add(&bar[XB_XGEN(bx)], 1u);
      asm volatile("s_waitcnt vmcnt(0)" ::: "memory");
    } else {
      XB_SPIN(xb_ld(&bar[XB_XGEN(bx)]) == gen, bar);
      __builtin_amdgcn_fence(__ATOMIC_ACQUIRE, "agent");
      asm volatile("s_waitcnt vmcnt(0)" ::: "memory");
    }
  }
  __syncthreads();
}

constexpr int LDS_MAIN = PC_LDS > GEMM_LDS + 256 ? PC_LDS : GEMM_LDS + 256;
constexpr int LDS_TOTAL = LDS_MAIN + 16;
static_assert(GEMM_LDS + 256 <= LDS_MAIN && ATT_LDS <= LDS_MAIN, "lds");
__global__ void __launch_bounds__(512) mega_fwd(Params p) {
  __shared__ __attribute__((aligned(16))) char slds[LDS_TOTAL];
  LAS char* lds = (LAS char*)slds;
  volatile LAS unsigned* st = (volatile LAS unsigned*)(lds + LDS_MAIN);
  if (threadIdx.x < 4) st[threadIdx.x] = 0u;
  __syncthreads();
  const XcdBarrier bar = xcd_barrier_post((unsigned*)(p.ws + OFF_BAR), st);
  const int bid = blockIdx.x, nblk = gridDim.x;
  phase_p0(p, lds, bid, nblk);
  xcd_barrier(bar);
#pragma unroll 1
  for (int layer = 0; layer < 2; ++layer) {
    phase_a0(p, layer, bid, nblk);
    xcd_barrier(bar);
    phase_a1(p, layer, lds, bid, nblk);
    xcd_barrier(bar);
    phase_b(p, layer, lds, bid, nblk);
    xcd_barrier(bar);
    phase_c1(p, layer, lds, bid, nblk);
    xcd_barrier(bar);
    phase_c2(p, layer, lds, bid, nblk);
    xcd_barrier(bar);
    phase_d1(p, layer, lds, bid, nblk);
    xcd_barrier(bar);
    phase_d2(p, layer, lds, bid, nblk);
    xcd_barrier(bar);
  }
  phase_final(p, bid, nblk);
}

extern "C" void kernel_launch(void* const* d_in, const int* in_sizes, int n_in, void* d_out, int out_size, void* d_ws, size_t ws_size,
                              hipStream_t stream) {
  static int grid = 0;
  if (grid == 0) {
    if (ws_size < WS_END || n_in != 28) { fprintf(stderr, "kernel_launch: ws too small (%zu < %zu) or n_in %d != 28; nothing launched\n", ws_size, (size_t)WS_END, n_in); grid = -1; return; }
    int dev = 0, cus = 0, per_cu = 0;
    if (hipGetDevice(&dev) != hipSuccess || hipDeviceGetAttribute(&cus, hipDeviceAttributeMultiprocessorCount, dev) != hipSuccess) { grid = -1; return; }
    if (hipOccupancyMaxActiveBlocksPerMultiprocessor(&per_cu, (const void*)mega_fwd, 512, 0) != hipSuccess || per_cu < 1) {
      fprintf(stderr, "kernel_launch: occupancy query says %d blocks per CU; nothing launched\n", per_cu); grid = -1; return; }
    (void)hipGetLastError();
    grid = cus;
  }
  if (grid < 0) return;
  if (hipMemsetAsync((char*)d_ws + OFF_BAR, 0, BAR_BYTES, stream) != hipSuccess) { fprintf(stderr, "kernel_launch: memset failed\n"); return; }
  Params p{};
  const float** f = (const float**)&p;
  for (int i = 0; i < 28; ++i) f[i] = (const float*)d_in[i];
  p.out = (float*)d_out; p.ws = (char*)d_ws;
  hipLaunchKernelGGL(mega_fwd, dim3(grid), dim3(512), 0, stream, p);
}
```

```cpp
#include <hip/hip_runtime.h>
#include <cstdio>
#include <cstdint>

typedef unsigned short bf16_t;
#define LAS __attribute__((address_space(3)))

constexpr int D = 1024, SEQ = 16384, NCTX = 256, TT = SEQ + NCTX;
constexpr int INW = 1536;
constexpr int NE = 32, DE = 512;
constexpr int CAPL = 2 * TT;
constexpr int HMID_ROWS = 2 * TT + NE * 128;
constexpr float ALPHA = 1.41421356237309515f;
constexpr float EPS = 1e-6f;

constexpr size_t al(size_t x) { return (x + 255) / 256 * 256; }
constexpr size_t OFF_BAR = 0;
constexpr size_t BAR_BYTES = 3456 * 4;
constexpr size_t OFF_MOD = OFF_BAR + al(BAR_BYTES);
constexpr size_t OFF_ROPE = OFF_MOD + al(2 * 2 * 6144 * 4);
constexpr int CNT_STRIDE = 32;
constexpr size_t OFF_CNT = OFF_ROPE + al(256 * 16 * 2 * 4);
constexpr size_t OFF_FLAG = OFF_CNT + al(2 * 32 * 32 * 4);
constexpr size_t OFF_X = OFF_FLAG + 256;
constexpr size_t OFF_H = OFF_X + al((size_t)TT * D * 4);
constexpr size_t OFF_MIX = OFF_H + al((size_t)TT * D * 2);
constexpr size_t OFF_Y = OFF_MIX + al((size_t)TT * D * 2);
constexpr size_t OFF_Q = OFF_Y + al((size_t)TT * D * 2);
constexpr size_t OFF_K = OFF_Q + al((size_t)TT * 512 * 2);
constexpr size_t OFF_V = OFF_K + al((size_t)TT * 128 * 2);
constexpr size_t OFF_U = OFF_V + al((size_t)TT * 128 * 2);
constexpr size_t OFF_AG = OFF_U + al((size_t)TT * 256 * 4);
constexpr size_t OFF_HMID = OFF_Q;
constexpr size_t OFF_OMOE = OFF_AG + al((size_t)TT * 512 * 2);
constexpr size_t OFF_GATE = OFF_OMOE + al((size_t)TT * 2 * D * 2);
constexpr size_t OFF_LIST = OFF_GATE + al((size_t)TT * 2 * 4);
constexpr size_t OFF_WIN = OFF_LIST + al((size_t)NE * CAPL * 4);
constexpr size_t OFF_WOUT = OFF_WIN + al((size_t)2 * D * INW * 2);
constexpr size_t OFF_WPWT = OFF_WOUT + al((size_t)2 * D * D * 2);
constexpr size_t OFF_WPOOLT = OFF_WPWT + al((size_t)2 * 256 * 256 * 2);
constexpr size_t OFF_Q8 = OFF_WPOOLT + al((size_t)2 * 4 * 64 * 64 * 2);
constexpr size_t OFF_K8 = OFF_Q8 + al((size_t)TT * 512);
constexpr size_t OFF_VT8 = OFF_K8 + al((size_t)TT * 128);
constexpr size_t OFF_WG = OFF_VT8 + al((size_t)128 * TT);
constexpr size_t OFF_WU = OFF_WG + al((size_t)2 * NE * D * DE * 2);
constexpr size_t OFF_WD = OFF_WU + al((size_t)2 * NE * D * DE * 2);
constexpr size_t WS_END = OFF_WD + al((size_t)2 * NE * D * DE * 2);
static_assert(OFF_AG - OFF_HMID >= (size_t)HMID_ROWS * DE * 2, "HMID alias too small");
static_assert(WS_END < 530000000, "ws budget");

struct Params {
  const float *x, *c, *ctx, *c_ctx, *w_mod, *b_mod, *w_in, *q_gain, *k_gain, *w_pool, *pool_scale, *w_dw, *b_dw,
      *cv_ln_g, *cv_ln_b, *w_cv_pw, *w_out, *ln1_g, *ln1_b, *ln2_g, *ln2_b, *w_rg, *b_rg, *w_re, *b_re, *w_e_gate, *w_e_up, *w_e_down;
  float* out;
  char* ws;
};

__device__ __forceinline__ float bf2f(bf16_t v) { return __uint_as_float(((unsigned)v) << 16); }
__device__ __forceinline__ bf16_t f2bf(float f) {
  unsigned u = __float_as_uint(f);
  u += 0x7fffu + ((u >> 16) & 1u);
  return (bf16_t)(u >> 16);
}
template <int CTRL> __device__ __forceinline__ float dppf(float v) { return __int_as_float(__builtin_amdgcn_update_dpp(0, __float_as_int(v), CTRL, 0xf, 0xf, true)); }
__device__ __forceinline__ float wave_sum(float v) {
  v += dppf<0xB1>(v); v += dppf<0x4E>(v); v += dppf<0x141>(v); v += dppf<0x140>(v);
  { auto r = __builtin_amdgcn_permlane16_swap(__float_as_uint(v), __float_as_uint(v), false, false); v = __uint_as_float(r[0]) + __uint_as_float(r[1]); }
  { auto r = __builtin_amdgcn_permlane32_swap(__float_as_uint(v), __float_as_uint(v), false, false); v = __uint_as_float(r[0]) + __uint_as_float(r[1]); }
  return v;
}
__device__ __forceinline__ float silu(float v) { return v / (1.f + __expf(-v)); }
__device__ __forceinline__ int opaque0() { int z; asm volatile("s_mov_b32 %0, 0" : "=s"(z)); return z; }
#define TIDX ((int)threadIdx.x + opaque0())
using bf16x8 = __attribute__((ext_vector_type(8))) short;
using s16x4 = __attribute__((ext_vector_type(4))) short;
using f32x16 = __attribute__((ext_vector_type(16))) float;
using f32x4 = __attribute__((ext_vector_type(4))) float;
using u32x4 = __attribute__((ext_vector_type(4))) unsigned;
using u32x2 = __attribute__((ext_vector_type(2))) unsigned;

__device__ __forceinline__ int crow(int r, int hi) { return (r & 3) + 8 * (r >> 2) + 4 * hi; }
typedef float f32x2 __attribute__((ext_vector_type(2)));
typedef __bf16 bf16x2v __attribute__((ext_vector_type(2)));
__device__ __forceinline__ unsigned cvtpk(float lo, float hi) {
  bf16x2v b = __builtin_convertvector((f32x2){lo, hi}, bf16x2v);
  return __builtin_bit_cast(unsigned, b);
}
__device__ __forceinline__ float sum32(float v) {
  auto rr = __builtin_amdgcn_permlane32_swap(__float_as_uint(v), __float_as_uint(v), false, false);
  return __uint_as_float(rr[0]) + __uint_as_float(rr[1]);
}

__device__ __forceinline__ void cvt_range(const float* __restrict__ src, bf16_t* __restrict__ dst, long n8, long gtid, long gthreads) {
  for (long i = gtid; i < n8; i += gthreads) {
    const f32x4 a = *(const f32x4*)(src + i * 8), b = *(const f32x4*)(src + i * 8 + 4);
    u32x4 w = {cvtpk(a[0], a[1]), cvtpk(a[2], a[3]), cvtpk(b[0], b[1]), cvtpk(b[2], b[3])};
    *(u32x4*)(dst + i * 8) = w;
  }
}

__device__ __forceinline__ int xoff(int row, int chunk) { return row * 128 + ((chunk ^ ((row >> 1) & 7)) << 4); }
__device__ __forceinline__ int wst(int k, int c) { const int kk = (k & ~0xC) | ((k & 4) << 1) | ((k & 8) >> 1); return ((kk >> 3) * 4 + (c >> 5)) * 512 + ((kk & 7) * 32 + (c & 31)) * 2; }
__device__ __forceinline__ int v_rd_base(int lane) { return ((lane & 3) << 3) | (((lane >> 2) & 3) << 6) | (((lane >> 4) & 1) << 5) | (((lane >> 5) & 1) << 8); }

__device__ __forceinline__ bf16x8 tr_frag(const LAS char* p) {
  s16x4 a = __builtin_amdgcn_ds_read_tr16_b64_v4i16((LAS s16x4*)p);
  s16x4 b = __builtin_amdgcn_ds_read_tr16_b64_v4i16((LAS s16x4*)(p + 2048));
  return (bf16x8){a[0], a[1], a[2], a[3], b[0], b[1], b[2], b[3]};
}

template <int OFF> __device__ __forceinline__ bf16x8 tr_frag_asm(int addr) {
  s16x4 a, b;
  asm volatile("ds_read_b64_tr_b16 %0, %1 offset:%2" : "=&v"(a) : "v"(addr), "i"(OFF) : "memory");
  asm volatile("ds_read_b64_tr_b16 %0, %1 offset:%2" : "=&v"(b) : "v"(addr), "i"(OFF + 2048) : "memory");
  return (bf16x8){a[0], a[1], a[2], a[3], b[0], b[1], b[2], b[3]};
}

template <int BM, int BN> struct GemmCfg {
  static constexpr int WM = BM / 64, WN = 8 / WM, NSLAB = BN / 128, XB = BM * 128, WB = NSLAB * 16384, STAGE = XB + WB, NXP = BM / 64, NWP = NSLAB * 2;
  static_assert(WM * WN == 8 && WN * 64 == BN, "tile");
};
constexpr int GEMM_LDS = 3 * (256 * 128 + 16384);

template <int BM, int BN, int NMAP, bool BG = false, class XRow, class WPtr>
__device__ __forceinline__ void gemm_mainloop(LAS char* lds, f32x16 (&acc)[2][2], const XRow& xrow, const WPtr& wptr, int ldw, int K, int& bgdone, int bgn = 0, long bgc0 = 0,
                                              const float* bs0 = nullptr, const float* bs1 = nullptr, const float* bs2 = nullptr, bf16_t* bd0 = nullptr, bf16_t* bd1 = nullptr, bf16_t* bd2 = nullptr) {
#define BG_ISSUE(i, a, b) do { long c_ = bgc0 + (long)(i) * 512; if (c_ >= (3L << 21)) c_ = 0; const int t_ = (int)(c_ >> 21); const long o_ = (c_ & 0x1fffff) * 8; \
    const float* sp_ = (t_ == 0 ? bs0 : (t_ == 1 ? bs1 : bs2)) + o_; a = *(const f32x4*)sp_; b = *(const f32x4*)(sp_ + 4); } while (0)
#define BG_RETIRE(i, a, b) do { const long c_ = bgc0 + (long)(i) * 512; if (c_ < (3L << 21)) { const int t_ = (int)(c_ >> 21); const long o_ = (c_ & 0x1fffff) * 8; \
    bf16_t* dp_ = (t_ == 0 ? bd0 : (t_ == 1 ? bd1 : bd2)) + o_; *(u32x4*)dp_ = (u32x4){cvtpk(a[0], a[1]), cvtpk(a[2], a[3]), cvtpk(b[0], b[1]), cvtpk(b[2], b[3])}; } } while (0)
  using C = GemmCfg<BM, BN>;
  const int tid = TIDX, wid = tid >> 6, lane = tid & 63, r32 = lane & 31, hi = lane >> 5;
  const int wm = wid / C::WN, wn = wid % C::WN;
  const bf16_t *g0, *g1, *g2, *g3, *g4, *g5; int l0, l1, l2, l3, l4, l5;
  auto xpiece = [&](int i, const bf16_t*& gp, int& lp) { const int q = wid * C::NXP + i, row = 8 * q + (lane >> 3), c = (lane & 7) ^ ((row >> 1) & 7); gp = xrow(row) + c * 8; lp = q * 1024; };
  auto wpiece = [&](int i, const bf16_t*& gp, int& lp) {
    const int idx = wid * C::NWP + i, s = idx >> 4, q = idx & 15, sub = 2 * q + (lane >> 5), kk = (sub >> 2) * 8 + ((lane & 31) >> 2);
    const int k = (kk & ~0xC) | ((kk & 4) << 1) | ((kk & 8) >> 1), c = (sub & 3) * 32 + (lane & 3) * 8;
    gp = wptr(s) + (size_t)k * ldw + c; lp = C::XB + s * 16384 + q * 1024; };
  if (C::NXP == 4) { xpiece(0, g0, l0); xpiece(1, g1, l1); xpiece(2, g2, l2); xpiece(3, g3, l3); wpiece(0, g4, l4); wpiece(1, g5, l5); }
  else { xpiece(0, g0, l0); xpiece(1, g1, l1); wpiece(0, g2, l2); wpiece(1, g3, l3); wpiece(2, g4, l4); wpiece(3, g5, l5); }
  const size_t stepx = 64, stepw = (size_t)64 * ldw;
  const size_t stp0 = stepx, stp1 = stepx, stp2 = C::NXP == 4 ? stepx : stepw, stp3 = C::NXP == 4 ? stepx : stepw, stp4 = stepw, stp5 = stepw;
  int xr[2];
#pragma unroll
  for (int ti = 0; ti < 2; ++ti) xr[ti] = (wm * 64 + ti * 32 + r32) * 128;
  const int xsw = (r32 >> 1) & 7;
  int wr[2];
#pragma unroll
  for (int ni = 0; ni < 2; ++ni) {
    const int slab = NMAP == 0 ? 0 : (NMAP == 1 ? (wn >> 1) : ni);
    const int nb = NMAP == 0 ? (2 * wn + ni) : (NMAP == 1 ? ((wn & 1) * 2 + ni) : wn);
    wr[ni] = C::XB + slab * 16384 + nb * 512 + v_rd_base(lane);
  }
  const int nk = K / 64;
#define G_DMA1(gp, sp, lp, kt, _d) __builtin_amdgcn_global_load_lds((const unsigned*)((gp) + (size_t)(kt) * (sp)), (LAS unsigned*)((_d) + (lp)), 16, 0, 0)
#define G_DMA(kt, st) do { LAS char* _d = lds + (st) * C::STAGE; \
    G_DMA1(g0, stp0, l0, kt, _d); G_DMA1(g1, stp1, l1, kt, _d); G_DMA1(g2, stp2, l2, kt, _d); G_DMA1(g3, stp3, l3, kt, _d); G_DMA1(g4, stp4, l4, kt, _d); G_DMA1(g5, stp5, l5, kt, _d); } while (0)
#define G_HALF(cur, wa0, wa1, H) do { bf16x8 xf[2][2], wf[2][2]; \
      _Pragma("unroll") for (int k2 = 0; k2 < 2; ++k2) _Pragma("unroll") for (int ti = 0; ti < 2; ++ti) xf[k2][ti] = *(const LAS bf16x8*)(cur + xr[ti] + ((((H * 2 + k2) * 2 + hi) ^ xsw) << 4)); \
      wf[0][0] = tr_frag_asm<(H * 2 + 0) * 4096>(wa0); wf[0][1] = tr_frag_asm<(H * 2 + 0) * 4096>(wa1); \
      wf[1][0] = tr_frag_asm<(H * 2 + 1) * 4096>(wa0); wf[1][1] = tr_frag_asm<(H * 2 + 1) * 4096>(wa1); \
      asm volatile("s_waitcnt lgkmcnt(0)" ::: "memory"); __builtin_amdgcn_sched_barrier(0); \
      _Pragma("unroll") for (int k2 = 0; k2 < 2; ++k2) _Pragma("unroll") for (int ti = 0; ti < 2; ++ti) _Pragma("unroll") for (int ni = 0; ni < 2; ++ni) \
        acc[ti][ni] = __builtin_amdgcn_mfma_f32_32x32x16_bf16(wf[k2][ni], xf[k2][ti], acc[ti][ni], 0, 0, 0); } while (0)
#define G_COMPUTE(st) do { const LAS char* cur = lds + (st) * C::STAGE; const int wa0 = (int)(uintptr_t)(cur + wr[0]), wa1 = (int)(uintptr_t)(cur + wr[1]); \
    G_HALF(cur, wa0, wa1, 0); G_HALF(cur, wa0, wa1, 1); } while (0)
  static_assert(C::NXP + C::NWP == 6, "vmcnt(6) below assumes 6 DMA pieces per wave per k-tile");
  G_DMA(0, 0); G_DMA(1, 1);
  int st = 0;
  f32x4 bga, bgb; int bgi = -1, bgy1 = 0, bgy2 = 0;
  for (int kt = 0; kt < nk; ++kt) {
    if (kt + 1 < nk) {
      const int young = BG ? (bgy1 + bgy2) : 0;
      if (young == 0) asm volatile("s_waitcnt vmcnt(6)" ::: "memory"); else if (young == 1) asm volatile("s_waitcnt vmcnt(8)" ::: "memory"); else asm volatile("s_waitcnt vmcnt(10)" ::: "memory");
    } else asm volatile("s_waitcnt vmcnt(0)" ::: "memory");
    asm volatile("s_waitcnt lgkmcnt(0)" ::: "memory"); __builtin_amdgcn_s_barrier();
    const int s2 = st == 0 ? 2 : st - 1;
    if (kt + 2 < nk) G_DMA(kt + 2, s2);
    if (BG) {
      bgy2 = bgy1; bgy1 = 0;
      if (bgi >= 0) { BG_RETIRE(bgi, bga, bgb); bgi = -1; }
      if (bgdone < bgn) { bgi = bgdone++; BG_ISSUE(bgi, bga, bgb); bgy1 = 1; }
    }
    G_COMPUTE(st);
    st = st == 2 ? 0 : st + 1;
  }
  if (BG) { if (bgi >= 0) BG_RETIRE(bgi, bga, bgb); }
  asm volatile("s_waitcnt lgkmcnt(0)" ::: "memory"); __builtin_amdgcn_s_barrier();
#undef G_DMA
#undef G_DMA1
#undef G_COMPUTE
#undef G_HALF
}

__device__ __forceinline__ unsigned pack4_fp8(const f32x16& a, int g) {
  int w = __builtin_amdgcn_cvt_pk_fp8_f32(a[4 * g], a[4 * g + 1], 0, false);
  w = __builtin_amdgcn_cvt_pk_fp8_f32(a[4 * g + 2], a[4 * g + 3], w, true);
  return (unsigned)w;
}
__device__ __forceinline__ u32x2 pack4(const f32x16& a, int g) { return (u32x2){cvtpk(a[4 * g], a[4 * g + 1]), cvtpk(a[4 * g + 2], a[4 * g + 3])}; }

__device__ __forceinline__ void phase_a1(const Params& p, int layer, LAS char* lds, int bid, int nblk) {
  const bf16_t* H = (const bf16_t*)(p.ws + OFF_H);
  const bf16_t* W = (const bf16_t*)(p.ws + OFF_WIN) + (size_t)layer * D * INW;
  bf16_t* Q = (bf16_t*)(p.ws + OFF_Q); bf16_t* Kb = (bf16_t*)(p.ws + OFF_K); bf16_t* Vb = (bf16_t*)(p.ws + OFF_V);
  float* U = (float*)(p.ws + OFF_U); bf16_t* AG = (bf16_t*)(p.ws + OFF_AG);
  unsigned char* Q8 = (unsigned char*)(p.ws + OFF_Q8); unsigned char* K8 = (unsigned char*)(p.ws + OFF_K8); unsigned char* VT8 = (unsigned char*)(p.ws + OFF_VT8);
  const float* rt = (const float*)(p.ws + OFF_ROPE);
  const int lane = TIDX & 63, wid = TIDX >> 6, r32 = lane & 31, hi = lane >> 5, wm = wid >> 1, wn = wid & 1;
  const size_t wo = (size_t)layer * NE * D * DE;
  const int bgn = (3 * (1 << 21) + nblk * 512 - 1) / (nblk * 512);
  const long bgc0 = (long)bid * bgn * 512 + (TIDX);
  const float* bs0 = p.w_e_gate + wo; const float* bs1 = p.w_e_up + wo; const float* bs2 = p.w_e_down + wo;
  bf16_t* bd0 = (bf16_t*)(p.ws + OFF_WG) + wo; bf16_t* bd1 = (bf16_t*)(p.ws + OFF_WU) + wo; bf16_t* bd2 = (bf16_t*)(p.ws + OFF_WD) + wo;
  int bgdone = 0;
  const int nlat = 64 * 12, nctx = layer == 0 ? 12 : 2, nunits = nlat + nctx;
  const bool xmap = (nblk & 7) == 0;
  const int xcd = bid & 7, lb = bid >> 3, nlb = nblk >> 3, nl = lb < 96 ? (96 - lb + nlb - 1) / nlb : 0;
  for (int it = 0;; ++it) {
    int rtile, ct;
    if (xmap) {
      if (it < nl) { const int v = lb + it * nlb; rtile = 1 + xcd + 8 * (v / 12); ct = v % 12; }
      else { const int e2 = bid + (it - nl) * nblk; if (e2 >= nctx) break; rtile = 0; ct = layer == 0 ? e2 : 4 + e2; }
    } else {
      const int u = bid + it * nblk; if (u >= nunits) break;
      if (u < nlat) { rtile = 1 + u / 12; ct = u % 12; } else { rtile = 0; ct = layer == 0 ? (u - nlat) : (4 + u - nlat); }
    }
    const int m0 = rtile * 256, n0 = ct * 128;
    f32x16 acc[2][2];
#pragma unroll
    for (int a = 0; a < 2; ++a)
#pragma unroll
      for (int b = 0; b < 2; ++b) acc[a][b] = (f32x16){};
    gemm_mainloop<256, 128, 0, true>(lds, acc, [&](int row) { return H + (size_t)(m0 + row) * D; }, [&](int) { return W + n0; }, INW, D, bgdone, bgn, bgc0, bs0, bs1, bs2, bd0, bd1, bd2);
#pragma unroll
    for (int ti = 0; ti < 2; ++ti) {
      const int tok = m0 + wm * 64 + ti * 32 + r32;
      if (ct < 5) {
        float ss = 0.f;
#pragma unroll
        for (int ni = 0; ni < 2; ++ni)
#pragma unroll
          for (int r = 0; r < 16; ++r) ss += acc[ti][ni][r] * acc[ti][ni][r];
        ss = sum32(ss);
        const float rs = rsqrtf(ss * (1.f / 64.f) + EPS);
        const float* gain = (ct < 4 ? p.q_gain : p.k_gain) + layer * 64;
        const float osc = ct < 4 ? 0.125f * 1.4426950408889634f : 1.f;
        const bool lat = rtile > 0;
        const int t = tok - NCTX;
#pragma unroll
        for (int ni = 0; ni < 2; ++ni) {
          f32x16 v;
#pragma unroll
          for (int r = 0; r < 16; ++r) v[r] = acc[ti][ni][r] * rs * gain[ni * 32 + crow(r, hi)];
          if (lat) {
            const int pos = ni == 0 ? (t >> 6) : (t & 63);
#pragma unroll
            for (int r = 0; r < 8; ++r) {
              const int f = crow(r, hi);
              const float cs = rt[(pos * 16 + f) * 2], sn = rt[(pos * 16 + f) * 2 + 1];
              const float t1 = v[r], t2 = v[r + 8];
              v[r] = t1 * cs - t2 * sn; v[r + 8] = t2 * cs + t1 * sn;
            }
          }
#pragma unroll
          for (int r = 0; r < 16; ++r) v[r] *= osc;
          bf16_t* dst = ct < 4 ? Q + (size_t)tok * 512 + (ct * 2 + wn) * 64 + ni * 32 : Kb + (size_t)tok * 128 + wn * 64 + ni * 32;
          unsigned char* dst8 = ct < 4 ? Q8 + (size_t)tok * 512 + (ct * 2 + wn) * 64 + ni * 32 : K8 + (size_t)tok * 128 + wn * 64 + ni * 32;
#pragma unroll
          for (int g = 0; g < 4; ++g) { *(u32x2*)(dst + 8 * g + 4 * hi) = pack4(v, g); *(unsigned*)(dst8 + 8 * g + 4 * hi) = pack4_fp8(v, g); }
        }
      } else if (ct == 5) {
#pragma unroll
        for (int ni = 0; ni < 2; ++ni) {
#pragma unroll
          for (int g = 0; g < 4; ++g) *(u32x2*)(Vb + (size_t)tok * 128 + wn * 64 + ni * 32 + 8 * g + 4 * hi) = pack4(acc[ti][ni], g);
          float vmx = 0.f;
#pragma unroll
          for (int r = 0; r < 16; ++r) {
            const float vv = acc[ti][ni][r]; vmx = fmaxf(vmx, fabsf(vv));
            VT8[(size_t)(wn * 64 + ni * 32 + crow(r, hi)) * TT + tok] = (unsigned char)(__builtin_amdgcn_cvt_pk_fp8_f32(vv, vv, 0, false) & 0xff);
          }
          if (!(vmx <= 400.f)) atomicOr((int*)(p.ws + OFF_FLAG) + 1, 1);
        }
      } else if (ct < 8) {
#pragma unroll
        for (int ni = 0; ni < 2; ++ni)
#pragma unroll
          for (int g = 0; g < 4; ++g)
            *(f32x4*)(U + (size_t)tok * 256 + (ct - 6) * 128 + wn * 64 + ni * 32 + 8 * g + 4 * hi) =
                (f32x4){acc[ti][ni][4 * g], acc[ti][ni][4 * g + 1], acc[ti][ni][4 * g + 2], acc[ti][ni][4 * g + 3]};
      } else {
#pragma unroll
        for (int ni = 0; ni < 2; ++ni)
#pragma unroll
          for (int g = 0; g < 4; ++g) *(u32x2*)(AG + (size_t)tok * 512 + (ct - 8) * 128 + wn * 64 + ni * 32 + 8 * g + 4 * hi) = pack4(acc[ti][ni], g);
      }
    }
  }
  while (bgdone < bgn) { f32x4 a, b2; const int i = bgdone++; BG_ISSUE(i, a, b2); BG_RETIRE(i, a, b2); }
}

__device__ __forceinline__ void phase_c1(const Params& p, int layer, LAS char* lds, int bid, int nblk) {
  const bf16_t* A = (const bf16_t*)(p.ws + OFF_MIX);
  const bf16_t* W = (const bf16_t*)(p.ws + OFF_WOUT) + (size_t)layer * D * D;
  bf16_t* Y = (bf16_t*)(p.ws + OFF_Y);
  const int lane = TIDX & 63, wid = TIDX >> 6, r32 = lane & 31, hi = lane >> 5, wm = wid >> 1, wn = wid & 1;
  const int nctx = layer == 0 ? 8 : 0;
  const bool xmap = (nblk & 7) == 0;
  const int xcd = bid & 7, lb = bid >> 3, nlb = nblk >> 3, nl = lb < 64 ? (64 - lb + nlb - 1) / nlb : 0;
  for (int it = 0;; ++it) {
    int rtile, ct;
    if (xmap) {
      if (it < nl) { const int v = lb + it * nlb; rtile = 1 + xcd + 8 * (v >> 3); ct = v & 7; }
      else { const int e2 = bid + (it - nl) * nblk; if (e2 >= nctx) break; rtile = 0; ct = e2; }
    } else {
      const int u = bid + it * nblk; if (u >= 64 * 8 + nctx) break;
      if (u < 512) { rtile = 1 + (u >> 3); ct = u & 7; } else { rtile = 0; ct = u - 512; }
    }
    const int m0 = rtile * 256, n0 = ct * 128;
    f32x16 acc[2][2];
#pragma unroll
    for (int a = 0; a < 2; ++a)
#pragma unroll
      for (int b = 0; b < 2; ++b) acc[a][b] = (f32x16){};
    { int nd = 0; gemm_mainloop<256, 128, 0>(lds, acc, [&](int row) { return A + (size_t)(m0 + row) * D; }, [&](int) { return W + n0; }, D, D, nd); }
#pragma unroll
    for (int ti = 0; ti < 2; ++ti) {
      const int tok = m0 + wm * 64 + ti * 32 + r32;
#pragma unroll
      for (int ni = 0; ni < 2; ++ni)
#pragma unroll
        for (int g = 0; g < 4; ++g) *(u32x2*)(Y + (size_t)tok * D + n0 + wn * 64 + ni * 32 + 8 * g + 4 * hi) = pack4(acc[ti][ni], g);
    }
  }
}

__device__ __forceinline__ void moe_prefix(const int* cnt, LAS int* pre, int xcd) {
  if (TIDX == 0) {
    int o = 0; for (int e = 0; e < NE; ++e) { pre[e] = o; o += (cnt[e * CNT_STRIDE] + 127) >> 7; } pre[NE] = o;
    int l = 0; for (int j = 0; j < 4; ++j) { pre[40 + j] = l; l += (cnt[(xcd + 8 * j) * CNT_STRIDE] + 127) >> 7; } pre[44] = l;
  }
  __syncthreads();
}
__device__ __forceinline__ bool moe_unit(const LAS int* pre, int bid, int nblk, int it, int& e, int& rt, int& ct, int& g) {
  if ((nblk & 7) == 0) {
    const int xcd = bid & 7, v = (bid >> 3) + it * (nblk >> 3), gl = v >> 2;
    if (gl >= pre[44]) return false;
    int j = 0; if (gl >= pre[41]) j = 1; if (gl >= pre[42]) j = 2; if (gl >= pre[43]) j = 3;
    e = xcd + 8 * j; rt = gl - pre[40 + j]; ct = v & 3; g = pre[e] + rt; return true;
  } else {
    const int u = bid + it * nblk; g = u >> 2; if (g >= pre[NE]) return false;
    int ee = 0; for (int i = 1; i < NE; ++i) ee += (pre[i] <= g) ? 1 : 0;
    e = ee; rt = g - pre[ee]; ct = u & 3; return true;
  }
}

__device__ __forceinline__ void phase_d1(const Params& p, int layer, LAS char* lds, int bid, int nblk) {
  const int* cnt = (const int*)(p.ws + OFF_CNT) + layer * NE * CNT_STRIDE;
  const bf16_t* H2 = (const bf16_t*)(p.ws + OFF_MIX);
  bf16_t* HM = (bf16_t*)(p.ws + OFF_HMID);
  LAS int* pre = (LAS int*)(lds + GEMM_LDS);
  moe_prefix(cnt, pre, bid & 7);
  const int lane = TIDX & 63, wid = TIDX >> 6, r32 = lane & 31, hi = lane >> 5, wm = wid >> 2, wn = wid & 3;
  for (int it = 0;; ++it) {
    int e, rt, ct, g; if (!moe_unit(pre, bid, nblk, it, e, rt, ct, g)) break;
    const int n = cnt[e * CNT_STRIDE];
    const int* list = (const int*)(p.ws + OFF_LIST) + (size_t)e * CAPL + rt * 128;
    const bf16_t* Wg = (const bf16_t*)(p.ws + OFF_WG) + ((size_t)layer * NE + e) * D * DE + ct * 128;
    const bf16_t* Wu = (const bf16_t*)(p.ws + OFF_WU) + ((size_t)layer * NE + e) * D * DE + ct * 128;
    const int nvalid = n - rt * 128;
    f32x16 acc[2][2];
#pragma unroll
    for (int a = 0; a < 2; ++a)
#pragma unroll
      for (int b = 0; b < 2; ++b) acc[a][b] = (f32x16){};
    int nd = 0;
    gemm_mainloop<128, 256, 2>(lds, acc, [&](int row) { const int tok = row < nvalid ? (list[row] >> 1) : 0; return H2 + (size_t)tok * D; },
                               [&](int s) { return s == 0 ? Wg : Wu; }, DE, D, nd);
    const size_t hrow0 = (size_t)(pre[e] + rt) * 128;
#pragma unroll
    for (int ti = 0; ti < 2; ++ti) {
      const size_t row = hrow0 + wm * 64 + ti * 32 + r32;
      f32x16 a;
#pragma unroll
      for (int r = 0; r < 16; ++r) { const float gv = acc[ti][0][r]; a[r] = gv / (1.f + __expf(-gv)) * acc[ti][1][r]; }
#pragma unroll
      for (int gq = 0; gq < 4; ++gq) *(u32x2*)(HM + row * DE + ct * 128 + wn * 32 + 8 * gq + 4 * hi) = pack4(a, gq);
    }
  }
}

__device__ __forceinline__ void phase_d2(const Params& p, int layer, LAS char* lds, int bid, int nblk) {
  const int* cnt = (const int*)(p.ws + OFF_CNT) + layer * NE * CNT_STRIDE;
  const bf16_t* HM = (const bf16_t*)(p.ws + OFF_HMID);
  const float* GATE = (const float*)(p.ws + OFF_GATE);
  bf16_t* OM = (bf16_t*)(p.ws + OFF_OMOE);
  LAS int* pre = (LAS int*)(lds + GEMM_LDS);
  moe_prefix(cnt, pre, bid & 7);
  const int lane = TIDX & 63, wid = TIDX >> 6, r32 = lane & 31, hi = lane >> 5, wm = wid >> 2, wn = wid & 3;
  for (int it = 0;; ++it) {
    int e, rt, ct, g; if (!moe_unit(pre, bid, nblk, it, e, rt, ct, g)) break;
    const int n = cnt[e * CNT_STRIDE];
    const int* list = (const int*)(p.ws + OFF_LIST) + (size_t)e * CAPL + rt * 128;
    const bf16_t* Wd = (const bf16_t*)(p.ws + OFF_WD) + ((size_t)layer * NE + e) * DE * D + ct * 256;
    const int nvalid = n - rt * 128;
    const bf16_t* A = HM + (size_t)g * 128 * DE;
    f32x16 acc[2][2];
#pragma unroll
    for (int a = 0; a < 2; ++a)
#pragma unroll
      for (int b = 0; b < 2; ++b) acc[a][b] = (f32x16){};
    { int nd = 0; gemm_mainloop<128, 256, 1>(lds, acc, [&](int row) { return A + (size_t)row * DE; }, [&](int s) { return Wd + s * 128; }, D, DE, nd); }
#pragma unroll
    for (int ti = 0; ti < 2; ++ti) {
      const int row = wm * 64 + ti * 32 + r32;
      if (row < nvalid) {
        const int ts = list[row];
        const float gt = GATE[ts];
#pragma unroll
        for (int ni = 0; ni < 2; ++ni) {
          f32x16 a;
#pragma unroll
          for (int r = 0; r < 16; ++r) a[r] = acc[ti][ni][r] * gt;
#pragma unroll
          for (int gq = 0; gq < 4; ++gq) *(u32x2*)(OM + (size_t)ts * D + ct * 256 + wn * 64 + ni * 32 + 8 * gq + 4 * hi) = pack4(a, gq);
        }
      }
    }
  }
}

constexpr int ATT_SLOT = 16384, ATT_LDS = 4 * ATT_SLOT;
__device__ __forceinline__ int vst64(int k, int c) { const int kk = (k & ~0xC) | ((k & 4) << 1) | ((k & 8) >> 1); return ((kk >> 3) * 2 + (c >> 5)) * 512 + ((kk & 7) * 32 + (c & 31)) * 2; }
__device__ __forceinline__ bf16x8 tr_frag64(const LAS char* p) {
  s16x4 a = __builtin_amdgcn_ds_read_tr16_b64_v4i16((LAS s16x4*)p);
  s16x4 b = __builtin_amdgcn_ds_read_tr16_b64_v4i16((LAS s16x4*)(p + 1024));
  return (bf16x8){a[0], a[1], a[2], a[3], b[0], b[1], b[2], b[3]};
}
__device__ __forceinline__ bf16x8 pk4(const f32x16& P, int B) {
  unsigned a0 = cvtpk(P[B + 0], P[B + 1]), a1 = cvtpk(P[B + 2], P[B + 3]), b0 = cvtpk(P[B + 4], P[B + 5]), b1 = cvtpk(P[B + 6], P[B + 7]);
  auto r0 = __builtin_amdgcn_permlane32_swap(a0, b0, false, false); auto r1 = __builtin_amdgcn_permlane32_swap(a1, b1, false, false);
  u32x4 w = {r0[0], r1[0], r0[1], r1[1]};
  return __builtin_bit_cast(bf16x8, w);
}
struct AttnCtx { int krd0, krd1, ksw, hi, vrd; };
#define SBAR() __builtin_amdgcn_sched_barrier(0)
__device__ __forceinline__ void att_kload(const LAS char* slot, const AttnCtx& c, bf16x8 (&kf)[8]) {
#pragma unroll
  for (int d0 = 0; d0 < 4; ++d0) {
    kf[2 * d0] = *(const LAS bf16x8*)(slot + c.krd0 + (((2 * d0 + c.hi) ^ c.ksw) << 4));
    kf[2 * d0 + 1] = *(const LAS bf16x8*)(slot + c.krd1 + (((2 * d0 + c.hi) ^ c.ksw) << 4));
  }
}
__device__ __forceinline__ void att_qk(const bf16x8 (&kf)[8], const bf16x8 (&qr)[4], f32x16& s0, f32x16& s1) {
  s0 = (f32x16){}; s1 = (f32x16){};
#pragma unroll
  for (int d0 = 0; d0 < 4; ++d0) {
    s0 = __builtin_amdgcn_mfma_f32_32x32x16_bf16(kf[2 * d0], qr[d0], s0, 0, 0, 0);
    s1 = __builtin_amdgcn_mfma_f32_32x32x16_bf16(kf[2 * d0 + 1], qr[d0], s1, 0, 0, 0);
  }
}
__device__ __forceinline__ void att_exp(f32x16& s, float& l) {
#pragma unroll
  for (int r = 0; r < 16; ++r) { s[r] = __builtin_amdgcn_exp2f(s[r]); l += s[r]; }
  asm volatile("" : "+v"(l));
}
template <int KS0>
__device__ __forceinline__ void att_vload(const LAS char* slot, const AttnCtx& c, bf16x8 (&vf)[4]) {
#pragma unroll
  for (int i = 0; i < 2; ++i) { vf[2 * i] = tr_frag64(slot + c.vrd + (KS0 + i) * 2048); vf[2 * i + 1] = tr_frag64(slot + c.vrd + 512 + (KS0 + i) * 2048); }
}
__device__ __forceinline__ void att_pv2(const bf16x8& pa, const bf16x8& pb, const bf16x8 (&vf)[4], f32x16& o0, f32x16& o1) {
  o0 = __builtin_amdgcn_mfma_f32_32x32x16_bf16(pa, vf[0], o0, 0, 0, 0);
  o1 = __builtin_amdgcn_mfma_f32_32x32x16_bf16(pa, vf[1], o1, 0, 0, 0);
  o0 = __builtin_amdgcn_mfma_f32_32x32x16_bf16(pb, vf[2], o0, 0, 0, 0);
  o1 = __builtin_amdgcn_mfma_f32_32x32x16_bf16(pb, vf[3], o1, 0, 0, 0);
}
__device__ __forceinline__ void attn_unit(const Params& p, LAS char* lds, int row0, int hp, int nkeys) {
  const bf16_t* Q = (const bf16_t*)(p.ws + OFF_Q); const bf16_t* Kb = (const bf16_t*)(p.ws + OFF_K); const bf16_t* Vb = (const bf16_t*)(p.ws + OFF_V);
  bf16_t* MIX = (bf16_t*)(p.ws + OFF_MIX);
  const int tid = TIDX, wid = tid >> 6, lane = tid & 63, r32 = lane & 31, hi = lane >> 5, kvh = hp >> 1;
  bf16x8 qa[4], qb[4];
  { const bf16_t* Qg = Q + (size_t)(row0 + wid * 32 + r32) * 512 + hp * 128 + hi * 8;
#pragma unroll
    for (int d0 = 0; d0 < 4; ++d0) { qa[d0] = *(const bf16x8*)(Qg + d0 * 16); qb[d0] = *(const bf16x8*)(Qg + 64 + d0 * 16); } }
  const bf16_t* Kg = Kb + (size_t)(tid >> 3) * 128 + kvh * 64 + (tid & 7) * 8;
  const bf16_t* Vg = Vb + (size_t)(tid >> 3) * 128 + kvh * 64 + (tid & 7) * 8;
  const int kst = xoff(tid >> 3, tid & 7), vstw = 8192 + vst64(tid >> 3, (tid & 7) * 8);
  AttnCtx c; c.krd0 = r32 * 128; c.krd1 = (32 + r32) * 128; c.ksw = (r32 >> 1) & 7; c.hi = hi; c.vrd = 8192 + v_rd_base(lane);
  const int NT = nkeys >> 6;
  f32x16 oa0 = {}, oa1 = {}, ob0 = {}, ob1 = {}; float la = 0.f, lb = 0.f;
  u32x4 ks, vs;
  {
    const u32x4 k0 = *(const u32x4*)Kg, k1 = *(const u32x4*)(Kg + 64 * 128), v0 = *(const u32x4*)Vg, v1 = *(const u32x4*)(Vg + 64 * 128);
    *(LAS u32x4*)(lds + kst) = k0; *(LAS u32x4*)(lds + ATT_SLOT + kst) = k1;
    *(LAS u32x4*)(lds + vstw) = v0; *(LAS u32x4*)(lds + ATT_SLOT + vstw) = v1;
    ks = *(const u32x4*)(Kg + 2 * 64 * 128); vs = *(const u32x4*)(Vg + 2 * 64 * 128);
  }
  __syncthreads();
  for (int j = 0; j < NT; ++j) {
    const LAS char* sl = lds + (j & 3) * ATT_SLOT;
    bf16x8 kf[8], vfa[4], vfb[4];
    f32x16 sa0, sa1, sb0, sb1;
    att_kload(sl, c, kf);
    SBAR();
    att_qk(kf, qa, sa0, sa1);
    SBAR();
    att_qk(kf, qb, sb0, sb1);
    att_exp(sa0, la); att_exp(sa1, la);
    SBAR();
    const bf16x8 pa0 = pk4(sa0, 0), pa1 = pk4(sa0, 8), pa2 = pk4(sa1, 0), pa3 = pk4(sa1, 8);
    att_vload<0>(sl, c, vfa);
    SBAR();
    att_pv2(pa0, pa1, vfa, oa0, oa1);
    att_exp(sb0, lb);
    att_vload<2>(sl, c, vfb);
    SBAR();
    att_pv2(pa2, pa3, vfb, oa0, oa1);
    att_exp(sb1, lb);
    const bf16x8 pb0 = pk4(sb0, 0), pb1 = pk4(sb0, 8), pb2 = pk4(sb1, 0), pb3 = pk4(sb1, 8);
    att_vload<0>(sl, c, vfa);
    SBAR();
    att_pv2(pb0, pb1, vfa, ob0, ob1);
    att_vload<2>(sl, c, vfb);
    SBAR();
    att_pv2(pb2, pb3, vfb, ob0, ob1);
    { LAS char* w = lds + ((j + 2) & 3) * ATT_SLOT;
      if (j + 2 < NT) { *(LAS u32x4*)(w + kst) = ks; *(LAS u32x4*)(w + vstw) = vs; }
      if (j + 3 < NT) { ks = *(const u32x4*)(Kg + (size_t)(j + 3) * 64 * 128); vs = *(const u32x4*)(Vg + (size_t)(j + 3) * 64 * 128); } }
    __syncthreads();
  }
  la = sum32(la); lb = sum32(lb);
  LAS float* li = (LAS float*)(lds + wid * 256);
  if (hi == 0) { li[r32] = la; li[32 + r32] = lb; }
  __syncthreads();
  bf16_t* Og = MIX + (size_t)(row0 + wid * 32) * D + hp * 128 + r32;
#pragma unroll
  for (int r = 0; r < 16; ++r) {
    const int orow = crow(r, hi);
    const float ra = __builtin_amdgcn_rcpf(li[orow]), rb = __builtin_amdgcn_rcpf(li[32 + orow]);
    Og[(size_t)orow * D] = f2bf(oa0[r] * ra); Og[(size_t)orow * D + 32] = f2bf(oa1[r] * ra);
    Og[(size_t)orow * D + 64] = f2bf(ob0[r] * rb); Og[(size_t)orow * D + 96] = f2bf(ob1[r] * rb);
  }
  __syncthreads();
}
typedef int i32x8 __attribute__((ext_vector_type(8)));
constexpr int A8_SLOT = 8192, A8_LDS = 4 * A8_SLOT;
__device__ __forceinline__ int off8(int row, int chunk) { return row * 64 + ((chunk ^ ((row >> 2) & 3)) << 4); }
__device__ __forceinline__ i32x8 ld_frag8(const LAS char* tile, int row, int h) {
  const int sw = (row >> 2) & 3;
  const u32x4 lo = *(const LAS u32x4*)(tile + row * 64 + (((2 * h) ^ sw) << 4)), hi = *(const LAS u32x4*)(tile + row * 64 + (((2 * h + 1) ^ sw) << 4));
  return (i32x8){(int)lo[0], (int)lo[1], (int)lo[2], (int)lo[3], (int)hi[0], (int)hi[1], (int)hi[2], (int)hi[3]};
}
#define MX_FP8_FP8(a, b, c) __builtin_amdgcn_mfma_scale_f32_32x32x64_f8f6f4(a, b, c, 0, 0, 0, 0x7f7f7f7f, 0, 0x7f7f7f7f)
#define MX_BF8_FP8(a, b, c) __builtin_amdgcn_mfma_scale_f32_32x32x64_f8f6f4(a, b, c, 1, 0, 0, 0x7f7f7f7f, 0, 0x7f7f7f7f)
typedef _Float16 f16x2 __attribute__((ext_vector_type(2)));
__device__ __forceinline__ unsigned att8_code4(float s0, float s1, float s2, float s3) {
  const f16x2 four = {(_Float16)4.f, (_Float16)4.f}, bias = {(_Float16)1084.f, (_Float16)1084.f};
  const f16x2 x = __builtin_bit_cast(f16x2, __builtin_amdgcn_cvt_pkrtz(s0, s1)) * four + bias, y = __builtin_bit_cast(f16x2, __builtin_amdgcn_cvt_pkrtz(s2, s3)) * four + bias;
  return __builtin_amdgcn_perm(__builtin_bit_cast(unsigned, y), __builtin_bit_cast(unsigned, x), 0x06040200u);
}
__device__ __forceinline__ i32x8 att8_pack(const f32x16& p0, const f32x16& p1) {
  i32x8 w;
#pragma unroll
  for (int i = 0; i < 4; ++i) {
    const unsigned d = att8_code4(p0[4 * i], p0[4 * i + 1], p0[4 * i + 2], p0[4 * i + 3]), e = att8_code4(p1[4 * i], p1[4 * i + 1], p1[4 * i + 2], p1[4 * i + 3]);
    auto r = __builtin_amdgcn_permlane32_swap(d, e, false, false);
    w[2 * i] = (int)r[0]; w[2 * i + 1] = (int)r[1];
  }
  return w;
}
__device__ __forceinline__ void attn_unit8(const Params& p, LAS char* lds, int row0, int hp, int nkeys, bf16_t* MIXP = nullptr) {
  const unsigned char* Q8 = (const unsigned char*)(p.ws + OFF_Q8); const unsigned char* K8 = (const unsigned char*)(p.ws + OFF_K8); const unsigned char* VT8 = (const unsigned char*)(p.ws + OFF_VT8);
  bf16_t* MIX = MIXP ? MIXP : (bf16_t*)(p.ws + OFF_MIX);
  const int tid = TIDX, wid = tid >> 6, lane = tid & 63, r32 = lane & 31, hi = lane >> 5, kvh = hp >> 1;
  i32x8 qa, qb;
  { const unsigned char* Qg = Q8 + (size_t)(row0 + wid * 32 + r32) * 512 + hp * 128 + hi * 32;
    const u32x4 a0 = *(const u32x4*)Qg, a1 = *(const u32x4*)(Qg + 16), b0 = *(const u32x4*)(Qg + 64), b1 = *(const u32x4*)(Qg + 80);
    qa = (i32x8){(int)a0[0], (int)a0[1], (int)a0[2], (int)a0[3], (int)a1[0], (int)a1[1], (int)a1[2], (int)a1[3]};
    qb = (i32x8){(int)b0[0], (int)b0[1], (int)b0[2], (int)b0[3], (int)b1[0], (int)b1[1], (int)b1[2], (int)b1[3]}; }
  const int su = tid & 255, srow = su >> 2, sch = su & 3;
  const unsigned char* Sg = tid < 256 ? K8 + (size_t)srow * 128 + kvh * 64 + sch * 16 : VT8 + (size_t)(kvh * 64 + srow) * TT + sch * 16;
  const size_t sstep = tid < 256 ? (size_t)64 * 128 : (size_t)64;
  const int sst = (tid < 256 ? 0 : 4096) + off8(srow, sch);
  const int NT = nkeys >> 6;
  f32x16 oa0 = {}, oa1 = {}, ob0 = {}, ob1 = {}, ola = {}, olb = {};
  const i32x8 ones = {0x38383838, 0x38383838, 0x38383838, 0x38383838, 0x38383838, 0x38383838, 0x38383838, 0x38383838};
  u32x4 sv;
  { const u32x4 t0 = *(const u32x4*)Sg, t1 = *(const u32x4*)(Sg + sstep);
    *(LAS u32x4*)(lds + sst) = t0; *(LAS u32x4*)(lds + A8_SLOT + sst) = t1;
    sv = *(const u32x4*)(Sg + 2 * sstep); }
  __syncthreads();
  for (int j = 0; j < NT; ++j) {
    const LAS char* sl = lds + (j & 3) * A8_SLOT;
    f32x16 sa0 = {}, sa1 = {}, sb0 = {}, sb1 = {};
    const i32x8 kf0 = ld_frag8(sl, r32, hi), kf1 = ld_frag8(sl, 32 + r32, hi);
    SBAR();
    sa0 = MX_FP8_FP8(kf0, qa, sa0); sa1 = MX_FP8_FP8(kf1, qa, sa1);
    SBAR();
    sb0 = MX_FP8_FP8(kf0, qb, sb0); sb1 = MX_FP8_FP8(kf1, qb, sb1);
    SBAR();
    const i32x8 pa = att8_pack(sa0, sa1);
    const i32x8 vf0 = ld_frag8(sl + 4096, r32, hi), vf1 = ld_frag8(sl + 4096, 32 + r32, hi);
    SBAR();
    oa0 = MX_BF8_FP8(pa, vf0, oa0); oa1 = MX_BF8_FP8(pa, vf1, oa1); ola = MX_BF8_FP8(pa, ones, ola);
    const i32x8 pb = att8_pack(sb0, sb1);
    SBAR();
    ob0 = MX_BF8_FP8(pb, vf0, ob0); ob1 = MX_BF8_FP8(pb, vf1, ob1); olb = MX_BF8_FP8(pb, ones, olb);
    { LAS char* w = lds + ((j + 2) & 3) * A8_SLOT;
      if (j + 2 < NT) *(LAS u32x4*)(w + sst) = sv;
      if (j + 3 < NT) sv = *(const u32x4*)(Sg + (size_t)(j + 3) * sstep); }
    __syncthreads();
  }
  bf16_t* Og = MIX + (size_t)(row0 + wid * 32) * D + hp * 128 + r32;
#pragma unroll
  for (int r = 0; r < 16; ++r) {
    const int orow = crow(r, hi);
    const float ra = __builtin_amdgcn_rcpf(ola[r]), rb = __builtin_amdgcn_rcpf(olb[r]);
    Og[(size_t)orow * D] = f2bf(oa0[r] * ra); Og[(size_t)orow * D + 32] = f2bf(oa1[r] * ra);
    Og[(size_t)orow * D + 64] = f2bf(ob0[r] * rb); Og[(size_t)orow * D + 96] = f2bf(ob1[r] * rb);
  }
  __syncthreads();
}
__device__ __forceinline__ void attn_fallback(const Params& p, int layer, int bid, int nblk) {
  const bf16_t* Q = (const bf16_t*)(p.ws + OFF_Q); const bf16_t* Kb = (const bf16_t*)(p.ws + OFF_K); const bf16_t* Vb = (const bf16_t*)(p.ws + OFF_V);
  bf16_t* MIX = (bf16_t*)(p.ws + OFF_MIX);
  const int lane = TIDX & 63, nwv = nblk * 8;
  const int rg0 = layer == 0 ? 0 : NCTX / 64;
  for (int wv = bid * 8 + (TIDX >> 6) + rg0 * 8; wv < (TT / 64) * 8; wv += nwv) {
    const int head = wv & 7, r = (wv >> 3) * 64 + lane, kvh = head >> 2;
    float q[64], o[64];
#pragma unroll
    for (int d = 0; d < 64; ++d) { q[d] = bf2f(Q[(size_t)r * 512 + head * 64 + d]); o[d] = 0.f; }
    float m = -1e30f, l = 0.f;
    const int nk = r >= NCTX ? TT : NCTX;
    for (int j = 0; j < nk; ++j) {
      const bf16_t* kr = Kb + (size_t)j * 128 + kvh * 64;
      const bf16_t* vr = Vb + (size_t)j * 128 + kvh * 64;
      float s = 0.f;
#pragma unroll
      for (int d = 0; d < 64; ++d) s += q[d] * bf2f(kr[d]);
      if (s > m) {
        const float a = __builtin_amdgcn_exp2f(m - s);
        l *= a;
#pragma unroll
        for (int d = 0; d < 64; ++d) o[d] *= a;
        m = s;
      }
      const float pe = __builtin_amdgcn_exp2f(s - m);
      l += pe;
#pragma unroll
      for (int d = 0; d < 64; ++d) o[d] += pe * bf2f(vr[d]);
    }
    const float il = 1.f / l;
#pragma unroll
    for (int d = 0; d < 64; ++d) MIX[(size_t)r * D + head * 64 + d] = f2bf(o[d] * il);
  }
}

constexpr int PC_U = 0;
constexpr int PC_Y = 49152;
constexpr int PC_LDS = PC_Y + 65536;
__device__ __forceinline__ void poolconv_unit(const Params& p, int layer, LAS char* lds, int tile) {
  const int tid = TIDX, wid = tid >> 6, lane = tid & 63, r32 = lane & 31, hi = lane >> 5;
  const int t0 = tile * 64, base = tile < 4 ? 0 : NCTX, n = tile < 4 ? NCTX : SEQ;
  const bf16_t* AG = (const bf16_t*)(p.ws + OFF_AG);
  const float* U = (const float*)(p.ws + OFF_U);
  bf16_t* MIX = (bf16_t*)(p.ws + OFF_MIX);
#pragma unroll
  for (int h = 0; h < 2; ++h) {
    u32x4 av[3], gv[3]; bool in[3];
#pragma unroll
    for (int q = 0; q < 3; ++q) {
      const int idx = tid + (h * 3 + q) * 512, rr = idx >> 5, ch = (idx & 31) * 8, t = t0 - 15 + rr;
      in[q] = idx < 94 * 32 && t >= base && t < base + n;
      const size_t off = (size_t)(in[q] ? t : t0) * 512 + ch;
      av[q] = *(const u32x4*)(AG + off); gv[q] = *(const u32x4*)(AG + off + 256);
    }
#pragma unroll
    for (int q = 0; q < 3; ++q) {
      const int idx = tid + (h * 3 + q) * 512, rr = idx >> 5, ch = (idx & 31) * 8;
      u32x4 out = {0u, 0u, 0u, 0u};
      if (in[q]) {
#pragma unroll
        for (int i = 0; i < 4; ++i) {
          const float a0 = __uint_as_float(av[q][i] << 16), a1 = __uint_as_float(av[q][i] & 0xffff0000u);
          const float g0 = __uint_as_float(gv[q][i] << 16), g1 = __uint_as_float(gv[q][i] & 0xffff0000u);
          out[i] = cvtpk(a0 / (1.f + __expf(-g0)), a1 / (1.f + __expf(-g1)));
        }
      }
      if (idx < 94 * 32) *(LAS u32x4*)(lds + PC_U + (rr * 256 + ch) * 2) = out;
    }
  }
  __syncthreads();
  {
    const int c = tid & 255, th = tid >> 8;
    float w[31];
#pragma unroll
    for (int j = 0; j < 31; ++j) w[j] = p.w_dw[(size_t)layer * 31 * 256 + j * 256 + c];
    const float b = p.b_dw[layer * 256 + c];
    float acc[32];
#pragma unroll
    for (int i = 0; i < 32; ++i) acc[i] = b;
    const LAS bf16_t* up = (const LAS bf16_t*)(lds + PC_U) + (th * 32) * 256 + c;
#pragma unroll
    for (int rr = 0; rr < 62; ++rr) {
      const float uv = bf2f(up[rr * 256]);
#pragma unroll
      for (int i = 0; i < 32; ++i) if (rr - i >= 0 && rr - i < 31) acc[i] += uv * w[rr - i];
    }
    LAS float* yp = (LAS float*)(lds + PC_Y) + (th * 32) * 256 + c;
#pragma unroll
    for (int i = 0; i < 32; ++i) yp[i * 256] = acc[i];
  }
  __syncthreads();
  {
    const f32x4 g4 = *(const f32x4*)(p.cv_ln_g + layer * 256 + lane * 4), b4 = *(const f32x4*)(p.cv_ln_b + layer * 256 + lane * 4);
#pragma unroll
    for (int i = 0; i < 8; ++i) {
      const int tok = wid * 8 + i;
      const f32x4 y = *(const LAS f32x4*)(lds + PC_Y + (tok * 256 + lane * 4) * 4);
      const float mu = wave_sum(y[0] + y[1] + y[2] + y[3]) * (1.f / 256.f);
      const float d0 = y[0] - mu, d1 = y[1] - mu, d2 = y[2] - mu, d3 = y[3] - mu;
      const float rs = rsqrtf(wave_sum(d0 * d0 + d1 * d1 + d2 * d2 + d3 * d3) * (1.f / 256.f) + EPS);
      const float z0 = silu(d0 * rs * g4[0] + b4[0]), z1 = silu(d1 * rs * g4[1] + b4[1]), z2 = silu(d2 * rs * g4[2] + b4[2]), z3 = silu(d3 * rs * g4[3] + b4[3]);
      const int chunk = lane >> 1, sw = (chunk & 16) | ((chunk ^ tok) & 15);
      *(LAS u32x2*)(lds + PC_U + tok * 512 + sw * 16 + (lane & 1) * 8) = (u32x2){cvtpk(z0, z1), cvtpk(z2, z3)};
    }
  }
  __syncthreads();
  {
    const int tb = wid >> 2, dg = wid & 3, trow = tb * 32 + r32, t = t0 + trow;
    const bf16_t* Wt = (const bf16_t*)(p.ws + OFF_WPWT) + ((size_t)layer * 256 + dg * 64 + r32) * 256 + hi * 8;
    f32x16 acc0 = {}, acc1 = {};
#pragma unroll 8
    for (int ks = 0; ks < 16; ++ks) {
      const int chunk = 2 * ks + hi, sw = (chunk & 16) | ((chunk ^ trow) & 15);
      const bf16x8 zf = *(const LAS bf16x8*)(lds + PC_U + trow * 512 + sw * 16);
      const bf16x8 w0 = *(const bf16x8*)(Wt + ks * 16), w1 = *(const bf16x8*)(Wt + 32 * 256 + ks * 16);
      acc0 = __builtin_amdgcn_mfma_f32_32x32x16_bf16(w0, zf, acc0, 0, 0, 0);
      acc1 = __builtin_amdgcn_mfma_f32_32x32x16_bf16(w1, zf, acc1, 0, 0, 0);
    }
    bf16_t* dst = MIX + (size_t)t * D + 768 + dg * 64;
#pragma unroll
    for (int g = 0; g < 4; ++g) { *(u32x2*)(dst + 8 * g + 4 * hi) = pack4(acc0, g); *(u32x2*)(dst + 32 + 8 * g + 4 * hi) = pack4(acc1, g); }
    const int w = 2 << dg, tl = t - base, lo = max(tl - w / 2, 0), hh = min(tl + w / 2, n);
    const float inv = 1.f / (float)(hh - lo);
    const bf16_t* Pt = (const bf16_t*)(p.ws + OFF_WPOOLT) + ((size_t)(layer * 4 + dg) * 64 + r32) * 64 + hi * 8;
    f32x16 pc0 = {}, pc1 = {};
#pragma unroll
    for (int ks = 0; ks < 4; ++ks) {
      const int c0 = dg * 64 + ks * 16 + hi * 8;
      f32x4 s0 = {0.f, 0.f, 0.f, 0.f}, s1 = {0.f, 0.f, 0.f, 0.f};
#pragma unroll
      for (int i = 0; i < 16; ++i) {
        const int rr = lo + i; const bool in = i < w && rr < hh;
        const float* ur = U + (size_t)(base + (in ? rr : lo)) * 256 + c0; const float wgt = in ? 1.f : 0.f;
        s0 += *(const f32x4*)ur * wgt; s1 += *(const f32x4*)(ur + 4) * wgt;
      }
      const float* uo = U + (size_t)t * 256 + c0;
      const f32x4 o0 = *(const f32x4*)uo, o1 = *(const f32x4*)(uo + 4);
      s0 = s0 * inv - o0; s1 = s1 * inv - o1;
      u32x4 pw = {cvtpk(s0[0], s0[1]), cvtpk(s0[2], s0[3]), cvtpk(s1[0], s1[1]), cvtpk(s1[2], s1[3])};
      const bf16x8 pf = __builtin_bit_cast(bf16x8, pw);
      const bf16x8 w0 = *(const bf16x8*)(Pt + ks * 16), w1 = *(const bf16x8*)(Pt + 32 * 64 + ks * 16);
      pc0 = __builtin_amdgcn_mfma_f32_32x32x16_bf16(w0, pf, pc0, 0, 0, 0);
      pc1 = __builtin_amdgcn_mfma_f32_32x32x16_bf16(w1, pf, pc1, 0, 0, 0);
    }
    const float* psc = p.pool_scale + layer * 256 + dg * 64;
#pragma unroll
    for (int r = 0; r < 16; ++r) { pc0[r] *= psc[crow(r, hi)]; pc1[r] *= psc[32 + crow(r, hi)]; }
    bf16_t* pd = MIX + (size_t)t * D + 512 + dg * 64;
#pragma unroll
    for (int g = 0; g < 4; ++g) { *(u32x2*)(pd + 8 * g + 4 * hi) = pack4(pc0, g); *(u32x2*)(pd + 32 + 8 * g + 4 * hi) = pack4(pc1, g); }
  }
  __syncthreads();
}

__device__ __forceinline__ void phase_b(const Params& p, int layer, LAS char* lds, int bid, int nblk) {
  const int mode0 = ((const int*)(p.ws + OFF_FLAG))[0], vbig = ((const int*)(p.ws + OFF_FLAG))[1];
  const int mode = (mode0 == 2 && vbig != 0) ? 1 : mode0;
  const bool fast = mode != 0;
  const int nu = (520 - bid + nblk - 1) / nblk;
  for (int i = 0; i < nu; ++i) {
    const int u = bid + ((bid & 1) ? (nu - 1 - i) : i) * nblk;
    if (u < 256) { if (mode == 2) attn_unit8(p, lds, NCTX + (u >> 2) * 256, u & 3, TT); else if (mode == 1) attn_unit(p, lds, NCTX + (u >> 2) * 256, u & 3, TT); }
    else if (u < 260) { if (layer == 0) { if (mode == 2) attn_unit8(p, lds, 0, u - 256, NCTX); else if (mode == 1) attn_unit(p, lds, 0, u - 256, NCTX); } }
    else { const int tile = u - 260; if (layer == 0 || tile >= 4) poolconv_unit(p, layer, lds, tile); }
  }
  if (!fast) attn_fallback(p, layer, bid, nblk);
}

constexpr int NR = 2, NRA = 2;
__device__ __forceinline__ float hsum4(const f32x4 (&v)[4]) { float s = 0.f;
#pragma unroll
  for (int i = 0; i < 4; ++i) s += (v[i][0] + v[i][1]) + (v[i][2] + v[i][3]);
  return s; }
__device__ __forceinline__ float hsq4(const f32x4 (&v)[4], float mu) { float q = 0.f;
#pragma unroll
  for (int i = 0; i < 4; ++i) { const f32x4 d = v[i] - mu; q += (d[0] * d[0] + d[1] * d[1]) + (d[2] * d[2] + d[3] * d[3]); }
  return q; }
__device__ __forceinline__ f32x4 bf4(u32x2 w) { return (f32x4){__uint_as_float(w[0] << 16), __uint_as_float(w[0] & 0xffff0000u), __uint_as_float(w[1] << 16), __uint_as_float(w[1] & 0xffff0000u)}; }

__device__ __forceinline__ void phase_a0(const Params& p, int layer, int bid, int nblk) {
  const int wave = bid * 8 + (TIDX >> 6), lane = TIDX & 63, nw = nblk * 8;
  float* X = (float*)(p.ws + OFF_X);
  bf16_t* H = (bf16_t*)(p.ws + OFF_H);
  const bf16_t* OM = (const bf16_t*)(p.ws + OFF_OMOE);
  for (int rb = wave * NRA; rb < TT; rb += nw * NRA) {
    f32x4 v[NRA][4]; u32x2 oa[NRA][4], ob[NRA][4];
#pragma unroll
    for (int k = 0; k < NRA; ++k) {
      const int r = rb + k;
      const float* src = layer == 0 ? (r < NCTX ? p.ctx + (size_t)r * D : p.x + (size_t)(r - NCTX) * D) : X + (size_t)r * D;
#pragma unroll
      for (int i = 0; i < 4; ++i) { const int c = i * 256 + lane * 4; v[k][i] = *(const f32x4*)(src + c);
        if (layer != 0) { oa[k][i] = *(const u32x2*)(OM + ((size_t)r * 2 + 0) * D + c); ob[k][i] = *(const u32x2*)(OM + ((size_t)r * 2 + 1) * D + c); } }
    }
    if (layer != 0) {
#pragma unroll
      for (int k = 0; k < NRA; ++k) {
        const int r = rb + k, s = r < NCTX ? 1 : 0;
        const float* g2 = (const float*)(p.ws + OFF_MOD) + ((layer - 1) * 2 + s) * 6144 + 5 * D;
#pragma unroll
        for (int i = 0; i < 4; ++i) { const int c = i * 256 + lane * 4; v[k][i] = v[k][i] * ALPHA + *(const f32x4*)(g2 + c) * (bf4(oa[k][i]) + bf4(ob[k][i])); }
      }
      float mu[NRA], rs[NRA];
#pragma unroll
      for (int k = 0; k < NRA; ++k) mu[k] = wave_sum(hsum4(v[k])) * (1.f / D);
#pragma unroll
      for (int k = 0; k < NRA; ++k) rs[k] = rsqrtf(wave_sum(hsq4(v[k], mu[k])) * (1.f / D) + EPS);
      const float* g = p.ln2_g + (layer - 1) * D; const float* b = p.ln2_b + (layer - 1) * D;
#pragma unroll
      for (int k = 0; k < NRA; ++k)
#pragma unroll
        for (int i = 0; i < 4; ++i) { const int c = i * 256 + lane * 4; v[k][i] = (v[k][i] - mu[k]) * rs[k] * *(const f32x4*)(g + c) + *(const f32x4*)(b + c); *(f32x4*)(X + (size_t)(rb + k) * D + c) = v[k][i]; }
    }
    float mu[NRA], rs[NRA];
#pragma unroll
    for (int k = 0; k < NRA; ++k) mu[k] = wave_sum(hsum4(v[k])) * (1.f / D);
#pragma unroll
    for (int k = 0; k < NRA; ++k) rs[k] = rsqrtf(wave_sum(hsq4(v[k], mu[k])) * (1.f / D) + EPS);
#pragma unroll
    for (int k = 0; k < NRA; ++k) {
      const int r = rb + k, s = r < NCTX ? 1 : 0;
      const float* modp = (const float*)(p.ws + OFF_MOD) + (layer * 2 + s) * 6144;
#pragma unroll
      for (int i = 0; i < 4; ++i) {
        const int c = i * 256 + lane * 4;
        const f32x4 h = (v[k][i] - mu[k]) * rs[k] * (*(const f32x4*)(modp + D + c) + 1.f) + *(const f32x4*)(modp + c);
        *(u32x2*)(H + (size_t)r * D + c) = (u32x2){cvtpk(h[0], h[1]), cvtpk(h[2], h[3])};
      }
    }
  }
}

__device__ __forceinline__ void phase_c2(const Params& p, int layer, LAS char* lds, int bid, int nblk) {
  const int tid = TIDX, wid = tid >> 6, lane = tid & 63;
  float* X = (float*)(p.ws + OFF_X);
  const bf16_t* Y = (const bf16_t*)(p.ws + OFF_Y);
  bf16_t* H2 = (bf16_t*)(p.ws + OFF_MIX);
  int* cnt = (int*)(p.ws + OFF_CNT) + layer * NE * CNT_STRIDE;
  float* GATE = (float*)(p.ws + OFF_GATE); int* LIST = (int*)(p.ws + OFF_LIST);
  LAS int* lcnt = (LAS int*)lds;
  LAS int* lbase = lcnt + 32;
  LAS int* ent = lcnt + 64;
  if (tid < 32) lcnt[tid] = 0;
  LAS float* wre = (LAS float*)(lds + 4096);
#pragma unroll
  for (int kk = 0; kk < 2; ++kk) {
    const int k = tid + kk * 512;
    f32x4 w[8];
#pragma unroll
    for (int g = 0; g < 8; ++g) w[g] = *(const f32x4*)(p.w_re + ((size_t)layer * D + k) * 32 + g * 4);
#pragma unroll
    for (int g = 0; g < 8; ++g)
#pragma unroll
      for (int j = 0; j < 4; ++j) wre[(g * 4 + j) * 1024 + k] = w[g][j];
  }
  __syncthreads();
  const int r0 = layer == 0 ? 0 : NCTX, nrows = TT - r0, rpb = (nrows + nblk - 1) / nblk;
  const int rbeg = r0 + bid * rpb, rend = min(rbeg + rpb, TT);
  for (int rb = rbeg + wid * NR; rb < rend; rb += 8 * NR) {
    f32x4 v[NR][4]; u32x2 yv[NR][4]; int rr[NR]; bool ok[NR];
#pragma unroll
    for (int k = 0; k < NR; ++k) {
      ok[k] = rb + k < rend; rr[k] = ok[k] ? rb + k : rb;
      const int r = rr[k];
      const float* xin = layer == 0 ? (r < NCTX ? p.ctx + (size_t)r * D : p.x + (size_t)(r - NCTX) * D) : X + (size_t)r * D;
#pragma unroll
      for (int i = 0; i < 4; ++i) { const int c = i * 256 + lane * 4; v[k][i] = *(const f32x4*)(xin + c); yv[k][i] = *(const u32x2*)(Y + (size_t)r * D + c); }
    }
#pragma unroll
    for (int k = 0; k < NR; ++k) {
      const float* modp = (const float*)(p.ws + OFF_MOD) + (layer * 2 + (rr[k] < NCTX ? 1 : 0)) * 6144;
#pragma unroll
      for (int i = 0; i < 4; ++i) { const int c = i * 256 + lane * 4; v[k][i] = v[k][i] * ALPHA + *(const f32x4*)(modp + 2 * D + c) * bf4(yv[k][i]); }
    }
    float mu[NR], rs[NR];
#pragma unroll
    for (int k = 0; k < NR; ++k) mu[k] = wave_sum(hsum4(v[k])) * (1.f / D);
#pragma unroll
    for (int k = 0; k < NR; ++k) rs[k] = rsqrtf(wave_sum(hsq4(v[k], mu[k])) * (1.f / D) + EPS);
#pragma unroll
    for (int k = 0; k < NR; ++k)
#pragma unroll
      for (int i = 0; i < 4; ++i) {
        const int c = i * 256 + lane * 4;
        v[k][i] = (v[k][i] - mu[k]) * rs[k] * *(const f32x4*)(p.ln1_g + layer * D + c) + *(const f32x4*)(p.ln1_b + layer * D + c);
        if (ok[k]) *(f32x4*)(X + (size_t)rr[k] * D + c) = v[k][i];
      }
#pragma unroll
    for (int k = 0; k < NR; ++k) mu[k] = wave_sum(hsum4(v[k])) * (1.f / D);
#pragma unroll
    for (int k = 0; k < NR; ++k) rs[k] = rsqrtf(wave_sum(hsq4(v[k], mu[k])) * (1.f / D) + EPS);
#pragma unroll
    for (int k = 0; k < NR; ++k) {
      const float* modp = (const float*)(p.ws + OFF_MOD) + (layer * 2 + (rr[k] < NCTX ? 1 : 0)) * 6144;
#pragma unroll
      for (int i = 0; i < 4; ++i) {
        const int c = i * 256 + lane * 4;
        v[k][i] = (v[k][i] - mu[k]) * rs[k] * (*(const f32x4*)(modp + 4 * D + c) + 1.f) + *(const f32x4*)(modp + 3 * D + c);
        if (ok[k]) *(u32x2*)(H2 + (size_t)rr[k] * D + c) = (u32x2){cvtpk(v[k][i][0], v[k][i][1]), cvtpk(v[k][i][2], v[k][i][3])};
      }
    }
    f32x4 lg[NR];
#pragma unroll
    for (int k = 0; k < NR; ++k) lg[k] = (f32x4){0.f, 0.f, 0.f, 0.f};
#pragma unroll
    for (int i = 0; i < 4; ++i)
#pragma unroll
      for (int j = 0; j < 4; ++j) { const f32x4 w = *(const f32x4*)(p.w_rg + ((size_t)layer * D + i * 256 + lane * 4 + j) * 4);
#pragma unroll
        for (int k = 0; k < NR; ++k) lg[k] += w * v[k][i][j]; }
    int gsel[NR]; float pgrp[NR];
#pragma unroll
    for (int k = 0; k < NR; ++k) {
      float l0 = wave_sum(lg[k][0]) + p.b_rg[layer * 4 + 0], l1 = wave_sum(lg[k][1]) + p.b_rg[layer * 4 + 1];
      float l2 = wave_sum(lg[k][2]) + p.b_rg[layer * 4 + 2], l3 = wave_sum(lg[k][3]) + p.b_rg[layer * 4 + 3];
      int gs = 0; float gm = l0;
      if (l1 > gm) { gm = l1; gs = 1; }
      if (l2 > gm) { gm = l2; gs = 2; }
      if (l3 > gm) { gm = l3; gs = 3; }
      gsel[k] = gs; pgrp[k] = 1.f / (__expf(l0 - gm) + __expf(l1 - gm) + __expf(l2 - gm) + __expf(l3 - gm));
    }
#pragma unroll
    for (int k = 0; k < NR; ++k) {
      float le[8];
#pragma unroll
      for (int e = 0; e < 8; ++e) {
        const LAS float* wr = wre + (gsel[k] * 8 + e) * 1024 + lane * 4;
        float a = 0.f;
#pragma unroll
        for (int i = 0; i < 4; ++i) { const f32x4 w = *(const LAS f32x4*)(wr + i * 256); a += (w[0] * v[k][i][0] + w[1] * v[k][i][1]) + (w[2] * v[k][i][2] + w[3] * v[k][i][3]); }
        le[e] = a;
      }
#pragma unroll
      for (int e = 0; e < 8; ++e) le[e] = wave_sum(le[e]) + p.b_re[layer * 32 + gsel[k] * 8 + e];
      int i0 = 0; float v0 = le[0];
#pragma unroll
      for (int e = 1; e < 8; ++e) if (le[e] > v0) { v0 = le[e]; i0 = e; }
      int i1 = -1; float v1 = -3.0e38f;
#pragma unroll
      for (int e = 0; e < 8; ++e) if (e != i0 && le[e] > v1) { v1 = le[e]; i1 = e; }
      if (i1 < 0) { i1 = (i0 + 1) & 7; v1 = v0; }
      const float e1 = __expf(v1 - v0);
      if (lane == 0 && ok[k]) {
        const int r = rr[k], xa = gsel[k] * 8 + i0, xb = gsel[k] * 8 + i1;
        const int pa = __hip_atomic_fetch_add(&lcnt[xa], 1, __ATOMIC_RELAXED, __HIP_MEMORY_SCOPE_WORKGROUP);
        const int pb = __hip_atomic_fetch_add(&lcnt[xb], 1, __ATOMIC_RELAXED, __HIP_MEMORY_SCOPE_WORKGROUP);
        const int li = (r - rbeg) * 2;
        ent[li * 3 + 0] = xa; ent[li * 3 + 1] = pa; ent[li * 3 + 2] = r * 2 + 0;
        ent[li * 3 + 3] = xb; ent[li * 3 + 4] = pb; ent[li * 3 + 5] = r * 2 + 1;
        GATE[r * 2] = pgrp[k] / (1.f + e1); GATE[r * 2 + 1] = pgrp[k] * e1 / (1.f + e1);
      }
    }
  }
  __syncthreads();
  if (tid < 32) { const int c = lcnt[tid]; lbase[tid] = c > 0 ? atomicAdd(&cnt[tid * CNT_STRIDE], c) : 0; }
  __syncthreads();
  for (int i = tid; i < (rend - rbeg) * 2; i += 512) { const int e = ent[i * 3], lp = ent[i * 3 + 1]; LIST[(size_t)e * CAPL + lbase[e] + lp] = ent[i * 3 + 2]; }
  __syncthreads();
}

__device__ __forceinline__ void phase_final(const Params& p, int bid, int nblk) {
  const int wave = bid * 8 + (TIDX >> 6), lane = TIDX & 63, nw = nblk * 8;
  const float* X = (const float*)(p.ws + OFF_X);
  const bf16_t* OM = (const bf16_t*)(p.ws + OFF_OMOE);
  const float* g2 = (const float*)(p.ws + OFF_MOD) + (1 * 2 + 0) * 6144 + 5 * D;
  for (int rb = NCTX + wave * NRA; rb < TT; rb += nw * NRA) {
    f32x4 v[NRA][4]; u32x2 oa[NRA][4], ob[NRA][4];
#pragma unroll
    for (int k = 0; k < NRA; ++k)
#pragma unroll
      for (int i = 0; i < 4; ++i) { const int c = i * 256 + lane * 4, r = rb + k;
        v[k][i] = *(const f32x4*)(X + (size_t)r * D + c); oa[k][i] = *(const u32x2*)(OM + ((size_t)r * 2 + 0) * D + c); ob[k][i] = *(const u32x2*)(OM + ((size_t)r * 2 + 1) * D + c); }
#pragma unroll
    for (int k = 0; k < NRA; ++k)
#pragma unroll
      for (int i = 0; i < 4; ++i) { const int c = i * 256 + lane * 4; v[k][i] = v[k][i] * ALPHA + *(const f32x4*)(g2 + c) * (bf4(oa[k][i]) + bf4(ob[k][i])); }
    float mu[NRA], rs[NRA];
#pragma unroll
    for (int k = 0; k < NRA; ++k) mu[k] = wave_sum(hsum4(v[k])) * (1.f / D);
#pragma unroll
    for (int k = 0; k < NRA; ++k) rs[k] = rsqrtf(wave_sum(hsq4(v[k], mu[k])) * (1.f / D) + EPS);
#pragma unroll
    for (int k = 0; k < NRA; ++k)
#pragma unroll
      for (int i = 0; i < 4; ++i) {
        const int c = i * 256 + lane * 4;
        *(f32x4*)(p.out + (size_t)(rb + k - NCTX) * D + c) = (v[k][i] - mu[k]) * rs[k] * *(const f32x4*)(p.ln2_g + D + c) + *(const f32x4*)(p.ln2_b + D + c);
      }
  }
}

__device__ __forceinline__ void phase_p0(const Params& p, LAS char* lds, int bid, int nblk) {
  const int tid = TIDX;
  const long gtid = (long)bid * 512 + tid, gth = (long)nblk * 512;
  LAS float* sc = (LAS float*)lds;
  LAS float* red = (LAS float*)(lds + 8192);
  for (int i = tid; i < 2048; i += 512) { const float v = i < 1024 ? p.c[i] : p.c_ctx[i - 1024]; sc[i] = silu(v); }
  __syncthreads();
  float* mod = (float*)(p.ws + OFF_MOD);
  for (int u = bid; u < 384; u += nblk) {
    const int layer = u / 192, cg = u % 192, col = tid & 31, ksl = tid >> 5;
    const float* w = p.w_mod + ((size_t)layer * D + ksl * 64) * 6144 + cg * 32 + col;
    float a0 = 0.f, a1 = 0.f;
#pragma unroll 8
    for (int k = 0; k < 64; ++k) { const float wv = w[(size_t)k * 6144]; a0 += sc[ksl * 64 + k] * wv; a1 += sc[1024 + ksl * 64 + k] * wv; }
    red[(ksl * 32 + col) * 2] = a0; red[(ksl * 32 + col) * 2 + 1] = a1;
    __syncthreads();
    if (tid < 64) {
      const int c2 = tid & 31, s = tid >> 5; float a = 0.f;
#pragma unroll
      for (int k = 0; k < 16; ++k) a += red[(k * 32 + c2) * 2 + s];
      mod[(layer * 2 + s) * 6144 + cg * 32 + c2] = a + p.b_mod[layer * 6144 + cg * 32 + c2];
    }
    __syncthreads();
  }
  if (gtid < 256 * 16) {
    const int pos = (int)gtid / 16, f = (int)gtid % 16;
    const float ang = (float)pos * powf(10000.f, -(float)f / 16.f);
    float* rt = (float*)(p.ws + OFF_ROPE);
    rt[gtid * 2 + 0] = cosf(ang); rt[gtid * 2 + 1] = sinf(ang);
  }
  if (gtid < 2 * NE * CNT_STRIDE) ((int*)(p.ws + OFF_CNT))[gtid] = 0;
  if (gtid == 0) {
    float bmax = 0.f;
    for (int l = 0; l < 2; ++l) {
      float gq = 0.f, gk = 0.f;
      for (int i = 0; i < 64; ++i) { gq = fmaxf(gq, fabsf(p.q_gain[l * 64 + i])); gk = fmaxf(gk, fabsf(p.k_gain[l * 64 + i])); }
      bmax = fmaxf(bmax, 11.55f * gq * gk);
    }
    ((int*)(p.ws + OFF_FLAG))[0] = bmax <= 13.2f ? 2 : (bmax <= 100.f ? 1 : 0);
    ((int*)(p.ws + OFF_FLAG))[1] = 0;
  }
  for (long i = gtid; i < 2 * 65536; i += gth) { const int l = (int)(i >> 16), d = (int)(i >> 8) & 255, c = (int)i & 255; ((bf16_t*)(p.ws + OFF_WPWT))[i] = f2bf(p.w_cv_pw[((size_t)l * 256 + c) * 256 + d]); }
  for (long i = gtid; i < 8 * 4096; i += gth) { const int lg = (int)(i >> 12), d = (int)(i >> 6) & 63, c = (int)i & 63; ((bf16_t*)(p.ws + OFF_WPOOLT))[i] = f2bf(p.w_pool[((size_t)lg * 64 + c) * 64 + d]); }
  cvt_range(p.w_in, (bf16_t*)(p.ws + OFF_WIN), 2L * D * INW / 8, gtid, gth);
  cvt_range(p.w_out, (bf16_t*)(p.ws + OFF_WOUT), 2L * D * D / 8, gtid, gth);
}
#define XB_TMO      128
#define XB_XCNT(j)  (256  + 64 * (j))
#define XB_XSUB(j)  (1280 + 64 * (j))
#define XB_XGEN(j)  (2304 + 64 * (j))
#define XB_TOP      3328
#define XB_TOPGEN   3392
#define XCD_BAR_WORDS 3456
#define XB_SPIN_CAP (1u << 22)
__device__ __forceinline__ unsigned xb_ld(unsigned* p)              { return __hip_atomic_load(p, __ATOMIC_RELAXED, __HIP_MEMORY_SCOPE_AGENT); }
__device__ __forceinline__ unsigned xb_add(unsigned* p, unsigned v) { return __hip_atomic_fetch_add(p, v, __ATOMIC_RELAXED, __HIP_MEMORY_SCOPE_AGENT); }
__device__ __forceinline__ unsigned xb_xcc_id() { return (unsigned)__builtin_amdgcn_s_getreg((3 << 11) | 20) & 0xFu; }
#define XB_SPIN(cond, bar) do { unsigned _sp = 0; while (cond) { __builtin_amdgcn_s_sleep(1); \
    if ((++_sp & 255u) == 0u) { if (xb_ld(&(bar)[XB_TMO])) break; if (_sp > XB_SPIN_CAP) { atomicAdd(&(bar)[XB_TMO], 1u); break; } } } } while (0)
struct XcdBarrier { unsigned* bar; unsigned x; volatile LAS unsigned* st; };
__device__ __forceinline__ XcdBarrier xcd_barrier_post(unsigned* bar, volatile LAS unsigned* st) {
  XcdBarrier b; b.bar = bar; b.x = xb_xcc_id(); b.st = st;
  if (threadIdx.x == 0) (void)xb_add(&bar[XB_XCNT(b.x)], 1u);
  return b;
}
__device__ __forceinline__ void xcd_barrier_complete(unsigned* bar, unsigned x, unsigned& nloc, unsigned& nx) {
  const unsigned G = gridDim.x * gridDim.y * gridDim.z;
  unsigned sum, cnt, mine, sp = 0u;
  for (;;) {
    sum = 0u; cnt = 0u; mine = 0u;
#pragma unroll
    for (unsigned j = 0; j < 16; ++j) { const unsigned c = xb_ld(&bar[XB_XCNT(j)]); sum += c; cnt += (c > 0u) ? 1u : 0u; mine = (j == x) ? c : mine; }
    if (sum == G) break;
    __builtin_amdgcn_s_sleep(1);
    if ((++sp & 255u) == 0u) { if (xb_ld(&bar[XB_TMO])) break; if (sp > XB_SPIN_CAP) { atomicAdd(&bar[XB_TMO], 1u); break; } }
  }
  nloc = mine > 0u ? mine : 1u; nx = cnt > 0u ? cnt : 1u;
}
__device__ __forceinline__ void xcd_barrier(const XcdBarrier& b) {
  asm volatile("s_waitcnt vmcnt(0)" ::: "memory");
  __syncthreads();
  if (threadIdx.x == 0) {
    unsigned* bar = b.bar; unsigned bx = b.x;
    asm volatile("" : "+s"(bar), "+s"(bx));
    __builtin_amdgcn_s_waitcnt(0);
    unsigned nloc = b.st[0], nx = b.st[1];
    if (nloc == 0u) { xcd_barrier_complete(bar, bx, nloc, nx); b.st[0] = nloc; b.st[1] = nx; }
    const unsigned old = xb_add(&bar[XB_XSUB(bx)], 1u);
    const unsigned gen = old / nloc;
    if (old + 1u == (gen + 1u) * nloc) {
      __builtin_amdgcn_fence(__ATOMIC_RELEASE, "agent");
      asm volatile("s_waitcnt vmcnt(0)" ::: "memory");
      const unsigned og = xb_add(&bar[XB_TOP], 1u);
      const unsigned tg = og / nx;
      if (og + 1u == (tg + 1u) * nx) xb_add(&bar[XB_TOPGEN], 1u);
      else XB_SPIN(xb_ld(&bar[XB_TOPGEN]) == tg, bar);
      __builtin_amdgcn_fence(__ATOMIC_ACQUIRE, "agent");
      xb_add(&bar[XB_XGEN(bx)], 1u);
      asm volatile("s_waitcnt vmcnt(0)" ::: "memory");
    } else {
      XB_SPIN(xb_ld(&bar[XB_XGEN(bx)]) == gen, bar);
      __builtin_amdgcn_fence(__ATOMIC_ACQUIRE, "agent");
      asm volatile("s_waitcnt vmcnt(0)" ::: "memory");
    }
  }
  __syncthreads();
}

constexpr int LDS_MAIN = PC_LDS > GEMM_LDS + 256 ? PC_LDS : GEMM_LDS + 256;
constexpr int LDS_TOTAL = LDS_MAIN + 16;
static_assert(GEMM_LDS + 256 <= LDS_MAIN && ATT_LDS <= LDS_MAIN, "lds");
__global__ void __launch_bounds__(512) mega_fwd(Params p) {
  __shared__ __attribute__((aligned(16))) char slds[LDS_TOTAL];
  LAS char* lds = (LAS char*)slds;
  volatile LAS unsigned* st = (volatile LAS unsigned*)(lds + LDS_MAIN);
  if (threadIdx.x < 4) st[threadIdx.x] = 0u;
  __syncthreads();
  const XcdBarrier bar = xcd_barrier_post((unsigned*)(p.ws + OFF_BAR), st);
  const int bid = blockIdx.x, nblk = gridDim.x;
  phase_p0(p, lds, bid, nblk);
  xcd_barrier(bar);
#pragma unroll 1
  for (int layer = 0; layer < 2; ++layer) {
    phase_a0(p, layer, bid, nblk);
    xcd_barrier(bar);
    phase_a1(p, layer, lds, bid, nblk);
    xcd_barrier(bar);
    phase_b(p, layer, lds, bid, nblk);
    xcd_barrier(bar);
    phase_c1(p, layer, lds, bid, nblk);
    xcd_barrier(bar);
    phase_c2(p, layer, lds, bid, nblk);
    xcd_barrier(bar);
    phase_d1(p, layer, lds, bid, nblk);
    xcd_barrier(bar);
    phase_d2(p, layer, lds, bid, nblk);
    xcd_barrier(bar);
  }
  phase_final(p, bid, nblk);
}

extern "C" void kernel_launch(void* const* d_in, const int* in_sizes, int n_in, void* d_out, int out_size, void* d_ws, size_t ws_size,
                              hipStream_t stream) {
  static int grid = 0;
  if (grid == 0) {
    if (ws_size < WS_END || n_in != 28) { fprintf(stderr, "kernel_launch: ws too small (%zu < %zu) or n_in %d != 28; nothing launched\n", ws_size, (size_t)WS_END, n_in); grid = -1; return; }
    int dev = 0, cus = 0, per_cu = 0;
    if (hipGetDevice(&dev) != hipSuccess || hipDeviceGetAttribute(&cus, hipDeviceAttributeMultiprocessorCount, dev) != hipSuccess) { grid = -1; return; }
    if (hipOccupancyMaxActiveBlocksPerMultiprocessor(&per_cu, (const void*)mega_fwd, 512, 0) != hipSuccess || per_cu < 1) {
      fprintf(stderr, "kernel_launch: occupancy query says %d blocks per CU; nothing launched\n", per_cu); grid = -1; return; }
    (void)hipGetLastError();
    grid = cus;
  }
  if (grid < 0) return;
  if (hipMemsetAsync((char*)d_ws + OFF_BAR, 0, BAR_BYTES, stream) != hipSuccess) { fprintf(stderr, "kernel_launch: memset failed\n"); return; }
  Params p{};
  const float** f = (const float**)&p;
  for (int i = 0; i < 28; ++i) f[i] = (const float*)d_in[i];
  p.out = (float*)d_out; p.ws = (char*)d_ws;
  hipLaunchKernelGGL(mega_fwd, dim3(grid), dim3(512), 0, stream, p);
}
```

```cpp
#include <hip/hip_runtime.h>
#include <cstdio>
#include <cstdint>

typedef unsigned short bf16_t;
#define LAS __attribute__((address_space(3)))

constexpr int D = 1024, SEQ = 16384, NCTX = 256, TT = SEQ + NCTX;
constexpr int INW = 1536;
constexpr int NE = 32, DE = 512;
constexpr int CAPL = 2 * TT;
constexpr int HMID_ROWS = 2 * TT + NE * 128;
constexpr float ALPHA = 1.41421356237309515f;
constexpr float EPS = 1e-6f;

constexpr size_t al(size_t x) { return (x + 255) / 256 * 256; }
constexpr size_t OFF_BAR = 0;
constexpr size_t BAR_BYTES = 3456 * 4;
constexpr size_t OFF_MOD = OFF_BAR + al(BAR_BYTES);
constexpr size_t OFF_ROPE = OFF_MOD + al(2 * 2 * 6144 * 4);
constexpr int CNT_STRIDE = 32;
constexpr size_t OFF_CNT = OFF_ROPE + al(256 * 16 * 2 * 4);
constexpr size_t OFF_FLAG = OFF_CNT + al(2 * 32 * 32 * 4);
constexpr size_t OFF_X = OFF_FLAG + 256;
constexpr size_t OFF_H = OFF_X + al((size_t)TT * D * 4);
constexpr size_t OFF_MIX = OFF_H + al((size_t)TT * D * 2);
constexpr size_t OFF_Y = OFF_MIX + al((size_t)TT * D * 2);
constexpr size_t OFF_Q = OFF_Y + al((size_t)TT * D * 2);
constexpr size_t OFF_K = OFF_Q + al((size_t)TT * 512 * 2);
constexpr size_t OFF_V = OFF_K + al((size_t)TT * 128 * 2);
constexpr size_t OFF_U = OFF_V + al((size_t)TT * 128 * 2);
constexpr size_t OFF_AG = OFF_U + al((size_t)TT * 256 * 4);
constexpr size_t OFF_HMID = OFF_Q;
constexpr size_t OFF_OMOE = OFF_AG + al((size_t)TT * 512 * 2);
constexpr size_t OFF_GATE = OFF_OMOE + al((size_t)TT * 2 * D * 2);
constexpr size_t OFF_LIST = OFF_GATE + al((size_t)TT * 2 * 4);
constexpr size_t OFF_WIN = OFF_LIST + al((size_t)NE * CAPL * 4);
constexpr size_t OFF_WOUT = OFF_WIN + al((size_t)2 * D * INW * 2);
constexpr size_t OFF_WPWT = OFF_WOUT + al((size_t)2 * D * D * 2);
constexpr size_t OFF_WPOOLT = OFF_WPWT + al((size_t)2 * 256 * 256 * 2);
constexpr size_t OFF_Q8 = OFF_WPOOLT + al((size_t)2 * 4 * 64 * 64 * 2);
constexpr size_t OFF_K8 = OFF_Q8 + al((size_t)TT * 512);
constexpr size_t OFF_VT8 = OFF_K8 + al((size_t)TT * 128);
constexpr size_t OFF_WG = OFF_VT8 + al((size_t)128 * TT);
constexpr size_t OFF_WU = OFF_WG + al((size_t)2 * NE * D * DE * 2);
constexpr size_t OFF_WD = OFF_WU + al((size_t)2 * NE * D * DE * 2);
constexpr size_t WS_END = OFF_WD + al((size_t)2 * NE * D * DE * 2);
static_assert(OFF_AG - OFF_HMID >= (size_t)HMID_ROWS * DE * 2, "HMID alias too small");
static_assert(WS_END < 530000000, "ws budget");

struct Params {
  const float *x, *c, *ctx, *c_ctx, *w_mod, *b_mod, *w_in, *q_gain, *k_gain, *w_pool, *pool_scale, *w_dw, *b_dw,
      *cv_ln_g, *cv_ln_b, *w_cv_pw, *w_out, *ln1_g, *ln1_b, *ln2_g, *ln2_b, *w_rg, *b_rg, *w_re, *b_re, *w_e_gate, *w_e_up, *w_e_down;
  float* out;
  char* ws;
};

__device__ __forceinline__ float bf2f(bf16_t v) { return __uint_as_float(((unsigned)v) << 16); }
__device__ __forceinline__ bf16_t f2bf(float f) {
  unsigned u = __float_as_uint(f);
  u += 0x7fffu + ((u >> 16) & 1u);
  return (bf16_t)(u >> 16);
}
template <int CTRL> __device__ __forceinline__ float dppf(float v) { return __int_as_float(__builtin_amdgcn_update_dpp(0, __float_as_int(v), CTRL, 0xf, 0xf, true)); }
__device__ __forceinline__ float wave_sum(float v) {
  v += dppf<0xB1>(v); v += dppf<0x4E>(v); v += dppf<0x141>(v); v += dppf<0x140>(v);
  { auto r = __builtin_amdgcn_permlane16_swap(__float_as_uint(v), __float_as_uint(v), false, false); v = __uint_as_float(r[0]) + __uint_as_float(r[1]); }
  { auto r = __builtin_amdgcn_permlane32_swap(__float_as_uint(v), __float_as_uint(v), false, false); v = __uint_as_float(r[0]) + __uint_as_float(r[1]); }
  return v;
}
__device__ __forceinline__ float silu(float v) { return v / (1.f + __expf(-v)); }
__device__ __forceinline__ int opaque0() { int z; asm volatile("s_mov_b32 %0, 0" : "=s"(z)); return z; }
#define TIDX ((int)threadIdx.x + opaque0())
using bf16x8 = __attribute__((ext_vector_type(8))) short;
using s16x4 = __attribute__((ext_vector_type(4))) short;
using f32x16 = __attribute__((ext_vector_type(16))) float;
using f32x4 = __attribute__((ext_vector_type(4))) float;
using u32x4 = __attribute__((ext_vector_type(4))) unsigned;
using u32x2 = __attribute__((ext_vector_type(2))) unsigned;

__device__ __forceinline__ int crow(int r, int hi) { return (r & 3) + 8 * (r >> 2) + 4 * hi; }
typedef float f32x2 __attribute__((ext_vector_type(2)));
typedef __bf16 bf16x2v __attribute__((ext_vector_type(2)));
__device__ __forceinline__ unsigned cvtpk(float lo, float hi) {
  bf16x2v b = __builtin_convertvector((f32x2){lo, hi}, bf16x2v);
  return __builtin_bit_cast(unsigned, b);
}
__device__ __forceinline__ float sum32(float v) {
  auto rr = __builtin_amdgcn_permlane32_swap(__float_as_uint(v), __float_as_uint(v), false, false);
  return __uint_as_float(rr[0]) + __uint_as_float(rr[1]);
}

__device__ __forceinline__ void cvt_range(const float* __restrict__ src, bf16_t* __restrict__ dst, long n8, long gtid, long gthreads) {
  for (long i = gtid; i < n8; i += gthreads) {
    const f32x4 a = *(const f32x4*)(src + i * 8), b = *(const f32x4*)(src + i * 8 + 4);
    u32x4 w = {cvtpk(a[0], a[1]), cvtpk(a[2], a[3]), cvtpk(b[0], b[1]), cvtpk(b[2], b[3])};
    *(u32x4*)(dst + i * 8) = w;
  }
}

__device__ __forceinline__ int xoff(int row, int chunk) { return row * 128 + ((chunk ^ ((row >> 1) & 7)) << 4); }
__device__ __forceinline__ int wst(int k, int c) { const int kk = (k & ~0xC) | ((k & 4) << 1) | ((k & 8) >> 1); return ((kk >> 3) * 4 + (c >> 5)) * 512 + ((kk & 7) * 32 + (c & 31)) * 2; }
__device__ __forceinline__ int v_rd_base(int lane) { return ((lane & 3) << 3) | (((lane >> 2) & 3) << 6) | (((lane >> 4) & 1) << 5) | (((lane >> 5) & 1) << 8); }

__device__ __forceinline__ bf16x8 tr_frag(const LAS char* p) {
  s16x4 a = __builtin_amdgcn_ds_read_tr16_b64_v4i16((LAS s16x4*)p);
  s16x4 b = __builtin_amdgcn_ds_read_tr16_b64_v4i16((LAS s16x4*)(p + 2048));
  return (bf16x8){a[0], a[1], a[2], a[3], b[0], b[1], b[2], b[3]};
}

template <int OFF> __device__ __forceinline__ bf16x8 tr_frag_asm(int addr) {
  s16x4 a, b;
  asm volatile("ds_read_b64_tr_b16 %0, %1 offset:%2" : "=&v"(a) : "v"(addr), "i"(OFF) : "memory");
  asm volatile("ds_read_b64_tr_b16 %0, %1 offset:%2" : "=&v"(b) : "v"(addr), "i"(OFF + 2048) : "memory");
  return (bf16x8){a[0], a[1], a[2], a[3], b[0], b[1], b[2], b[3]};
}

template <int BM, int BN> struct GemmCfg {
  static constexpr int WM = BM / 64, WN = 8 / WM, NSLAB = BN / 128, XB = BM * 128, WB = NSLAB * 16384, STAGE = XB + WB, NXP = BM / 64, NWP = NSLAB * 2;
  static_assert(WM * WN == 8 && WN * 64 == BN, "tile");
};
constexpr int GEMM_LDS = 3 * (256 * 128 + 16384);

template <int BM, int BN, int NMAP, bool BG = false, class XRow, class WPtr>
__device__ __forceinline__ void gemm_mainloop(LAS char* lds, f32x16 (&acc)[2][2], const XRow& xrow, const WPtr& wptr, int ldw, int K, int& bgdone, int bgn = 0, long bgc0 = 0,
                                              const float* bs0 = nullptr, const float* bs1 = nullptr, const float* bs2 = nullptr, bf16_t* bd0 = nullptr, bf16_t* bd1 = nullptr, bf16_t* bd2 = nullptr) {
#define BG_ADDR(i, off, SP, DP) long c_ = bgc0 + (long)(i) * 512 + (off); const bool ok_ = c_ < (3L << 21); if (!ok_) c_ = 0; const int t_ = (int)(c_ >> 21); const long o_ = (c_ & 0x1fffff) * 8; \
    const float* SP = (t_ == 0 ? bs0 : (t_ == 1 ? bs1 : bs2)) + o_; bf16_t* DP = (t_ == 0 ? bd0 : (t_ == 1 ? bd1 : bd2)) + o_
#define BG_ISSUE(i, off, a, b) do { BG_ADDR(i, off, sp_, dp_); (void)dp_; a = *(const f32x4*)sp_; b = *(const f32x4*)(sp_ + 4); } while (0)
#define BG_RETIRE(i, off, a, b) do { BG_ADDR(i, off, sp_, dp_); (void)sp_; if (ok_) *(u32x4*)dp_ = (u32x4){cvtpk(a[0], a[1]), cvtpk(a[2], a[3]), cvtpk(b[0], b[1]), cvtpk(b[2], b[3])}; } while (0)
#define BGA_ISSUE(i, off, a, b) do { BG_ADDR(i, off, sp_, dp_); (void)dp_; \
    asm volatile("global_load_dwordx4 %0, %2, off\n\tglobal_load_dwordx4 %1, %2, off offset:16" : "=&v"(a), "=&v"(b) : "v"(sp_) : "memory"); } while (0)
#define BGA_RETIRE(i, off, a, b) do { BG_ADDR(i, off, sp_, dp_); (void)sp_; const u32x4 w_ = {cvtpk(a[0], a[1]), cvtpk(a[2], a[3]), cvtpk(b[0], b[1]), cvtpk(b[2], b[3])}; \
    if (ok_) asm volatile("global_store_dwordx4 %0, %1, off" :: "v"(dp_), "v"(w_) : "memory"); } while (0)
  using C = GemmCfg<BM, BN>;
  const int tid = TIDX, wid = __builtin_amdgcn_readfirstlane(tid >> 6), lane = tid & 63, r32 = lane & 31, hi = lane >> 5;
  const int wm = wid / C::WN, wn = wid % C::WN;
  const bf16_t *g0, *g1, *g2, *g3, *g4, *g5, *g6 = nullptr, *g7 = nullptr, *g8 = nullptr, *g9 = nullptr, *g10 = nullptr, *g11 = nullptr;
  int l0, l1, l2, l3, l4, l5, l6 = 0, l7 = 0, l8 = 0, l9 = 0, l10 = 0, l11 = 0;
  auto xpieceq = [&](int q, const bf16_t*& gp, int& lp) { const int row = 8 * q + (lane >> 3), c = (lane & 7) ^ ((row >> 1) & 7); gp = xrow(row) + c * 8; lp = q * 1024; };
  auto wpieceq = [&](int idx, const bf16_t*& gp, int& lp) {
    const int s = idx >> 4, q = idx & 15, sub = 2 * q + (lane >> 5), kk = (sub >> 2) * 8 + ((lane & 31) >> 2);
    const int k = (kk & ~0xC) | ((kk & 4) << 1) | ((kk & 8) >> 1), c = (sub & 3) * 32 + (lane & 3) * 8;
    gp = wptr(s) + (size_t)k * ldw + c; lp = C::XB + s * 16384 + q * 1024; };
  const size_t stepx = 64, stepw = (size_t)64 * ldw;
  if (BG) {
    const int w4 = wid & 3;
    xpieceq(w4 * 8 + 0, g0, l0); xpieceq(w4 * 8 + 1, g1, l1); xpieceq(w4 * 8 + 2, g2, l2); xpieceq(w4 * 8 + 3, g3, l3);
    xpieceq(w4 * 8 + 4, g4, l4); xpieceq(w4 * 8 + 5, g5, l5); xpieceq(w4 * 8 + 6, g6, l6); xpieceq(w4 * 8 + 7, g7, l7);
    wpieceq(w4 * 4 + 0, g8, l8); wpieceq(w4 * 4 + 1, g9, l9); wpieceq(w4 * 4 + 2, g10, l10); wpieceq(w4 * 4 + 3, g11, l11);
  } else if (C::NXP == 4) { xpieceq(wid * 4 + 0, g0, l0); xpieceq(wid * 4 + 1, g1, l1); xpieceq(wid * 4 + 2, g2, l2); xpieceq(wid * 4 + 3, g3, l3); wpieceq(wid * 2 + 0, g4, l4); wpieceq(wid * 2 + 1, g5, l5); }
  else { xpieceq(wid * 2 + 0, g0, l0); xpieceq(wid * 2 + 1, g1, l1); wpieceq(wid * 4 + 0, g2, l2); wpieceq(wid * 4 + 1, g3, l3); wpieceq(wid * 4 + 2, g4, l4); wpieceq(wid * 4 + 3, g5, l5); }
  const size_t stp0 = stepx, stp1 = stepx, stp2 = (BG || C::NXP == 4) ? stepx : stepw, stp3 = (BG || C::NXP == 4) ? stepx : stepw, stp4 = BG ? stepx : stepw, stp5 = BG ? stepx : stepw;
  const bool dmaw = !BG || wid < 4;
  int xr[2];
#pragma unroll
  for (int ti = 0; ti < 2; ++ti) xr[ti] = (wm * 64 + ti * 32 + r32) * 128;
  const int xsw = (r32 >> 1) & 7;
  int wr[2];
#pragma unroll
  for (int ni = 0; ni < 2; ++ni) {
    const int slab = NMAP == 0 ? 0 : (NMAP == 1 ? (wn >> 1) : ni);
    const int nb = NMAP == 0 ? (2 * wn + ni) : (NMAP == 1 ? ((wn & 1) * 2 + ni) : wn);
    wr[ni] = C::XB + slab * 16384 + nb * 512 + v_rd_base(lane);
  }
  const int nk = K / 64;
#define G_DMA1(gp, sp, lp, kt, _d) __builtin_amdgcn_global_load_lds((const unsigned*)((gp) + (size_t)(kt) * (sp)), (LAS unsigned*)((_d) + (lp)), 16, 0, 0)
#define G_DMA(kt, st) do { if (dmaw) { LAS char* _d = lds + (st) * C::STAGE; \
    G_DMA1(g0, stp0, l0, kt, _d); G_DMA1(g1, stp1, l1, kt, _d); G_DMA1(g2, stp2, l2, kt, _d); G_DMA1(g3, stp3, l3, kt, _d); G_DMA1(g4, stp4, l4, kt, _d); G_DMA1(g5, stp5, l5, kt, _d); \
    if (BG) { G_DMA1(g6, stepx, l6, kt, _d); G_DMA1(g7, stepx, l7, kt, _d); G_DMA1(g8, stepw, l8, kt, _d); G_DMA1(g9, stepw, l9, kt, _d); G_DMA1(g10, stepw, l10, kt, _d); G_DMA1(g11, stepw, l11, kt, _d); } } } while (0)
#define G_HALF(cur, wa0, wa1, H) do { bf16x8 xf[2][2], wf[2][2]; \
      _Pragma("unroll") for (int k2 = 0; k2 < 2; ++k2) _Pragma("unroll") for (int ti = 0; ti < 2; ++ti) xf[k2][ti] = *(const LAS bf16x8*)(cur + xr[ti] + ((((H * 2 + k2) * 2 + hi) ^ xsw) << 4)); \
      wf[0][0] = tr_frag_asm<(H * 2 + 0) * 4096>(wa0); wf[0][1] = tr_frag_asm<(H * 2 + 0) * 4096>(wa1); \
      wf[1][0] = tr_frag_asm<(H * 2 + 1) * 4096>(wa0); wf[1][1] = tr_frag_asm<(H * 2 + 1) * 4096>(wa1); \
      asm volatile("s_waitcnt lgkmcnt(0)" ::: "memory"); __builtin_amdgcn_sched_barrier(0); \
      _Pragma("unroll") for (int k2 = 0; k2 < 2; ++k2) _Pragma("unroll") for (int ti = 0; ti < 2; ++ti) _Pragma("unroll") for (int ni = 0; ni < 2; ++ni) \
        acc[ti][ni] = __builtin_amdgcn_mfma_f32_32x32x16_bf16(wf[k2][ni], xf[k2][ti], acc[ti][ni], 0, 0, 0); } while (0)
#define G_COMPUTE(st) do { const LAS char* cur = lds + (st) * C::STAGE; const int wa0 = (int)(uintptr_t)(cur + wr[0]), wa1 = (int)(uintptr_t)(cur + wr[1]); \
    G_HALF(cur, wa0, wa1, 0); G_HALF(cur, wa0, wa1, 1); } while (0)
  static_assert(C::NXP + C::NWP == 6 && (!BG || (C::NXP == 4 && C::NWP == 2)), "piece counts assumed by the vmcnt waits");
  G_DMA(0, 0); G_DMA(1, 1);
  f32x4 b0a, b0b, b0c, b0d, b1a, b1b, b1c, b1d, b2a, b2b, b2c, b2d; int bi0 = -1, bi1 = -1, bi2 = -1;
  const int bgoff = tid - 256;
#define BG_SLOT(bi, xa, xb, xc, xd) do { if (bi >= 0) { asm volatile("s_waitcnt vmcnt(8)" ::: "memory");     \
      BGA_RETIRE(bi, bgoff, xa, xb); BGA_RETIRE(bi, bgoff + 256, xc, xd); bi = -1; } \
    if (bgdone < bgn) { bi = bgdone; BGA_ISSUE(bi, bgoff, xa, xb); BGA_ISSUE(bi, bgoff + 256, xc, xd); } } while (0)
#define G_STEP(kt, ST, bi, xa, xb, xc, xd) do { \
    if (dmaw) { if ((kt) + 1 < nk) { if (BG) asm volatile("s_waitcnt vmcnt(12)" ::: "memory"); else asm volatile("s_waitcnt vmcnt(6)" ::: "memory"); } \
                else asm volatile("s_waitcnt vmcnt(0)" ::: "memory"); } \
    asm volatile("s_waitcnt lgkmcnt(0)" ::: "memory"); __builtin_amdgcn_s_barrier(); \
    if ((kt) + 2 < nk) G_DMA((kt) + 2, ((ST) + 2) % 3); \
    if (BG && !dmaw) BG_SLOT(bi, xa, xb, xc, xd); \
    if (BG && bgdone < bgn) ++bgdone; \
    G_COMPUTE(ST); } while (0)
  for (int kt = 0; kt < nk; kt += 3) {
    G_STEP(kt, 0, bi0, b0a, b0b, b0c, b0d);
    if (kt + 1 < nk) G_STEP(kt + 1, 1, bi1, b1a, b1b, b1c, b1d);
    if (kt + 2 < nk) G_STEP(kt + 2, 2, bi2, b2a, b2b, b2c, b2d);
  }
  if (BG && !dmaw) {
    asm volatile("s_waitcnt vmcnt(0)" ::: "memory");
    if (bi0 >= 0) { BGA_RETIRE(bi0, bgoff, b0a, b0b); BGA_RETIRE(bi0, bgoff + 256, b0c, b0d); }
    if (bi1 >= 0) { BGA_RETIRE(bi1, bgoff, b1a, b1b); BGA_RETIRE(bi1, bgoff + 256, b1c, b1d); }
    if (bi2 >= 0) { BGA_RETIRE(bi2, bgoff, b2a, b2b); BGA_RETIRE(bi2, bgoff + 256, b2c, b2d); }
    asm volatile("s_waitcnt vmcnt(0)" ::: "memory");
  }
#undef G_STEP
#undef BG_SLOT
  asm volatile("s_waitcnt lgkmcnt(0)" ::: "memory"); __builtin_amdgcn_s_barrier();
#undef G_DMA
#undef G_DMA1
#undef G_COMPUTE
#undef G_HALF
}

__device__ __forceinline__ unsigned pack4_fp8(const f32x16& a, int g) {
  int w = __builtin_amdgcn_cvt_pk_fp8_f32(a[4 * g], a[4 * g + 1], 0, false);
  w = __builtin_amdgcn_cvt_pk_fp8_f32(a[4 * g + 2], a[4 * g + 3], w, true);
  return (unsigned)w;
}
__device__ __forceinline__ u32x2 pack4(const f32x16& a, int g) { return (u32x2){cvtpk(a[4 * g], a[4 * g + 1]), cvtpk(a[4 * g + 2], a[4 * g + 3])}; }

__device__ __forceinline__ void phase_a1(const Params& p, int layer, LAS char* lds, int bid, int nblk) {
  const bf16_t* H = (const bf16_t*)(p.ws + OFF_H);
  const bf16_t* W = (const bf16_t*)(p.ws + OFF_WIN) + (size_t)layer * D * INW;
  bf16_t* Q = (bf16_t*)(p.ws + OFF_Q); bf16_t* Kb = (bf16_t*)(p.ws + OFF_K); bf16_t* Vb = (bf16_t*)(p.ws + OFF_V);
  float* U = (float*)(p.ws + OFF_U); bf16_t* AG = (bf16_t*)(p.ws + OFF_AG);
  unsigned char* Q8 = (unsigned char*)(p.ws + OFF_Q8); unsigned char* K8 = (unsigned char*)(p.ws + OFF_K8); unsigned char* VT8 = (unsigned char*)(p.ws + OFF_VT8);
  const float* rt = (const float*)(p.ws + OFF_ROPE);
  const int lane = TIDX & 63, wid = TIDX >> 6, r32 = lane & 31, hi = lane >> 5, wm = wid >> 1, wn = wid & 1;
  const size_t wo = (size_t)layer * NE * D * DE;
  const int bgn = (3 * (1 << 21) + nblk * 512 - 1) / (nblk * 512);
  const long bgc0 = (long)bid * bgn * 512;
  const float* bs0 = p.w_e_gate + wo; const float* bs1 = p.w_e_up + wo; const float* bs2 = p.w_e_down + wo;
  bf16_t* bd0 = (bf16_t*)(p.ws + OFF_WG) + wo; bf16_t* bd1 = (bf16_t*)(p.ws + OFF_WU) + wo; bf16_t* bd2 = (bf16_t*)(p.ws + OFF_WD) + wo;
  int bgdone = 0;
  const int nlat = 64 * 12, nctx = layer == 0 ? 12 : 2, nunits = nlat + nctx;
  const bool xmap = (nblk & 7) == 0;
  const int xcd = bid & 7, lb = bid >> 3, nlb = nblk >> 3, nl = lb < 96 ? (96 - lb + nlb - 1) / nlb : 0;
  for (int it = 0;; ++it) {
    int rtile, ct;
    if (xmap) {
      if (it < nl) { const int v = lb + it * nlb; rtile = 1 + xcd + 8 * (v / 12); ct = v % 12; }
      else { const int e2 = bid + (it - nl) * nblk; if (e2 >= nctx) break; rtile = 0; ct = layer == 0 ? e2 : 4 + e2; }
    } else {
      const int u = bid + it * nblk; if (u >= nunits) break;
      if (u < nlat) { rtile = 1 + u / 12; ct = u % 12; } else { rtile = 0; ct = layer == 0 ? (u - nlat) : (4 + u - nlat); }
    }
    const int m0 = rtile * 256, n0 = ct * 128;
    f32x16 acc[2][2];
#pragma unroll
    for (int a = 0; a < 2; ++a)
#pragma unroll
      for (int b = 0; b < 2; ++b) acc[a][b] = (f32x16){};
    gemm_mainloop<256, 128, 0, true>(lds, acc, [&](int row) { return H + (size_t)(m0 + row) * D; }, [&](int) { return W + n0; }, INW, D, bgdone, bgn, bgc0, bs0, bs1, bs2, bd0, bd1, bd2);
#pragma unroll
    for (int ti = 0; ti < 2; ++ti) {
      const int tok = m0 + wm * 64 + ti * 32 + r32;
      if (ct < 5) {
        float ss = 0.f;
#pragma unroll
        for (int ni = 0; ni < 2; ++ni)
#pragma unroll
          for (int r = 0; r < 16; ++r) ss += acc[ti][ni][r] * acc[ti][ni][r];
        ss = sum32(ss);
        const float rs = rsqrtf(ss * (1.f / 64.f) + EPS);
        const float* gain = (ct < 4 ? p.q_gain : p.k_gain) + layer * 64;
        const float osc = ct < 4 ? 0.125f * 1.4426950408889634f : 1.f;
        const bool lat = rtile > 0;
        const int t = tok - NCTX;
#pragma unroll
        for (int ni = 0; ni < 2; ++ni) {
          f32x16 v;
#pragma unroll
          for (int r = 0; r < 16; ++r) v[r] = acc[ti][ni][r] * rs * gain[ni * 32 + crow(r, hi)];
          if (lat) {
            const int pos = ni == 0 ? (t >> 6) : (t & 63);
#pragma unroll
            for (int r = 0; r < 8; ++r) {
              const int f = crow(r, hi);
              const float cs = rt[(pos * 16 + f) * 2], sn = rt[(pos * 16 + f) * 2 + 1];
              const float t1 = v[r], t2 = v[r + 8];
              v[r] = t1 * cs - t2 * sn; v[r + 8] = t2 * cs + t1 * sn;
            }
          }
#pragma unroll
          for (int r = 0; r < 16; ++r) v[r] *= osc;
          bf16_t* dst = ct < 4 ? Q + (size_t)tok * 512 + (ct * 2 + wn) * 64 + ni * 32 : Kb + (size_t)tok * 128 + wn * 64 + ni * 32;
          unsigned char* dst8 = ct < 4 ? Q8 + (size_t)tok * 512 + (ct * 2 + wn) * 64 + ni * 32 : K8 + (size_t)tok * 128 + wn * 64 + ni * 32;
#pragma unroll
          for (int g = 0; g < 4; ++g) { *(u32x2*)(dst + 8 * g + 4 * hi) = pack4(v, g); *(unsigned*)(dst8 + 8 * g + 4 * hi) = pack4_fp8(v, g); }
        }
      } else if (ct == 5) {
#pragma unroll
        for (int ni = 0; ni < 2; ++ni) {
#pragma unroll
          for (int g = 0; g < 4; ++g) *(u32x2*)(Vb + (size_t)tok * 128 + wn * 64 + ni * 32 + 8 * g + 4 * hi) = pack4(acc[ti][ni], g);
          float vmx = 0.f;
#pragma unroll
          for (int r = 0; r < 16; ++r) {
            const float vv = acc[ti][ni][r]; vmx = fmaxf(vmx, fabsf(vv));
            VT8[(size_t)(wn * 64 + ni * 32 + crow(r, hi)) * TT + tok] = (unsigned char)(__builtin_amdgcn_cvt_pk_fp8_f32(vv, vv, 0, false) & 0xff);
          }
          if (!(vmx <= 400.f)) atomicOr((int*)(p.ws + OFF_FLAG) + 1, 1);
        }
      } else if (ct < 8) {
#pragma unroll
        for (int ni = 0; ni < 2; ++ni)
#pragma unroll
          for (int g = 0; g < 4; ++g)
            *(f32x4*)(U + (size_t)tok * 256 + (ct - 6) * 128 + wn * 64 + ni * 32 + 8 * g + 4 * hi) =
                (f32x4){acc[ti][ni][4 * g], acc[ti][ni][4 * g + 1], acc[ti][ni][4 * g + 2], acc[ti][ni][4 * g + 3]};
      } else {
#pragma unroll
        for (int ni = 0; ni < 2; ++ni)
#pragma unroll
          for (int g = 0; g < 4; ++g) *(u32x2*)(AG + (size_t)tok * 512 + (ct - 8) * 128 + wn * 64 + ni * 32 + 8 * g + 4 * hi) = pack4(acc[ti][ni], g);
      }
    }
  }
  { const int tid = TIDX; while (bgdone < bgn) { f32x4 a, b2; const int i = bgdone++; BG_ISSUE(i, tid, a, b2); BG_RETIRE(i, tid, a, b2); } }
}

__device__ __forceinline__ void phase_c1(const Params& p, int layer, LAS char* lds, int bid, int nblk) {
  const bf16_t* A = (const bf16_t*)(p.ws + OFF_MIX);
  const bf16_t* W = (const bf16_t*)(p.ws + OFF_WOUT) + (size_t)layer * D * D;
  bf16_t* Y = (bf16_t*)(p.ws + OFF_Y);
  const int lane = TIDX & 63, wid = TIDX >> 6, r32 = lane & 31, hi = lane >> 5, wm = wid >> 1, wn = wid & 1;
  const int nctx = layer == 0 ? 8 : 0;
  const bool xmap = (nblk & 7) == 0;
  const int xcd = bid & 7, lb = bid >> 3, nlb = nblk >> 3, nl = lb < 64 ? (64 - lb + nlb - 1) / nlb : 0;
  for (int it = 0;; ++it) {
    int rtile, ct;
    if (xmap) {
      if (it < nl) { const int v = lb + it * nlb; rtile = 1 + xcd + 8 * (v >> 3); ct = v & 7; }
      else { const int e2 = bid + (it - nl) * nblk; if (e2 >= nctx) break; rtile = 0; ct = e2; }
    } else {
      const int u = bid + it * nblk; if (u >= 64 * 8 + nctx) break;
      if (u < 512) { rtile = 1 + (u >> 3); ct = u & 7; } else { rtile = 0; ct = u - 512; }
    }
    const int m0 = rtile * 256, n0 = ct * 128;
    f32x16 acc[2][2];
#pragma unroll
    for (int a = 0; a < 2; ++a)
#pragma unroll
      for (int b = 0; b < 2; ++b) acc[a][b] = (f32x16){};
    { int nd = 0; gemm_mainloop<256, 128, 0>(lds, acc, [&](int row) { return A + (size_t)(m0 + row) * D; }, [&](int) { return W + n0; }, D, D, nd); }
#pragma unroll
    for (int ti = 0; ti < 2; ++ti) {
      const int tok = m0 + wm * 64 + ti * 32 + r32;
#pragma unroll
      for (int ni = 0; ni < 2; ++ni)
#pragma unroll
        for (int g = 0; g < 4; ++g) *(u32x2*)(Y + (size_t)tok * D + n0 + wn * 64 + ni * 32 + 8 * g + 4 * hi) = pack4(acc[ti][ni], g);
    }
  }
}

#ifndef MOE_XCD_MAP
#define MOE_XCD_MAP 0
#endif
__device__ __forceinline__ void moe_prefix(const int* cnt, LAS int* pre, int xcd) {
  if (TIDX == 0) {
    int o = 0; for (int e = 0; e < NE; ++e) { pre[e] = o; o += (cnt[e * CNT_STRIDE] + 127) >> 7; } pre[NE] = o;
    int l = 0; for (int j = 0; j < 4; ++j) { pre[40 + j] = l; l += (cnt[(xcd + 8 * j) * CNT_STRIDE] + 127) >> 7; } pre[44] = l;
  }
  __syncthreads();
}
__device__ __forceinline__ bool moe_unit(const LAS int* pre, int bid, int nblk, int it, int& e, int& rt, int& ct, int& g) {
  if (MOE_XCD_MAP && (nblk & 7) == 0) {
    const int xcd = bid & 7, v = (bid >> 3) + it * (nblk >> 3), gl = v >> 2;
    if (gl >= pre[44]) return false;
    int j = 0; if (gl >= pre[41]) j = 1; if (gl >= pre[42]) j = 2; if (gl >= pre[43]) j = 3;
    e = xcd + 8 * j; rt = gl - pre[40 + j]; ct = v & 3; g = pre[e] + rt; return true;
  } else {
    const int u = bid + it * nblk; g = u >> 2; if (g >= pre[NE]) return false;
    int ee = 0; for (int i = 1; i < NE; ++i) ee += (pre[i] <= g) ? 1 : 0;
    e = ee; rt = g - pre[ee]; ct = u & 3; return true;
  }
}

__device__ __forceinline__ void phase_d1(const Params& p, int layer, LAS char* lds, int bid, int nblk) {
  const int* cnt = (const int*)(p.ws + OFF_CNT) + layer * NE * CNT_STRIDE;
  const bf16_t* H2 = (const bf16_t*)(p.ws + OFF_MIX);
  bf16_t* HM = (bf16_t*)(p.ws + OFF_HMID);
  LAS int* pre = (LAS int*)(lds + GEMM_LDS);
  moe_prefix(cnt, pre, bid & 7);
  const int lane = TIDX & 63, wid = TIDX >> 6, r32 = lane & 31, hi = lane >> 5, wm = wid >> 2, wn = wid & 3;
  for (int it = 0;; ++it) {
    int e, rt, ct, g; if (!moe_unit(pre, bid, nblk, it, e, rt, ct, g)) break;
    const int n = cnt[e * CNT_STRIDE];
    const int* list = (const int*)(p.ws + OFF_LIST) + (size_t)e * CAPL + rt * 128;
    const bf16_t* Wg = (const bf16_t*)(p.ws + OFF_WG) + ((size_t)layer * NE + e) * D * DE + ct * 128;
    const bf16_t* Wu = (const bf16_t*)(p.ws + OFF_WU) + ((size_t)layer * NE + e) * D * DE + ct * 128;
    const int nvalid = n - rt * 128;
    f32x16 acc[2][2];
#pragma unroll
    for (int a = 0; a < 2; ++a)
#pragma unroll
      for (int b = 0; b < 2; ++b) acc[a][b] = (f32x16){};
    int nd = 0;
    gemm_mainloop<128, 256, 2>(lds, acc, [&](int row) { const int tok = row < nvalid ? (list[row] >> 1) : 0; return H2 + (size_t)tok * D; },
                               [&](int s) { return s == 0 ? Wg : Wu; }, DE, D, nd);
    const size_t hrow0 = (size_t)(pre[e] + rt) * 128;
#pragma unroll
    for (int ti = 0; ti < 2; ++ti) {
      const size_t row = hrow0 + wm * 64 + ti * 32 + r32;
      f32x16 a;
#pragma unroll
      for (int r = 0; r < 16; ++r) { const float gv = acc[ti][0][r]; a[r] = gv / (1.f + __expf(-gv)) * acc[ti][1][r]; }
#pragma unroll
      for (int gq = 0; gq < 4; ++gq) *(u32x2*)(HM + row * DE + ct * 128 + wn * 32 + 8 * gq + 4 * hi) = pack4(a, gq);
    }
  }
}

__device__ __forceinline__ void phase_d2(const Params& p, int layer, LAS char* lds, int bid, int nblk) {
  const int* cnt = (const int*)(p.ws + OFF_CNT) + layer * NE * CNT_STRIDE;
  const bf16_t* HM = (const bf16_t*)(p.ws + OFF_HMID);
  const float* GATE = (const float*)(p.ws + OFF_GATE);
  bf16_t* OM = (bf16_t*)(p.ws + OFF_OMOE);
  LAS int* pre = (LAS int*)(lds + GEMM_LDS);
  moe_prefix(cnt, pre, bid & 7);
  const int lane = TIDX & 63, wid = TIDX >> 6, r32 = lane & 31, hi = lane >> 5, wm = wid >> 2, wn = wid & 3;
  for (int it = 0;; ++it) {
    int e, rt, ct, g; if (!moe_unit(pre, bid, nblk, it, e, rt, ct, g)) break;
    const int n = cnt[e * CNT_STRIDE];
    const int* list = (const int*)(p.ws + OFF_LIST) + (size_t)e * CAPL + rt * 128;
    const bf16_t* Wd = (const bf16_t*)(p.ws + OFF_WD) + ((size_t)layer * NE + e) * DE * D + ct * 256;
    const int nvalid = n - rt * 128;
    const bf16_t* A = HM + (size_t)g * 128 * DE;
    int ts2[2]; float gt2[2];
#pragma unroll
    for (int ti = 0; ti < 2; ++ti) { const int row = wm * 64 + ti * 32 + r32; ts2[ti] = row < nvalid ? list[row] : 0; }
#pragma unroll
    for (int ti = 0; ti < 2; ++ti) gt2[ti] = GATE[ts2[ti]];
    f32x16 acc[2][2];
#pragma unroll
    for (int a = 0; a < 2; ++a)
#pragma unroll
      for (int b = 0; b < 2; ++b) acc[a][b] = (f32x16){};
    { int nd = 0; gemm_mainloop<128, 256, 1>(lds, acc, [&](int row) { return A + (size_t)row * DE; }, [&](int s) { return Wd + s * 128; }, D, DE, nd); }
#pragma unroll
    for (int ti = 0; ti < 2; ++ti) {
      const int row = wm * 64 + ti * 32 + r32;
      if (row < nvalid) {
        const int ts = ts2[ti];
        const float gt = gt2[ti];
#pragma unroll
        for (int ni = 0; ni < 2; ++ni) {
          f32x16 a;
#pragma unroll
          for (int r = 0; r < 16; ++r) a[r] = acc[ti][ni][r] * gt;
#pragma unroll
          for (int gq = 0; gq < 4; ++gq) *(u32x2*)(OM + (size_t)ts * D + ct * 256 + wn * 64 + ni * 32 + 8 * gq + 4 * hi) = pack4(a, gq);
        }
      }
    }
  }
}

constexpr int ATT_SLOT = 16384, ATT_LDS = 4 * ATT_SLOT;
__device__ __forceinline__ int vst64(int k, int c) { const int kk = (k & ~0xC) | ((k & 4) << 1) | ((k & 8) >> 1); return ((kk >> 3) * 2 + (c >> 5)) * 512 + ((kk & 7) * 32 + (c & 31)) * 2; }
__device__ __forceinline__ bf16x8 tr_frag64(const LAS char* p) {
  s16x4 a = __builtin_amdgcn_ds_read_tr16_b64_v4i16((LAS s16x4*)p);
  s16x4 b = __builtin_amdgcn_ds_read_tr16_b64_v4i16((LAS s16x4*)(p + 1024));
  return (bf16x8){a[0], a[1], a[2], a[3], b[0], b[1], b[2], b[3]};
}
__device__ __forceinline__ bf16x8 pk4(const f32x16& P, int B) {
  unsigned a0 = cvtpk(P[B + 0], P[B + 1]), a1 = cvtpk(P[B + 2], P[B + 3]), b0 = cvtpk(P[B + 4], P[B + 5]), b1 = cvtpk(P[B + 6], P[B + 7]);
  auto r0 = __builtin_amdgcn_permlane32_swap(a0, b0, false, false); auto r1 = __builtin_amdgcn_permlane32_swap(a1, b1, false, false);
  u32x4 w = {r0[0], r1[0], r0[1], r1[1]};
  return __builtin_bit_cast(bf16x8, w);
}
struct AttnCtx { int krd0, krd1, ksw, hi, vrd; };
#define SBAR() __builtin_amdgcn_sched_barrier(0)
__device__ __forceinline__ void att_kload(const LAS char* slot, const AttnCtx& c, bf16x8 (&kf)[8]) {
#pragma unroll
  for (int d0 = 0; d0 < 4; ++d0) {
    kf[2 * d0] = *(const LAS bf16x8*)(slot + c.krd0 + (((2 * d0 + c.hi) ^ c.ksw) << 4));
    kf[2 * d0 + 1] = *(const LAS bf16x8*)(slot + c.krd1 + (((2 * d0 + c.hi) ^ c.ksw) << 4));
  }
}
__device__ __forceinline__ void att_qk(const bf16x8 (&kf)[8], const bf16x8 (&qr)[4], f32x16& s0, f32x16& s1) {
  s0 = (f32x16){}; s1 = (f32x16){};
#pragma unroll
  for (int d0 = 0; d0 < 4; ++d0) {
    s0 = __builtin_amdgcn_mfma_f32_32x32x16_bf16(kf[2 * d0], qr[d0], s0, 0, 0, 0);
    s1 = __builtin_amdgcn_mfma_f32_32x32x16_bf16(kf[2 * d0 + 1], qr[d0], s1, 0, 0, 0);
  }
}
__device__ __forceinline__ void att_exp(f32x16& s, float& l) {
#pragma unroll
  for (int r = 0; r < 16; ++r) { s[r] = __builtin_amdgcn_exp2f(s[r]); l += s[r]; }
  asm volatile("" : "+v"(l));
}
template <int KS0>
__device__ __forceinline__ void att_vload(const LAS char* slot, const AttnCtx& c, bf16x8 (&vf)[4]) {
#pragma unroll
  for (int i = 0; i < 2; ++i) { vf[2 * i] = tr_frag64(slot + c.vrd + (KS0 + i) * 2048); vf[2 * i + 1] = tr_frag64(slot + c.vrd + 512 + (KS0 + i) * 2048); }
}
__device__ __forceinline__ void att_pv2(const bf16x8& pa, const bf16x8& pb, const bf16x8 (&vf)[4], f32x16& o0, f32x16& o1) {
  o0 = __builtin_amdgcn_mfma_f32_32x32x16_bf16(pa, vf[0], o0, 0, 0, 0);
  o1 = __builtin_amdgcn_mfma_f32_32x32x16_bf16(pa, vf[1], o1, 0, 0, 0);
  o0 = __builtin_amdgcn_mfma_f32_32x32x16_bf16(pb, vf[2], o0, 0, 0, 0);
  o1 = __builtin_amdgcn_mfma_f32_32x32x16_bf16(pb, vf[3], o1, 0, 0, 0);
}
__device__ __forceinline__ void attn_unit(const Params& p, LAS char* lds, int row0, int hp, int nkeys) {
  const bf16_t* Q = (const bf16_t*)(p.ws + OFF_Q); const bf16_t* Kb = (const bf16_t*)(p.ws + OFF_K); const bf16_t* Vb = (const bf16_t*)(p.ws + OFF_V);
  bf16_t* MIX = (bf16_t*)(p.ws + OFF_MIX);
  const int tid = TIDX, wid = tid >> 6, lane = tid & 63, r32 = lane & 31, hi = lane >> 5, kvh = hp >> 1;
  bf16x8 qa[4], qb[4];
  { const bf16_t* Qg = Q + (size_t)(row0 + wid * 32 + r32) * 512 + hp * 128 + hi * 8;
#pragma unroll
    for (int d0 = 0; d0 < 4; ++d0) { qa[d0] = *(const bf16x8*)(Qg + d0 * 16); qb[d0] = *(const bf16x8*)(Qg + 64 + d0 * 16); } }
  const bf16_t* Kg = Kb + (size_t)(tid >> 3) * 128 + kvh * 64 + (tid & 7) * 8;
  const bf16_t* Vg = Vb + (size_t)(tid >> 3) * 128 + kvh * 64 + (tid & 7) * 8;
  const int kst = xoff(tid >> 3, tid & 7), vstw = 8192 + vst64(tid >> 3, (tid & 7) * 8);
  AttnCtx c; c.krd0 = r32 * 128; c.krd1 = (32 + r32) * 128; c.ksw = (r32 >> 1) & 7; c.hi = hi; c.vrd = 8192 + v_rd_base(lane);
  const int NT = nkeys >> 6;
  f32x16 oa0 = {}, oa1 = {}, ob0 = {}, ob1 = {}; float la = 0.f, lb = 0.f;
  u32x4 ks, vs;
  {
    const u32x4 k0 = *(const u32x4*)Kg, k1 = *(const u32x4*)(Kg + 64 * 128), v0 = *(const u32x4*)Vg, v1 = *(const u32x4*)(Vg + 64 * 128);
    *(LAS u32x4*)(lds + kst) = k0; *(LAS u32x4*)(lds + ATT_SLOT + kst) = k1;
    *(LAS u32x4*)(lds + vstw) = v0; *(LAS u32x4*)(lds + ATT_SLOT + vstw) = v1;
    ks = *(const u32x4*)(Kg + 2 * 64 * 128); vs = *(const u32x4*)(Vg + 2 * 64 * 128);
  }
  __syncthreads();
  for (int j = 0; j < NT; ++j) {
    const LAS char* sl = lds + (j & 3) * ATT_SLOT;
    bf16x8 kf[8], vfa[4], vfb[4];
    f32x16 sa0, sa1, sb0, sb1;
    att_kload(sl, c, kf);
    SBAR();
    att_qk(kf, qa, sa0, sa1);
    SBAR();
    att_qk(kf, qb, sb0, sb1);
    att_exp(sa0, la); att_exp(sa1, la);
    SBAR();
    const bf16x8 pa0 = pk4(sa0, 0), pa1 = pk4(sa0, 8), pa2 = pk4(sa1, 0), pa3 = pk4(sa1, 8);
    att_vload<0>(sl, c, vfa);
    SBAR();
    att_pv2(pa0, pa1, vfa, oa0, oa1);
    att_exp(sb0, lb);
    att_vload<2>(sl, c, vfb);
    SBAR();
    att_pv2(pa2, pa3, vfb, oa0, oa1);
    att_exp(sb1, lb);
    const bf16x8 pb0 = pk4(sb0, 0), pb1 = pk4(sb0, 8), pb2 = pk4(sb1, 0), pb3 = pk4(sb1, 8);
    att_vload<0>(sl, c, vfa);
    SBAR();
    att_pv2(pb0, pb1, vfa, ob0, ob1);
    att_vload<2>(sl, c, vfb);
    SBAR();
    att_pv2(pb2, pb3, vfb, ob0, ob1);
    { LAS char* w = lds + ((j + 2) & 3) * ATT_SLOT;
      if (j + 2 < NT) { *(LAS u32x4*)(w + kst) = ks; *(LAS u32x4*)(w + vstw) = vs; }
      if (j + 3 < NT) { ks = *(const u32x4*)(Kg + (size_t)(j + 3) * 64 * 128); vs = *(const u32x4*)(Vg + (size_t)(j + 3) * 64 * 128); } }
    __syncthreads();
  }
  la = sum32(la); lb = sum32(lb);
  LAS float* li = (LAS float*)(lds + wid * 256);
  if (hi == 0) { li[r32] = la; li[32 + r32] = lb; }
  __syncthreads();
  bf16_t* Og = MIX + (size_t)(row0 + wid * 32) * D + hp * 128 + r32;
#pragma unroll
  for (int r = 0; r < 16; ++r) {
    const int orow = crow(r, hi);
    const float ra = __builtin_amdgcn_rcpf(li[orow]), rb = __builtin_amdgcn_rcpf(li[32 + orow]);
    Og[(size_t)orow * D] = f2bf(oa0[r] * ra); Og[(size_t)orow * D + 32] = f2bf(oa1[r] * ra);
    Og[(size_t)orow * D + 64] = f2bf(ob0[r] * rb); Og[(size_t)orow * D + 96] = f2bf(ob1[r] * rb);
  }
  __syncthreads();
}
typedef int i32x8 __attribute__((ext_vector_type(8)));
constexpr int A8_SLOT = 8192, A8_LDS = 4 * A8_SLOT;
__device__ __forceinline__ int off8(int row, int chunk) { return row * 64 + ((chunk ^ ((row >> 2) & 3)) << 4); }
__device__ __forceinline__ i32x8 ld_frag8(const LAS char* tile, int row, int h) {
  const int sw = (row >> 2) & 3;
  const u32x4 lo = *(const LAS u32x4*)(tile + row * 64 + (((2 * h) ^ sw) << 4)), hi = *(const LAS u32x4*)(tile + row * 64 + (((2 * h + 1) ^ sw) << 4));
  return (i32x8){(int)lo[0], (int)lo[1], (int)lo[2], (int)lo[3], (int)hi[0], (int)hi[1], (int)hi[2], (int)hi[3]};
}
#define MX_FP8_FP8(a, b, c) __builtin_amdgcn_mfma_scale_f32_32x32x64_f8f6f4(a, b, c, 0, 0, 0, 0x7f7f7f7f, 0, 0x7f7f7f7f)
#define MX_BF8_FP8(a, b, c) __builtin_amdgcn_mfma_scale_f32_32x32x64_f8f6f4(a, b, c, 1, 0, 0, 0x7f7f7f7f, 0, 0x7f7f7f7f)
typedef _Float16 f16x2 __attribute__((ext_vector_type(2)));
__device__ __forceinline__ unsigned att8_code4(float s0, float s1, float s2, float s3) {
  const f16x2 four = {(_Float16)4.f, (_Float16)4.f}, bias = {(_Float16)1084.f, (_Float16)1084.f};
  const f16x2 x = __builtin_bit_cast(f16x2, __builtin_amdgcn_cvt_pkrtz(s0, s1)) * four + bias, y = __builtin_bit_cast(f16x2, __builtin_amdgcn_cvt_pkrtz(s2, s3)) * four + bias;
  return __builtin_amdgcn_perm(__builtin_bit_cast(unsigned, y), __builtin_bit_cast(unsigned, x), 0x06040200u);
}
__device__ __forceinline__ i32x8 att8_pack(const f32x16& p0, const f32x16& p1) {
  i32x8 w;
#pragma unroll
  for (int i = 0; i < 4; ++i) {
    const unsigned d = att8_code4(p0[4 * i], p0[4 * i + 1], p0[4 * i + 2], p0[4 * i + 3]), e = att8_code4(p1[4 * i], p1[4 * i + 1], p1[4 * i + 2], p1[4 * i + 3]);
    auto r = __builtin_amdgcn_permlane32_swap(d, e, false, false);
    w[2 * i] = (int)r[0]; w[2 * i + 1] = (int)r[1];
  }
  return w;
}
__device__ __forceinline__ void attn_unit8(const Params& p, LAS char* lds, int row0, int hp, int nkeys, bf16_t* MIXP = nullptr) {
  const unsigned char* Q8 = (const unsigned char*)(p.ws + OFF_Q8); const unsigned char* K8 = (const unsigned char*)(p.ws + OFF_K8); const unsigned char* VT8 = (const unsigned char*)(p.ws + OFF_VT8);
  bf16_t* MIX = MIXP ? MIXP : (bf16_t*)(p.ws + OFF_MIX);
  const int tid = TIDX, wid = tid >> 6, lane = tid & 63, r32 = lane & 31, hi = lane >> 5, kvh = hp >> 1;
  i32x8 qa, qb;
  { const unsigned char* Qg = Q8 + (size_t)(row0 + wid * 32 + r32) * 512 + hp * 128 + hi * 32;
    const u32x4 a0 = *(const u32x4*)Qg, a1 = *(const u32x4*)(Qg + 16), b0 = *(const u32x4*)(Qg + 64), b1 = *(const u32x4*)(Qg + 80);
    qa = (i32x8){(int)a0[0], (int)a0[1], (int)a0[2], (int)a0[3], (int)a1[0], (int)a1[1], (int)a1[2], (int)a1[3]};
    qb = (i32x8){(int)b0[0], (int)b0[1], (int)b0[2], (int)b0[3], (int)b1[0], (int)b1[1], (int)b1[2], (int)b1[3]}; }
  const int su = tid & 255, srow = su >> 2, sch = su & 3;
  const unsigned char* Sg = tid < 256 ? K8 + (size_t)srow * 128 + kvh * 64 + sch * 16 : VT8 + (size_t)(kvh * 64 + srow) * TT + sch * 16;
  const size_t sstep = tid < 256 ? (size_t)64 * 128 : (size_t)64;
  const int sst = (tid < 256 ? 0 : 4096) + off8(srow, sch);
  const int NT = nkeys >> 6;
  f32x16 oa0 = {}, oa1 = {}, ob0 = {}, ob1 = {}, ola = {}, olb = {};
  const i32x8 ones = {0x38383838, 0x38383838, 0x38383838, 0x38383838, 0x38383838, 0x38383838, 0x38383838, 0x38383838};
  u32x4 sv;
  { const u32x4 t0 = *(const u32x4*)Sg, t1 = *(const u32x4*)(Sg + sstep);
    *(LAS u32x4*)(lds + sst) = t0; *(LAS u32x4*)(lds + A8_SLOT + sst) = t1;
    sv = *(const u32x4*)(Sg + 2 * sstep); }
  __syncthreads();
  for (int j = 0; j < NT; ++j) {
    const LAS char* sl = lds + (j & 3) * A8_SLOT;
    f32x16 sa0 = {}, sa1 = {}, sb0 = {}, sb1 = {};
    const i32x8 kf0 = ld_frag8(sl, r32, hi), kf1 = ld_frag8(sl, 32 + r32, hi);
    SBAR();
    sa0 = MX_FP8_FP8(kf0, qa, sa0); sa1 = MX_FP8_FP8(kf1, qa, sa1);
    SBAR();
    sb0 = MX_FP8_FP8(kf0, qb, sb0); sb1 = MX_FP8_FP8(kf1, qb, sb1);
    SBAR();
    const i32x8 pa = att8_pack(sa0, sa1);
    const i32x8 vf0 = ld_frag8(sl + 4096, r32, hi), vf1 = ld_frag8(sl + 4096, 32 + r32, hi);
    SBAR();
    oa0 = MX_BF8_FP8(pa, vf0, oa0); oa1 = MX_BF8_FP8(pa, vf1, oa1); ola = MX_BF8_FP8(pa, ones, ola);
    const i32x8 pb = att8_pack(sb0, sb1);
    SBAR();
    ob0 = MX_BF8_FP8(pb, vf0, ob0); ob1 = MX_BF8_FP8(pb, vf1, ob1); olb = MX_BF8_FP8(pb, ones, olb);
    { LAS char* w = lds + ((j + 2) & 3) * A8_SLOT;
      if (j + 2 < NT) *(LAS u32x4*)(w + sst) = sv;
      if (j + 3 < NT) sv = *(const u32x4*)(Sg + (size_t)(j + 3) * sstep); }
    __syncthreads();
  }
  bf16_t* Og = MIX + (size_t)(row0 + wid * 32) * D + hp * 128 + r32;
#pragma unroll
  for (int r = 0; r < 16; ++r) {
    const int orow = crow(r, hi);
    const float ra = __builtin_amdgcn_rcpf(ola[r]), rb = __builtin_amdgcn_rcpf(olb[r]);
    Og[(size_t)orow * D] = f2bf(oa0[r] * ra); Og[(size_t)orow * D + 32] = f2bf(oa1[r] * ra);
    Og[(size_t)orow * D + 64] = f2bf(ob0[r] * rb); Og[(size_t)orow * D + 96] = f2bf(ob1[r] * rb);
  }
  __syncthreads();
}
__device__ __forceinline__ void attn_fallback(const Params& p, int layer, int bid, int nblk) {
  const bf16_t* Q = (const bf16_t*)(p.ws + OFF_Q); const bf16_t* Kb = (const bf16_t*)(p.ws + OFF_K); const bf16_t* Vb = (const bf16_t*)(p.ws + OFF_V);
  bf16_t* MIX = (bf16_t*)(p.ws + OFF_MIX);
  const int lane = TIDX & 63, nwv = nblk * 8;
  const int rg0 = layer == 0 ? 0 : NCTX / 64;
  for (int wv = bid * 8 + (TIDX >> 6) + rg0 * 8; wv < (TT / 64) * 8; wv += nwv) {
    const int head = wv & 7, r = (wv >> 3) * 64 + lane, kvh = head >> 2;
    float q[64], o[64];
#pragma unroll
    for (int d = 0; d < 64; ++d) { q[d] = bf2f(Q[(size_t)r * 512 + head * 64 + d]); o[d] = 0.f; }
    float m = -1e30f, l = 0.f;
    const int nk = r >= NCTX ? TT : NCTX;
    for (int j = 0; j < nk; ++j) {
      const bf16_t* kr = Kb + (size_t)j * 128 + kvh * 64;
      const bf16_t* vr = Vb + (size_t)j * 128 + kvh * 64;
      float s = 0.f;
#pragma unroll
      for (int d = 0; d < 64; ++d) s += q[d] * bf2f(kr[d]);
      if (s > m) {
        const float a = __builtin_amdgcn_exp2f(m - s);
        l *= a;
#pragma unroll
        for (int d = 0; d < 64; ++d) o[d] *= a;
        m = s;
      }
      const float pe = __builtin_amdgcn_exp2f(s - m);
      l += pe;
#pragma unroll
      for (int d = 0; d < 64; ++d) o[d] += pe * bf2f(vr[d]);
    }
    const float il = 1.f / l;
#pragma unroll
    for (int d = 0; d < 64; ++d) MIX[(size_t)r * D + head * 64 + d] = f2bf(o[d] * il);
  }
}

constexpr int PC_U = 0;
constexpr int PC_Y = 49152;
constexpr int PC_P = PC_Y + 65536;
constexpr int PC_LDS = PC_P + 32768;
__device__ __forceinline__ void poolconv_unit(const Params& p, int layer, LAS char* lds, int tile) {
  const int tid = TIDX, wid = tid >> 6, lane = tid & 63, r32 = lane & 31, hi = lane >> 5;
  const int t0 = tile * 64, base = tile < 4 ? 0 : NCTX, n = tile < 4 ? NCTX : SEQ;
  const bf16_t* AG = (const bf16_t*)(p.ws + OFF_AG);
  const float* U = (const float*)(p.ws + OFF_U);
  bf16_t* MIX = (bf16_t*)(p.ws + OFF_MIX);
#pragma unroll
  for (int h = 0; h < 2; ++h) {
    u32x4 av[3], gv[3]; bool in[3];
#pragma unroll
    for (int q = 0; q < 3; ++q) {
      const int idx = tid + (h * 3 + q) * 512, rr = idx >> 5, ch = (idx & 31) * 8, t = t0 - 15 + rr;
      in[q] = idx < 94 * 32 && t >= base && t < base + n;
      const size_t off = (size_t)(in[q] ? t : t0) * 512 + ch;
      av[q] = *(const u32x4*)(AG + off); gv[q] = *(const u32x4*)(AG + off + 256);
    }
#pragma unroll
    for (int q = 0; q < 3; ++q) {
      const int idx = tid + (h * 3 + q) * 512, rr = idx >> 5, ch = (idx & 31) * 8;
      u32x4 out = {0u, 0u, 0u, 0u};
      if (in[q]) {
#pragma unroll
        for (int i = 0; i < 4; ++i) {
          const float a0 = __uint_as_float(av[q][i] << 16), a1 = __uint_as_float(av[q][i] & 0xffff0000u);
          const float g0 = __uint_as_float(gv[q][i] << 16), g1 = __uint_as_float(gv[q][i] & 0xffff0000u);
          out[i] = cvtpk(a0 / (1.f + __expf(-g0)), a1 / (1.f + __expf(-g1)));
        }
      }
      if (idx < 94 * 32) *(LAS u32x4*)(lds + PC_U + (rr * 256 + ch) * 2) = out;
    }
  }
  __syncthreads();
  {
    const int c = tid & 255, th = tid >> 8;
    float w[31];
#pragma unroll
    for (int j = 0; j < 31; ++j) w[j] = p.w_dw[(size_t)layer * 31 * 256 + j * 256 + c];
    const float b = p.b_dw[layer * 256 + c];
    float acc[32];
#pragma unroll
    for (int i = 0; i < 32; ++i) acc[i] = b;
    const LAS bf16_t* up = (const LAS bf16_t*)(lds + PC_U) + (th * 32) * 256 + c;
#pragma unroll
    for (int rr = 0; rr < 62; ++rr) {
      const float uv = bf2f(up[rr * 256]);
#pragma unroll
      for (int i = 0; i < 32; ++i) if (rr - i >= 0 && rr - i < 31) acc[i] += uv * w[rr - i];
    }
    LAS float* yp = (LAS float*)(lds + PC_Y) + (th * 32) * 256 + c;
#pragma unroll
    for (int i = 0; i < 32; ++i) yp[i * 256] = acc[i];
  }
  {
    const int c = tid & 255, th = tid >> 8, grp = c >> 6, w = 2 << grp, hw = w >> 1;
    const int tl0 = t0 - base + th * 32;
    float uv[48];
#pragma unroll
    for (int i = 0; i < 48; ++i) { const int j = tl0 - 8 + i; const bool in = j >= 0 && j < n; uv[i] = in ? U[(size_t)(base + j) * 256 + c] : 0.f; }
#pragma unroll
    for (int i = 0; i < 32; ++i) {
      const int tl = tl0 + i, lo = max(tl - hw, 0), hh = min(tl + hw, n);
      float s = 0.f;
#pragma unroll
      for (int d = -8; d < 8; ++d) if (d >= -hw && d < hw) s += uv[8 + i + d];
      const float pv = s / (float)(hh - lo) - uv[8 + i];
      const int tok = th * 32 + i, chunk = c >> 3, sw = (chunk & 16) | ((chunk ^ tok) & 15);
      *(LAS bf16_t*)(lds + PC_P + tok * 512 + sw * 16 + (c & 7) * 2) = f2bf(pv);
    }
  }
  __syncthreads();
  {
    const f32x4 g4 = *(const f32x4*)(p.cv_ln_g + layer * 256 + lane * 4), b4 = *(const f32x4*)(p.cv_ln_b + layer * 256 + lane * 4);
#pragma unroll
    for (int i = 0; i < 8; ++i) {
      const int tok = wid * 8 + i;
      const f32x4 y = *(const LAS f32x4*)(lds + PC_Y + (tok * 256 + lane * 4) * 4);
      const float mu = wave_sum(y[0] + y[1] + y[2] + y[3]) * (1.f / 256.f);
      const float d0 = y[0] - mu, d1 = y[1] - mu, d2 = y[2] - mu, d3 = y[3] - mu;
      const float rs = rsqrtf(wave_sum(d0 * d0 + d1 * d1 + d2 * d2 + d3 * d3) * (1.f / 256.f) + EPS);
      const float z0 = silu(d0 * rs * g4[0] + b4[0]), z1 = silu(d1 * rs * g4[1] + b4[1]), z2 = silu(d2 * rs * g4[2] + b4[2]), z3 = silu(d3 * rs * g4[3] + b4[3]);
      const int chunk = lane >> 1, sw = (chunk & 16) | ((chunk ^ tok) & 15);
      *(LAS u32x2*)(lds + PC_U + tok * 512 + sw * 16 + (lane & 1) * 8) = (u32x2){cvtpk(z0, z1), cvtpk(z2, z3)};
    }
  }
  __syncthreads();
  {
    const int tb = wid >> 2, dg = wid & 3, trow = tb * 32 + r32, t = t0 + trow;
    const bf16_t* Wt = (const bf16_t*)(p.ws + OFF_WPWT) + ((size_t)layer * 256 + dg * 64 + r32) * 256 + hi * 8;
    f32x16 acc0 = {}, acc1 = {};
#pragma unroll 8
    for (int ks = 0; ks < 16; ++ks) {
      const int chunk = 2 * ks + hi, sw = (chunk & 16) | ((chunk ^ trow) & 15);
      const bf16x8 zf = *(const LAS bf16x8*)(lds + PC_U + trow * 512 + sw * 16);
      const bf16x8 w0 = *(const bf16x8*)(Wt + ks * 16), w1 = *(const bf16x8*)(Wt + 32 * 256 + ks * 16);
      acc0 = __builtin_amdgcn_mfma_f32_32x32x16_bf16(w0, zf, acc0, 0, 0, 0);
      acc1 = __builtin_amdgcn_mfma_f32_32x32x16_bf16(w1, zf, acc1, 0, 0, 0);
    }
    bf16_t* dst = MIX + (size_t)t * D + 768 + dg * 64;
#pragma unroll
    for (int g = 0; g < 4; ++g) { *(u32x2*)(dst + 8 * g + 4 * hi) = pack4(acc0, g); *(u32x2*)(dst + 32 + 8 * g + 4 * hi) = pack4(acc1, g); }
    const bf16_t* Pt = (const bf16_t*)(p.ws + OFF_WPOOLT) + ((size_t)(layer * 4 + dg) * 64 + r32) * 64 + hi * 8;
    f32x16 pc0 = {}, pc1 = {};
#pragma unroll
    for (int ks = 0; ks < 4; ++ks) {
      const int chunk = dg * 8 + 2 * ks + hi, sw = (chunk & 16) | ((chunk ^ trow) & 15);
      const bf16x8 pf = *(const LAS bf16x8*)(lds + PC_P + trow * 512 + sw * 16);
      const bf16x8 w0 = *(const bf16x8*)(Pt + ks * 16), w1 = *(const bf16x8*)(Pt + 32 * 64 + ks * 16);
      pc0 = __builtin_amdgcn_mfma_f32_32x32x16_bf16(w0, pf, pc0, 0, 0, 0);
      pc1 = __builtin_amdgcn_mfma_f32_32x32x16_bf16(w1, pf, pc1, 0, 0, 0);
    }
    const float* psc = p.pool_scale + layer * 256 + dg * 64;
#pragma unroll
    for (int r = 0; r < 16; ++r) { pc0[r] *= psc[crow(r, hi)]; pc1[r] *= psc[32 + crow(r, hi)]; }
    bf16_t* pd = MIX + (size_t)t * D + 512 + dg * 64;
#pragma unroll
    for (int g = 0; g < 4; ++g) { *(u32x2*)(pd + 8 * g + 4 * hi) = pack4(pc0, g); *(u32x2*)(pd + 32 + 8 * g + 4 * hi) = pack4(pc1, g); }
  }
  __syncthreads();
}

__device__ __forceinline__ void phase_b(const Params& p, int layer, LAS char* lds, int bid, int nblk) {
  const int mode0 = ((const int*)(p.ws + OFF_FLAG))[0], vbig = ((const int*)(p.ws + OFF_FLAG))[1];
  const int mode = (mode0 == 2 && vbig != 0) ? 1 : mode0;
  const bool fast = mode != 0;
  const int nu = (520 - bid + nblk - 1) / nblk;
  for (int i = 0; i < nu; ++i) {
    const int u = bid + ((bid & 1) ? (nu - 1 - i) : i) * nblk;
    if (u < 256) { if (mode == 2) attn_unit8(p, lds, NCTX + (u >> 2) * 256, u & 3, TT); else if (mode == 1) attn_unit(p, lds, NCTX + (u >> 2) * 256, u & 3, TT); }
    else if (u < 260) { if (layer == 0) { if (mode == 2) attn_unit8(p, lds, 0, u - 256, NCTX); else if (mode == 1) attn_unit(p, lds, 0, u - 256, NCTX); } }
    else { const int tile = u - 260; if (layer == 0 || tile >= 4) poolconv_unit(p, layer, lds, tile); }
  }
  if (!fast) attn_fallback(p, layer, bid, nblk);
}

constexpr int NR = 2, NRA = 2;
__device__ __forceinline__ float hsum4(const f32x4 (&v)[4]) { float s = 0.f;
#pragma unroll
  for (int i = 0; i < 4; ++i) s += (v[i][0] + v[i][1]) + (v[i][2] + v[i][3]);
  return s; }
__device__ __forceinline__ float hsq4(const f32x4 (&v)[4], float mu) { float q = 0.f;
#pragma unroll
  for (int i = 0; i < 4; ++i) { const f32x4 d = v[i] - mu; q += (d[0] * d[0] + d[1] * d[1]) + (d[2] * d[2] + d[3] * d[3]); }
  return q; }
__device__ __forceinline__ f32x4 bf4(u32x2 w) { return (f32x4){__uint_as_float(w[0] << 16), __uint_as_float(w[0] & 0xffff0000u), __uint_as_float(w[1] << 16), __uint_as_float(w[1] & 0xffff0000u)}; }

__device__ __forceinline__ void phase_a0(const Params& p, int layer, int bid, int nblk) {
  const int wave = bid * 8 + (TIDX >> 6), lane = TIDX & 63, nw = nblk * 8;
  float* X = (float*)(p.ws + OFF_X);
  bf16_t* H = (bf16_t*)(p.ws + OFF_H);
  const bf16_t* OM = (const bf16_t*)(p.ws + OFF_OMOE);
  for (int rb = wave * NRA; rb < TT; rb += nw * NRA) {
    f32x4 v[NRA][4]; u32x2 oa[NRA][4], ob[NRA][4];
#pragma unroll
    for (int k = 0; k < NRA; ++k) {
      const int r = rb + k;
      const float* src = layer == 0 ? (r < NCTX ? p.ctx + (size_t)r * D : p.x + (size_t)(r - NCTX) * D) : X + (size_t)r * D;
#pragma unroll
      for (int i = 0; i < 4; ++i) { const int c = i * 256 + lane * 4; v[k][i] = *(const f32x4*)(src + c);
        if (layer != 0) { oa[k][i] = *(const u32x2*)(OM + ((size_t)r * 2 + 0) * D + c); ob[k][i] = *(const u32x2*)(OM + ((size_t)r * 2 + 1) * D + c); } }
    }
    if (layer != 0) {
#pragma unroll
      for (int k = 0; k < NRA; ++k) {
        const int r = rb + k, s = r < NCTX ? 1 : 0;
        const float* g2 = (const float*)(p.ws + OFF_MOD) + ((layer - 1) * 2 + s) * 6144 + 5 * D;
#pragma unroll
        for (int i = 0; i < 4; ++i) { const int c = i * 256 + lane * 4; v[k][i] = v[k][i] * ALPHA + *(const f32x4*)(g2 + c) * (bf4(oa[k][i]) + bf4(ob[k][i])); }
      }
      float mu[NRA], rs[NRA];
#pragma unroll
      for (int k = 0; k < NRA; ++k) mu[k] = wave_sum(hsum4(v[k])) * (1.f / D);
#pragma unroll
      for (int k = 0; k < NRA; ++k) rs[k] = rsqrtf(wave_sum(hsq4(v[k], mu[k])) * (1.f / D) + EPS);
      const float* g = p.ln2_g + (layer - 1) * D; const float* b = p.ln2_b + (layer - 1) * D;
#pragma unroll
      for (int k = 0; k < NRA; ++k)
#pragma unroll
        for (int i = 0; i < 4; ++i) { const int c = i * 256 + lane * 4; v[k][i] = (v[k][i] - mu[k]) * rs[k] * *(const f32x4*)(g + c) + *(const f32x4*)(b + c); *(f32x4*)(X + (size_t)(rb + k) * D + c) = v[k][i]; }
    }
    float mu[NRA], rs[NRA];
#pragma unroll
    for (int k = 0; k < NRA; ++k) mu[k] = wave_sum(hsum4(v[k])) * (1.f / D);
#pragma unroll
    for (int k = 0; k < NRA; ++k) rs[k] = rsqrtf(wave_sum(hsq4(v[k], mu[k])) * (1.f / D) + EPS);
#pragma unroll
    for (int k = 0; k < NRA; ++k) {
      const int r = rb + k, s = r < NCTX ? 1 : 0;
      const float* modp = (const float*)(p.ws + OFF_MOD) + (layer * 2 + s) * 6144;
#pragma unroll
      for (int i = 0; i < 4; ++i) {
        const int c = i * 256 + lane * 4;
        const f32x4 h = (v[k][i] - mu[k]) * rs[k] * (*(const f32x4*)(modp + D + c) + 1.f) + *(const f32x4*)(modp + c);
        *(u32x2*)(H + (size_t)r * D + c) = (u32x2){cvtpk(h[0], h[1]), cvtpk(h[2], h[3])};
      }
    }
  }
}

__device__ __forceinline__ void phase_c2(const Params& p, int layer, LAS char* lds, int bid, int nblk) {
  const int tid = TIDX, wid = tid >> 6, lane = tid & 63;
  float* X = (float*)(p.ws + OFF_X);
  const bf16_t* Y = (const bf16_t*)(p.ws + OFF_Y);
  bf16_t* H2 = (bf16_t*)(p.ws + OFF_MIX);
  int* cnt = (int*)(p.ws + OFF_CNT) + layer * NE * CNT_STRIDE;
  float* GATE = (float*)(p.ws + OFF_GATE); int* LIST = (int*)(p.ws + OFF_LIST);
  LAS int* lcnt = (LAS int*)lds;
  LAS int* lbase = lcnt + 32;
  LAS int* ent = lcnt + 64;
  if (tid < 32) lcnt[tid] = 0;
  LAS float* wre = (LAS float*)(lds + 4096);
#pragma unroll
  for (int kk = 0; kk < 2; ++kk) {
    const int k = tid + kk * 512;
    f32x4 w[8];
#pragma unroll
    for (int g = 0; g < 8; ++g) w[g] = *(const f32x4*)(p.w_re + ((size_t)layer * D + k) * 32 + g * 4);
#pragma unroll
    for (int g = 0; g < 8; ++g)
#pragma unroll
      for (int j = 0; j < 4; ++j) wre[(g * 4 + j) * 1024 + k] = w[g][j];
  }
  __syncthreads();
  const int r0 = layer == 0 ? 0 : NCTX, nrows = TT - r0, rpb = (nrows + nblk - 1) / nblk;
  const int rbeg = r0 + bid * rpb, rend = min(rbeg + rpb, TT);
  for (int rb = rbeg + wid * NR; rb < rend; rb += 8 * NR) {
    f32x4 v[NR][4]; u32x2 yv[NR][4]; int rr[NR]; bool ok[NR];
#pragma unroll
    for (int k = 0; k < NR; ++k) {
      ok[k] = rb + k < rend; rr[k] = ok[k] ? rb + k : rb;
      const int r = rr[k];
      const float* xin = layer == 0 ? (r < NCTX ? p.ctx + (size_t)r * D : p.x + (size_t)(r - NCTX) * D) : X + (size_t)r * D;
#pragma unroll
      for (int i = 0; i < 4; ++i) { const int c = i * 256 + lane * 4; v[k][i] = *(const f32x4*)(xin + c); yv[k][i] = *(const u32x2*)(Y + (size_t)r * D + c); }
    }
#pragma unroll
    for (int k = 0; k < NR; ++k) {
      const float* modp = (const float*)(p.ws + OFF_MOD) + (layer * 2 + (rr[k] < NCTX ? 1 : 0)) * 6144;
#pragma unroll
      for (int i = 0; i < 4; ++i) { const int c = i * 256 + lane * 4; v[k][i] = v[k][i] * ALPHA + *(const f32x4*)(modp + 2 * D + c) * bf4(yv[k][i]); }
    }
    float mu[NR], rs[NR];
#pragma unroll
    for (int k = 0; k < NR; ++k) mu[k] = wave_sum(hsum4(v[k])) * (1.f / D);
#pragma unroll
    for (int k = 0; k < NR; ++k) rs[k] = rsqrtf(wave_sum(hsq4(v[k], mu[k])) * (1.f / D) + EPS);
#pragma unroll
    for (int k = 0; k < NR; ++k)
#pragma unroll
      for (int i = 0; i < 4; ++i) {
        const int c = i * 256 + lane * 4;
        v[k][i] = (v[k][i] - mu[k]) * rs[k] * *(const f32x4*)(p.ln1_g + layer * D + c) + *(const f32x4*)(p.ln1_b + layer * D + c);
        if (ok[k]) *(f32x4*)(X + (size_t)rr[k] * D + c) = v[k][i];
      }
#pragma unroll
    for (int k = 0; k < NR; ++k) mu[k] = wave_sum(hsum4(v[k])) * (1.f / D);
#pragma unroll
    for (int k = 0; k < NR; ++k) rs[k] = rsqrtf(wave_sum(hsq4(v[k], mu[k])) * (1.f / D) + EPS);
#pragma unroll
    for (int k = 0; k < NR; ++k) {
      const float* modp = (const float*)(p.ws + OFF_MOD) + (layer * 2 + (rr[k] < NCTX ? 1 : 0)) * 6144;
#pragma unroll
      for (int i = 0; i < 4; ++i) {
        const int c = i * 256 + lane * 4;
        v[k][i] = (v[k][i] - mu[k]) * rs[k] * (*(const f32x4*)(modp + 4 * D + c) + 1.f) + *(const f32x4*)(modp + 3 * D + c);
        if (ok[k]) *(u32x2*)(H2 + (size_t)rr[k] * D + c) = (u32x2){cvtpk(v[k][i][0], v[k][i][1]), cvtpk(v[k][i][2], v[k][i][3])};
      }
    }
    f32x4 lg[NR];
#pragma unroll
    for (int k = 0; k < NR; ++k) lg[k] = (f32x4){0.f, 0.f, 0.f, 0.f};
#pragma unroll
    for (int i = 0; i < 4; ++i)
#pragma unroll
      for (int j = 0; j < 4; ++j) { const f32x4 w = *(const f32x4*)(p.w_rg + ((size_t)layer * D + i * 256 + lane * 4 + j) * 4);
#pragma unroll
        for (int k = 0; k < NR; ++k) lg[k] += w * v[k][i][j]; }
    int gsel[NR]; float pgrp[NR];
#pragma unroll
    for (int k = 0; k < NR; ++k) {
      float l0 = wave_sum(lg[k][0]) + p.b_rg[layer * 4 + 0], l1 = wave_sum(lg[k][1]) + p.b_rg[layer * 4 + 1];
      float l2 = wave_sum(lg[k][2]) + p.b_rg[layer * 4 + 2], l3 = wave_sum(lg[k][3]) + p.b_rg[layer * 4 + 3];
      int gs = 0; float gm = l0;
      if (l1 > gm) { gm = l1; gs = 1; }
      if (l2 > gm) { gm = l2; gs = 2; }
      if (l3 > gm) { gm = l3; gs = 3; }
      gsel[k] = gs; pgrp[k] = 1.f / (__expf(l0 - gm) + __expf(l1 - gm) + __expf(l2 - gm) + __expf(l3 - gm));
    }
#pragma unroll
    for (int k = 0; k < NR; ++k) {
      float le[8];
#pragma unroll
      for (int e = 0; e < 8; ++e) {
        const LAS float* wr = wre + (gsel[k] * 8 + e) * 1024 + lane * 4;
        float a = 0.f;
#pragma unroll
        for (int i = 0; i < 4; ++i) { const f32x4 w = *(const LAS f32x4*)(wr + i * 256); a += (w[0] * v[k][i][0] + w[1] * v[k][i][1]) + (w[2] * v[k][i][2] + w[3] * v[k][i][3]); }
        le[e] = a;
      }
#pragma unroll
      for (int e = 0; e < 8; ++e) le[e] = wave_sum(le[e]) + p.b_re[layer * 32 + gsel[k] * 8 + e];
      int i0 = 0; float v0 = le[0];
#pragma unroll
      for (int e = 1; e < 8; ++e) if (le[e] > v0) { v0 = le[e]; i0 = e; }
      int i1 = -1; float v1 = -3.0e38f;
#pragma unroll
      for (int e = 0; e < 8; ++e) if (e != i0 && le[e] > v1) { v1 = le[e]; i1 = e; }
      if (i1 < 0) { i1 = (i0 + 1) & 7; v1 = v0; }
      const float e1 = __expf(v1 - v0);
      if (lane == 0 && ok[k]) {
        const int r = rr[k], xa = gsel[k] * 8 + i0, xb = gsel[k] * 8 + i1;
        const int pa = __hip_atomic_fetch_add(&lcnt[xa], 1, __ATOMIC_RELAXED, __HIP_MEMORY_SCOPE_WORKGROUP);
        const int pb = __hip_atomic_fetch_add(&lcnt[xb], 1, __ATOMIC_RELAXED, __HIP_MEMORY_SCOPE_WORKGROUP);
        const int li = (r - rbeg) * 2;
        ent[li * 3 + 0] = xa; ent[li * 3 + 1] = pa; ent[li * 3 + 2] = r * 2 + 0;
        ent[li * 3 + 3] = xb; ent[li * 3 + 4] = pb; ent[li * 3 + 5] = r * 2 + 1;
        GATE[r * 2] = pgrp[k] / (1.f + e1); GATE[r * 2 + 1] = pgrp[k] * e1 / (1.f + e1);
      }
    }
  }
  __syncthreads();
  if (tid < 32) { const int c = lcnt[tid]; lbase[tid] = c > 0 ? atomicAdd(&cnt[tid * CNT_STRIDE], c) : 0; }
  __syncthreads();
  for (int i = tid; i < (rend - rbeg) * 2; i += 512) { const int e = ent[i * 3], lp = ent[i * 3 + 1]; LIST[(size_t)e * CAPL + lbase[e] + lp] = ent[i * 3 + 2]; }
  __syncthreads();
}

__device__ __forceinline__ void phase_final(const Params& p, int bid, int nblk) {
  const int wave = bid * 8 + (TIDX >> 6), lane = TIDX & 63, nw = nblk * 8;
  const float* X = (const float*)(p.ws + OFF_X);
  const bf16_t* OM = (const bf16_t*)(p.ws + OFF_OMOE);
  const float* g2 = (const float*)(p.ws + OFF_MOD) + (1 * 2 + 0) * 6144 + 5 * D;
  for (int rb = NCTX + wave * NRA; rb < TT; rb += nw * NRA) {
    f32x4 v[NRA][4]; u32x2 oa[NRA][4], ob[NRA][4];
#pragma unroll
    for (int k = 0; k < NRA; ++k)
#pragma unroll
      for (int i = 0; i < 4; ++i) { const int c = i * 256 + lane * 4, r = rb + k;
        v[k][i] = *(const f32x4*)(X + (size_t)r * D + c); oa[k][i] = *(const u32x2*)(OM + ((size_t)r * 2 + 0) * D + c); ob[k][i] = *(const u32x2*)(OM + ((size_t)r * 2 + 1) * D + c); }
#pragma unroll
    for (int k = 0; k < NRA; ++k)
#pragma unroll
      for (int i = 0; i < 4; ++i) { const int c = i * 256 + lane * 4; v[k][i] = v[k][i] * ALPHA + *(const f32x4*)(g2 + c) * (bf4(oa[k][i]) + bf4(ob[k][i])); }
    float mu[NRA], rs[NRA];
#pragma unroll
    for (int k = 0; k < NRA; ++k) mu[k] = wave_sum(hsum4(v[k])) * (1.f / D);
#pragma unroll
    for (int k = 0; k < NRA; ++k) rs[k] = rsqrtf(wave_sum(hsq4(v[k], mu[k])) * (1.f / D) + EPS);
#pragma unroll
    for (int k = 0; k < NRA; ++k)
#pragma unroll
      for (int i = 0; i < 4; ++i) {
        const int c = i * 256 + lane * 4;
        *(f32x4*)(p.out + (size_t)(rb + k - NCTX) * D + c) = (v[k][i] - mu[k]) * rs[k] * *(const f32x4*)(p.ln2_g + D + c) + *(const f32x4*)(p.ln2_b + D + c);
      }
  }
}

__device__ __forceinline__ void phase_p0(const Params& p, LAS char* lds, int bid, int nblk) {
  const int tid = TIDX;
  const long gtid = (long)bid * 512 + tid, gth = (long)nblk * 512;
  LAS float* sc = (LAS float*)lds;
  LAS float* red = (LAS float*)(lds + 8192);
  for (int i = tid; i < 2048; i += 512) { const float v = i < 1024 ? p.c[i] : p.c_ctx[i - 1024]; sc[i] = silu(v); }
  __syncthreads();
  float* mod = (float*)(p.ws + OFF_MOD);
  for (int u = bid; u < 384; u += nblk) {
    const int layer = u / 192, cg = u % 192, col = tid & 31, ksl = tid >> 5;
    const float* w = p.w_mod + ((size_t)layer * D + ksl * 64) * 6144 + cg * 32 + col;
    float a0 = 0.f, a1 = 0.f;
#pragma unroll 8
    for (int k = 0; k < 64; ++k) { const float wv = w[(size_t)k * 6144]; a0 += sc[ksl * 64 + k] * wv; a1 += sc[1024 + ksl * 64 + k] * wv; }
    red[(ksl * 32 + col) * 2] = a0; red[(ksl * 32 + col) * 2 + 1] = a1;
    __syncthreads();
    if (tid < 64) {
      const int c2 = tid & 31, s = tid >> 5; float a = 0.f;
#pragma unroll
      for (int k = 0; k < 16; ++k) a += red[(k * 32 + c2) * 2 + s];
      mod[(layer * 2 + s) * 6144 + cg * 32 + c2] = a + p.b_mod[layer * 6144 + cg * 32 + c2];
    }
    __syncthreads();
  }
  if (gtid < 256 * 16) {
    const int pos = (int)gtid / 16, f = (int)gtid % 16;
    const float ang = (float)pos * powf(10000.f, -(float)f / 16.f);
    float* rt = (float*)(p.ws + OFF_ROPE);
    rt[gtid * 2 + 0] = cosf(ang); rt[gtid * 2 + 1] = sinf(ang);
  }
  if (gtid < 2 * NE * CNT_STRIDE) ((int*)(p.ws + OFF_CNT))[gtid] = 0;
  if (gtid == 0) {
    float bmax = 0.f;
    for (int l = 0; l < 2; ++l) {
      float gq = 0.f, gk = 0.f;
      for (int i = 0; i < 64; ++i) { gq = fmaxf(gq, fabsf(p.q_gain[l * 64 + i])); gk = fmaxf(gk, fabsf(p.k_gain[l * 64 + i])); }
      bmax = fmaxf(bmax, 11.55f * gq * gk);
    }
    ((int*)(p.ws + OFF_FLAG))[0] = bmax <= 13.2f ? 2 : (bmax <= 100.f ? 1 : 0);
    ((int*)(p.ws + OFF_FLAG))[1] = 0;
  }
  for (long i = gtid; i < 2 * 65536; i += gth) { const int l = (int)(i >> 16), d = (int)(i >> 8) & 255, c = (int)i & 255; ((bf16_t*)(p.ws + OFF_WPWT))[i] = f2bf(p.w_cv_pw[((size_t)l * 256 + c) * 256 + d]); }
  for (long i = gtid; i < 8 * 4096; i += gth) { const int lg = (int)(i >> 12), d = (int)(i >> 6) & 63, c = (int)i & 63; ((bf16_t*)(p.ws + OFF_WPOOLT))[i] = f2bf(p.w_pool[((size_t)lg * 64 + c) * 64 + d]); }
  cvt_range(p.w_in, (bf16_t*)(p.ws + OFF_WIN), 2L * D * INW / 8, gtid, gth);
  cvt_range(p.w_out, (bf16_t*)(p.ws + OFF_WOUT), 2L * D * D / 8, gtid, gth);
}
#define XB_TMO      128
#define XB_XCNT(j)  (256  + 64 * (j))
#define XB_XSUB(j)  (1280 + 64 * (j))
#define XB_XGEN(j)  (2304 + 64 * (j))
#define XB_TOP      3328
#define XB_TOPGEN   3392
#define XCD_BAR_WORDS 3456
#define XB_SPIN_CAP (1u << 22)
__device__ __forceinline__ unsigned xb_ld(unsigned* p)              { return __hip_atomic_load(p, __ATOMIC_RELAXED, __HIP_MEMORY_SCOPE_AGENT); }
__device__ __forceinline__ unsigned xb_add(unsigned* p, unsigned v) { return __hip_atomic_fetch_add(p, v, __ATOMIC_RELAXED, __HIP_MEMORY_SCOPE_AGENT); }
__device__ __forceinline__ unsigned xb_xcc_id() { return (unsigned)__builtin_amdgcn_s_getreg((3 << 11) | 20) & 0xFu; }
#define XB_SPIN(cond, bar) do { unsigned _sp = 0; while (cond) { __builtin_amdgcn_s_sleep(1); \
    if ((++_sp & 255u) == 0u) { if (xb_ld(&(bar)[XB_TMO])) break; if (_sp > XB_SPIN_CAP) { atomicAdd(&(bar)[XB_TMO], 1u); break; } } } } while (0)
struct XcdBarrier { unsigned* bar; unsigned x; volatile LAS unsigned* st; };
__device__ __forceinline__ XcdBarrier xcd_barrier_post(unsigned* bar, volatile LAS unsigned* st) {
  XcdBarrier b; b.bar = bar; b.x = xb_xcc_id(); b.st = st;
  if (threadIdx.x == 0) (void)xb_add(&bar[XB_XCNT(b.x)], 1u);
  return b;
}
__device__ __forceinline__ void xcd_barrier_complete(unsigned* bar, unsigned x, unsigned& nloc, unsigned& nx) {
  const unsigned G = gridDim.x * gridDim.y * gridDim.z;
  unsigned sum, cnt, mine, sp = 0u;
  for (;;) {
    sum = 0u; cnt = 0u; mine = 0u;
#pragma unroll
    for (unsigned j = 0; j < 16; ++j) { const unsigned c = xb_ld(&bar[XB_XCNT(j)]); sum += c; cnt += (c > 0u) ? 1u : 0u; mine = (j == x) ? c : mine; }
    if (sum == G) break;
    __builtin_amdgcn_s_sleep(1);
    if ((++sp & 255u) == 0u) { if (xb_ld(&bar[XB_TMO])) break; if (sp > XB_SPIN_CAP) { atomicAdd(&bar[XB_TMO], 1u); break; } }
  }
  nloc = mine > 0u ? mine : 1u; nx = cnt > 0u ? cnt : 1u;
}
__device__ __forceinline__ void xcd_barrier(const XcdBarrier& b) {
  asm volatile("s_waitcnt vmcnt(0)" ::: "memory");
  __syncthreads();
  if (threadIdx.x == 0) {
    unsigned* bar = b.bar; unsigned bx = b.x;
    asm volatile("" : "+s"(bar), "+s"(bx));
    __builtin_amdgcn_s_waitcnt(0);
    unsigned nloc = b.st[0], nx = b.st[1];
    if (nloc == 0u) { xcd_barrier_complete(bar, bx, nloc, nx); b.st[0] = nloc; b.st[1] = nx; }
    const unsigned old = xb_add(&bar[XB_XSUB(bx)], 1u);
    const unsigned gen = old / nloc;
    if (old + 1u == (gen + 1u) * nloc) {
      __builtin_amdgcn_fence(__ATOMIC_RELEASE, "agent");
      asm volatile("s_waitcnt vmcnt(0)" ::: "memory");
      const unsigned og = xb_add(&bar[XB_TOP], 1u);
      const unsigned tg = og / nx;
      if (og + 1u == (tg + 1u) * nx) xb_add(&bar[XB_TOPGEN], 1u);
      else XB_SPIN(xb_ld(&bar[XB_TOPGEN]) == tg, bar);
      __builtin_amdgcn_fence(__ATOMIC_ACQUIRE, "agent");
      xb_add(&bar[XB_XGEN(bx)], 1u);
      asm volatile("s_waitcnt vmcnt(0)" ::: "memory");
    } else {
      XB_SPIN(xb_ld(&bar[XB_XGEN(bx)]) == gen, bar);
      __builtin_amdgcn_fence(__ATOMIC_ACQUIRE, "agent");
      asm volatile("s_waitcnt vmcnt(0)" ::: "memory");
    }
  }
  __syncthreads();
}

constexpr int LDS_MAIN = PC_LDS > GEMM_LDS + 256 ? PC_LDS : GEMM_LDS + 256;
constexpr int LDS_TOTAL = LDS_MAIN + 16;
static_assert(GEMM_LDS + 256 <= LDS_MAIN && ATT_LDS <= LDS_MAIN, "lds");
__global__ void __launch_bounds__(512) mega_fwd(Params p) {
  __shared__ __attribute__((aligned(16))) char slds[LDS_TOTAL];
  LAS char* lds = (LAS char*)slds;
  volatile LAS unsigned* st = (volatile LAS unsigned*)(lds + LDS_MAIN);
  if (threadIdx.x < 4) st[threadIdx.x] = 0u;
  __syncthreads();
  const XcdBarrier bar = xcd_barrier_post((unsigned*)(p.ws + OFF_BAR), st);
  const int bid = blockIdx.x, nblk = gridDim.x;
  phase_p0(p, lds, bid, nblk);
  xcd_barrier(bar);
#pragma unroll 1
  for (int layer = 0; layer < 2; ++layer) {
    phase_a0(p, layer, bid, nblk);
    xcd_barrier(bar);
    phase_a1(p, layer, lds, bid, nblk);
    xcd_barrier(bar);
    phase_b(p, layer, lds, bid, nblk);
    xcd_barrier(bar);
    phase_c1(p, layer, lds, bid, nblk);
    xcd_barrier(bar);
    phase_c2(p, layer, lds, bid, nblk);
    xcd_barrier(bar);
    phase_d1(p, layer, lds, bid, nblk);
    xcd_barrier(bar);
    phase_d2(p, layer, lds, bid, nblk);
    xcd_barrier(bar);
  }
  phase_final(p, bid, nblk);
}

extern "C" void kernel_launch(void* const* d_in, const int* in_sizes, int n_in, void* d_out, int out_size, void* d_ws, size_t ws_size,
                              hipStream_t stream) {
  static int grid = 0;
  if (grid == 0) {
    if (ws_size < WS_END || n_in != 28) { fprintf(stderr, "kernel_launch: ws too small (%zu < %zu) or n_in %d != 28; nothing launched\n", ws_size, (size_t)WS_END, n_in); grid = -1; return; }
    int dev = 0, cus = 0, per_cu = 0;
    if (hipGetDevice(&dev) != hipSuccess || hipDeviceGetAttribute(&cus, hipDeviceAttributeMultiprocessorCount, dev) != hipSuccess) { grid = -1; return; }
    if (hipOccupancyMaxActiveBlocksPerMultiprocessor(&per_cu, (const void*)mega_fwd, 512, 0) != hipSuccess || per_cu < 1) {
      fprintf(stderr, "kernel_launch: occupancy query says %d blocks per CU; nothing launched\n", per_cu); grid = -1; return; }
    (void)hipGetLastError();
    grid = cus;
  }
  if (grid < 0) return;
  if (hipMemsetAsync((char*)d_ws + OFF_BAR, 0, BAR_BYTES, stream) != hipSuccess) { fprintf(stderr, "kernel_launch: memset failed\n"); return; }
  Params p{};
  const float** f = (const float**)&p;
  for (int i = 0; i < 28; ++i) f[i] = (const float*)d_in[i];
  p.out = (float*)d_out; p.ws = (char*)d_ws;
  hipLaunchKernelGGL(mega_fwd, dim3(grid), dim3(512), 0, stream, p);
}
```

```cpp
#include <hip/hip_runtime.h>
#include <cstdio>
#include <cstdint>

typedef unsigned short bf16_t;
#define LAS __attribute__((address_space(3)))

constexpr int D = 1024, SEQ = 16384, NCTX = 256, TT = SEQ + NCTX;
constexpr int INW = 1536;
constexpr int NE = 32, DE = 512;
constexpr int CAPL = 2 * TT;
constexpr int HMID_ROWS = 2 * TT + NE * 128;
constexpr float ALPHA = 1.41421356237309515f;
constexpr float EPS = 1e-6f;

constexpr size_t al(size_t x) { return (x + 255) / 256 * 256; }
constexpr size_t OFF_BAR = 0;
constexpr size_t BAR_BYTES = 3456 * 4;
constexpr size_t OFF_MOD = OFF_BAR + al(BAR_BYTES);
constexpr size_t OFF_ROPE = OFF_MOD + al(2 * 2 * 6144 * 4);
constexpr int CNT_STRIDE = 32;
constexpr size_t OFF_CNT = OFF_ROPE + al(256 * 16 * 2 * 4);
constexpr size_t OFF_FLAG = OFF_CNT + al(2 * 32 * 32 * 4);
constexpr size_t OFF_X = OFF_FLAG + 256;
constexpr size_t OFF_H = OFF_X + al((size_t)TT * D * 4);
constexpr size_t OFF_MIX = OFF_H + al((size_t)TT * D * 2);
constexpr size_t OFF_Y = OFF_MIX + al((size_t)TT * D * 2);
constexpr size_t OFF_Q = OFF_Y + al((size_t)TT * D * 2);
constexpr size_t OFF_K = OFF_Q + al((size_t)TT * 512 * 2);
constexpr size_t OFF_V = OFF_K + al((size_t)TT * 128 * 2);
constexpr size_t OFF_U = OFF_V + al((size_t)TT * 128 * 2);
constexpr size_t OFF_AG = OFF_U + al((size_t)TT * 256 * 4);
constexpr size_t OFF_HMID = OFF_Q;
constexpr size_t OFF_OMOE = OFF_AG + al((size_t)TT * 512 * 2);
constexpr size_t OFF_GATE = OFF_OMOE + al((size_t)TT * 2 * D * 2);
constexpr size_t OFF_LIST = OFF_GATE + al((size_t)TT * 2 * 4);
constexpr size_t OFF_WIN = OFF_LIST + al((size_t)NE * CAPL * 4);
constexpr size_t OFF_WOUT = OFF_WIN + al((size_t)2 * D * INW * 2);
constexpr size_t OFF_WPWT = OFF_WOUT + al((size_t)2 * D * D * 2);
constexpr size_t OFF_WPOOLT = OFF_WPWT + al((size_t)2 * 256 * 256 * 2);
constexpr size_t OFF_Q8 = OFF_WPOOLT + al((size_t)2 * 4 * 64 * 64 * 2);
constexpr size_t OFF_K8 = OFF_Q8 + al((size_t)TT * 512);
constexpr size_t OFF_VT8 = OFF_K8 + al((size_t)TT * 128);
constexpr size_t OFF_WG = OFF_VT8 + al((size_t)128 * TT);
constexpr size_t OFF_WU = OFF_WG + al((size_t)2 * NE * D * DE * 2);
constexpr size_t OFF_WD = OFF_WU + al((size_t)2 * NE * D * DE * 2);
constexpr size_t WS_END = OFF_WD + al((size_t)2 * NE * D * DE * 2);
static_assert(OFF_AG - OFF_HMID >= (size_t)HMID_ROWS * DE * 2, "HMID alias too small");
static_assert(WS_END < 530000000, "ws budget");

struct Params {
  const float *x, *c, *ctx, *c_ctx, *w_mod, *b_mod, *w_in, *q_gain, *k_gain, *w_pool, *pool_scale, *w_dw, *b_dw,
      *cv_ln_g, *cv_ln_b, *w_cv_pw, *w_out, *ln1_g, *ln1_b, *ln2_g, *ln2_b, *w_rg, *b_rg, *w_re, *b_re, *w_e_gate, *w_e_up, *w_e_down;
  float* out;
  char* ws;
};

__device__ __forceinline__ float bf2f(bf16_t v) { return __uint_as_float(((unsigned)v) << 16); }
__device__ __forceinline__ bf16_t f2bf(float f) {
  unsigned u = __float_as_uint(f);
  u += 0x7fffu + ((u >> 16) & 1u);
  return (bf16_t)(u >> 16);
}
template <int CTRL> __device__ __forceinline__ float dppf(float v) { return __int_as_float(__builtin_amdgcn_update_dpp(0, __float_as_int(v), CTRL, 0xf, 0xf, true)); }
__device__ __forceinline__ float wave_sum(float v) {
  v += dppf<0xB1>(v); v += dppf<0x4E>(v); v += dppf<0x141>(v); v += dppf<0x140>(v);
  { auto r = __builtin_amdgcn_permlane16_swap(__float_as_uint(v), __float_as_uint(v), false, false); v = __uint_as_float(r[0]) + __uint_as_float(r[1]); }
  { auto r = __builtin_amdgcn_permlane32_swap(__float_as_uint(v), __float_as_uint(v), false, false); v = __uint_as_float(r[0]) + __uint_as_float(r[1]); }
  return v;
}
__device__ __forceinline__ float silu(float v) { return v / (1.f + __expf(-v)); }
__device__ __forceinline__ int opaque0() { int z; asm volatile("s_mov_b32 %0, 0" : "=s"(z)); return z; }
#define TIDX ((int)threadIdx.x + opaque0())
using bf16x8 = __attribute__((ext_vector_type(8))) short;
using s16x4 = __attribute__((ext_vector_type(4))) short;
using f32x16 = __attribute__((ext_vector_type(16))) float;
using f32x4 = __attribute__((ext_vector_type(4))) float;
using u32x4 = __attribute__((ext_vector_type(4))) unsigned;
using u32x2 = __attribute__((ext_vector_type(2))) unsigned;

__device__ __forceinline__ int crow(int r, int hi) { return (r & 3) + 8 * (r >> 2) + 4 * hi; }
typedef float f32x2 __attribute__((ext_vector_type(2)));
typedef __bf16 bf16x2v __attribute__((ext_vector_type(2)));
__device__ __forceinline__ unsigned cvtpk(float lo, float hi) {
  bf16x2v b = __builtin_convertvector((f32x2){lo, hi}, bf16x2v);
  return __builtin_bit_cast(unsigned, b);
}
__device__ __forceinline__ float sum32(float v) {
  auto rr = __builtin_amdgcn_permlane32_swap(__float_as_uint(v), __float_as_uint(v), false, false);
  return __uint_as_float(rr[0]) + __uint_as_float(rr[1]);
}

__device__ __forceinline__ void cvt_range(const float* __restrict__ src, bf16_t* __restrict__ dst, long n8, long gtid, long gthreads) {
  for (long i = gtid; i < n8; i += gthreads) {
    const f32x4 a = *(const f32x4*)(src + i * 8), b = *(const f32x4*)(src + i * 8 + 4);
    u32x4 w = {cvtpk(a[0], a[1]), cvtpk(a[2], a[3]), cvtpk(b[0], b[1]), cvtpk(b[2], b[3])};
    *(u32x4*)(dst + i * 8) = w;
  }
}

__device__ __forceinline__ int xoff(int row, int chunk) { return row * 128 + ((chunk ^ ((row >> 1) & 7)) << 4); }
__device__ __forceinline__ int wst(int k, int c) { const int kk = (k & ~0xC) | ((k & 4) << 1) | ((k & 8) >> 1); return ((kk >> 3) * 4 + (c >> 5)) * 512 + ((kk & 7) * 32 + (c & 31)) * 2; }
__device__ __forceinline__ int v_rd_base(int lane) { return ((lane & 3) << 3) | (((lane >> 2) & 3) << 6) | (((lane >> 4) & 1) << 5) | (((lane >> 5) & 1) << 8); }

__device__ __forceinline__ bf16x8 tr_frag(const LAS char* p) {
  s16x4 a = __builtin_amdgcn_ds_read_tr16_b64_v4i16((LAS s16x4*)p);
  s16x4 b = __builtin_amdgcn_ds_read_tr16_b64_v4i16((LAS s16x4*)(p + 2048));
  return (bf16x8){a[0], a[1], a[2], a[3], b[0], b[1], b[2], b[3]};
}

template <int OFF> __device__ __forceinline__ bf16x8 tr_frag_asm(int addr) {
  s16x4 a, b;
  asm volatile("ds_read_b64_tr_b16 %0, %1 offset:%2" : "=&v"(a) : "v"(addr), "i"(OFF) : "memory");
  asm volatile("ds_read_b64_tr_b16 %0, %1 offset:%2" : "=&v"(b) : "v"(addr), "i"(OFF + 2048) : "memory");
  return (bf16x8){a[0], a[1], a[2], a[3], b[0], b[1], b[2], b[3]};
}

template <int BM, int BN> struct GemmCfg {
  static constexpr int WM = BM / 64, WN = 8 / WM, NSLAB = BN / 128, XB = BM * 128, WB = NSLAB * 16384, STAGE = XB + WB, NXP = BM / 64, NWP = NSLAB * 2;
  static_assert(WM * WN == 8 && WN * 64 == BN, "tile");
};
constexpr int GEMM_LDS = 3 * (256 * 128 + 16384);

template <int BM, int BN, int NMAP, bool BG = false, class XRow, class WPtr>
__device__ __forceinline__ void gemm_mainloop(LAS char* lds, f32x16 (&acc)[2][2], const XRow& xrow, const WPtr& wptr, int ldw, int K, int& bgdone, int bgn = 0, long bgc0 = 0,
                                              const float* bs0 = nullptr, const float* bs1 = nullptr, const float* bs2 = nullptr, bf16_t* bd0 = nullptr, bf16_t* bd1 = nullptr, bf16_t* bd2 = nullptr) {
#define BG_ADDR(i, off, SP, DP) long c_ = bgc0 + (long)(i) * 512 + (off); const bool ok_ = c_ < (3L << 21); if (!ok_) c_ = 0; const int t_ = (int)(c_ >> 21); const long o_ = (c_ & 0x1fffff) * 8; \
    const float* SP = (t_ == 0 ? bs0 : (t_ == 1 ? bs1 : bs2)) + o_; bf16_t* DP = (t_ == 0 ? bd0 : (t_ == 1 ? bd1 : bd2)) + o_
#define BG_ISSUE(i, off, a, b) do { BG_ADDR(i, off, sp_, dp_); (void)dp_; a = *(const f32x4*)sp_; b = *(const f32x4*)(sp_ + 4); } while (0)
#define BG_RETIRE(i, off, a, b) do { BG_ADDR(i, off, sp_, dp_); (void)sp_; if (ok_) *(u32x4*)dp_ = (u32x4){cvtpk(a[0], a[1]), cvtpk(a[2], a[3]), cvtpk(b[0], b[1]), cvtpk(b[2], b[3])}; } while (0)
#define BGA_ISSUE(i, off, a, b) do { BG_ADDR(i, off, sp_, dp_); (void)dp_; \
    asm volatile("global_load_dwordx4 %0, %2, off\n\tglobal_load_dwordx4 %1, %2, off offset:16" : "=&v"(a), "=&v"(b) : "v"(sp_) : "memory"); } while (0)
#define BGA_RETIRE(i, off, a, b) do { BG_ADDR(i, off, sp_, dp_); (void)sp_; const u32x4 w_ = {cvtpk(a[0], a[1]), cvtpk(a[2], a[3]), cvtpk(b[0], b[1]), cvtpk(b[2], b[3])}; \
    if (ok_) asm volatile("global_store_dwordx4 %0, %1, off" :: "v"(dp_), "v"(w_) : "memory"); } while (0)
  using C = GemmCfg<BM, BN>;
  const int tid = TIDX, wid = __builtin_amdgcn_readfirstlane(tid >> 6), lane = tid & 63, r32 = lane & 31, hi = lane >> 5;
  const int wm = wid / C::WN, wn = wid % C::WN;
  const bf16_t *g0, *g1, *g2, *g3, *g4, *g5, *g6 = nullptr, *g7 = nullptr, *g8 = nullptr, *g9 = nullptr, *g10 = nullptr, *g11 = nullptr;
  int l0, l1, l2, l3, l4, l5, l6 = 0, l7 = 0, l8 = 0, l9 = 0, l10 = 0, l11 = 0;
  auto xpieceq = [&](int q, const bf16_t*& gp, int& lp) { const int row = 8 * q + (lane >> 3), c = (lane & 7) ^ ((row >> 1) & 7); gp = xrow(row) + c * 8; lp = q * 1024; };
  auto wpieceq = [&](int idx, const bf16_t*& gp, int& lp) {
    const int s = idx >> 4, q = idx & 15, sub = 2 * q + (lane >> 5), kk = (sub >> 2) * 8 + ((lane & 31) >> 2);
    const int k = (kk & ~0xC) | ((kk & 4) << 1) | ((kk & 8) >> 1), c = (sub & 3) * 32 + (lane & 3) * 8;
    gp = wptr(s) + (size_t)k * ldw + c; lp = C::XB + s * 16384 + q * 1024; };
  const size_t stepx = 64, stepw = (size_t)64 * ldw;
  if (BG) {
    const int w4 = wid & 3;
    xpieceq(w4 * 8 + 0, g0, l0); xpieceq(w4 * 8 + 1, g1, l1); xpieceq(w4 * 8 + 2, g2, l2); xpieceq(w4 * 8 + 3, g3, l3);
    xpieceq(w4 * 8 + 4, g4, l4); xpieceq(w4 * 8 + 5, g5, l5); xpieceq(w4 * 8 + 6, g6, l6); xpieceq(w4 * 8 + 7, g7, l7);
    wpieceq(w4 * 4 + 0, g8, l8); wpieceq(w4 * 4 + 1, g9, l9); wpieceq(w4 * 4 + 2, g10, l10); wpieceq(w4 * 4 + 3, g11, l11);
  } else if (C::NXP == 4) { xpieceq(wid * 4 + 0, g0, l0); xpieceq(wid * 4 + 1, g1, l1); xpieceq(wid * 4 + 2, g2, l2); xpieceq(wid * 4 + 3, g3, l3); wpieceq(wid * 2 + 0, g4, l4); wpieceq(wid * 2 + 1, g5, l5); }
  else { xpieceq(wid * 2 + 0, g0, l0); xpieceq(wid * 2 + 1, g1, l1); wpieceq(wid * 4 + 0, g2, l2); wpieceq(wid * 4 + 1, g3, l3); wpieceq(wid * 4 + 2, g4, l4); wpieceq(wid * 4 + 3, g5, l5); }
  const size_t stp0 = stepx, stp1 = stepx, stp2 = (BG || C::NXP == 4) ? stepx : stepw, stp3 = (BG || C::NXP == 4) ? stepx : stepw, stp4 = BG ? stepx : stepw, stp5 = BG ? stepx : stepw;
  const bool dmaw = !BG || wid < 4;
  int xr[2];
#pragma unroll
  for (int ti = 0; ti < 2; ++ti) xr[ti] = (wm * 64 + ti * 32 + r32) * 128;
  const int xsw = (r32 >> 1) & 7;
  int wr[2];
#pragma unroll
  for (int ni = 0; ni < 2; ++ni) {
    const int slab = NMAP == 0 ? 0 : (NMAP == 1 ? (wn >> 1) : ni);
    const int nb = NMAP == 0 ? (2 * wn + ni) : (NMAP == 1 ? ((wn & 1) * 2 + ni) : wn);
    wr[ni] = C::XB + slab * 16384 + nb * 512 + v_rd_base(lane);
  }
  const int nk = K / 64;
#define G_DMA1(gp, sp, lp, kt, _d) __builtin_amdgcn_global_load_lds((const unsigned*)((gp) + (size_t)(kt) * (sp)), (LAS unsigned*)((_d) + (lp)), 16, 0, 0)
#define G_DMA(kt, st) do { if (dmaw) { LAS char* _d = lds + (st) * C::STAGE; \
    G_DMA1(g0, stp0, l0, kt, _d); G_DMA1(g1, stp1, l1, kt, _d); G_DMA1(g2, stp2, l2, kt, _d); G_DMA1(g3, stp3, l3, kt, _d); G_DMA1(g4, stp4, l4, kt, _d); G_DMA1(g5, stp5, l5, kt, _d); \
    if (BG) { G_DMA1(g6, stepx, l6, kt, _d); G_DMA1(g7, stepx, l7, kt, _d); G_DMA1(g8, stepw, l8, kt, _d); G_DMA1(g9, stepw, l9, kt, _d); G_DMA1(g10, stepw, l10, kt, _d); G_DMA1(g11, stepw, l11, kt, _d); } } } while (0)
#define G_HALF(cur, wa0, wa1, H) do { bf16x8 xf[2][2], wf[2][2]; \
      _Pragma("unroll") for (int k2 = 0; k2 < 2; ++k2) _Pragma("unroll") for (int ti = 0; ti < 2; ++ti) xf[k2][ti] = *(const LAS bf16x8*)(cur + xr[ti] + ((((H * 2 + k2) * 2 + hi) ^ xsw) << 4)); \
      wf[0][0] = tr_frag_asm<(H * 2 + 0) * 4096>(wa0); wf[0][1] = tr_frag_asm<(H * 2 + 0) * 4096>(wa1); \
      wf[1][0] = tr_frag_asm<(H * 2 + 1) * 4096>(wa0); wf[1][1] = tr_frag_asm<(H * 2 + 1) * 4096>(wa1); \
      asm volatile("s_waitcnt lgkmcnt(0)" ::: "memory"); __builtin_amdgcn_sched_barrier(0); \
      _Pragma("unroll") for (int k2 = 0; k2 < 2; ++k2) _Pragma("unroll") for (int ti = 0; ti < 2; ++ti) _Pragma("unroll") for (int ni = 0; ni < 2; ++ni) \
        acc[ti][ni] = __builtin_amdgcn_mfma_f32_32x32x16_bf16(wf[k2][ni], xf[k2][ti], acc[ti][ni], 0, 0, 0); } while (0)
#define G_COMPUTE(st) do { const LAS char* cur = lds + (st) * C::STAGE; const int wa0 = (int)(uintptr_t)(cur + wr[0]), wa1 = (int)(uintptr_t)(cur + wr[1]); \
    G_HALF(cur, wa0, wa1, 0); G_HALF(cur, wa0, wa1, 1); } while (0)
  static_assert(C::NXP + C::NWP == 6 && (!BG || (C::NXP == 4 && C::NWP == 2)), "piece counts assumed by the vmcnt waits");
  G_DMA(0, 0); G_DMA(1, 1);
  f32x4 b0a, b0b, b0c, b0d, b1a, b1b, b1c, b1d, b2a, b2b, b2c, b2d; int bi0 = -1, bi1 = -1, bi2 = -1;
  const int bgoff = tid - 256;
#define BG_SLOT(bi, xa, xb, xc, xd) do { if (bi >= 0) { asm volatile("s_waitcnt vmcnt(8)" ::: "memory");     \
      BGA_RETIRE(bi, bgoff, xa, xb); BGA_RETIRE(bi, bgoff + 256, xc, xd); bi = -1; } \
    if (bgdone < bgn) { bi = bgdone; BGA_ISSUE(bi, bgoff, xa, xb); BGA_ISSUE(bi, bgoff + 256, xc, xd); } } while (0)
#define G_STEP(kt, ST, bi, xa, xb, xc, xd) do { \
    if (dmaw) { if ((kt) + 1 < nk) { if (BG) asm volatile("s_waitcnt vmcnt(12)" ::: "memory"); else asm volatile("s_waitcnt vmcnt(6)" ::: "memory"); } \
                else asm volatile("s_waitcnt vmcnt(0)" ::: "memory"); } \
    asm volatile("s_waitcnt lgkmcnt(0)" ::: "memory"); __builtin_amdgcn_s_barrier(); \
    if ((kt) + 2 < nk) G_DMA((kt) + 2, ((ST) + 2) % 3); \
    if (BG && !dmaw) BG_SLOT(bi, xa, xb, xc, xd); \
    if (BG && bgdone < bgn) ++bgdone; \
    G_COMPUTE(ST); } while (0)
  for (int kt = 0; kt < nk; kt += 3) {
    G_STEP(kt, 0, bi0, b0a, b0b, b0c, b0d);
    if (kt + 1 < nk) G_STEP(kt + 1, 1, bi1, b1a, b1b, b1c, b1d);
    if (kt + 2 < nk) G_STEP(kt + 2, 2, bi2, b2a, b2b, b2c, b2d);
  }
  if (BG && !dmaw) {
    asm volatile("s_waitcnt vmcnt(0)" ::: "memory");
    if (bi0 >= 0) { BGA_RETIRE(bi0, bgoff, b0a, b0b); BGA_RETIRE(bi0, bgoff + 256, b0c, b0d); }
    if (bi1 >= 0) { BGA_RETIRE(bi1, bgoff, b1a, b1b); BGA_RETIRE(bi1, bgoff + 256, b1c, b1d); }
    if (bi2 >= 0) { BGA_RETIRE(bi2, bgoff, b2a, b2b); BGA_RETIRE(bi2, bgoff + 256, b2c, b2d); }
    asm volatile("s_waitcnt vmcnt(0)" ::: "memory");
  }
#undef G_STEP
#undef BG_SLOT
  asm volatile("s_waitcnt lgkmcnt(0)" ::: "memory"); __builtin_amdgcn_s_barrier();
#undef G_DMA
#undef G_DMA1
#undef G_COMPUTE
#undef G_HALF
}

__device__ __forceinline__ unsigned pack4_fp8(const f32x16& a, int g) {
  int w = __builtin_amdgcn_cvt_pk_fp8_f32(a[4 * g], a[4 * g + 1], 0, false);
  w = __builtin_amdgcn_cvt_pk_fp8_f32(a[4 * g + 2], a[4 * g + 3], w, true);
  return (unsigned)w;
}
__device__ __forceinline__ u32x2 pack4(const f32x16& a, int g) { return (u32x2){cvtpk(a[4 * g], a[4 * g + 1]), cvtpk(a[4 * g + 2], a[4 * g + 3])}; }

__device__ __forceinline__ void phase_a1(const Params& p, int layer, LAS char* lds, int bid, int nblk) {
  const bf16_t* H = (const bf16_t*)(p.ws + OFF_H);
  const bf16_t* W = (const bf16_t*)(p.ws + OFF_WIN) + (size_t)layer * D * INW;
  bf16_t* Q = (bf16_t*)(p.ws + OFF_Q); bf16_t* Kb = (bf16_t*)(p.ws + OFF_K); bf16_t* Vb = (bf16_t*)(p.ws + OFF_V);
  float* U = (float*)(p.ws + OFF_U); bf16_t* AG = (bf16_t*)(p.ws + OFF_AG);
  unsigned char* Q8 = (unsigned char*)(p.ws + OFF_Q8); unsigned char* K8 = (unsigned char*)(p.ws + OFF_K8); unsigned char* VT8 = (unsigned char*)(p.ws + OFF_VT8);
  const float* rt = (const float*)(p.ws + OFF_ROPE);
  const int lane = TIDX & 63, wid = TIDX >> 6, r32 = lane & 31, hi = lane >> 5, wm = wid >> 1, wn = wid & 1;
  const size_t wo = (size_t)layer * NE * D * DE;
  const int bgn = (3 * (1 << 21) + nblk * 512 - 1) / (nblk * 512);
  const long bgc0 = (long)bid * bgn * 512;
  const float* bs0 = p.w_e_gate + wo; const float* bs1 = p.w_e_up + wo; const float* bs2 = p.w_e_down + wo;
  bf16_t* bd0 = (bf16_t*)(p.ws + OFF_WG) + wo; bf16_t* bd1 = (bf16_t*)(p.ws + OFF_WU) + wo; bf16_t* bd2 = (bf16_t*)(p.ws + OFF_WD) + wo;
  int bgdone = 0;
  const int nlat = 64 * 12, nctx = layer == 0 ? 12 : 2, nunits = nlat + nctx;
  const bool xmap = (nblk & 7) == 0;
  const int xcd = bid & 7, lb = bid >> 3, nlb = nblk >> 3, nl = lb < 96 ? (96 - lb + nlb - 1) / nlb : 0;
  for (int it = 0;; ++it) {
    int rtile, ct;
    if (xmap) {
      if (it < nl) { const int v = lb + it * nlb; rtile = 1 + xcd + 8 * (v / 12); ct = v % 12; }
      else { const int e2 = bid + (it - nl) * nblk; if (e2 >= nctx) break; rtile = 0; ct = layer == 0 ? e2 : 4 + e2; }
    } else {
      const int u = bid + it * nblk; if (u >= nunits) break;
      if (u < nlat) { rtile = 1 + u / 12; ct = u % 12; } else { rtile = 0; ct = layer == 0 ? (u - nlat) : (4 + u - nlat); }
    }
    const int m0 = rtile * 256, n0 = ct * 128;
    f32x16 acc[2][2];
#pragma unroll
    for (int a = 0; a < 2; ++a)
#pragma unroll
      for (int b = 0; b < 2; ++b) acc[a][b] = (f32x16){};
    gemm_mainloop<256, 128, 0, true>(lds, acc, [&](int row) { return H + (size_t)(m0 + row) * D; }, [&](int) { return W + n0; }, INW, D, bgdone, bgn, bgc0, bs0, bs1, bs2, bd0, bd1, bd2);
#pragma unroll
    for (int ti = 0; ti < 2; ++ti) {
      const int tok = m0 + wm * 64 + ti * 32 + r32;
      if (ct < 5) {
        float ss = 0.f;
#pragma unroll
        for (int ni = 0; ni < 2; ++ni)
#pragma unroll
          for (int r = 0; r < 16; ++r) ss += acc[ti][ni][r] * acc[ti][ni][r];
        ss = sum32(ss);
        const float rs = rsqrtf(ss * (1.f / 64.f) + EPS);
        const float* gain = (ct < 4 ? p.q_gain : p.k_gain) + layer * 64;
        const float osc = ct < 4 ? 0.125f * 1.4426950408889634f : 1.f;
        const bool lat = rtile > 0;
        const int t = tok - NCTX;
#pragma unroll
        for (int ni = 0; ni < 2; ++ni) {
          f32x16 v;
#pragma unroll
          for (int r = 0; r < 16; ++r) v[r] = acc[ti][ni][r] * rs * gain[ni * 32 + crow(r, hi)];
          if (lat) {
            const int pos = ni == 0 ? (t >> 6) : (t & 63);
#pragma unroll
            for (int r = 0; r < 8; ++r) {
              const int f = crow(r, hi);
              const float cs = rt[(pos * 16 + f) * 2], sn = rt[(pos * 16 + f) * 2 + 1];
              const float t1 = v[r], t2 = v[r + 8];
              v[r] = t1 * cs - t2 * sn; v[r + 8] = t2 * cs + t1 * sn;
            }
          }
#pragma unroll
          for (int r = 0; r < 16; ++r) v[r] *= osc;
          bf16_t* dst = ct < 4 ? Q + (size_t)tok * 512 + (ct * 2 + wn) * 64 + ni * 32 : Kb + (size_t)tok * 128 + wn * 64 + ni * 32;
          unsigned char* dst8 = ct < 4 ? Q8 + (size_t)tok * 512 + (ct * 2 + wn) * 64 + ni * 32 : K8 + (size_t)tok * 128 + wn * 64 + ni * 32;
#pragma unroll
          for (int g = 0; g < 4; ++g) { *(u32x2*)(dst + 8 * g + 4 * hi) = pack4(v, g); *(unsigned*)(dst8 + 8 * g + 4 * hi) = pack4_fp8(v, g); }
        }
      } else if (ct == 5) {
#pragma unroll
        for (int ni = 0; ni < 2; ++ni) {
#pragma unroll
          for (int g = 0; g < 4; ++g) *(u32x2*)(Vb + (size_t)tok * 128 + wn * 64 + ni * 32 + 8 * g + 4 * hi) = pack4(acc[ti][ni], g);
          float vmx = 0.f;
#pragma unroll
          for (int r = 0; r < 16; ++r) {
            const float vv = acc[ti][ni][r]; vmx = fmaxf(vmx, fabsf(vv));
            VT8[(size_t)(wn * 64 + ni * 32 + crow(r, hi)) * TT + tok] = (unsigned char)(__builtin_amdgcn_cvt_pk_fp8_f32(vv, vv, 0, false) & 0xff);
          }
          if (!(vmx <= 400.f)) atomicOr((int*)(p.ws + OFF_FLAG) + 1, 1);
        }
      } else if (ct < 8) {
#pragma unroll
        for (int ni = 0; ni < 2; ++ni)
#pragma unroll
          for (int g = 0; g < 4; ++g)
            *(f32x4*)(U + (size_t)tok * 256 + (ct - 6) * 128 + wn * 64 + ni * 32 + 8 * g + 4 * hi) =
                (f32x4){acc[ti][ni][4 * g], acc[ti][ni][4 * g + 1], acc[ti][ni][4 * g + 2], acc[ti][ni][4 * g + 3]};
      } else {
#pragma unroll
        for (int ni = 0; ni < 2; ++ni)
#pragma unroll
          for (int g = 0; g < 4; ++g) *(u32x2*)(AG + (size_t)tok * 512 + (ct - 8) * 128 + wn * 64 + ni * 32 + 8 * g + 4 * hi) = pack4(acc[ti][ni], g);
      }
    }
  }
  { const int tid = TIDX; while (bgdone < bgn) { f32x4 a, b2; const int i = bgdone++; BG_ISSUE(i, tid, a, b2); BG_RETIRE(i, tid, a, b2); } }
}

__device__ __forceinline__ void phase_c1(const Params& p, int layer, LAS char* lds, int bid, int nblk) {
  const bf16_t* A = (const bf16_t*)(p.ws + OFF_MIX);
  const bf16_t* W = (const bf16_t*)(p.ws + OFF_WOUT) + (size_t)layer * D * D;
  bf16_t* Y = (bf16_t*)(p.ws + OFF_Y);
  const int lane = TIDX & 63, wid = TIDX >> 6, r32 = lane & 31, hi = lane >> 5, wm = wid >> 1, wn = wid & 1;
  const int nctx = layer == 0 ? 8 : 0;
  const bool xmap = (nblk & 7) == 0;
  const int xcd = bid & 7, lb = bid >> 3, nlb = nblk >> 3, nl = lb < 64 ? (64 - lb + nlb - 1) / nlb : 0;
  for (int it = 0;; ++it) {
    int rtile, ct;
    if (xmap) {
      if (it < nl) { const int v = lb + it * nlb; rtile = 1 + xcd + 8 * (v >> 3); ct = v & 7; }
      else { const int e2 = bid + (it - nl) * nblk; if (e2 >= nctx) break; rtile = 0; ct = e2; }
    } else {
      const int u = bid + it * nblk; if (u >= 64 * 8 + nctx) break;
      if (u < 512) { rtile = 1 + (u >> 3); ct = u & 7; } else { rtile = 0; ct = u - 512; }
    }
    const int m0 = rtile * 256, n0 = ct * 128;
    f32x16 acc[2][2];
#pragma unroll
    for (int a = 0; a < 2; ++a)
#pragma unroll
      for (int b = 0; b < 2; ++b) acc[a][b] = (f32x16){};
    { int nd = 0; gemm_mainloop<256, 128, 0>(lds, acc, [&](int row) { return A + (size_t)(m0 + row) * D; }, [&](int) { return W + n0; }, D, D, nd); }
#pragma unroll
    for (int ti = 0; ti < 2; ++ti) {
      const int tok = m0 + wm * 64 + ti * 32 + r32;
#pragma unroll
      for (int ni = 0; ni < 2; ++ni)
#pragma unroll
        for (int g = 0; g < 4; ++g) *(u32x2*)(Y + (size_t)tok * D + n0 + wn * 64 + ni * 32 + 8 * g + 4 * hi) = pack4(acc[ti][ni], g);
    }
  }
}

#ifndef MOE_XCD_MAP
#define MOE_XCD_MAP 0
#endif
__device__ __forceinline__ void moe_prefix(const int* cnt, LAS int* pre, int xcd) {
  if (TIDX == 0) {
    int o = 0; for (int e = 0; e < NE; ++e) { pre[e] = o; o += (cnt[e * CNT_STRIDE] + 127) >> 7; } pre[NE] = o;
    int l = 0; for (int j = 0; j < 4; ++j) { pre[40 + j] = l; l += (cnt[(xcd + 8 * j) * CNT_STRIDE] + 127) >> 7; } pre[44] = l;
  }
  __syncthreads();
}
__device__ __forceinline__ bool moe_unit(const LAS int* pre, int bid, int nblk, int it, int& e, int& rt, int& ct, int& g) {
  if (MOE_XCD_MAP && (nblk & 7) == 0) {
    const int xcd = bid & 7, v = (bid >> 3) + it * (nblk >> 3), gl = v >> 2;
    if (gl >= pre[44]) return false;
    int j = 0; if (gl >= pre[41]) j = 1; if (gl >= pre[42]) j = 2; if (gl >= pre[43]) j = 3;
    e = xcd + 8 * j; rt = gl - pre[40 + j]; ct = v & 3; g = pre[e] + rt; return true;
  } else {
    const int u = bid + it * nblk; g = u >> 2; if (g >= pre[NE]) return false;
    int ee = 0; for (int i = 1; i < NE; ++i) ee += (pre[i] <= g) ? 1 : 0;
    e = ee; rt = g - pre[ee]; ct = u & 3; return true;
  }
}

__device__ __forceinline__ void phase_d1(const Params& p, int layer, LAS char* lds, int bid, int nblk) {
  const int* cnt = (const int*)(p.ws + OFF_CNT) + layer * NE * CNT_STRIDE;
  const bf16_t* H2 = (const bf16_t*)(p.ws + OFF_MIX);
  bf16_t* HM = (bf16_t*)(p.ws + OFF_HMID);
  LAS int* pre = (LAS int*)(lds + GEMM_LDS);
  moe_prefix(cnt, pre, bid & 7);
  const int lane = TIDX & 63, wid = TIDX >> 6, r32 = lane & 31, hi = lane >> 5, wm = wid >> 2, wn = wid & 3;
  for (int it = 0;; ++it) {
    int e, rt, ct, g; if (!moe_unit(pre, bid, nblk, it, e, rt, ct, g)) break;
    const int n = cnt[e * CNT_STRIDE];
    const int* list = (const int*)(p.ws + OFF_LIST) + (size_t)e * CAPL + rt * 128;
    const bf16_t* Wg = (const bf16_t*)(p.ws + OFF_WG) + ((size_t)layer * NE + e) * D * DE + ct * 128;
    const bf16_t* Wu = (const bf16_t*)(p.ws + OFF_WU) + ((size_t)layer * NE + e) * D * DE + ct * 128;
    const int nvalid = n - rt * 128;
    f32x16 acc[2][2];
#pragma unroll
    for (int a = 0; a < 2; ++a)
#pragma unroll
      for (int b = 0; b < 2; ++b) acc[a][b] = (f32x16){};
    int nd = 0;
    gemm_mainloop<128, 256, 2>(lds, acc, [&](int row) { const int tok = row < nvalid ? (list[row] >> 1) : 0; return H2 + (size_t)tok * D; },
                               [&](int s) { return s == 0 ? Wg : Wu; }, DE, D, nd);
    const size_t hrow0 = (size_t)(pre[e] + rt) * 128;
#pragma unroll
    for (int ti = 0; ti < 2; ++ti) {
      const size_t row = hrow0 + wm * 64 + ti * 32 + r32;
      f32x16 a;
#pragma unroll
      for (int r = 0; r < 16; ++r) { const float gv = acc[ti][0][r]; a[r] = gv / (1.f + __expf(-gv)) * acc[ti][1][r]; }
#pragma unroll
      for (int gq = 0; gq < 4; ++gq) *(u32x2*)(HM + row * DE + ct * 128 + wn * 32 + 8 * gq + 4 * hi) = pack4(a, gq);
    }
  }
}

__device__ __forceinline__ void phase_d2(const Params& p, int layer, LAS char* lds, int bid, int nblk) {
  const int* cnt = (const int*)(p.ws + OFF_CNT) + layer * NE * CNT_STRIDE;
  const bf16_t* HM = (const bf16_t*)(p.ws + OFF_HMID);
  const float* GATE = (const float*)(p.ws + OFF_GATE);
  bf16_t* OM = (bf16_t*)(p.ws + OFF_OMOE);
  LAS int* pre = (LAS int*)(lds + GEMM_LDS);
  moe_prefix(cnt, pre, bid & 7);
  const int lane = TIDX & 63, wid = TIDX >> 6, r32 = lane & 31, hi = lane >> 5, wm = wid >> 2, wn = wid & 3;
  for (int it = 0;; ++it) {
    int e, rt, ct, g; if (!moe_unit(pre, bid, nblk, it, e, rt, ct, g)) break;
    const int n = cnt[e * CNT_STRIDE];
    const int* list = (const int*)(p.ws + OFF_LIST) + (size_t)e * CAPL + rt * 128;
    const bf16_t* Wd = (const bf16_t*)(p.ws + OFF_WD) + ((size_t)layer * NE + e) * DE * D + ct * 256;
    const int nvalid = n - rt * 128;
    const bf16_t* A = HM + (size_t)g * 128 * DE;
    int ts2[2]; float gt2[2];
#pragma unroll
    for (int ti = 0; ti < 2; ++ti) { const int row = wm * 64 + ti * 32 + r32; ts2[ti] = row < nvalid ? list[row] : 0; }
#pragma unroll
    for (int ti = 0; ti < 2; ++ti) gt2[ti] = GATE[ts2[ti]];
    f32x16 acc[2][2];
#pragma unroll
    for (int a = 0; a < 2; ++a)
#pragma unroll
      for (int b = 0; b < 2; ++b) acc[a][b] = (f32x16){};
    { int nd = 0; gemm_mainloop<128, 256, 1>(lds, acc, [&](int row) { return A + (size_t)row * DE; }, [&](int s) { return Wd + s * 128; }, D, DE, nd); }
#pragma unroll
    for (int ti = 0; ti < 2; ++ti) {
      const int row = wm * 64 + ti * 32 + r32;
      if (row < nvalid) {
        const int ts = ts2[ti];
        const float gt = gt2[ti];
#pragma unroll
        for (int ni = 0; ni < 2; ++ni) {
          f32x16 a;
#pragma unroll
          for (int r = 0; r < 16; ++r) a[r] = acc[ti][ni][r] * gt;
#pragma unroll
          for (int gq = 0; gq < 4; ++gq) *(u32x2*)(OM + (size_t)ts * D + ct * 256 + wn * 64 + ni * 32 + 8 * gq + 4 * hi) = pack4(a, gq);
        }
      }
    }
  }
}

constexpr int ATT_SLOT = 16384, ATT_LDS = 4 * ATT_SLOT;
__device__ __forceinline__ int vst64(int k, int c) { const int kk = (k & ~0xC) | ((k & 4) << 1) | ((k & 8) >> 1); return ((kk >> 3) * 2 + (c >> 5)) * 512 + ((kk & 7) * 32 + (c & 31)) * 2; }
__device__ __forceinline__ bf16x8 tr_frag64(const LAS char* p) {
  s16x4 a = __builtin_amdgcn_ds_read_tr16_b64_v4i16((LAS s16x4*)p);
  s16x4 b = __builtin_amdgcn_ds_read_tr16_b64_v4i16((LAS s16x4*)(p + 1024));
  return (bf16x8){a[0], a[1], a[2], a[3], b[0], b[1], b[2], b[3]};
}
__device__ __forceinline__ bf16x8 pk4(const f32x16& P, int B) {
  unsigned a0 = cvtpk(P[B + 0], P[B + 1]), a1 = cvtpk(P[B + 2], P[B + 3]), b0 = cvtpk(P[B + 4], P[B + 5]), b1 = cvtpk(P[B + 6], P[B + 7]);
  auto r0 = __builtin_amdgcn_permlane32_swap(a0, b0, false, false); auto r1 = __builtin_amdgcn_permlane32_swap(a1, b1, false, false);
  u32x4 w = {r0[0], r1[0], r0[1], r1[1]};
  return __builtin_bit_cast(bf16x8, w);
}
struct AttnCtx { int krd0, krd1, ksw, hi, vrd; };
#define SBAR() __builtin_amdgcn_sched_barrier(0)
__device__ __forceinline__ void att_kload(const LAS char* slot, const AttnCtx& c, bf16x8 (&kf)[8]) {
#pragma unroll
  for (int d0 = 0; d0 < 4; ++d0) {
    kf[2 * d0] = *(const LAS bf16x8*)(slot + c.krd0 + (((2 * d0 + c.hi) ^ c.ksw) << 4));
    kf[2 * d0 + 1] = *(const LAS bf16x8*)(slot + c.krd1 + (((2 * d0 + c.hi) ^ c.ksw) << 4));
  }
}
__device__ __forceinline__ void att_qk(const bf16x8 (&kf)[8], const bf16x8 (&qr)[4], f32x16& s0, f32x16& s1) {
  s0 = (f32x16){}; s1 = (f32x16){};
#pragma unroll
  for (int d0 = 0; d0 < 4; ++d0) {
    s0 = __builtin_amdgcn_mfma_f32_32x32x16_bf16(kf[2 * d0], qr[d0], s0, 0, 0, 0);
    s1 = __builtin_amdgcn_mfma_f32_32x32x16_bf16(kf[2 * d0 + 1], qr[d0], s1, 0, 0, 0);
  }
}
__device__ __forceinline__ void att_exp(f32x16& s, float& l) {
#pragma unroll
  for (int r = 0; r < 16; ++r) { s[r] = __builtin_amdgcn_exp2f(s[r]); l += s[r]; }
  asm volatile("" : "+v"(l));
}
template <int KS0>
__device__ __forceinline__ void att_vload(const LAS char* slot, const AttnCtx& c, bf16x8 (&vf)[4]) {
#pragma unroll
  for (int i = 0; i < 2; ++i) { vf[2 * i] = tr_frag64(slot + c.vrd + (KS0 + i) * 2048); vf[2 * i + 1] = tr_frag64(slot + c.vrd + 512 + (KS0 + i) * 2048); }
}
__device__ __forceinline__ void att_pv2(const bf16x8& pa, const bf16x8& pb, const bf16x8 (&vf)[4], f32x16& o0, f32x16& o1) {
  o0 = __builtin_amdgcn_mfma_f32_32x32x16_bf16(pa, vf[0], o0, 0, 0, 0);
  o1 = __builtin_amdgcn_mfma_f32_32x32x16_bf16(pa, vf[1], o1, 0, 0, 0);
  o0 = __builtin_amdgcn_mfma_f32_32x32x16_bf16(pb, vf[2], o0, 0, 0, 0);
  o1 = __builtin_amdgcn_mfma_f32_32x32x16_bf16(pb, vf[3], o1, 0, 0, 0);
}
__device__ __forceinline__ void attn_unit(const Params& p, LAS char* lds, int row0, int hp, int nkeys) {
  const bf16_t* Q = (const bf16_t*)(p.ws + OFF_Q); const bf16_t* Kb = (const bf16_t*)(p.ws + OFF_K); const bf16_t* Vb = (const bf16_t*)(p.ws + OFF_V);
  bf16_t* MIX = (bf16_t*)(p.ws + OFF_MIX);
  const int tid = TIDX, wid = tid >> 6, lane = tid & 63, r32 = lane & 31, hi = lane >> 5, kvh = hp >> 1;
  bf16x8 qa[4], qb[4];
  { const bf16_t* Qg = Q + (size_t)(row0 + wid * 32 + r32) * 512 + hp * 128 + hi * 8;
#pragma unroll
    for (int d0 = 0; d0 < 4; ++d0) { qa[d0] = *(const bf16x8*)(Qg + d0 * 16); qb[d0] = *(const bf16x8*)(Qg + 64 + d0 * 16); } }
  const bf16_t* Kg = Kb + (size_t)(tid >> 3) * 128 + kvh * 64 + (tid & 7) * 8;
  const bf16_t* Vg = Vb + (size_t)(tid >> 3) * 128 + kvh * 64 + (tid & 7) * 8;
  const int kst = xoff(tid >> 3, tid & 7), vstw = 8192 + vst64(tid >> 3, (tid & 7) * 8);
  AttnCtx c; c.krd0 = r32 * 128; c.krd1 = (32 + r32) * 128; c.ksw = (r32 >> 1) & 7; c.hi = hi; c.vrd = 8192 + v_rd_base(lane);
  const int NT = nkeys >> 6;
  f32x16 oa0 = {}, oa1 = {}, ob0 = {}, ob1 = {}; float la = 0.f, lb = 0.f;
  u32x4 ks, vs;
  {
    const u32x4 k0 = *(const u32x4*)Kg, k1 = *(const u32x4*)(Kg + 64 * 128), v0 = *(const u32x4*)Vg, v1 = *(const u32x4*)(Vg + 64 * 128);
    *(LAS u32x4*)(lds + kst) = k0; *(LAS u32x4*)(lds + ATT_SLOT + kst) = k1;
    *(LAS u32x4*)(lds + vstw) = v0; *(LAS u32x4*)(lds + ATT_SLOT + vstw) = v1;
    ks = *(const u32x4*)(Kg + 2 * 64 * 128); vs = *(const u32x4*)(Vg + 2 * 64 * 128);
  }
  __syncthreads();
  for (int j = 0; j < NT; ++j) {
    const LAS char* sl = lds + (j & 3) * ATT_SLOT;
    bf16x8 kf[8], vfa[4], vfb[4];
    f32x16 sa0, sa1, sb0, sb1;
    att_kload(sl, c, kf);
    SBAR();
    att_qk(kf, qa, sa0, sa1);
    SBAR();
    att_qk(kf, qb, sb0, sb1);
    att_exp(sa0, la); att_exp(sa1, la);
    SBAR();
    const bf16x8 pa0 = pk4(sa0, 0), pa1 = pk4(sa0, 8), pa2 = pk4(sa1, 0), pa3 = pk4(sa1, 8);
    att_vload<0>(sl, c, vfa);
    SBAR();
    att_pv2(pa0, pa1, vfa, oa0, oa1);
    att_exp(sb0, lb);
    att_vload<2>(sl, c, vfb);
    SBAR();
    att_pv2(pa2, pa3, vfb, oa0, oa1);
    att_exp(sb1, lb);
    const bf16x8 pb0 = pk4(sb0, 0), pb1 = pk4(sb0, 8), pb2 = pk4(sb1, 0), pb3 = pk4(sb1, 8);
    att_vload<0>(sl, c, vfa);
    SBAR();
    att_pv2(pb0, pb1, vfa, ob0, ob1);
    att_vload<2>(sl, c, vfb);
    SBAR();
    att_pv2(pb2, pb3, vfb, ob0, ob1);
    { LAS char* w = lds + ((j + 2) & 3) * ATT_SLOT;
      if (j + 2 < NT) { *(LAS u32x4*)(w + kst) = ks; *(LAS u32x4*)(w + vstw) = vs; }
      if (j + 3 < NT) { ks = *(const u32x4*)(Kg + (size_t)(j + 3) * 64 * 128); vs = *(const u32x4*)(Vg + (size_t)(j + 3) * 64 * 128); } }
    __syncthreads();
  }
  la = sum32(la); lb = sum32(lb);
  LAS float* li = (LAS float*)(lds + wid * 256);
  if (hi == 0) { li[r32] = la; li[32 + r32] = lb; }
  __syncthreads();
  bf16_t* Og = MIX + (size_t)(row0 + wid * 32) * D + hp * 128 + r32;
#pragma unroll
  for (int r = 0; r < 16; ++r) {
    const int orow = crow(r, hi);
    const float ra = __builtin_amdgcn_rcpf(li[orow]), rb = __builtin_amdgcn_rcpf(li[32 + orow]);
    Og[(size_t)orow * D] = f2bf(oa0[r] * ra); Og[(size_t)orow * D + 32] = f2bf(oa1[r] * ra);
    Og[(size_t)orow * D + 64] = f2bf(ob0[r] * rb); Og[(size_t)orow * D + 96] = f2bf(ob1[r] * rb);
  }
  __syncthreads();
}
typedef int i32x8 __attribute__((ext_vector_type(8)));
constexpr int A8_SLOT = 8192, A8_NSLOT = 8, A8_LDS = A8_NSLOT * A8_SLOT;
__device__ __forceinline__ int off8(int row, int chunk) { return row * 64 + ((chunk ^ ((row >> 2) & 3)) << 4); }
__device__ __forceinline__ i32x8 ld_frag8(const LAS char* tile, int row, int h) {
  const int sw = (row >> 2) & 3;
  const u32x4 lo = *(const LAS u32x4*)(tile + row * 64 + (((2 * h) ^ sw) << 4)), hi = *(const LAS u32x4*)(tile + row * 64 + (((2 * h + 1) ^ sw) << 4));
  return (i32x8){(int)lo[0], (int)lo[1], (int)lo[2], (int)lo[3], (int)hi[0], (int)hi[1], (int)hi[2], (int)hi[3]};
}
#define MX_FP8_FP8(a, b, c) __builtin_amdgcn_mfma_scale_f32_32x32x64_f8f6f4(a, b, c, 0, 0, 0, 0x7f7f7f7f, 0, 0x7f7f7f7f)
#define MX_BF8_FP8(a, b, c) __builtin_amdgcn_mfma_scale_f32_32x32x64_f8f6f4(a, b, c, 1, 0, 0, 0x7f7f7f7f, 0, 0x7f7f7f7f)
typedef _Float16 f16x2 __attribute__((ext_vector_type(2)));
__device__ __forceinline__ unsigned att8_code4(float s0, float s1, float s2, float s3) {
  const f16x2 four = {(_Float16)4.f, (_Float16)4.f}, bias = {(_Float16)1084.f, (_Float16)1084.f};
  const f16x2 x = __builtin_bit_cast(f16x2, __builtin_amdgcn_cvt_pkrtz(s0, s1)) * four + bias, y = __builtin_bit_cast(f16x2, __builtin_amdgcn_cvt_pkrtz(s2, s3)) * four + bias;
  return __builtin_amdgcn_perm(__builtin_bit_cast(unsigned, y), __builtin_bit_cast(unsigned, x), 0x06040200u);
}
__device__ __forceinline__ i32x8 att8_pack(const f32x16& p0, const f32x16& p1) {
  i32x8 w;
#pragma unroll
  for (int i = 0; i < 4; ++i) {
    const unsigned d = att8_code4(p0[4 * i], p0[4 * i + 1], p0[4 * i + 2], p0[4 * i + 3]), e = att8_code4(p1[4 * i], p1[4 * i + 1], p1[4 * i + 2], p1[4 * i + 3]);
    auto r = __builtin_amdgcn_permlane32_swap(d, e, false, false);
    w[2 * i] = (int)r[0]; w[2 * i + 1] = (int)r[1];
  }
  return w;
}
__device__ __forceinline__ void attn_unit8(const Params& p, LAS char* lds, int row0, int hp, int nkeys, bf16_t* MIXP = nullptr) {
  const unsigned char* Q8 = (const unsigned char*)(p.ws + OFF_Q8); const unsigned char* K8 = (const unsigned char*)(p.ws + OFF_K8); const unsigned char* VT8 = (const unsigned char*)(p.ws + OFF_VT8);
  bf16_t* MIX = MIXP ? MIXP : (bf16_t*)(p.ws + OFF_MIX);
  const int tid = TIDX, wid = tid >> 6, lane = tid & 63, r32 = lane & 31, hi = lane >> 5, kvh = hp >> 1;
  i32x8 qa, qb;
  { const unsigned char* Qg = Q8 + (size_t)(row0 + wid * 32 + r32) * 512 + hp * 128 + hi * 32;
    const u32x4 a0 = *(const u32x4*)Qg, a1 = *(const u32x4*)(Qg + 16), b0 = *(const u32x4*)(Qg + 64), b1 = *(const u32x4*)(Qg + 80);
    qa = (i32x8){(int)a0[0], (int)a0[1], (int)a0[2], (int)a0[3], (int)a1[0], (int)a1[1], (int)a1[2], (int)a1[3]};
    qb = (i32x8){(int)b0[0], (int)b0[1], (int)b0[2], (int)b0[3], (int)b1[0], (int)b1[1], (int)b1[2], (int)b1[3]}; }
  const int wv = __builtin_amdgcn_readfirstlane(wid);
  const int prow = (wv & 3) * 16 + (lane >> 2), pch = (lane & 3) ^ ((prow >> 2) & 3);
  const unsigned char* Sg = wv < 4 ? K8 + (size_t)prow * 128 + kvh * 64 + pch * 16 : VT8 + (size_t)(kvh * 64 + prow) * TT + pch * 16;
  const size_t sstep = wv < 4 ? (size_t)64 * 128 : (size_t)64;
  const int sdst = (wv < 4 ? 0 : 4096) + (wv & 3) * 1024;
#define A8_DMA(t) __builtin_amdgcn_global_load_lds((const unsigned*)(Sg + (size_t)(t) * sstep), (LAS unsigned*)(lds + ((t) & (A8_NSLOT - 1)) * A8_SLOT + sdst), 16, 0, 0)
  const int NT = nkeys >> 6;
  f32x16 oa0 = {}, oa1 = {}, ob0 = {}, ob1 = {}, ola = {}, olb = {};
  const i32x8 ones = {0x38383838, 0x38383838, 0x38383838, 0x38383838, 0x38383838, 0x38383838, 0x38383838, 0x38383838};
  A8_DMA(0); A8_DMA(1); if (NT > 2) { A8_DMA(2); A8_DMA(3); }
  for (int j = 0; j < NT; j += 2) {
    if (j + 2 < NT) asm volatile("s_waitcnt vmcnt(2)" ::: "memory"); else asm volatile("s_waitcnt vmcnt(0)" ::: "memory");
    asm volatile("s_waitcnt lgkmcnt(0)" ::: "memory"); __builtin_amdgcn_s_barrier();
    if (j + 4 < NT) { A8_DMA(j + 4); A8_DMA(j + 5); }
#pragma unroll
    for (int jj = 0; jj < 2; ++jj) {
      const LAS char* sl = lds + ((j + jj) & (A8_NSLOT - 1)) * A8_SLOT;
      f32x16 sa0 = {}, sa1 = {}, sb0 = {}, sb1 = {};
      const i32x8 kf0 = ld_frag8(sl, r32, hi), kf1 = ld_frag8(sl, 32 + r32, hi);
      SBAR();
      sa0 = MX_FP8_FP8(kf0, qa, sa0); sa1 = MX_FP8_FP8(kf1, qa, sa1);
      SBAR();
      sb0 = MX_FP8_FP8(kf0, qb, sb0); sb1 = MX_FP8_FP8(kf1, qb, sb1);
      SBAR();
      const i32x8 pa = att8_pack(sa0, sa1);
      const i32x8 vf0 = ld_frag8(sl + 4096, r32, hi), vf1 = ld_frag8(sl + 4096, 32 + r32, hi);
      SBAR();
      oa0 = MX_BF8_FP8(pa, vf0, oa0); oa1 = MX_BF8_FP8(pa, vf1, oa1); ola = MX_BF8_FP8(pa, ones, ola);
      const i32x8 pb = att8_pack(sb0, sb1);
      SBAR();
      ob0 = MX_BF8_FP8(pb, vf0, ob0); ob1 = MX_BF8_FP8(pb, vf1, ob1); olb = MX_BF8_FP8(pb, ones, olb);
    }
  }
#undef A8_DMA
  asm volatile("s_waitcnt lgkmcnt(0)" ::: "memory"); __builtin_amdgcn_s_barrier();
  bf16_t* Og = MIX + (size_t)(row0 + wid * 32) * D + hp * 128 + r32;
#pragma unroll
  for (int r = 0; r < 16; ++r) {
    const int orow = crow(r, hi);
    const float ra = __builtin_amdgcn_rcpf(ola[r]), rb = __builtin_amdgcn_rcpf(olb[r]);
    Og[(size_t)orow * D] = f2bf(oa0[r] * ra); Og[(size_t)orow * D + 32] = f2bf(oa1[r] * ra);
    Og[(size_t)orow * D + 64] = f2bf(ob0[r] * rb); Og[(size_t)orow * D + 96] = f2bf(ob1[r] * rb);
  }
  __syncthreads();
}
__device__ __forceinline__ void attn_fallback(const Params& p, int layer, int bid, int nblk) {
  const bf16_t* Q = (const bf16_t*)(p.ws + OFF_Q); const bf16_t* Kb = (const bf16_t*)(p.ws + OFF_K); const bf16_t* Vb = (const bf16_t*)(p.ws + OFF_V);
  bf16_t* MIX = (bf16_t*)(p.ws + OFF_MIX);
  const int lane = TIDX & 63, nwv = nblk * 8;
  const int rg0 = layer == 0 ? 0 : NCTX / 64;
  for (int wv = bid * 8 + (TIDX >> 6) + rg0 * 8; wv < (TT / 64) * 8; wv += nwv) {
    const int head = wv & 7, r = (wv >> 3) * 64 + lane, kvh = head >> 2;
    float q[64], o[64];
#pragma unroll
    for (int d = 0; d < 64; ++d) { q[d] = bf2f(Q[(size_t)r * 512 + head * 64 + d]); o[d] = 0.f; }
    float m = -1e30f, l = 0.f;
    const int nk = r >= NCTX ? TT : NCTX;
    for (int j = 0; j < nk; ++j) {
      const bf16_t* kr = Kb + (size_t)j * 128 + kvh * 64;
      const bf16_t* vr = Vb + (size_t)j * 128 + kvh * 64;
      float s = 0.f;
#pragma unroll
      for (int d = 0; d < 64; ++d) s += q[d] * bf2f(kr[d]);
      if (s > m) {
        const float a = __builtin_amdgcn_exp2f(m - s);
        l *= a;
#pragma unroll
        for (int d = 0; d < 64; ++d) o[d] *= a;
        m = s;
      }
      const float pe = __builtin_amdgcn_exp2f(s - m);
      l += pe;
#pragma unroll
      for (int d = 0; d < 64; ++d) o[d] += pe * bf2f(vr[d]);
    }
    const float il = 1.f / l;
#pragma unroll
    for (int d = 0; d < 64; ++d) MIX[(size_t)r * D + head * 64 + d] = f2bf(o[d] * il);
  }
}

constexpr int PC_U = 0;
constexpr int PC_Y = 49152;
constexpr int PC_P = PC_Y + 65536;
constexpr int PC_LDS = PC_P + 32768;
__device__ __forceinline__ void poolconv_unit(const Params& p, int layer, LAS char* lds, int tile) {
  const int tid = TIDX, wid = tid >> 6, lane = tid & 63, r32 = lane & 31, hi = lane >> 5;
  const int t0 = tile * 64, base = tile < 4 ? 0 : NCTX, n = tile < 4 ? NCTX : SEQ;
  const bf16_t* AG = (const bf16_t*)(p.ws + OFF_AG);
  const float* U = (const float*)(p.ws + OFF_U);
  bf16_t* MIX = (bf16_t*)(p.ws + OFF_MIX);
#pragma unroll
  for (int h = 0; h < 2; ++h) {
    u32x4 av[3], gv[3]; bool in[3];
#pragma unroll
    for (int q = 0; q < 3; ++q) {
      const int idx = tid + (h * 3 + q) * 512, rr = idx >> 5, ch = (idx & 31) * 8, t = t0 - 15 + rr;
      in[q] = idx < 94 * 32 && t >= base && t < base + n;
      const size_t off = (size_t)(in[q] ? t : t0) * 512 + ch;
      av[q] = *(const u32x4*)(AG + off); gv[q] = *(const u32x4*)(AG + off + 256);
    }
#pragma unroll
    for (int q = 0; q < 3; ++q) {
      const int idx = tid + (h * 3 + q) * 512, rr = idx >> 5, ch = (idx & 31) * 8;
      u32x4 out = {0u, 0u, 0u, 0u};
      if (in[q]) {
#pragma unroll
        for (int i = 0; i < 4; ++i) {
          const float a0 = __uint_as_float(av[q][i] << 16), a1 = __uint_as_float(av[q][i] & 0xffff0000u);
          const float g0 = __uint_as_float(gv[q][i] << 16), g1 = __uint_as_float(gv[q][i] & 0xffff0000u);
          out[i] = cvtpk(a0 / (1.f + __expf(-g0)), a1 / (1.f + __expf(-g1)));
        }
      }
      if (idx < 94 * 32) *(LAS u32x4*)(lds + PC_U + (rr * 256 + ch) * 2) = out;
    }
  }
  __syncthreads();
  {
    const int c = tid & 255, th = tid >> 8;
    float w[31];
#pragma unroll
    for (int j = 0; j < 31; ++j) w[j] = p.w_dw[(size_t)layer * 31 * 256 + j * 256 + c];
    const float b = p.b_dw[layer * 256 + c];
    float acc[32];
#pragma unroll
    for (int i = 0; i < 32; ++i) acc[i] = b;
    const LAS bf16_t* up = (const LAS bf16_t*)(lds + PC_U) + (th * 32) * 256 + c;
#pragma unroll
    for (int rr = 0; rr < 62; ++rr) {
      const float uv = bf2f(up[rr * 256]);
#pragma unroll
      for (int i = 0; i < 32; ++i) if (rr - i >= 0 && rr - i < 31) acc[i] += uv * w[rr - i];
    }
    LAS float* yp = (LAS float*)(lds + PC_Y) + (th * 32) * 256 + c;
#pragma unroll
    for (int i = 0; i < 32; ++i) yp[i * 256] = acc[i];
  }
  {
    const int c = tid & 255, th = tid >> 8, grp = c >> 6, w = 2 << grp, hw = w >> 1;
    const int tl0 = t0 - base + th * 32;
    float uv[48];
#pragma unroll
    for (int i = 0; i < 48; ++i) { const int j = tl0 - 8 + i; const bool in = j >= 0 && j < n; uv[i] = in ? U[(size_t)(base + j) * 256 + c] : 0.f; }
#pragma unroll
    for (int i = 0; i < 32; ++i) {
      const int tl = tl0 + i, lo = max(tl - hw, 0), hh = min(tl + hw, n);
      float s = 0.f;
#pragma unroll
      for (int d = -8; d < 8; ++d) if (d >= -hw && d < hw) s += uv[8 + i + d];
      const float pv = s / (float)(hh - lo) - uv[8 + i];
      const int tok = th * 32 + i, chunk = c >> 3, sw = (chunk & 16) | ((chunk ^ tok) & 15);
      *(LAS bf16_t*)(lds + PC_P + tok * 512 + sw * 16 + (c & 7) * 2) = f2bf(pv);
    }
  }
  __syncthreads();
  {
    const f32x4 g4 = *(const f32x4*)(p.cv_ln_g + layer * 256 + lane * 4), b4 = *(const f32x4*)(p.cv_ln_b + layer * 256 + lane * 4);
#pragma unroll
    for (int i = 0; i < 8; ++i) {
      const int tok = wid * 8 + i;
      const f32x4 y = *(const LAS f32x4*)(lds + PC_Y + (tok * 256 + lane * 4) * 4);
      const float mu = wave_sum(y[0] + y[1] + y[2] + y[3]) * (1.f / 256.f);
      const float d0 = y[0] - mu, d1 = y[1] - mu, d2 = y[2] - mu, d3 = y[3] - mu;
      const float rs = rsqrtf(wave_sum(d0 * d0 + d1 * d1 + d2 * d2 + d3 * d3) * (1.f / 256.f) + EPS);
      const float z0 = silu(d0 * rs * g4[0] + b4[0]), z1 = silu(d1 * rs * g4[1] + b4[1]), z2 = silu(d2 * rs * g4[2] + b4[2]), z3 = silu(d3 * rs * g4[3] + b4[3]);
      const int chunk = lane >> 1, sw = (chunk & 16) | ((chunk ^ tok) & 15);
      *(LAS u32x2*)(lds + PC_U + tok * 512 + sw * 16 + (lane & 1) * 8) = (u32x2){cvtpk(z0, z1), cvtpk(z2, z3)};
    }
  }
  __syncthreads();
  {
    const int tb = wid >> 2, dg = wid & 3, trow = tb * 32 + r32, t = t0 + trow;
    const bf16_t* Wt = (const bf16_t*)(p.ws + OFF_WPWT) + ((size_t)layer * 256 + dg * 64 + r32) * 256 + hi * 8;
    f32x16 acc0 = {}, acc1 = {};
#pragma unroll 8
    for (int ks = 0; ks < 16; ++ks) {
      const int chunk = 2 * ks + hi, sw = (chunk & 16) | ((chunk ^ trow) & 15);
      const bf16x8 zf = *(const LAS bf16x8*)(lds + PC_U + trow * 512 + sw * 16);
      const bf16x8 w0 = *(const bf16x8*)(Wt + ks * 16), w1 = *(const bf16x8*)(Wt + 32 * 256 + ks * 16);
      acc0 = __builtin_amdgcn_mfma_f32_32x32x16_bf16(w0, zf, acc0, 0, 0, 0);
      acc1 = __builtin_amdgcn_mfma_f32_32x32x16_bf16(w1, zf, acc1, 0, 0, 0);
    }
    bf16_t* dst = MIX + (size_t)t * D + 768 + dg * 64;
#pragma unroll
    for (int g = 0; g < 4; ++g) { *(u32x2*)(dst + 8 * g + 4 * hi) = pack4(acc0, g); *(u32x2*)(dst + 32 + 8 * g + 4 * hi) = pack4(acc1, g); }
    const bf16_t* Pt = (const bf16_t*)(p.ws + OFF_WPOOLT) + ((size_t)(layer * 4 + dg) * 64 + r32) * 64 + hi * 8;
    f32x16 pc0 = {}, pc1 = {};
#pragma unroll
    for (int ks = 0; ks < 4; ++ks) {
      const int chunk = dg * 8 + 2 * ks + hi, sw = (chunk & 16) | ((chunk ^ trow) & 15);
      const bf16x8 pf = *(const LAS bf16x8*)(lds + PC_P + trow * 512 + sw * 16);
      const bf16x8 w0 = *(const bf16x8*)(Pt + ks * 16), w1 = *(const bf16x8*)(Pt + 32 * 64 + ks * 16);
      pc0 = __builtin_amdgcn_mfma_f32_32x32x16_bf16(w0, pf, pc0, 0, 0, 0);
      pc1 = __builtin_amdgcn_mfma_f32_32x32x16_bf16(w1, pf, pc1, 0, 0, 0);
    }
    const float* psc = p.pool_scale + layer * 256 + dg * 64;
#pragma unroll
    for (int r = 0; r < 16; ++r) { pc0[r] *= psc[crow(r, hi)]; pc1[r] *= psc[32 + crow(r, hi)]; }
    bf16_t* pd = MIX + (size_t)t * D + 512 + dg * 64;
#pragma unroll
    for (int g = 0; g < 4; ++g) { *(u32x2*)(pd + 8 * g + 4 * hi) = pack4(pc0, g); *(u32x2*)(pd + 32 + 8 * g + 4 * hi) = pack4(pc1, g); }
  }
  __syncthreads();
}

__device__ __forceinline__ void phase_b(const Params& p, int layer, LAS char* lds, int bid, int nblk) {
  const int mode0 = ((const int*)(p.ws + OFF_FLAG))[0], vbig = ((const int*)(p.ws + OFF_FLAG))[1];
  const int mode = (mode0 == 2 && vbig != 0) ? 1 : mode0;
  const bool fast = mode != 0;
  const int nu = (520 - bid + nblk - 1) / nblk;
  for (int i = 0; i < nu; ++i) {
    const int u = bid + ((bid & 1) ? (nu - 1 - i) : i) * nblk;
    if (u < 256) { if (mode == 2) attn_unit8(p, lds, NCTX + (u >> 2) * 256, u & 3, TT); else if (mode == 1) attn_unit(p, lds, NCTX + (u >> 2) * 256, u & 3, TT); }
    else if (u < 260) { if (layer == 0) { if (mode == 2) attn_unit8(p, lds, 0, u - 256, NCTX); else if (mode == 1) attn_unit(p, lds, 0, u - 256, NCTX); } }
    else { const int tile = u - 260; if (layer == 0 || tile >= 4) poolconv_unit(p, layer, lds, tile); }
  }
  if (!fast) attn_fallback(p, layer, bid, nblk);
}

constexpr int NR = 2, NRA = 2;
__device__ __forceinline__ float hsum4(const f32x4 (&v)[4]) { float s = 0.f;
#pragma unroll
  for (int i = 0; i < 4; ++i) s += (v[i][0] + v[i][1]) + (v[i][2] + v[i][3]);
  return s; }
__device__ __forceinline__ float hsq4(const f32x4 (&v)[4], float mu) { float q = 0.f;
#pragma unroll
  for (int i = 0; i < 4; ++i) { const f32x4 d = v[i] - mu; q += (d[0] * d[0] + d[1] * d[1]) + (d[2] * d[2] + d[3] * d[3]); }
  return q; }
__device__ __forceinline__ f32x4 bf4(u32x2 w) { return (f32x4){__uint_as_float(w[0] << 16), __uint_as_float(w[0] & 0xffff0000u), __uint_as_float(w[1] << 16), __uint_as_float(w[1] & 0xffff0000u)}; }

__device__ __forceinline__ void phase_a0(const Params& p, int layer, int bid, int nblk) {
  const int wave = bid * 8 + (TIDX >> 6), lane = TIDX & 63, nw = nblk * 8;
  float* X = (float*)(p.ws + OFF_X);
  bf16_t* H = (bf16_t*)(p.ws + OFF_H);
  const bf16_t* OM = (const bf16_t*)(p.ws + OFF_OMOE);
  for (int rb = wave * NRA; rb < TT; rb += nw * NRA) {
    f32x4 v[NRA][4]; u32x2 oa[NRA][4], ob[NRA][4];
#pragma unroll
    for (int k = 0; k < NRA; ++k) {
      const int r = rb + k;
      const float* src = layer == 0 ? (r < NCTX ? p.ctx + (size_t)r * D : p.x + (size_t)(r - NCTX) * D) : X + (size_t)r * D;
#pragma unroll
      for (int i = 0; i < 4; ++i) { const int c = i * 256 + lane * 4; v[k][i] = *(const f32x4*)(src + c);
        if (layer != 0) { oa[k][i] = *(const u32x2*)(OM + ((size_t)r * 2 + 0) * D + c); ob[k][i] = *(const u32x2*)(OM + ((size_t)r * 2 + 1) * D + c); } }
    }
    if (layer != 0) {
#pragma unroll
      for (int k = 0; k < NRA; ++k) {
        const int r = rb + k, s = r < NCTX ? 1 : 0;
        const float* g2 = (const float*)(p.ws + OFF_MOD) + ((layer - 1) * 2 + s) * 6144 + 5 * D;
#pragma unroll
        for (int i = 0; i < 4; ++i) { const int c = i * 256 + lane * 4; v[k][i] = v[k][i] * ALPHA + *(const f32x4*)(g2 + c) * (bf4(oa[k][i]) + bf4(ob[k][i])); }
      }
      float mu[NRA], rs[NRA];
#pragma unroll
      for (int k = 0; k < NRA; ++k) mu[k] = wave_sum(hsum4(v[k])) * (1.f / D);
#pragma unroll
      for (int k = 0; k < NRA; ++k) rs[k] = rsqrtf(wave_sum(hsq4(v[k], mu[k])) * (1.f / D) + EPS);
      const float* g = p.ln2_g + (layer - 1) * D; const float* b = p.ln2_b + (layer - 1) * D;
#pragma unroll
      for (int k = 0; k < NRA; ++k)
#pragma unroll
        for (int i = 0; i < 4; ++i) { const int c = i * 256 + lane * 4; v[k][i] = (v[k][i] - mu[k]) * rs[k] * *(const f32x4*)(g + c) + *(const f32x4*)(b + c); *(f32x4*)(X + (size_t)(rb + k) * D + c) = v[k][i]; }
    }
    float mu[NRA], rs[NRA];
#pragma unroll
    for (int k = 0; k < NRA; ++k) mu[k] = wave_sum(hsum4(v[k])) * (1.f / D);
#pragma unroll
    for (int k = 0; k < NRA; ++k) rs[k] = rsqrtf(wave_sum(hsq4(v[k], mu[k])) * (1.f / D) + EPS);
#pragma unroll
    for (int k = 0; k < NRA; ++k) {
      const int r = rb + k, s = r < NCTX ? 1 : 0;
      const float* modp = (const float*)(p.ws + OFF_MOD) + (layer * 2 + s) * 6144;
#pragma unroll
      for (int i = 0; i < 4; ++i) {
        const int c = i * 256 + lane * 4;
        const f32x4 h = (v[k][i] - mu[k]) * rs[k] * (*(const f32x4*)(modp + D + c) + 1.f) + *(const f32x4*)(modp + c);
        *(u32x2*)(H + (size_t)r * D + c) = (u32x2){cvtpk(h[0], h[1]), cvtpk(h[2], h[3])};
      }
    }
  }
}

__device__ __forceinline__ void phase_c2(const Params& p, int layer, LAS char* lds, int bid, int nblk) {
  const int tid = TIDX, wid = tid >> 6, lane = tid & 63;
  float* X = (float*)(p.ws + OFF_X);
  const bf16_t* Y = (const bf16_t*)(p.ws + OFF_Y);
  bf16_t* H2 = (bf16_t*)(p.ws + OFF_MIX);
  int* cnt = (int*)(p.ws + OFF_CNT) + layer * NE * CNT_STRIDE;
  float* GATE = (float*)(p.ws + OFF_GATE); int* LIST = (int*)(p.ws + OFF_LIST);
  LAS int* lcnt = (LAS int*)lds;
  LAS int* lbase = lcnt + 32;
  LAS int* ent = lcnt + 64;
  if (tid < 32) lcnt[tid] = 0;
  LAS float* wre = (LAS float*)(lds + 4096);
#pragma unroll
  for (int kk = 0; kk < 2; ++kk) {
    const int k = tid + kk * 512;
    f32x4 w[8];
#pragma unroll
    for (int g = 0; g < 8; ++g) w[g] = *(const f32x4*)(p.w_re + ((size_t)layer * D + k) * 32 + g * 4);
#pragma unroll
    for (int g = 0; g < 8; ++g)
#pragma unroll
      for (int j = 0; j < 4; ++j) wre[(g * 4 + j) * 1024 + k] = w[g][j];
  }
  __syncthreads();
  const int r0 = layer == 0 ? 0 : NCTX, nrows = TT - r0, rpb = (nrows + nblk - 1) / nblk;
  const int rbeg = r0 + bid * rpb, rend = min(rbeg + rpb, TT);
  for (int rb = rbeg + wid * NR; rb < rend; rb += 8 * NR) {
    f32x4 v[NR][4]; u32x2 yv[NR][4]; int rr[NR]; bool ok[NR];
#pragma unroll
    for (int k = 0; k < NR; ++k) {
      ok[k] = rb + k < rend; rr[k] = ok[k] ? rb + k : rb;
      const int r = rr[k];
      const float* xin = layer == 0 ? (r < NCTX ? p.ctx + (size_t)r * D : p.x + (size_t)(r - NCTX) * D) : X + (size_t)r * D;
#pragma unroll
      for (int i = 0; i < 4; ++i) { const int c = i * 256 + lane * 4; v[k][i] = *(const f32x4*)(xin + c); yv[k][i] = *(const u32x2*)(Y + (size_t)r * D + c); }
    }
#pragma unroll
    for (int k = 0; k < NR; ++k) {
      const float* modp = (const float*)(p.ws + OFF_MOD) + (layer * 2 + (rr[k] < NCTX ? 1 : 0)) * 6144;
#pragma unroll
      for (int i = 0; i < 4; ++i) { const int c = i * 256 + lane * 4; v[k][i] = v[k][i] * ALPHA + *(const f32x4*)(modp + 2 * D + c) * bf4(yv[k][i]); }
    }
    float mu[NR], rs[NR];
#pragma unroll
    for (int k = 0; k < NR; ++k) mu[k] = wave_sum(hsum4(v[k])) * (1.f / D);
#pragma unroll
    for (int k = 0; k < NR; ++k) rs[k] = rsqrtf(wave_sum(hsq4(v[k], mu[k])) * (1.f / D) + EPS);
#pragma unroll
    for (int k = 0; k < NR; ++k)
#pragma unroll
      for (int i = 0; i < 4; ++i) {
        const int c = i * 256 + lane * 4;
        v[k][i] = (v[k][i] - mu[k]) * rs[k] * *(const f32x4*)(p.ln1_g + layer * D + c) + *(const f32x4*)(p.ln1_b + layer * D + c);
        if (ok[k]) *(f32x4*)(X + (size_t)rr[k] * D + c) = v[k][i];
      }
#pragma unroll
    for (int k = 0; k < NR; ++k) mu[k] = wave_sum(hsum4(v[k])) * (1.f / D);
#pragma unroll
    for (int k = 0; k < NR; ++k) rs[k] = rsqrtf(wave_sum(hsq4(v[k], mu[k])) * (1.f / D) + EPS);
#pragma unroll
    for (int k = 0; k < NR; ++k) {
      const float* modp = (const float*)(p.ws + OFF_MOD) + (layer * 2 + (rr[k] < NCTX ? 1 : 0)) * 6144;
#pragma unroll
      for (int i = 0; i < 4; ++i) {
        const int c = i * 256 + lane * 4;
        v[k][i] = (v[k][i] - mu[k]) * rs[k] * (*(const f32x4*)(modp + 4 * D + c) + 1.f) + *(const f32x4*)(modp + 3 * D + c);
        if (ok[k]) *(u32x2*)(H2 + (size_t)rr[k] * D + c) = (u32x2){cvtpk(v[k][i][0], v[k][i][1]), cvtpk(v[k][i][2], v[k][i][3])};
      }
    }
    f32x4 lg[NR];
#pragma unroll
    for (int k = 0; k < NR; ++k) lg[k] = (f32x4){0.f, 0.f, 0.f, 0.f};
#pragma unroll
    for (int i = 0; i < 4; ++i)
#pragma unroll
      for (int j = 0; j < 4; ++j) { const f32x4 w = *(const f32x4*)(p.w_rg + ((size_t)layer * D + i * 256 + lane * 4 + j) * 4);
#pragma unroll
        for (int k = 0; k < NR; ++k) lg[k] += w * v[k][i][j]; }
    int gsel[NR]; float pgrp[NR];
#pragma unroll
    for (int k = 0; k < NR; ++k) {
      float l0 = wave_sum(lg[k][0]) + p.b_rg[layer * 4 + 0], l1 = wave_sum(lg[k][1]) + p.b_rg[layer * 4 + 1];
      float l2 = wave_sum(lg[k][2]) + p.b_rg[layer * 4 + 2], l3 = wave_sum(lg[k][3]) + p.b_rg[layer * 4 + 3];
      int gs = 0; float gm = l0;
      if (l1 > gm) { gm = l1; gs = 1; }
      if (l2 > gm) { gm = l2; gs = 2; }
      if (l3 > gm) { gm = l3; gs = 3; }
      gsel[k] = gs; pgrp[k] = 1.f / (__expf(l0 - gm) + __expf(l1 - gm) + __expf(l2 - gm) + __expf(l3 - gm));
    }
#pragma unroll
    for (int k = 0; k < NR; ++k) {
      float le[8];
#pragma unroll
      for (int e = 0; e < 8; ++e) {
        const LAS float* wr = wre + (gsel[k] * 8 + e) * 1024 + lane * 4;
        float a = 0.f;
#pragma unroll
        for (int i = 0; i < 4; ++i) { const f32x4 w = *(const LAS f32x4*)(wr + i * 256); a += (w[0] * v[k][i][0] + w[1] * v[k][i][1]) + (w[2] * v[k][i][2] + w[3] * v[k][i][3]); }
        le[e] = a;
      }
#pragma unroll
      for (int e = 0; e < 8; ++e) le[e] = wave_sum(le[e]) + p.b_re[layer * 32 + gsel[k] * 8 + e];
      int i0 = 0; float v0 = le[0];
#pragma unroll
      for (int e = 1; e < 8; ++e) if (le[e] > v0) { v0 = le[e]; i0 = e; }
      int i1 = -1; float v1 = -3.0e38f;
#pragma unroll
      for (int e = 0; e < 8; ++e) if (e != i0 && le[e] > v1) { v1 = le[e]; i1 = e; }
      if (i1 < 0) { i1 = (i0 + 1) & 7; v1 = v0; }
      const float e1 = __expf(v1 - v0);
      if (lane == 0 && ok[k]) {
        const int r = rr[k], xa = gsel[k] * 8 + i0, xb = gsel[k] * 8 + i1;
        const int pa = __hip_atomic_fetch_add(&lcnt[xa], 1, __ATOMIC_RELAXED, __HIP_MEMORY_SCOPE_WORKGROUP);
        const int pb = __hip_atomic_fetch_add(&lcnt[xb], 1, __ATOMIC_RELAXED, __HIP_MEMORY_SCOPE_WORKGROUP);
        const int li = (r - rbeg) * 2;
        ent[li * 3 + 0] = xa; ent[li * 3 + 1] = pa; ent[li * 3 + 2] = r * 2 + 0;
        ent[li * 3 + 3] = xb; ent[li * 3 + 4] = pb; ent[li * 3 + 5] = r * 2 + 1;
        GATE[r * 2] = pgrp[k] / (1.f + e1); GATE[r * 2 + 1] = pgrp[k] * e1 / (1.f + e1);
      }
    }
  }
  __syncthreads();
  if (tid < 32) { const int c = lcnt[tid]; lbase[tid] = c > 0 ? atomicAdd(&cnt[tid * CNT_STRIDE], c) : 0; }
  __syncthreads();
  for (int i = tid; i < (rend - rbeg) * 2; i += 512) { const int e = ent[i * 3], lp = ent[i * 3 + 1]; LIST[(size_t)e * CAPL + lbase[e] + lp] = ent[i * 3 + 2]; }
  __syncthreads();
}

__device__ __forceinline__ void phase_final(const Params& p, int bid, int nblk) {
  const int wave = bid * 8 + (TIDX >> 6), lane = TIDX & 63, nw = nblk * 8;
  const float* X = (const float*)(p.ws + OFF_X);
  const bf16_t* OM = (const bf16_t*)(p.ws + OFF_OMOE);
  const float* g2 = (const float*)(p.ws + OFF_MOD) + (1 * 2 + 0) * 6144 + 5 * D;
  for (int rb = NCTX + wave * NRA; rb < TT; rb += nw * NRA) {
    f32x4 v[NRA][4]; u32x2 oa[NRA][4], ob[NRA][4];
#pragma unroll
    for (int k = 0; k < NRA; ++k)
#pragma unroll
      for (int i = 0; i < 4; ++i) { const int c = i * 256 + lane * 4, r = rb + k;
        v[k][i] = *(const f32x4*)(X + (size_t)r * D + c); oa[k][i] = *(const u32x2*)(OM + ((size_t)r * 2 + 0) * D + c); ob[k][i] = *(const u32x2*)(OM + ((size_t)r * 2 + 1) * D + c); }
#pragma unroll
    for (int k = 0; k < NRA; ++k)
#pragma unroll
      for (int i = 0; i < 4; ++i) { const int c = i * 256 + lane * 4; v[k][i] = v[k][i] * ALPHA + *(const f32x4*)(g2 + c) * (bf4(oa[k][i]) + bf4(ob[k][i])); }
    float mu[NRA], rs[NRA];
#pragma unroll
    for (int k = 0; k < NRA; ++k) mu[k] = wave_sum(hsum4(v[k])) * (1.f / D);
#pragma unroll
    for (int k = 0; k < NRA; ++k) rs[k] = rsqrtf(wave_sum(hsq4(v[k], mu[k])) * (1.f / D) + EPS);
#pragma unroll
    for (int k = 0; k < NRA; ++k)
#pragma unroll
      for (int i = 0; i < 4; ++i) {
        const int c = i * 256 + lane * 4;
        *(f32x4*)(p.out + (size_t)(rb + k - NCTX) * D + c) = (v[k][i] - mu[k]) * rs[k] * *(const f32x4*)(p.ln2_g + D + c) + *(const f32x4*)(p.ln2_b + D + c);
      }
  }
}

__device__ __forceinline__ void phase_p0(const Params& p, LAS char* lds, int bid, int nblk) {
  const int tid = TIDX;
  const long gtid = (long)bid * 512 + tid, gth = (long)nblk * 512;
  LAS float* sc = (LAS float*)lds;
  LAS float* red = (LAS float*)(lds + 8192);
  for (int i = tid; i < 2048; i += 512) { const float v = i < 1024 ? p.c[i] : p.c_ctx[i - 1024]; sc[i] = silu(v); }
  __syncthreads();
  float* mod = (float*)(p.ws + OFF_MOD);
  for (int u = bid; u < 384; u += nblk) {
    const int layer = u / 192, cg = u % 192, col = tid & 31, ksl = tid >> 5;
    const float* w = p.w_mod + ((size_t)layer * D + ksl * 64) * 6144 + cg * 32 + col;
    float a0 = 0.f, a1 = 0.f;
#pragma unroll 8
    for (int k = 0; k < 64; ++k) { const float wv = w[(size_t)k * 6144]; a0 += sc[ksl * 64 + k] * wv; a1 += sc[1024 + ksl * 64 + k] * wv; }
    red[(ksl * 32 + col) * 2] = a0; red[(ksl * 32 + col) * 2 + 1] = a1;
    __syncthreads();
    if (tid < 64) {
      const int c2 = tid & 31, s = tid >> 5; float a = 0.f;
#pragma unroll
      for (int k = 0; k < 16; ++k) a += red[(k * 32 + c2) * 2 + s];
      mod[(layer * 2 + s) * 6144 + cg * 32 + c2] = a + p.b_mod[layer * 6144 + cg * 32 + c2];
    }
    __syncthreads();
  }
  if (gtid < 256 * 16) {
    const int pos = (int)gtid / 16, f = (int)gtid % 16;
    const float ang = (float)pos * powf(10000.f, -(float)f / 16.f);
    float* rt = (float*)(p.ws + OFF_ROPE);
    rt[gtid * 2 + 0] = cosf(ang); rt[gtid * 2 + 1] = sinf(ang);
  }
  if (gtid < 2 * NE * CNT_STRIDE) ((int*)(p.ws + OFF_CNT))[gtid] = 0;
  if (gtid == 0) {
    float bmax = 0.f;
    for (int l = 0; l < 2; ++l) {
      float gq = 0.f, gk = 0.f;
      for (int i = 0; i < 64; ++i) { gq = fmaxf(gq, fabsf(p.q_gain[l * 64 + i])); gk = fmaxf(gk, fabsf(p.k_gain[l * 64 + i])); }
      bmax = fmaxf(bmax, 11.55f * gq * gk);
    }
    ((int*)(p.ws + OFF_FLAG))[0] = bmax <= 13.2f ? 2 : (bmax <= 100.f ? 1 : 0);
    ((int*)(p.ws + OFF_FLAG))[1] = 0;
  }
  for (long i = gtid; i < 2 * 65536; i += gth) { const int l = (int)(i >> 16), d = (int)(i >> 8) & 255, c = (int)i & 255; ((bf16_t*)(p.ws + OFF_WPWT))[i] = f2bf(p.w_cv_pw[((size_t)l * 256 + c) * 256 + d]); }
  for (long i = gtid; i < 8 * 4096; i += gth) { const int lg = (int)(i >> 12), d = (int)(i >> 6) & 63, c = (int)i & 63; ((bf16_t*)(p.ws + OFF_WPOOLT))[i] = f2bf(p.w_pool[((size_t)lg * 64 + c) * 64 + d]); }
  cvt_range(p.w_in, (bf16_t*)(p.ws + OFF_WIN), 2L * D * INW / 8, gtid, gth);
  cvt_range(p.w_out, (bf16_t*)(p.ws + OFF_WOUT), 2L * D * D / 8, gtid, gth);
}
#define XB_TMO      128
#define XB_XCNT(j)  (256  + 64 * (j))
#define XB_XSUB(j)  (1280 + 64 * (j))
#define XB_XGEN(j)  (2304 + 64 * (j))
#define XB_TOP      3328
#define XB_TOPGEN   3392
#define XCD_BAR_WORDS 3456
#define XB_SPIN_CAP (1u << 22)
__device__ __forceinline__ unsigned xb_ld(unsigned* p)              { return __hip_atomic_load(p, __ATOMIC_RELAXED, __HIP_MEMORY_SCOPE_AGENT); }
__device__ __forceinline__ unsigned xb_add(unsigned* p, unsigned v) { return __hip_atomic_fetch_add(p, v, __ATOMIC_RELAXED, __HIP_MEMORY_SCOPE_AGENT); }
__device__ __forceinline__ unsigned xb_xcc_id() { return (unsigned)__builtin_amdgcn_s_getreg((3 << 11) | 20) & 0xFu; }
#define XB_SPIN(cond, bar) do { unsigned _sp = 0; while (cond) { __builtin_amdgcn_s_sleep(1); \
    if ((++_sp & 255u) == 0u) { if (xb_ld(&(bar)[XB_TMO])) break; if (_sp > XB_SPIN_CAP) { atomicAdd(&(bar)[XB_TMO], 1u); break; } } } } while (0)
struct XcdBarrier { unsigned* bar; unsigned x; volatile LAS unsigned* st; };
__device__ __forceinline__ XcdBarrier xcd_barrier_post(unsigned* bar, volatile LAS unsigned* st) {
  XcdBarrier b; b.bar = bar; b.x = xb_xcc_id(); b.st = st;
  if (threadIdx.x == 0) (void)xb_add(&bar[XB_XCNT(b.x)], 1u);
  return b;
}
__device__ __forceinline__ void xcd_barrier_complete(unsigned* bar, unsigned x, unsigned& nloc, unsigned& nx) {
  const unsigned G = gridDim.x * gridDim.y * gridDim.z;
  unsigned sum, cnt, mine, sp = 0u;
  for (;;) {
    sum = 0u; cnt = 0u; mine = 0u;
#pragma unroll
    for (unsigned j = 0; j < 16; ++j) { const unsigned c = xb_ld(&bar[XB_XCNT(j)]); sum += c; cnt += (c > 0u) ? 1u : 0u; mine = (j == x) ? c : mine; }
    if (sum == G) break;
    __builtin_amdgcn_s_sleep(1);
    if ((++sp & 255u) == 0u) { if (xb_ld(&bar[XB_TMO])) break; if (sp > XB_SPIN_CAP) { atomicAdd(&bar[XB_TMO], 1u); break; } }
  }
  nloc = mine > 0u ? mine : 1u; nx = cnt > 0u ? cnt : 1u;
}
__device__ __forceinline__ void xcd_barrier(const XcdBarrier& b) {
  asm volatile("s_waitcnt vmcnt(0)" ::: "memory");
  __syncthreads();
  if (threadIdx.x == 0) {
    unsigned* bar = b.bar; unsigned bx = b.x;
    asm volatile("" : "+s"(bar), "+s"(bx));
    __builtin_amdgcn_s_waitcnt(0);
    unsigned nloc = b.st[0], nx = b.st[1];
    if (nloc == 0u) { xcd_barrier_complete(bar, bx, nloc, nx); b.st[0] = nloc; b.st[1] = nx; }
    const unsigned old = xb_add(&bar[XB_XSUB(bx)], 1u);
    const unsigned gen = old / nloc;
    if (old + 1u == (gen + 1u) * nloc) {
      __builtin_amdgcn_fence(__ATOMIC_RELEASE, "agent");
      asm volatile("s_waitcnt vmcnt(0)" ::: "memory");
      const unsigned og = xb_add(&bar[XB_TOP], 1u);
      const unsigned tg = og / nx;
      if (og + 1u == (tg + 1u) * nx) xb_add(&bar[XB_TOPGEN], 1u);
      else XB_SPIN(xb_ld(&bar[XB_TOPGEN]) == tg, bar);
      __builtin_amdgcn_fence(__ATOMIC_ACQUIRE, "agent");
      xb_add(&bar[XB_XGEN(bx)], 1u);
      asm volatile("s_waitcnt vmcnt(0)" ::: "memory");
    } else {
      XB_SPIN(xb_ld(&bar[XB_XGEN(bx)]) == gen, bar);
      __builtin_amdgcn_fence(__ATOMIC_ACQUIRE, "agent");
      asm volatile("s_waitcnt vmcnt(0)" ::: "memory");
    }
  }
  __syncthreads();
}

constexpr int LDS_MAIN = PC_LDS > GEMM_LDS + 256 ? PC_LDS : GEMM_LDS + 256;
constexpr int LDS_TOTAL = LDS_MAIN + 16;
static_assert(GEMM_LDS + 256 <= LDS_MAIN && ATT_LDS <= LDS_MAIN, "lds");
__global__ void __launch_bounds__(512) mega_fwd(Params p) {
  __shared__ __attribute__((aligned(16))) char slds[LDS_TOTAL];
  LAS char* lds = (LAS char*)slds;
  volatile LAS unsigned* st = (volatile LAS unsigned*)(lds + LDS_MAIN);
  if (threadIdx.x < 4) st[threadIdx.x] = 0u;
  __syncthreads();
  const XcdBarrier bar = xcd_barrier_post((unsigned*)(p.ws + OFF_BAR), st);
  const int bid = blockIdx.x, nblk = gridDim.x;
  phase_p0(p, lds, bid, nblk);
  xcd_barrier(bar);
#pragma unroll 1
  for (int layer = 0; layer < 2; ++layer) {
    phase_a0(p, layer, bid, nblk);
    xcd_barrier(bar);
    phase_a1(p, layer, lds, bid, nblk);
    xcd_barrier(bar);
    phase_b(p, layer, lds, bid, nblk);
    xcd_barrier(bar);
    phase_c1(p, layer, lds, bid, nblk);
    xcd_barrier(bar);
    phase_c2(p, layer, lds, bid, nblk);
    xcd_barrier(bar);
    phase_d1(p, layer, lds, bid, nblk);
    xcd_barrier(bar);
    phase_d2(p, layer, lds, bid, nblk);
    xcd_barrier(bar);
  }
  phase_final(p, bid, nblk);
}

extern "C" void kernel_launch(void* const* d_in, const int* in_sizes, int n_in, void* d_out, int out_size, void* d_ws, size_t ws_size,
                              hipStream_t stream) {
  static int grid = 0;
  if (grid == 0) {
    if (ws_size < WS_END || n_in != 28) { fprintf(stderr, "kernel_launch: ws too small (%zu < %zu) or n_in %d != 28; nothing launched\n", ws_size, (size_t)WS_END, n_in); grid = -1; return; }
    int dev = 0, cus = 0, per_cu = 0;
    if (hipGetDevice(&dev) != hipSuccess || hipDeviceGetAttribute(&cus, hipDeviceAttributeMultiprocessorCount, dev) != hipSuccess) { grid = -1; return; }
    if (hipOccupancyMaxActiveBlocksPerMultiprocessor(&per_cu, (const void*)mega_fwd, 512, 0) != hipSuccess || per_cu < 1) {
      fprintf(stderr, "kernel_launch: occupancy query says %d blocks per CU; nothing launched\n", per_cu); grid = -1; return; }
    (void)hipGetLastError();
    grid = cus;
  }
  if (grid < 0) return;
  if (hipMemsetAsync((char*)d_ws + OFF_BAR, 0, BAR_BYTES, stream) != hipSuccess) { fprintf(stderr, "kernel_launch: memset failed\n"); return; }
  Params p{};
  const float** f = (const float**)&p;
  for (int i = 0; i < 28; ++i) f[i] = (const float*)d_in[i];
  p.out = (float*)d_out; p.ws = (char*)d_ws;
  hipLaunchKernelGGL(mega_fwd, dim3(grid), dim3(512), 0, stream, p);
}
```

```cpp
#include <hip/hip_runtime.h>
#include <cstdio>
#include <cstdint>

typedef unsigned short bf16_t;
#define LAS __attribute__((address_space(3)))

constexpr int D = 1024, SEQ = 16384, NCTX = 256, TT = SEQ + NCTX;
constexpr int INW = 1536;
constexpr int NE = 32, DE = 512;
constexpr int CAPL = 2 * TT;
constexpr int HMID_ROWS = 2 * TT + NE * 128;
constexpr float ALPHA = 1.41421356237309515f;
constexpr float EPS = 1e-6f;

constexpr size_t al(size_t x) { return (x + 255) / 256 * 256; }
constexpr size_t OFF_BAR = 0;
constexpr size_t BAR_BYTES = 3456 * 4;
constexpr size_t OFF_MOD = OFF_BAR + al(BAR_BYTES);
constexpr size_t OFF_ROPE = OFF_MOD + al(2 * 2 * 6144 * 4);
constexpr int CNT_STRIDE = 32;
constexpr size_t OFF_CNT = OFF_ROPE + al(256 * 16 * 2 * 4);
constexpr size_t OFF_FLAG = OFF_CNT + al(2 * 32 * 32 * 4);
constexpr size_t OFF_X = OFF_FLAG + 256;
constexpr size_t OFF_H = OFF_X + al((size_t)TT * D * 4);
constexpr size_t OFF_MIX = OFF_H + al((size_t)TT * D * 2);
constexpr size_t OFF_Y = OFF_MIX + al((size_t)TT * D * 2);
constexpr size_t OFF_Q = OFF_Y + al((size_t)TT * D * 2);
constexpr size_t OFF_K = OFF_Q + al((size_t)TT * 512 * 2);
constexpr size_t OFF_V = OFF_K + al((size_t)TT * 128 * 2);
constexpr size_t OFF_U = OFF_V + al((size_t)TT * 128 * 2);
constexpr size_t OFF_AG = OFF_U + al((size_t)TT * 256 * 4);
constexpr size_t OFF_HMID = OFF_Q;
constexpr size_t OFF_OMOE = OFF_AG + al((size_t)TT * 512 * 2);
constexpr size_t OFF_GATE = OFF_OMOE + al((size_t)TT * 2 * D * 2);
constexpr size_t OFF_LIST = OFF_GATE + al((size_t)TT * 2 * 4);
constexpr size_t OFF_WIN = OFF_LIST + al((size_t)NE * CAPL * 4);
constexpr size_t OFF_WOUT = OFF_WIN + al((size_t)2 * D * INW * 2);
constexpr size_t OFF_WPWT = OFF_WOUT + al((size_t)2 * D * D * 2);
constexpr size_t OFF_WPOOLT = OFF_WPWT + al((size_t)2 * 256 * 256 * 2);
constexpr size_t OFF_Q8 = OFF_WPOOLT + al((size_t)2 * 4 * 64 * 64 * 2);
constexpr size_t OFF_K8 = OFF_Q8 + al((size_t)TT * 512);
constexpr size_t OFF_VT8 = OFF_K8 + al((size_t)TT * 128);
constexpr size_t OFF_WG = OFF_VT8 + al((size_t)128 * TT);
constexpr size_t OFF_WU = OFF_WG + al((size_t)2 * NE * D * DE * 2);
constexpr size_t OFF_WD = OFF_WU + al((size_t)2 * NE * D * DE * 2);
constexpr size_t WS_END = OFF_WD + al((size_t)2 * NE * D * DE * 2);
static_assert(OFF_AG - OFF_HMID >= (size_t)HMID_ROWS * DE * 2, "HMID alias too small");
static_assert(WS_END < 530000000, "ws budget");

struct Params {
  const float *x, *c, *ctx, *c_ctx, *w_mod, *b_mod, *w_in, *q_gain, *k_gain, *w_pool, *pool_scale, *w_dw, *b_dw,
      *cv_ln_g, *cv_ln_b, *w_cv_pw, *w_out, *ln1_g, *ln1_b, *ln2_g, *ln2_b, *w_rg, *b_rg, *w_re, *b_re, *w_e_gate, *w_e_up, *w_e_down;
  float* out;
  char* ws;
};

__device__ __forceinline__ float bf2f(bf16_t v) { return __uint_as_float(((unsigned)v) << 16); }
__device__ __forceinline__ bf16_t f2bf(float f) {
  unsigned u = __float_as_uint(f);
  u += 0x7fffu + ((u >> 16) & 1u);
  return (bf16_t)(u >> 16);
}
template <int CTRL> __device__ __forceinline__ float dppf(float v) { return __int_as_float(__builtin_amdgcn_update_dpp(0, __float_as_int(v), CTRL, 0xf, 0xf, true)); }
__device__ __forceinline__ float wave_sum(float v) {
  v += dppf<0xB1>(v); v += dppf<0x4E>(v); v += dppf<0x141>(v); v += dppf<0x140>(v);
  { auto r = __builtin_amdgcn_permlane16_swap(__float_as_uint(v), __float_as_uint(v), false, false); v = __uint_as_float(r[0]) + __uint_as_float(r[1]); }
  { auto r = __builtin_amdgcn_permlane32_swap(__float_as_uint(v), __float_as_uint(v), false, false); v = __uint_as_float(r[0]) + __uint_as_float(r[1]); }
  return v;
}
__device__ __forceinline__ float silu(float v) { return v / (1.f + __expf(-v)); }
__device__ __forceinline__ int opaque0() { int z; asm volatile("s_mov_b32 %0, 0" : "=s"(z)); return z; }
#define TIDX ((int)threadIdx.x + opaque0())
using bf16x8 = __attribute__((ext_vector_type(8))) short;
using s16x4 = __attribute__((ext_vector_type(4))) short;
using f32x16 = __attribute__((ext_vector_type(16))) float;
using f32x4 = __attribute__((ext_vector_type(4))) float;
using u32x4 = __attribute__((ext_vector_type(4))) unsigned;
using u32x2 = __attribute__((ext_vector_type(2))) unsigned;

__device__ __forceinline__ int crow(int r, int hi) { return (r & 3) + 8 * (r >> 2) + 4 * hi; }
typedef float f32x2 __attribute__((ext_vector_type(2)));
typedef __bf16 bf16x2v __attribute__((ext_vector_type(2)));
__device__ __forceinline__ unsigned cvtpk(float lo, float hi) {
  bf16x2v b = __builtin_convertvector((f32x2){lo, hi}, bf16x2v);
  return __builtin_bit_cast(unsigned, b);
}
__device__ __forceinline__ float sum32(float v) {
  auto rr = __builtin_amdgcn_permlane32_swap(__float_as_uint(v), __float_as_uint(v), false, false);
  return __uint_as_float(rr[0]) + __uint_as_float(rr[1]);
}

__device__ __forceinline__ void cvt_range(const float* __restrict__ src, bf16_t* __restrict__ dst, long n8, long gtid, long gthreads) {
  for (long i = gtid; i < n8; i += gthreads) {
    const f32x4 a = *(const f32x4*)(src + i * 8), b = *(const f32x4*)(src + i * 8 + 4);
    u32x4 w = {cvtpk(a[0], a[1]), cvtpk(a[2], a[3]), cvtpk(b[0], b[1]), cvtpk(b[2], b[3])};
    *(u32x4*)(dst + i * 8) = w;
  }
}

__device__ __forceinline__ int xoff(int row, int chunk) { return row * 128 + ((chunk ^ ((row >> 1) & 7)) << 4); }
__device__ __forceinline__ int wst(int k, int c) { const int kk = (k & ~0xC) | ((k & 4) << 1) | ((k & 8) >> 1); return ((kk >> 3) * 4 + (c >> 5)) * 512 + ((kk & 7) * 32 + (c & 31)) * 2; }
__device__ __forceinline__ int v_rd_base(int lane) { return ((lane & 3) << 3) | (((lane >> 2) & 3) << 6) | (((lane >> 4) & 1) << 5) | (((lane >> 5) & 1) << 8); }

__device__ __forceinline__ bf16x8 tr_frag(const LAS char* p) {
  s16x4 a = __builtin_amdgcn_ds_read_tr16_b64_v4i16((LAS s16x4*)p);
  s16x4 b = __builtin_amdgcn_ds_read_tr16_b64_v4i16((LAS s16x4*)(p + 2048));
  return (bf16x8){a[0], a[1], a[2], a[3], b[0], b[1], b[2], b[3]};
}

template <int OFF> __device__ __forceinline__ bf16x8 tr_frag_asm(int addr) {
  s16x4 a, b;
  asm volatile("ds_read_b64_tr_b16 %0, %1 offset:%2" : "=&v"(a) : "v"(addr), "i"(OFF) : "memory");
  asm volatile("ds_read_b64_tr_b16 %0, %1 offset:%2" : "=&v"(b) : "v"(addr), "i"(OFF + 2048) : "memory");
  return (bf16x8){a[0], a[1], a[2], a[3], b[0], b[1], b[2], b[3]};
}

template <int BM, int BN> struct GemmCfg {
  static constexpr int WM = BM / 64, WN = 8 / WM, NSLAB = BN / 128, XB = BM * 128, WB = NSLAB * 16384, STAGE = XB + WB, NXP = BM / 64, NWP = NSLAB * 2;
  static_assert(WM * WN == 8 && WN * 64 == BN, "tile");
};
constexpr int GEMM_LDS = 3 * (256 * 128 + 16384);

template <int BM, int BN, int NMAP, bool BG = false, class XRow, class WPtr, class Pre>
__device__ __forceinline__ void gemm_mainloop(LAS char* lds, f32x16 (&acc)[2][2], const XRow& xrow, const WPtr& wptr, const Pre& pre, int sprev, int ldw, int K, int& bgdone, int bgn = 0, long bgc0 = 0,
                                              const float* bs0 = nullptr, const float* bs1 = nullptr, const float* bs2 = nullptr, bf16_t* bd0 = nullptr, bf16_t* bd1 = nullptr, bf16_t* bd2 = nullptr) {
#define BG_ADDR(i, off, SP, DP) long c_ = bgc0 + (long)(i) * 512 + (off); const bool ok_ = c_ < (3L << 21); if (!ok_) c_ = 0; const int t_ = (int)(c_ >> 21); const long o_ = (c_ & 0x1fffff) * 8; \
    const float* SP = (t_ == 0 ? bs0 : (t_ == 1 ? bs1 : bs2)) + o_; bf16_t* DP = (t_ == 0 ? bd0 : (t_ == 1 ? bd1 : bd2)) + o_
#define BG_ISSUE(i, off, a, b) do { BG_ADDR(i, off, sp_, dp_); (void)dp_; a = *(const f32x4*)sp_; b = *(const f32x4*)(sp_ + 4); } while (0)
#define BG_RETIRE(i, off, a, b) do { BG_ADDR(i, off, sp_, dp_); (void)sp_; if (ok_) *(u32x4*)dp_ = (u32x4){cvtpk(a[0], a[1]), cvtpk(a[2], a[3]), cvtpk(b[0], b[1]), cvtpk(b[2], b[3])}; } while (0)
#define BGA_ISSUE(i, off, a, b) do { BG_ADDR(i, off, sp_, dp_); (void)dp_; \
    asm volatile("global_load_dwordx4 %0, %2, off\n\tglobal_load_dwordx4 %1, %2, off offset:16" : "=&v"(a), "=&v"(b) : "v"(sp_) : "memory"); } while (0)
#define BGA_RETIRE(i, off, a, b) do { BG_ADDR(i, off, sp_, dp_); (void)sp_; const u32x4 w_ = {cvtpk(a[0], a[1]), cvtpk(a[2], a[3]), cvtpk(b[0], b[1]), cvtpk(b[2], b[3])}; \
    if (ok_) asm volatile("global_store_dwordx4 %0, %1, off" :: "v"(dp_), "v"(w_) : "memory"); } while (0)
  using C = GemmCfg<BM, BN>;
  const int tid = TIDX, wid = __builtin_amdgcn_readfirstlane(tid >> 6), lane = tid & 63, r32 = lane & 31, hi = lane >> 5;
  const int wm = wid / C::WN, wn = wid % C::WN;
  const bf16_t *g0, *g1, *g2, *g3, *g4, *g5, *g6 = nullptr, *g7 = nullptr, *g8 = nullptr, *g9 = nullptr, *g10 = nullptr, *g11 = nullptr;
  int l0, l1, l2, l3, l4, l5, l6 = 0, l7 = 0, l8 = 0, l9 = 0, l10 = 0, l11 = 0;
  auto xpieceq = [&](int q, const bf16_t*& gp, int& lp) { const int row = 8 * q + (lane >> 3), c = (lane & 7) ^ ((row >> 1) & 7); gp = xrow(row) + c * 8; lp = q * 1024; };
  auto wpieceq = [&](int idx, const bf16_t*& gp, int& lp) {
    const int s = idx >> 4, q = idx & 15, sub = 2 * q + (lane >> 5), kk = (sub >> 2) * 8 + ((lane & 31) >> 2);
    const int k = (kk & ~0xC) | ((kk & 4) << 1) | ((kk & 8) >> 1), c = (sub & 3) * 32 + (lane & 3) * 8;
    gp = wptr(s) + (size_t)k * ldw + c; lp = C::XB + s * 16384 + q * 1024; };
  const size_t stepx = 64, stepw = (size_t)64 * ldw;
  if (BG) {
    const int w4 = wid & 3;
    xpieceq(w4 * 8 + 0, g0, l0); xpieceq(w4 * 8 + 1, g1, l1); xpieceq(w4 * 8 + 2, g2, l2); xpieceq(w4 * 8 + 3, g3, l3);
    xpieceq(w4 * 8 + 4, g4, l4); xpieceq(w4 * 8 + 5, g5, l5); xpieceq(w4 * 8 + 6, g6, l6); xpieceq(w4 * 8 + 7, g7, l7);
    wpieceq(w4 * 4 + 0, g8, l8); wpieceq(w4 * 4 + 1, g9, l9); wpieceq(w4 * 4 + 2, g10, l10); wpieceq(w4 * 4 + 3, g11, l11);
  } else if (C::NXP == 4) { xpieceq(wid * 4 + 0, g0, l0); xpieceq(wid * 4 + 1, g1, l1); xpieceq(wid * 4 + 2, g2, l2); xpieceq(wid * 4 + 3, g3, l3); wpieceq(wid * 2 + 0, g4, l4); wpieceq(wid * 2 + 1, g5, l5); }
  else { xpieceq(wid * 2 + 0, g0, l0); xpieceq(wid * 2 + 1, g1, l1); wpieceq(wid * 4 + 0, g2, l2); wpieceq(wid * 4 + 1, g3, l3); wpieceq(wid * 4 + 2, g4, l4); wpieceq(wid * 4 + 3, g5, l5); }
  const size_t stp0 = stepx, stp1 = stepx, stp2 = (BG || C::NXP == 4) ? stepx : stepw, stp3 = (BG || C::NXP == 4) ? stepx : stepw, stp4 = BG ? stepx : stepw, stp5 = BG ? stepx : stepw;
  const bool dmaw = !BG || wid < 4;
  int xr[2];
#pragma unroll
  for (int ti = 0; ti < 2; ++ti) xr[ti] = (wm * 64 + ti * 32 + r32) * 128;
  const int xsw = (r32 >> 1) & 7;
  int wr[2];
#pragma unroll
  for (int ni = 0; ni < 2; ++ni) {
    const int slab = NMAP == 0 ? 0 : (NMAP == 1 ? (wn >> 1) : ni);
    const int nb = NMAP == 0 ? (2 * wn + ni) : (NMAP == 1 ? ((wn & 1) * 2 + ni) : wn);
    wr[ni] = C::XB + slab * 16384 + nb * 512 + v_rd_base(lane);
  }
  const int nk = K / 64;
#define G_DMA1(gp, sp, lp, kt, _d) __builtin_amdgcn_global_load_lds((const unsigned*)((gp) + (size_t)(kt) * (sp)), (LAS unsigned*)((_d) + (lp)), 16, 0, 0)
#define G_DMA(kt, st) do { if (dmaw) { LAS char* _d = lds + (st) * C::STAGE; \
    G_DMA1(g0, stp0, l0, kt, _d); G_DMA1(g1, stp1, l1, kt, _d); G_DMA1(g2, stp2, l2, kt, _d); G_DMA1(g3, stp3, l3, kt, _d); G_DMA1(g4, stp4, l4, kt, _d); G_DMA1(g5, stp5, l5, kt, _d); \
    if (BG) { G_DMA1(g6, stepx, l6, kt, _d); G_DMA1(g7, stepx, l7, kt, _d); G_DMA1(g8, stepw, l8, kt, _d); G_DMA1(g9, stepw, l9, kt, _d); G_DMA1(g10, stepw, l10, kt, _d); G_DMA1(g11, stepw, l11, kt, _d); } } } while (0)
#define G_HALF(cur, wa0, wa1, H) do { bf16x8 xf[2][2], wf[2][2]; \
      _Pragma("unroll") for (int k2 = 0; k2 < 2; ++k2) _Pragma("unroll") for (int ti = 0; ti < 2; ++ti) xf[k2][ti] = *(const LAS bf16x8*)(cur + xr[ti] + ((((H * 2 + k2) * 2 + hi) ^ xsw) << 4)); \
      wf[0][0] = tr_frag_asm<(H * 2 + 0) * 4096>(wa0); wf[0][1] = tr_frag_asm<(H * 2 + 0) * 4096>(wa1); \
      wf[1][0] = tr_frag_asm<(H * 2 + 1) * 4096>(wa0); wf[1][1] = tr_frag_asm<(H * 2 + 1) * 4096>(wa1); \
      asm volatile("s_waitcnt lgkmcnt(0)" ::: "memory"); __builtin_amdgcn_sched_barrier(0); \
      _Pragma("unroll") for (int k2 = 0; k2 < 2; ++k2) _Pragma("unroll") for (int ti = 0; ti < 2; ++ti) _Pragma("unroll") for (int ni = 0; ni < 2; ++ni) \
        acc[ti][ni] = __builtin_amdgcn_mfma_f32_32x32x16_bf16(wf[k2][ni], xf[k2][ti], acc[ti][ni], 0, 0, 0); } while (0)
#define G_COMPUTE(st) do { const LAS char* cur = lds + (st) * C::STAGE; const int wa0 = (int)(uintptr_t)(cur + wr[0]), wa1 = (int)(uintptr_t)(cur + wr[1]); \
    G_HALF(cur, wa0, wa1, 0); G_HALF(cur, wa0, wa1, 1); } while (0)
  static_assert(C::NXP + C::NWP == 6 && (!BG || (C::NXP == 4 && C::NWP == 2)), "piece counts assumed by the vmcnt waits");
  G_DMA(0, 0); G_DMA(1, 1);
  pre();
#pragma unroll
  for (int a_ = 0; a_ < 2; ++a_)
#pragma unroll
    for (int b_ = 0; b_ < 2; ++b_) acc[a_][b_] = (f32x16){};
  f32x4 b0a, b0b, b0c, b0d, b1a, b1b, b1c, b1d, b2a, b2b, b2c, b2d; int bi0 = -1, bi1 = -1, bi2 = -1;
  const int bgoff = tid - 256;
#define BG_SLOT(bi, xa, xb, xc, xd) do { if (bi >= 0) { asm volatile("s_waitcnt vmcnt(8)" ::: "memory");     \
      BGA_RETIRE(bi, bgoff, xa, xb); BGA_RETIRE(bi, bgoff + 256, xc, xd); bi = -1; } \
    if (bgdone < bgn) { bi = bgdone; BGA_ISSUE(bi, bgoff, xa, xb); BGA_ISSUE(bi, bgoff + 256, xc, xd); } } while (0)
#define G_STEP(kt, ST, bi, xa, xb, xc, xd) do { \
    if (dmaw) { if ((kt) + 1 < nk) { if (BG) asm volatile("s_waitcnt vmcnt(12)" ::: "memory"); \
                                     else if ((kt) < 2 && sprev >= 16) asm volatile("s_waitcnt vmcnt(22)" ::: "memory"); \
                                     else if ((kt) < 2 && sprev >= 8) asm volatile("s_waitcnt vmcnt(14)" ::: "memory"); \
                                     else asm volatile("s_waitcnt vmcnt(6)" ::: "memory"); } \
                else asm volatile("s_waitcnt vmcnt(0)" ::: "memory"); } \
    asm volatile("s_waitcnt lgkmcnt(0)" ::: "memory"); __builtin_amdgcn_s_barrier(); \
    if ((kt) + 2 < nk) G_DMA((kt) + 2, ((ST) + 2) % 3); \
    if (BG && !dmaw) BG_SLOT(bi, xa, xb, xc, xd); \
    if (BG && bgdone < bgn) ++bgdone; \
    G_COMPUTE(ST); } while (0)
  for (int kt = 0; kt < nk; kt += 3) {
    G_STEP(kt, 0, bi0, b0a, b0b, b0c, b0d);
    if (kt + 1 < nk) G_STEP(kt + 1, 1, bi1, b1a, b1b, b1c, b1d);
    if (kt + 2 < nk) G_STEP(kt + 2, 2, bi2, b2a, b2b, b2c, b2d);
  }
  if (BG && !dmaw) {
    asm volatile("s_waitcnt vmcnt(0)" ::: "memory");
    if (bi0 >= 0) { BGA_RETIRE(bi0, bgoff, b0a, b0b); BGA_RETIRE(bi0, bgoff + 256, b0c, b0d); }
    if (bi1 >= 0) { BGA_RETIRE(bi1, bgoff, b1a, b1b); BGA_RETIRE(bi1, bgoff + 256, b1c, b1d); }
    if (bi2 >= 0) { BGA_RETIRE(bi2, bgoff, b2a, b2b); BGA_RETIRE(bi2, bgoff + 256, b2c, b2d); }
    asm volatile("s_waitcnt vmcnt(0)" ::: "memory");
  }
#undef G_STEP
#undef BG_SLOT
  asm volatile("s_waitcnt lgkmcnt(0)" ::: "memory"); __builtin_amdgcn_s_barrier();
#undef G_DMA
#undef G_DMA1
#undef G_COMPUTE
#undef G_HALF
}

__device__ __forceinline__ unsigned pack4_fp8(const f32x16& a, int g) {
  int w = __builtin_amdgcn_cvt_pk_fp8_f32(a[4 * g], a[4 * g + 1], 0, false);
  w = __builtin_amdgcn_cvt_pk_fp8_f32(a[4 * g + 2], a[4 * g + 3], w, true);
  return (unsigned)w;
}
__device__ __forceinline__ u32x2 pack4(const f32x16& a, int g) { return (u32x2){cvtpk(a[4 * g], a[4 * g + 1]), cvtpk(a[4 * g + 2], a[4 * g + 3])}; }

__device__ __forceinline__ void phase_a1(const Params& p, int layer, LAS char* lds, int bid, int nblk) {
  const bf16_t* H = (const bf16_t*)(p.ws + OFF_H);
  const bf16_t* W = (const bf16_t*)(p.ws + OFF_WIN) + (size_t)layer * D * INW;
  bf16_t* Q = (bf16_t*)(p.ws + OFF_Q); bf16_t* Kb = (bf16_t*)(p.ws + OFF_K); bf16_t* Vb = (bf16_t*)(p.ws + OFF_V);
  float* U = (float*)(p.ws + OFF_U); bf16_t* AG = (bf16_t*)(p.ws + OFF_AG);
  unsigned char* Q8 = (unsigned char*)(p.ws + OFF_Q8); unsigned char* K8 = (unsigned char*)(p.ws + OFF_K8); unsigned char* VT8 = (unsigned char*)(p.ws + OFF_VT8);
  const float* rt = (const float*)(p.ws + OFF_ROPE);
  const int lane = TIDX & 63, wid = TIDX >> 6, r32 = lane & 31, hi = lane >> 5, wm = wid >> 1, wn = wid & 1;
  const size_t wo = (size_t)layer * NE * D * DE;
  const int bgn = (3 * (1 << 21) + nblk * 512 - 1) / (nblk * 512);
  const long bgc0 = (long)bid * bgn * 512;
  const float* bs0 = p.w_e_gate + wo; const float* bs1 = p.w_e_up + wo; const float* bs2 = p.w_e_down + wo;
  bf16_t* bd0 = (bf16_t*)(p.ws + OFF_WG) + wo; bf16_t* bd1 = (bf16_t*)(p.ws + OFF_WU) + wo; bf16_t* bd2 = (bf16_t*)(p.ws + OFF_WD) + wo;
  int bgdone = 0;
  const int nlat = 64 * 12, nctx = layer == 0 ? 12 : 2, nunits = nlat + nctx;
  const bool xmap = (nblk & 7) == 0;
  const int xcd = bid & 7, lb = bid >> 3, nlb = nblk >> 3, nl = lb < 96 ? (96 - lb + nlb - 1) / nlb : 0;
  for (int it = 0;; ++it) {
    int rtile, ct;
    if (xmap) {
      if (it < nl) { const int v = lb + it * nlb; rtile = 1 + xcd + 8 * (v / 12); ct = v % 12; }
      else { const int e2 = bid + (it - nl) * nblk; if (e2 >= nctx) break; rtile = 0; ct = layer == 0 ? e2 : 4 + e2; }
    } else {
      const int u = bid + it * nblk; if (u >= nunits) break;
      if (u < nlat) { rtile = 1 + u / 12; ct = u % 12; } else { rtile = 0; ct = layer == 0 ? (u - nlat) : (4 + u - nlat); }
    }
    const int m0 = rtile * 256, n0 = ct * 128;
    f32x16 acc[2][2];
#pragma unroll
    for (int a = 0; a < 2; ++a)
#pragma unroll
      for (int b = 0; b < 2; ++b) acc[a][b] = (f32x16){};
    gemm_mainloop<256, 128, 0, true>(lds, acc, [&](int row) { return H + (size_t)(m0 + row) * D; }, [&](int) { return W + n0; }, []() {}, 0, INW, D, bgdone, bgn, bgc0, bs0, bs1, bs2, bd0, bd1, bd2);
#pragma unroll
    for (int ti = 0; ti < 2; ++ti) {
      const int tok = m0 + wm * 64 + ti * 32 + r32;
      if (ct < 5) {
        float ss = 0.f;
#pragma unroll
        for (int ni = 0; ni < 2; ++ni)
#pragma unroll
          for (int r = 0; r < 16; ++r) ss += acc[ti][ni][r] * acc[ti][ni][r];
        ss = sum32(ss);
        const float rs = rsqrtf(ss * (1.f / 64.f) + EPS);
        const float* gain = (ct < 4 ? p.q_gain : p.k_gain) + layer * 64;
        const float osc = ct < 4 ? 0.125f * 1.4426950408889634f : 1.f;
        const bool lat = rtile > 0;
        const int t = tok - NCTX;
#pragma unroll
        for (int ni = 0; ni < 2; ++ni) {
          f32x16 v;
#pragma unroll
          for (int r = 0; r < 16; ++r) v[r] = acc[ti][ni][r] * rs * gain[ni * 32 + crow(r, hi)];
          if (lat) {
            const int pos = ni == 0 ? (t >> 6) : (t & 63);
#pragma unroll
            for (int r = 0; r < 8; ++r) {
              const int f = crow(r, hi);
              const float cs = rt[(pos * 16 + f) * 2], sn = rt[(pos * 16 + f) * 2 + 1];
              const float t1 = v[r], t2 = v[r + 8];
              v[r] = t1 * cs - t2 * sn; v[r + 8] = t2 * cs + t1 * sn;
            }
          }
#pragma unroll
          for (int r = 0; r < 16; ++r) v[r] *= osc;
          bf16_t* dst = ct < 4 ? Q + (size_t)tok * 512 + (ct * 2 + wn) * 64 + ni * 32 : Kb + (size_t)tok * 128 + wn * 64 + ni * 32;
          unsigned char* dst8 = ct < 4 ? Q8 + (size_t)tok * 512 + (ct * 2 + wn) * 64 + ni * 32 : K8 + (size_t)tok * 128 + wn * 64 + ni * 32;
#pragma unroll
          for (int g = 0; g < 4; ++g) { *(u32x2*)(dst + 8 * g + 4 * hi) = pack4(v, g); *(unsigned*)(dst8 + 8 * g + 4 * hi) = pack4_fp8(v, g); }
        }
      } else if (ct == 5) {
#pragma unroll
        for (int ni = 0; ni < 2; ++ni) {
#pragma unroll
          for (int g = 0; g < 4; ++g) *(u32x2*)(Vb + (size_t)tok * 128 + wn * 64 + ni * 32 + 8 * g + 4 * hi) = pack4(acc[ti][ni], g);
          float vmx = 0.f;
#pragma unroll
          for (int r = 0; r < 16; ++r) {
            const float vv = acc[ti][ni][r]; vmx = fmaxf(vmx, fabsf(vv));
            VT8[(size_t)(wn * 64 + ni * 32 + crow(r, hi)) * TT + tok] = (unsigned char)(__builtin_amdgcn_cvt_pk_fp8_f32(vv, vv, 0, false) & 0xff);
          }
          if (!(vmx <= 400.f)) atomicOr((int*)(p.ws + OFF_FLAG) + 1, 1);
        }
      } else if (ct < 8) {
#pragma unroll
        for (int ni = 0; ni < 2; ++ni)
#pragma unroll
          for (int g = 0; g < 4; ++g)
            *(f32x4*)(U + (size_t)tok * 256 + (ct - 6) * 128 + wn * 64 + ni * 32 + 8 * g + 4 * hi) =
                (f32x4){acc[ti][ni][4 * g], acc[ti][ni][4 * g + 1], acc[ti][ni][4 * g + 2], acc[ti][ni][4 * g + 3]};
      } else {
#pragma unroll
        for (int ni = 0; ni < 2; ++ni)
#pragma unroll
          for (int g = 0; g < 4; ++g) *(u32x2*)(AG + (size_t)tok * 512 + (ct - 8) * 128 + wn * 64 + ni * 32 + 8 * g + 4 * hi) = pack4(acc[ti][ni], g);
      }
    }
  }
  { const int tid = TIDX; while (bgdone < bgn) { f32x4 a, b2; const int i = bgdone++; BG_ISSUE(i, tid, a, b2); BG_RETIRE(i, tid, a, b2); } }
}

__device__ __forceinline__ void phase_c1(const Params& p, int layer, LAS char* lds, int bid, int nblk) {
  const bf16_t* A = (const bf16_t*)(p.ws + OFF_MIX);
  const bf16_t* W = (const bf16_t*)(p.ws + OFF_WOUT) + (size_t)layer * D * D;
  bf16_t* Y = (bf16_t*)(p.ws + OFF_Y);
  const int lane = TIDX & 63, wid = TIDX >> 6, r32 = lane & 31, hi = lane >> 5, wm = wid >> 1, wn = wid & 1;
  const int nctx = layer == 0 ? 8 : 0;
  const bool xmap = (nblk & 7) == 0;
  const int xcd = bid & 7, lb = bid >> 3, nlb = nblk >> 3, nl = lb < 64 ? (64 - lb + nlb - 1) / nlb : 0;
  f32x16 acc[2][2];
  int pm0 = 0, pn0 = 0; bool have = false;
  auto epi = [&acc, Y, wm, wn, r32, hi](int m0, int n0) {
#pragma unroll
    for (int ti = 0; ti < 2; ++ti) {
      const int tok = m0 + wm * 64 + ti * 32 + r32;
#pragma unroll
      for (int ni = 0; ni < 2; ++ni)
#pragma unroll
        for (int g = 0; g < 4; ++g) *(u32x2*)(Y + (size_t)tok * D + n0 + wn * 64 + ni * 32 + 8 * g + 4 * hi) = pack4(acc[ti][ni], g);
    }
  };
  for (int it = 0;; ++it) {
    int rtile, ct;
    if (xmap) {
      if (it < nl) { const int v = lb + it * nlb; rtile = 1 + xcd + 8 * (v >> 3); ct = v & 7; }
      else { const int e2 = bid + (it - nl) * nblk; if (e2 >= nctx) break; rtile = 0; ct = e2; }
    } else {
      const int u = bid + it * nblk; if (u >= 64 * 8 + nctx) break;
      if (u < 512) { rtile = 1 + (u >> 3); ct = u & 7; } else { rtile = 0; ct = u - 512; }
    }
    const int m0 = rtile * 256, n0 = ct * 128;
    { int nd = 0; gemm_mainloop<256, 128, 0>(lds, acc, [&](int row) { return A + (size_t)(m0 + row) * D; }, [&](int) { return W + n0; }, [epi, have, pm0, pn0]() { if (have) epi(pm0, pn0); },
                                             have ? 16 : 0, D, D, nd); }
    pm0 = m0; pn0 = n0; have = true;
  }
  if (have) epi(pm0, pn0);
}

#ifndef MOE_XCD_MAP
#define MOE_XCD_MAP 0
#endif
__device__ __forceinline__ void moe_prefix(const int* cnt, LAS int* pre, int xcd) {
  if (TIDX == 0) {
    int o = 0; for (int e = 0; e < NE; ++e) { pre[e] = o; o += (cnt[e * CNT_STRIDE] + 127) >> 7; } pre[NE] = o;
    int l = 0; for (int j = 0; j < 4; ++j) { pre[40 + j] = l; l += (cnt[(xcd + 8 * j) * CNT_STRIDE] + 127) >> 7; } pre[44] = l;
  }
  if (TIDX >= 64 && TIDX < 64 + NE) pre[48 + TIDX - 64] = cnt[(TIDX - 64) * CNT_STRIDE];
  __syncthreads();
}
__device__ __forceinline__ bool moe_unit(const LAS int* pre, int bid, int nblk, int it, int& e, int& rt, int& ct, int& g) {
  if (MOE_XCD_MAP && (nblk & 7) == 0) {
    const int xcd = bid & 7, v = (bid >> 3) + it * (nblk >> 3), gl = v >> 2;
    if (gl >= pre[44]) return false;
    int j = 0; if (gl >= pre[41]) j = 1; if (gl >= pre[42]) j = 2; if (gl >= pre[43]) j = 3;
    e = xcd + 8 * j; rt = gl - pre[40 + j]; ct = v & 3; g = pre[e] + rt; return true;
  } else {
    const int u = bid + it * nblk; g = u >> 2; if (g >= pre[NE]) return false;
    int ee = 0; for (int i = 1; i < NE; ++i) ee += (pre[i] <= g) ? 1 : 0;
    e = ee; rt = g - pre[ee]; ct = u & 3; return true;
  }
}

__device__ __forceinline__ void phase_d1(const Params& p, int layer, LAS char* lds, int bid, int nblk) {
  const int* cnt = (const int*)(p.ws + OFF_CNT) + layer * NE * CNT_STRIDE;
  const bf16_t* H2 = (const bf16_t*)(p.ws + OFF_MIX);
  bf16_t* HM = (bf16_t*)(p.ws + OFF_HMID);
  LAS int* pre = (LAS int*)(lds + GEMM_LDS);
  moe_prefix(cnt, pre, bid & 7);
  const int lane = TIDX & 63, wid = TIDX >> 6, r32 = lane & 31, hi = lane >> 5, wm = wid >> 2, wn = wid & 3;
  f32x16 acc[2][2];
  int pg = 0, pct = 0; bool have = false;
  auto epi = [&acc, HM, wm, wn, r32, hi](int pg, int pct) {
    const size_t hrow0 = (size_t)pg * 128;
#pragma unroll
    for (int ti = 0; ti < 2; ++ti) {
      const size_t row = hrow0 + wm * 64 + ti * 32 + r32;
      f32x16 a;
#pragma unroll
      for (int r = 0; r < 16; ++r) { const float gv = acc[ti][0][r]; a[r] = gv / (1.f + __expf(-gv)) * acc[ti][1][r]; }
#pragma unroll
      for (int gq = 0; gq < 4; ++gq) *(u32x2*)(HM + row * DE + pct * 128 + wn * 32 + 8 * gq + 4 * hi) = pack4(a, gq);
    }
  };
  for (int it = 0;; ++it) {
    int e, rt, ct, g; if (!moe_unit(pre, bid, nblk, it, e, rt, ct, g)) break;
    const int n = pre[48 + e];
    const int* list = (const int*)(p.ws + OFF_LIST) + (size_t)e * CAPL + rt * 128;
    const bf16_t* Wg = (const bf16_t*)(p.ws + OFF_WG) + ((size_t)layer * NE + e) * D * DE + ct * 128;
    const bf16_t* Wu = (const bf16_t*)(p.ws + OFF_WU) + ((size_t)layer * NE + e) * D * DE + ct * 128;
    const int nvalid = n - rt * 128;
    int nd = 0;
    gemm_mainloop<128, 256, 2>(lds, acc, [&](int row) { const int tok = row < nvalid ? (list[row] >> 1) : 0; return H2 + (size_t)tok * D; },
                               [&](int s) { return s == 0 ? Wg : Wu; }, [epi, have, pg, pct]() { if (have) epi(pg, pct); }, have ? 8 : 0, DE, D, nd);
    pg = g; pct = ct; have = true;
  }
  if (have) epi(pg, pct);
}

__device__ __forceinline__ void phase_d2(const Params& p, int layer, LAS char* lds, int bid, int nblk) {
  const int* cnt = (const int*)(p.ws + OFF_CNT) + layer * NE * CNT_STRIDE;
  const bf16_t* HM = (const bf16_t*)(p.ws + OFF_HMID);
  const float* GATE = (const float*)(p.ws + OFF_GATE);
  bf16_t* OM = (bf16_t*)(p.ws + OFF_OMOE);
  LAS int* pre = (LAS int*)(lds + GEMM_LDS);
  moe_prefix(cnt, pre, bid & 7);
  const int lane = TIDX & 63, wid = TIDX >> 6, r32 = lane & 31, hi = lane >> 5, wm = wid >> 2, wn = wid & 3;
  f32x16 acc[2][2];
  int pts0 = -1, pts1 = -1, pct = 0; float pgt0 = 0.f, pgt1 = 0.f; bool have = false, pfull = false;
  auto epi = [&acc, OM, wn, hi](int ts0, int ts1, float gt0, float gt1, int pct) {
#pragma unroll
    for (int ti = 0; ti < 2; ++ti) {
      const int ts = ti == 0 ? ts0 : ts1;
      const float gt = ti == 0 ? gt0 : gt1;
      if (ts >= 0) {
#pragma unroll
        for (int ni = 0; ni < 2; ++ni) {
          f32x16 a;
#pragma unroll
          for (int r = 0; r < 16; ++r) a[r] = acc[ti][ni][r] * gt;
#pragma unroll
          for (int gq = 0; gq < 4; ++gq) *(u32x2*)(OM + (size_t)ts * D + pct * 256 + wn * 64 + ni * 32 + 8 * gq + 4 * hi) = pack4(a, gq);
        }
      }
    }
  };
  for (int it = 0;; ++it) {
    int e, rt, ct, g; if (!moe_unit(pre, bid, nblk, it, e, rt, ct, g)) break;
    const int n = pre[48 + e];
    const int* list = (const int*)(p.ws + OFF_LIST) + (size_t)e * CAPL + rt * 128;
    const bf16_t* Wd = (const bf16_t*)(p.ws + OFF_WD) + ((size_t)layer * NE + e) * DE * D + ct * 256;
    const int nvalid = n - rt * 128;
    const bf16_t* A = HM + (size_t)g * 128 * DE;
    int ts0 = -1, ts1 = -1; float gt0 = 0.f, gt1 = 0.f;
    { int nd = 0; gemm_mainloop<128, 256, 1>(lds, acc, [&](int row) { return A + (size_t)row * DE; }, [&](int s) { return Wd + s * 128; },
                                             [&, epi, have, pts0, pts1, pgt0, pgt1, pct]() {
                                               const int row0 = wm * 64 + r32, row1 = row0 + 32;
                                               if (row0 < nvalid) ts0 = list[row0];
                                               if (row1 < nvalid) ts1 = list[row1];
                                               if (have) epi(pts0, pts1, pgt0, pgt1, pct);
                                               gt0 = GATE[ts0 < 0 ? 0 : ts0]; gt1 = GATE[ts1 < 0 ? 0 : ts1];
                                             }, (have && pfull) ? 16 : 0, D, DE, nd); }
    pts0 = ts0; pts1 = ts1; pgt0 = gt0; pgt1 = gt1; pct = ct; pfull = nvalid >= 128; have = true;
  }
  if (have) epi(pts0, pts1, pgt0, pgt1, pct);
}
constexpr int ATT_SLOT = 16384, ATT_LDS = 4 * ATT_SLOT;
__device__ __forceinline__ int vst64(int k, int c) { const int kk = (k & ~0xC) | ((k & 4) << 1) | ((k & 8) >> 1); return ((kk >> 3) * 2 + (c >> 5)) * 512 + ((kk & 7) * 32 + (c & 31)) * 2; }
__device__ __forceinline__ bf16x8 tr_frag64(const LAS char* p) {
  s16x4 a = __builtin_amdgcn_ds_read_tr16_b64_v4i16((LAS s16x4*)p);
  s16x4 b = __builtin_amdgcn_ds_read_tr16_b64_v4i16((LAS s16x4*)(p + 1024));
  return (bf16x8){a[0], a[1], a[2], a[3], b[0], b[1], b[2], b[3]};
}
__device__ __forceinline__ bf16x8 pk4(const f32x16& P, int B) {
  unsigned a0 = cvtpk(P[B + 0], P[B + 1]), a1 = cvtpk(P[B + 2], P[B + 3]), b0 = cvtpk(P[B + 4], P[B + 5]), b1 = cvtpk(P[B + 6], P[B + 7]);
  auto r0 = __builtin_amdgcn_permlane32_swap(a0, b0, false, false); auto r1 = __builtin_amdgcn_permlane32_swap(a1, b1, false, false);
  u32x4 w = {r0[0], r1[0], r0[1], r1[1]};
  return __builtin_bit_cast(bf16x8, w);
}
struct AttnCtx { int krd0, krd1, ksw, hi, vrd; };
#define SBAR() __builtin_amdgcn_sched_barrier(0)
__device__ __forceinline__ void att_kload(const LAS char* slot, const AttnCtx& c, bf16x8 (&kf)[8]) {
#pragma unroll
  for (int d0 = 0; d0 < 4; ++d0) {
    kf[2 * d0] = *(const LAS bf16x8*)(slot + c.krd0 + (((2 * d0 + c.hi) ^ c.ksw) << 4));
    kf[2 * d0 + 1] = *(const LAS bf16x8*)(slot + c.krd1 + (((2 * d0 + c.hi) ^ c.ksw) << 4));
  }
}
__device__ __forceinline__ void att_qk(const bf16x8 (&kf)[8], const bf16x8 (&qr)[4], f32x16& s0, f32x16& s1) {
  s0 = (f32x16){}; s1 = (f32x16){};
#pragma unroll
  for (int d0 = 0; d0 < 4; ++d0) {
    s0 = __builtin_amdgcn_mfma_f32_32x32x16_bf16(kf[2 * d0], qr[d0], s0, 0, 0, 0);
    s1 = __builtin_amdgcn_mfma_f32_32x32x16_bf16(kf[2 * d0 + 1], qr[d0], s1, 0, 0, 0);
  }
}
__device__ __forceinline__ void att_exp(f32x16& s, float& l) {
#pragma unroll
  for (int r = 0; r < 16; ++r) { s[r] = __builtin_amdgcn_exp2f(s[r]); l += s[r]; }
  asm volatile("" : "+v"(l));
}
template <int KS0>
__device__ __forceinline__ void att_vload(const LAS char* slot, const AttnCtx& c, bf16x8 (&vf)[4]) {
#pragma unroll
  for (int i = 0; i < 2; ++i) { vf[2 * i] = tr_frag64(slot + c.vrd + (KS0 + i) * 2048); vf[2 * i + 1] = tr_frag64(slot + c.vrd + 512 + (KS0 + i) * 2048); }
}
__device__ __forceinline__ void att_pv2(const bf16x8& pa, const bf16x8& pb, const bf16x8 (&vf)[4], f32x16& o0, f32x16& o1) {
  o0 = __builtin_amdgcn_mfma_f32_32x32x16_bf16(pa, vf[0], o0, 0, 0, 0);
  o1 = __builtin_amdgcn_mfma_f32_32x32x16_bf16(pa, vf[1], o1, 0, 0, 0);
  o0 = __builtin_amdgcn_mfma_f32_32x32x16_bf16(pb, vf[2], o0, 0, 0, 0);
  o1 = __builtin_amdgcn_mfma_f32_32x32x16_bf16(pb, vf[3], o1, 0, 0, 0);
}
__device__ __forceinline__ void attn_unit(const Params& p, LAS char* lds, int row0, int hp, int nkeys) {
  const bf16_t* Q = (const bf16_t*)(p.ws + OFF_Q); const bf16_t* Kb = (const bf16_t*)(p.ws + OFF_K); const bf16_t* Vb = (const bf16_t*)(p.ws + OFF_V);
  bf16_t* MIX = (bf16_t*)(p.ws + OFF_MIX);
  const int tid = TIDX, wid = tid >> 6, lane = tid & 63, r32 = lane & 31, hi = lane >> 5, kvh = hp >> 1;
  bf16x8 qa[4], qb[4];
  { const bf16_t* Qg = Q + (size_t)(row0 + wid * 32 + r32) * 512 + hp * 128 + hi * 8;
#pragma unroll
    for (int d0 = 0; d0 < 4; ++d0) { qa[d0] = *(const bf16x8*)(Qg + d0 * 16); qb[d0] = *(const bf16x8*)(Qg + 64 + d0 * 16); } }
  const bf16_t* Kg = Kb + (size_t)(tid >> 3) * 128 + kvh * 64 + (tid & 7) * 8;
  const bf16_t* Vg = Vb + (size_t)(tid >> 3) * 128 + kvh * 64 + (tid & 7) * 8;
  const int kst = xoff(tid >> 3, tid & 7), vstw = 8192 + vst64(tid >> 3, (tid & 7) * 8);
  AttnCtx c; c.krd0 = r32 * 128; c.krd1 = (32 + r32) * 128; c.ksw = (r32 >> 1) & 7; c.hi = hi; c.vrd = 8192 + v_rd_base(lane);
  const int NT = nkeys >> 6;
  f32x16 oa0 = {}, oa1 = {}, ob0 = {}, ob1 = {}; float la = 0.f, lb = 0.f;
  u32x4 ks, vs;
  {
    const u32x4 k0 = *(const u32x4*)Kg, k1 = *(const u32x4*)(Kg + 64 * 128), v0 = *(const u32x4*)Vg, v1 = *(const u32x4*)(Vg + 64 * 128);
    *(LAS u32x4*)(lds + kst) = k0; *(LAS u32x4*)(lds + ATT_SLOT + kst) = k1;
    *(LAS u32x4*)(lds + vstw) = v0; *(LAS u32x4*)(lds + ATT_SLOT + vstw) = v1;
    ks = *(const u32x4*)(Kg + 2 * 64 * 128); vs = *(const u32x4*)(Vg + 2 * 64 * 128);
  }
  __syncthreads();
  for (int j = 0; j < NT; ++j) {
    const LAS char* sl = lds + (j & 3) * ATT_SLOT;
    bf16x8 kf[8], vfa[4], vfb[4];
    f32x16 sa0, sa1, sb0, sb1;
    att_kload(sl, c, kf);
    SBAR();
    att_qk(kf, qa, sa0, sa1);
    SBAR();
    att_qk(kf, qb, sb0, sb1);
    att_exp(sa0, la); att_exp(sa1, la);
    SBAR();
    const bf16x8 pa0 = pk4(sa0, 0), pa1 = pk4(sa0, 8), pa2 = pk4(sa1, 0), pa3 = pk4(sa1, 8);
    att_vload<0>(sl, c, vfa);
    SBAR();
    att_pv2(pa0, pa1, vfa, oa0, oa1);
    att_exp(sb0, lb);
    att_vload<2>(sl, c, vfb);
    SBAR();
    att_pv2(pa2, pa3, vfb, oa0, oa1);
    att_exp(sb1, lb);
    const bf16x8 pb0 = pk4(sb0, 0), pb1 = pk4(sb0, 8), pb2 = pk4(sb1, 0), pb3 = pk4(sb1, 8);
    att_vload<0>(sl, c, vfa);
    SBAR();
    att_pv2(pb0, pb1, vfa, ob0, ob1);
    att_vload<2>(sl, c, vfb);
    SBAR();
    att_pv2(pb2, pb3, vfb, ob0, ob1);
    { LAS char* w = lds + ((j + 2) & 3) * ATT_SLOT;
      if (j + 2 < NT) { *(LAS u32x4*)(w + kst) = ks; *(LAS u32x4*)(w + vstw) = vs; }
      if (j + 3 < NT) { ks = *(const u32x4*)(Kg + (size_t)(j + 3) * 64 * 128); vs = *(const u32x4*)(Vg + (size_t)(j + 3) * 64 * 128); } }
    __syncthreads();
  }
  la = sum32(la); lb = sum32(lb);
  LAS float* li = (LAS float*)(lds + wid * 256);
  if (hi == 0) { li[r32] = la; li[32 + r32] = lb; }
  __syncthreads();
  bf16_t* Og = MIX + (size_t)(row0 + wid * 32) * D + hp * 128 + r32;
#pragma unroll
  for (int r = 0; r < 16; ++r) {
    const int orow = crow(r, hi);
    const float ra = __builtin_amdgcn_rcpf(li[orow]), rb = __builtin_amdgcn_rcpf(li[32 + orow]);
    Og[(size_t)orow * D] = f2bf(oa0[r] * ra); Og[(size_t)orow * D + 32] = f2bf(oa1[r] * ra);
    Og[(size_t)orow * D + 64] = f2bf(ob0[r] * rb); Og[(size_t)orow * D + 96] = f2bf(ob1[r] * rb);
  }
  __syncthreads();
}
typedef int i32x8 __attribute__((ext_vector_type(8)));
constexpr int A8_SLOT = 8192, A8_NSLOT = 8, A8_LDS = A8_NSLOT * A8_SLOT;
__device__ __forceinline__ int off8(int row, int chunk) { return row * 64 + ((chunk ^ ((row >> 2) & 3)) << 4); }
__device__ __forceinline__ i32x8 ld_frag8(const LAS char* tile, int row, int h) {
  const int sw = (row >> 2) & 3;
  const u32x4 lo = *(const LAS u32x4*)(tile + row * 64 + (((2 * h) ^ sw) << 4)), hi = *(const LAS u32x4*)(tile + row * 64 + (((2 * h + 1) ^ sw) << 4));
  return (i32x8){(int)lo[0], (int)lo[1], (int)lo[2], (int)lo[3], (int)hi[0], (int)hi[1], (int)hi[2], (int)hi[3]};
}
#define MX_FP8_FP8(a, b, c) __builtin_amdgcn_mfma_scale_f32_32x32x64_f8f6f4(a, b, c, 0, 0, 0, 0x7f7f7f7f, 0, 0x7f7f7f7f)
#define MX_BF8_FP8(a, b, c) __builtin_amdgcn_mfma_scale_f32_32x32x64_f8f6f4(a, b, c, 1, 0, 0, 0x7f7f7f7f, 0, 0x7f7f7f7f)
typedef _Float16 f16x2 __attribute__((ext_vector_type(2)));
__device__ __forceinline__ unsigned att8_code4(float s0, float s1, float s2, float s3) {
  const f16x2 four = {(_Float16)4.f, (_Float16)4.f}, bias = {(_Float16)1084.f, (_Float16)1084.f};
  const f16x2 x = __builtin_bit_cast(f16x2, __builtin_amdgcn_cvt_pkrtz(s0, s1)) * four + bias, y = __builtin_bit_cast(f16x2, __builtin_amdgcn_cvt_pkrtz(s2, s3)) * four + bias;
  return __builtin_amdgcn_perm(__builtin_bit_cast(unsigned, y), __builtin_bit_cast(unsigned, x), 0x06040200u);
}
__device__ __forceinline__ i32x8 att8_pack(const f32x16& p0, const f32x16& p1) {
  i32x8 w;
#pragma unroll
  for (int i = 0; i < 4; ++i) {
    const unsigned d = att8_code4(p0[4 * i], p0[4 * i + 1], p0[4 * i + 2], p0[4 * i + 3]), e = att8_code4(p1[4 * i], p1[4 * i + 1], p1[4 * i + 2], p1[4 * i + 3]);
    auto r = __builtin_amdgcn_permlane32_swap(d, e, false, false);
    w[2 * i] = (int)r[0]; w[2 * i + 1] = (int)r[1];
  }
  return w;
}
__device__ __forceinline__ void attn_unit8(const Params& p, LAS char* lds, int row0, int hp, int nkeys, bf16_t* MIXP = nullptr) {
  const unsigned char* Q8 = (const unsigned char*)(p.ws + OFF_Q8); const unsigned char* K8 = (const unsigned char*)(p.ws + OFF_K8); const unsigned char* VT8 = (const unsigned char*)(p.ws + OFF_VT8);
  bf16_t* MIX = MIXP ? MIXP : (bf16_t*)(p.ws + OFF_MIX);
  const int tid = TIDX, wid = tid >> 6, lane = tid & 63, r32 = lane & 31, hi = lane >> 5, kvh = hp >> 1;
  i32x8 qa, qb;
  { const unsigned char* Qg = Q8 + (size_t)(row0 + wid * 32 + r32) * 512 + hp * 128 + hi * 32;
    const u32x4 a0 = *(const u32x4*)Qg, a1 = *(const u32x4*)(Qg + 16), b0 = *(const u32x4*)(Qg + 64), b1 = *(const u32x4*)(Qg + 80);
    qa = (i32x8){(int)a0[0], (int)a0[1], (int)a0[2], (int)a0[3], (int)a1[0], (int)a1[1], (int)a1[2], (int)a1[3]};
    qb = (i32x8){(int)b0[0], (int)b0[1], (int)b0[2], (int)b0[3], (int)b1[0], (int)b1[1], (int)b1[2], (int)b1[3]}; }
  const int wv = __builtin_amdgcn_readfirstlane(wid);
  const int prow = (wv & 3) * 16 + (lane >> 2), pch = (lane & 3) ^ ((prow >> 2) & 3);
  const unsigned char* Sg = wv < 4 ? K8 + (size_t)prow * 128 + kvh * 64 + pch * 16 : VT8 + (size_t)(kvh * 64 + prow) * TT + pch * 16;
  const size_t sstep = wv < 4 ? (size_t)64 * 128 : (size_t)64;
  const int sdst = (wv < 4 ? 0 : 4096) + (wv & 3) * 1024;
#define A8_DMA(t) __builtin_amdgcn_global_load_lds((const unsigned*)(Sg + (size_t)(t) * sstep), (LAS unsigned*)(lds + ((t) & (A8_NSLOT - 1)) * A8_SLOT + sdst), 16, 0, 0)
  const int NT = nkeys >> 6;
  f32x16 oa0 = {}, oa1 = {}, ob0 = {}, ob1 = {}, ola = {}, olb = {};
  const i32x8 ones = {0x38383838, 0x38383838, 0x38383838, 0x38383838, 0x38383838, 0x38383838, 0x38383838, 0x38383838};
  A8_DMA(0); A8_DMA(1); if (NT > 2) { A8_DMA(2); A8_DMA(3); }
  for (int j = 0; j < NT; j += 2) {
    if (j + 2 < NT) asm volatile("s_waitcnt vmcnt(2)" ::: "memory"); else asm volatile("s_waitcnt vmcnt(0)" ::: "memory");
    asm volatile("s_waitcnt lgkmcnt(0)" ::: "memory"); __builtin_amdgcn_s_barrier();
    if (j + 4 < NT) { A8_DMA(j + 4); A8_DMA(j + 5); }
#pragma unroll
    for (int jj = 0; jj < 2; ++jj) {
      const LAS char* sl = lds + ((j + jj) & (A8_NSLOT - 1)) * A8_SLOT;
      f32x16 sa0 = {}, sa1 = {}, sb0 = {}, sb1 = {};
      const i32x8 kf0 = ld_frag8(sl, r32, hi), kf1 = ld_frag8(sl, 32 + r32, hi);
      SBAR();
      sa0 = MX_FP8_FP8(kf0, qa, sa0); sa1 = MX_FP8_FP8(kf1, qa, sa1);
      SBAR();
      sb0 = MX_FP8_FP8(kf0, qb, sb0); sb1 = MX_FP8_FP8(kf1, qb, sb1);
      SBAR();
      const i32x8 pa = att8_pack(sa0, sa1);
      const i32x8 vf0 = ld_frag8(sl + 4096, r32, hi), vf1 = ld_frag8(sl + 4096, 32 + r32, hi);
      SBAR();
      oa0 = MX_BF8_FP8(pa, vf0, oa0); oa1 = MX_BF8_FP8(pa, vf1, oa1); ola = MX_BF8_FP8(pa, ones, ola);
      const i32x8 pb = att8_pack(sb0, sb1);
      SBAR();
      ob0 = MX_BF8_FP8(pb, vf0, ob0); ob1 = MX_BF8_FP8(pb, vf1, ob1); olb = MX_BF8_FP8(pb, ones, olb);
    }
  }
#undef A8_DMA
  asm volatile("s_waitcnt lgkmcnt(0)" ::: "memory"); __builtin_amdgcn_s_barrier();
  bf16_t* Og = MIX + (size_t)(row0 + wid * 32) * D + hp * 128 + r32;
#pragma unroll
  for (int r = 0; r < 16; ++r) {
    const int orow = crow(r, hi);
    const float ra = __builtin_amdgcn_rcpf(ola[r]), rb = __builtin_amdgcn_rcpf(olb[r]);
    Og[(size_t)orow * D] = f2bf(oa0[r] * ra); Og[(size_t)orow * D + 32] = f2bf(oa1[r] * ra);
    Og[(size_t)orow * D + 64] = f2bf(ob0[r] * rb); Og[(size_t)orow * D + 96] = f2bf(ob1[r] * rb);
  }
  __syncthreads();
}
__device__ __forceinline__ void attn_fallback(const Params& p, int layer, int bid, int nblk) {
  const bf16_t* Q = (const bf16_t*)(p.ws + OFF_Q); const bf16_t* Kb = (const bf16_t*)(p.ws + OFF_K); const bf16_t* Vb = (const bf16_t*)(p.ws + OFF_V);
  bf16_t* MIX = (bf16_t*)(p.ws + OFF_MIX);
  const int lane = TIDX & 63, nwv = nblk * 8;
  const int rg0 = layer == 0 ? 0 : NCTX / 64;
  for (int wv = bid * 8 + (TIDX >> 6) + rg0 * 8; wv < (TT / 64) * 8; wv += nwv) {
    const int head = wv & 7, r = (wv >> 3) * 64 + lane, kvh = head >> 2;
    float q[64], o[64];
#pragma unroll
    for (int d = 0; d < 64; ++d) { q[d] = bf2f(Q[(size_t)r * 512 + head * 64 + d]); o[d] = 0.f; }
    float m = -1e30f, l = 0.f;
    const int nk = r >= NCTX ? TT : NCTX;
    for (int j = 0; j < nk; ++j) {
      const bf16_t* kr = Kb + (size_t)j * 128 + kvh * 64;
      const bf16_t* vr = Vb + (size_t)j * 128 + kvh * 64;
      float s = 0.f;
#pragma unroll
      for (int d = 0; d < 64; ++d) s += q[d] * bf2f(kr[d]);
      if (s > m) {
        const float a = __builtin_amdgcn_exp2f(m - s);
        l *= a;
#pragma unroll
        for (int d = 0; d < 64; ++d) o[d] *= a;
        m = s;
      }
      const float pe = __builtin_amdgcn_exp2f(s - m);
      l += pe;
#pragma unroll
      for (int d = 0; d < 64; ++d) o[d] += pe * bf2f(vr[d]);
    }
    const float il = 1.f / l;
#pragma unroll
    for (int d = 0; d < 64; ++d) MIX[(size_t)r * D + head * 64 + d] = f2bf(o[d] * il);
  }
}

constexpr int PC_U = 0;
constexpr int PC_Y = 49152;
constexpr int PC_P = PC_Y + 65536;
constexpr int PC_LDS = PC_P + 32768;
__device__ __forceinline__ void poolconv_unit(const Params& p, int layer, LAS char* lds, int tile) {
  const int tid = TIDX, wid = tid >> 6, lane = tid & 63, r32 = lane & 31, hi = lane >> 5;
  const int t0 = tile * 64, base = tile < 4 ? 0 : NCTX, n = tile < 4 ? NCTX : SEQ;
  const bf16_t* AG = (const bf16_t*)(p.ws + OFF_AG);
  const float* U = (const float*)(p.ws + OFF_U);
  bf16_t* MIX = (bf16_t*)(p.ws + OFF_MIX);
#pragma unroll
  for (int h = 0; h < 2; ++h) {
    u32x4 av[3], gv[3]; bool in[3];
#pragma unroll
    for (int q = 0; q < 3; ++q) {
      const int idx = tid + (h * 3 + q) * 512, rr = idx >> 5, ch = (idx & 31) * 8, t = t0 - 15 + rr;
      in[q] = idx < 94 * 32 && t >= base && t < base + n;
      const size_t off = (size_t)(in[q] ? t : t0) * 512 + ch;
      av[q] = *(const u32x4*)(AG + off); gv[q] = *(const u32x4*)(AG + off + 256);
    }
#pragma unroll
    for (int q = 0; q < 3; ++q) {
      const int idx = tid + (h * 3 + q) * 512, rr = idx >> 5, ch = (idx & 31) * 8;
      u32x4 out = {0u, 0u, 0u, 0u};
      if (in[q]) {
#pragma unroll
        for (int i = 0; i < 4; ++i) {
          const float a0 = __uint_as_float(av[q][i] << 16), a1 = __uint_as_float(av[q][i] & 0xffff0000u);
          const float g0 = __uint_as_float(gv[q][i] << 16), g1 = __uint_as_float(gv[q][i] & 0xffff0000u);
          out[i] = cvtpk(a0 / (1.f + __expf(-g0)), a1 / (1.f + __expf(-g1)));
        }
      }
      if (idx < 94 * 32) *(LAS u32x4*)(lds + PC_U + (rr * 256 + ch) * 2) = out;
    }
  }
  __syncthreads();
  {
    const int c = tid & 255, th = tid >> 8;
    float w[31];
#pragma unroll
    for (int j = 0; j < 31; ++j) w[j] = p.w_dw[(size_t)layer * 31 * 256 + j * 256 + c];
    const float b = p.b_dw[layer * 256 + c];
    float acc[32];
#pragma unroll
    for (int i = 0; i < 32; ++i) acc[i] = b;
    const LAS bf16_t* up = (const LAS bf16_t*)(lds + PC_U) + (th * 32) * 256 + c;
#pragma unroll
    for (int rr = 0; rr < 62; ++rr) {
      const float uv = bf2f(up[rr * 256]);
#pragma unroll
      for (int i = 0; i < 32; ++i) if (rr - i >= 0 && rr - i < 31) acc[i] += uv * w[rr - i];
    }
    LAS float* yp = (LAS float*)(lds + PC_Y) + (th * 32) * 256 + c;
#pragma unroll
    for (int i = 0; i < 32; ++i) yp[i * 256] = acc[i];
  }
  {
    const int c = tid & 255, th = tid >> 8, grp = c >> 6, w = 2 << grp, hw = w >> 1;
    const int tl0 = t0 - base + th * 32;
    float uv[48];
#pragma unroll
    for (int i = 0; i < 48; ++i) { const int j = tl0 - 8 + i; const bool in = j >= 0 && j < n; uv[i] = in ? U[(size_t)(base + j) * 256 + c] : 0.f; }
#pragma unroll
    for (int i = 0; i < 32; ++i) {
      const int tl = tl0 + i, lo = max(tl - hw, 0), hh = min(tl + hw, n);
      float s = 0.f;
#pragma unroll
      for (int d = -8; d < 8; ++d) if (d >= -hw && d < hw) s += uv[8 + i + d];
      const float pv = s / (float)(hh - lo) - uv[8 + i];
      const int tok = th * 32 + i, chunk = c >> 3, sw = (chunk & 16) | ((chunk ^ tok) & 15);
      *(LAS bf16_t*)(lds + PC_P + tok * 512 + sw * 16 + (c & 7) * 2) = f2bf(pv);
    }
  }
  __syncthreads();
  {
    const f32x4 g4 = *(const f32x4*)(p.cv_ln_g + layer * 256 + lane * 4), b4 = *(const f32x4*)(p.cv_ln_b + layer * 256 + lane * 4);
#pragma unroll
    for (int i = 0; i < 8; ++i) {
      const int tok = wid * 8 + i;
      const f32x4 y = *(const LAS f32x4*)(lds + PC_Y + (tok * 256 + lane * 4) * 4);
      const float mu = wave_sum(y[0] + y[1] + y[2] + y[3]) * (1.f / 256.f);
      const float d0 = y[0] - mu, d1 = y[1] - mu, d2 = y[2] - mu, d3 = y[3] - mu;
      const float rs = rsqrtf(wave_sum(d0 * d0 + d1 * d1 + d2 * d2 + d3 * d3) * (1.f / 256.f) + EPS);
      const float z0 = silu(d0 * rs * g4[0] + b4[0]), z1 = silu(d1 * rs * g4[1] + b4[1]), z2 = silu(d2 * rs * g4[2] + b4[2]), z3 = silu(d3 * rs * g4[3] + b4[3]);
      const int chunk = lane >> 1, sw = (chunk & 16) | ((chunk ^ tok) & 15);
      *(LAS u32x2*)(lds + PC_U + tok * 512 + sw * 16 + (lane & 1) * 8) = (u32x2){cvtpk(z0, z1), cvtpk(z2, z3)};
    }
  }
  __syncthreads();
  {
    const int tb = wid >> 2, dg = wid & 3, trow = tb * 32 + r32, t = t0 + trow;
    const bf16_t* Wt = (const bf16_t*)(p.ws + OFF_WPWT) + ((size_t)layer * 256 + dg * 64 + r32) * 256 + hi * 8;
    f32x16 acc0 = {}, acc1 = {};
#pragma unroll 8
    for (int ks = 0; ks < 16; ++ks) {
      const int chunk = 2 * ks + hi, sw = (chunk & 16) | ((chunk ^ trow) & 15);
      const bf16x8 zf = *(const LAS bf16x8*)(lds + PC_U + trow * 512 + sw * 16);
      const bf16x8 w0 = *(const bf16x8*)(Wt + ks * 16), w1 = *(const bf16x8*)(Wt + 32 * 256 + ks * 16);
      acc0 = __builtin_amdgcn_mfma_f32_32x32x16_bf16(w0, zf, acc0, 0, 0, 0);
      acc1 = __builtin_amdgcn_mfma_f32_32x32x16_bf16(w1, zf, acc1, 0, 0, 0);
    }
    bf16_t* dst = MIX + (size_t)t * D + 768 + dg * 64;
#pragma unroll
    for (int g = 0; g < 4; ++g) { *(u32x2*)(dst + 8 * g + 4 * hi) = pack4(acc0, g); *(u32x2*)(dst + 32 + 8 * g + 4 * hi) = pack4(acc1, g); }
    const bf16_t* Pt = (const bf16_t*)(p.ws + OFF_WPOOLT) + ((size_t)(layer * 4 + dg) * 64 + r32) * 64 + hi * 8;
    f32x16 pc0 = {}, pc1 = {};
#pragma unroll
    for (int ks = 0; ks < 4; ++ks) {
      const int chunk = dg * 8 + 2 * ks + hi, sw = (chunk & 16) | ((chunk ^ trow) & 15);
      const bf16x8 pf = *(const LAS bf16x8*)(lds + PC_P + trow * 512 + sw * 16);
      const bf16x8 w0 = *(const bf16x8*)(Pt + ks * 16), w1 = *(const bf16x8*)(Pt + 32 * 64 + ks * 16);
      pc0 = __builtin_amdgcn_mfma_f32_32x32x16_bf16(w0, pf, pc0, 0, 0, 0);
      pc1 = __builtin_amdgcn_mfma_f32_32x32x16_bf16(w1, pf, pc1, 0, 0, 0);
    }
    const float* psc = p.pool_scale + layer * 256 + dg * 64;
#pragma unroll
    for (int r = 0; r < 16; ++r) { pc0[r] *= psc[crow(r, hi)]; pc1[r] *= psc[32 + crow(r, hi)]; }
    bf16_t* pd = MIX + (size_t)t * D + 512 + dg * 64;
#pragma unroll
    for (int g = 0; g < 4; ++g) { *(u32x2*)(pd + 8 * g + 4 * hi) = pack4(pc0, g); *(u32x2*)(pd + 32 + 8 * g + 4 * hi) = pack4(pc1, g); }
  }
  __syncthreads();
}

__device__ __forceinline__ void phase_b(const Params& p, int layer, LAS char* lds, int bid, int nblk) {
  const int mode0 = ((const int*)(p.ws + OFF_FLAG))[0], vbig = ((const int*)(p.ws + OFF_FLAG))[1];
  const int mode = (mode0 == 2 && vbig != 0) ? 1 : mode0;
  const bool fast = mode != 0;
  const int nu = (520 - bid + nblk - 1) / nblk;
  for (int i = 0; i < nu; ++i) {
    const int u = bid + ((bid & 1) ? (nu - 1 - i) : i) * nblk;
    if (u < 256) { if (mode == 2) attn_unit8(p, lds, NCTX + (u >> 2) * 256, u & 3, TT); else if (mode == 1) attn_unit(p, lds, NCTX + (u >> 2) * 256, u & 3, TT); }
    else if (u < 260) { if (layer == 0) { if (mode == 2) attn_unit8(p, lds, 0, u - 256, NCTX); else if (mode == 1) attn_unit(p, lds, 0, u - 256, NCTX); } }
    else { const int tile = u - 260; if (layer == 0 || tile >= 4) poolconv_unit(p, layer, lds, tile); }
  }
  if (!fast) attn_fallback(p, layer, bid, nblk);
}

constexpr int NR = 2, NRA = 2;
__device__ __forceinline__ float hsum4(const f32x4 (&v)[4]) { float s = 0.f;
#pragma unroll
  for (int i = 0; i < 4; ++i) s += (v[i][0] + v[i][1]) + (v[i][2] + v[i][3]);
  return s; }
__device__ __forceinline__ float hsq4(const f32x4 (&v)[4], float mu) { float q = 0.f;
#pragma unroll
  for (int i = 0; i < 4; ++i) { const f32x4 d = v[i] - mu; q += (d[0] * d[0] + d[1] * d[1]) + (d[2] * d[2] + d[3] * d[3]); }
  return q; }
__device__ __forceinline__ f32x4 bf4(u32x2 w) { return (f32x4){__uint_as_float(w[0] << 16), __uint_as_float(w[0] & 0xffff0000u), __uint_as_float(w[1] << 16), __uint_as_float(w[1] & 0xffff0000u)}; }

__device__ __forceinline__ void phase_a0(const Params& p, int layer, int bid, int nblk) {
  const int wave = bid * 8 + (TIDX >> 6), lane = TIDX & 63, nw = nblk * 8;
  float* X = (float*)(p.ws + OFF_X);
  bf16_t* H = (bf16_t*)(p.ws + OFF_H);
  const bf16_t* OM = (const bf16_t*)(p.ws + OFF_OMOE);
  for (int rb = wave * NRA; rb < TT; rb += nw * NRA) {
    f32x4 v[NRA][4]; u32x2 oa[NRA][4], ob[NRA][4];
#pragma unroll
    for (int k = 0; k < NRA; ++k) {
      const int r = rb + k;
      const float* src = layer == 0 ? (r < NCTX ? p.ctx + (size_t)r * D : p.x + (size_t)(r - NCTX) * D) : X + (size_t)r * D;
#pragma unroll
      for (int i = 0; i < 4; ++i) { const int c = i * 256 + lane * 4; v[k][i] = *(const f32x4*)(src + c);
        if (layer != 0) { oa[k][i] = *(const u32x2*)(OM + ((size_t)r * 2 + 0) * D + c); ob[k][i] = *(const u32x2*)(OM + ((size_t)r * 2 + 1) * D + c); } }
    }
    if (layer != 0) {
#pragma unroll
      for (int k = 0; k < NRA; ++k) {
        const int r = rb + k, s = r < NCTX ? 1 : 0;
        const float* g2 = (const float*)(p.ws + OFF_MOD) + ((layer - 1) * 2 + s) * 6144 + 5 * D;
#pragma unroll
        for (int i = 0; i < 4; ++i) { const int c = i * 256 + lane * 4; v[k][i] = v[k][i] * ALPHA + *(const f32x4*)(g2 + c) * (bf4(oa[k][i]) + bf4(ob[k][i])); }
      }
      float mu[NRA], rs[NRA];
#pragma unroll
      for (int k = 0; k < NRA; ++k) mu[k] = wave_sum(hsum4(v[k])) * (1.f / D);
#pragma unroll
      for (int k = 0; k < NRA; ++k) rs[k] = rsqrtf(wave_sum(hsq4(v[k], mu[k])) * (1.f / D) + EPS);
      const float* g = p.ln2_g + (layer - 1) * D; const float* b = p.ln2_b + (layer - 1) * D;
#pragma unroll
      for (int k = 0; k < NRA; ++k)
#pragma unroll
        for (int i = 0; i < 4; ++i) { const int c = i * 256 + lane * 4; v[k][i] = (v[k][i] - mu[k]) * rs[k] * *(const f32x4*)(g + c) + *(const f32x4*)(b + c); *(f32x4*)(X + (size_t)(rb + k) * D + c) = v[k][i]; }
    }
    float mu[NRA], rs[NRA];
#pragma unroll
    for (int k = 0; k < NRA; ++k) mu[k] = wave_sum(hsum4(v[k])) * (1.f / D);
#pragma unroll
    for (int k = 0; k < NRA; ++k) rs[k] = rsqrtf(wave_sum(hsq4(v[k], mu[k])) * (1.f / D) + EPS);
#pragma unroll
    for (int k = 0; k < NRA; ++k) {
      const int r = rb + k, s = r < NCTX ? 1 : 0;
      const float* modp = (const float*)(p.ws + OFF_MOD) + (layer * 2 + s) * 6144;
#pragma unroll
      for (int i = 0; i < 4; ++i) {
        const int c = i * 256 + lane * 4;
        const f32x4 h = (v[k][i] - mu[k]) * rs[k] * (*(const f32x4*)(modp + D + c) + 1.f) + *(const f32x4*)(modp + c);
        *(u32x2*)(H + (size_t)r * D + c) = (u32x2){cvtpk(h[0], h[1]), cvtpk(h[2], h[3])};
      }
    }
  }
}

__device__ __forceinline__ void phase_c2(const Params& p, int layer, LAS char* lds, int bid, int nblk) {
  const int tid = TIDX, wid = tid >> 6, lane = tid & 63;
  float* X = (float*)(p.ws + OFF_X);
  const bf16_t* Y = (const bf16_t*)(p.ws + OFF_Y);
  bf16_t* H2 = (bf16_t*)(p.ws + OFF_MIX);
  int* cnt = (int*)(p.ws + OFF_CNT) + layer * NE * CNT_STRIDE;
  float* GATE = (float*)(p.ws + OFF_GATE); int* LIST = (int*)(p.ws + OFF_LIST);
  LAS int* lcnt = (LAS int*)lds;
  LAS int* lbase = lcnt + 32;
  LAS int* ent = lcnt + 64;
  if (tid < 32) lcnt[tid] = 0;
  LAS float* wre = (LAS float*)(lds + 4096);
#pragma unroll
  for (int kk = 0; kk < 2; ++kk) {
    const int k = tid + kk * 512;
    f32x4 w[8];
#pragma unroll
    for (int g = 0; g < 8; ++g) w[g] = *(const f32x4*)(p.w_re + ((size_t)layer * D + k) * 32 + g * 4);
#pragma unroll
    for (int g = 0; g < 8; ++g)
#pragma unroll
      for (int j = 0; j < 4; ++j) wre[(g * 4 + j) * 1024 + k] = w[g][j];
  }
  __syncthreads();
  const int r0 = layer == 0 ? 0 : NCTX, nrows = TT - r0, rpb = (nrows + nblk - 1) / nblk;
  const int rbeg = r0 + bid * rpb, rend = min(rbeg + rpb, TT);
  for (int rb = rbeg + wid * NR; rb < rend; rb += 8 * NR) {
    f32x4 v[NR][4]; u32x2 yv[NR][4]; int rr[NR]; bool ok[NR];
#pragma unroll
    for (int k = 0; k < NR; ++k) {
      ok[k] = rb + k < rend; rr[k] = ok[k] ? rb + k : rb;
      const int r = rr[k];
      const float* xin = layer == 0 ? (r < NCTX ? p.ctx + (size_t)r * D : p.x + (size_t)(r - NCTX) * D) : X + (size_t)r * D;
#pragma unroll
      for (int i = 0; i < 4; ++i) { const int c = i * 256 + lane * 4; v[k][i] = *(const f32x4*)(xin + c); yv[k][i] = *(const u32x2*)(Y + (size_t)r * D + c); }
    }
#pragma unroll
    for (int k = 0; k < NR; ++k) {
      const float* modp = (const float*)(p.ws + OFF_MOD) + (layer * 2 + (rr[k] < NCTX ? 1 : 0)) * 6144;
#pragma unroll
      for (int i = 0; i < 4; ++i) { const int c = i * 256 + lane * 4; v[k][i] = v[k][i] * ALPHA + *(const f32x4*)(modp + 2 * D + c) * bf4(yv[k][i]); }
    }
    float mu[NR], rs[NR];
#pragma unroll
    for (int k = 0; k < NR; ++k) mu[k] = wave_sum(hsum4(v[k])) * (1.f / D);
#pragma unroll
    for (int k = 0; k < NR; ++k) rs[k] = rsqrtf(wave_sum(hsq4(v[k], mu[k])) * (1.f / D) + EPS);
#pragma unroll
    for (int k = 0; k < NR; ++k)
#pragma unroll
      for (int i = 0; i < 4; ++i) {
        const int c = i * 256 + lane * 4;
        v[k][i] = (v[k][i] - mu[k]) * rs[k] * *(const f32x4*)(p.ln1_g + layer * D + c) + *(const f32x4*)(p.ln1_b + layer * D + c);
        if (ok[k]) *(f32x4*)(X + (size_t)rr[k] * D + c) = v[k][i];
      }
#pragma unroll
    for (int k = 0; k < NR; ++k) mu[k] = wave_sum(hsum4(v[k])) * (1.f / D);
#pragma unroll
    for (int k = 0; k < NR; ++k) rs[k] = rsqrtf(wave_sum(hsq4(v[k], mu[k])) * (1.f / D) + EPS);
#pragma unroll
    for (int k = 0; k < NR; ++k) {
      const float* modp = (const float*)(p.ws + OFF_MOD) + (layer * 2 + (rr[k] < NCTX ? 1 : 0)) * 6144;
#pragma unroll
      for (int i = 0; i < 4; ++i) {
        const int c = i * 256 + lane * 4;
        v[k][i] = (v[k][i] - mu[k]) * rs[k] * (*(const f32x4*)(modp + 4 * D + c) + 1.f) + *(const f32x4*)(modp + 3 * D + c);
        if (ok[k]) *(u32x2*)(H2 + (size_t)rr[k] * D + c) = (u32x2){cvtpk(v[k][i][0], v[k][i][1]), cvtpk(v[k][i][2], v[k][i][3])};
      }
    }
    f32x4 lg[NR];
#pragma unroll
    for (int k = 0; k < NR; ++k) lg[k] = (f32x4){0.f, 0.f, 0.f, 0.f};
#pragma unroll
    for (int i = 0; i < 4; ++i)
#pragma unroll
      for (int j = 0; j < 4; ++j) { const f32x4 w = *(const f32x4*)(p.w_rg + ((size_t)layer * D + i * 256 + lane * 4 + j) * 4);
#pragma unroll
        for (int k = 0; k < NR; ++k) lg[k] += w * v[k][i][j]; }
    int gsel[NR]; float pgrp[NR];
#pragma unroll
    for (int k = 0; k < NR; ++k) {
      float l0 = wave_sum(lg[k][0]) + p.b_rg[layer * 4 + 0], l1 = wave_sum(lg[k][1]) + p.b_rg[layer * 4 + 1];
      float l2 = wave_sum(lg[k][2]) + p.b_rg[layer * 4 + 2], l3 = wave_sum(lg[k][3]) + p.b_rg[layer * 4 + 3];
      int gs = 0; float gm = l0;
      if (l1 > gm) { gm = l1; gs = 1; }
      if (l2 > gm) { gm = l2; gs = 2; }
      if (l3 > gm) { gm = l3; gs = 3; }
      gsel[k] = gs; pgrp[k] = 1.f / (__expf(l0 - gm) + __expf(l1 - gm) + __expf(l2 - gm) + __expf(l3 - gm));
    }
#pragma unroll
    for (int k = 0; k < NR; ++k) {
      float le[8];
#pragma unroll
      for (int e = 0; e < 8; ++e) {
        const LAS float* wr = wre + (gsel[k] * 8 + e) * 1024 + lane * 4;
        float a = 0.f;
#pragma unroll
        for (int i = 0; i < 4; ++i) { const f32x4 w = *(const LAS f32x4*)(wr + i * 256); a += (w[0] * v[k][i][0] + w[1] * v[k][i][1]) + (w[2] * v[k][i][2] + w[3] * v[k][i][3]); }
        le[e] = a;
      }
#pragma unroll
      for (int e = 0; e < 8; ++e) le[e] = wave_sum(le[e]) + p.b_re[layer * 32 + gsel[k] * 8 + e];
      int i0 = 0; float v0 = le[0];
#pragma unroll
      for (int e = 1; e < 8; ++e) if (le[e] > v0) { v0 = le[e]; i0 = e; }
      int i1 = -1; float v1 = -3.0e38f;
#pragma unroll
      for (int e = 0; e < 8; ++e) if (e != i0 && le[e] > v1) { v1 = le[e]; i1 = e; }
      if (i1 < 0) { i1 = (i0 + 1) & 7; v1 = v0; }
      const float e1 = __expf(v1 - v0);
      if (lane == 0 && ok[k]) {
        const int r = rr[k], xa = gsel[k] * 8 + i0, xb = gsel[k] * 8 + i1;
        const int pa = __hip_atomic_fetch_add(&lcnt[xa], 1, __ATOMIC_RELAXED, __HIP_MEMORY_SCOPE_WORKGROUP);
        const int pb = __hip_atomic_fetch_add(&lcnt[xb], 1, __ATOMIC_RELAXED, __HIP_MEMORY_SCOPE_WORKGROUP);
        const int li = (r - rbeg) * 2;
        ent[li * 3 + 0] = xa; ent[li * 3 + 1] = pa; ent[li * 3 + 2] = r * 2 + 0;
        ent[li * 3 + 3] = xb; ent[li * 3 + 4] = pb; ent[li * 3 + 5] = r * 2 + 1;
        GATE[r * 2] = pgrp[k] / (1.f + e1); GATE[r * 2 + 1] = pgrp[k] * e1 / (1.f + e1);
      }
    }
  }
  __syncthreads();
  if (tid < 32) { const int c = lcnt[tid]; lbase[tid] = c > 0 ? atomicAdd(&cnt[tid * CNT_STRIDE], c) : 0; }
  __syncthreads();
  for (int i = tid; i < (rend - rbeg) * 2; i += 512) { const int e = ent[i * 3], lp = ent[i * 3 + 1]; LIST[(size_t)e * CAPL + lbase[e] + lp] = ent[i * 3 + 2]; }
  __syncthreads();
}

__device__ __forceinline__ void phase_final(const Params& p, int bid, int nblk) {
  const int wave = bid * 8 + (TIDX >> 6), lane = TIDX & 63, nw = nblk * 8;
  const float* X = (const float*)(p.ws + OFF_X);
  const bf16_t* OM = (const bf16_t*)(p.ws + OFF_OMOE);
  const float* g2 = (const float*)(p.ws + OFF_MOD) + (1 * 2 + 0) * 6144 + 5 * D;
  for (int rb = NCTX + wave * NRA; rb < TT; rb += nw * NRA) {
    f32x4 v[NRA][4]; u32x2 oa[NRA][4], ob[NRA][4];
#pragma unroll
    for (int k = 0; k < NRA; ++k)
#pragma unroll
      for (int i = 0; i < 4; ++i) { const int c = i * 256 + lane * 4, r = rb + k;
        v[k][i] = *(const f32x4*)(X + (size_t)r * D + c); oa[k][i] = *(const u32x2*)(OM + ((size_t)r * 2 + 0) * D + c); ob[k][i] = *(const u32x2*)(OM + ((size_t)r * 2 + 1) * D + c); }
#pragma unroll
    for (int k = 0; k < NRA; ++k)
#pragma unroll
      for (int i = 0; i < 4; ++i) { const int c = i * 256 + lane * 4; v[k][i] = v[k][i] * ALPHA + *(const f32x4*)(g2 + c) * (bf4(oa[k][i]) + bf4(ob[k][i])); }
    float mu[NRA], rs[NRA];
#pragma unroll
    for (int k = 0; k < NRA; ++k) mu[k] = wave_sum(hsum4(v[k])) * (1.f / D);
#pragma unroll
    for (int k = 0; k < NRA; ++k) rs[k] = rsqrtf(wave_sum(hsq4(v[k], mu[k])) * (1.f / D) + EPS);
#pragma unroll
    for (int k = 0; k < NRA; ++k)
#pragma unroll
      for (int i = 0; i < 4; ++i) {
        const int c = i * 256 + lane * 4;
        *(f32x4*)(p.out + (size_t)(rb + k - NCTX) * D + c) = (v[k][i] - mu[k]) * rs[k] * *(const f32x4*)(p.ln2_g + D + c) + *(const f32x4*)(p.ln2_b + D + c);
      }
  }
}

__device__ __forceinline__ void phase_p0(const Params& p, LAS char* lds, int bid, int nblk) {
  const int tid = TIDX;
  const long gtid = (long)bid * 512 + tid, gth = (long)nblk * 512;
  LAS float* sc = (LAS float*)lds;
  LAS float* red = (LAS float*)(lds + 8192);
  for (int i = tid; i < 2048; i += 512) { const float v = i < 1024 ? p.c[i] : p.c_ctx[i - 1024]; sc[i] = silu(v); }
  __syncthreads();
  float* mod = (float*)(p.ws + OFF_MOD);
  for (int u = bid; u < 384; u += nblk) {
    const int layer = u / 192, cg = u % 192, col = tid & 31, ksl = tid >> 5;
    const float* w = p.w_mod + ((size_t)layer * D + ksl * 64) * 6144 + cg * 32 + col;
    float a0 = 0.f, a1 = 0.f;
#pragma unroll 8
    for (int k = 0; k < 64; ++k) { const float wv = w[(size_t)k * 6144]; a0 += sc[ksl * 64 + k] * wv; a1 += sc[1024 + ksl * 64 + k] * wv; }
    red[(ksl * 32 + col) * 2] = a0; red[(ksl * 32 + col) * 2 + 1] = a1;
    __syncthreads();
    if (tid < 64) {
      const int c2 = tid & 31, s = tid >> 5; float a = 0.f;
#pragma unroll
      for (int k = 0; k < 16; ++k) a += red[(k * 32 + c2) * 2 + s];
      mod[(layer * 2 + s) * 6144 + cg * 32 + c2] = a + p.b_mod[layer * 6144 + cg * 32 + c2];
    }
    __syncthreads();
  }
  if (gtid < 256 * 16) {
    const int pos = (int)gtid / 16, f = (int)gtid % 16;
    const float ang = (float)pos * powf(10000.f, -(float)f / 16.f);
    float* rt = (float*)(p.ws + OFF_ROPE);
    rt[gtid * 2 + 0] = cosf(ang); rt[gtid * 2 + 1] = sinf(ang);
  }
  if (gtid < 2 * NE * CNT_STRIDE) ((int*)(p.ws + OFF_CNT))[gtid] = 0;
  if (gtid == 0) {
    float bmax = 0.f;
    for (int l = 0; l < 2; ++l) {
      float gq = 0.f, gk = 0.f;
      for (int i = 0; i < 64; ++i) { gq = fmaxf(gq, fabsf(p.q_gain[l * 64 + i])); gk = fmaxf(gk, fabsf(p.k_gain[l * 64 + i])); }
      bmax = fmaxf(bmax, 11.55f * gq * gk);
    }
    ((int*)(p.ws + OFF_FLAG))[0] = bmax <= 13.2f ? 2 : (bmax <= 100.f ? 1 : 0);
    ((int*)(p.ws + OFF_FLAG))[1] = 0;
  }
  for (long i = gtid; i < 2 * 65536; i += gth) { const int l = (int)(i >> 16), d = (int)(i >> 8) & 255, c = (int)i & 255; ((bf16_t*)(p.ws + OFF_WPWT))[i] = f2bf(p.w_cv_pw[((size_t)l * 256 + c) * 256 + d]); }
  for (long i = gtid; i < 8 * 4096; i += gth) { const int lg = (int)(i >> 12), d = (int)(i >> 6) & 63, c = (int)i & 63; ((bf16_t*)(p.ws + OFF_WPOOLT))[i] = f2bf(p.w_pool[((size_t)lg * 64 + c) * 64 + d]); }
  cvt_range(p.w_in, (bf16_t*)(p.ws + OFF_WIN), 2L * D * INW / 8, gtid, gth);
  cvt_range(p.w_out, (bf16_t*)(p.ws + OFF_WOUT), 2L * D * D / 8, gtid, gth);
}
#define XB_TMO      128
#define XB_XCNT(j)  (256  + 64 * (j))
#define XB_XSUB(j)  (1280 + 64 * (j))
#define XB_XGEN(j)  (2304 + 64 * (j))
#define XB_TOP      3328
#define XB_TOPGEN   3392
#define XCD_BAR_WORDS 3456
#define XB_SPIN_CAP (1u << 22)
__device__ __forceinline__ unsigned xb_ld(unsigned* p)              { return __hip_atomic_load(p, __ATOMIC_RELAXED, __HIP_MEMORY_SCOPE_AGENT); }
__device__ __forceinline__ unsigned xb_add(unsigned* p, unsigned v) { return __hip_atomic_fetch_add(p, v, __ATOMIC_RELAXED, __HIP_MEMORY_SCOPE_AGENT); }
__device__ __forceinline__ unsigned xb_xcc_id() { return (unsigned)__builtin_amdgcn_s_getreg((3 << 11) | 20) & 0xFu; }
#define XB_SPIN(cond, bar) do { unsigned _sp = 0; while (cond) { __builtin_amdgcn_s_sleep(1); \
    if ((++_sp & 255u) == 0u) { if (xb_ld(&(bar)[XB_TMO])) break; if (_sp > XB_SPIN_CAP) { atomicAdd(&(bar)[XB_TMO], 1u); break; } } } } while (0)
struct XcdBarrier { unsigned* bar; unsigned x; volatile LAS unsigned* st; };
__device__ __forceinline__ XcdBarrier xcd_barrier_post(unsigned* bar, volatile LAS unsigned* st) {
  XcdBarrier b; b.bar = bar; b.x = xb_xcc_id(); b.st = st;
  if (threadIdx.x == 0) (void)xb_add(&bar[XB_XCNT(b.x)], 1u);
  return b;
}
__device__ __forceinline__ void xcd_barrier_complete(unsigned* bar, unsigned x, unsigned& nloc, unsigned& nx) {
  const unsigned G = gridDim.x * gridDim.y * gridDim.z;
  unsigned sum, cnt, mine, sp = 0u;
  for (;;) {
    sum = 0u; cnt = 0u; mine = 0u;
#pragma unroll
    for (unsigned j = 0; j < 16; ++j) { const unsigned c = xb_ld(&bar[XB_XCNT(j)]); sum += c; cnt += (c > 0u) ? 1u : 0u; mine = (j == x) ? c : mine; }
    if (sum == G) break;
    __builtin_amdgcn_s_sleep(1);
    if ((++sp & 255u) == 0u) { if (xb_ld(&bar[XB_TMO])) break; if (sp > XB_SPIN_CAP) { atomicAdd(&bar[XB_TMO], 1u); break; } }
  }
  nloc = mine > 0u ? mine : 1u; nx = cnt > 0u ? cnt : 1u;
}
__device__ __forceinline__ void xcd_barrier(const XcdBarrier& b) {
  asm volatile("s_waitcnt vmcnt(0)" ::: "memory");
  __syncthreads();
  if (threadIdx.x == 0) {
    unsigned* bar = b.bar; unsigned bx = b.x;
    asm volatile("" : "+s"(bar), "+s"(bx));
    __builtin_amdgcn_s_waitcnt(0);
    unsigned nloc = b.st[0], nx = b.st[1];
    if (nloc == 0u) { xcd_barrier_complete(bar, bx, nloc, nx); b.st[0] = nloc; b.st[1] = nx; }
    const unsigned old = xb_add(&bar[XB_XSUB(bx)], 1u);
    const unsigned gen = old / nloc;
    if (old + 1u == (gen + 1u) * nloc) {
      __builtin_amdgcn_fence(__ATOMIC_RELEASE, "agent");
      asm volatile("s_waitcnt vmcnt(0)" ::: "memory");
      const unsigned og = xb_add(&bar[XB_TOP], 1u);
      const unsigned tg = og / nx;
      if (og + 1u == (tg + 1u) * nx) xb_add(&bar[XB_TOPGEN], 1u);
      else XB_SPIN(xb_ld(&bar[XB_TOPGEN]) == tg, bar);
      __builtin_amdgcn_fence(__ATOMIC_ACQUIRE, "agent");
      xb_add(&bar[XB_XGEN(bx)], 1u);
      asm volatile("s_waitcnt vmcnt(0)" ::: "memory");
    } else {
      XB_SPIN(xb_ld(&bar[XB_XGEN(bx)]) == gen, bar);
      __builtin_amdgcn_fence(__ATOMIC_ACQUIRE, "agent");
      asm volatile("s_waitcnt vmcnt(0)" ::: "memory");
    }
  }
  __syncthreads();
}

constexpr int LDS_MAIN = PC_LDS > GEMM_LDS + 512 ? PC_LDS : GEMM_LDS + 512;
constexpr int LDS_TOTAL = LDS_MAIN + 16;
static_assert(GEMM_LDS + 512 <= LDS_MAIN && ATT_LDS <= LDS_MAIN, "lds");
__global__ void __launch_bounds__(512) mega_fwd(Params p) {
  __shared__ __attribute__((aligned(16))) char slds[LDS_TOTAL];
  LAS char* lds = (LAS char*)slds;
  volatile LAS unsigned* st = (volatile LAS unsigned*)(lds + LDS_MAIN);
  if (threadIdx.x < 4) st[threadIdx.x] = 0u;
  __syncthreads();
  const XcdBarrier bar = xcd_barrier_post((unsigned*)(p.ws + OFF_BAR), st);
  const int bid = blockIdx.x, nblk = gridDim.x;
  phase_p0(p, lds, bid, nblk);
  xcd_barrier(bar);
#pragma unroll 1
  for (int layer = 0; layer < 2; ++layer) {
    phase_a0(p, layer, bid, nblk);
    xcd_barrier(bar);
    phase_a1(p, layer, lds, bid, nblk);
    xcd_barrier(bar);
    phase_b(p, layer, lds, bid, nblk);
    xcd_barrier(bar);
    phase_c1(p, layer, lds, bid, nblk);
    xcd_barrier(bar);
    phase_c2(p, layer, lds, bid, nblk);
    xcd_barrier(bar);
    phase_d1(p, layer, lds, bid, nblk);
    xcd_barrier(bar);
    phase_d2(p, layer, lds, bid, nblk);
    xcd_barrier(bar);
  }
  phase_final(p, bid, nblk);
}

extern "C" void kernel_launch(void* const* d_in, const int* in_sizes, int n_in, void* d_out, int out_size, void* d_ws, size_t ws_size,
                              hipStream_t stream) {
  static int grid = 0;
  if (grid == 0) {
    if (ws_size < WS_END || n_in != 28) { fprintf(stderr, "kernel_launch: ws too small (%zu < %zu) or n_in %d != 28; nothing launched\n", ws_size, (size_t)WS_END, n_in); grid = -1; return; }
    int dev = 0, cus = 0, per_cu = 0;
    if (hipGetDevice(&dev) != hipSuccess || hipDeviceGetAttribute(&cus, hipDeviceAttributeMultiprocessorCount, dev) != hipSuccess) { grid = -1; return; }
    if (hipOccupancyMaxActiveBlocksPerMultiprocessor(&per_cu, (const void*)mega_fwd, 512, 0) != hipSuccess || per_cu < 1) {
      fprintf(stderr, "kernel_launch: occupancy query says %d blocks per CU; nothing launched\n", per_cu); grid = -1; return; }
    (void)hipGetLastError();
    grid = cus;
  }
  if (grid < 0) return;
  if (hipMemsetAsync((char*)d_ws + OFF_BAR, 0, BAR_BYTES, stream) != hipSuccess) { fprintf(stderr, "kernel_launch: memset failed\n"); return; }
  Params p{};
  const float** f = (const float**)&p;
  for (int i = 0; i < 28; ++i) f[i] = (const float*)d_in[i];
  p.out = (float*)d_out; p.ws = (char*)d_ws;
  hipLaunchKernelGGL(mega_fwd, dim3(grid), dim3(512), 0, stream, p);
}
```

```cpp
#include <hip/hip_runtime.h>
#include <cstdio>
#include <cstdint>

typedef unsigned short bf16_t;
#define LAS __attribute__((address_space(3)))

constexpr int D = 1024, SEQ = 16384, NCTX = 256, TT = SEQ + NCTX;
constexpr int INW = 1536;
constexpr int NE = 32, DE = 512;
constexpr int CAPL = 2 * TT;
constexpr int HMID_ROWS = 2 * TT + NE * 128;
constexpr float ALPHA = 1.41421356237309515f;
constexpr float EPS = 1e-6f;

constexpr size_t al(size_t x) { return (x + 255) / 256 * 256; }
constexpr size_t OFF_BAR = 0;
constexpr size_t BAR_BYTES = 3456 * 4;
constexpr size_t OFF_MOD = OFF_BAR + al(BAR_BYTES);
constexpr size_t OFF_ROPE = OFF_MOD + al(2 * 2 * 6144 * 4);
constexpr int CNT_STRIDE = 32;
constexpr size_t OFF_CNT = OFF_ROPE + al(256 * 16 * 2 * 4);
constexpr size_t OFF_FLAG = OFF_CNT + al(2 * 32 * 32 * 4);
constexpr size_t OFF_X = OFF_FLAG + 256;
constexpr size_t OFF_H = OFF_X + al((size_t)TT * D * 4);
constexpr size_t OFF_MIX = OFF_H + al((size_t)TT * D * 2);
constexpr size_t OFF_Y = OFF_MIX + al((size_t)TT * D * 2);
constexpr size_t OFF_Q = OFF_Y + al((size_t)TT * D * 2);
constexpr size_t OFF_K = OFF_Q + al((size_t)TT * 512 * 2);
constexpr size_t OFF_V = OFF_K + al((size_t)TT * 128 * 2);
constexpr size_t OFF_U = OFF_V + al((size_t)TT * 128 * 2);
constexpr size_t OFF_AG = OFF_U + al((size_t)TT * 256 * 4);
constexpr size_t OFF_HMID = OFF_Q;
constexpr size_t OFF_OMOE = OFF_AG + al((size_t)TT * 512 * 2);
constexpr size_t OFF_GATE = OFF_OMOE + al((size_t)TT * 2 * D * 2);
constexpr size_t OFF_LIST = OFF_GATE + al((size_t)TT * 2 * 4);
constexpr size_t OFF_WIN = OFF_LIST + al((size_t)NE * CAPL * 4);
constexpr size_t OFF_WOUT = OFF_WIN + al((size_t)2 * D * INW * 2);
constexpr size_t OFF_WPWT = OFF_WOUT + al((size_t)2 * D * D * 2);
constexpr size_t OFF_WPOOLT = OFF_WPWT + al((size_t)2 * 256 * 256 * 2);
constexpr size_t OFF_Q8 = OFF_WPOOLT + al((size_t)2 * 4 * 64 * 64 * 2);
constexpr size_t OFF_K8 = OFF_Q8 + al((size_t)TT * 512);
constexpr size_t OFF_VT8 = OFF_K8 + al((size_t)TT * 128);
constexpr size_t OFF_WG = OFF_VT8 + al((size_t)128 * TT);
constexpr size_t OFF_WU = OFF_WG + al((size_t)2 * NE * D * DE * 2);
constexpr size_t OFF_WD = OFF_WU + al((size_t)2 * NE * D * DE * 2);
constexpr size_t WS_END = OFF_WD + al((size_t)2 * NE * D * DE * 2);
static_assert(OFF_AG - OFF_HMID >= (size_t)HMID_ROWS * DE * 2, "HMID alias too small");
static_assert(WS_END < 530000000, "ws budget");

struct Params {
  const float *x, *c, *ctx, *c_ctx, *w_mod, *b_mod, *w_in, *q_gain, *k_gain, *w_pool, *pool_scale, *w_dw, *b_dw,
      *cv_ln_g, *cv_ln_b, *w_cv_pw, *w_out, *ln1_g, *ln1_b, *ln2_g, *ln2_b, *w_rg, *b_rg, *w_re, *b_re, *w_e_gate, *w_e_up, *w_e_down;
  float* out;
  char* ws;
};

__device__ __forceinline__ float bf2f(bf16_t v) { return __uint_as_float(((unsigned)v) << 16); }
__device__ __forceinline__ bf16_t f2bf(float f) {
  unsigned u = __float_as_uint(f);
  u += 0x7fffu + ((u >> 16) & 1u);
  return (bf16_t)(u >> 16);
}
template <int CTRL> __device__ __forceinline__ float dppf(float v) { return __int_as_float(__builtin_amdgcn_update_dpp(0, __float_as_int(v), CTRL, 0xf, 0xf, true)); }
__device__ __forceinline__ float wave_sum(float v) {
  v += dppf<0xB1>(v); v += dppf<0x4E>(v); v += dppf<0x141>(v); v += dppf<0x140>(v);
  { auto r = __builtin_amdgcn_permlane16_swap(__float_as_uint(v), __float_as_uint(v), false, false); v = __uint_as_float(r[0]) + __uint_as_float(r[1]); }
  { auto r = __builtin_amdgcn_permlane32_swap(__float_as_uint(v), __float_as_uint(v), false, false); v = __uint_as_float(r[0]) + __uint_as_float(r[1]); }
  return v;
}
__device__ __forceinline__ float silu(float v) { return v / (1.f + __expf(-v)); }
__device__ __forceinline__ int opaque0() { int z; asm volatile("s_mov_b32 %0, 0" : "=s"(z)); return z; }
#define TIDX ((int)threadIdx.x + opaque0())
using bf16x8 = __attribute__((ext_vector_type(8))) short;
using s16x4 = __attribute__((ext_vector_type(4))) short;
using f32x16 = __attribute__((ext_vector_type(16))) float;
using f32x4 = __attribute__((ext_vector_type(4))) float;
using u32x4 = __attribute__((ext_vector_type(4))) unsigned;
using u32x2 = __attribute__((ext_vector_type(2))) unsigned;

__device__ __forceinline__ int crow(int r, int hi) { return (r & 3) + 8 * (r >> 2) + 4 * hi; }
typedef float f32x2 __attribute__((ext_vector_type(2)));
typedef __bf16 bf16x2v __attribute__((ext_vector_type(2)));
__device__ __forceinline__ unsigned cvtpk(float lo, float hi) {
  bf16x2v b = __builtin_convertvector((f32x2){lo, hi}, bf16x2v);
  return __builtin_bit_cast(unsigned, b);
}
__device__ __forceinline__ float sum32(float v) {
  auto rr = __builtin_amdgcn_permlane32_swap(__float_as_uint(v), __float_as_uint(v), false, false);
  return __uint_as_float(rr[0]) + __uint_as_float(rr[1]);
}

__device__ __forceinline__ void cvt_range(const float* __restrict__ src, bf16_t* __restrict__ dst, long n8, long gtid, long gthreads) {
  for (long i = gtid; i < n8; i += gthreads) {
    const f32x4 a = *(const f32x4*)(src + i * 8), b = *(const f32x4*)(src + i * 8 + 4);
    u32x4 w = {cvtpk(a[0], a[1]), cvtpk(a[2], a[3]), cvtpk(b[0], b[1]), cvtpk(b[2], b[3])};
    *(u32x4*)(dst + i * 8) = w;
  }
}

__device__ __forceinline__ int xoff(int row, int chunk) { return row * 128 + ((chunk ^ ((row >> 1) & 7)) << 4); }
__device__ __forceinline__ int wst(int k, int c) { const int kk = (k & ~0xC) | ((k & 4) << 1) | ((k & 8) >> 1); return ((kk >> 3) * 4 + (c >> 5)) * 512 + ((kk & 7) * 32 + (c & 31)) * 2; }
__device__ __forceinline__ int v_rd_base(int lane) { return ((lane & 3) << 3) | (((lane >> 2) & 3) << 6) | (((lane >> 4) & 1) << 5) | (((lane >> 5) & 1) << 8); }

__device__ __forceinline__ bf16x8 tr_frag(const LAS char* p) {
  s16x4 a = __builtin_amdgcn_ds_read_tr16_b64_v4i16((LAS s16x4*)p);
  s16x4 b = __builtin_amdgcn_ds_read_tr16_b64_v4i16((LAS s16x4*)(p + 2048));
  return (bf16x8){a[0], a[1], a[2], a[3], b[0], b[1], b[2], b[3]};
}

template <int OFF> __device__ __forceinline__ bf16x8 tr_frag_asm(int addr) {
  s16x4 a, b;
  asm volatile("ds_read_b64_tr_b16 %0, %1 offset:%2" : "=&v"(a) : "v"(addr), "i"(OFF) : "memory");
  asm volatile("ds_read_b64_tr_b16 %0, %1 offset:%2" : "=&v"(b) : "v"(addr), "i"(OFF + 2048) : "memory");
  return (bf16x8){a[0], a[1], a[2], a[3], b[0], b[1], b[2], b[3]};
}

template <int BM, int BN> struct GemmCfg {
  static constexpr int WM = BM / 64, WN = 8 / WM, NSLAB = BN / 128, XB = BM * 128, WB = NSLAB * 16384, STAGE = XB + WB, NXP = BM / 64, NWP = NSLAB * 2;
  static_assert(WM * WN == 8 && WN * 64 == BN, "tile");
};
constexpr int GEMM_LDS = 3 * (256 * 128 + 16384);

template <int BM, int BN, int NMAP, bool BG = false, class XRow, class WPtr, class Pre>
__device__ __forceinline__ void gemm_mainloop(LAS char* lds, f32x16 (&acc)[2][2], const XRow& xrow, const WPtr& wptr, const Pre& pre, int sprev, int ldw, int K, int& bgdone, int bgn = 0, long bgc0 = 0,
                                              const float* bs0 = nullptr, const float* bs1 = nullptr, const float* bs2 = nullptr, bf16_t* bd0 = nullptr, bf16_t* bd1 = nullptr, bf16_t* bd2 = nullptr) {
#define BG_ADDR(i, off, SP, DP) long c_ = bgc0 + (long)(i) * 512 + (off); const bool ok_ = c_ < (3L << 21); if (!ok_) c_ = 0; const int t_ = (int)(c_ >> 21); const long o_ = (c_ & 0x1fffff) * 8; \
    const float* SP = (t_ == 0 ? bs0 : (t_ == 1 ? bs1 : bs2)) + o_; bf16_t* DP = (t_ == 0 ? bd0 : (t_ == 1 ? bd1 : bd2)) + o_
#define BG_ISSUE(i, off, a, b) do { BG_ADDR(i, off, sp_, dp_); (void)dp_; a = *(const f32x4*)sp_; b = *(const f32x4*)(sp_ + 4); } while (0)
#define BG_RETIRE(i, off, a, b) do { BG_ADDR(i, off, sp_, dp_); (void)sp_; if (ok_) *(u32x4*)dp_ = (u32x4){cvtpk(a[0], a[1]), cvtpk(a[2], a[3]), cvtpk(b[0], b[1]), cvtpk(b[2], b[3])}; } while (0)
#define BGA_ISSUE(i, off, a, b) do { BG_ADDR(i, off, sp_, dp_); (void)dp_; \
    asm volatile("global_load_dwordx4 %0, %2, off\n\tglobal_load_dwordx4 %1, %2, off offset:16" : "=&v"(a), "=&v"(b) : "v"(sp_) : "memory"); } while (0)
#define BGA_RETIRE(i, off, a, b) do { BG_ADDR(i, off, sp_, dp_); (void)sp_; const u32x4 w_ = {cvtpk(a[0], a[1]), cvtpk(a[2], a[3]), cvtpk(b[0], b[1]), cvtpk(b[2], b[3])}; \
    if (ok_) asm volatile("global_store_dwordx4 %0, %1, off" :: "v"(dp_), "v"(w_) : "memory"); } while (0)
  using C = GemmCfg<BM, BN>;
  const int tid = TIDX, wid = __builtin_amdgcn_readfirstlane(tid >> 6), lane = tid & 63, r32 = lane & 31, hi = lane >> 5;
  const int wm = wid / C::WN, wn = wid % C::WN;
  const bf16_t *g0, *g1, *g2, *g3, *g4, *g5, *g6 = nullptr, *g7 = nullptr, *g8 = nullptr, *g9 = nullptr, *g10 = nullptr, *g11 = nullptr;
  int l0, l1, l2, l3, l4, l5, l6 = 0, l7 = 0, l8 = 0, l9 = 0, l10 = 0, l11 = 0;
  auto xpieceq = [&](int q, const bf16_t*& gp, int& lp) { const int row = 8 * q + (lane >> 3), c = (lane & 7) ^ ((row >> 1) & 7); gp = xrow(row) + c * 8; lp = q * 1024; };
  auto wpieceq = [&](int idx, const bf16_t*& gp, int& lp) {
    const int s = idx >> 4, q = idx & 15, sub = 2 * q + (lane >> 5), kk = (sub >> 2) * 8 + ((lane & 31) >> 2);
    const int k = (kk & ~0xC) | ((kk & 4) << 1) | ((kk & 8) >> 1), c = (sub & 3) * 32 + (lane & 3) * 8;
    gp = wptr(s) + (size_t)k * ldw + c; lp = C::XB + s * 16384 + q * 1024; };
  const size_t stepx = 64, stepw = (size_t)64 * ldw;
  if (BG) {
    const int w4 = wid & 3;
    xpieceq(w4 * 8 + 0, g0, l0); xpieceq(w4 * 8 + 1, g1, l1); xpieceq(w4 * 8 + 2, g2, l2); xpieceq(w4 * 8 + 3, g3, l3);
    xpieceq(w4 * 8 + 4, g4, l4); xpieceq(w4 * 8 + 5, g5, l5); xpieceq(w4 * 8 + 6, g6, l6); xpieceq(w4 * 8 + 7, g7, l7);
    wpieceq(w4 * 4 + 0, g8, l8); wpieceq(w4 * 4 + 1, g9, l9); wpieceq(w4 * 4 + 2, g10, l10); wpieceq(w4 * 4 + 3, g11, l11);
  } else if (C::NXP == 4) { xpieceq(wid * 4 + 0, g0, l0); xpieceq(wid * 4 + 1, g1, l1); xpieceq(wid * 4 + 2, g2, l2); xpieceq(wid * 4 + 3, g3, l3); wpieceq(wid * 2 + 0, g4, l4); wpieceq(wid * 2 + 1, g5, l5); }
  else { xpieceq(wid * 2 + 0, g0, l0); xpieceq(wid * 2 + 1, g1, l1); wpieceq(wid * 4 + 0, g2, l2); wpieceq(wid * 4 + 1, g3, l3); wpieceq(wid * 4 + 2, g4, l4); wpieceq(wid * 4 + 3, g5, l5); }
  const size_t stp0 = stepx, stp1 = stepx, stp2 = (BG || C::NXP == 4) ? stepx : stepw, stp3 = (BG || C::NXP == 4) ? stepx : stepw, stp4 = BG ? stepx : stepw, stp5 = BG ? stepx : stepw;
  const bool dmaw = !BG || wid < 4;
  int xr[2];
#pragma unroll
  for (int ti = 0; ti < 2; ++ti) xr[ti] = (wm * 64 + ti * 32 + r32) * 128;
  const int xsw = (r32 >> 1) & 7;
  int wr[2];
#pragma unroll
  for (int ni = 0; ni < 2; ++ni) {
    const int slab = NMAP == 0 ? 0 : (NMAP == 1 ? (wn >> 1) : ni);
    const int nb = NMAP == 0 ? (2 * wn + ni) : (NMAP == 1 ? ((wn & 1) * 2 + ni) : wn);
    wr[ni] = C::XB + slab * 16384 + nb * 512 + v_rd_base(lane);
  }
  const int nk = K / 64;
#define G_DMA1(gp, sp, lp, kt, _d) __builtin_amdgcn_global_load_lds((const unsigned*)((gp) + (size_t)(kt) * (sp)), (LAS unsigned*)((_d) + (lp)), 16, 0, 0)
#define G_DMA(kt, st) do { if (dmaw) { LAS char* _d = lds + (st) * C::STAGE; \
    G_DMA1(g0, stp0, l0, kt, _d); G_DMA1(g1, stp1, l1, kt, _d); G_DMA1(g2, stp2, l2, kt, _d); G_DMA1(g3, stp3, l3, kt, _d); G_DMA1(g4, stp4, l4, kt, _d); G_DMA1(g5, stp5, l5, kt, _d); \
    if (BG) { G_DMA1(g6, stepx, l6, kt, _d); G_DMA1(g7, stepx, l7, kt, _d); G_DMA1(g8, stepw, l8, kt, _d); G_DMA1(g9, stepw, l9, kt, _d); G_DMA1(g10, stepw, l10, kt, _d); G_DMA1(g11, stepw, l11, kt, _d); } } } while (0)
#define G_HALF(cur, wa0, wa1, H) do { bf16x8 xf[2][2], wf[2][2]; \
      _Pragma("unroll") for (int k2 = 0; k2 < 2; ++k2) _Pragma("unroll") for (int ti = 0; ti < 2; ++ti) xf[k2][ti] = *(const LAS bf16x8*)(cur + xr[ti] + ((((H * 2 + k2) * 2 + hi) ^ xsw) << 4)); \
      wf[0][0] = tr_frag_asm<(H * 2 + 0) * 4096>(wa0); wf[0][1] = tr_frag_asm<(H * 2 + 0) * 4096>(wa1); \
      wf[1][0] = tr_frag_asm<(H * 2 + 1) * 4096>(wa0); wf[1][1] = tr_frag_asm<(H * 2 + 1) * 4096>(wa1); \
      asm volatile("s_waitcnt lgkmcnt(0)" ::: "memory"); __builtin_amdgcn_sched_barrier(0); \
      _Pragma("unroll") for (int k2 = 0; k2 < 2; ++k2) _Pragma("unroll") for (int ti = 0; ti < 2; ++ti) _Pragma("unroll") for (int ni = 0; ni < 2; ++ni) \
        acc[ti][ni] = __builtin_amdgcn_mfma_f32_32x32x16_bf16(wf[k2][ni], xf[k2][ti], acc[ti][ni], 0, 0, 0); } while (0)
#define G_COMPUTE(st) do { const LAS char* cur = lds + (st) * C::STAGE; const int wa0 = (int)(uintptr_t)(cur + wr[0]), wa1 = (int)(uintptr_t)(cur + wr[1]); \
    G_HALF(cur, wa0, wa1, 0); G_HALF(cur, wa0, wa1, 1); } while (0)
  static_assert(C::NXP + C::NWP == 6 && (!BG || (C::NXP == 4 && C::NWP == 2)), "piece counts assumed by the vmcnt waits");
  G_DMA(0, 0); G_DMA(1, 1);
  pre();
#pragma unroll
  for (int a_ = 0; a_ < 2; ++a_)
#pragma unroll
    for (int b_ = 0; b_ < 2; ++b_) acc[a_][b_] = (f32x16){};
  f32x4 b0a, b0b, b0c, b0d, b1a, b1b, b1c, b1d, b2a, b2b, b2c, b2d; int bi0 = -1, bi1 = -1, bi2 = -1;
  const int bgoff = tid - 256;
#define BG_SLOT(bi, xa, xb, xc, xd) do { if (bi >= 0) { asm volatile("s_waitcnt vmcnt(8)" ::: "memory");     \
      BGA_RETIRE(bi, bgoff, xa, xb); BGA_RETIRE(bi, bgoff + 256, xc, xd); bi = -1; } \
    if (bgdone < bgn) { bi = bgdone; BGA_ISSUE(bi, bgoff, xa, xb); BGA_ISSUE(bi, bgoff + 256, xc, xd); } } while (0)
#define G_STEP(kt, ST, bi, xa, xb, xc, xd) do { \
    if (dmaw) { if ((kt) + 1 < nk) { if (BG) asm volatile("s_waitcnt vmcnt(12)" ::: "memory"); \
                                     else if ((kt) < 2 && sprev >= 16) asm volatile("s_waitcnt vmcnt(22)" ::: "memory"); \
                                     else if ((kt) < 2 && sprev >= 8) asm volatile("s_waitcnt vmcnt(14)" ::: "memory"); \
                                     else asm volatile("s_waitcnt vmcnt(6)" ::: "memory"); } \
                else asm volatile("s_waitcnt vmcnt(0)" ::: "memory"); } \
    asm volatile("s_waitcnt lgkmcnt(0)" ::: "memory"); __builtin_amdgcn_s_barrier(); \
    if ((kt) + 2 < nk) G_DMA((kt) + 2, ((ST) + 2) % 3); \
    if (BG && !dmaw) BG_SLOT(bi, xa, xb, xc, xd); \
    if (BG && bgdone < bgn) ++bgdone; \
    G_COMPUTE(ST); } while (0)
  for (int kt = 0; kt < nk; kt += 3) {
    G_STEP(kt, 0, bi0, b0a, b0b, b0c, b0d);
    if (kt + 1 < nk) G_STEP(kt + 1, 1, bi1, b1a, b1b, b1c, b1d);
    if (kt + 2 < nk) G_STEP(kt + 2, 2, bi2, b2a, b2b, b2c, b2d);
  }
  if (BG && !dmaw) {
    asm volatile("s_waitcnt vmcnt(0)" ::: "memory");
    if (bi0 >= 0) { BGA_RETIRE(bi0, bgoff, b0a, b0b); BGA_RETIRE(bi0, bgoff + 256, b0c, b0d); }
    if (bi1 >= 0) { BGA_RETIRE(bi1, bgoff, b1a, b1b); BGA_RETIRE(bi1, bgoff + 256, b1c, b1d); }
    if (bi2 >= 0) { BGA_RETIRE(bi2, bgoff, b2a, b2b); BGA_RETIRE(bi2, bgoff + 256, b2c, b2d); }
    asm volatile("s_waitcnt vmcnt(0)" ::: "memory");
  }
#undef G_STEP
#undef BG_SLOT
  asm volatile("s_waitcnt lgkmcnt(0)" ::: "memory"); __builtin_amdgcn_s_barrier();
#undef G_DMA
#undef G_DMA1
#undef G_COMPUTE
#undef G_HALF
}


struct UnitD { int a, b, c, d, lv0, lv1; };
template <int BM, int BN, int NMAP, class Dec, class XRow, class WPtr, class Epi>
__device__ __forceinline__ void gemm_stream(LAS char* lds, int ldw, int K, const Dec& dec, const XRow& xrow, const WPtr& wptr, const Epi& epi) {
  using C = GemmCfg<BM, BN>;
  const int tid = TIDX, wid = __builtin_amdgcn_readfirstlane(tid >> 6), lane = tid & 63, r32 = lane & 31, hi = lane >> 5;
  const int wm = wid / C::WN, wn = wid % C::WN;
  static_assert(C::NXP + C::NWP == 6, "six DMA pieces per wave per k-tile");
  auto xptr = [&](const UnitD& u, int q) { const int row = 8 * q + (lane >> 3), c = (lane & 7) ^ ((row >> 1) & 7); return xrow(u, row) + c * 8; };
  auto wptr2 = [&](const UnitD& u, int idx) {
    const int s = idx >> 4, q = idx & 15, sub = 2 * q + (lane >> 5), kk = (sub >> 2) * 8 + ((lane & 31) >> 2);
    const int k = (kk & ~0xC) | ((kk & 4) << 1) | ((kk & 8) >> 1), c = (sub & 3) * 32 + (lane & 3) * 8;
    return wptr(u, s) + (size_t)k * ldw + c; };
  auto wlds = [&](int idx) { return C::XB + (idx >> 4) * 16384 + (idx & 15) * 1024; };
  const int l0 = (wid * C::NXP + 0) * 1024, l1 = (wid * C::NXP + 1) * 1024;
  const int l2 = C::NXP == 4 ? (wid * 4 + 2) * 1024 : wlds(wid * 4 + 0), l3 = C::NXP == 4 ? (wid * 4 + 3) * 1024 : wlds(wid * 4 + 1);
  const int l4 = C::NXP == 4 ? wlds(wid * 2 + 0) : wlds(wid * 4 + 2), l5 = C::NXP == 4 ? wlds(wid * 2 + 1) : wlds(wid * 4 + 3);
  const size_t stepx = 64, stepw = (size_t)64 * ldw;
  const size_t stp0 = stepx, stp1 = stepx, stp2 = C::NXP == 4 ? stepx : stepw, stp3 = C::NXP == 4 ? stepx : stepw, stp4 = stepw, stp5 = stepw;
#define S_SETUP(u, P) do { P##0 = xptr(u, wid * C::NXP + 0); P##1 = xptr(u, wid * C::NXP + 1); \
    if (C::NXP == 4) { P##2 = xptr(u, wid * 4 + 2); P##3 = xptr(u, wid * 4 + 3); P##4 = wptr2(u, wid * 2 + 0); P##5 = wptr2(u, wid * 2 + 1); } \
    else { P##2 = wptr2(u, wid * 4 + 0); P##3 = wptr2(u, wid * 4 + 1); P##4 = wptr2(u, wid * 4 + 2); P##5 = wptr2(u, wid * 4 + 3); } } while (0)
#define S_DMA1(gp, sp, lp, kt, _d) __builtin_amdgcn_global_load_lds((const unsigned*)((gp) + (size_t)(kt) * (sp)), (LAS unsigned*)((_d) + (lp)), 16, 0, 0)
#define S_DMA(P, kt, stg) do { LAS char* _d = lds + (stg) * C::STAGE; S_DMA1(P##0, stp0, l0, kt, _d); S_DMA1(P##1, stp1, l1, kt, _d); S_DMA1(P##2, stp2, l2, kt, _d); \
    S_DMA1(P##3, stp3, l3, kt, _d); S_DMA1(P##4, stp4, l4, kt, _d); S_DMA1(P##5, stp5, l5, kt, _d); } while (0)
  int xr[2];
#pragma unroll
  for (int ti = 0; ti < 2; ++ti) xr[ti] = (wm * 64 + ti * 32 + r32) * 128;
  const int xsw = (r32 >> 1) & 7;
  int wr[2];
#pragma unroll
  for (int ni = 0; ni < 2; ++ni) {
    const int slab = NMAP == 0 ? 0 : (NMAP == 1 ? (wn >> 1) : ni);
    const int nb = NMAP == 0 ? (2 * wn + ni) : (NMAP == 1 ? ((wn & 1) * 2 + ni) : wn);
    wr[ni] = C::XB + slab * 16384 + nb * 512 + v_rd_base(lane);
  }
  const int nk = K / 64;
#define S_HALF(cur, wa0, wa1, H) do { bf16x8 xf[2][2], wf[2][2]; \
      _Pragma("unroll") for (int k2 = 0; k2 < 2; ++k2) _Pragma("unroll") for (int ti = 0; ti < 2; ++ti) xf[k2][ti] = *(const LAS bf16x8*)(cur + xr[ti] + ((((H * 2 + k2) * 2 + hi) ^ xsw) << 4)); \
      wf[0][0] = tr_frag_asm<(H * 2 + 0) * 4096>(wa0); wf[0][1] = tr_frag_asm<(H * 2 + 0) * 4096>(wa1); \
      wf[1][0] = tr_frag_asm<(H * 2 + 1) * 4096>(wa0); wf[1][1] = tr_frag_asm<(H * 2 + 1) * 4096>(wa1); \
      asm volatile("s_waitcnt lgkmcnt(0)" ::: "memory"); __builtin_amdgcn_sched_barrier(0); \
      _Pragma("unroll") for (int k2 = 0; k2 < 2; ++k2) _Pragma("unroll") for (int ti = 0; ti < 2; ++ti) _Pragma("unroll") for (int ni = 0; ni < 2; ++ni) \
        acc[ti][ni] = __builtin_amdgcn_mfma_f32_32x32x16_bf16(wf[k2][ni], xf[k2][ti], acc[ti][ni], 0, 0, 0); } while (0)
  UnitD cu, nu;
  if (!dec(0, cu)) return;
  asm volatile("s_waitcnt vmcnt(0)" : "+v"(cu.lv0), "+v"(cu.lv1) :: "memory");
  const bf16_t *g0, *g1, *g2, *g3, *g4, *g5, *n0 = nullptr, *n1 = nullptr, *n2 = nullptr, *n3 = nullptr, *n4 = nullptr, *n5 = nullptr;
  S_SETUP(cu, g);
  int st = 0;
  S_DMA(g, 0, 0); S_DMA(g, 1, 1);
  int sprev = 0;
  f32x16 acc[2][2];
  for (int it = 0;; ++it) {
    const bool okn = dec(it + 1, nu);
#pragma unroll
    for (int a_ = 0; a_ < 2; ++a_)
#pragma unroll
      for (int b_ = 0; b_ < 2; ++b_) acc[a_][b_] = (f32x16){};
    for (int kt = 0; kt < nk; ++kt) {
      if (kt + 1 < nk || okn) {
        if (kt < 2 && sprev >= 16) asm volatile("s_waitcnt vmcnt(22)" ::: "memory");
        else if (kt < 2 && sprev >= 8) asm volatile("s_waitcnt vmcnt(14)" ::: "memory");
        else asm volatile("s_waitcnt vmcnt(6)" ::: "memory");
      } else asm volatile("s_waitcnt vmcnt(0)" ::: "memory");
      asm volatile("s_waitcnt lgkmcnt(0)" ::: "memory"); __builtin_amdgcn_s_barrier();
      const int st2 = st == 0 ? 2 : st - 1;
      if (kt + 2 < nk) S_DMA(g, kt + 2, st2);
      else if (okn) {
        if (kt + 2 == nk) { asm volatile("" : "+v"(nu.lv0), "+v"(nu.lv1) :: "memory"); S_SETUP(nu, n); }
        S_DMA(n, kt + 2 - nk, st2);
      }
      { const LAS char* cur = lds + st * C::STAGE; const int wa0 = (int)(uintptr_t)(cur + wr[0]), wa1 = (int)(uintptr_t)(cur + wr[1]);
        S_HALF(cur, wa0, wa1, 0); S_HALF(cur, wa0, wa1, 1); }
      st = st == 2 ? 0 : st + 1;
    }
    sprev = epi(cu, acc);
    if (!okn) break;
    cu = nu; g0 = n0; g1 = n1; g2 = n2; g3 = n3; g4 = n4; g5 = n5;
  }
#undef S_HALF
#undef S_DMA
#undef S_DMA1
#undef S_SETUP
}

__device__ __forceinline__ unsigned pack4_fp8(const f32x16& a, int g) {
  int w = __builtin_amdgcn_cvt_pk_fp8_f32(a[4 * g], a[4 * g + 1], 0, false);
  w = __builtin_amdgcn_cvt_pk_fp8_f32(a[4 * g + 2], a[4 * g + 3], w, true);
  return (unsigned)w;
}
__device__ __forceinline__ u32x2 pack4(const f32x16& a, int g) { return (u32x2){cvtpk(a[4 * g], a[4 * g + 1]), cvtpk(a[4 * g + 2], a[4 * g + 3])}; }

__device__ __forceinline__ void phase_a1(const Params& p, int layer, LAS char* lds, int bid, int nblk) {
  const bf16_t* H = (const bf16_t*)(p.ws + OFF_H);
  const bf16_t* W = (const bf16_t*)(p.ws + OFF_WIN) + (size_t)layer * D * INW;
  bf16_t* Q = (bf16_t*)(p.ws + OFF_Q); bf16_t* Kb = (bf16_t*)(p.ws + OFF_K); bf16_t* Vb = (bf16_t*)(p.ws + OFF_V);
  float* U = (float*)(p.ws + OFF_U); bf16_t* AG = (bf16_t*)(p.ws + OFF_AG);
  unsigned char* Q8 = (unsigned char*)(p.ws + OFF_Q8); unsigned char* K8 = (unsigned char*)(p.ws + OFF_K8); unsigned char* VT8 = (unsigned char*)(p.ws + OFF_VT8);
  const float* rt = (const float*)(p.ws + OFF_ROPE);
  const int lane = TIDX & 63, wid = TIDX >> 6, r32 = lane & 31, hi = lane >> 5, wm = wid >> 1, wn = wid & 1;
  const size_t wo = (size_t)layer * NE * D * DE;
  const int bgn = (3 * (1 << 21) + nblk * 512 - 1) / (nblk * 512);
  const long bgc0 = (long)bid * bgn * 512;
  const float* bs0 = p.w_e_gate + wo; const float* bs1 = p.w_e_up + wo; const float* bs2 = p.w_e_down + wo;
  bf16_t* bd0 = (bf16_t*)(p.ws + OFF_WG) + wo; bf16_t* bd1 = (bf16_t*)(p.ws + OFF_WU) + wo; bf16_t* bd2 = (bf16_t*)(p.ws + OFF_WD) + wo;
  int bgdone = 0;
  const int nlat = 64 * 12, nctx = layer == 0 ? 12 : 2, nunits = nlat + nctx;
  const bool xmap = (nblk & 7) == 0;
  const int xcd = bid & 7, lb = bid >> 3, nlb = nblk >> 3, nl = lb < 96 ? (96 - lb + nlb - 1) / nlb : 0;
  for (int it = 0;; ++it) {
    int rtile, ct;
    if (xmap) {
      if (it < nl) { const int v = lb + it * nlb; rtile = 1 + xcd + 8 * (v / 12); ct = v % 12; }
      else { const int e2 = bid + (it - nl) * nblk; if (e2 >= nctx) break; rtile = 0; ct = layer == 0 ? e2 : 4 + e2; }
    } else {
      const int u = bid + it * nblk; if (u >= nunits) break;
      if (u < nlat) { rtile = 1 + u / 12; ct = u % 12; } else { rtile = 0; ct = layer == 0 ? (u - nlat) : (4 + u - nlat); }
    }
    const int m0 = rtile * 256, n0 = ct * 128;
    f32x16 acc[2][2];
#pragma unroll
    for (int a = 0; a < 2; ++a)
#pragma unroll
      for (int b = 0; b < 2; ++b) acc[a][b] = (f32x16){};
    gemm_mainloop<256, 128, 0, true>(lds, acc, [&](int row) { return H + (size_t)(m0 + row) * D; }, [&](int) { return W + n0; }, []() {}, 0, INW, D, bgdone, bgn, bgc0, bs0, bs1, bs2, bd0, bd1, bd2);
#pragma unroll
    for (int ti = 0; ti < 2; ++ti) {
      const int tok = m0 + wm * 64 + ti * 32 + r32;
      if (ct < 5) {
        float ss = 0.f;
#pragma unroll
        for (int ni = 0; ni < 2; ++ni)
#pragma unroll
          for (int r = 0; r < 16; ++r) ss += acc[ti][ni][r] * acc[ti][ni][r];
        ss = sum32(ss);
        const float rs = rsqrtf(ss * (1.f / 64.f) + EPS);
        const float* gain = (ct < 4 ? p.q_gain : p.k_gain) + layer * 64;
        const float osc = ct < 4 ? 0.125f * 1.4426950408889634f : 1.f;
        const bool lat = rtile > 0;
        const int t = tok - NCTX;
#pragma unroll
        for (int ni = 0; ni < 2; ++ni) {
          f32x16 v;
#pragma unroll
          for (int r = 0; r < 16; ++r) v[r] = acc[ti][ni][r] * rs * gain[ni * 32 + crow(r, hi)];
          if (lat) {
            const int pos = ni == 0 ? (t >> 6) : (t & 63);
#pragma unroll
            for (int r = 0; r < 8; ++r) {
              const int f = crow(r, hi);
              const float cs = rt[(pos * 16 + f) * 2], sn = rt[(pos * 16 + f) * 2 + 1];
              const float t1 = v[r], t2 = v[r + 8];
              v[r] = t1 * cs - t2 * sn; v[r + 8] = t2 * cs + t1 * sn;
            }
          }
#pragma unroll
          for (int r = 0; r < 16; ++r) v[r] *= osc;
          bf16_t* dst = ct < 4 ? Q + (size_t)tok * 512 + (ct * 2 + wn) * 64 + ni * 32 : Kb + (size_t)tok * 128 + wn * 64 + ni * 32;
          unsigned char* dst8 = ct < 4 ? Q8 + (size_t)tok * 512 + (ct * 2 + wn) * 64 + ni * 32 : K8 + (size_t)tok * 128 + wn * 64 + ni * 32;
#pragma unroll
          for (int g = 0; g < 4; ++g) { *(u32x2*)(dst + 8 * g + 4 * hi) = pack4(v, g); *(unsigned*)(dst8 + 8 * g + 4 * hi) = pack4_fp8(v, g); }
        }
      } else if (ct == 5) {
#pragma unroll
        for (int ni = 0; ni < 2; ++ni) {
#pragma unroll
          for (int g = 0; g < 4; ++g) *(u32x2*)(Vb + (size_t)tok * 128 + wn * 64 + ni * 32 + 8 * g + 4 * hi) = pack4(acc[ti][ni], g);
          float vmx = 0.f;
#pragma unroll
          for (int r = 0; r < 16; ++r) {
            const float vv = acc[ti][ni][r]; vmx = fmaxf(vmx, fabsf(vv));
            VT8[(size_t)(wn * 64 + ni * 32 + crow(r, hi)) * TT + tok] = (unsigned char)(__builtin_amdgcn_cvt_pk_fp8_f32(vv, vv, 0, false) & 0xff);
          }
          if (!(vmx <= 400.f)) atomicOr((int*)(p.ws + OFF_FLAG) + 1, 1);
        }
      } else if (ct < 8) {
#pragma unroll
        for (int ni = 0; ni < 2; ++ni)
#pragma unroll
          for (int g = 0; g < 4; ++g)
            *(f32x4*)(U + (size_t)tok * 256 + (ct - 6) * 128 + wn * 64 + ni * 32 + 8 * g + 4 * hi) =
                (f32x4){acc[ti][ni][4 * g], acc[ti][ni][4 * g + 1], acc[ti][ni][4 * g + 2], acc[ti][ni][4 * g + 3]};
      } else {
#pragma unroll
        for (int ni = 0; ni < 2; ++ni)
#pragma unroll
          for (int g = 0; g < 4; ++g) *(u32x2*)(AG + (size_t)tok * 512 + (ct - 8) * 128 + wn * 64 + ni * 32 + 8 * g + 4 * hi) = pack4(acc[ti][ni], g);
      }
    }
  }
  { const int tid = TIDX; while (bgdone < bgn) { f32x4 a, b2; const int i = bgdone++; BG_ISSUE(i, tid, a, b2); BG_RETIRE(i, tid, a, b2); } }
}

__device__ __forceinline__ void phase_c1(const Params& p, int layer, LAS char* lds, int bid, int nblk) {
  const bf16_t* A = (const bf16_t*)(p.ws + OFF_MIX);
  const bf16_t* W = (const bf16_t*)(p.ws + OFF_WOUT) + (size_t)layer * D * D;
  bf16_t* Y = (bf16_t*)(p.ws + OFF_Y);
  const int lane = TIDX & 63, wid = TIDX >> 6, r32 = lane & 31, hi = lane >> 5, wm = wid >> 1, wn = wid & 1;
  const int nctx = layer == 0 ? 8 : 0;
  const bool xmap = (nblk & 7) == 0;
  const int xcd = bid & 7, lb = bid >> 3, nlb = nblk >> 3, nl = lb < 64 ? (64 - lb + nlb - 1) / nlb : 0;
  gemm_stream<256, 128, 0>(lds, D, D,
    [&](int it, UnitD& u) {
      int rtile, ct;
      if (xmap) {
        if (it < nl) { const int v = lb + it * nlb; rtile = 1 + xcd + 8 * (v >> 3); ct = v & 7; }
        else { const int e2 = bid + (it - nl) * nblk; if (e2 >= nctx) return false; rtile = 0; ct = e2; }
      } else {
        const int un = bid + it * nblk; if (un >= 64 * 8 + nctx) return false;
        if (un < 512) { rtile = 1 + (un >> 3); ct = un & 7; } else { rtile = 0; ct = un - 512; }
      }
      u.a = rtile * 256; u.b = ct * 128; u.c = 0; u.d = 0; u.lv0 = 0; u.lv1 = 0; return true; },
    [&](const UnitD& u, int row) { return A + (size_t)(u.a + row) * D; },
    [&](const UnitD& u, int) { return W + u.b; },
    [&](const UnitD& u, f32x16 (&acc)[2][2]) {
#pragma unroll
      for (int ti = 0; ti < 2; ++ti) {
        const int tok = u.a + wm * 64 + ti * 32 + r32;
#pragma unroll
        for (int ni = 0; ni < 2; ++ni)
#pragma unroll
          for (int g = 0; g < 4; ++g) *(u32x2*)(Y + (size_t)tok * D + u.b + wn * 64 + ni * 32 + 8 * g + 4 * hi) = pack4(acc[ti][ni], g);
      }
      return 16; });
}

#ifndef MOE_XCD_MAP
#define MOE_XCD_MAP 0
#endif
__device__ __forceinline__ void moe_prefix(const int* cnt, LAS int* pre, int xcd) {
  if (TIDX == 0) {
    int o = 0; for (int e = 0; e < NE; ++e) { pre[e] = o; o += (cnt[e * CNT_STRIDE] + 127) >> 7; } pre[NE] = o;
    int l = 0; for (int j = 0; j < 4; ++j) { pre[40 + j] = l; l += (cnt[(xcd + 8 * j) * CNT_STRIDE] + 127) >> 7; } pre[44] = l;
  }
  if (TIDX >= 64 && TIDX < 64 + NE) pre[48 + TIDX - 64] = cnt[(TIDX - 64) * CNT_STRIDE];
  __syncthreads();
}
__device__ __forceinline__ bool moe_unit(const LAS int* pre, int bid, int nblk, int it, int& e, int& rt, int& ct, int& g) {
  if (MOE_XCD_MAP && (nblk & 7) == 0) {
    const int xcd = bid & 7, v = (bid >> 3) + it * (nblk >> 3), gl = v >> 2;
    if (gl >= pre[44]) return false;
    int j = 0; if (gl >= pre[41]) j = 1; if (gl >= pre[42]) j = 2; if (gl >= pre[43]) j = 3;
    e = xcd + 8 * j; rt = gl - pre[40 + j]; ct = v & 3; g = pre[e] + rt; return true;
  } else {
    const int u = bid + it * nblk; g = u >> 2; if (g >= pre[NE]) return false;
    int ee = 0; for (int i = 1; i < NE; ++i) ee += (pre[i] <= g) ? 1 : 0;
    e = ee; rt = g - pre[ee]; ct = u & 3; return true;
  }
}

__device__ __forceinline__ void phase_d1(const Params& p, int layer, LAS char* lds, int bid, int nblk) {
  const int* cnt = (const int*)(p.ws + OFF_CNT) + layer * NE * CNT_STRIDE;
  const bf16_t* H2 = (const bf16_t*)(p.ws + OFF_MIX);
  bf16_t* HM = (bf16_t*)(p.ws + OFF_HMID);
  LAS int* pre = (LAS int*)(lds + GEMM_LDS);
  moe_prefix(cnt, pre, bid & 7);
  const int lane = TIDX & 63, wid = TIDX >> 6, r32 = lane & 31, hi = lane >> 5, wm = wid >> 2, wn = wid & 3;
  const int grow = 16 * wid + (lane >> 3);
  const bf16_t* WG = (const bf16_t*)(p.ws + OFF_WG) + (size_t)layer * NE * D * DE; const bf16_t* WU = (const bf16_t*)(p.ws + OFF_WU) + (size_t)layer * NE * D * DE;
  gemm_stream<128, 256, 2>(lds, DE, D,
    [&](int it, UnitD& u) {
      int e, rt, ct, g; if (!moe_unit(pre, bid, nblk, it, e, rt, ct, g)) return false;
      const int* list = (const int*)(p.ws + OFF_LIST) + (size_t)e * CAPL + rt * 128 + grow;
      u.a = e; u.b = ct; u.c = g; u.d = pre[48 + e] - rt * 128;
      asm volatile("global_load_dword %0, %2, off\n\tglobal_load_dword %1, %2, off offset:32" : "=&v"(u.lv0), "=&v"(u.lv1) : "v"(list) : "memory");
      return true; },
    [&](const UnitD& u, int row) { const int lv = (row & 8) ? u.lv1 : u.lv0; const int tok = row < u.d ? (lv >> 1) : 0; return H2 + (size_t)tok * D; },
    [&](const UnitD& u, int s) { return (s == 0 ? WG : WU) + (size_t)u.a * D * DE + u.b * 128; },
    [&](const UnitD& u, f32x16 (&acc)[2][2]) {
      const size_t hrow0 = (size_t)u.c * 128;
#pragma unroll
      for (int ti = 0; ti < 2; ++ti) {
        const size_t row = hrow0 + wm * 64 + ti * 32 + r32;
        f32x16 a;
#pragma unroll
        for (int r = 0; r < 16; ++r) { const float gv = acc[ti][0][r]; a[r] = gv / (1.f + __expf(-gv)) * acc[ti][1][r]; }
#pragma unroll
        for (int gq = 0; gq < 4; ++gq) *(u32x2*)(HM + row * DE + u.b * 128 + wn * 32 + 8 * gq + 4 * hi) = pack4(a, gq);
      }
      return 8; });
}

__device__ __forceinline__ void phase_d2(const Params& p, int layer, LAS char* lds, int bid, int nblk) {
  const int* cnt = (const int*)(p.ws + OFF_CNT) + layer * NE * CNT_STRIDE;
  const bf16_t* HM = (const bf16_t*)(p.ws + OFF_HMID);
  bf16_t* OM = (bf16_t*)(p.ws + OFF_OMOE);
  LAS int* pre = (LAS int*)(lds + GEMM_LDS);
  moe_prefix(cnt, pre, bid & 7);
  const int lane = TIDX & 63, wid = TIDX >> 6, r32 = lane & 31, hi = lane >> 5, wm = wid >> 2, wn = wid & 3;
  const int row0 = wm * 64 + r32;
  const bf16_t* WD = (const bf16_t*)(p.ws + OFF_WD) + (size_t)layer * NE * DE * D;
  gemm_stream<128, 256, 1>(lds, D, DE,
    [&](int it, UnitD& u) {
      int e, rt, ct, g; if (!moe_unit(pre, bid, nblk, it, e, rt, ct, g)) return false;
      const int* list = (const int*)(p.ws + OFF_LIST) + (size_t)e * CAPL + rt * 128 + row0;
      u.a = e; u.b = ct; u.c = g; u.d = pre[48 + e] - rt * 128;
      asm volatile("global_load_dword %0, %2, off\n\tglobal_load_dword %1, %2, off offset:128" : "=&v"(u.lv0), "=&v"(u.lv1) : "v"(list) : "memory");
      return true; },
    [&](const UnitD& u, int row) { return HM + ((size_t)u.c * 128 + row) * DE; },
    [&](const UnitD& u, int s) { return WD + (size_t)u.a * DE * D + u.b * 256 + s * 128; },
    [&](const UnitD& u, f32x16 (&acc)[2][2]) {
#pragma unroll
      for (int ti = 0; ti < 2; ++ti) {
        const int ts = ti == 0 ? u.lv0 : u.lv1;
        if (row0 + ti * 32 < u.d) {
#pragma unroll
          for (int ni = 0; ni < 2; ++ni)
#pragma unroll
            for (int gq = 0; gq < 4; ++gq) *(u32x2*)(OM + (size_t)ts * D + u.b * 256 + wn * 64 + ni * 32 + 8 * gq + 4 * hi) = pack4(acc[ti][ni], gq);
        }
      }
      return u.d >= 128 ? 16 : 0; });
}
constexpr int ATT_SLOT = 16384, ATT_LDS = 4 * ATT_SLOT;
__device__ __forceinline__ int vst64(int k, int c) { const int kk = (k & ~0xC) | ((k & 4) << 1) | ((k & 8) >> 1); return ((kk >> 3) * 2 + (c >> 5)) * 512 + ((kk & 7) * 32 + (c & 31)) * 2; }
__device__ __forceinline__ bf16x8 tr_frag64(const LAS char* p) {
  s16x4 a = __builtin_amdgcn_ds_read_tr16_b64_v4i16((LAS s16x4*)p);
  s16x4 b = __builtin_amdgcn_ds_read_tr16_b64_v4i16((LAS s16x4*)(p + 1024));
  return (bf16x8){a[0], a[1], a[2], a[3], b[0], b[1], b[2], b[3]};
}
__device__ __forceinline__ bf16x8 pk4(const f32x16& P, int B) {
  unsigned a0 = cvtpk(P[B + 0], P[B + 1]), a1 = cvtpk(P[B + 2], P[B + 3]), b0 = cvtpk(P[B + 4], P[B + 5]), b1 = cvtpk(P[B + 6], P[B + 7]);
  auto r0 = __builtin_amdgcn_permlane32_swap(a0, b0, false, false); auto r1 = __builtin_amdgcn_permlane32_swap(a1, b1, false, false);
  u32x4 w = {r0[0], r1[0], r0[1], r1[1]};
  return __builtin_bit_cast(bf16x8, w);
}
struct AttnCtx { int krd0, krd1, ksw, hi, vrd; };
#define SBAR() __builtin_amdgcn_sched_barrier(0)
__device__ __forceinline__ void att_kload(const LAS char* slot, const AttnCtx& c, bf16x8 (&kf)[8]) {
#pragma unroll
  for (int d0 = 0; d0 < 4; ++d0) {
    kf[2 * d0] = *(const LAS bf16x8*)(slot + c.krd0 + (((2 * d0 + c.hi) ^ c.ksw) << 4));
    kf[2 * d0 + 1] = *(const LAS bf16x8*)(slot + c.krd1 + (((2 * d0 + c.hi) ^ c.ksw) << 4));
  }
}
__device__ __forceinline__ void att_qk(const bf16x8 (&kf)[8], const bf16x8 (&qr)[4], f32x16& s0, f32x16& s1) {
  s0 = (f32x16){}; s1 = (f32x16){};
#pragma unroll
  for (int d0 = 0; d0 < 4; ++d0) {
    s0 = __builtin_amdgcn_mfma_f32_32x32x16_bf16(kf[2 * d0], qr[d0], s0, 0, 0, 0);
    s1 = __builtin_amdgcn_mfma_f32_32x32x16_bf16(kf[2 * d0 + 1], qr[d0], s1, 0, 0, 0);
  }
}
__device__ __forceinline__ void att_exp(f32x16& s, float& l) {
#pragma unroll
  for (int r = 0; r < 16; ++r) { s[r] = __builtin_amdgcn_exp2f(s[r]); l += s[r]; }
  asm volatile("" : "+v"(l));
}
template <int KS0>
__device__ __forceinline__ void att_vload(const LAS char* slot, const AttnCtx& c, bf16x8 (&vf)[4]) {
#pragma unroll
  for (int i = 0; i < 2; ++i) { vf[2 * i] = tr_frag64(slot + c.vrd + (KS0 + i) * 2048); vf[2 * i + 1] = tr_frag64(slot + c.vrd + 512 + (KS0 + i) * 2048); }
}
__device__ __forceinline__ void att_pv2(const bf16x8& pa, const bf16x8& pb, const bf16x8 (&vf)[4], f32x16& o0, f32x16& o1) {
  o0 = __builtin_amdgcn_mfma_f32_32x32x16_bf16(pa, vf[0], o0, 0, 0, 0);
  o1 = __builtin_amdgcn_mfma_f32_32x32x16_bf16(pa, vf[1], o1, 0, 0, 0);
  o0 = __builtin_amdgcn_mfma_f32_32x32x16_bf16(pb, vf[2], o0, 0, 0, 0);
  o1 = __builtin_amdgcn_mfma_f32_32x32x16_bf16(pb, vf[3], o1, 0, 0, 0);
}
__device__ __forceinline__ void attn_unit(const Params& p, LAS char* lds, int row0, int hp, int nkeys) {
  const bf16_t* Q = (const bf16_t*)(p.ws + OFF_Q); const bf16_t* Kb = (const bf16_t*)(p.ws + OFF_K); const bf16_t* Vb = (const bf16_t*)(p.ws + OFF_V);
  bf16_t* MIX = (bf16_t*)(p.ws + OFF_MIX);
  const int tid = TIDX, wid = tid >> 6, lane = tid & 63, r32 = lane & 31, hi = lane >> 5, kvh = hp >> 1;
  bf16x8 qa[4], qb[4];
  { const bf16_t* Qg = Q + (size_t)(row0 + wid * 32 + r32) * 512 + hp * 128 + hi * 8;
#pragma unroll
    for (int d0 = 0; d0 < 4; ++d0) { qa[d0] = *(const bf16x8*)(Qg + d0 * 16); qb[d0] = *(const bf16x8*)(Qg + 64 + d0 * 16); } }
  const bf16_t* Kg = Kb + (size_t)(tid >> 3) * 128 + kvh * 64 + (tid & 7) * 8;
  const bf16_t* Vg = Vb + (size_t)(tid >> 3) * 128 + kvh * 64 + (tid & 7) * 8;
  const int kst = xoff(tid >> 3, tid & 7), vstw = 8192 + vst64(tid >> 3, (tid & 7) * 8);
  AttnCtx c; c.krd0 = r32 * 128; c.krd1 = (32 + r32) * 128; c.ksw = (r32 >> 1) & 7; c.hi = hi; c.vrd = 8192 + v_rd_base(lane);
  const int NT = nkeys >> 6;
  f32x16 oa0 = {}, oa1 = {}, ob0 = {}, ob1 = {}; float la = 0.f, lb = 0.f;
  u32x4 ks, vs;
  {
    const u32x4 k0 = *(const u32x4*)Kg, k1 = *(const u32x4*)(Kg + 64 * 128), v0 = *(const u32x4*)Vg, v1 = *(const u32x4*)(Vg + 64 * 128);
    *(LAS u32x4*)(lds + kst) = k0; *(LAS u32x4*)(lds + ATT_SLOT + kst) = k1;
    *(LAS u32x4*)(lds + vstw) = v0; *(LAS u32x4*)(lds + ATT_SLOT + vstw) = v1;
    ks = *(const u32x4*)(Kg + 2 * 64 * 128); vs = *(const u32x4*)(Vg + 2 * 64 * 128);
  }
  __syncthreads();
  for (int j = 0; j < NT; ++j) {
    const LAS char* sl = lds + (j & 3) * ATT_SLOT;
    bf16x8 kf[8], vfa[4], vfb[4];
    f32x16 sa0, sa1, sb0, sb1;
    att_kload(sl, c, kf);
    SBAR();
    att_qk(kf, qa, sa0, sa1);
    SBAR();
    att_qk(kf, qb, sb0, sb1);
    att_exp(sa0, la); att_exp(sa1, la);
    SBAR();
    const bf16x8 pa0 = pk4(sa0, 0), pa1 = pk4(sa0, 8), pa2 = pk4(sa1, 0), pa3 = pk4(sa1, 8);
    att_vload<0>(sl, c, vfa);
    SBAR();
    att_pv2(pa0, pa1, vfa, oa0, oa1);
    att_exp(sb0, lb);
    att_vload<2>(sl, c, vfb);
    SBAR();
    att_pv2(pa2, pa3, vfb, oa0, oa1);
    att_exp(sb1, lb);
    const bf16x8 pb0 = pk4(sb0, 0), pb1 = pk4(sb0, 8), pb2 = pk4(sb1, 0), pb3 = pk4(sb1, 8);
    att_vload<0>(sl, c, vfa);
    SBAR();
    att_pv2(pb0, pb1, vfa, ob0, ob1);
    att_vload<2>(sl, c, vfb);
    SBAR();
    att_pv2(pb2, pb3, vfb, ob0, ob1);
    { LAS char* w = lds + ((j + 2) & 3) * ATT_SLOT;
      if (j + 2 < NT) { *(LAS u32x4*)(w + kst) = ks; *(LAS u32x4*)(w + vstw) = vs; }
      if (j + 3 < NT) { ks = *(const u32x4*)(Kg + (size_t)(j + 3) * 64 * 128); vs = *(const u32x4*)(Vg + (size_t)(j + 3) * 64 * 128); } }
    __syncthreads();
  }
  la = sum32(la); lb = sum32(lb);
  LAS float* li = (LAS float*)(lds + wid * 256);
  if (hi == 0) { li[r32] = la; li[32 + r32] = lb; }
  __syncthreads();
  bf16_t* Og = MIX + (size_t)(row0 + wid * 32) * D + hp * 128 + r32;
#pragma unroll
  for (int r = 0; r < 16; ++r) {
    const int orow = crow(r, hi);
    const float ra = __builtin_amdgcn_rcpf(li[orow]), rb = __builtin_amdgcn_rcpf(li[32 + orow]);
    Og[(size_t)orow * D] = f2bf(oa0[r] * ra); Og[(size_t)orow * D + 32] = f2bf(oa1[r] * ra);
    Og[(size_t)orow * D + 64] = f2bf(ob0[r] * rb); Og[(size_t)orow * D + 96] = f2bf(ob1[r] * rb);
  }
  __syncthreads();
}
typedef int i32x8 __attribute__((ext_vector_type(8)));
constexpr int A8_SLOT = 8192, A8_NSLOT = 8, A8_LDS = A8_NSLOT * A8_SLOT;
__device__ __forceinline__ int off8(int row, int chunk) { return row * 64 + ((chunk ^ ((row >> 2) & 3)) << 4); }
__device__ __forceinline__ i32x8 ld_frag8(const LAS char* tile, int row, int h) {
  const int sw = (row >> 2) & 3;
  const u32x4 lo = *(const LAS u32x4*)(tile + row * 64 + (((2 * h) ^ sw) << 4)), hi = *(const LAS u32x4*)(tile + row * 64 + (((2 * h + 1) ^ sw) << 4));
  return (i32x8){(int)lo[0], (int)lo[1], (int)lo[2], (int)lo[3], (int)hi[0], (int)hi[1], (int)hi[2], (int)hi[3]};
}
#define MX_FP8_FP8(a, b, c) __builtin_amdgcn_mfma_scale_f32_32x32x64_f8f6f4(a, b, c, 0, 0, 0, 0x7f7f7f7f, 0, 0x7f7f7f7f)
#define MX_BF8_FP8(a, b, c) __builtin_amdgcn_mfma_scale_f32_32x32x64_f8f6f4(a, b, c, 1, 0, 0, 0x7f7f7f7f, 0, 0x7f7f7f7f)
typedef _Float16 f16x2 __attribute__((ext_vector_type(2)));
__device__ __forceinline__ unsigned att8_code4(float s0, float s1, float s2, float s3) {
  const f16x2 four = {(_Float16)4.f, (_Float16)4.f}, bias = {(_Float16)1084.f, (_Float16)1084.f};
  const f16x2 x = __builtin_bit_cast(f16x2, __builtin_amdgcn_cvt_pkrtz(s0, s1)) * four + bias, y = __builtin_bit_cast(f16x2, __builtin_amdgcn_cvt_pkrtz(s2, s3)) * four + bias;
  return __builtin_amdgcn_perm(__builtin_bit_cast(unsigned, y), __builtin_bit_cast(unsigned, x), 0x06040200u);
}
__device__ __forceinline__ i32x8 att8_pack(const f32x16& p0, const f32x16& p1) {
  i32x8 w;
#pragma unroll
  for (int i = 0; i < 4; ++i) {
    const unsigned d = att8_code4(p0[4 * i], p0[4 * i + 1], p0[4 * i + 2], p0[4 * i + 3]), e = att8_code4(p1[4 * i], p1[4 * i + 1], p1[4 * i + 2], p1[4 * i + 3]);
    auto r = __builtin_amdgcn_permlane32_swap(d, e, false, false);
    w[2 * i] = (int)r[0]; w[2 * i + 1] = (int)r[1];
  }
  return w;
}
__device__ __forceinline__ void attn_unit8(const Params& p, LAS char* lds, int row0, int hp, int nkeys, bf16_t* MIXP = nullptr) {
  const unsigned char* Q8 = (const unsigned char*)(p.ws + OFF_Q8); const unsigned char* K8 = (const unsigned char*)(p.ws + OFF_K8); const unsigned char* VT8 = (const unsigned char*)(p.ws + OFF_VT8);
  bf16_t* MIX = MIXP ? MIXP : (bf16_t*)(p.ws + OFF_MIX);
  const int tid = TIDX, wid = tid >> 6, lane = tid & 63, r32 = lane & 31, hi = lane >> 5, kvh = hp >> 1;
  i32x8 qa, qb;
  { const unsigned char* Qg = Q8 + (size_t)(row0 + wid * 32 + r32) * 512 + hp * 128 + hi * 32;
    const u32x4 a0 = *(const u32x4*)Qg, a1 = *(const u32x4*)(Qg + 16), b0 = *(const u32x4*)(Qg + 64), b1 = *(const u32x4*)(Qg + 80);
    qa = (i32x8){(int)a0[0], (int)a0[1], (int)a0[2], (int)a0[3], (int)a1[0], (int)a1[1], (int)a1[2], (int)a1[3]};
    qb = (i32x8){(int)b0[0], (int)b0[1], (int)b0[2], (int)b0[3], (int)b1[0], (int)b1[1], (int)b1[2], (int)b1[3]}; }
  const int wv = __builtin_amdgcn_readfirstlane(wid);
  const int prow = (wv & 3) * 16 + (lane >> 2), pch = (lane & 3) ^ ((prow >> 2) & 3);
  const unsigned char* Sg = wv < 4 ? K8 + (size_t)prow * 128 + kvh * 64 + pch * 16 : VT8 + (size_t)(kvh * 64 + prow) * TT + pch * 16;
  const size_t sstep = wv < 4 ? (size_t)64 * 128 : (size_t)64;
  const int sdst = (wv < 4 ? 0 : 4096) + (wv & 3) * 1024;
#define A8_DMA(t) __builtin_amdgcn_global_load_lds((const unsigned*)(Sg + (size_t)(t) * sstep), (LAS unsigned*)(lds + ((t) & (A8_NSLOT - 1)) * A8_SLOT + sdst), 16, 0, 0)
  const int NT = nkeys >> 6;
  f32x16 oa0 = {}, oa1 = {}, ob0 = {}, ob1 = {}, ola = {}, olb = {};
  const i32x8 ones = {0x38383838, 0x38383838, 0x38383838, 0x38383838, 0x38383838, 0x38383838, 0x38383838, 0x38383838};
  A8_DMA(0); A8_DMA(1); if (NT > 2) { A8_DMA(2); A8_DMA(3); }
  for (int j = 0; j < NT; j += 2) {
    if (j + 2 < NT) asm volatile("s_waitcnt vmcnt(2)" ::: "memory"); else asm volatile("s_waitcnt vmcnt(0)" ::: "memory");
    asm volatile("s_waitcnt lgkmcnt(0)" ::: "memory"); __builtin_amdgcn_s_barrier();
    if (j + 4 < NT) { A8_DMA(j + 4); A8_DMA(j + 5); }
#pragma unroll
    for (int jj = 0; jj < 2; ++jj) {
      const LAS char* sl = lds + ((j + jj) & (A8_NSLOT - 1)) * A8_SLOT;
      f32x16 sa0 = {}, sa1 = {}, sb0 = {}, sb1 = {};
      const i32x8 kf0 = ld_frag8(sl, r32, hi), kf1 = ld_frag8(sl, 32 + r32, hi);
      SBAR();
      sa0 = MX_FP8_FP8(kf0, qa, sa0); sa1 = MX_FP8_FP8(kf1, qa, sa1);
      SBAR();
      sb0 = MX_FP8_FP8(kf0, qb, sb0); sb1 = MX_FP8_FP8(kf1, qb, sb1);
      SBAR();
      const i32x8 pa = att8_pack(sa0, sa1);
      const i32x8 vf0 = ld_frag8(sl + 4096, r32, hi), vf1 = ld_frag8(sl + 4096, 32 + r32, hi);
      SBAR();
      oa0 = MX_BF8_FP8(pa, vf0, oa0); oa1 = MX_BF8_FP8(pa, vf1, oa1); ola = MX_BF8_FP8(pa, ones, ola);
      const i32x8 pb = att8_pack(sb0, sb1);
      SBAR();
      ob0 = MX_BF8_FP8(pb, vf0, ob0); ob1 = MX_BF8_FP8(pb, vf1, ob1); olb = MX_BF8_FP8(pb, ones, olb);
    }
  }
#undef A8_DMA
  asm volatile("s_waitcnt lgkmcnt(0)" ::: "memory"); __builtin_amdgcn_s_barrier();
  bf16_t* Og = MIX + (size_t)(row0 + wid * 32) * D + hp * 128 + r32;
#pragma unroll
  for (int r = 0; r < 16; ++r) {
    const int orow = crow(r, hi);
    const float ra = __builtin_amdgcn_rcpf(ola[r]), rb = __builtin_amdgcn_rcpf(olb[r]);
    Og[(size_t)orow * D] = f2bf(oa0[r] * ra); Og[(size_t)orow * D + 32] = f2bf(oa1[r] * ra);
    Og[(size_t)orow * D + 64] = f2bf(ob0[r] * rb); Og[(size_t)orow * D + 96] = f2bf(ob1[r] * rb);
  }
  __syncthreads();
}
__device__ __forceinline__ void attn_fallback(const Params& p, int layer, int bid, int nblk) {
  const bf16_t* Q = (const bf16_t*)(p.ws + OFF_Q); const bf16_t* Kb = (const bf16_t*)(p.ws + OFF_K); const bf16_t* Vb = (const bf16_t*)(p.ws + OFF_V);
  bf16_t* MIX = (bf16_t*)(p.ws + OFF_MIX);
  const int lane = TIDX & 63, nwv = nblk * 8;
  const int rg0 = layer == 0 ? 0 : NCTX / 64;
  for (int wv = bid * 8 + (TIDX >> 6) + rg0 * 8; wv < (TT / 64) * 8; wv += nwv) {
    const int head = wv & 7, r = (wv >> 3) * 64 + lane, kvh = head >> 2;
    float q[64], o[64];
#pragma unroll
    for (int d = 0; d < 64; ++d) { q[d] = bf2f(Q[(size_t)r * 512 + head * 64 + d]); o[d] = 0.f; }
    float m = -1e30f, l = 0.f;
    const int nk = r >= NCTX ? TT : NCTX;
    for (int j = 0; j < nk; ++j) {
      const bf16_t* kr = Kb + (size_t)j * 128 + kvh * 64;
      const bf16_t* vr = Vb + (size_t)j * 128 + kvh * 64;
      float s = 0.f;
#pragma unroll
      for (int d = 0; d < 64; ++d) s += q[d] * bf2f(kr[d]);
      if (s > m) {
        const float a = __builtin_amdgcn_exp2f(m - s);
        l *= a;
#pragma unroll
        for (int d = 0; d < 64; ++d) o[d] *= a;
        m = s;
      }
      const float pe = __builtin_amdgcn_exp2f(s - m);
      l += pe;
#pragma unroll
      for (int d = 0; d < 64; ++d) o[d] += pe * bf2f(vr[d]);
    }
    const float il = 1.f / l;
#pragma unroll
    for (int d = 0; d < 64; ++d) MIX[(size_t)r * D + head * 64 + d] = f2bf(o[d] * il);
  }
}

constexpr int PC_U = 0;
constexpr int PC_Y = 49152;
constexpr int PC_P = PC_Y + 65536;
constexpr int PC_LDS = PC_P + 32768;
__device__ __forceinline__ void poolconv_unit(const Params& p, int layer, LAS char* lds, int tile) {
  const int tid = TIDX, wid = tid >> 6, lane = tid & 63, r32 = lane & 31, hi = lane >> 5;
  const int t0 = tile * 64, base = tile < 4 ? 0 : NCTX, n = tile < 4 ? NCTX : SEQ;
  const bf16_t* AG = (const bf16_t*)(p.ws + OFF_AG);
  const float* U = (const float*)(p.ws + OFF_U);
  bf16_t* MIX = (bf16_t*)(p.ws + OFF_MIX);
#pragma unroll
  for (int h = 0; h < 2; ++h) {
    u32x4 av[3], gv[3]; bool in[3];
#pragma unroll
    for (int q = 0; q < 3; ++q) {
      const int idx = tid + (h * 3 + q) * 512, rr = idx >> 5, ch = (idx & 31) * 8, t = t0 - 15 + rr;
      in[q] = idx < 94 * 32 && t >= base && t < base + n;
      const size_t off = (size_t)(in[q] ? t : t0) * 512 + ch;
      av[q] = *(const u32x4*)(AG + off); gv[q] = *(const u32x4*)(AG + off + 256);
    }
#pragma unroll
    for (int q = 0; q < 3; ++q) {
      const int idx = tid + (h * 3 + q) * 512, rr = idx >> 5, ch = (idx & 31) * 8;
      u32x4 out = {0u, 0u, 0u, 0u};
      if (in[q]) {
#pragma unroll
        for (int i = 0; i < 4; ++i) {
          const float a0 = __uint_as_float(av[q][i] << 16), a1 = __uint_as_float(av[q][i] & 0xffff0000u);
          const float g0 = __uint_as_float(gv[q][i] << 16), g1 = __uint_as_float(gv[q][i] & 0xffff0000u);
          out[i] = cvtpk(a0 / (1.f + __expf(-g0)), a1 / (1.f + __expf(-g1)));
        }
      }
      if (idx < 94 * 32) *(LAS u32x4*)(lds + PC_U + (rr * 256 + ch) * 2) = out;
    }
  }
  __syncthreads();
  {
    const int c = tid & 255, th = tid >> 8;
    float w[31];
#pragma unroll
    for (int j = 0; j < 31; ++j) w[j] = p.w_dw[(size_t)layer * 31 * 256 + j * 256 + c];
    const float b = p.b_dw[layer * 256 + c];
    float acc[32];
#pragma unroll
    for (int i = 0; i < 32; ++i) acc[i] = b;
    const LAS bf16_t* up = (const LAS bf16_t*)(lds + PC_U) + (th * 32) * 256 + c;
#pragma unroll
    for (int rr = 0; rr < 62; ++rr) {
      const float uv = bf2f(up[rr * 256]);
#pragma unroll
      for (int i = 0; i < 32; ++i) if (rr - i >= 0 && rr - i < 31) acc[i] += uv * w[rr - i];
    }
    LAS float* yp = (LAS float*)(lds + PC_Y) + (th * 32) * 256 + c;
#pragma unroll
    for (int i = 0; i < 32; ++i) yp[i * 256] = acc[i];
  }
  {
    const int c = tid & 255, th = tid >> 8, grp = c >> 6, w = 2 << grp, hw = w >> 1;
    const int tl0 = t0 - base + th * 32;
    float uv[48];
#pragma unroll
    for (int i = 0; i < 48; ++i) { const int j = tl0 - 8 + i; const bool in = j >= 0 && j < n; uv[i] = in ? U[(size_t)(base + j) * 256 + c] : 0.f; }
#pragma unroll
    for (int i = 0; i < 32; ++i) {
      const int tl = tl0 + i, lo = max(tl - hw, 0), hh = min(tl + hw, n);
      float s = 0.f;
#pragma unroll
      for (int d = -8; d < 8; ++d) if (d >= -hw && d < hw) s += uv[8 + i + d];
      const float pv = s / (float)(hh - lo) - uv[8 + i];
      const int tok = th * 32 + i, chunk = c >> 3, sw = (chunk & 16) | ((chunk ^ tok) & 15);
      *(LAS bf16_t*)(lds + PC_P + tok * 512 + sw * 16 + (c & 7) * 2) = f2bf(pv);
    }
  }
  __syncthreads();
  {
    const f32x4 g4 = *(const f32x4*)(p.cv_ln_g + layer * 256 + lane * 4), b4 = *(const f32x4*)(p.cv_ln_b + layer * 256 + lane * 4);
#pragma unroll
    for (int i = 0; i < 8; ++i) {
      const int tok = wid * 8 + i;
      const f32x4 y = *(const LAS f32x4*)(lds + PC_Y + (tok * 256 + lane * 4) * 4);
      const float mu = wave_sum(y[0] + y[1] + y[2] + y[3]) * (1.f / 256.f);
      const float d0 = y[0] - mu, d1 = y[1] - mu, d2 = y[2] - mu, d3 = y[3] - mu;
      const float rs = rsqrtf(wave_sum(d0 * d0 + d1 * d1 + d2 * d2 + d3 * d3) * (1.f / 256.f) + EPS);
      const float z0 = silu(d0 * rs * g4[0] + b4[0]), z1 = silu(d1 * rs * g4[1] + b4[1]), z2 = silu(d2 * rs * g4[2] + b4[2]), z3 = silu(d3 * rs * g4[3] + b4[3]);
      const int chunk = lane >> 1, sw = (chunk & 16) | ((chunk ^ tok) & 15);
      *(LAS u32x2*)(lds + PC_U + tok * 512 + sw * 16 + (lane & 1) * 8) = (u32x2){cvtpk(z0, z1), cvtpk(z2, z3)};
    }
  }
  __syncthreads();
  {
    const int tb = wid >> 2, dg = wid & 3, trow = tb * 32 + r32, t = t0 + trow;
    const bf16_t* Wt = (const bf16_t*)(p.ws + OFF_WPWT) + ((size_t)layer * 256 + dg * 64 + r32) * 256 + hi * 8;
    f32x16 acc0 = {}, acc1 = {};
#pragma unroll 8
    for (int ks = 0; ks < 16; ++ks) {
      const int chunk = 2 * ks + hi, sw = (chunk & 16) | ((chunk ^ trow) & 15);
      const bf16x8 zf = *(const LAS bf16x8*)(lds + PC_U + trow * 512 + sw * 16);
      const bf16x8 w0 = *(const bf16x8*)(Wt + ks * 16), w1 = *(const bf16x8*)(Wt + 32 * 256 + ks * 16);
      acc0 = __builtin_amdgcn_mfma_f32_32x32x16_bf16(w0, zf, acc0, 0, 0, 0);
      acc1 = __builtin_amdgcn_mfma_f32_32x32x16_bf16(w1, zf, acc1, 0, 0, 0);
    }
    bf16_t* dst = MIX + (size_t)t * D + 768 + dg * 64;
#pragma unroll
    for (int g = 0; g < 4; ++g) { *(u32x2*)(dst + 8 * g + 4 * hi) = pack4(acc0, g); *(u32x2*)(dst + 32 + 8 * g + 4 * hi) = pack4(acc1, g); }
    const bf16_t* Pt = (const bf16_t*)(p.ws + OFF_WPOOLT) + ((size_t)(layer * 4 + dg) * 64 + r32) * 64 + hi * 8;
    f32x16 pc0 = {}, pc1 = {};
#pragma unroll
    for (int ks = 0; ks < 4; ++ks) {
      const int chunk = dg * 8 + 2 * ks + hi, sw = (chunk & 16) | ((chunk ^ trow) & 15);
      const bf16x8 pf = *(const LAS bf16x8*)(lds + PC_P + trow * 512 + sw * 16);
      const bf16x8 w0 = *(const bf16x8*)(Pt + ks * 16), w1 = *(const bf16x8*)(Pt + 32 * 64 + ks * 16);
      pc0 = __builtin_amdgcn_mfma_f32_32x32x16_bf16(w0, pf, pc0, 0, 0, 0);
      pc1 = __builtin_amdgcn_mfma_f32_32x32x16_bf16(w1, pf, pc1, 0, 0, 0);
    }
    const float* psc = p.pool_scale + layer * 256 + dg * 64;
#pragma unroll
    for (int r = 0; r < 16; ++r) { pc0[r] *= psc[crow(r, hi)]; pc1[r] *= psc[32 + crow(r, hi)]; }
    bf16_t* pd = MIX + (size_t)t * D + 512 + dg * 64;
#pragma unroll
    for (int g = 0; g < 4; ++g) { *(u32x2*)(pd + 8 * g + 4 * hi) = pack4(pc0, g); *(u32x2*)(pd + 32 + 8 * g + 4 * hi) = pack4(pc1, g); }
  }
  __syncthreads();
}

__device__ __forceinline__ void phase_b(const Params& p, int layer, LAS char* lds, int bid, int nblk) {
  const int mode0 = ((const int*)(p.ws + OFF_FLAG))[0], vbig = ((const int*)(p.ws + OFF_FLAG))[1];
  const int mode = (mode0 == 2 && vbig != 0) ? 1 : mode0;
  const bool fast = mode != 0;
  const int nu = (520 - bid + nblk - 1) / nblk;
  for (int i = 0; i < nu; ++i) {
    const int u = bid + ((bid & 1) ? (nu - 1 - i) : i) * nblk;
    if (u < 256) { if (mode == 2) attn_unit8(p, lds, NCTX + (u >> 2) * 256, u & 3, TT); else if (mode == 1) attn_unit(p, lds, NCTX + (u >> 2) * 256, u & 3, TT); }
    else if (u < 260) { if (layer == 0) { if (mode == 2) attn_unit8(p, lds, 0, u - 256, NCTX); else if (mode == 1) attn_unit(p, lds, 0, u - 256, NCTX); } }
    else { const int tile = u - 260; if (layer == 0 || tile >= 4) poolconv_unit(p, layer, lds, tile); }
  }
  if (!fast) attn_fallback(p, layer, bid, nblk);
}

constexpr int NR = 2, NRA = 2;
__device__ __forceinline__ float hsum4(const f32x4 (&v)[4]) { float s = 0.f;
#pragma unroll
  for (int i = 0; i < 4; ++i) s += (v[i][0] + v[i][1]) + (v[i][2] + v[i][3]);
  return s; }
__device__ __forceinline__ float hsq4(const f32x4 (&v)[4], float mu) { float q = 0.f;
#pragma unroll
  for (int i = 0; i < 4; ++i) { const f32x4 d = v[i] - mu; q += (d[0] * d[0] + d[1] * d[1]) + (d[2] * d[2] + d[3] * d[3]); }
  return q; }
__device__ __forceinline__ f32x4 bf4(u32x2 w) { return (f32x4){__uint_as_float(w[0] << 16), __uint_as_float(w[0] & 0xffff0000u), __uint_as_float(w[1] << 16), __uint_as_float(w[1] & 0xffff0000u)}; }

__device__ __forceinline__ void phase_a0(const Params& p, int layer, int bid, int nblk) {
  const int wave = bid * 8 + (TIDX >> 6), lane = TIDX & 63, nw = nblk * 8;
  float* X = (float*)(p.ws + OFF_X);
  bf16_t* H = (bf16_t*)(p.ws + OFF_H);
  const bf16_t* OM = (const bf16_t*)(p.ws + OFF_OMOE);
  for (int rb = wave * NRA; rb < TT; rb += nw * NRA) {
    f32x4 v[NRA][4]; u32x2 oa[NRA][4], ob[NRA][4];
#pragma unroll
    for (int k = 0; k < NRA; ++k) {
      const int r = rb + k;
      const float* src = layer == 0 ? (r < NCTX ? p.ctx + (size_t)r * D : p.x + (size_t)(r - NCTX) * D) : X + (size_t)r * D;
#pragma unroll
      for (int i = 0; i < 4; ++i) { const int c = i * 256 + lane * 4; v[k][i] = *(const f32x4*)(src + c);
        if (layer != 0) { oa[k][i] = *(const u32x2*)(OM + ((size_t)r * 2 + 0) * D + c); ob[k][i] = *(const u32x2*)(OM + ((size_t)r * 2 + 1) * D + c); } }
    }
    if (layer != 0) {
#pragma unroll
      for (int k = 0; k < NRA; ++k) {
        const int r = rb + k, s = r < NCTX ? 1 : 0;
        const float* g2 = (const float*)(p.ws + OFF_MOD) + ((layer - 1) * 2 + s) * 6144 + 5 * D;
        const float ga = ((const float*)(p.ws + OFF_GATE))[r * 2], gb = ((const float*)(p.ws + OFF_GATE))[r * 2 + 1];
#pragma unroll
        for (int i = 0; i < 4; ++i) { const int c = i * 256 + lane * 4; v[k][i] = v[k][i] * ALPHA + *(const f32x4*)(g2 + c) * (bf4(oa[k][i]) * ga + bf4(ob[k][i]) * gb); }
      }
      float mu[NRA], rs[NRA];
#pragma unroll
      for (int k = 0; k < NRA; ++k) mu[k] = wave_sum(hsum4(v[k])) * (1.f / D);
#pragma unroll
      for (int k = 0; k < NRA; ++k) rs[k] = rsqrtf(wave_sum(hsq4(v[k], mu[k])) * (1.f / D) + EPS);
      const float* g = p.ln2_g + (layer - 1) * D; const float* b = p.ln2_b + (layer - 1) * D;
#pragma unroll
      for (int k = 0; k < NRA; ++k)
#pragma unroll
        for (int i = 0; i < 4; ++i) { const int c = i * 256 + lane * 4; v[k][i] = (v[k][i] - mu[k]) * rs[k] * *(const f32x4*)(g + c) + *(const f32x4*)(b + c); *(f32x4*)(X + (size_t)(rb + k) * D + c) = v[k][i]; }
    }
    float mu[NRA], rs[NRA];
#pragma unroll
    for (int k = 0; k < NRA; ++k) mu[k] = wave_sum(hsum4(v[k])) * (1.f / D);
#pragma unroll
    for (int k = 0; k < NRA; ++k) rs[k] = rsqrtf(wave_sum(hsq4(v[k], mu[k])) * (1.f / D) + EPS);
#pragma unroll
    for (int k = 0; k < NRA; ++k) {
      const int r = rb + k, s = r < NCTX ? 1 : 0;
      const float* modp = (const float*)(p.ws + OFF_MOD) + (layer * 2 + s) * 6144;
#pragma unroll
      for (int i = 0; i < 4; ++i) {
        const int c = i * 256 + lane * 4;
        const f32x4 h = (v[k][i] - mu[k]) * rs[k] * (*(const f32x4*)(modp + D + c) + 1.f) + *(const f32x4*)(modp + c);
        *(u32x2*)(H + (size_t)r * D + c) = (u32x2){cvtpk(h[0], h[1]), cvtpk(h[2], h[3])};
      }
    }
  }
}

__device__ __forceinline__ void phase_c2(const Params& p, int layer, LAS char* lds, int bid, int nblk) {
  const int tid = TIDX, wid = tid >> 6, lane = tid & 63;
  float* X = (float*)(p.ws + OFF_X);
  const bf16_t* Y = (const bf16_t*)(p.ws + OFF_Y);
  bf16_t* H2 = (bf16_t*)(p.ws + OFF_MIX);
  int* cnt = (int*)(p.ws + OFF_CNT) + layer * NE * CNT_STRIDE;
  float* GATE = (float*)(p.ws + OFF_GATE); int* LIST = (int*)(p.ws + OFF_LIST);
  LAS int* lcnt = (LAS int*)lds;
  LAS int* lbase = lcnt + 32;
  LAS int* ent = lcnt + 64;
  if (tid < 32) lcnt[tid] = 0;
  LAS float* wre = (LAS float*)(lds + 4096);
#pragma unroll
  for (int kk = 0; kk < 2; ++kk) {
    const int k = tid + kk * 512;
    f32x4 w[8];
#pragma unroll
    for (int g = 0; g < 8; ++g) w[g] = *(const f32x4*)(p.w_re + ((size_t)layer * D + k) * 32 + g * 4);
#pragma unroll
    for (int g = 0; g < 8; ++g)
#pragma unroll
      for (int j = 0; j < 4; ++j) wre[(g * 4 + j) * 1024 + k] = w[g][j];
  }
  __syncthreads();
  const int r0 = layer == 0 ? 0 : NCTX, nrows = TT - r0, rpb = (nrows + nblk - 1) / nblk;
  const int rbeg = r0 + bid * rpb, rend = min(rbeg + rpb, TT);
  for (int rb = rbeg + wid * NR; rb < rend; rb += 8 * NR) {
    f32x4 v[NR][4]; u32x2 yv[NR][4]; int rr[NR]; bool ok[NR];
#pragma unroll
    for (int k = 0; k < NR; ++k) {
      ok[k] = rb + k < rend; rr[k] = ok[k] ? rb + k : rb;
      const int r = rr[k];
      const float* xin = layer == 0 ? (r < NCTX ? p.ctx + (size_t)r * D : p.x + (size_t)(r - NCTX) * D) : X + (size_t)r * D;
#pragma unroll
      for (int i = 0; i < 4; ++i) { const int c = i * 256 + lane * 4; v[k][i] = *(const f32x4*)(xin + c); yv[k][i] = *(const u32x2*)(Y + (size_t)r * D + c); }
    }
#pragma unroll
    for (int k = 0; k < NR; ++k) {
      const float* modp = (const float*)(p.ws + OFF_MOD) + (layer * 2 + (rr[k] < NCTX ? 1 : 0)) * 6144;
#pragma unroll
      for (int i = 0; i < 4; ++i) { const int c = i * 256 + lane * 4; v[k][i] = v[k][i] * ALPHA + *(const f32x4*)(modp + 2 * D + c) * bf4(yv[k][i]); }
    }
    float mu[NR], rs[NR];
#pragma unroll
    for (int k = 0; k < NR; ++k) mu[k] = wave_sum(hsum4(v[k])) * (1.f / D);
#pragma unroll
    for (int k = 0; k < NR; ++k) rs[k] = rsqrtf(wave_sum(hsq4(v[k], mu[k])) * (1.f / D) + EPS);
#pragma unroll
    for (int k = 0; k < NR; ++k)
#pragma unroll
      for (int i = 0; i < 4; ++i) {
        const int c = i * 256 + lane * 4;
        v[k][i] = (v[k][i] - mu[k]) * rs[k] * *(const f32x4*)(p.ln1_g + layer * D + c) + *(const f32x4*)(p.ln1_b + layer * D + c);
        if (ok[k]) *(f32x4*)(X + (size_t)rr[k] * D + c) = v[k][i];
      }
#pragma unroll
    for (int k = 0; k < NR; ++k) mu[k] = wave_sum(hsum4(v[k])) * (1.f / D);
#pragma unroll
    for (int k = 0; k < NR; ++k) rs[k] = rsqrtf(wave_sum(hsq4(v[k], mu[k])) * (1.f / D) + EPS);
#pragma unroll
    for (int k = 0; k < NR; ++k) {
      const float* modp = (const float*)(p.ws + OFF_MOD) + (layer * 2 + (rr[k] < NCTX ? 1 : 0)) * 6144;
#pragma unroll
      for (int i = 0; i < 4; ++i) {
        const int c = i * 256 + lane * 4;
        v[k][i] = (v[k][i] - mu[k]) * rs[k] * (*(const f32x4*)(modp + 4 * D + c) + 1.f) + *(const f32x4*)(modp + 3 * D + c);
        if (ok[k]) *(u32x2*)(H2 + (size_t)rr[k] * D + c) = (u32x2){cvtpk(v[k][i][0], v[k][i][1]), cvtpk(v[k][i][2], v[k][i][3])};
      }
    }
    f32x4 lg[NR];
#pragma unroll
    for (int k = 0; k < NR; ++k) lg[k] = (f32x4){0.f, 0.f, 0.f, 0.f};
#pragma unroll
    for (int i = 0; i < 4; ++i)
#pragma unroll
      for (int j = 0; j < 4; ++j) { const f32x4 w = *(const f32x4*)(p.w_rg + ((size_t)layer * D + i * 256 + lane * 4 + j) * 4);
#pragma unroll
        for (int k = 0; k < NR; ++k) lg[k] += w * v[k][i][j]; }
    int gsel[NR]; float pgrp[NR];
#pragma unroll
    for (int k = 0; k < NR; ++k) {
      float l0 = wave_sum(lg[k][0]) + p.b_rg[layer * 4 + 0], l1 = wave_sum(lg[k][1]) + p.b_rg[layer * 4 + 1];
      float l2 = wave_sum(lg[k][2]) + p.b_rg[layer * 4 + 2], l3 = wave_sum(lg[k][3]) + p.b_rg[layer * 4 + 3];
      int gs = 0; float gm = l0;
      if (l1 > gm) { gm = l1; gs = 1; }
      if (l2 > gm) { gm = l2; gs = 2; }
      if (l3 > gm) { gm = l3; gs = 3; }
      gsel[k] = gs; pgrp[k] = 1.f / (__expf(l0 - gm) + __expf(l1 - gm) + __expf(l2 - gm) + __expf(l3 - gm));
    }
#pragma unroll
    for (int k = 0; k < NR; ++k) {
      float le[8];
#pragma unroll
      for (int e = 0; e < 8; ++e) {
        const LAS float* wr = wre + (gsel[k] * 8 + e) * 1024 + lane * 4;
        float a = 0.f;
#pragma unroll
        for (int i = 0; i < 4; ++i) { const f32x4 w = *(const LAS f32x4*)(wr + i * 256); a += (w[0] * v[k][i][0] + w[1] * v[k][i][1]) + (w[2] * v[k][i][2] + w[3] * v[k][i][3]); }
        le[e] = a;
      }
#pragma unroll
      for (int e = 0; e < 8; ++e) le[e] = wave_sum(le[e]) + p.b_re[layer * 32 + gsel[k] * 8 + e];
      int i0 = 0; float v0 = le[0];
#pragma unroll
      for (int e = 1; e < 8; ++e) if (le[e] > v0) { v0 = le[e]; i0 = e; }
      int i1 = -1; float v1 = -3.0e38f;
#pragma unroll
      for (int e = 0; e < 8; ++e) if (e != i0 && le[e] > v1) { v1 = le[e]; i1 = e; }
      if (i1 < 0) { i1 = (i0 + 1) & 7; v1 = v0; }
      const float e1 = __expf(v1 - v0);
      if (lane == 0 && ok[k]) {
        const int r = rr[k], xa = gsel[k] * 8 + i0, xb = gsel[k] * 8 + i1;
        const int pa = __hip_atomic_fetch_add(&lcnt[xa], 1, __ATOMIC_RELAXED, __HIP_MEMORY_SCOPE_WORKGROUP);
        const int pb = __hip_atomic_fetch_add(&lcnt[xb], 1, __ATOMIC_RELAXED, __HIP_MEMORY_SCOPE_WORKGROUP);
        const int li = (r - rbeg) * 2;
        ent[li * 3 + 0] = xa; ent[li * 3 + 1] = pa; ent[li * 3 + 2] = r * 2 + 0;
        ent[li * 3 + 3] = xb; ent[li * 3 + 4] = pb; ent[li * 3 + 5] = r * 2 + 1;
        GATE[r * 2] = pgrp[k] / (1.f + e1); GATE[r * 2 + 1] = pgrp[k] * e1 / (1.f + e1);
      }
    }
  }
  __syncthreads();
  if (tid < 32) { const int c = lcnt[tid]; lbase[tid] = c > 0 ? atomicAdd(&cnt[tid * CNT_STRIDE], c) : 0; }
  __syncthreads();
  for (int i = tid; i < (rend - rbeg) * 2; i += 512) { const int e = ent[i * 3], lp = ent[i * 3 + 1]; LIST[(size_t)e * CAPL + lbase[e] + lp] = ent[i * 3 + 2]; }
  __syncthreads();
}

__device__ __forceinline__ void phase_final(const Params& p, int bid, int nblk) {
  const int wave = bid * 8 + (TIDX >> 6), lane = TIDX & 63, nw = nblk * 8;
  const float* X = (const float*)(p.ws + OFF_X);
  const bf16_t* OM = (const bf16_t*)(p.ws + OFF_OMOE);
  const float* g2 = (const float*)(p.ws + OFF_MOD) + (1 * 2 + 0) * 6144 + 5 * D;
  for (int rb = NCTX + wave * NRA; rb < TT; rb += nw * NRA) {
    f32x4 v[NRA][4]; u32x2 oa[NRA][4], ob[NRA][4];
#pragma unroll
    for (int k = 0; k < NRA; ++k)
#pragma unroll
      for (int i = 0; i < 4; ++i) { const int c = i * 256 + lane * 4, r = rb + k;
        v[k][i] = *(const f32x4*)(X + (size_t)r * D + c); oa[k][i] = *(const u32x2*)(OM + ((size_t)r * 2 + 0) * D + c); ob[k][i] = *(const u32x2*)(OM + ((size_t)r * 2 + 1) * D + c); }
#pragma unroll
    for (int k = 0; k < NRA; ++k) {
      const float ga = ((const float*)(p.ws + OFF_GATE))[(rb + k) * 2], gb = ((const float*)(p.ws + OFF_GATE))[(rb + k) * 2 + 1];
#pragma unroll
      for (int i = 0; i < 4; ++i) { const int c = i * 256 + lane * 4; v[k][i] = v[k][i] * ALPHA + *(const f32x4*)(g2 + c) * (bf4(oa[k][i]) * ga + bf4(ob[k][i]) * gb); }
    }
    float mu[NRA], rs[NRA];
#pragma unroll
    for (int k = 0; k < NRA; ++k) mu[k] = wave_sum(hsum4(v[k])) * (1.f / D);
#pragma unroll
    for (int k = 0; k < NRA; ++k) rs[k] = rsqrtf(wave_sum(hsq4(v[k], mu[k])) * (1.f / D) + EPS);
#pragma unroll
    for (int k = 0; k < NRA; ++k)
#pragma unroll
      for (int i = 0; i < 4; ++i) {
        const int c = i * 256 + lane * 4;
        *(f32x4*)(p.out + (size_t)(rb + k - NCTX) * D + c) = (v[k][i] - mu[k]) * rs[k] * *(const f32x4*)(p.ln2_g + D + c) + *(const f32x4*)(p.ln2_b + D + c);
      }
  }
}

__device__ __forceinline__ void phase_p0(const Params& p, LAS char* lds, int bid, int nblk) {
  const int tid = TIDX;
  const long gtid = (long)bid * 512 + tid, gth = (long)nblk * 512;
  LAS float* sc = (LAS float*)lds;
  LAS float* red = (LAS float*)(lds + 8192);
  for (int i = tid; i < 2048; i += 512) { const float v = i < 1024 ? p.c[i] : p.c_ctx[i - 1024]; sc[i] = silu(v); }
  __syncthreads();
  float* mod = (float*)(p.ws + OFF_MOD);
  for (int u = bid; u < 384; u += nblk) {
    const int layer = u / 192, cg = u % 192, col = tid & 31, ksl = tid >> 5;
    const float* w = p.w_mod + ((size_t)layer * D + ksl * 64) * 6144 + cg * 32 + col;
    float a0 = 0.f, a1 = 0.f;
#pragma unroll 8
    for (int k = 0; k < 64; ++k) { const float wv = w[(size_t)k * 6144]; a0 += sc[ksl * 64 + k] * wv; a1 += sc[1024 + ksl * 64 + k] * wv; }
    red[(ksl * 32 + col) * 2] = a0; red[(ksl * 32 + col) * 2 + 1] = a1;
    __syncthreads();
    if (tid < 64) {
      const int c2 = tid & 31, s = tid >> 5; float a = 0.f;
#pragma unroll
      for (int k = 0; k < 16; ++k) a += red[(k * 32 + c2) * 2 + s];
      mod[(layer * 2 + s) * 6144 + cg * 32 + c2] = a + p.b_mod[layer * 6144 + cg * 32 + c2];
    }
    __syncthreads();
  }
  if (gtid < 256 * 16) {
    const int pos = (int)gtid / 16, f = (int)gtid % 16;
    const float ang = (float)pos * powf(10000.f, -(float)f / 16.f);
    float* rt = (float*)(p.ws + OFF_ROPE);
    rt[gtid * 2 + 0] = cosf(ang); rt[gtid * 2 + 1] = sinf(ang);
  }
  if (gtid < 2 * NE * CNT_STRIDE) ((int*)(p.ws + OFF_CNT))[gtid] = 0;
  if (gtid == 0) {
    float bmax = 0.f;
    for (int l = 0; l < 2; ++l) {
      float gq = 0.f, gk = 0.f;
      for (int i = 0; i < 64; ++i) { gq = fmaxf(gq, fabsf(p.q_gain[l * 64 + i])); gk = fmaxf(gk, fabsf(p.k_gain[l * 64 + i])); }
      bmax = fmaxf(bmax, 11.55f * gq * gk);
    }
    ((int*)(p.ws + OFF_FLAG))[0] = bmax <= 13.2f ? 2 : (bmax <= 100.f ? 1 : 0);
    ((int*)(p.ws + OFF_FLAG))[1] = 0;
  }
  for (long i = gtid; i < 2 * 65536; i += gth) { const int l = (int)(i >> 16), d = (int)(i >> 8) & 255, c = (int)i & 255; ((bf16_t*)(p.ws + OFF_WPWT))[i] = f2bf(p.w_cv_pw[((size_t)l * 256 + c) * 256 + d]); }
  for (long i = gtid; i < 8 * 4096; i += gth) { const int lg = (int)(i >> 12), d = (int)(i >> 6) & 63, c = (int)i & 63; ((bf16_t*)(p.ws + OFF_WPOOLT))[i] = f2bf(p.w_pool[((size_t)lg * 64 + c) * 64 + d]); }
  cvt_range(p.w_in, (bf16_t*)(p.ws + OFF_WIN), 2L * D * INW / 8, gtid, gth);
  cvt_range(p.w_out, (bf16_t*)(p.ws + OFF_WOUT), 2L * D * D / 8, gtid, gth);
}
#define XB_TMO      128
#define XB_XCNT(j)  (256  + 64 * (j))
#define XB_XSUB(j)  (1280 + 64 * (j))
#define XB_XGEN(j)  (2304 + 64 * (j))
#define XB_TOP      3328
#define XB_TOPGEN   3392
#define XCD_BAR_WORDS 3456
#define XB_SPIN_CAP (1u << 22)
__device__ __forceinline__ unsigned xb_ld(unsigned* p)              { return __hip_atomic_load(p, __ATOMIC_RELAXED, __HIP_MEMORY_SCOPE_AGENT); }
__device__ __forceinline__ unsigned xb_add(unsigned* p, unsigned v) { return __hip_atomic_fetch_add(p, v, __ATOMIC_RELAXED, __HIP_MEMORY_SCOPE_AGENT); }
__device__ __forceinline__ unsigned xb_xcc_id() { return (unsigned)__builtin_amdgcn_s_getreg((3 << 11) | 20) & 0xFu; }
#define XB_SPIN(cond, bar) do { unsigned _sp = 0; while (cond) { __builtin_amdgcn_s_sleep(1); \
    if ((++_sp & 255u) == 0u) { if (xb_ld(&(bar)[XB_TMO])) break; if (_sp > XB_SPIN_CAP) { atomicAdd(&(bar)[XB_TMO], 1u); break; } } } } while (0)
struct XcdBarrier { unsigned* bar; unsigned x; volatile LAS unsigned* st; };
__device__ __forceinline__ XcdBarrier xcd_barrier_post(unsigned* bar, volatile LAS unsigned* st) {
  XcdBarrier b; b.bar = bar; b.x = xb_xcc_id(); b.st = st;
  if (threadIdx.x == 0) (void)xb_add(&bar[XB_XCNT(b.x)], 1u);
  return b;
}
__device__ __forceinline__ void xcd_barrier_complete(unsigned* bar, unsigned x, unsigned& nloc, unsigned& nx) {
  const unsigned G = gridDim.x * gridDim.y * gridDim.z;
  unsigned sum, cnt, mine, sp = 0u;
  for (;;) {
    sum = 0u; cnt = 0u; mine = 0u;
#pragma unroll
    for (unsigned j = 0; j < 16; ++j) { const unsigned c = xb_ld(&bar[XB_XCNT(j)]); sum += c; cnt += (c > 0u) ? 1u : 0u; mine = (j == x) ? c : mine; }
    if (sum == G) break;
    __builtin_amdgcn_s_sleep(1);
    if ((++sp & 255u) == 0u) { if (xb_ld(&bar[XB_TMO])) break; if (sp > XB_SPIN_CAP) { atomicAdd(&bar[XB_TMO], 1u); break; } }
  }
  nloc = mine > 0u ? mine : 1u; nx = cnt > 0u ? cnt : 1u;
}
__device__ __forceinline__ void xcd_barrier(const XcdBarrier& b) {
  asm volatile("s_waitcnt vmcnt(0)" ::: "memory");
  __syncthreads();
  if (threadIdx.x == 0) {
    unsigned* bar = b.bar; unsigned bx = b.x;
    asm volatile("" : "+s"(bar), "+s"(bx));
    __builtin_amdgcn_s_waitcnt(0);
    unsigned nloc = b.st[0], nx = b.st[1];
    if (nloc == 0u) { xcd_barrier_complete(bar, bx, nloc, nx); b.st[0] = nloc; b.st[1] = nx; }
    const unsigned old = xb_add(&bar[XB_XSUB(bx)], 1u);
    const unsigned gen = old / nloc;
    if (old + 1u == (gen + 1u) * nloc) {
      __builtin_amdgcn_fence(__ATOMIC_RELEASE, "agent");
      asm volatile("s_waitcnt vmcnt(0)" ::: "memory");
      const unsigned og = xb_add(&bar[XB_TOP], 1u);
      const unsigned tg = og / nx;
      if (og + 1u == (tg + 1u) * nx) xb_add(&bar[XB_TOPGEN], 1u);
      else XB_SPIN(xb_ld(&bar[XB_TOPGEN]) == tg, bar);
      __builtin_amdgcn_fence(__ATOMIC_ACQUIRE, "agent");
      xb_add(&bar[XB_XGEN(bx)], 1u);
      asm volatile("s_waitcnt vmcnt(0)" ::: "memory");
    } else {
      XB_SPIN(xb_ld(&bar[XB_XGEN(bx)]) == gen, bar);
      __builtin_amdgcn_fence(__ATOMIC_ACQUIRE, "agent");
      asm volatile("s_waitcnt vmcnt(0)" ::: "memory");
    }
  }
  __syncthreads();
}

constexpr int LDS_MAIN = PC_LDS > GEMM_LDS + 512 ? PC_LDS : GEMM_LDS + 512;
constexpr int LDS_TOTAL = LDS_MAIN + 16;
static_assert(GEMM_LDS + 512 <= LDS_MAIN && ATT_LDS <= LDS_MAIN, "lds");
__global__ void __launch_bounds__(512) mega_fwd(Params p) {
  __shared__ __attribute__((aligned(16))) char slds[LDS_TOTAL];
  LAS char* lds = (LAS char*)slds;
  volatile LAS unsigned* st = (volatile LAS unsigned*)(lds + LDS_MAIN);
  if (threadIdx.x < 4) st[threadIdx.x] = 0u;
  __syncthreads();
  const XcdBarrier bar = xcd_barrier_post((unsigned*)(p.ws + OFF_BAR), st);
  const int bid = blockIdx.x, nblk = gridDim.x;
  phase_p0(p, lds, bid, nblk);
  xcd_barrier(bar);
#pragma unroll 1
  for (int layer = 0; layer < 2; ++layer) {
    phase_a0(p, layer, bid, nblk);
    xcd_barrier(bar);
    phase_a1(p, layer, lds, bid, nblk);
    xcd_barrier(bar);
    phase_b(p, layer, lds, bid, nblk);
    xcd_barrier(bar);
    phase_c1(p, layer, lds, bid, nblk);
    xcd_barrier(bar);
    phase_c2(p, layer, lds, bid, nblk);
    xcd_barrier(bar);
    phase_d1(p, layer, lds, bid, nblk);
    xcd_barrier(bar);
    phase_d2(p, layer, lds, bid, nblk);
    xcd_barrier(bar);
  }
  phase_final(p, bid, nblk);
}

extern "C" void kernel_launch(void* const* d_in, const int* in_sizes, int n_in, void* d_out, int out_size, void* d_ws, size_t ws_size,
                              hipStream_t stream) {
  static int grid = 0;
  if (grid == 0) {
    if (ws_size < WS_END || n_in != 28) { fprintf(stderr, "kernel_launch: ws too small (%zu < %zu) or n_in %d != 28; nothing launched\n", ws_size, (size_t)WS_END, n_in); grid = -1; return; }
    int dev = 0, cus = 0, per_cu = 0;
    if (hipGetDevice(&dev) != hipSuccess || hipDeviceGetAttribute(&cus, hipDeviceAttributeMultiprocessorCount, dev) != hipSuccess) { grid = -1; return; }
    if (hipOccupancyMaxActiveBlocksPerMultiprocessor(&per_cu, (const void*)mega_fwd, 512, 0) != hipSuccess || per_cu < 1) {
      fprintf(stderr, "kernel_launch: occupancy query says %d blocks per CU; nothing launched\n", per_cu); grid = -1; return; }
    (void)hipGetLastError();
    grid = cus;
  }
  if (grid < 0) return;
  if (hipMemsetAsync((char*)d_ws + OFF_BAR, 0, BAR_BYTES, stream) != hipSuccess) { fprintf(stderr, "kernel_launch: memset failed\n"); return; }
  Params p{};
  const float** f = (const float**)&p;
  for (int i = 0; i < 28; ++i) f[i] = (const float*)d_in[i];
  p.out = (float*)d_out; p.ws = (char*)d_ws;
  hipLaunchKernelGGL(mega_fwd, dim3(grid), dim3(512), 0, stream, p);
}
```

```cpp
#include <hip/hip_runtime.h>
#include <cstdio>
#include <cstdint>

typedef unsigned short bf16_t;
#define LAS __attribute__((address_space(3)))

constexpr int D = 1024, SEQ = 16384, NCTX = 256, TT = SEQ + NCTX;
constexpr int INW = 1536;
constexpr int NE = 32, DE = 512;
constexpr int CAPL = 2 * TT;
constexpr int HMID_ROWS = 2 * TT + NE * 128;
constexpr float ALPHA = 1.41421356237309515f;
constexpr float EPS = 1e-6f;

constexpr size_t al(size_t x) { return (x + 255) / 256 * 256; }
constexpr size_t OFF_BAR = 0;
constexpr size_t BAR_BYTES = 3456 * 4;
constexpr size_t OFF_MOD = OFF_BAR + al(BAR_BYTES);
constexpr size_t OFF_ROPE = OFF_MOD + al(2 * 2 * 6144 * 4);
constexpr int CNT_STRIDE = 32;
constexpr size_t OFF_CNT = OFF_ROPE + al(256 * 16 * 2 * 4);
constexpr size_t OFF_FLAG = OFF_CNT + al(2 * 32 * 32 * 4);
constexpr size_t OFF_X = OFF_FLAG + 256;
constexpr size_t OFF_H = OFF_X + al((size_t)TT * D * 4);
constexpr size_t OFF_MIX = OFF_H + al((size_t)TT * D * 2);
constexpr size_t OFF_Y = OFF_MIX + al((size_t)TT * D * 2);
constexpr size_t OFF_Q = OFF_Y + al((size_t)TT * D * 2);
constexpr size_t OFF_K = OFF_Q + al((size_t)TT * 512 * 2);
constexpr size_t OFF_V = OFF_K + al((size_t)TT * 128 * 2);
constexpr size_t OFF_U = OFF_V + al((size_t)TT * 128 * 2);
constexpr size_t OFF_AG = OFF_U + al((size_t)TT * 256 * 4);
constexpr size_t OFF_HMID = OFF_Q;
constexpr size_t OFF_OMOE = OFF_AG + al((size_t)TT * 512 * 2);
constexpr size_t OFF_GATE = OFF_OMOE + al((size_t)TT * 2 * D * 2);
constexpr size_t OFF_LIST = OFF_GATE + al((size_t)TT * 2 * 4);
constexpr size_t OFF_WIN = OFF_LIST + al((size_t)NE * CAPL * 4);
constexpr size_t OFF_WOUT = OFF_WIN + al((size_t)2 * D * INW * 2);
constexpr size_t OFF_WPWT = OFF_WOUT + al((size_t)2 * D * D * 2);
constexpr size_t OFF_WPOOLT = OFF_WPWT + al((size_t)2 * 256 * 256 * 2);
constexpr size_t OFF_Q8 = OFF_WPOOLT + al((size_t)2 * 4 * 64 * 64 * 2);
constexpr size_t OFF_K8 = OFF_Q8 + al((size_t)TT * 512);
constexpr size_t OFF_VT8 = OFF_K8 + al((size_t)TT * 128);
constexpr size_t OFF_WG = OFF_VT8 + al((size_t)128 * TT);
constexpr size_t OFF_WU = OFF_WG + al((size_t)2 * NE * D * DE * 2);
constexpr size_t OFF_WD = OFF_WU + al((size_t)2 * NE * D * DE * 2);
constexpr size_t WS_END = OFF_WD + al((size_t)2 * NE * D * DE * 2);
static_assert(OFF_AG - OFF_HMID >= (size_t)HMID_ROWS * DE * 2, "HMID alias too small");
static_assert(WS_END < 530000000, "ws budget");

struct Params {
  const float *x, *c, *ctx, *c_ctx, *w_mod, *b_mod, *w_in, *q_gain, *k_gain, *w_pool, *pool_scale, *w_dw, *b_dw,
      *cv_ln_g, *cv_ln_b, *w_cv_pw, *w_out, *ln1_g, *ln1_b, *ln2_g, *ln2_b, *w_rg, *b_rg, *w_re, *b_re, *w_e_gate, *w_e_up, *w_e_down;
  float* out;
  char* ws;
};

__device__ __forceinline__ float bf2f(bf16_t v) { return __uint_as_float(((unsigned)v) << 16); }
__device__ __forceinline__ bf16_t f2bf(float f) {
  unsigned u = __float_as_uint(f);
  u += 0x7fffu + ((u >> 16) & 1u);
  return (bf16_t)(u >> 16);
}
template <int CTRL> __device__ __forceinline__ float dppf(float v) { return __int_as_float(__builtin_amdgcn_update_dpp(0, __float_as_int(v), CTRL, 0xf, 0xf, true)); }
__device__ __forceinline__ float wave_sum(float v) {
  v += dppf<0xB1>(v); v += dppf<0x4E>(v); v += dppf<0x141>(v); v += dppf<0x140>(v);
  { auto r = __builtin_amdgcn_permlane16_swap(__float_as_uint(v), __float_as_uint(v), false, false); v = __uint_as_float(r[0]) + __uint_as_float(r[1]); }
  { auto r = __builtin_amdgcn_permlane32_swap(__float_as_uint(v), __float_as_uint(v), false, false); v = __uint_as_float(r[0]) + __uint_as_float(r[1]); }
  return v;
}
__device__ __forceinline__ float silu(float v) { return v / (1.f + __expf(-v)); }
__device__ __forceinline__ int opaque0() { int z; asm volatile("s_mov_b32 %0, 0" : "=s"(z)); return z; }
#define TIDX ((int)threadIdx.x + opaque0())
using bf16x8 = __attribute__((ext_vector_type(8))) short;
using s16x4 = __attribute__((ext_vector_type(4))) short;
using f32x16 = __attribute__((ext_vector_type(16))) float;
using f32x4 = __attribute__((ext_vector_type(4))) float;
using u32x4 = __attribute__((ext_vector_type(4))) unsigned;
using u32x2 = __attribute__((ext_vector_type(2))) unsigned;

__device__ __forceinline__ int crow(int r, int hi) { return (r & 3) + 8 * (r >> 2) + 4 * hi; }
typedef float f32x2 __attribute__((ext_vector_type(2)));
typedef __bf16 bf16x2v __attribute__((ext_vector_type(2)));
__device__ __forceinline__ unsigned cvtpk(float lo, float hi) {
  bf16x2v b = __builtin_convertvector((f32x2){lo, hi}, bf16x2v);
  return __builtin_bit_cast(unsigned, b);
}
__device__ __forceinline__ float sum32(float v) {
  auto rr = __builtin_amdgcn_permlane32_swap(__float_as_uint(v), __float_as_uint(v), false, false);
  return __uint_as_float(rr[0]) + __uint_as_float(rr[1]);
}

__device__ __forceinline__ void cvt_range(const float* __restrict__ src, bf16_t* __restrict__ dst, long n8, long gtid, long gthreads) {
  for (long i = gtid; i < n8; i += gthreads) {
    const f32x4 a = *(const f32x4*)(src + i * 8), b = *(const f32x4*)(src + i * 8 + 4);
    u32x4 w = {cvtpk(a[0], a[1]), cvtpk(a[2], a[3]), cvtpk(b[0], b[1]), cvtpk(b[2], b[3])};
    *(u32x4*)(dst + i * 8) = w;
  }
}

__device__ __forceinline__ int xoff(int row, int chunk) { return row * 128 + ((chunk ^ ((row >> 1) & 7)) << 4); }
__device__ __forceinline__ int wst(int k, int c) { const int kk = (k & ~0xC) | ((k & 4) << 1) | ((k & 8) >> 1); return ((kk >> 3) * 4 + (c >> 5)) * 512 + ((kk & 7) * 32 + (c & 31)) * 2; }
__device__ __forceinline__ int v_rd_base(int lane) { return ((lane & 3) << 3) | (((lane >> 2) & 3) << 6) | (((lane >> 4) & 1) << 5) | (((lane >> 5) & 1) << 8); }

__device__ __forceinline__ bf16x8 tr_frag(const LAS char* p) {
  s16x4 a = __builtin_amdgcn_ds_read_tr16_b64_v4i16((LAS s16x4*)p);
  s16x4 b = __builtin_amdgcn_ds_read_tr16_b64_v4i16((LAS s16x4*)(p + 2048));
  return (bf16x8){a[0], a[1], a[2], a[3], b[0], b[1], b[2], b[3]};
}

template <int OFF> __device__ __forceinline__ bf16x8 tr_frag_asm(int addr) {
  s16x4 a, b;
  asm volatile("ds_read_b64_tr_b16 %0, %1 offset:%2" : "=&v"(a) : "v"(addr), "i"(OFF) : "memory");
  asm volatile("ds_read_b64_tr_b16 %0, %1 offset:%2" : "=&v"(b) : "v"(addr), "i"(OFF + 2048) : "memory");
  return (bf16x8){a[0], a[1], a[2], a[3], b[0], b[1], b[2], b[3]};
}

template <int BM, int BN> struct GemmCfg {
  static constexpr int WM = BM / 64, WN = 8 / WM, NSLAB = BN / 128, XB = BM * 128, WB = NSLAB * 16384, STAGE = XB + WB, NXP = BM / 64, NWP = NSLAB * 2;
  static_assert(WM * WN == 8 && WN * 64 == BN, "tile");
};
constexpr int GEMM_LDS = 3 * (256 * 128 + 16384);

template <int BM, int BN, int NMAP, bool BG = false, class XRow, class WPtr, class Pre>
__device__ __forceinline__ void gemm_mainloop(LAS char* lds, f32x16 (&acc)[2][2], const XRow& xrow, const WPtr& wptr, const Pre& pre, int sprev, int ldw, int K, int& bgdone, int bgn = 0, long bgc0 = 0,
                                              const float* bs0 = nullptr, const float* bs1 = nullptr, const float* bs2 = nullptr, bf16_t* bd0 = nullptr, bf16_t* bd1 = nullptr, bf16_t* bd2 = nullptr) {
#define BG_ADDR(i, off, SP, DP) long c_ = bgc0 + (long)(i) * 512 + (off); const bool ok_ = c_ < (3L << 21); if (!ok_) c_ = 0; const int t_ = (int)(c_ >> 21); const long o_ = (c_ & 0x1fffff) * 8; \
    const float* SP = (t_ == 0 ? bs0 : (t_ == 1 ? bs1 : bs2)) + o_; bf16_t* DP = (t_ == 0 ? bd0 : (t_ == 1 ? bd1 : bd2)) + o_
#define BG_ISSUE(i, off, a, b) do { BG_ADDR(i, off, sp_, dp_); (void)dp_; a = *(const f32x4*)sp_; b = *(const f32x4*)(sp_ + 4); } while (0)
#define BG_RETIRE(i, off, a, b) do { BG_ADDR(i, off, sp_, dp_); (void)sp_; if (ok_) *(u32x4*)dp_ = (u32x4){cvtpk(a[0], a[1]), cvtpk(a[2], a[3]), cvtpk(b[0], b[1]), cvtpk(b[2], b[3])}; } while (0)
#define BGA_ISSUE(i, off, a, b) do { BG_ADDR(i, off, sp_, dp_); (void)dp_; \
    asm volatile("global_load_dwordx4 %0, %2, off\n\tglobal_load_dwordx4 %1, %2, off offset:16" : "=&v"(a), "=&v"(b) : "v"(sp_) : "memory"); } while (0)
#define BGA_RETIRE(i, off, a, b) do { BG_ADDR(i, off, sp_, dp_); (void)sp_; const u32x4 w_ = {cvtpk(a[0], a[1]), cvtpk(a[2], a[3]), cvtpk(b[0], b[1]), cvtpk(b[2], b[3])}; \
    if (ok_) asm volatile("global_store_dwordx4 %0, %1, off" :: "v"(dp_), "v"(w_) : "memory"); } while (0)
  using C = GemmCfg<BM, BN>;
  const int tid = TIDX, wid = __builtin_amdgcn_readfirstlane(tid >> 6), lane = tid & 63, r32 = lane & 31, hi = lane >> 5;
  const int wm = wid / C::WN, wn = wid % C::WN;
  const bf16_t *g0, *g1, *g2, *g3, *g4, *g5, *g6 = nullptr, *g7 = nullptr, *g8 = nullptr, *g9 = nullptr, *g10 = nullptr, *g11 = nullptr;
  int l0, l1, l2, l3, l4, l5, l6 = 0, l7 = 0, l8 = 0, l9 = 0, l10 = 0, l11 = 0;
  auto xpieceq = [&](int q, const bf16_t*& gp, int& lp) { const int row = 8 * q + (lane >> 3), c = (lane & 7) ^ ((row >> 1) & 7); gp = xrow(row) + c * 8; lp = q * 1024; };
  auto wpieceq = [&](int idx, const bf16_t*& gp, int& lp) {
    const int s = idx >> 4, q = idx & 15, sub = 2 * q + (lane >> 5), kk = (sub >> 2) * 8 + ((lane & 31) >> 2);
    const int k = (kk & ~0xC) | ((kk & 4) << 1) | ((kk & 8) >> 1), c = (sub & 3) * 32 + (lane & 3) * 8;
    gp = wptr(s) + (size_t)k * ldw + c; lp = C::XB + s * 16384 + q * 1024; };
  const size_t stepx = 64, stepw = (size_t)64 * ldw;
  if (BG) {
    const int w4 = wid & 3;
    xpieceq(w4 * 8 + 0, g0, l0); xpieceq(w4 * 8 + 1, g1, l1); xpieceq(w4 * 8 + 2, g2, l2); xpieceq(w4 * 8 + 3, g3, l3);
    xpieceq(w4 * 8 + 4, g4, l4); xpieceq(w4 * 8 + 5, g5, l5); xpieceq(w4 * 8 + 6, g6, l6); xpieceq(w4 * 8 + 7, g7, l7);
    wpieceq(w4 * 4 + 0, g8, l8); wpieceq(w4 * 4 + 1, g9, l9); wpieceq(w4 * 4 + 2, g10, l10); wpieceq(w4 * 4 + 3, g11, l11);
  } else if (C::NXP == 4) { xpieceq(wid * 4 + 0, g0, l0); xpieceq(wid * 4 + 1, g1, l1); xpieceq(wid * 4 + 2, g2, l2); xpieceq(wid * 4 + 3, g3, l3); wpieceq(wid * 2 + 0, g4, l4); wpieceq(wid * 2 + 1, g5, l5); }
  else { xpieceq(wid * 2 + 0, g0, l0); xpieceq(wid * 2 + 1, g1, l1); wpieceq(wid * 4 + 0, g2, l2); wpieceq(wid * 4 + 1, g3, l3); wpieceq(wid * 4 + 2, g4, l4); wpieceq(wid * 4 + 3, g5, l5); }
  const size_t stp0 = stepx, stp1 = stepx, stp2 = (BG || C::NXP == 4) ? stepx : stepw, stp3 = (BG || C::NXP == 4) ? stepx : stepw, stp4 = BG ? stepx : stepw, stp5 = BG ? stepx : stepw;
  const bool dmaw = !BG || wid < 4;
  int xr[2];
#pragma unroll
  for (int ti = 0; ti < 2; ++ti) xr[ti] = (wm * 64 + ti * 32 + r32) * 128;
  const int xsw = (r32 >> 1) & 7;
  int wr[2];
#pragma unroll
  for (int ni = 0; ni < 2; ++ni) {
    const int slab = NMAP == 0 ? 0 : (NMAP == 1 ? (wn >> 1) : ni);
    const int nb = NMAP == 0 ? (2 * wn + ni) : (NMAP == 1 ? ((wn & 1) * 2 + ni) : wn);
    wr[ni] = C::XB + slab * 16384 + nb * 512 + v_rd_base(lane);
  }
  const int nk = K / 64;
#define G_DMA1(gp, sp, lp, kt, _d) __builtin_amdgcn_global_load_lds((const unsigned*)((gp) + (size_t)(kt) * (sp)), (LAS unsigned*)((_d) + (lp)), 16, 0, 0)
#define G_DMA(kt, st) do { if (dmaw) { LAS char* _d = lds + (st) * C::STAGE; \
    G_DMA1(g0, stp0, l0, kt, _d); G_DMA1(g1, stp1, l1, kt, _d); G_DMA1(g2, stp2, l2, kt, _d); G_DMA1(g3, stp3, l3, kt, _d); G_DMA1(g4, stp4, l4, kt, _d); G_DMA1(g5, stp5, l5, kt, _d); \
    if (BG) { G_DMA1(g6, stepx, l6, kt, _d); G_DMA1(g7, stepx, l7, kt, _d); G_DMA1(g8, stepw, l8, kt, _d); G_DMA1(g9, stepw, l9, kt, _d); G_DMA1(g10, stepw, l10, kt, _d); G_DMA1(g11, stepw, l11, kt, _d); } } } while (0)
#define G_HALF(cur, wa0, wa1, H) do { bf16x8 xf[2][2], wf[2][2]; \
      _Pragma("unroll") for (int k2 = 0; k2 < 2; ++k2) _Pragma("unroll") for (int ti = 0; ti < 2; ++ti) xf[k2][ti] = *(const LAS bf16x8*)(cur + xr[ti] + ((((H * 2 + k2) * 2 + hi) ^ xsw) << 4)); \
      wf[0][0] = tr_frag_asm<(H * 2 + 0) * 4096>(wa0); wf[0][1] = tr_frag_asm<(H * 2 + 0) * 4096>(wa1); \
      wf[1][0] = tr_frag_asm<(H * 2 + 1) * 4096>(wa0); wf[1][1] = tr_frag_asm<(H * 2 + 1) * 4096>(wa1); \
      asm volatile("s_waitcnt lgkmcnt(0)" ::: "memory"); __builtin_amdgcn_sched_barrier(0); \
      _Pragma("unroll") for (int k2 = 0; k2 < 2; ++k2) _Pragma("unroll") for (int ti = 0; ti < 2; ++ti) _Pragma("unroll") for (int ni = 0; ni < 2; ++ni) \
        acc[ti][ni] = __builtin_amdgcn_mfma_f32_32x32x16_bf16(wf[k2][ni], xf[k2][ti], acc[ti][ni], 0, 0, 0); } while (0)
#define G_COMPUTE(st) do { const LAS char* cur = lds + (st) * C::STAGE; const int wa0 = (int)(uintptr_t)(cur + wr[0]), wa1 = (int)(uintptr_t)(cur + wr[1]); \
    G_HALF(cur, wa0, wa1, 0); G_HALF(cur, wa0, wa1, 1); } while (0)
  static_assert(C::NXP + C::NWP == 6 && (!BG || (C::NXP == 4 && C::NWP == 2)), "piece counts assumed by the vmcnt waits");
  G_DMA(0, 0); G_DMA(1, 1);
  pre();
#pragma unroll
  for (int a_ = 0; a_ < 2; ++a_)
#pragma unroll
    for (int b_ = 0; b_ < 2; ++b_) acc[a_][b_] = (f32x16){};
  f32x4 b0a, b0b, b0c, b0d, b1a, b1b, b1c, b1d, b2a, b2b, b2c, b2d; int bi0 = -1, bi1 = -1, bi2 = -1;
  const int bgoff = tid - 256;
#define BG_SLOT(bi, xa, xb, xc, xd) do { if (bi >= 0) { asm volatile("s_waitcnt vmcnt(8)" ::: "memory");     \
      BGA_RETIRE(bi, bgoff, xa, xb); BGA_RETIRE(bi, bgoff + 256, xc, xd); bi = -1; } \
    if (bgdone < bgn) { bi = bgdone; BGA_ISSUE(bi, bgoff, xa, xb); BGA_ISSUE(bi, bgoff + 256, xc, xd); } } while (0)
#define G_STEP(kt, ST, bi, xa, xb, xc, xd) do { \
    if (dmaw) { if ((kt) + 1 < nk) { if (BG) asm volatile("s_waitcnt vmcnt(12)" ::: "memory"); \
                                     else if ((kt) < 2 && sprev >= 16) asm volatile("s_waitcnt vmcnt(22)" ::: "memory"); \
                                     else if ((kt) < 2 && sprev >= 8) asm volatile("s_waitcnt vmcnt(14)" ::: "memory"); \
                                     else asm volatile("s_waitcnt vmcnt(6)" ::: "memory"); } \
                else asm volatile("s_waitcnt vmcnt(0)" ::: "memory"); } \
    asm volatile("s_waitcnt lgkmcnt(0)" ::: "memory"); __builtin_amdgcn_s_barrier(); \
    if ((kt) + 2 < nk) G_DMA((kt) + 2, ((ST) + 2) % 3); \
    if (BG && !dmaw) BG_SLOT(bi, xa, xb, xc, xd); \
    if (BG && bgdone < bgn) ++bgdone; \
    G_COMPUTE(ST); } while (0)
  for (int kt = 0; kt < nk; kt += 3) {
    G_STEP(kt, 0, bi0, b0a, b0b, b0c, b0d);
    if (kt + 1 < nk) G_STEP(kt + 1, 1, bi1, b1a, b1b, b1c, b1d);
    if (kt + 2 < nk) G_STEP(kt + 2, 2, bi2, b2a, b2b, b2c, b2d);
  }
  if (BG && !dmaw) {
    asm volatile("s_waitcnt vmcnt(0)" ::: "memory");
    if (bi0 >= 0) { BGA_RETIRE(bi0, bgoff, b0a, b0b); BGA_RETIRE(bi0, bgoff + 256, b0c, b0d); }
    if (bi1 >= 0) { BGA_RETIRE(bi1, bgoff, b1a, b1b); BGA_RETIRE(bi1, bgoff + 256, b1c, b1d); }
    if (bi2 >= 0) { BGA_RETIRE(bi2, bgoff, b2a, b2b); BGA_RETIRE(bi2, bgoff + 256, b2c, b2d); }
    asm volatile("s_waitcnt vmcnt(0)" ::: "memory");
  }
#undef G_STEP
#undef BG_SLOT
  asm volatile("s_waitcnt lgkmcnt(0)" ::: "memory"); __builtin_amdgcn_s_barrier();
#undef G_DMA
#undef G_DMA1
#undef G_COMPUTE
#undef G_HALF
}


struct UnitD { int a, b, c, d, lv0, lv1; };
template <int BM, int BN, int NMAP, bool BG = false, class Dec, class XRow, class WPtr, class Epi>
__device__ __forceinline__ void gemm_stream(LAS char* lds, const char* wsb, int ldw, int K, const Dec& dec, const XRow& xrow, const WPtr& wptr, const Epi& epi,
                                            int* bgdone_p = nullptr, int bgn = 0, long bgc0 = 0, const float* bs0 = nullptr, const float* bs1 = nullptr, const float* bs2 = nullptr,
                                            bf16_t* bd0 = nullptr, bf16_t* bd1 = nullptr, bf16_t* bd2 = nullptr) {
  using C = GemmCfg<BM, BN>;
  const int tid = TIDX, wid = __builtin_amdgcn_readfirstlane(tid >> 6), lane = tid & 63, r32 = lane & 31, hi = lane >> 5;
  const int wm = wid / C::WN, wn = wid % C::WN;
  static_assert(C::NXP + C::NWP == 6 && (!BG || (C::NXP == 4 && C::NWP == 2)), "piece counts assumed by the vmcnt waits");
  auto xptr = [&](const UnitD& u, int q) { const int row = 8 * q + (lane >> 3), c = (lane & 7) ^ ((row >> 1) & 7); return (unsigned)(xrow(u, row) + c * 16); };
  auto wptr2 = [&](const UnitD& u, int idx) {
    const int s = idx >> 4, q = idx & 15, sub = 2 * q + (lane >> 5), kk = (sub >> 2) * 8 + ((lane & 31) >> 2);
    const int k = (kk & ~0xC) | ((kk & 4) << 1) | ((kk & 8) >> 1), c = (sub & 3) * 32 + (lane & 3) * 8;
    return (unsigned)(wptr(u, s) + (unsigned)(k * ldw + c) * 2u); };
  auto wlds = [&](int idx) { return C::XB + (idx >> 4) * 16384 + (idx & 15) * 1024; };
  const int w4 = wid & 3;
  const bool dmaw = !BG || wid < 4;
  const int l0 = BG ? (w4 * 8 + 0) * 1024 : (wid * C::NXP + 0) * 1024, l1 = BG ? (w4 * 8 + 1) * 1024 : (wid * C::NXP + 1) * 1024;
  const int l2 = BG ? (w4 * 8 + 2) * 1024 : (C::NXP == 4 ? (wid * 4 + 2) * 1024 : wlds(wid * 4 + 0)), l3 = BG ? (w4 * 8 + 3) * 1024 : (C::NXP == 4 ? (wid * 4 + 3) * 1024 : wlds(wid * 4 + 1));
  const int l4 = BG ? (w4 * 8 + 4) * 1024 : (C::NXP == 4 ? wlds(wid * 2 + 0) : wlds(wid * 4 + 2)), l5 = BG ? (w4 * 8 + 5) * 1024 : (C::NXP == 4 ? wlds(wid * 2 + 1) : wlds(wid * 4 + 3));
  const int l6 = (w4 * 8 + 6) * 1024, l7 = (w4 * 8 + 7) * 1024, l8 = wlds(w4 * 4 + 0), l9 = wlds(w4 * 4 + 1), l10 = wlds(w4 * 4 + 2), l11 = wlds(w4 * 4 + 3);
  const unsigned stepx = 128, stepw = 128u * (unsigned)ldw;
  const unsigned stp0 = stepx, stp1 = stepx, stp2 = (BG || C::NXP == 4) ? stepx : stepw, stp3 = (BG || C::NXP == 4) ? stepx : stepw, stp4 = BG ? stepx : stepw, stp5 = BG ? stepx : stepw;
#define S_SETUP(u, P) do { \
    if (BG) { if (dmaw) { P##0 = xptr(u, w4 * 8 + 0); P##1 = xptr(u, w4 * 8 + 1); P##2 = xptr(u, w4 * 8 + 2); P##3 = xptr(u, w4 * 8 + 3); P##4 = xptr(u, w4 * 8 + 4); P##5 = xptr(u, w4 * 8 + 5); \
                          P##6 = xptr(u, w4 * 8 + 6); P##7 = xptr(u, w4 * 8 + 7); P##8 = wptr2(u, w4 * 4 + 0); P##9 = wptr2(u, w4 * 4 + 1); P##10 = wptr2(u, w4 * 4 + 2); P##11 = wptr2(u, w4 * 4 + 3); } } \
    else { P##0 = xptr(u, wid * C::NXP + 0); P##1 = xptr(u, wid * C::NXP + 1); \
      if (C::NXP == 4) { P##2 = xptr(u, wid * 4 + 2); P##3 = xptr(u, wid * 4 + 3); P##4 = wptr2(u, wid * 2 + 0); P##5 = wptr2(u, wid * 2 + 1); } \
      else { P##2 = wptr2(u, wid * 4 + 0); P##3 = wptr2(u, wid * 4 + 1); P##4 = wptr2(u, wid * 4 + 2); P##5 = wptr2(u, wid * 4 + 3); } } } while (0)
#define S_DMA1(gp, sp, lp, kt, _d) __builtin_amdgcn_global_load_lds((const unsigned*)(wsb + (size_t)((gp) + (unsigned)(kt) * (sp))), (LAS unsigned*)((_d) + (lp)), 16, 0, 0)
#define S_DMA(P, kt, stg) do { if (dmaw) { LAS char* _d = lds + (stg) * C::STAGE; S_DMA1(P##0, stp0, l0, kt, _d); S_DMA1(P##1, stp1, l1, kt, _d); S_DMA1(P##2, stp2, l2, kt, _d); \
    S_DMA1(P##3, stp3, l3, kt, _d); S_DMA1(P##4, stp4, l4, kt, _d); S_DMA1(P##5, stp5, l5, kt, _d); \
    if (BG) { S_DMA1(P##6, stepx, l6, kt, _d); S_DMA1(P##7, stepx, l7, kt, _d); S_DMA1(P##8, stepw, l8, kt, _d); S_DMA1(P##9, stepw, l9, kt, _d); S_DMA1(P##10, stepw, l10, kt, _d); \
              S_DMA1(P##11, stepw, l11, kt, _d); } } } while (0)
  int xr[2];
#pragma unroll
  for (int ti = 0; ti < 2; ++ti) xr[ti] = (wm * 64 + ti * 32 + r32) * 128;
  const int xsw = (r32 >> 1) & 7;
  int wr[2];
#pragma unroll
  for (int ni = 0; ni < 2; ++ni) {
    const int slab = NMAP == 0 ? 0 : (NMAP == 1 ? (wn >> 1) : ni);
    const int nb = NMAP == 0 ? (2 * wn + ni) : (NMAP == 1 ? ((wn & 1) * 2 + ni) : wn);
    wr[ni] = C::XB + slab * 16384 + nb * 512 + v_rd_base(lane);
  }
  const int nk = K / 64;
#define S_HALF(cur, wa0, wa1, H) do { bf16x8 xf[2][2], wf[2][2]; \
      _Pragma("unroll") for (int k2 = 0; k2 < 2; ++k2) _Pragma("unroll") for (int ti = 0; ti < 2; ++ti) xf[k2][ti] = *(const LAS bf16x8*)(cur + xr[ti] + ((((H * 2 + k2) * 2 + hi) ^ xsw) << 4)); \
      wf[0][0] = tr_frag_asm<(H * 2 + 0) * 4096>(wa0); wf[0][1] = tr_frag_asm<(H * 2 + 0) * 4096>(wa1); \
      wf[1][0] = tr_frag_asm<(H * 2 + 1) * 4096>(wa0); wf[1][1] = tr_frag_asm<(H * 2 + 1) * 4096>(wa1); \
      asm volatile("s_waitcnt lgkmcnt(0)" ::: "memory"); __builtin_amdgcn_sched_barrier(0); \
      _Pragma("unroll") for (int k2 = 0; k2 < 2; ++k2) _Pragma("unroll") for (int ti = 0; ti < 2; ++ti) _Pragma("unroll") for (int ni = 0; ni < 2; ++ni) \
        acc[ti][ni] = __builtin_amdgcn_mfma_f32_32x32x16_bf16(wf[k2][ni], xf[k2][ti], acc[ti][ni], 0, 0, 0); } while (0)
  UnitD cu, nu;
  if (!dec(0, cu)) return;
  asm volatile("s_waitcnt vmcnt(0)" : "+v"(cu.lv0), "+v"(cu.lv1) :: "memory");
  unsigned g0 = 0, g1 = 0, g2 = 0, g3 = 0, g4 = 0, g5 = 0, g6 = 0, g7 = 0, g8 = 0, g9 = 0, g10 = 0, g11 = 0;
  S_SETUP(cu, g);
  int st = 0;
  S_DMA(g, 0, 0); S_DMA(g, 1, 1);
  int sprev = 0;
  f32x16 acc[2][2];
  f32x4 b0a, b0b, b0c, b0d, b1a, b1b, b1c, b1d, b2a, b2b, b2c, b2d; int bi0 = -1, bi1 = -1, bi2 = -1, j3 = 0;
  int bgdone = BG ? *bgdone_p : 0;
  const int bgoff = tid - 256;
#define S_BGSLOT(bi, xa, xb, xc, xd) do { if (bi >= 0) { \
      if (kt < 3 && sprev >= 16) asm volatile("s_waitcnt vmcnt(24)" ::: "memory");     \
      else asm volatile("s_waitcnt vmcnt(8)" ::: "memory"); \
      BGA_RETIRE(bi, bgoff, xa, xb); BGA_RETIRE(bi, bgoff + 256, xc, xd); bi = -1; } \
    if (bgdone < bgn) { bi = bgdone; BGA_ISSUE(bi, bgoff, xa, xb); BGA_ISSUE(bi, bgoff + 256, xc, xd); } } while (0)
  for (int it = 0;; ++it) {
    const bool okn = dec(it + 1, nu);
#pragma unroll
    for (int a_ = 0; a_ < 2; ++a_)
#pragma unroll
      for (int b_ = 0; b_ < 2; ++b_) acc[a_][b_] = (f32x16){};
    for (int kt = 0; kt < nk; ++kt) {
      if (dmaw) {
        if (kt + 1 < nk || okn) {
          const int extra = kt < 2 ? sprev : 0;
          if (BG) { if (extra >= 16) asm volatile("s_waitcnt vmcnt(28)" ::: "memory"); else asm volatile("s_waitcnt vmcnt(12)" ::: "memory"); }
          else if (extra >= 16) asm volatile("s_waitcnt vmcnt(22)" ::: "memory");
          else if (extra >= 8) asm volatile("s_waitcnt vmcnt(14)" ::: "memory");
          else asm volatile("s_waitcnt vmcnt(6)" ::: "memory");
        } else asm volatile("s_waitcnt vmcnt(0)" ::: "memory");
      }
      asm volatile("s_waitcnt lgkmcnt(0)" ::: "memory"); __builtin_amdgcn_s_barrier();
      const int st2 = st == 0 ? 2 : st - 1;
      if (kt + 2 < nk) S_DMA(g, kt + 2, st2);
      else if (okn) {
        if (kt + 2 == nk) { asm volatile("" : "+v"(nu.lv0), "+v"(nu.lv1) :: "memory"); S_SETUP(nu, g); }
        S_DMA(g, kt + 2 - nk, st2);
      }
      if (BG && !dmaw) { if (j3 == 0) S_BGSLOT(bi0, b0a, b0b, b0c, b0d); else if (j3 == 1) S_BGSLOT(bi1, b1a, b1b, b1c, b1d); else S_BGSLOT(bi2, b2a, b2b, b2c, b2d); }
      if (BG) { if (bgdone < bgn) ++bgdone; j3 = j3 == 2 ? 0 : j3 + 1; }
      { const LAS char* cur = lds + st * C::STAGE; const int wa0 = (int)(uintptr_t)(cur + wr[0]), wa1 = (int)(uintptr_t)(cur + wr[1]);
        S_HALF(cur, wa0, wa1, 0); S_HALF(cur, wa0, wa1, 1); }
      st = st == 2 ? 0 : st + 1;
    }
    if (BG && !dmaw) {
      asm volatile("s_waitcnt vmcnt(0)" ::: "memory");
      if (bi0 >= 0) { BGA_RETIRE(bi0, bgoff, b0a, b0b); BGA_RETIRE(bi0, bgoff + 256, b0c, b0d); bi0 = -1; }
      if (bi1 >= 0) { BGA_RETIRE(bi1, bgoff, b1a, b1b); BGA_RETIRE(bi1, bgoff + 256, b1c, b1d); bi1 = -1; }
      if (bi2 >= 0) { BGA_RETIRE(bi2, bgoff, b2a, b2b); BGA_RETIRE(bi2, bgoff + 256, b2c, b2d); bi2 = -1; }
    }
    sprev = epi(cu, acc);
    if (!okn) break;
    cu = nu;
  }
  if (BG) *bgdone_p = bgdone;
#undef S_BGSLOT
#undef S_HALF
#undef S_DMA
#undef S_DMA1
#undef S_SETUP
}

__device__ __forceinline__ unsigned pack4_fp8(const f32x16& a, int g) {
  int w = __builtin_amdgcn_cvt_pk_fp8_f32(a[4 * g], a[4 * g + 1], 0, false);
  w = __builtin_amdgcn_cvt_pk_fp8_f32(a[4 * g + 2], a[4 * g + 3], w, true);
  return (unsigned)w;
}
__device__ __forceinline__ u32x2 pack4(const f32x16& a, int g) { return (u32x2){cvtpk(a[4 * g], a[4 * g + 1]), cvtpk(a[4 * g + 2], a[4 * g + 3])}; }

__device__ __forceinline__ void phase_a1(const Params& p, int layer, LAS char* lds, int bid, int nblk) {
  const bf16_t* H = (const bf16_t*)(p.ws + OFF_H);
  const bf16_t* W = (const bf16_t*)(p.ws + OFF_WIN) + (size_t)layer * D * INW;
  bf16_t* Q = (bf16_t*)(p.ws + OFF_Q); bf16_t* Kb = (bf16_t*)(p.ws + OFF_K); bf16_t* Vb = (bf16_t*)(p.ws + OFF_V);
  float* U = (float*)(p.ws + OFF_U); bf16_t* AG = (bf16_t*)(p.ws + OFF_AG);
  unsigned char* Q8 = (unsigned char*)(p.ws + OFF_Q8); unsigned char* K8 = (unsigned char*)(p.ws + OFF_K8); unsigned char* VT8 = (unsigned char*)(p.ws + OFF_VT8);
  const float* rt = (const float*)(p.ws + OFF_ROPE);
  const int lane = TIDX & 63, wid = TIDX >> 6, r32 = lane & 31, hi = lane >> 5, wm = wid >> 1, wn = wid & 1;
  const size_t wo = (size_t)layer * NE * D * DE;
  const int bgn = (3 * (1 << 21) + nblk * 512 - 1) / (nblk * 512);
  const long bgc0 = (long)bid * bgn * 512;
  const float* bs0 = p.w_e_gate + wo; const float* bs1 = p.w_e_up + wo; const float* bs2 = p.w_e_down + wo;
  bf16_t* bd0 = (bf16_t*)(p.ws + OFF_WG) + wo; bf16_t* bd1 = (bf16_t*)(p.ws + OFF_WU) + wo; bf16_t* bd2 = (bf16_t*)(p.ws + OFF_WD) + wo;
  int bgdone = 0;
  const int nlat = 64 * 12, nctx = layer == 0 ? 12 : 2, nunits = nlat + nctx;
  const bool xmap = (nblk & 7) == 0;
  const int xcd = bid & 7, lb = bid >> 3, nlb = nblk >> 3, nl = lb < 96 ? (96 - lb + nlb - 1) / nlb : 0;
  for (int it = 0;; ++it) {
    int rtile, ct;
    if (xmap) {
      if (it < nl) { const int v = lb + it * nlb; rtile = 1 + xcd + 8 * (v / 12); ct = v % 12; }
      else { const int e2 = bid + (it - nl) * nblk; if (e2 >= nctx) break; rtile = 0; ct = layer == 0 ? e2 : 4 + e2; }
    } else {
      const int u = bid + it * nblk; if (u >= nunits) break;
      if (u < nlat) { rtile = 1 + u / 12; ct = u % 12; } else { rtile = 0; ct = layer == 0 ? (u - nlat) : (4 + u - nlat); }
    }
    const int m0 = rtile * 256, n0 = ct * 128;
    f32x16 acc[2][2];
#pragma unroll
    for (int a = 0; a < 2; ++a)
#pragma unroll
      for (int b = 0; b < 2; ++b) acc[a][b] = (f32x16){};
    gemm_mainloop<256, 128, 0, true>(lds, acc, [&](int row) { return H + (size_t)(m0 + row) * D; }, [&](int) { return W + n0; }, []() {}, 0, INW, D, bgdone, bgn, bgc0, bs0, bs1, bs2, bd0, bd1, bd2);
#pragma unroll
    for (int ti = 0; ti < 2; ++ti) {
      const int tok = m0 + wm * 64 + ti * 32 + r32;
      if (ct < 5) {
        float ss = 0.f;
#pragma unroll
        for (int ni = 0; ni < 2; ++ni)
#pragma unroll
          for (int r = 0; r < 16; ++r) ss += acc[ti][ni][r] * acc[ti][ni][r];
        ss = sum32(ss);
        const float rs = rsqrtf(ss * (1.f / 64.f) + EPS);
        const float* gain = (ct < 4 ? p.q_gain : p.k_gain) + layer * 64;
        const float osc = ct < 4 ? 0.125f * 1.4426950408889634f : 1.f;
        const bool lat = rtile > 0;
        const int t = tok - NCTX;
#pragma unroll
        for (int ni = 0; ni < 2; ++ni) {
          f32x16 v;
#pragma unroll
          for (int r = 0; r < 16; ++r) v[r] = acc[ti][ni][r] * rs * gain[ni * 32 + crow(r, hi)];
          if (lat) {
            const int pos = ni == 0 ? (t >> 6) : (t & 63);
#pragma unroll
            for (int r = 0; r < 8; ++r) {
              const int f = crow(r, hi);
              const float cs = rt[(pos * 16 + f) * 2], sn = rt[(pos * 16 + f) * 2 + 1];
              const float t1 = v[r], t2 = v[r + 8];
              v[r] = t1 * cs - t2 * sn; v[r + 8] = t2 * cs + t1 * sn;
            }
          }
#pragma unroll
          for (int r = 0; r < 16; ++r) v[r] *= osc;
          bf16_t* dst = ct < 4 ? Q + (size_t)tok * 512 + (ct * 2 + wn) * 64 + ni * 32 : Kb + (size_t)tok * 128 + wn * 64 + ni * 32;
          unsigned char* dst8 = ct < 4 ? Q8 + (size_t)tok * 512 + (ct * 2 + wn) * 64 + ni * 32 : K8 + (size_t)tok * 128 + wn * 64 + ni * 32;
#pragma unroll
          for (int g = 0; g < 4; ++g) { *(u32x2*)(dst + 8 * g + 4 * hi) = pack4(v, g); *(unsigned*)(dst8 + 8 * g + 4 * hi) = pack4_fp8(v, g); }
        }
      } else if (ct == 5) {
#pragma unroll
        for (int ni = 0; ni < 2; ++ni) {
#pragma unroll
          for (int g = 0; g < 4; ++g) *(u32x2*)(Vb + (size_t)tok * 128 + wn * 64 + ni * 32 + 8 * g + 4 * hi) = pack4(acc[ti][ni], g);
          float vmx = 0.f;
#pragma unroll
          for (int r = 0; r < 16; ++r) {
            const float vv = acc[ti][ni][r]; vmx = fmaxf(vmx, fabsf(vv));
            VT8[(size_t)(wn * 64 + ni * 32 + crow(r, hi)) * TT + tok] = (unsigned char)(__builtin_amdgcn_cvt_pk_fp8_f32(vv, vv, 0, false) & 0xff);
          }
          if (!(vmx <= 400.f)) atomicOr((int*)(p.ws + OFF_FLAG) + 1, 1);
        }
      } else if (ct < 8) {
#pragma unroll
        for (int ni = 0; ni < 2; ++ni)
#pragma unroll
          for (int g = 0; g < 4; ++g)
            *(f32x4*)(U + (size_t)tok * 256 + (ct - 6) * 128 + wn * 64 + ni * 32 + 8 * g + 4 * hi) =
                (f32x4){acc[ti][ni][4 * g], acc[ti][ni][4 * g + 1], acc[ti][ni][4 * g + 2], acc[ti][ni][4 * g + 3]};
      } else {
#pragma unroll
        for (int ni = 0; ni < 2; ++ni)
#pragma unroll
          for (int g = 0; g < 4; ++g) *(u32x2*)(AG + (size_t)tok * 512 + (ct - 8) * 128 + wn * 64 + ni * 32 + 8 * g + 4 * hi) = pack4(acc[ti][ni], g);
      }
    }
  }
  { const int tid = TIDX; while (bgdone < bgn) { f32x4 a, b2; const int i = bgdone++; BG_ISSUE(i, tid, a, b2); BG_RETIRE(i, tid, a, b2); } }
}

__device__ __forceinline__ void phase_c1(const Params& p, int layer, LAS char* lds, int bid, int nblk) {
  const bf16_t* A = (const bf16_t*)(p.ws + OFF_MIX);
  const bf16_t* W = (const bf16_t*)(p.ws + OFF_WOUT) + (size_t)layer * D * D;
  bf16_t* Y = (bf16_t*)(p.ws + OFF_Y);
  const int lane = TIDX & 63, wid = TIDX >> 6, r32 = lane & 31, hi = lane >> 5, wm = wid >> 1, wn = wid & 1;
  const int nctx = layer == 0 ? 8 : 0;
  const bool xmap = (nblk & 7) == 0;
  const int xcd = bid & 7, lb = bid >> 3, nlb = nblk >> 3, nl = lb < 64 ? (64 - lb + nlb - 1) / nlb : 0;
  const unsigned oA = (unsigned)OFF_MIX, oW = (unsigned)(OFF_WOUT + (size_t)layer * D * D * 2);
  gemm_stream<256, 128, 0>(lds, p.ws, D, D,
    [&](int it, UnitD& u) {
      int rtile, ct;
      if (xmap) {
        if (it < nl) { const int v = lb + it * nlb; rtile = 1 + xcd + 8 * (v >> 3); ct = v & 7; }
        else { const int e2 = bid + (it - nl) * nblk; if (e2 >= nctx) return false; rtile = 0; ct = e2; }
      } else {
        const int un = bid + it * nblk; if (un >= 64 * 8 + nctx) return false;
        if (un < 512) { rtile = 1 + (un >> 3); ct = un & 7; } else { rtile = 0; ct = un - 512; }
      }
      u.a = rtile * 256; u.b = ct * 128; u.c = 0; u.d = 0; u.lv0 = 0; u.lv1 = 0; return true; },
    [&](const UnitD& u, int row) { return oA + (unsigned)(u.a + row) * (D * 2); },
    [&](const UnitD& u, int) { return oW + (unsigned)u.b * 2; },
    [&](const UnitD& u, f32x16 (&acc)[2][2]) {
#pragma unroll
      for (int ti = 0; ti < 2; ++ti) {
        const int tok = u.a + wm * 64 + ti * 32 + r32;
#pragma unroll
        for (int ni = 0; ni < 2; ++ni)
#pragma unroll
          for (int g = 0; g < 4; ++g) *(u32x2*)(Y + (size_t)tok * D + u.b + wn * 64 + ni * 32 + 8 * g + 4 * hi) = pack4(acc[ti][ni], g);
      }
      return 16; });
}

#ifndef MOE_XCD_MAP
#define MOE_XCD_MAP 0
#endif
__device__ __forceinline__ void moe_prefix(const int* cnt, LAS int* pre, int xcd) {
  if (TIDX == 0) {
    int o = 0; for (int e = 0; e < NE; ++e) { pre[e] = o; o += (cnt[e * CNT_STRIDE] + 127) >> 7; } pre[NE] = o;
    int l = 0; for (int j = 0; j < 4; ++j) { pre[40 + j] = l; l += (cnt[(xcd + 8 * j) * CNT_STRIDE] + 127) >> 7; } pre[44] = l;
  }
  if (TIDX >= 64 && TIDX < 64 + NE) pre[48 + TIDX - 64] = cnt[(TIDX - 64) * CNT_STRIDE];
  __syncthreads();
}
__device__ __forceinline__ bool moe_unit(const LAS int* pre, int bid, int nblk, int it, int& e, int& rt, int& ct, int& g) {
  if (MOE_XCD_MAP && (nblk & 7) == 0) {
    const int xcd = bid & 7, v = (bid >> 3) + it * (nblk >> 3), gl = v >> 2;
    if (gl >= pre[44]) return false;
    int j = 0; if (gl >= pre[41]) j = 1; if (gl >= pre[42]) j = 2; if (gl >= pre[43]) j = 3;
    e = xcd + 8 * j; rt = gl - pre[40 + j]; ct = v & 3; g = pre[e] + rt; return true;
  } else {
    const int u = bid + it * nblk; g = u >> 2; if (g >= pre[NE]) return false;
    int ee = 0; for (int i = 1; i < NE; ++i) ee += (pre[i] <= g) ? 1 : 0;
    e = ee; rt = g - pre[ee]; ct = u & 3; return true;
  }
}

__device__ __forceinline__ void phase_d1(const Params& p, int layer, LAS char* lds, int bid, int nblk) {
  const int* cnt = (const int*)(p.ws + OFF_CNT) + layer * NE * CNT_STRIDE;
  const bf16_t* H2 = (const bf16_t*)(p.ws + OFF_MIX);
  bf16_t* HM = (bf16_t*)(p.ws + OFF_HMID);
  LAS int* pre = (LAS int*)(lds + GEMM_LDS);
  moe_prefix(cnt, pre, bid & 7);
  const int lane = TIDX & 63, wid = TIDX >> 6, r32 = lane & 31, hi = lane >> 5, wm = wid >> 2, wn = wid & 3;
  const int grow = 16 * wid + (lane >> 3);
  const bf16_t* WG = (const bf16_t*)(p.ws + OFF_WG) + (size_t)layer * NE * D * DE; const bf16_t* WU = (const bf16_t*)(p.ws + OFF_WU) + (size_t)layer * NE * D * DE;
  const unsigned oH2 = (unsigned)OFF_MIX, oWG = (unsigned)(OFF_WG + (size_t)layer * NE * D * DE * 2), oWU = (unsigned)(OFF_WU + (size_t)layer * NE * D * DE * 2);
  gemm_stream<128, 256, 2>(lds, p.ws, DE, D,
    [&](int it, UnitD& u) {
      int e, rt, ct, g; if (!moe_unit(pre, bid, nblk, it, e, rt, ct, g)) return false;
      const int* list = (const int*)(p.ws + OFF_LIST) + (size_t)e * CAPL + rt * 128 + grow;
      u.a = e; u.b = ct; u.c = g; u.d = pre[48 + e] - rt * 128;
      asm volatile("global_load_dword %0, %2, off\n\tglobal_load_dword %1, %2, off offset:32" : "=&v"(u.lv0), "=&v"(u.lv1) : "v"(list) : "memory");
      return true; },
    [&](const UnitD& u, int row) { const int lv = (row & 8) ? u.lv1 : u.lv0; const int tok = row < u.d ? (lv >> 1) : 0; return oH2 + (unsigned)tok * (D * 2); },
    [&](const UnitD& u, int s) { return (s == 0 ? oWG : oWU) + (unsigned)u.a * (D * DE * 2) + (unsigned)u.b * 256; },
    [&](const UnitD& u, f32x16 (&acc)[2][2]) {
#pragma unroll
      for (int ti = 0; ti < 2; ++ti) {
        const size_t row = (size_t)u.c * 128 + wm * 64 + ti * 32 + r32;
        f32x16 a;
#pragma unroll
        for (int r = 0; r < 16; ++r) { const float gv = acc[ti][0][r]; a[r] = gv / (1.f + __expf(-gv)) * acc[ti][1][r]; }
#pragma unroll
        for (int gq = 0; gq < 4; ++gq) *(u32x2*)(HM + row * DE + u.b * 128 + wn * 32 + 8 * gq + 4 * hi) = pack4(a, gq);
      }
      return 8; });
}

__device__ __forceinline__ void phase_d2(const Params& p, int layer, LAS char* lds, int bid, int nblk) {
  const int* cnt = (const int*)(p.ws + OFF_CNT) + layer * NE * CNT_STRIDE;
  const bf16_t* HM = (const bf16_t*)(p.ws + OFF_HMID);
  bf16_t* OM = (bf16_t*)(p.ws + OFF_OMOE);
  LAS int* pre = (LAS int*)(lds + GEMM_LDS);
  moe_prefix(cnt, pre, bid & 7);
  const int lane = TIDX & 63, wid = TIDX >> 6, r32 = lane & 31, hi = lane >> 5, wm = wid >> 2, wn = wid & 3;
  const int row0 = wm * 64 + r32;
  const bf16_t* WD = (const bf16_t*)(p.ws + OFF_WD) + (size_t)layer * NE * DE * D;
  const unsigned oHM = (unsigned)OFF_HMID, oWD = (unsigned)(OFF_WD + (size_t)layer * NE * DE * D * 2);
  gemm_stream<128, 256, 1>(lds, p.ws, D, DE,
    [&](int it, UnitD& u) {
      int e, rt, ct, g; if (!moe_unit(pre, bid, nblk, it, e, rt, ct, g)) return false;
      const int* list = (const int*)(p.ws + OFF_LIST) + (size_t)e * CAPL + rt * 128 + row0;
      u.a = e; u.b = ct; u.c = g; u.d = pre[48 + e] - rt * 128;
      asm volatile("global_load_dword %0, %2, off\n\tglobal_load_dword %1, %2, off offset:128" : "=&v"(u.lv0), "=&v"(u.lv1) : "v"(list) : "memory");
      return true; },
    [&](const UnitD& u, int row) { return oHM + (unsigned)(u.c * 128 + row) * (DE * 2); },
    [&](const UnitD& u, int s) { return oWD + (unsigned)u.a * (DE * D * 2) + (unsigned)(u.b * 256 + s * 128) * 2; },
    [&](const UnitD& u, f32x16 (&acc)[2][2]) {
#pragma unroll
      for (int ti = 0; ti < 2; ++ti) {
        const int ts = ti == 0 ? u.lv0 : u.lv1;
        if (row0 + ti * 32 < u.d) {
#pragma unroll
          for (int ni = 0; ni < 2; ++ni)
#pragma unroll
            for (int gq = 0; gq < 4; ++gq) *(u32x2*)(OM + (size_t)ts * D + u.b * 256 + wn * 64 + ni * 32 + 8 * gq + 4 * hi) = pack4(acc[ti][ni], gq);
        }
      }
      return u.d >= 128 ? 16 : 0; });
}
constexpr int ATT_SLOT = 16384, ATT_LDS = 4 * ATT_SLOT;
__device__ __forceinline__ int vst64(int k, int c) { const int kk = (k & ~0xC) | ((k & 4) << 1) | ((k & 8) >> 1); return ((kk >> 3) * 2 + (c >> 5)) * 512 + ((kk & 7) * 32 + (c & 31)) * 2; }
__device__ __forceinline__ bf16x8 tr_frag64(const LAS char* p) {
  s16x4 a = __builtin_amdgcn_ds_read_tr16_b64_v4i16((LAS s16x4*)p);
  s16x4 b = __builtin_amdgcn_ds_read_tr16_b64_v4i16((LAS s16x4*)(p + 1024));
  return (bf16x8){a[0], a[1], a[2], a[3], b[0], b[1], b[2], b[3]};
}
__device__ __forceinline__ bf16x8 pk4(const f32x16& P, int B) {
  unsigned a0 = cvtpk(P[B + 0], P[B + 1]), a1 = cvtpk(P[B + 2], P[B + 3]), b0 = cvtpk(P[B + 4], P[B + 5]), b1 = cvtpk(P[B + 6], P[B + 7]);
  auto r0 = __builtin_amdgcn_permlane32_swap(a0, b0, false, false); auto r1 = __builtin_amdgcn_permlane32_swap(a1, b1, false, false);
  u32x4 w = {r0[0], r1[0], r0[1], r1[1]};
  return __builtin_bit_cast(bf16x8, w);
}
struct AttnCtx { int krd0, krd1, ksw, hi, vrd; };
#define SBAR() __builtin_amdgcn_sched_barrier(0)
__device__ __forceinline__ void att_kload(const LAS char* slot, const AttnCtx& c, bf16x8 (&kf)[8]) {
#pragma unroll
  for (int d0 = 0; d0 < 4; ++d0) {
    kf[2 * d0] = *(const LAS bf16x8*)(slot + c.krd0 + (((2 * d0 + c.hi) ^ c.ksw) << 4));
    kf[2 * d0 + 1] = *(const LAS bf16x8*)(slot + c.krd1 + (((2 * d0 + c.hi) ^ c.ksw) << 4));
  }
}
__device__ __forceinline__ void att_qk(const bf16x8 (&kf)[8], const bf16x8 (&qr)[4], f32x16& s0, f32x16& s1) {
  s0 = (f32x16){}; s1 = (f32x16){};
#pragma unroll
  for (int d0 = 0; d0 < 4; ++d0) {
    s0 = __builtin_amdgcn_mfma_f32_32x32x16_bf16(kf[2 * d0], qr[d0], s0, 0, 0, 0);
    s1 = __builtin_amdgcn_mfma_f32_32x32x16_bf16(kf[2 * d0 + 1], qr[d0], s1, 0, 0, 0);
  }
}
__device__ __forceinline__ void att_exp(f32x16& s, float& l) {
#pragma unroll
  for (int r = 0; r < 16; ++r) { s[r] = __builtin_amdgcn_exp2f(s[r]); l += s[r]; }
  asm volatile("" : "+v"(l));
}
template <int KS0>
__device__ __forceinline__ void att_vload(const LAS char* slot, const AttnCtx& c, bf16x8 (&vf)[4]) {
#pragma unroll
  for (int i = 0; i < 2; ++i) { vf[2 * i] = tr_frag64(slot + c.vrd + (KS0 + i) * 2048); vf[2 * i + 1] = tr_frag64(slot + c.vrd + 512 + (KS0 + i) * 2048); }
}
__device__ __forceinline__ void att_pv2(const bf16x8& pa, const bf16x8& pb, const bf16x8 (&vf)[4], f32x16& o0, f32x16& o1) {
  o0 = __builtin_amdgcn_mfma_f32_32x32x16_bf16(pa, vf[0], o0, 0, 0, 0);
  o1 = __builtin_amdgcn_mfma_f32_32x32x16_bf16(pa, vf[1], o1, 0, 0, 0);
  o0 = __builtin_amdgcn_mfma_f32_32x32x16_bf16(pb, vf[2], o0, 0, 0, 0);
  o1 = __builtin_amdgcn_mfma_f32_32x32x16_bf16(pb, vf[3], o1, 0, 0, 0);
}
__device__ __forceinline__ void attn_unit(const Params& p, LAS char* lds, int row0, int hp, int nkeys) {
  const bf16_t* Q = (const bf16_t*)(p.ws + OFF_Q); const bf16_t* Kb = (const bf16_t*)(p.ws + OFF_K); const bf16_t* Vb = (const bf16_t*)(p.ws + OFF_V);
  bf16_t* MIX = (bf16_t*)(p.ws + OFF_MIX);
  const int tid = TIDX, wid = tid >> 6, lane = tid & 63, r32 = lane & 31, hi = lane >> 5, kvh = hp >> 1;
  bf16x8 qa[4], qb[4];
  { const bf16_t* Qg = Q + (size_t)(row0 + wid * 32 + r32) * 512 + hp * 128 + hi * 8;
#pragma unroll
    for (int d0 = 0; d0 < 4; ++d0) { qa[d0] = *(const bf16x8*)(Qg + d0 * 16); qb[d0] = *(const bf16x8*)(Qg + 64 + d0 * 16); } }
  const bf16_t* Kg = Kb + (size_t)(tid >> 3) * 128 + kvh * 64 + (tid & 7) * 8;
  const bf16_t* Vg = Vb + (size_t)(tid >> 3) * 128 + kvh * 64 + (tid & 7) * 8;
  const int kst = xoff(tid >> 3, tid & 7), vstw = 8192 + vst64(tid >> 3, (tid & 7) * 8);
  AttnCtx c; c.krd0 = r32 * 128; c.krd1 = (32 + r32) * 128; c.ksw = (r32 >> 1) & 7; c.hi = hi; c.vrd = 8192 + v_rd_base(lane);
  const int NT = nkeys >> 6;
  f32x16 oa0 = {}, oa1 = {}, ob0 = {}, ob1 = {}; float la = 0.f, lb = 0.f;
  u32x4 ks, vs;
  {
    const u32x4 k0 = *(const u32x4*)Kg, k1 = *(const u32x4*)(Kg + 64 * 128), v0 = *(const u32x4*)Vg, v1 = *(const u32x4*)(Vg + 64 * 128);
    *(LAS u32x4*)(lds + kst) = k0; *(LAS u32x4*)(lds + ATT_SLOT + kst) = k1;
    *(LAS u32x4*)(lds + vstw) = v0; *(LAS u32x4*)(lds + ATT_SLOT + vstw) = v1;
    ks = *(const u32x4*)(Kg + 2 * 64 * 128); vs = *(const u32x4*)(Vg + 2 * 64 * 128);
  }
  __syncthreads();
  for (int j = 0; j < NT; ++j) {
    const LAS char* sl = lds + (j & 3) * ATT_SLOT;
    bf16x8 kf[8], vfa[4], vfb[4];
    f32x16 sa0, sa1, sb0, sb1;
    att_kload(sl, c, kf);
    SBAR();
    att_qk(kf, qa, sa0, sa1);
    SBAR();
    att_qk(kf, qb, sb0, sb1);
    att_exp(sa0, la); att_exp(sa1, la);
    SBAR();
    const bf16x8 pa0 = pk4(sa0, 0), pa1 = pk4(sa0, 8), pa2 = pk4(sa1, 0), pa3 = pk4(sa1, 8);
    att_vload<0>(sl, c, vfa);
    SBAR();
    att_pv2(pa0, pa1, vfa, oa0, oa1);
    att_exp(sb0, lb);
    att_vload<2>(sl, c, vfb);
    SBAR();
    att_pv2(pa2, pa3, vfb, oa0, oa1);
    att_exp(sb1, lb);
    const bf16x8 pb0 = pk4(sb0, 0), pb1 = pk4(sb0, 8), pb2 = pk4(sb1, 0), pb3 = pk4(sb1, 8);
    att_vload<0>(sl, c, vfa);
    SBAR();
    att_pv2(pb0, pb1, vfa, ob0, ob1);
    att_vload<2>(sl, c, vfb);
    SBAR();
    att_pv2(pb2, pb3, vfb, ob0, ob1);
    { LAS char* w = lds + ((j + 2) & 3) * ATT_SLOT;
      if (j + 2 < NT) { *(LAS u32x4*)(w + kst) = ks; *(LAS u32x4*)(w + vstw) = vs; }
      if (j + 3 < NT) { ks = *(const u32x4*)(Kg + (size_t)(j + 3) * 64 * 128); vs = *(const u32x4*)(Vg + (size_t)(j + 3) * 64 * 128); } }
    __syncthreads();
  }
  la = sum32(la); lb = sum32(lb);
  LAS float* li = (LAS float*)(lds + wid * 256);
  if (hi == 0) { li[r32] = la; li[32 + r32] = lb; }
  __syncthreads();
  bf16_t* Og = MIX + (size_t)(row0 + wid * 32) * D + hp * 128 + r32;
#pragma unroll
  for (int r = 0; r < 16; ++r) {
    const int orow = crow(r, hi);
    const float ra = __builtin_amdgcn_rcpf(li[orow]), rb = __builtin_amdgcn_rcpf(li[32 + orow]);
    Og[(size_t)orow * D] = f2bf(oa0[r] * ra); Og[(size_t)orow * D + 32] = f2bf(oa1[r] * ra);
    Og[(size_t)orow * D + 64] = f2bf(ob0[r] * rb); Og[(size_t)orow * D + 96] = f2bf(ob1[r] * rb);
  }
  __syncthreads();
}
typedef int i32x8 __attribute__((ext_vector_type(8)));
constexpr int A8_SLOT = 8192, A8_NSLOT = 8, A8_LDS = A8_NSLOT * A8_SLOT;
__device__ __forceinline__ int off8(int row, int chunk) { return row * 64 + ((chunk ^ ((row >> 2) & 3)) << 4); }
__device__ __forceinline__ i32x8 ld_frag8(const LAS char* tile, int row, int h) {
  const int sw = (row >> 2) & 3;
  const u32x4 lo = *(const LAS u32x4*)(tile + row * 64 + (((2 * h) ^ sw) << 4)), hi = *(const LAS u32x4*)(tile + row * 64 + (((2 * h + 1) ^ sw) << 4));
  return (i32x8){(int)lo[0], (int)lo[1], (int)lo[2], (int)lo[3], (int)hi[0], (int)hi[1], (int)hi[2], (int)hi[3]};
}
#define MX_FP8_FP8(a, b, c) __builtin_amdgcn_mfma_scale_f32_32x32x64_f8f6f4(a, b, c, 0, 0, 0, 0x7f7f7f7f, 0, 0x7f7f7f7f)
#define MX_BF8_FP8(a, b, c) __builtin_amdgcn_mfma_scale_f32_32x32x64_f8f6f4(a, b, c, 1, 0, 0, 0x7f7f7f7f, 0, 0x7f7f7f7f)
typedef _Float16 f16x2 __attribute__((ext_vector_type(2)));
__device__ __forceinline__ unsigned att8_code4(float s0, float s1, float s2, float s3) {
  const f16x2 four = {(_Float16)4.f, (_Float16)4.f}, bias = {(_Float16)1084.f, (_Float16)1084.f};
  const f16x2 x = __builtin_bit_cast(f16x2, __builtin_amdgcn_cvt_pkrtz(s0, s1)) * four + bias, y = __builtin_bit_cast(f16x2, __builtin_amdgcn_cvt_pkrtz(s2, s3)) * four + bias;
  return __builtin_amdgcn_perm(__builtin_bit_cast(unsigned, y), __builtin_bit_cast(unsigned, x), 0x06040200u);
}
__device__ __forceinline__ i32x8 att8_pack(const f32x16& p0, const f32x16& p1) {
  i32x8 w;
#pragma unroll
  for (int i = 0; i < 4; ++i) {
    const unsigned d = att8_code4(p0[4 * i], p0[4 * i + 1], p0[4 * i + 2], p0[4 * i + 3]), e = att8_code4(p1[4 * i], p1[4 * i + 1], p1[4 * i + 2], p1[4 * i + 3]);
    auto r = __builtin_amdgcn_permlane32_swap(d, e, false, false);
    w[2 * i] = (int)r[0]; w[2 * i + 1] = (int)r[1];
  }
  return w;
}
__device__ __forceinline__ void attn_unit8(const Params& p, LAS char* lds, int row0, int hp, int nkeys, bf16_t* MIXP = nullptr) {
  const unsigned char* Q8 = (const unsigned char*)(p.ws + OFF_Q8); const unsigned char* K8 = (const unsigned char*)(p.ws + OFF_K8); const unsigned char* VT8 = (const unsigned char*)(p.ws + OFF_VT8);
  bf16_t* MIX = MIXP ? MIXP : (bf16_t*)(p.ws + OFF_MIX);
  const int tid = TIDX, wid = tid >> 6, lane = tid & 63, r32 = lane & 31, hi = lane >> 5, kvh = hp >> 1;
  i32x8 qa, qb;
  { const unsigned char* Qg = Q8 + (size_t)(row0 + wid * 32 + r32) * 512 + hp * 128 + hi * 32;
    const u32x4 a0 = *(const u32x4*)Qg, a1 = *(const u32x4*)(Qg + 16), b0 = *(const u32x4*)(Qg + 64), b1 = *(const u32x4*)(Qg + 80);
    qa = (i32x8){(int)a0[0], (int)a0[1], (int)a0[2], (int)a0[3], (int)a1[0], (int)a1[1], (int)a1[2], (int)a1[3]};
    qb = (i32x8){(int)b0[0], (int)b0[1], (int)b0[2], (int)b0[3], (int)b1[0], (int)b1[1], (int)b1[2], (int)b1[3]}; }
  const int wv = __builtin_amdgcn_readfirstlane(wid);
  const int prow = (wv & 3) * 16 + (lane >> 2), pch = (lane & 3) ^ ((prow >> 2) & 3);
  const unsigned char* Sg = wv < 4 ? K8 + (size_t)prow * 128 + kvh * 64 + pch * 16 : VT8 + (size_t)(kvh * 64 + prow) * TT + pch * 16;
  const size_t sstep = wv < 4 ? (size_t)64 * 128 : (size_t)64;
  const int sdst = (wv < 4 ? 0 : 4096) + (wv & 3) * 1024;
#define A8_DMA(t) __builtin_amdgcn_global_load_lds((const unsigned*)(Sg + (size_t)(t) * sstep), (LAS unsigned*)(lds + ((t) & (A8_NSLOT - 1)) * A8_SLOT + sdst), 16, 0, 0)
  const int NT = nkeys >> 6;
  f32x16 oa0 = {}, oa1 = {}, ob0 = {}, ob1 = {}, ola = {}, olb = {};
  const i32x8 ones = {0x38383838, 0x38383838, 0x38383838, 0x38383838, 0x38383838, 0x38383838, 0x38383838, 0x38383838};
  A8_DMA(0); A8_DMA(1); if (NT > 2) { A8_DMA(2); A8_DMA(3); }
  for (int j = 0; j < NT; j += 2) {
    if (j + 2 < NT) asm volatile("s_waitcnt vmcnt(2)" ::: "memory"); else asm volatile("s_waitcnt vmcnt(0)" ::: "memory");
    asm volatile("s_waitcnt lgkmcnt(0)" ::: "memory"); __builtin_amdgcn_s_barrier();
    if (j + 4 < NT) { A8_DMA(j + 4); A8_DMA(j + 5); }
#pragma unroll
    for (int jj = 0; jj < 2; ++jj) {
      const LAS char* sl = lds + ((j + jj) & (A8_NSLOT - 1)) * A8_SLOT;
      f32x16 sa0 = {}, sa1 = {}, sb0 = {}, sb1 = {};
      const i32x8 kf0 = ld_frag8(sl, r32, hi), kf1 = ld_frag8(sl, 32 + r32, hi);
      SBAR();
      sa0 = MX_FP8_FP8(kf0, qa, sa0); sa1 = MX_FP8_FP8(kf1, qa, sa1);
      SBAR();
      sb0 = MX_FP8_FP8(kf0, qb, sb0); sb1 = MX_FP8_FP8(kf1, qb, sb1);
      SBAR();
      const i32x8 pa = att8_pack(sa0, sa1);
      const i32x8 vf0 = ld_frag8(sl + 4096, r32, hi), vf1 = ld_frag8(sl + 4096, 32 + r32, hi);
      SBAR();
      oa0 = MX_BF8_FP8(pa, vf0, oa0); oa1 = MX_BF8_FP8(pa, vf1, oa1); ola = MX_BF8_FP8(pa, ones, ola);
      const i32x8 pb = att8_pack(sb0, sb1);
      SBAR();
      ob0 = MX_BF8_FP8(pb, vf0, ob0); ob1 = MX_BF8_FP8(pb, vf1, ob1); olb = MX_BF8_FP8(pb, ones, olb);
    }
  }
#undef A8_DMA
  asm volatile("s_waitcnt lgkmcnt(0)" ::: "memory"); __builtin_amdgcn_s_barrier();
  bf16_t* Og = MIX + (size_t)(row0 + wid * 32) * D + hp * 128 + r32;
#pragma unroll
  for (int r = 0; r < 16; ++r) {
    const int orow = crow(r, hi);
    const float ra = __builtin_amdgcn_rcpf(ola[r]), rb = __builtin_amdgcn_rcpf(olb[r]);
    Og[(size_t)orow * D] = f2bf(oa0[r] * ra); Og[(size_t)orow * D + 32] = f2bf(oa1[r] * ra);
    Og[(size_t)orow * D + 64] = f2bf(ob0[r] * rb); Og[(size_t)orow * D + 96] = f2bf(ob1[r] * rb);
  }
  __syncthreads();
}
__device__ __forceinline__ void attn_fallback(const Params& p, int layer, int bid, int nblk) {
  const bf16_t* Q = (const bf16_t*)(p.ws + OFF_Q); const bf16_t* Kb = (const bf16_t*)(p.ws + OFF_K); const bf16_t* Vb = (const bf16_t*)(p.ws + OFF_V);
  bf16_t* MIX = (bf16_t*)(p.ws + OFF_MIX);
  const int lane = TIDX & 63, nwv = nblk * 8;
  const int rg0 = layer == 0 ? 0 : NCTX / 64;
  for (int wv = bid * 8 + (TIDX >> 6) + rg0 * 8; wv < (TT / 64) * 8; wv += nwv) {
    const int head = wv & 7, r = (wv >> 3) * 64 + lane, kvh = head >> 2;
    float q[64], o[64];
#pragma unroll
    for (int d = 0; d < 64; ++d) { q[d] = bf2f(Q[(size_t)r * 512 + head * 64 + d]); o[d] = 0.f; }
    float m = -1e30f, l = 0.f;
    const int nk = r >= NCTX ? TT : NCTX;
    for (int j = 0; j < nk; ++j) {
      const bf16_t* kr = Kb + (size_t)j * 128 + kvh * 64;
      const bf16_t* vr = Vb + (size_t)j * 128 + kvh * 64;
      float s = 0.f;
#pragma unroll
      for (int d = 0; d < 64; ++d) s += q[d] * bf2f(kr[d]);
      if (s > m) {
        const float a = __builtin_amdgcn_exp2f(m - s);
        l *= a;
#pragma unroll
        for (int d = 0; d < 64; ++d) o[d] *= a;
        m = s;
      }
      const float pe = __builtin_amdgcn_exp2f(s - m);
      l += pe;
#pragma unroll
      for (int d = 0; d < 64; ++d) o[d] += pe * bf2f(vr[d]);
    }
    const float il = 1.f / l;
#pragma unroll
    for (int d = 0; d < 64; ++d) MIX[(size_t)r * D + head * 64 + d] = f2bf(o[d] * il);
  }
}

constexpr int PC_U = 0;
constexpr int PC_Y = 49152;
constexpr int PC_P = PC_Y + 65536;
constexpr int PC_LDS = PC_P + 32768;
__device__ __forceinline__ void poolconv_unit(const Params& p, int layer, LAS char* lds, int tile) {
  const int tid = TIDX, wid = tid >> 6, lane = tid & 63, r32 = lane & 31, hi = lane >> 5;
  const int t0 = tile * 64, base = tile < 4 ? 0 : NCTX, n = tile < 4 ? NCTX : SEQ;
  const bf16_t* AG = (const bf16_t*)(p.ws + OFF_AG);
  const float* U = (const float*)(p.ws + OFF_U);
  bf16_t* MIX = (bf16_t*)(p.ws + OFF_MIX);
#pragma unroll
  for (int h = 0; h < 2; ++h) {
    u32x4 av[3], gv[3]; bool in[3];
#pragma unroll
    for (int q = 0; q < 3; ++q) {
      const int idx = tid + (h * 3 + q) * 512, rr = idx >> 5, ch = (idx & 31) * 8, t = t0 - 15 + rr;
      in[q] = idx < 94 * 32 && t >= base && t < base + n;
      const size_t off = (size_t)(in[q] ? t : t0) * 512 + ch;
      av[q] = *(const u32x4*)(AG + off); gv[q] = *(const u32x4*)(AG + off + 256);
    }
#pragma unroll
    for (int q = 0; q < 3; ++q) {
      const int idx = tid + (h * 3 + q) * 512, rr = idx >> 5, ch = (idx & 31) * 8;
      u32x4 out = {0u, 0u, 0u, 0u};
      if (in[q]) {
#pragma unroll
        for (int i = 0; i < 4; ++i) {
          const float a0 = __uint_as_float(av[q][i] << 16), a1 = __uint_as_float(av[q][i] & 0xffff0000u);
          const float g0 = __uint_as_float(gv[q][i] << 16), g1 = __uint_as_float(gv[q][i] & 0xffff0000u);
          out[i] = cvtpk(a0 / (1.f + __expf(-g0)), a1 / (1.f + __expf(-g1)));
        }
      }
      if (idx < 94 * 32) *(LAS u32x4*)(lds + PC_U + (rr * 256 + ch) * 2) = out;
    }
  }
  __syncthreads();
  {
    const int c = tid & 255, th = tid >> 8;
    float w[31];
#pragma unroll
    for (int j = 0; j < 31; ++j) w[j] = p.w_dw[(size_t)layer * 31 * 256 + j * 256 + c];
    const float b = p.b_dw[layer * 256 + c];
    float acc[32];
#pragma unroll
    for (int i = 0; i < 32; ++i) acc[i] = b;
    const LAS bf16_t* up = (const LAS bf16_t*)(lds + PC_U) + (th * 32) * 256 + c;
#pragma unroll
    for (int rr = 0; rr < 62; ++rr) {
      const float uv = bf2f(up[rr * 256]);
#pragma unroll
      for (int i = 0; i < 32; ++i) if (rr - i >= 0 && rr - i < 31) acc[i] += uv * w[rr - i];
    }
    LAS float* yp = (LAS float*)(lds + PC_Y) + (th * 32) * 256 + c;
#pragma unroll
    for (int i = 0; i < 32; ++i) yp[i * 256] = acc[i];
  }
  {
    const int c = tid & 255, th = tid >> 8, grp = c >> 6, w = 2 << grp, hw = w >> 1;
    const int tl0 = t0 - base + th * 32;
    float uv[48];
#pragma unroll
    for (int i = 0; i < 48; ++i) { const int j = tl0 - 8 + i; const bool in = j >= 0 && j < n; uv[i] = in ? U[(size_t)(base + j) * 256 + c] : 0.f; }
#pragma unroll
    for (int i = 0; i < 32; ++i) {
      const int tl = tl0 + i, lo = max(tl - hw, 0), hh = min(tl + hw, n);
      float s = 0.f;
#pragma unroll
      for (int d = -8; d < 8; ++d) if (d >= -hw && d < hw) s += uv[8 + i + d];
      const float pv = s / (float)(hh - lo) - uv[8 + i];
      const int tok = th * 32 + i, chunk = c >> 3, sw = (chunk & 16) | ((chunk ^ tok) & 15);
      *(LAS bf16_t*)(lds + PC_P + tok * 512 + sw * 16 + (c & 7) * 2) = f2bf(pv);
    }
  }
  __syncthreads();
  {
    const f32x4 g4 = *(const f32x4*)(p.cv_ln_g + layer * 256 + lane * 4), b4 = *(const f32x4*)(p.cv_ln_b + layer * 256 + lane * 4);
#pragma unroll
    for (int i = 0; i < 8; ++i) {
      const int tok = wid * 8 + i;
      const f32x4 y = *(const LAS f32x4*)(lds + PC_Y + (tok * 256 + lane * 4) * 4);
      const float mu = wave_sum(y[0] + y[1] + y[2] + y[3]) * (1.f / 256.f);
      const float d0 = y[0] - mu, d1 = y[1] - mu, d2 = y[2] - mu, d3 = y[3] - mu;
      const float rs = rsqrtf(wave_sum(d0 * d0 + d1 * d1 + d2 * d2 + d3 * d3) * (1.f / 256.f) + EPS);
      const float z0 = silu(d0 * rs * g4[0] + b4[0]), z1 = silu(d1 * rs * g4[1] + b4[1]), z2 = silu(d2 * rs * g4[2] + b4[2]), z3 = silu(d3 * rs * g4[3] + b4[3]);
      const int chunk = lane >> 1, sw = (chunk & 16) | ((chunk ^ tok) & 15);
      *(LAS u32x2*)(lds + PC_U + tok * 512 + sw * 16 + (lane & 1) * 8) = (u32x2){cvtpk(z0, z1), cvtpk(z2, z3)};
    }
  }
  __syncthreads();
  {
    const int tb = wid >> 2, dg = wid & 3, trow = tb * 32 + r32, t = t0 + trow;
    const bf16_t* Wt = (const bf16_t*)(p.ws + OFF_WPWT) + ((size_t)layer * 256 + dg * 64 + r32) * 256 + hi * 8;
    f32x16 acc0 = {}, acc1 = {};
#pragma unroll 8
    for (int ks = 0; ks < 16; ++ks) {
      const int chunk = 2 * ks + hi, sw = (chunk & 16) | ((chunk ^ trow) & 15);
      const bf16x8 zf = *(const LAS bf16x8*)(lds + PC_U + trow * 512 + sw * 16);
      const bf16x8 w0 = *(const bf16x8*)(Wt + ks * 16), w1 = *(const bf16x8*)(Wt + 32 * 256 + ks * 16);
      acc0 = __builtin_amdgcn_mfma_f32_32x32x16_bf16(w0, zf, acc0, 0, 0, 0);
      acc1 = __builtin_amdgcn_mfma_f32_32x32x16_bf16(w1, zf, acc1, 0, 0, 0);
    }
    bf16_t* dst = MIX + (size_t)t * D + 768 + dg * 64;
#pragma unroll
    for (int g = 0; g < 4; ++g) { *(u32x2*)(dst + 8 * g + 4 * hi) = pack4(acc0, g); *(u32x2*)(dst + 32 + 8 * g + 4 * hi) = pack4(acc1, g); }
    const bf16_t* Pt = (const bf16_t*)(p.ws + OFF_WPOOLT) + ((size_t)(layer * 4 + dg) * 64 + r32) * 64 + hi * 8;
    f32x16 pc0 = {}, pc1 = {};
#pragma unroll
    for (int ks = 0; ks < 4; ++ks) {
      const int chunk = dg * 8 + 2 * ks + hi, sw = (chunk & 16) | ((chunk ^ trow) & 15);
      const bf16x8 pf = *(const LAS bf16x8*)(lds + PC_P + trow * 512 + sw * 16);
      const bf16x8 w0 = *(const bf16x8*)(Pt + ks * 16), w1 = *(const bf16x8*)(Pt + 32 * 64 + ks * 16);
      pc0 = __builtin_amdgcn_mfma_f32_32x32x16_bf16(w0, pf, pc0, 0, 0, 0);
      pc1 = __builtin_amdgcn_mfma_f32_32x32x16_bf16(w1, pf, pc1, 0, 0, 0);
    }
    const float* psc = p.pool_scale + layer * 256 + dg * 64;
#pragma unroll
    for (int r = 0; r < 16; ++r) { pc0[r] *= psc[crow(r, hi)]; pc1[r] *= psc[32 + crow(r, hi)]; }
    bf16_t* pd = MIX + (size_t)t * D + 512 + dg * 64;
#pragma unroll
    for (int g = 0; g < 4; ++g) { *(u32x2*)(pd + 8 * g + 4 * hi) = pack4(pc0, g); *(u32x2*)(pd + 32 + 8 * g + 4 * hi) = pack4(pc1, g); }
  }
  __syncthreads();
}

__device__ __forceinline__ void phase_b(const Params& p, int layer, LAS char* lds, int bid, int nblk) {
  const int mode0 = ((const int*)(p.ws + OFF_FLAG))[0], vbig = ((const int*)(p.ws + OFF_FLAG))[1];
  const int mode = (mode0 == 2 && vbig != 0) ? 1 : mode0;
  const bool fast = mode != 0;
  const int nu = (520 - bid + nblk - 1) / nblk;
  for (int i = 0; i < nu; ++i) {
    const int u = bid + ((bid & 1) ? (nu - 1 - i) : i) * nblk;
    if (u < 256) { if (mode == 2) attn_unit8(p, lds, NCTX + (u >> 2) * 256, u & 3, TT); else if (mode == 1) attn_unit(p, lds, NCTX + (u >> 2) * 256, u & 3, TT); }
    else if (u < 260) { if (layer == 0) { if (mode == 2) attn_unit8(p, lds, 0, u - 256, NCTX); else if (mode == 1) attn_unit(p, lds, 0, u - 256, NCTX); } }
    else { const int tile = u - 260; if (layer == 0 || tile >= 4) poolconv_unit(p, layer, lds, tile); }
  }
  if (!fast) attn_fallback(p, layer, bid, nblk);
}

constexpr int NR = 2, NRA = 2;
__device__ __forceinline__ float hsum4(const f32x4 (&v)[4]) { float s = 0.f;
#pragma unroll
  for (int i = 0; i < 4; ++i) s += (v[i][0] + v[i][1]) + (v[i][2] + v[i][3]);
  return s; }
__device__ __forceinline__ float hsq4(const f32x4 (&v)[4], float mu) { float q = 0.f;
#pragma unroll
  for (int i = 0; i < 4; ++i) { const f32x4 d = v[i] - mu; q += (d[0] * d[0] + d[1] * d[1]) + (d[2] * d[2] + d[3] * d[3]); }
  return q; }
__device__ __forceinline__ f32x4 bf4(u32x2 w) { return (f32x4){__uint_as_float(w[0] << 16), __uint_as_float(w[0] & 0xffff0000u), __uint_as_float(w[1] << 16), __uint_as_float(w[1] & 0xffff0000u)}; }

__device__ __forceinline__ void phase_a0(const Params& p, int layer, int bid, int nblk) {
  const int wave = bid * 8 + (TIDX >> 6), lane = TIDX & 63, nw = nblk * 8;
  float* X = (float*)(p.ws + OFF_X);
  bf16_t* H = (bf16_t*)(p.ws + OFF_H);
  const bf16_t* OM = (const bf16_t*)(p.ws + OFF_OMOE);
  for (int rb = wave * NRA; rb < TT; rb += nw * NRA) {
    f32x4 v[NRA][4]; u32x2 oa[NRA][4], ob[NRA][4];
#pragma unroll
    for (int k = 0; k < NRA; ++k) {
      const int r = rb + k;
      const float* src = layer == 0 ? (r < NCTX ? p.ctx + (size_t)r * D : p.x + (size_t)(r - NCTX) * D) : X + (size_t)r * D;
#pragma unroll
      for (int i = 0; i < 4; ++i) { const int c = i * 256 + lane * 4; v[k][i] = *(const f32x4*)(src + c);
        if (layer != 0) { oa[k][i] = *(const u32x2*)(OM + ((size_t)r * 2 + 0) * D + c); ob[k][i] = *(const u32x2*)(OM + ((size_t)r * 2 + 1) * D + c); } }
    }
    if (layer != 0) {
#pragma unroll
      for (int k = 0; k < NRA; ++k) {
        const int r = rb + k, s = r < NCTX ? 1 : 0;
        const float* g2 = (const float*)(p.ws + OFF_MOD) + ((layer - 1) * 2 + s) * 6144 + 5 * D;
        const float ga = ((const float*)(p.ws + OFF_GATE))[r * 2], gb = ((const float*)(p.ws + OFF_GATE))[r * 2 + 1];
#pragma unroll
        for (int i = 0; i < 4; ++i) { const int c = i * 256 + lane * 4; v[k][i] = v[k][i] * ALPHA + *(const f32x4*)(g2 + c) * (bf4(oa[k][i]) * ga + bf4(ob[k][i]) * gb); }
      }
      float mu[NRA], rs[NRA];
#pragma unroll
      for (int k = 0; k < NRA; ++k) mu[k] = wave_sum(hsum4(v[k])) * (1.f / D);
#pragma unroll
      for (int k = 0; k < NRA; ++k) rs[k] = rsqrtf(wave_sum(hsq4(v[k], mu[k])) * (1.f / D) + EPS);
      const float* g = p.ln2_g + (layer - 1) * D; const float* b = p.ln2_b + (layer - 1) * D;
#pragma unroll
      for (int k = 0; k < NRA; ++k)
#pragma unroll
        for (int i = 0; i < 4; ++i) { const int c = i * 256 + lane * 4; v[k][i] = (v[k][i] - mu[k]) * rs[k] * *(const f32x4*)(g + c) + *(const f32x4*)(b + c); *(f32x4*)(X + (size_t)(rb + k) * D + c) = v[k][i]; }
    }
    float mu[NRA], rs[NRA];
#pragma unroll
    for (int k = 0; k < NRA; ++k) mu[k] = wave_sum(hsum4(v[k])) * (1.f / D);
#pragma unroll
    for (int k = 0; k < NRA; ++k) rs[k] = rsqrtf(wave_sum(hsq4(v[k], mu[k])) * (1.f / D) + EPS);
#pragma unroll
    for (int k = 0; k < NRA; ++k) {
      const int r = rb + k, s = r < NCTX ? 1 : 0;
      const float* modp = (const float*)(p.ws + OFF_MOD) + (layer * 2 + s) * 6144;
#pragma unroll
      for (int i = 0; i < 4; ++i) {
        const int c = i * 256 + lane * 4;
        const f32x4 h = (v[k][i] - mu[k]) * rs[k] * (*(const f32x4*)(modp + D + c) + 1.f) + *(const f32x4*)(modp + c);
        *(u32x2*)(H + (size_t)r * D + c) = (u32x2){cvtpk(h[0], h[1]), cvtpk(h[2], h[3])};
      }
    }
  }
}

__device__ __forceinline__ void phase_c2(const Params& p, int layer, LAS char* lds, int bid, int nblk) {
  const int tid = TIDX, wid = tid >> 6, lane = tid & 63;
  float* X = (float*)(p.ws + OFF_X);
  const bf16_t* Y = (const bf16_t*)(p.ws + OFF_Y);
  bf16_t* H2 = (bf16_t*)(p.ws + OFF_MIX);
  int* cnt = (int*)(p.ws + OFF_CNT) + layer * NE * CNT_STRIDE;
  float* GATE = (float*)(p.ws + OFF_GATE); int* LIST = (int*)(p.ws + OFF_LIST);
  LAS int* lcnt = (LAS int*)lds;
  LAS int* lbase = lcnt + 32;
  LAS int* ent = lcnt + 64;
  if (tid < 32) lcnt[tid] = 0;
  LAS float* wre = (LAS float*)(lds + 4096);
#pragma unroll
  for (int kk = 0; kk < 2; ++kk) {
    const int k = tid + kk * 512;
    f32x4 w[8];
#pragma unroll
    for (int g = 0; g < 8; ++g) w[g] = *(const f32x4*)(p.w_re + ((size_t)layer * D + k) * 32 + g * 4);
#pragma unroll
    for (int g = 0; g < 8; ++g)
#pragma unroll
      for (int j = 0; j < 4; ++j) wre[(g * 4 + j) * 1024 + k] = w[g][j];
  }
  __syncthreads();
  const int r0 = layer == 0 ? 0 : NCTX, nrows = TT - r0, rpb = (nrows + nblk - 1) / nblk;
  const int rbeg = r0 + bid * rpb, rend = min(rbeg + rpb, TT);
  for (int rb = rbeg + wid * NR; rb < rend; rb += 8 * NR) {
    f32x4 v[NR][4]; u32x2 yv[NR][4]; int rr[NR]; bool ok[NR];
#pragma unroll
    for (int k = 0; k < NR; ++k) {
      ok[k] = rb + k < rend; rr[k] = ok[k] ? rb + k : rb;
      const int r = rr[k];
      const float* xin = layer == 0 ? (r < NCTX ? p.ctx + (size_t)r * D : p.x + (size_t)(r - NCTX) * D) : X + (size_t)r * D;
#pragma unroll
      for (int i = 0; i < 4; ++i) { const int c = i * 256 + lane * 4; v[k][i] = *(const f32x4*)(xin + c); yv[k][i] = *(const u32x2*)(Y + (size_t)r * D + c); }
    }
#pragma unroll
    for (int k = 0; k < NR; ++k) {
      const float* modp = (const float*)(p.ws + OFF_MOD) + (layer * 2 + (rr[k] < NCTX ? 1 : 0)) * 6144;
#pragma unroll
      for (int i = 0; i < 4; ++i) { const int c = i * 256 + lane * 4; v[k][i] = v[k][i] * ALPHA + *(const f32x4*)(modp + 2 * D + c) * bf4(yv[k][i]); }
    }
    float mu[NR], rs[NR];
#pragma unroll
    for (int k = 0; k < NR; ++k) mu[k] = wave_sum(hsum4(v[k])) * (1.f / D);
#pragma unroll
    for (int k = 0; k < NR; ++k) rs[k] = rsqrtf(wave_sum(hsq4(v[k], mu[k])) * (1.f / D) + EPS);
#pragma unroll
    for (int k = 0; k < NR; ++k)
#pragma unroll
      for (int i = 0; i < 4; ++i) {
        const int c = i * 256 + lane * 4;
        v[k][i] = (v[k][i] - mu[k]) * rs[k] * *(const f32x4*)(p.ln1_g + layer * D + c) + *(const f32x4*)(p.ln1_b + layer * D + c);
        if (ok[k]) *(f32x4*)(X + (size_t)rr[k] * D + c) = v[k][i];
      }
#pragma unroll
    for (int k = 0; k < NR; ++k) mu[k] = wave_sum(hsum4(v[k])) * (1.f / D);
#pragma unroll
    for (int k = 0; k < NR; ++k) rs[k] = rsqrtf(wave_sum(hsq4(v[k], mu[k])) * (1.f / D) + EPS);
#pragma unroll
    for (int k = 0; k < NR; ++k) {
      const float* modp = (const float*)(p.ws + OFF_MOD) + (layer * 2 + (rr[k] < NCTX ? 1 : 0)) * 6144;
#pragma unroll
      for (int i = 0; i < 4; ++i) {
        const int c = i * 256 + lane * 4;
        v[k][i] = (v[k][i] - mu[k]) * rs[k] * (*(const f32x4*)(modp + 4 * D + c) + 1.f) + *(const f32x4*)(modp + 3 * D + c);
        if (ok[k]) *(u32x2*)(H2 + (size_t)rr[k] * D + c) = (u32x2){cvtpk(v[k][i][0], v[k][i][1]), cvtpk(v[k][i][2], v[k][i][3])};
      }
    }
    f32x4 lg[NR];
#pragma unroll
    for (int k = 0; k < NR; ++k) lg[k] = (f32x4){0.f, 0.f, 0.f, 0.f};
#pragma unroll
    for (int i = 0; i < 4; ++i)
#pragma unroll
      for (int j = 0; j < 4; ++j) { const f32x4 w = *(const f32x4*)(p.w_rg + ((size_t)layer * D + i * 256 + lane * 4 + j) * 4);
#pragma unroll
        for (int k = 0; k < NR; ++k) lg[k] += w * v[k][i][j]; }
    int gsel[NR]; float pgrp[NR];
#pragma unroll
    for (int k = 0; k < NR; ++k) {
      float l0 = wave_sum(lg[k][0]) + p.b_rg[layer * 4 + 0], l1 = wave_sum(lg[k][1]) + p.b_rg[layer * 4 + 1];
      float l2 = wave_sum(lg[k][2]) + p.b_rg[layer * 4 + 2], l3 = wave_sum(lg[k][3]) + p.b_rg[layer * 4 + 3];
      int gs = 0; float gm = l0;
      if (l1 > gm) { gm = l1; gs = 1; }
      if (l2 > gm) { gm = l2; gs = 2; }
      if (l3 > gm) { gm = l3; gs = 3; }
      gsel[k] = gs; pgrp[k] = 1.f / (__expf(l0 - gm) + __expf(l1 - gm) + __expf(l2 - gm) + __expf(l3 - gm));
    }
#pragma unroll
    for (int k = 0; k < NR; ++k) {
      float le[8];
#pragma unroll
      for (int e = 0; e < 8; ++e) {
        const LAS float* wr = wre + (gsel[k] * 8 + e) * 1024 + lane * 4;
        float a = 0.f;
#pragma unroll
        for (int i = 0; i < 4; ++i) { const f32x4 w = *(const LAS f32x4*)(wr + i * 256); a += (w[0] * v[k][i][0] + w[1] * v[k][i][1]) + (w[2] * v[k][i][2] + w[3] * v[k][i][3]); }
        le[e] = a;
      }
#pragma unroll
      for (int e = 0; e < 8; ++e) le[e] = wave_sum(le[e]) + p.b_re[layer * 32 + gsel[k] * 8 + e];
      int i0 = 0; float v0 = le[0];
#pragma unroll
      for (int e = 1; e < 8; ++e) if (le[e] > v0) { v0 = le[e]; i0 = e; }
      int i1 = -1; float v1 = -3.0e38f;
#pragma unroll
      for (int e = 0; e < 8; ++e) if (e != i0 && le[e] > v1) { v1 = le[e]; i1 = e; }
      if (i1 < 0) { i1 = (i0 + 1) & 7; v1 = v0; }
      const float e1 = __expf(v1 - v0);
      if (lane == 0 && ok[k]) {
        const int r = rr[k], xa = gsel[k] * 8 + i0, xb = gsel[k] * 8 + i1;
        const int pa = __hip_atomic_fetch_add(&lcnt[xa], 1, __ATOMIC_RELAXED, __HIP_MEMORY_SCOPE_WORKGROUP);
        const int pb = __hip_atomic_fetch_add(&lcnt[xb], 1, __ATOMIC_RELAXED, __HIP_MEMORY_SCOPE_WORKGROUP);
        const int li = (r - rbeg) * 2;
        ent[li * 3 + 0] = xa; ent[li * 3 + 1] = pa; ent[li * 3 + 2] = r * 2 + 0;
        ent[li * 3 + 3] = xb; ent[li * 3 + 4] = pb; ent[li * 3 + 5] = r * 2 + 1;
        GATE[r * 2] = pgrp[k] / (1.f + e1); GATE[r * 2 + 1] = pgrp[k] * e1 / (1.f + e1);
      }
    }
  }
  __syncthreads();
  if (tid < 32) { const int c = lcnt[tid]; lbase[tid] = c > 0 ? atomicAdd(&cnt[tid * CNT_STRIDE], c) : 0; }
  __syncthreads();
  for (int i = tid; i < (rend - rbeg) * 2; i += 512) { const int e = ent[i * 3], lp = ent[i * 3 + 1]; LIST[(size_t)e * CAPL + lbase[e] + lp] = ent[i * 3 + 2]; }
  __syncthreads();
}

__device__ __forceinline__ void phase_final(const Params& p, int bid, int nblk) {
  const int wave = bid * 8 + (TIDX >> 6), lane = TIDX & 63, nw = nblk * 8;
  const float* X = (const float*)(p.ws + OFF_X);
  const bf16_t* OM = (const bf16_t*)(p.ws + OFF_OMOE);
  const float* g2 = (const float*)(p.ws + OFF_MOD) + (1 * 2 + 0) * 6144 + 5 * D;
  for (int rb = NCTX + wave * NRA; rb < TT; rb += nw * NRA) {
    f32x4 v[NRA][4]; u32x2 oa[NRA][4], ob[NRA][4];
#pragma unroll
    for (int k = 0; k < NRA; ++k)
#pragma unroll
      for (int i = 0; i < 4; ++i) { const int c = i * 256 + lane * 4, r = rb + k;
        v[k][i] = *(const f32x4*)(X + (size_t)r * D + c); oa[k][i] = *(const u32x2*)(OM + ((size_t)r * 2 + 0) * D + c); ob[k][i] = *(const u32x2*)(OM + ((size_t)r * 2 + 1) * D + c); }
#pragma unroll
    for (int k = 0; k < NRA; ++k) {
      const float ga = ((const float*)(p.ws + OFF_GATE))[(rb + k) * 2], gb = ((const float*)(p.ws + OFF_GATE))[(rb + k) * 2 + 1];
#pragma unroll
      for (int i = 0; i < 4; ++i) { const int c = i * 256 + lane * 4; v[k][i] = v[k][i] * ALPHA + *(const f32x4*)(g2 + c) * (bf4(oa[k][i]) * ga + bf4(ob[k][i]) * gb); }
    }
    float mu[NRA], rs[NRA];
#pragma unroll
    for (int k = 0; k < NRA; ++k) mu[k] = wave_sum(hsum4(v[k])) * (1.f / D);
#pragma unroll
    for (int k = 0; k < NRA; ++k) rs[k] = rsqrtf(wave_sum(hsq4(v[k], mu[k])) * (1.f / D) + EPS);
#pragma unroll
    for (int k = 0; k < NRA; ++k)
#pragma unroll
      for (int i = 0; i < 4; ++i) {
        const int c = i * 256 + lane * 4;
        *(f32x4*)(p.out + (size_t)(rb + k - NCTX) * D + c) = (v[k][i] - mu[k]) * rs[k] * *(const f32x4*)(p.ln2_g + D + c) + *(const f32x4*)(p.ln2_b + D + c);
      }
  }
}

__device__ __forceinline__ void phase_p0(const Params& p, LAS char* lds, int bid, int nblk) {
  const int tid = TIDX;
  const long gtid = (long)bid * 512 + tid, gth = (long)nblk * 512;
  LAS float* sc = (LAS float*)lds;
  LAS float* red = (LAS float*)(lds + 8192);
  for (int i = tid; i < 2048; i += 512) { const float v = i < 1024 ? p.c[i] : p.c_ctx[i - 1024]; sc[i] = silu(v); }
  __syncthreads();
  float* mod = (float*)(p.ws + OFF_MOD);
  for (int u = bid; u < 384; u += nblk) {
    const int layer = u / 192, cg = u % 192, col = tid & 31, ksl = tid >> 5;
    const float* w = p.w_mod + ((size_t)layer * D + ksl * 64) * 6144 + cg * 32 + col;
    float a0 = 0.f, a1 = 0.f;
#pragma unroll 8
    for (int k = 0; k < 64; ++k) { const float wv = w[(size_t)k * 6144]; a0 += sc[ksl * 64 + k] * wv; a1 += sc[1024 + ksl * 64 + k] * wv; }
    red[(ksl * 32 + col) * 2] = a0; red[(ksl * 32 + col) * 2 + 1] = a1;
    __syncthreads();
    if (tid < 64) {
      const int c2 = tid & 31, s = tid >> 5; float a = 0.f;
#pragma unroll
      for (int k = 0; k < 16; ++k) a += red[(k * 32 + c2) * 2 + s];
      mod[(layer * 2 + s) * 6144 + cg * 32 + c2] = a + p.b_mod[layer * 6144 + cg * 32 + c2];
    }
    __syncthreads();
  }
  if (gtid < 256 * 16) {
    const int pos = (int)gtid / 16, f = (int)gtid % 16;
    const float ang = (float)pos * powf(10000.f, -(float)f / 16.f);
    float* rt = (float*)(p.ws + OFF_ROPE);
    rt[gtid * 2 + 0] = cosf(ang); rt[gtid * 2 + 1] = sinf(ang);
  }
  if (gtid < 2 * NE * CNT_STRIDE) ((int*)(p.ws + OFF_CNT))[gtid] = 0;
  if (gtid == 0) {
    float bmax = 0.f;
    for (int l = 0; l < 2; ++l) {
      float gq = 0.f, gk = 0.f;
      for (int i = 0; i < 64; ++i) { gq = fmaxf(gq, fabsf(p.q_gain[l * 64 + i])); gk = fmaxf(gk, fabsf(p.k_gain[l * 64 + i])); }
      bmax = fmaxf(bmax, 11.55f * gq * gk);
    }
    ((int*)(p.ws + OFF_FLAG))[0] = bmax <= 13.2f ? 2 : (bmax <= 100.f ? 1 : 0);
    ((int*)(p.ws + OFF_FLAG))[1] = 0;
  }
  for (long i = gtid; i < 2 * 65536; i += gth) { const int l = (int)(i >> 16), d = (int)(i >> 8) & 255, c = (int)i & 255; ((bf16_t*)(p.ws + OFF_WPWT))[i] = f2bf(p.w_cv_pw[((size_t)l * 256 + c) * 256 + d]); }
  for (long i = gtid; i < 8 * 4096; i += gth) { const int lg = (int)(i >> 12), d = (int)(i >> 6) & 63, c = (int)i & 63; ((bf16_t*)(p.ws + OFF_WPOOLT))[i] = f2bf(p.w_pool[((size_t)lg * 64 + c) * 64 + d]); }
  cvt_range(p.w_in, (bf16_t*)(p.ws + OFF_WIN), 2L * D * INW / 8, gtid, gth);
  cvt_range(p.w_out, (bf16_t*)(p.ws + OFF_WOUT), 2L * D * D / 8, gtid, gth);
}
#define XB_TMO      128
#define XB_XCNT(j)  (256  + 64 * (j))
#define XB_XSUB(j)  (1280 + 64 * (j))
#define XB_XGEN(j)  (2304 + 64 * (j))
#define XB_TOP      3328
#define XB_TOPGEN   3392
#define XCD_BAR_WORDS 3456
#define XB_SPIN_CAP (1u << 22)
__device__ __forceinline__ unsigned xb_ld(unsigned* p)              { return __hip_atomic_load(p, __ATOMIC_RELAXED, __HIP_MEMORY_SCOPE_AGENT); }
__device__ __forceinline__ unsigned xb_add(unsigned* p, unsigned v) { return __hip_atomic_fetch_add(p, v, __ATOMIC_RELAXED, __HIP_MEMORY_SCOPE_AGENT); }
__device__ __forceinline__ unsigned xb_xcc_id() { return (unsigned)__builtin_amdgcn_s_getreg((3 << 11) | 20) & 0xFu; }
#define XB_SPIN(cond, bar) do { unsigned _sp = 0; while (cond) { __builtin_amdgcn_s_sleep(1); \
    if ((++_sp & 255u) == 0u) { if (xb_ld(&(bar)[XB_TMO])) break; if (_sp > XB_SPIN_CAP) { atomicAdd(&(bar)[XB_TMO], 1u); break; } } } } while (0)
struct XcdBarrier { unsigned* bar; unsigned x; volatile LAS unsigned* st; };
__device__ __forceinline__ XcdBarrier xcd_barrier_post(unsigned* bar, volatile LAS unsigned* st) {
  XcdBarrier b; b.bar = bar; b.x = xb_xcc_id(); b.st = st;
  if (threadIdx.x == 0) (void)xb_add(&bar[XB_XCNT(b.x)], 1u);
  return b;
}
__device__ __forceinline__ void xcd_barrier_complete(unsigned* bar, unsigned x, unsigned& nloc, unsigned& nx) {
  const unsigned G = gridDim.x * gridDim.y * gridDim.z;
  unsigned sum, cnt, mine, sp = 0u;
  for (;;) {
    sum = 0u; cnt = 0u; mine = 0u;
#pragma unroll
    for (unsigned j = 0; j < 16; ++j) { const unsigned c = xb_ld(&bar[XB_XCNT(j)]); sum += c; cnt += (c > 0u) ? 1u : 0u; mine = (j == x) ? c : mine; }
    if (sum == G) break;
    __builtin_amdgcn_s_sleep(1);
    if ((++sp & 255u) == 0u) { if (xb_ld(&bar[XB_TMO])) break; if (sp > XB_SPIN_CAP) { atomicAdd(&bar[XB_TMO], 1u); break; } }
  }
  nloc = mine > 0u ? mine : 1u; nx = cnt > 0u ? cnt : 1u;
}
__device__ __forceinline__ void xcd_barrier(const XcdBarrier& b) {
  asm volatile("s_waitcnt vmcnt(0)" ::: "memory");
  __syncthreads();
  if (threadIdx.x == 0) {
    unsigned* bar = b.bar; unsigned bx = b.x;
    asm volatile("" : "+s"(bar), "+s"(bx));
    __builtin_amdgcn_s_waitcnt(0);
    unsigned nloc = b.st[0], nx = b.st[1];
    if (nloc == 0u) { xcd_barrier_complete(bar, bx, nloc, nx); b.st[0] = nloc; b.st[1] = nx; }
    const unsigned old = xb_add(&bar[XB_XSUB(bx)], 1u);
    const unsigned gen = old / nloc;
    if (old + 1u == (gen + 1u) * nloc) {
      __builtin_amdgcn_fence(__ATOMIC_RELEASE, "agent");
      asm volatile("s_waitcnt vmcnt(0)" ::: "memory");
      const unsigned og = xb_add(&bar[XB_TOP], 1u);
      const unsigned tg = og / nx;
      if (og + 1u == (tg + 1u) * nx) xb_add(&bar[XB_TOPGEN], 1u);
      else XB_SPIN(xb_ld(&bar[XB_TOPGEN]) == tg, bar);
      __builtin_amdgcn_fence(__ATOMIC_ACQUIRE, "agent");
      xb_add(&bar[XB_XGEN(bx)], 1u);
      asm volatile("s_waitcnt vmcnt(0)" ::: "memory");
    } else {
      XB_SPIN(xb_ld(&bar[XB_XGEN(bx)]) == gen, bar);
      __builtin_amdgcn_fence(__ATOMIC_ACQUIRE, "agent");
      asm volatile("s_waitcnt vmcnt(0)" ::: "memory");
    }
  }
  __syncthreads();
}

constexpr int LDS_MAIN = PC_LDS > GEMM_LDS + 512 ? PC_LDS : GEMM_LDS + 512;
constexpr int LDS_TOTAL = LDS_MAIN + 16;
static_assert(GEMM_LDS + 512 <= LDS_MAIN && ATT_LDS <= LDS_MAIN, "lds");
__global__ void __launch_bounds__(512) mega_fwd(Params p) {
  __shared__ __attribute__((aligned(16))) char slds[LDS_TOTAL];
  LAS char* lds = (LAS char*)slds;
  volatile LAS unsigned* st = (volatile LAS unsigned*)(lds + LDS_MAIN);
  if (threadIdx.x < 4) st[threadIdx.x] = 0u;
  __syncthreads();
  const XcdBarrier bar = xcd_barrier_post((unsigned*)(p.ws + OFF_BAR), st);
  const int bid = blockIdx.x, nblk = gridDim.x;
  phase_p0(p, lds, bid, nblk);
  xcd_barrier(bar);
#pragma unroll 1
  for (int layer = 0; layer < 2; ++layer) {
    phase_a0(p, layer, bid, nblk);
    xcd_barrier(bar);
    phase_a1(p, layer, lds, bid, nblk);
    xcd_barrier(bar);
    phase_b(p, layer, lds, bid, nblk);
    xcd_barrier(bar);
    phase_c1(p, layer, lds, bid, nblk);
    xcd_barrier(bar);
    phase_c2(p, layer, lds, bid, nblk);
    xcd_barrier(bar);
    phase_d1(p, layer, lds, bid, nblk);
    xcd_barrier(bar);
    phase_d2(p, layer, lds, bid, nblk);
    xcd_barrier(bar);
  }
  phase_final(p, bid, nblk);
}

extern "C" void kernel_launch(void* const* d_in, const int* in_sizes, int n_in, void* d_out, int out_size, void* d_ws, size_t ws_size,
                              hipStream_t stream) {
  static int grid = 0;
  if (grid == 0) {
    if (ws_size < WS_END || n_in != 28) { fprintf(stderr, "kernel_launch: ws too small (%zu < %zu) or n_in %d != 28; nothing launched\n", ws_size, (size_t)WS_END, n_in); grid = -1; return; }
    int dev = 0, cus = 0, per_cu = 0;
    if (hipGetDevice(&dev) != hipSuccess || hipDeviceGetAttribute(&cus, hipDeviceAttributeMultiprocessorCount, dev) != hipSuccess) { grid = -1; return; }
    if (hipOccupancyMaxActiveBlocksPerMultiprocessor(&per_cu, (const void*)mega_fwd, 512, 0) != hipSuccess || per_cu < 1) {
      fprintf(stderr, "kernel_launch: occupancy query says %d blocks per CU; nothing launched\n", per_cu); grid = -1; return; }
    (void)hipGetLastError();
    grid = cus;
  }
  if (grid < 0) return;
  if (hipMemsetAsync((char*)d_ws + OFF_BAR, 0, BAR_BYTES, stream) != hipSuccess) { fprintf(stderr, "kernel_launch: memset failed\n"); return; }
  Params p{};
  const float** f = (const float**)&p;
  for (int i = 0; i < 28; ++i) f[i] = (const float*)d_in[i];
  p.out = (float*)d_out; p.ws = (char*)d_ws;
  hipLaunchKernelGGL(mega_fwd, dim3(grid), dim3(512), 0, stream, p);
}
```

```cpp
#include <hip/hip_runtime.h>
#include <cstdio>
#include <cstdint>

typedef unsigned short bf16_t;
#define LAS __attribute__((address_space(3)))

constexpr int D = 1024, SEQ = 16384, NCTX = 256, TT = SEQ + NCTX;
constexpr int INW = 1536;
constexpr int NE = 32, DE = 512;
constexpr int CAPL = 2 * TT;
constexpr int HMID_ROWS = 2 * TT + NE * 128;
constexpr float ALPHA = 1.41421356237309515f;
constexpr float EPS = 1e-6f;

constexpr size_t al(size_t x) { return (x + 255) / 256 * 256; }
constexpr size_t OFF_BAR = 0;
constexpr size_t BAR_BYTES = 3456 * 4;
constexpr size_t OFF_MOD = OFF_BAR + al(BAR_BYTES);
constexpr size_t OFF_ROPE = OFF_MOD + al(2 * 2 * 6144 * 4);
constexpr int CNT_STRIDE = 32;
constexpr size_t OFF_CNT = OFF_ROPE + al(256 * 16 * 2 * 4);
constexpr size_t OFF_FLAG = OFF_CNT + al(2 * 32 * 32 * 4);
constexpr size_t OFF_X = OFF_FLAG + 256;
constexpr size_t OFF_H = OFF_X + al((size_t)TT * D * 4);
constexpr size_t OFF_MIX = OFF_H + al((size_t)TT * D * 2);
constexpr size_t OFF_Y = OFF_MIX + al((size_t)TT * D * 2);
constexpr size_t OFF_Q = OFF_Y + al((size_t)TT * D * 2);
constexpr size_t OFF_K = OFF_Q + al((size_t)TT * 512 * 2);
constexpr size_t OFF_V = OFF_K + al((size_t)TT * 128 * 2);
constexpr size_t OFF_U = OFF_V + al((size_t)TT * 128 * 2);
constexpr size_t OFF_AG = OFF_U + al((size_t)TT * 256 * 4);
constexpr size_t OFF_HMID = OFF_Q;
constexpr size_t OFF_OMOE = OFF_AG + al((size_t)TT * 512 * 2);
constexpr size_t OFF_GATE = OFF_OMOE + al((size_t)TT * 2 * D * 2);
constexpr size_t OFF_LIST = OFF_GATE + al((size_t)TT * 2 * 4);
constexpr size_t OFF_WIN = OFF_LIST + al((size_t)NE * CAPL * 4);
constexpr size_t OFF_WOUT = OFF_WIN + al((size_t)2 * D * INW * 2);
constexpr size_t OFF_WPWT = OFF_WOUT + al((size_t)2 * D * D * 2);
constexpr size_t OFF_WPOOLT = OFF_WPWT + al((size_t)2 * 256 * 256 * 2);
constexpr size_t OFF_Q8 = OFF_WPOOLT + al((size_t)2 * 4 * 64 * 64 * 2);
constexpr size_t OFF_K8 = OFF_Q8 + al((size_t)TT * 512);
constexpr size_t OFF_VT8 = OFF_K8 + al((size_t)TT * 128);
constexpr size_t OFF_WG = OFF_VT8 + al((size_t)128 * TT);
constexpr size_t OFF_WU = OFF_WG + al((size_t)2 * NE * D * DE * 2);
constexpr size_t OFF_WD = OFF_WU + al((size_t)2 * NE * D * DE * 2);
constexpr size_t WS_END = OFF_WD + al((size_t)2 * NE * D * DE * 2);
static_assert(OFF_AG - OFF_HMID >= (size_t)HMID_ROWS * DE * 2, "HMID alias too small");
static_assert(WS_END < 530000000, "ws budget");

struct Params {
  const float *x, *c, *ctx, *c_ctx, *w_mod, *b_mod, *w_in, *q_gain, *k_gain, *w_pool, *pool_scale, *w_dw, *b_dw,
      *cv_ln_g, *cv_ln_b, *w_cv_pw, *w_out, *ln1_g, *ln1_b, *ln2_g, *ln2_b, *w_rg, *b_rg, *w_re, *b_re, *w_e_gate, *w_e_up, *w_e_down;
  float* out;
  char* ws;
};

__device__ __forceinline__ float bf2f(bf16_t v) { return __uint_as_float(((unsigned)v) << 16); }
__device__ __forceinline__ bf16_t f2bf(float f) {
  unsigned u = __float_as_uint(f);
  u += 0x7fffu + ((u >> 16) & 1u);
  return (bf16_t)(u >> 16);
}
template <int CTRL> __device__ __forceinline__ float dppf(float v) { return __int_as_float(__builtin_amdgcn_update_dpp(0, __float_as_int(v), CTRL, 0xf, 0xf, true)); }
__device__ __forceinline__ float wave_sum(float v) {
  v += dppf<0xB1>(v); v += dppf<0x4E>(v); v += dppf<0x141>(v); v += dppf<0x140>(v);
  { auto r = __builtin_amdgcn_permlane16_swap(__float_as_uint(v), __float_as_uint(v), false, false); v = __uint_as_float(r[0]) + __uint_as_float(r[1]); }
  { auto r = __builtin_amdgcn_permlane32_swap(__float_as_uint(v), __float_as_uint(v), false, false); v = __uint_as_float(r[0]) + __uint_as_float(r[1]); }
  return v;
}
__device__ __forceinline__ float silu(float v) { return v / (1.f + __expf(-v)); }
__device__ __forceinline__ int opaque0() { int z; asm volatile("s_mov_b32 %0, 0" : "=s"(z)); return z; }
#define TIDX ((int)threadIdx.x + opaque0())
using bf16x8 = __attribute__((ext_vector_type(8))) short;
using s16x4 = __attribute__((ext_vector_type(4))) short;
using f32x16 = __attribute__((ext_vector_type(16))) float;
using f32x4 = __attribute__((ext_vector_type(4))) float;
using u32x4 = __attribute__((ext_vector_type(4))) unsigned;
using u32x2 = __attribute__((ext_vector_type(2))) unsigned;

__device__ __forceinline__ int crow(int r, int hi) { return (r & 3) + 8 * (r >> 2) + 4 * hi; }
typedef float f32x2 __attribute__((ext_vector_type(2)));
typedef __bf16 bf16x2v __attribute__((ext_vector_type(2)));
__device__ __forceinline__ unsigned cvtpk(float lo, float hi) {
  bf16x2v b = __builtin_convertvector((f32x2){lo, hi}, bf16x2v);
  return __builtin_bit_cast(unsigned, b);
}
__device__ __forceinline__ float sum32(float v) {
  auto rr = __builtin_amdgcn_permlane32_swap(__float_as_uint(v), __float_as_uint(v), false, false);
  return __uint_as_float(rr[0]) + __uint_as_float(rr[1]);
}

__device__ __forceinline__ void cvt_range(const float* __restrict__ src, bf16_t* __restrict__ dst, long n8, long gtid, long gthreads) {
  for (long i = gtid; i < n8; i += gthreads) {
    const f32x4 a = *(const f32x4*)(src + i * 8), b = *(const f32x4*)(src + i * 8 + 4);
    u32x4 w = {cvtpk(a[0], a[1]), cvtpk(a[2], a[3]), cvtpk(b[0], b[1]), cvtpk(b[2], b[3])};
    *(u32x4*)(dst + i * 8) = w;
  }
}

__device__ __forceinline__ int xoff(int row, int chunk) { return row * 128 + ((chunk ^ ((row >> 1) & 7)) << 4); }
__device__ __forceinline__ int wst(int k, int c) { const int kk = (k & ~0xC) | ((k & 4) << 1) | ((k & 8) >> 1); return ((kk >> 3) * 4 + (c >> 5)) * 512 + ((kk & 7) * 32 + (c & 31)) * 2; }
__device__ __forceinline__ int v_rd_base(int lane) { return ((lane & 3) << 3) | (((lane >> 2) & 3) << 6) | (((lane >> 4) & 1) << 5) | (((lane >> 5) & 1) << 8); }

__device__ __forceinline__ bf16x8 tr_frag(const LAS char* p) {
  s16x4 a = __builtin_amdgcn_ds_read_tr16_b64_v4i16((LAS s16x4*)p);
  s16x4 b = __builtin_amdgcn_ds_read_tr16_b64_v4i16((LAS s16x4*)(p + 2048));
  return (bf16x8){a[0], a[1], a[2], a[3], b[0], b[1], b[2], b[3]};
}

template <int OFF> __device__ __forceinline__ bf16x8 tr_frag_asm(int addr) {
  s16x4 a, b;
  asm volatile("ds_read_b64_tr_b16 %0, %1 offset:%2" : "=&v"(a) : "v"(addr), "i"(OFF) : "memory");
  asm volatile("ds_read_b64_tr_b16 %0, %1 offset:%2" : "=&v"(b) : "v"(addr), "i"(OFF + 2048) : "memory");
  return (bf16x8){a[0], a[1], a[2], a[3], b[0], b[1], b[2], b[3]};
}

template <int BM, int BN> struct GemmCfg {
  static constexpr int WM = BM / 64, WN = 8 / WM, NSLAB = BN / 128, XB = BM * 128, WB = NSLAB * 16384, STAGE = XB + WB, NXP = BM / 64, NWP = NSLAB * 2;
  static_assert(WM * WN == 8 && WN * 64 == BN, "tile");
};
constexpr int GEMM_LDS = 3 * (256 * 128 + 16384);

template <int BM, int BN, int NMAP, bool BG = false, class XRow, class WPtr, class Pre>
__device__ __forceinline__ void gemm_mainloop(LAS char* lds, f32x16 (&acc)[2][2], const XRow& xrow, const WPtr& wptr, const Pre& pre, int sprev, int ldw, int K, int& bgdone, int bgn = 0, long bgc0 = 0,
                                              const float* bs0 = nullptr, const float* bs1 = nullptr, const float* bs2 = nullptr, bf16_t* bd0 = nullptr, bf16_t* bd1 = nullptr, bf16_t* bd2 = nullptr) {
#define BG_ADDR(i, off, SP, DP) long c_ = bgc0 + (long)(i) * 512 + (off); const bool ok_ = c_ < (3L << 21); if (!ok_) c_ = 0; const int t_ = (int)(c_ >> 21); const long o_ = (c_ & 0x1fffff) * 8; \
    const float* SP = (t_ == 0 ? bs0 : (t_ == 1 ? bs1 : bs2)) + o_; bf16_t* DP = (t_ == 0 ? bd0 : (t_ == 1 ? bd1 : bd2)) + o_
#define BG_ISSUE(i, off, a, b) do { BG_ADDR(i, off, sp_, dp_); (void)dp_; a = *(const f32x4*)sp_; b = *(const f32x4*)(sp_ + 4); } while (0)
#define BG_RETIRE(i, off, a, b) do { BG_ADDR(i, off, sp_, dp_); (void)sp_; if (ok_) *(u32x4*)dp_ = (u32x4){cvtpk(a[0], a[1]), cvtpk(a[2], a[3]), cvtpk(b[0], b[1]), cvtpk(b[2], b[3])}; } while (0)
#define BGA_ISSUE(i, off, a, b) do { BG_ADDR(i, off, sp_, dp_); (void)dp_; \
    asm volatile("global_load_dwordx4 %0, %2, off\n\tglobal_load_dwordx4 %1, %2, off offset:16" : "=&v"(a), "=&v"(b) : "v"(sp_) : "memory"); } while (0)
#define BGA_RETIRE(i, off, a, b) do { BG_ADDR(i, off, sp_, dp_); (void)sp_; const u32x4 w_ = {cvtpk(a[0], a[1]), cvtpk(a[2], a[3]), cvtpk(b[0], b[1]), cvtpk(b[2], b[3])}; \
    if (ok_) asm volatile("global_store_dwordx4 %0, %1, off" :: "v"(dp_), "v"(w_) : "memory"); } while (0)
  using C = GemmCfg<BM, BN>;
  const int tid = TIDX, wid = __builtin_amdgcn_readfirstlane(tid >> 6), lane = tid & 63, r32 = lane & 31, hi = lane >> 5;
  const int wm = wid / C::WN, wn = wid % C::WN;
  const bf16_t *g0, *g1, *g2, *g3, *g4, *g5, *g6 = nullptr, *g7 = nullptr, *g8 = nullptr, *g9 = nullptr, *g10 = nullptr, *g11 = nullptr;
  int l0, l1, l2, l3, l4, l5, l6 = 0, l7 = 0, l8 = 0, l9 = 0, l10 = 0, l11 = 0;
  auto xpieceq = [&](int q, const bf16_t*& gp, int& lp) { const int row = 8 * q + (lane >> 3), c = (lane & 7) ^ ((row >> 1) & 7); gp = xrow(row) + c * 8; lp = q * 1024; };
  auto wpieceq = [&](int idx, const bf16_t*& gp, int& lp) {
    const int s = idx >> 4, q = idx & 15, sub = 2 * q + (lane >> 5), kk = (sub >> 2) * 8 + ((lane & 31) >> 2);
    const int k = (kk & ~0xC) | ((kk & 4) << 1) | ((kk & 8) >> 1), c = (sub & 3) * 32 + (lane & 3) * 8;
    gp = wptr(s) + (size_t)k * ldw + c; lp = C::XB + s * 16384 + q * 1024; };
  const size_t stepx = 64, stepw = (size_t)64 * ldw;
  if (BG) {
    const int w4 = wid & 3;
    xpieceq(w4 * 8 + 0, g0, l0); xpieceq(w4 * 8 + 1, g1, l1); xpieceq(w4 * 8 + 2, g2, l2); xpieceq(w4 * 8 + 3, g3, l3);
    xpieceq(w4 * 8 + 4, g4, l4); xpieceq(w4 * 8 + 5, g5, l5); xpieceq(w4 * 8 + 6, g6, l6); xpieceq(w4 * 8 + 7, g7, l7);
    wpieceq(w4 * 4 + 0, g8, l8); wpieceq(w4 * 4 + 1, g9, l9); wpieceq(w4 * 4 + 2, g10, l10); wpieceq(w4 * 4 + 3, g11, l11);
  } else if (C::NXP == 4) { xpieceq(wid * 4 + 0, g0, l0); xpieceq(wid * 4 + 1, g1, l1); xpieceq(wid * 4 + 2, g2, l2); xpieceq(wid * 4 + 3, g3, l3); wpieceq(wid * 2 + 0, g4, l4); wpieceq(wid * 2 + 1, g5, l5); }
  else { xpieceq(wid * 2 + 0, g0, l0); xpieceq(wid * 2 + 1, g1, l1); wpieceq(wid * 4 + 0, g2, l2); wpieceq(wid * 4 + 1, g3, l3); wpieceq(wid * 4 + 2, g4, l4); wpieceq(wid * 4 + 3, g5, l5); }
  const size_t stp0 = stepx, stp1 = stepx, stp2 = (BG || C::NXP == 4) ? stepx : stepw, stp3 = (BG || C::NXP == 4) ? stepx : stepw, stp4 = BG ? stepx : stepw, stp5 = BG ? stepx : stepw;
  const bool dmaw = !BG || wid < 4;
  int xr[2];
#pragma unroll
  for (int ti = 0; ti < 2; ++ti) xr[ti] = (wm * 64 + ti * 32 + r32) * 128;
  const int xsw = (r32 >> 1) & 7;
  int wr[2];
#pragma unroll
  for (int ni = 0; ni < 2; ++ni) {
    const int slab = NMAP == 0 ? 0 : (NMAP == 1 ? (wn >> 1) : ni);
    const int nb = NMAP == 0 ? (2 * wn + ni) : (NMAP == 1 ? ((wn & 1) * 2 + ni) : wn);
    wr[ni] = C::XB + slab * 16384 + nb * 512 + v_rd_base(lane);
  }
  const int nk = K / 64;
#define G_DMA1(gp, sp, lp, kt, _d) __builtin_amdgcn_global_load_lds((const unsigned*)((gp) + (size_t)(kt) * (sp)), (LAS unsigned*)((_d) + (lp)), 16, 0, 0)
#define G_DMA(kt, st) do { if (dmaw) { LAS char* _d = lds + (st) * C::STAGE; \
    G_DMA1(g0, stp0, l0, kt, _d); G_DMA1(g1, stp1, l1, kt, _d); G_DMA1(g2, stp2, l2, kt, _d); G_DMA1(g3, stp3, l3, kt, _d); G_DMA1(g4, stp4, l4, kt, _d); G_DMA1(g5, stp5, l5, kt, _d); \
    if (BG) { G_DMA1(g6, stepx, l6, kt, _d); G_DMA1(g7, stepx, l7, kt, _d); G_DMA1(g8, stepw, l8, kt, _d); G_DMA1(g9, stepw, l9, kt, _d); G_DMA1(g10, stepw, l10, kt, _d); G_DMA1(g11, stepw, l11, kt, _d); } } } while (0)
#define G_HALF(cur, wa0, wa1, H) do { bf16x8 xf[2][2], wf[2][2]; \
      _Pragma("unroll") for (int k2 = 0; k2 < 2; ++k2) _Pragma("unroll") for (int ti = 0; ti < 2; ++ti) xf[k2][ti] = *(const LAS bf16x8*)(cur + xr[ti] + ((((H * 2 + k2) * 2 + hi) ^ xsw) << 4)); \
      wf[0][0] = tr_frag_asm<(H * 2 + 0) * 4096>(wa0); wf[0][1] = tr_frag_asm<(H * 2 + 0) * 4096>(wa1); \
      wf[1][0] = tr_frag_asm<(H * 2 + 1) * 4096>(wa0); wf[1][1] = tr_frag_asm<(H * 2 + 1) * 4096>(wa1); \
      asm volatile("s_waitcnt lgkmcnt(0)" ::: "memory"); __builtin_amdgcn_sched_barrier(0); \
      _Pragma("unroll") for (int k2 = 0; k2 < 2; ++k2) _Pragma("unroll") for (int ti = 0; ti < 2; ++ti) _Pragma("unroll") for (int ni = 0; ni < 2; ++ni) \
        acc[ti][ni] = __builtin_amdgcn_mfma_f32_32x32x16_bf16(wf[k2][ni], xf[k2][ti], acc[ti][ni], 0, 0, 0); } while (0)
#define G_COMPUTE(st) do { const LAS char* cur = lds + (st) * C::STAGE; const int wa0 = (int)(uintptr_t)(cur + wr[0]), wa1 = (int)(uintptr_t)(cur + wr[1]); \
    G_HALF(cur, wa0, wa1, 0); G_HALF(cur, wa0, wa1, 1); } while (0)
  static_assert(C::NXP + C::NWP == 6 && (!BG || (C::NXP == 4 && C::NWP == 2)), "piece counts assumed by the vmcnt waits");
  G_DMA(0, 0); G_DMA(1, 1);
  pre();
#pragma unroll
  for (int a_ = 0; a_ < 2; ++a_)
#pragma unroll
    for (int b_ = 0; b_ < 2; ++b_) acc[a_][b_] = (f32x16){};
  f32x4 b0a, b0b, b0c, b0d, b1a, b1b, b1c, b1d, b2a, b2b, b2c, b2d; int bi0 = -1, bi1 = -1, bi2 = -1;
  const int bgoff = tid - 256;
#define BG_SLOT(bi, xa, xb, xc, xd) do { if (bi >= 0) { asm volatile("s_waitcnt vmcnt(8)" ::: "memory");     \
      BGA_RETIRE(bi, bgoff, xa, xb); BGA_RETIRE(bi, bgoff + 256, xc, xd); bi = -1; } \
    if (bgdone < bgn) { bi = bgdone; BGA_ISSUE(bi, bgoff, xa, xb); BGA_ISSUE(bi, bgoff + 256, xc, xd); } } while (0)
#define G_STEP(kt, ST, bi, xa, xb, xc, xd) do { \
    if (dmaw) { if ((kt) + 1 < nk) { if (BG) asm volatile("s_waitcnt vmcnt(12)" ::: "memory"); \
                                     else if ((kt) < 2 && sprev >= 16) asm volatile("s_waitcnt vmcnt(22)" ::: "memory"); \
                                     else if ((kt) < 2 && sprev >= 8) asm volatile("s_waitcnt vmcnt(14)" ::: "memory"); \
                                     else asm volatile("s_waitcnt vmcnt(6)" ::: "memory"); } \
                else asm volatile("s_waitcnt vmcnt(0)" ::: "memory"); } \
    asm volatile("s_waitcnt lgkmcnt(0)" ::: "memory"); __builtin_amdgcn_s_barrier(); \
    if ((kt) + 2 < nk) G_DMA((kt) + 2, ((ST) + 2) % 3); \
    if (BG && !dmaw) BG_SLOT(bi, xa, xb, xc, xd); \
    if (BG && bgdone < bgn) ++bgdone; \
    G_COMPUTE(ST); } while (0)
  for (int kt = 0; kt < nk; kt += 3) {
    G_STEP(kt, 0, bi0, b0a, b0b, b0c, b0d);
    if (kt + 1 < nk) G_STEP(kt + 1, 1, bi1, b1a, b1b, b1c, b1d);
    if (kt + 2 < nk) G_STEP(kt + 2, 2, bi2, b2a, b2b, b2c, b2d);
  }
  if (BG && !dmaw) {
    asm volatile("s_waitcnt vmcnt(0)" ::: "memory");
    if (bi0 >= 0) { BGA_RETIRE(bi0, bgoff, b0a, b0b); BGA_RETIRE(bi0, bgoff + 256, b0c, b0d); }
    if (bi1 >= 0) { BGA_RETIRE(bi1, bgoff, b1a, b1b); BGA_RETIRE(bi1, bgoff + 256, b1c, b1d); }
    if (bi2 >= 0) { BGA_RETIRE(bi2, bgoff, b2a, b2b); BGA_RETIRE(bi2, bgoff + 256, b2c, b2d); }
    asm volatile("s_waitcnt vmcnt(0)" ::: "memory");
  }
#undef G_STEP
#undef BG_SLOT
  asm volatile("s_waitcnt lgkmcnt(0)" ::: "memory"); __builtin_amdgcn_s_barrier();
#undef G_DMA
#undef G_DMA1
#undef G_COMPUTE
#undef G_HALF
}


struct UnitD { int a, b, c, d, lv0, lv1; };
template <int BM, int BN, int NMAP, bool BG = false, class Dec, class XRow, class WPtr, class Epi>
__device__ __forceinline__ void gemm_stream(LAS char* lds, const char* wsb, int ldw, int K, const Dec& dec, const XRow& xrow, const WPtr& wptr, const Epi& epi,
                                            int* bgdone_p = nullptr, int bgn = 0, long bgc0 = 0, const float* bs0 = nullptr, const float* bs1 = nullptr, const float* bs2 = nullptr,
                                            bf16_t* bd0 = nullptr, bf16_t* bd1 = nullptr, bf16_t* bd2 = nullptr) {
  using C = GemmCfg<BM, BN>;
  const int tid = TIDX, wid = __builtin_amdgcn_readfirstlane(tid >> 6), lane = tid & 63, r32 = lane & 31, hi = lane >> 5;
  const int wm = wid / C::WN, wn = wid % C::WN;
  static_assert(C::NXP + C::NWP == 6 && (!BG || (C::NXP == 4 && C::NWP == 2)), "piece counts assumed by the vmcnt waits");
  auto xptr = [&](const UnitD& u, int q) { const int row = 8 * q + (lane >> 3), c = (lane & 7) ^ ((row >> 1) & 7); return (unsigned)(xrow(u, row) + c * 16); };
  auto wptr2 = [&](const UnitD& u, int idx) {
    const int s = idx >> 4, q = idx & 15, sub = 2 * q + (lane >> 5), kk = (sub >> 2) * 8 + ((lane & 31) >> 2);
    const int k = (kk & ~0xC) | ((kk & 4) << 1) | ((kk & 8) >> 1), c = (sub & 3) * 32 + (lane & 3) * 8;
    return (unsigned)(wptr(u, s) + (unsigned)(k * ldw + c) * 2u); };
  auto wlds = [&](int idx) { return C::XB + (idx >> 4) * 16384 + (idx & 15) * 1024; };
  const int w4 = wid & 3;
  const bool dmaw = !BG || wid < 4;
  const int l0 = BG ? (w4 * 8 + 0) * 1024 : (wid * C::NXP + 0) * 1024, l1 = BG ? (w4 * 8 + 1) * 1024 : (wid * C::NXP + 1) * 1024;
  const int l2 = BG ? (w4 * 8 + 2) * 1024 : (C::NXP == 4 ? (wid * 4 + 2) * 1024 : wlds(wid * 4 + 0)), l3 = BG ? (w4 * 8 + 3) * 1024 : (C::NXP == 4 ? (wid * 4 + 3) * 1024 : wlds(wid * 4 + 1));
  const int l4 = BG ? (w4 * 8 + 4) * 1024 : (C::NXP == 4 ? wlds(wid * 2 + 0) : wlds(wid * 4 + 2)), l5 = BG ? (w4 * 8 + 5) * 1024 : (C::NXP == 4 ? wlds(wid * 2 + 1) : wlds(wid * 4 + 3));
  const int l6 = (w4 * 8 + 6) * 1024, l7 = (w4 * 8 + 7) * 1024, l8 = wlds(w4 * 4 + 0), l9 = wlds(w4 * 4 + 1), l10 = wlds(w4 * 4 + 2), l11 = wlds(w4 * 4 + 3);
  const unsigned stepx = 128, stepw = 128u * (unsigned)ldw;
  const unsigned stp0 = stepx, stp1 = stepx, stp2 = (BG || C::NXP == 4) ? stepx : stepw, stp3 = (BG || C::NXP == 4) ? stepx : stepw, stp4 = BG ? stepx : stepw, stp5 = BG ? stepx : stepw;
#define S_SETUP(u, P) do { \
    if (BG) { if (dmaw) { P##0 = xptr(u, w4 * 8 + 0); P##1 = xptr(u, w4 * 8 + 1); P##2 = xptr(u, w4 * 8 + 2); P##3 = xptr(u, w4 * 8 + 3); P##4 = xptr(u, w4 * 8 + 4); P##5 = xptr(u, w4 * 8 + 5); \
                          P##6 = xptr(u, w4 * 8 + 6); P##7 = xptr(u, w4 * 8 + 7); P##8 = wptr2(u, w4 * 4 + 0); P##9 = wptr2(u, w4 * 4 + 1); P##10 = wptr2(u, w4 * 4 + 2); P##11 = wptr2(u, w4 * 4 + 3); } } \
    else { P##0 = xptr(u, wid * C::NXP + 0); P##1 = xptr(u, wid * C::NXP + 1); \
      if (C::NXP == 4) { P##2 = xptr(u, wid * 4 + 2); P##3 = xptr(u, wid * 4 + 3); P##4 = wptr2(u, wid * 2 + 0); P##5 = wptr2(u, wid * 2 + 1); } \
      else { P##2 = wptr2(u, wid * 4 + 0); P##3 = wptr2(u, wid * 4 + 1); P##4 = wptr2(u, wid * 4 + 2); P##5 = wptr2(u, wid * 4 + 3); } } } while (0)
#define S_DMA1(gp, sp, lp, kt, _d) __builtin_amdgcn_global_load_lds((const unsigned*)(wsb + (size_t)((gp) + (unsigned)(kt) * (sp))), (LAS unsigned*)((_d) + (lp)), 16, 0, 0)
#define S_DMA(P, kt, stg) do { if (dmaw) { LAS char* _d = lds + (stg) * C::STAGE; S_DMA1(P##0, stp0, l0, kt, _d); S_DMA1(P##1, stp1, l1, kt, _d); S_DMA1(P##2, stp2, l2, kt, _d); \
    S_DMA1(P##3, stp3, l3, kt, _d); S_DMA1(P##4, stp4, l4, kt, _d); S_DMA1(P##5, stp5, l5, kt, _d); \
    if (BG) { S_DMA1(P##6, stepx, l6, kt, _d); S_DMA1(P##7, stepx, l7, kt, _d); S_DMA1(P##8, stepw, l8, kt, _d); S_DMA1(P##9, stepw, l9, kt, _d); S_DMA1(P##10, stepw, l10, kt, _d); \
              S_DMA1(P##11, stepw, l11, kt, _d); } } } while (0)
  int xr[2];
#pragma unroll
  for (int ti = 0; ti < 2; ++ti) xr[ti] = (wm * 64 + ti * 32 + r32) * 128;
  const int xsw = (r32 >> 1) & 7;
  int wr[2];
#pragma unroll
  for (int ni = 0; ni < 2; ++ni) {
    const int slab = NMAP == 0 ? 0 : (NMAP == 1 ? (wn >> 1) : ni);
    const int nb = NMAP == 0 ? (2 * wn + ni) : (NMAP == 1 ? ((wn & 1) * 2 + ni) : wn);
    wr[ni] = C::XB + slab * 16384 + nb * 512 + v_rd_base(lane);
  }
  const int nk = K / 64;
#define S_HALF(cur, wa0, wa1, H) do { bf16x8 xf[2][2], wf[2][2]; \
      _Pragma("unroll") for (int k2 = 0; k2 < 2; ++k2) _Pragma("unroll") for (int ti = 0; ti < 2; ++ti) xf[k2][ti] = *(const LAS bf16x8*)(cur + xr[ti] + ((((H * 2 + k2) * 2 + hi) ^ xsw) << 4)); \
      wf[0][0] = tr_frag_asm<(H * 2 + 0) * 4096>(wa0); wf[0][1] = tr_frag_asm<(H * 2 + 0) * 4096>(wa1); \
      wf[1][0] = tr_frag_asm<(H * 2 + 1) * 4096>(wa0); wf[1][1] = tr_frag_asm<(H * 2 + 1) * 4096>(wa1); \
      asm volatile("s_waitcnt lgkmcnt(0)" ::: "memory"); __builtin_amdgcn_sched_barrier(0); \
      _Pragma("unroll") for (int k2 = 0; k2 < 2; ++k2) _Pragma("unroll") for (int ti = 0; ti < 2; ++ti) _Pragma("unroll") for (int ni = 0; ni < 2; ++ni) \
        acc[ti][ni] = __builtin_amdgcn_mfma_f32_32x32x16_bf16(wf[k2][ni], xf[k2][ti], acc[ti][ni], 0, 0, 0); } while (0)
  UnitD cu, nu;
  if (!dec(0, cu)) return;
  asm volatile("s_waitcnt vmcnt(0)" : "+v"(cu.lv0), "+v"(cu.lv1) :: "memory");
  unsigned g0 = 0, g1 = 0, g2 = 0, g3 = 0, g4 = 0, g5 = 0, g6 = 0, g7 = 0, g8 = 0, g9 = 0, g10 = 0, g11 = 0;
  S_SETUP(cu, g);
  int st = 0;
  S_DMA(g, 0, 0); S_DMA(g, 1, 1);
  int sprev = 0;
  f32x16 acc[2][2];
  f32x4 b0a, b0b, b0c, b0d, b1a, b1b, b1c, b1d, b2a, b2b, b2c, b2d; int bi0 = -1, bi1 = -1, bi2 = -1, j3 = 0;
  int bgdone = BG ? *bgdone_p : 0;
  const int bgoff = tid - 256;
#define S_BGSLOT(bi, xa, xb, xc, xd) do { if (bi >= 0) { \
      if (kt < 3 && sprev >= 16) asm volatile("s_waitcnt vmcnt(24)" ::: "memory");     \
      else asm volatile("s_waitcnt vmcnt(8)" ::: "memory"); \
      BGA_RETIRE(bi, bgoff, xa, xb); BGA_RETIRE(bi, bgoff + 256, xc, xd); bi = -1; } \
    if (bgdone < bgn) { bi = bgdone; BGA_ISSUE(bi, bgoff, xa, xb); BGA_ISSUE(bi, bgoff + 256, xc, xd); } } while (0)
  for (int it = 0;; ++it) {
    const bool okn = dec(it + 1, nu);
#pragma unroll
    for (int a_ = 0; a_ < 2; ++a_)
#pragma unroll
      for (int b_ = 0; b_ < 2; ++b_) acc[a_][b_] = (f32x16){};
    for (int kt = 0; kt < nk; ++kt) {
      if (dmaw) {
        if (kt + 1 < nk || okn) {
          const int extra = kt < 2 ? sprev : 0;
          if (BG) { if (extra >= 16) asm volatile("s_waitcnt vmcnt(28)" ::: "memory"); else asm volatile("s_waitcnt vmcnt(12)" ::: "memory"); }
          else if (extra >= 16) asm volatile("s_waitcnt vmcnt(22)" ::: "memory");
          else if (extra >= 8) asm volatile("s_waitcnt vmcnt(14)" ::: "memory");
          else asm volatile("s_waitcnt vmcnt(6)" ::: "memory");
        } else asm volatile("s_waitcnt vmcnt(0)" ::: "memory");
      }
      asm volatile("s_waitcnt lgkmcnt(0)" ::: "memory"); __builtin_amdgcn_s_barrier();
      const int st2 = st == 0 ? 2 : st - 1;
      if (kt + 2 < nk) S_DMA(g, kt + 2, st2);
      else if (okn) {
        if (kt + 2 == nk) { asm volatile("" : "+v"(nu.lv0), "+v"(nu.lv1) :: "memory"); S_SETUP(nu, g); }
        S_DMA(g, kt + 2 - nk, st2);
      }
      if (BG && !dmaw) { if (j3 == 0) S_BGSLOT(bi0, b0a, b0b, b0c, b0d); else if (j3 == 1) S_BGSLOT(bi1, b1a, b1b, b1c, b1d); else S_BGSLOT(bi2, b2a, b2b, b2c, b2d); }
      if (BG) { if (bgdone < bgn) ++bgdone; j3 = j3 == 2 ? 0 : j3 + 1; }
      { const LAS char* cur = lds + st * C::STAGE; const int wa0 = (int)(uintptr_t)(cur + wr[0]), wa1 = (int)(uintptr_t)(cur + wr[1]);
        S_HALF(cur, wa0, wa1, 0); S_HALF(cur, wa0, wa1, 1); }
      st = st == 2 ? 0 : st + 1;
    }
    if (BG && !dmaw) {
      asm volatile("s_waitcnt vmcnt(0)" ::: "memory");
      if (bi0 >= 0) { BGA_RETIRE(bi0, bgoff, b0a, b0b); BGA_RETIRE(bi0, bgoff + 256, b0c, b0d); bi0 = -1; }
      if (bi1 >= 0) { BGA_RETIRE(bi1, bgoff, b1a, b1b); BGA_RETIRE(bi1, bgoff + 256, b1c, b1d); bi1 = -1; }
      if (bi2 >= 0) { BGA_RETIRE(bi2, bgoff, b2a, b2b); BGA_RETIRE(bi2, bgoff + 256, b2c, b2d); bi2 = -1; }
    }
    sprev = epi(cu, acc);
    if (!okn) break;
    cu = nu;
  }
  if (BG) *bgdone_p = bgdone;
#undef S_BGSLOT
#undef S_HALF
#undef S_DMA
#undef S_DMA1
#undef S_SETUP
}

__device__ __forceinline__ unsigned pack4_fp8(const f32x16& a, int g) {
  int w = __builtin_amdgcn_cvt_pk_fp8_f32(a[4 * g], a[4 * g + 1], 0, false);
  w = __builtin_amdgcn_cvt_pk_fp8_f32(a[4 * g + 2], a[4 * g + 3], w, true);
  return (unsigned)w;
}
__device__ __forceinline__ u32x2 pack4(const f32x16& a, int g) { return (u32x2){cvtpk(a[4 * g], a[4 * g + 1]), cvtpk(a[4 * g + 2], a[4 * g + 3])}; }

__device__ __forceinline__ void phase_a1(const Params& p, int layer, LAS char* lds, int bid, int nblk) {
  const bf16_t* H = (const bf16_t*)(p.ws + OFF_H);
  const bf16_t* W = (const bf16_t*)(p.ws + OFF_WIN) + (size_t)layer * D * INW;
  bf16_t* Q = (bf16_t*)(p.ws + OFF_Q); bf16_t* Kb = (bf16_t*)(p.ws + OFF_K); bf16_t* Vb = (bf16_t*)(p.ws + OFF_V);
  float* U = (float*)(p.ws + OFF_U); bf16_t* AG = (bf16_t*)(p.ws + OFF_AG);
  unsigned char* Q8 = (unsigned char*)(p.ws + OFF_Q8); unsigned char* K8 = (unsigned char*)(p.ws + OFF_K8); unsigned char* VT8 = (unsigned char*)(p.ws + OFF_VT8);
  const float* rt = (const float*)(p.ws + OFF_ROPE);
  const int lane = TIDX & 63, wid = TIDX >> 6, r32 = lane & 31, hi = lane >> 5, wm = wid >> 1, wn = wid & 1;
  const size_t wo = (size_t)layer * NE * D * DE;
  const int bgn = (3 * (1 << 21) + nblk * 512 - 1) / (nblk * 512);
  const long bgc0 = (long)bid * bgn * 512;
  const float* bs0 = p.w_e_gate + wo; const float* bs1 = p.w_e_up + wo; const float* bs2 = p.w_e_down + wo;
  bf16_t* bd0 = (bf16_t*)(p.ws + OFF_WG) + wo; bf16_t* bd1 = (bf16_t*)(p.ws + OFF_WU) + wo; bf16_t* bd2 = (bf16_t*)(p.ws + OFF_WD) + wo;
  int bgdone = 0;
  const int nlat = 64 * 12, nctx = layer == 0 ? 12 : 2, nunits = nlat + nctx;
  const bool xmap = (nblk & 7) == 0;
  const int xcd = bid & 7, lb = bid >> 3, nlb = nblk >> 3, nl = lb < 96 ? (96 - lb + nlb - 1) / nlb : 0;
  for (int it = 0;; ++it) {
    int rtile, ct;
    if (xmap) {
      if (it < nl) { const int v = lb + it * nlb; rtile = 1 + xcd + 8 * (v / 12); ct = v % 12; }
      else { const int e2 = bid + (it - nl) * nblk; if (e2 >= nctx) break; rtile = 0; ct = layer == 0 ? e2 : 4 + e2; }
    } else {
      const int u = bid + it * nblk; if (u >= nunits) break;
      if (u < nlat) { rtile = 1 + u / 12; ct = u % 12; } else { rtile = 0; ct = layer == 0 ? (u - nlat) : (4 + u - nlat); }
    }
    const int m0 = rtile * 256, n0 = ct * 128;
    f32x16 acc[2][2];
#pragma unroll
    for (int a = 0; a < 2; ++a)
#pragma unroll
      for (int b = 0; b < 2; ++b) acc[a][b] = (f32x16){};
    gemm_mainloop<256, 128, 0, true>(lds, acc, [&](int row) { return H + (size_t)(m0 + row) * D; }, [&](int) { return W + n0; }, []() {}, 0, INW, D, bgdone, bgn, bgc0, bs0, bs1, bs2, bd0, bd1, bd2);
#pragma unroll
    for (int ti = 0; ti < 2; ++ti) {
      const int tok = m0 + wm * 64 + ti * 32 + r32;
      if (ct < 5) {
        float ss = 0.f;
#pragma unroll
        for (int ni = 0; ni < 2; ++ni)
#pragma unroll
          for (int r = 0; r < 16; ++r) ss += acc[ti][ni][r] * acc[ti][ni][r];
        ss = sum32(ss);
        const float rs = rsqrtf(ss * (1.f / 64.f) + EPS);
        const float* gain = (ct < 4 ? p.q_gain : p.k_gain) + layer * 64;
        const float osc = ct < 4 ? 0.125f * 1.4426950408889634f : 1.f;
        const bool lat = rtile > 0;
        const int t = tok - NCTX;
#pragma unroll
        for (int ni = 0; ni < 2; ++ni) {
          f32x16 v;
#pragma unroll
          for (int r = 0; r < 16; ++r) v[r] = acc[ti][ni][r] * rs * gain[ni * 32 + crow(r, hi)];
          if (lat) {
            const int pos = ni == 0 ? (t >> 6) : (t & 63);
#pragma unroll
            for (int r = 0; r < 8; ++r) {
              const int f = crow(r, hi);
              const float cs = rt[(pos * 16 + f) * 2], sn = rt[(pos * 16 + f) * 2 + 1];
              const float t1 = v[r], t2 = v[r + 8];
              v[r] = t1 * cs - t2 * sn; v[r + 8] = t2 * cs + t1 * sn;
            }
          }
#pragma unroll
          for (int r = 0; r < 16; ++r) v[r] *= osc;
          bf16_t* dst = ct < 4 ? Q + (size_t)tok * 512 + (ct * 2 + wn) * 64 + ni * 32 : Kb + (size_t)tok * 128 + wn * 64 + ni * 32;
          unsigned char* dst8 = ct < 4 ? Q8 + (size_t)tok * 512 + (ct * 2 + wn) * 64 + ni * 32 : K8 + (size_t)tok * 128 + wn * 64 + ni * 32;
#pragma unroll
          for (int g = 0; g < 4; ++g) { *(u32x2*)(dst + 8 * g + 4 * hi) = pack4(v, g); *(unsigned*)(dst8 + 8 * g + 4 * hi) = pack4_fp8(v, g); }
        }
      } else if (ct == 5) {
#pragma unroll
        for (int ni = 0; ni < 2; ++ni) {
#pragma unroll
          for (int g = 0; g < 4; ++g) *(u32x2*)(Vb + (size_t)tok * 128 + wn * 64 + ni * 32 + 8 * g + 4 * hi) = pack4(acc[ti][ni], g);
          float vmx = 0.f;
#pragma unroll
          for (int r = 0; r < 16; ++r) {
            const float vv = acc[ti][ni][r]; vmx = fmaxf(vmx, fabsf(vv));
            VT8[(size_t)(wn * 64 + ni * 32 + crow(r, hi)) * TT + tok] = (unsigned char)(__builtin_amdgcn_cvt_pk_fp8_f32(vv, vv, 0, false) & 0xff);
          }
          if (!(vmx <= 400.f)) atomicOr((int*)(p.ws + OFF_FLAG) + 1, 1);
        }
      } else if (ct < 8) {
#pragma unroll
        for (int ni = 0; ni < 2; ++ni)
#pragma unroll
          for (int g = 0; g < 4; ++g)
            *(f32x4*)(U + (size_t)tok * 256 + (ct - 6) * 128 + wn * 64 + ni * 32 + 8 * g + 4 * hi) =
                (f32x4){acc[ti][ni][4 * g], acc[ti][ni][4 * g + 1], acc[ti][ni][4 * g + 2], acc[ti][ni][4 * g + 3]};
      } else {
#pragma unroll
        for (int ni = 0; ni < 2; ++ni)
#pragma unroll
          for (int g = 0; g < 4; ++g) *(u32x2*)(AG + (size_t)tok * 512 + (ct - 8) * 128 + wn * 64 + ni * 32 + 8 * g + 4 * hi) = pack4(acc[ti][ni], g);
      }
    }
  }
  { const int tid = TIDX; while (bgdone < bgn) { f32x4 a, b2; const int i = bgdone++; BG_ISSUE(i, tid, a, b2); BG_RETIRE(i, tid, a, b2); } }
}

__device__ __forceinline__ void phase_c1(const Params& p, int layer, LAS char* lds, int bid, int nblk) {
  const bf16_t* A = (const bf16_t*)(p.ws + OFF_MIX);
  const bf16_t* W = (const bf16_t*)(p.ws + OFF_WOUT) + (size_t)layer * D * D;
  bf16_t* Y = (bf16_t*)(p.ws + OFF_Y);
  const int lane = TIDX & 63, wid = TIDX >> 6, r32 = lane & 31, hi = lane >> 5, wm = wid >> 1, wn = wid & 1;
  const int nctx = layer == 0 ? 8 : 0;
  const bool xmap = (nblk & 7) == 0;
  const int xcd = bid & 7, lb = bid >> 3, nlb = nblk >> 3, nl = lb < 64 ? (64 - lb + nlb - 1) / nlb : 0;
  const unsigned oA = (unsigned)OFF_MIX, oW = (unsigned)(OFF_WOUT + (size_t)layer * D * D * 2);
  gemm_stream<256, 128, 0>(lds, p.ws, D, D,
    [&](int it, UnitD& u) {
      int rtile, ct;
      if (xmap) {
        if (it < nl) { const int v = lb + it * nlb; rtile = 1 + xcd + 8 * (v >> 3); ct = v & 7; }
        else { const int e2 = bid + (it - nl) * nblk; if (e2 >= nctx) return false; rtile = 0; ct = e2; }
      } else {
        const int un = bid + it * nblk; if (un >= 64 * 8 + nctx) return false;
        if (un < 512) { rtile = 1 + (un >> 3); ct = un & 7; } else { rtile = 0; ct = un - 512; }
      }
      u.a = rtile * 256; u.b = ct * 128; u.c = 0; u.d = 0; u.lv0 = 0; u.lv1 = 0; return true; },
    [&](const UnitD& u, int row) { return oA + (unsigned)(u.a + row) * (D * 2); },
    [&](const UnitD& u, int) { return oW + (unsigned)u.b * 2; },
    [&](const UnitD& u, f32x16 (&acc)[2][2]) {
#pragma unroll
      for (int ti = 0; ti < 2; ++ti) {
        const int tok = u.a + wm * 64 + ti * 32 + r32;
#pragma unroll
        for (int ni = 0; ni < 2; ++ni)
#pragma unroll
          for (int g = 0; g < 4; ++g) *(u32x2*)(Y + (size_t)tok * D + u.b + wn * 64 + ni * 32 + 8 * g + 4 * hi) = pack4(acc[ti][ni], g);
      }
      return 16; });
}

#ifndef MOE_XCD_MAP
#define MOE_XCD_MAP 0
#endif
__device__ __forceinline__ void moe_prefix(const int* cnt, LAS int* pre, int xcd) {
  if (TIDX == 0) {
    int o = 0; for (int e = 0; e < NE; ++e) { pre[e] = o; o += (cnt[e * CNT_STRIDE] + 127) >> 7; } pre[NE] = o;
    int l = 0; for (int j = 0; j < 4; ++j) { pre[40 + j] = l; l += (cnt[(xcd + 8 * j) * CNT_STRIDE] + 127) >> 7; } pre[44] = l;
  }
  if (TIDX >= 64 && TIDX < 64 + NE) pre[48 + TIDX - 64] = cnt[(TIDX - 64) * CNT_STRIDE];
  __syncthreads();
}
__device__ __forceinline__ bool moe_unit(const LAS int* pre, int bid, int nblk, int it, int& e, int& rt, int& ct, int& g) {
  if (MOE_XCD_MAP && (nblk & 7) == 0) {
    const int xcd = bid & 7, v = (bid >> 3) + it * (nblk >> 3), gl = v >> 2;
    if (gl >= pre[44]) return false;
    int j = 0; if (gl >= pre[41]) j = 1; if (gl >= pre[42]) j = 2; if (gl >= pre[43]) j = 3;
    e = xcd + 8 * j; rt = gl - pre[40 + j]; ct = v & 3; g = pre[e] + rt; return true;
  } else {
    const int u = bid + it * nblk; g = u >> 2; if (g >= pre[NE]) return false;
    int ee = 0; for (int i = 1; i < NE; ++i) ee += (pre[i] <= g) ? 1 : 0;
    e = ee; rt = g - pre[ee]; ct = u & 3; return true;
  }
}

__device__ __forceinline__ void phase_d1(const Params& p, int layer, LAS char* lds, int bid, int nblk) {
  const int* cnt = (const int*)(p.ws + OFF_CNT) + layer * NE * CNT_STRIDE;
  const bf16_t* H2 = (const bf16_t*)(p.ws + OFF_MIX);
  bf16_t* HM = (bf16_t*)(p.ws + OFF_HMID);
  LAS int* pre = (LAS int*)(lds + GEMM_LDS);
  moe_prefix(cnt, pre, bid & 7);
  const int lane = TIDX & 63, wid = TIDX >> 6, r32 = lane & 31, hi = lane >> 5, wm = wid >> 2, wn = wid & 3;
  const int grow = 16 * wid + (lane >> 3);
  const bf16_t* WG = (const bf16_t*)(p.ws + OFF_WG) + (size_t)layer * NE * D * DE; const bf16_t* WU = (const bf16_t*)(p.ws + OFF_WU) + (size_t)layer * NE * D * DE;
  const unsigned oH2 = (unsigned)OFF_MIX, oWG = (unsigned)(OFF_WG + (size_t)layer * NE * D * DE * 2), oWU = (unsigned)(OFF_WU + (size_t)layer * NE * D * DE * 2);
  gemm_stream<128, 256, 2>(lds, p.ws, DE, D,
    [&](int it, UnitD& u) {
      int e, rt, ct, g; if (!moe_unit(pre, bid, nblk, it, e, rt, ct, g)) return false;
      const int* list = (const int*)(p.ws + OFF_LIST) + (size_t)e * CAPL + rt * 128 + grow;
      u.a = e; u.b = ct; u.c = g; u.d = pre[48 + e] - rt * 128;
      asm volatile("global_load_dword %0, %2, off\n\tglobal_load_dword %1, %2, off offset:32" : "=&v"(u.lv0), "=&v"(u.lv1) : "v"(list) : "memory");
      return true; },
    [&](const UnitD& u, int row) { const int lv = (row & 8) ? u.lv1 : u.lv0; const int tok = row < u.d ? (lv >> 1) : 0; return oH2 + (unsigned)tok * (D * 2); },
    [&](const UnitD& u, int s) { return (s == 0 ? oWG : oWU) + (unsigned)u.a * (D * DE * 2) + (unsigned)u.b * 256; },
    [&](const UnitD& u, f32x16 (&acc)[2][2]) {
#pragma unroll
      for (int ti = 0; ti < 2; ++ti) {
        const size_t row = (size_t)u.c * 128 + wm * 64 + ti * 32 + r32;
        f32x16 a;
#pragma unroll
        for (int r = 0; r < 16; ++r) { const float gv = acc[ti][0][r]; a[r] = gv / (1.f + __expf(-gv)) * acc[ti][1][r]; }
#pragma unroll
        for (int gq = 0; gq < 4; ++gq) *(u32x2*)(HM + row * DE + u.b * 128 + wn * 32 + 8 * gq + 4 * hi) = pack4(a, gq);
      }
      return 8; });
}

__device__ __forceinline__ void phase_d2(const Params& p, int layer, LAS char* lds, int bid, int nblk) {
  const int* cnt = (const int*)(p.ws + OFF_CNT) + layer * NE * CNT_STRIDE;
  const bf16_t* HM = (const bf16_t*)(p.ws + OFF_HMID);
  bf16_t* OM = (bf16_t*)(p.ws + OFF_OMOE);
  LAS int* pre = (LAS int*)(lds + GEMM_LDS);
  moe_prefix(cnt, pre, bid & 7);
  const int lane = TIDX & 63, wid = TIDX >> 6, r32 = lane & 31, hi = lane >> 5, wm = wid >> 2, wn = wid & 3;
  const int row0 = wm * 64 + r32;
  const bf16_t* WD = (const bf16_t*)(p.ws + OFF_WD) + (size_t)layer * NE * DE * D;
  const unsigned oHM = (unsigned)OFF_HMID, oWD = (unsigned)(OFF_WD + (size_t)layer * NE * DE * D * 2);
  gemm_stream<128, 256, 1>(lds, p.ws, D, DE,
    [&](int it, UnitD& u) {
      int e, rt, ct, g; if (!moe_unit(pre, bid, nblk, it, e, rt, ct, g)) return false;
      const int* list = (const int*)(p.ws + OFF_LIST) + (size_t)e * CAPL + rt * 128 + row0;
      u.a = e; u.b = ct; u.c = g; u.d = pre[48 + e] - rt * 128;
      asm volatile("global_load_dword %0, %2, off\n\tglobal_load_dword %1, %2, off offset:128" : "=&v"(u.lv0), "=&v"(u.lv1) : "v"(list) : "memory");
      return true; },
    [&](const UnitD& u, int row) { return oHM + (unsigned)(u.c * 128 + row) * (DE * 2); },
    [&](const UnitD& u, int s) { return oWD + (unsigned)u.a * (DE * D * 2) + (unsigned)(u.b * 256 + s * 128) * 2; },
    [&](const UnitD& u, f32x16 (&acc)[2][2]) {
#pragma unroll
      for (int ti = 0; ti < 2; ++ti) {
        const int ts = ti == 0 ? u.lv0 : u.lv1;
        if (row0 + ti * 32 < u.d) {
#pragma unroll
          for (int ni = 0; ni < 2; ++ni)
#pragma unroll
            for (int gq = 0; gq < 4; ++gq) *(u32x2*)(OM + (size_t)ts * D + u.b * 256 + wn * 64 + ni * 32 + 8 * gq + 4 * hi) = pack4(acc[ti][ni], gq);
        }
      }
      return u.d >= 128 ? 16 : 0; });
}
constexpr int ATT_SLOT = 16384, ATT_LDS = 4 * ATT_SLOT;
__device__ __forceinline__ int vst64(int k, int c) { const int kk = (k & ~0xC) | ((k & 4) << 1) | ((k & 8) >> 1); return ((kk >> 3) * 2 + (c >> 5)) * 512 + ((kk & 7) * 32 + (c & 31)) * 2; }
__device__ __forceinline__ bf16x8 tr_frag64(const LAS char* p) {
  s16x4 a = __builtin_amdgcn_ds_read_tr16_b64_v4i16((LAS s16x4*)p);
  s16x4 b = __builtin_amdgcn_ds_read_tr16_b64_v4i16((LAS s16x4*)(p + 1024));
  return (bf16x8){a[0], a[1], a[2], a[3], b[0], b[1], b[2], b[3]};
}
__device__ __forceinline__ bf16x8 pk4(const f32x16& P, int B) {
  unsigned a0 = cvtpk(P[B + 0], P[B + 1]), a1 = cvtpk(P[B + 2], P[B + 3]), b0 = cvtpk(P[B + 4], P[B + 5]), b1 = cvtpk(P[B + 6], P[B + 7]);
  auto r0 = __builtin_amdgcn_permlane32_swap(a0, b0, false, false); auto r1 = __builtin_amdgcn_permlane32_swap(a1, b1, false, false);
  u32x4 w = {r0[0], r1[0], r0[1], r1[1]};
  return __builtin_bit_cast(bf16x8, w);
}
struct AttnCtx { int krd0, krd1, ksw, hi, vrd; };
#define SBAR() __builtin_amdgcn_sched_barrier(0)
__device__ __forceinline__ void att_kload(const LAS char* slot, const AttnCtx& c, bf16x8 (&kf)[8]) {
#pragma unroll
  for (int d0 = 0; d0 < 4; ++d0) {
    kf[2 * d0] = *(const LAS bf16x8*)(slot + c.krd0 + (((2 * d0 + c.hi) ^ c.ksw) << 4));
    kf[2 * d0 + 1] = *(const LAS bf16x8*)(slot + c.krd1 + (((2 * d0 + c.hi) ^ c.ksw) << 4));
  }
}
__device__ __forceinline__ void att_qk(const bf16x8 (&kf)[8], const bf16x8 (&qr)[4], f32x16& s0, f32x16& s1) {
  s0 = (f32x16){}; s1 = (f32x16){};
#pragma unroll
  for (int d0 = 0; d0 < 4; ++d0) {
    s0 = __builtin_amdgcn_mfma_f32_32x32x16_bf16(kf[2 * d0], qr[d0], s0, 0, 0, 0);
    s1 = __builtin_amdgcn_mfma_f32_32x32x16_bf16(kf[2 * d0 + 1], qr[d0], s1, 0, 0, 0);
  }
}
__device__ __forceinline__ void att_exp(f32x16& s, float& l) {
#pragma unroll
  for (int r = 0; r < 16; ++r) { s[r] = __builtin_amdgcn_exp2f(s[r]); l += s[r]; }
  asm volatile("" : "+v"(l));
}
template <int KS0>
__device__ __forceinline__ void att_vload(const LAS char* slot, const AttnCtx& c, bf16x8 (&vf)[4]) {
#pragma unroll
  for (int i = 0; i < 2; ++i) { vf[2 * i] = tr_frag64(slot + c.vrd + (KS0 + i) * 2048); vf[2 * i + 1] = tr_frag64(slot + c.vrd + 512 + (KS0 + i) * 2048); }
}
__device__ __forceinline__ void att_pv2(const bf16x8& pa, const bf16x8& pb, const bf16x8 (&vf)[4], f32x16& o0, f32x16& o1) {
  o0 = __builtin_amdgcn_mfma_f32_32x32x16_bf16(pa, vf[0], o0, 0, 0, 0);
  o1 = __builtin_amdgcn_mfma_f32_32x32x16_bf16(pa, vf[1], o1, 0, 0, 0);
  o0 = __builtin_amdgcn_mfma_f32_32x32x16_bf16(pb, vf[2], o0, 0, 0, 0);
  o1 = __builtin_amdgcn_mfma_f32_32x32x16_bf16(pb, vf[3], o1, 0, 0, 0);
}
__device__ __forceinline__ void attn_unit(const Params& p, LAS char* lds, int row0, int hp, int nkeys) {
  const bf16_t* Q = (const bf16_t*)(p.ws + OFF_Q); const bf16_t* Kb = (const bf16_t*)(p.ws + OFF_K); const bf16_t* Vb = (const bf16_t*)(p.ws + OFF_V);
  bf16_t* MIX = (bf16_t*)(p.ws + OFF_MIX);
  const int tid = TIDX, wid = tid >> 6, lane = tid & 63, r32 = lane & 31, hi = lane >> 5, kvh = hp >> 1;
  bf16x8 qa[4], qb[4];
  { const bf16_t* Qg = Q + (size_t)(row0 + wid * 32 + r32) * 512 + hp * 128 + hi * 8;
#pragma unroll
    for (int d0 = 0; d0 < 4; ++d0) { qa[d0] = *(const bf16x8*)(Qg + d0 * 16); qb[d0] = *(const bf16x8*)(Qg + 64 + d0 * 16); } }
  const bf16_t* Kg = Kb + (size_t)(tid >> 3) * 128 + kvh * 64 + (tid & 7) * 8;
  const bf16_t* Vg = Vb + (size_t)(tid >> 3) * 128 + kvh * 64 + (tid & 7) * 8;
  const int kst = xoff(tid >> 3, tid & 7), vstw = 8192 + vst64(tid >> 3, (tid & 7) * 8);
  AttnCtx c; c.krd0 = r32 * 128; c.krd1 = (32 + r32) * 128; c.ksw = (r32 >> 1) & 7; c.hi = hi; c.vrd = 8192 + v_rd_base(lane);
  const int NT = nkeys >> 6;
  f32x16 oa0 = {}, oa1 = {}, ob0 = {}, ob1 = {}; float la = 0.f, lb = 0.f;
  u32x4 ks, vs;
  {
    const u32x4 k0 = *(const u32x4*)Kg, k1 = *(const u32x4*)(Kg + 64 * 128), v0 = *(const u32x4*)Vg, v1 = *(const u32x4*)(Vg + 64 * 128);
    *(LAS u32x4*)(lds + kst) = k0; *(LAS u32x4*)(lds + ATT_SLOT + kst) = k1;
    *(LAS u32x4*)(lds + vstw) = v0; *(LAS u32x4*)(lds + ATT_SLOT + vstw) = v1;
    ks = *(const u32x4*)(Kg + 2 * 64 * 128); vs = *(const u32x4*)(Vg + 2 * 64 * 128);
  }
  __syncthreads();
  for (int j = 0; j < NT; ++j) {
    const LAS char* sl = lds + (j & 3) * ATT_SLOT;
    bf16x8 kf[8], vfa[4], vfb[4];
    f32x16 sa0, sa1, sb0, sb1;
    att_kload(sl, c, kf);
    SBAR();
    att_qk(kf, qa, sa0, sa1);
    SBAR();
    att_qk(kf, qb, sb0, sb1);
    att_exp(sa0, la); att_exp(sa1, la);
    SBAR();
    const bf16x8 pa0 = pk4(sa0, 0), pa1 = pk4(sa0, 8), pa2 = pk4(sa1, 0), pa3 = pk4(sa1, 8);
    att_vload<0>(sl, c, vfa);
    SBAR();
    att_pv2(pa0, pa1, vfa, oa0, oa1);
    att_exp(sb0, lb);
    att_vload<2>(sl, c, vfb);
    SBAR();
    att_pv2(pa2, pa3, vfb, oa0, oa1);
    att_exp(sb1, lb);
    const bf16x8 pb0 = pk4(sb0, 0), pb1 = pk4(sb0, 8), pb2 = pk4(sb1, 0), pb3 = pk4(sb1, 8);
    att_vload<0>(sl, c, vfa);
    SBAR();
    att_pv2(pb0, pb1, vfa, ob0, ob1);
    att_vload<2>(sl, c, vfb);
    SBAR();
    att_pv2(pb2, pb3, vfb, ob0, ob1);
    { LAS char* w = lds + ((j + 2) & 3) * ATT_SLOT;
      if (j + 2 < NT) { *(LAS u32x4*)(w + kst) = ks; *(LAS u32x4*)(w + vstw) = vs; }
      if (j + 3 < NT) { ks = *(const u32x4*)(Kg + (size_t)(j + 3) * 64 * 128); vs = *(const u32x4*)(Vg + (size_t)(j + 3) * 64 * 128); } }
    __syncthreads();
  }
  la = sum32(la); lb = sum32(lb);
  LAS float* li = (LAS float*)(lds + wid * 256);
  if (hi == 0) { li[r32] = la; li[32 + r32] = lb; }
  __syncthreads();
  bf16_t* Og = MIX + (size_t)(row0 + wid * 32) * D + hp * 128 + r32;
#pragma unroll
  for (int r = 0; r < 16; ++r) {
    const int orow = crow(r, hi);
    const float ra = __builtin_amdgcn_rcpf(li[orow]), rb = __builtin_amdgcn_rcpf(li[32 + orow]);
    Og[(size_t)orow * D] = f2bf(oa0[r] * ra); Og[(size_t)orow * D + 32] = f2bf(oa1[r] * ra);
    Og[(size_t)orow * D + 64] = f2bf(ob0[r] * rb); Og[(size_t)orow * D + 96] = f2bf(ob1[r] * rb);
  }
  __syncthreads();
}
typedef int i32x8 __attribute__((ext_vector_type(8)));
constexpr int A8_SLOT = 8192, A8_NSLOT = 8, A8_LDS = A8_NSLOT * A8_SLOT;
__device__ __forceinline__ int off8(int row, int chunk) { return row * 64 + ((chunk ^ ((row >> 2) & 3)) << 4); }
__device__ __forceinline__ i32x8 ld_frag8(const LAS char* tile, int row, int h) {
  const int sw = (row >> 2) & 3;
  const u32x4 lo = *(const LAS u32x4*)(tile + row * 64 + (((2 * h) ^ sw) << 4)), hi = *(const LAS u32x4*)(tile + row * 64 + (((2 * h + 1) ^ sw) << 4));
  return (i32x8){(int)lo[0], (int)lo[1], (int)lo[2], (int)lo[3], (int)hi[0], (int)hi[1], (int)hi[2], (int)hi[3]};
}
#define MX_FP8_FP8(a, b, c) __builtin_amdgcn_mfma_scale_f32_32x32x64_f8f6f4(a, b, c, 0, 0, 0, 0x7f7f7f7f, 0, 0x7f7f7f7f)
#define MX_BF8_FP8(a, b, c) __builtin_amdgcn_mfma_scale_f32_32x32x64_f8f6f4(a, b, c, 1, 0, 0, 0x7f7f7f7f, 0, 0x7f7f7f7f)
typedef _Float16 f16x2 __attribute__((ext_vector_type(2)));
__device__ __forceinline__ unsigned att8_code4(float s0, float s1, float s2, float s3) {
  const f16x2 four = {(_Float16)4.f, (_Float16)4.f}, bias = {(_Float16)1084.f, (_Float16)1084.f};
  const f16x2 x = __builtin_bit_cast(f16x2, __builtin_amdgcn_cvt_pkrtz(s0, s1)) * four + bias, y = __builtin_bit_cast(f16x2, __builtin_amdgcn_cvt_pkrtz(s2, s3)) * four + bias;
  return __builtin_amdgcn_perm(__builtin_bit_cast(unsigned, y), __builtin_bit_cast(unsigned, x), 0x06040200u);
}
__device__ __forceinline__ i32x8 att8_pack(const f32x16& p0, const f32x16& p1) {
  i32x8 w;
#pragma unroll
  for (int i = 0; i < 4; ++i) {
    const unsigned d = att8_code4(p0[4 * i], p0[4 * i + 1], p0[4 * i + 2], p0[4 * i + 3]), e = att8_code4(p1[4 * i], p1[4 * i + 1], p1[4 * i + 2], p1[4 * i + 3]);
    auto r = __builtin_amdgcn_permlane32_swap(d, e, false, false);
    w[2 * i] = (int)r[0]; w[2 * i + 1] = (int)r[1];
  }
  return w;
}
__device__ __forceinline__ void attn_unit8(const Params& p, LAS char* lds, int row0, int hp, int nkeys, bf16_t* MIXP = nullptr) {
  const unsigned char* Q8 = (const unsigned char*)(p.ws + OFF_Q8); const unsigned char* K8 = (const unsigned char*)(p.ws + OFF_K8); const unsigned char* VT8 = (const unsigned char*)(p.ws + OFF_VT8);
  bf16_t* MIX = MIXP ? MIXP : (bf16_t*)(p.ws + OFF_MIX);
  const int tid = TIDX, wid = tid >> 6, lane = tid & 63, r32 = lane & 31, hi = lane >> 5, kvh = hp >> 1;
  i32x8 qa, qb;
  { const unsigned char* Qg = Q8 + (size_t)(row0 + wid * 32 + r32) * 512 + hp * 128 + hi * 32;
    const u32x4 a0 = *(const u32x4*)Qg, a1 = *(const u32x4*)(Qg + 16), b0 = *(const u32x4*)(Qg + 64), b1 = *(const u32x4*)(Qg + 80);
    qa = (i32x8){(int)a0[0], (int)a0[1], (int)a0[2], (int)a0[3], (int)a1[0], (int)a1[1], (int)a1[2], (int)a1[3]};
    qb = (i32x8){(int)b0[0], (int)b0[1], (int)b0[2], (int)b0[3], (int)b1[0], (int)b1[1], (int)b1[2], (int)b1[3]}; }
  const int wv = __builtin_amdgcn_readfirstlane(wid);
  const int prow = (wv & 3) * 16 + (lane >> 2), pch = (lane & 3) ^ ((prow >> 2) & 3);
  const unsigned char* Sg = wv < 4 ? K8 + (size_t)prow * 128 + kvh * 64 + pch * 16 : VT8 + (size_t)(kvh * 64 + prow) * TT + pch * 16;
  const size_t sstep = wv < 4 ? (size_t)64 * 128 : (size_t)64;
  const int sdst = (wv < 4 ? 0 : 4096) + (wv & 3) * 1024;
#define A8_DMA(t) __builtin_amdgcn_global_load_lds((const unsigned*)(Sg + (size_t)(t) * sstep), (LAS unsigned*)(lds + ((t) & (A8_NSLOT - 1)) * A8_SLOT + sdst), 16, 0, 0)
  const int NT = nkeys >> 6;
  f32x16 oa0 = {}, oa1 = {}, ob0 = {}, ob1 = {}, ola = {}, olb = {};
  const i32x8 ones = {0x38383838, 0x38383838, 0x38383838, 0x38383838, 0x38383838, 0x38383838, 0x38383838, 0x38383838};
  A8_DMA(0); A8_DMA(1); if (NT > 2) { A8_DMA(2); A8_DMA(3); }
  for (int j = 0; j < NT; j += 2) {
    if (j + 2 < NT) asm volatile("s_waitcnt vmcnt(2)" ::: "memory"); else asm volatile("s_waitcnt vmcnt(0)" ::: "memory");
    asm volatile("s_waitcnt lgkmcnt(0)" ::: "memory"); __builtin_amdgcn_s_barrier();
    if (j + 4 < NT) { A8_DMA(j + 4); A8_DMA(j + 5); }
#pragma unroll
    for (int jj = 0; jj < 2; ++jj) {
      const LAS char* sl = lds + ((j + jj) & (A8_NSLOT - 1)) * A8_SLOT;
      f32x16 sa0 = {}, sa1 = {}, sb0 = {}, sb1 = {};
      const i32x8 kf0 = ld_frag8(sl, r32, hi), kf1 = ld_frag8(sl, 32 + r32, hi);
      SBAR();
      sa0 = MX_FP8_FP8(kf0, qa, sa0); sa1 = MX_FP8_FP8(kf1, qa, sa1);
      SBAR();
      sb0 = MX_FP8_FP8(kf0, qb, sb0); sb1 = MX_FP8_FP8(kf1, qb, sb1);
      SBAR();
      const i32x8 pa = att8_pack(sa0, sa1);
      const i32x8 vf0 = ld_frag8(sl + 4096, r32, hi), vf1 = ld_frag8(sl + 4096, 32 + r32, hi);
      SBAR();
      oa0 = MX_BF8_FP8(pa, vf0, oa0); oa1 = MX_BF8_FP8(pa, vf1, oa1); ola = MX_BF8_FP8(pa, ones, ola);
      const i32x8 pb = att8_pack(sb0, sb1);
      SBAR();
      ob0 = MX_BF8_FP8(pb, vf0, ob0); ob1 = MX_BF8_FP8(pb, vf1, ob1); olb = MX_BF8_FP8(pb, ones, olb);
    }
  }
#undef A8_DMA
  asm volatile("s_waitcnt lgkmcnt(0)" ::: "memory"); __builtin_amdgcn_s_barrier();
  bf16_t* Og = MIX + (size_t)(row0 + wid * 32) * D + hp * 128 + r32;
#pragma unroll
  for (int r = 0; r < 16; ++r) {
    const int orow = crow(r, hi);
    const float ra = __builtin_amdgcn_rcpf(ola[r]), rb = __builtin_amdgcn_rcpf(olb[r]);
    Og[(size_t)orow * D] = f2bf(oa0[r] * ra); Og[(size_t)orow * D + 32] = f2bf(oa1[r] * ra);
    Og[(size_t)orow * D + 64] = f2bf(ob0[r] * rb); Og[(size_t)orow * D + 96] = f2bf(ob1[r] * rb);
  }
  __syncthreads();
}
__device__ __forceinline__ void attn_fallback(const Params& p, int layer, int bid, int nblk) {
  const bf16_t* Q = (const bf16_t*)(p.ws + OFF_Q); const bf16_t* Kb = (const bf16_t*)(p.ws + OFF_K); const bf16_t* Vb = (const bf16_t*)(p.ws + OFF_V);
  bf16_t* MIX = (bf16_t*)(p.ws + OFF_MIX);
  const int lane = TIDX & 63, nwv = nblk * 8;
  const int rg0 = layer == 0 ? 0 : NCTX / 64;
  for (int wv = bid * 8 + (TIDX >> 6) + rg0 * 8; wv < (TT / 64) * 8; wv += nwv) {
    const int head = wv & 7, r = (wv >> 3) * 64 + lane, kvh = head >> 2;
    float q[64], o[64];
#pragma unroll
    for (int d = 0; d < 64; ++d) { q[d] = bf2f(Q[(size_t)r * 512 + head * 64 + d]); o[d] = 0.f; }
    float m = -1e30f, l = 0.f;
    const int nk = r >= NCTX ? TT : NCTX;
    for (int j = 0; j < nk; ++j) {
      const bf16_t* kr = Kb + (size_t)j * 128 + kvh * 64;
      const bf16_t* vr = Vb + (size_t)j * 128 + kvh * 64;
      float s = 0.f;
#pragma unroll
      for (int d = 0; d < 64; ++d) s += q[d] * bf2f(kr[d]);
      if (s > m) {
        const float a = __builtin_amdgcn_exp2f(m - s);
        l *= a;
#pragma unroll
        for (int d = 0; d < 64; ++d) o[d] *= a;
        m = s;
      }
      const float pe = __builtin_amdgcn_exp2f(s - m);
      l += pe;
#pragma unroll
      for (int d = 0; d < 64; ++d) o[d] += pe * bf2f(vr[d]);
    }
    const float il = 1.f / l;
#pragma unroll
    for (int d = 0; d < 64; ++d) MIX[(size_t)r * D + head * 64 + d] = f2bf(o[d] * il);
  }
}

constexpr int PC_U = 0;
constexpr int PC_Y = 49152;
constexpr int PC_P = PC_Y + 65536;
constexpr int PC_LDS = PC_P + 32768;
__device__ __forceinline__ void poolconv_unit(const Params& p, int layer, LAS char* lds, int tile) {
  const int tid = TIDX, wid = tid >> 6, lane = tid & 63, r32 = lane & 31, hi = lane >> 5;
  const int t0 = tile * 64, base = tile < 4 ? 0 : NCTX, n = tile < 4 ? NCTX : SEQ;
  const bf16_t* AG = (const bf16_t*)(p.ws + OFF_AG);
  const float* U = (const float*)(p.ws + OFF_U);
  bf16_t* MIX = (bf16_t*)(p.ws + OFF_MIX);
#pragma unroll
  for (int h = 0; h < 2; ++h) {
    u32x4 av[3], gv[3]; bool in[3];
#pragma unroll
    for (int q = 0; q < 3; ++q) {
      const int idx = tid + (h * 3 + q) * 512, rr = idx >> 5, ch = (idx & 31) * 8, t = t0 - 15 + rr;
      in[q] = idx < 94 * 32 && t >= base && t < base + n;
      const size_t off = (size_t)(in[q] ? t : t0) * 512 + ch;
      av[q] = *(const u32x4*)(AG + off); gv[q] = *(const u32x4*)(AG + off + 256);
    }
#pragma unroll
    for (int q = 0; q < 3; ++q) {
      const int idx = tid + (h * 3 + q) * 512, rr = idx >> 5, ch = (idx & 31) * 8;
      u32x4 out = {0u, 0u, 0u, 0u};
      if (in[q]) {
#pragma unroll
        for (int i = 0; i < 4; ++i) {
          const float a0 = __uint_as_float(av[q][i] << 16), a1 = __uint_as_float(av[q][i] & 0xffff0000u);
          const float g0 = __uint_as_float(gv[q][i] << 16), g1 = __uint_as_float(gv[q][i] & 0xffff0000u);
          out[i] = cvtpk(a0 / (1.f + __expf(-g0)), a1 / (1.f + __expf(-g1)));
        }
      }
      if (idx < 94 * 32) *(LAS u32x4*)(lds + PC_U + (rr * 256 + ch) * 2) = out;
    }
  }
  __syncthreads();
  {
    const int c = tid & 255, th = tid >> 8;
    float w[31];
#pragma unroll
    for (int j = 0; j < 31; ++j) w[j] = p.w_dw[(size_t)layer * 31 * 256 + j * 256 + c];
    const float b = p.b_dw[layer * 256 + c];
    float acc[32];
#pragma unroll
    for (int i = 0; i < 32; ++i) acc[i] = b;
    const LAS bf16_t* up = (const LAS bf16_t*)(lds + PC_U) + (th * 32) * 256 + c;
#pragma unroll
    for (int rr = 0; rr < 62; ++rr) {
      const float uv = bf2f(up[rr * 256]);
#pragma unroll
      for (int i = 0; i < 32; ++i) if (rr - i >= 0 && rr - i < 31) acc[i] += uv * w[rr - i];
    }
    LAS float* yp = (LAS float*)(lds + PC_Y) + (th * 32) * 256 + c;
#pragma unroll
    for (int i = 0; i < 32; ++i) yp[i * 256] = acc[i];
  }
  {
    const int c = tid & 255, th = tid >> 8, grp = c >> 6, w = 2 << grp, hw = w >> 1;
    const int tl0 = t0 - base + th * 32;
    float uv[48];
#pragma unroll
    for (int i = 0; i < 48; ++i) { const int j = tl0 - 8 + i; const bool in = j >= 0 && j < n; uv[i] = in ? U[(size_t)(base + j) * 256 + c] : 0.f; }
#pragma unroll
    for (int i = 0; i < 32; ++i) {
      const int tl = tl0 + i, lo = max(tl - hw, 0), hh = min(tl + hw, n);
      float s = 0.f;
#pragma unroll
      for (int d = -8; d < 8; ++d) if (d >= -hw && d < hw) s += uv[8 + i + d];
      const float pv = s / (float)(hh - lo) - uv[8 + i];
      const int tok = th * 32 + i, chunk = c >> 3, sw = (chunk & 16) | ((chunk ^ tok) & 15);
      *(LAS bf16_t*)(lds + PC_P + tok * 512 + sw * 16 + (c & 7) * 2) = f2bf(pv);
    }
  }
  __syncthreads();
  {
    const f32x4 g4 = *(const f32x4*)(p.cv_ln_g + layer * 256 + lane * 4), b4 = *(const f32x4*)(p.cv_ln_b + layer * 256 + lane * 4);
#pragma unroll
    for (int i = 0; i < 8; ++i) {
      const int tok = wid * 8 + i;
      const f32x4 y = *(const LAS f32x4*)(lds + PC_Y + (tok * 256 + lane * 4) * 4);
      const float mu = wave_sum(y[0] + y[1] + y[2] + y[3]) * (1.f / 256.f);
      const float d0 = y[0] - mu, d1 = y[1] - mu, d2 = y[2] - mu, d3 = y[3] - mu;
      const float rs = rsqrtf(wave_sum(d0 * d0 + d1 * d1 + d2 * d2 + d3 * d3) * (1.f / 256.f) + EPS);
      const float z0 = silu(d0 * rs * g4[0] + b4[0]), z1 = silu(d1 * rs * g4[1] + b4[1]), z2 = silu(d2 * rs * g4[2] + b4[2]), z3 = silu(d3 * rs * g4[3] + b4[3]);
      const int chunk = lane >> 1, sw = (chunk & 16) | ((chunk ^ tok) & 15);
      *(LAS u32x2*)(lds + PC_U + tok * 512 + sw * 16 + (lane & 1) * 8) = (u32x2){cvtpk(z0, z1), cvtpk(z2, z3)};
    }
  }
  __syncthreads();
  {
    const int tb = wid >> 2, dg = wid & 3, trow = tb * 32 + r32, t = t0 + trow;
    const bf16_t* Wt = (const bf16_t*)(p.ws + OFF_WPWT) + ((size_t)layer * 256 + dg * 64 + r32) * 256 + hi * 8;
    f32x16 acc0 = {}, acc1 = {};
#pragma unroll 8
    for (int ks = 0; ks < 16; ++ks) {
      const int chunk = 2 * ks + hi, sw = (chunk & 16) | ((chunk ^ trow) & 15);
      const bf16x8 zf = *(const LAS bf16x8*)(lds + PC_U + trow * 512 + sw * 16);
      const bf16x8 w0 = *(const bf16x8*)(Wt + ks * 16), w1 = *(const bf16x8*)(Wt + 32 * 256 + ks * 16);
      acc0 = __builtin_amdgcn_mfma_f32_32x32x16_bf16(w0, zf, acc0, 0, 0, 0);
      acc1 = __builtin_amdgcn_mfma_f32_32x32x16_bf16(w1, zf, acc1, 0, 0, 0);
    }
    bf16_t* dst = MIX + (size_t)t * D + 768 + dg * 64;
#pragma unroll
    for (int g = 0; g < 4; ++g) { *(u32x2*)(dst + 8 * g + 4 * hi) = pack4(acc0, g); *(u32x2*)(dst + 32 + 8 * g + 4 * hi) = pack4(acc1, g); }
    const bf16_t* Pt = (const bf16_t*)(p.ws + OFF_WPOOLT) + ((size_t)(layer * 4 + dg) * 64 + r32) * 64 + hi * 8;
    f32x16 pc0 = {}, pc1 = {};
#pragma unroll
    for (int ks = 0; ks < 4; ++ks) {
      const int chunk = dg * 8 + 2 * ks + hi, sw = (chunk & 16) | ((chunk ^ trow) & 15);
      const bf16x8 pf = *(const LAS bf16x8*)(lds + PC_P + trow * 512 + sw * 16);
      const bf16x8 w0 = *(const bf16x8*)(Pt + ks * 16), w1 = *(const bf16x8*)(Pt + 32 * 64 + ks * 16);
      pc0 = __builtin_amdgcn_mfma_f32_32x32x16_bf16(w0, pf, pc0, 0, 0, 0);
      pc1 = __builtin_amdgcn_mfma_f32_32x32x16_bf16(w1, pf, pc1, 0, 0, 0);
    }
    const float* psc = p.pool_scale + layer * 256 + dg * 64;
#pragma unroll
    for (int r = 0; r < 16; ++r) { pc0[r] *= psc[crow(r, hi)]; pc1[r] *= psc[32 + crow(r, hi)]; }
    bf16_t* pd = MIX + (size_t)t * D + 512 + dg * 64;
#pragma unroll
    for (int g = 0; g < 4; ++g) { *(u32x2*)(pd + 8 * g + 4 * hi) = pack4(pc0, g); *(u32x2*)(pd + 32 + 8 * g + 4 * hi) = pack4(pc1, g); }
  }
  __syncthreads();
}

__device__ __forceinline__ void phase_b(const Params& p, int layer, LAS char* lds, int bid, int nblk) {
  const int mode0 = ((const int*)(p.ws + OFF_FLAG))[0], vbig = ((const int*)(p.ws + OFF_FLAG))[1];
  const int mode = (mode0 == 2 && vbig != 0) ? 1 : mode0;
  const bool fast = mode != 0;
  const int nu = (520 - bid + nblk - 1) / nblk;
  for (int i = 0; i < nu; ++i) {
    const int u = bid + ((bid & 1) ? (nu - 1 - i) : i) * nblk;
    if (u < 256) { if (mode == 2) attn_unit8(p, lds, NCTX + (u >> 2) * 256, u & 3, TT); else if (mode == 1) attn_unit(p, lds, NCTX + (u >> 2) * 256, u & 3, TT); }
    else if (u < 260) { if (layer == 0) { if (mode == 2) attn_unit8(p, lds, 0, u - 256, NCTX); else if (mode == 1) attn_unit(p, lds, 0, u - 256, NCTX); } }
    else { const int tile = u - 260; if (layer == 0 || tile >= 4) poolconv_unit(p, layer, lds, tile); }
  }
  if (!fast) attn_fallback(p, layer, bid, nblk);
}

constexpr int NR = 2, NRA = 2;
__device__ __forceinline__ float hsum4(const f32x4 (&v)[4]) { float s = 0.f;
#pragma unroll
  for (int i = 0; i < 4; ++i) s += (v[i][0] + v[i][1]) + (v[i][2] + v[i][3]);
  return s; }
__device__ __forceinline__ float hsq4(const f32x4 (&v)[4], float mu) { float q = 0.f;
#pragma unroll
  for (int i = 0; i < 4; ++i) { const f32x4 d = v[i] - mu; q += (d[0] * d[0] + d[1] * d[1]) + (d[2] * d[2] + d[3] * d[3]); }
  return q; }
__device__ __forceinline__ f32x4 bf4(u32x2 w) { return (f32x4){__uint_as_float(w[0] << 16), __uint_as_float(w[0] & 0xffff0000u), __uint_as_float(w[1] << 16), __uint_as_float(w[1] & 0xffff0000u)}; }

__device__ __forceinline__ void phase_a0(const Params& p, int layer, int bid, int nblk) {
  const int wave = bid * 8 + (TIDX >> 6), lane = TIDX & 63, nw = nblk * 8;
  float* X = (float*)(p.ws + OFF_X);
  bf16_t* H = (bf16_t*)(p.ws + OFF_H);
  const bf16_t* OM = (const bf16_t*)(p.ws + OFF_OMOE);
  for (int rb = wave * NRA; rb < TT; rb += nw * NRA) {
    f32x4 v[NRA][4]; u32x2 oa[NRA][4], ob[NRA][4];
#pragma unroll
    for (int k = 0; k < NRA; ++k) {
      const int r = rb + k;
      const float* src = layer == 0 ? (r < NCTX ? p.ctx + (size_t)r * D : p.x + (size_t)(r - NCTX) * D) : X + (size_t)r * D;
#pragma unroll
      for (int i = 0; i < 4; ++i) { const int c = i * 256 + lane * 4; v[k][i] = *(const f32x4*)(src + c);
        if (layer != 0) { oa[k][i] = *(const u32x2*)(OM + ((size_t)r * 2 + 0) * D + c); ob[k][i] = *(const u32x2*)(OM + ((size_t)r * 2 + 1) * D + c); } }
    }
    if (layer != 0) {
#pragma unroll
      for (int k = 0; k < NRA; ++k) {
        const int r = rb + k, s = r < NCTX ? 1 : 0;
        const float* g2 = (const float*)(p.ws + OFF_MOD) + ((layer - 1) * 2 + s) * 6144 + 5 * D;
        const float ga = ((const float*)(p.ws + OFF_GATE))[r * 2], gb = ((const float*)(p.ws + OFF_GATE))[r * 2 + 1];
#pragma unroll
        for (int i = 0; i < 4; ++i) { const int c = i * 256 + lane * 4; v[k][i] = v[k][i] * ALPHA + *(const f32x4*)(g2 + c) * (bf4(oa[k][i]) * ga + bf4(ob[k][i]) * gb); }
      }
      float mu[NRA], rs[NRA];
#pragma unroll
      for (int k = 0; k < NRA; ++k) mu[k] = wave_sum(hsum4(v[k])) * (1.f / D);
#pragma unroll
      for (int k = 0; k < NRA; ++k) rs[k] = rsqrtf(wave_sum(hsq4(v[k], mu[k])) * (1.f / D) + EPS);
      const float* g = p.ln2_g + (layer - 1) * D; const float* b = p.ln2_b + (layer - 1) * D;
#pragma unroll
      for (int k = 0; k < NRA; ++k)
#pragma unroll
        for (int i = 0; i < 4; ++i) { const int c = i * 256 + lane * 4; v[k][i] = (v[k][i] - mu[k]) * rs[k] * *(const f32x4*)(g + c) + *(const f32x4*)(b + c); *(f32x4*)(X + (size_t)(rb + k) * D + c) = v[k][i]; }
    }
    float mu[NRA], rs[NRA];
#pragma unroll
    for (int k = 0; k < NRA; ++k) mu[k] = wave_sum(hsum4(v[k])) * (1.f / D);
#pragma unroll
    for (int k = 0; k < NRA; ++k) rs[k] = rsqrtf(wave_sum(hsq4(v[k], mu[k])) * (1.f / D) + EPS);
#pragma unroll
    for (int k = 0; k < NRA; ++k) {
      const int r = rb + k, s = r < NCTX ? 1 : 0;
      const float* modp = (const float*)(p.ws + OFF_MOD) + (layer * 2 + s) * 6144;
#pragma unroll
      for (int i = 0; i < 4; ++i) {
        const int c = i * 256 + lane * 4;
        const f32x4 h = (v[k][i] - mu[k]) * rs[k] * (*(const f32x4*)(modp + D + c) + 1.f) + *(const f32x4*)(modp + c);
        *(u32x2*)(H + (size_t)r * D + c) = (u32x2){cvtpk(h[0], h[1]), cvtpk(h[2], h[3])};
      }
    }
  }
}

constexpr int C2_ENT = 2048;
constexpr int C2_WRE = C2_ENT, C2_WRG = C2_WRE + 131072, C2_PAR = C2_WRG + 16384, C2_LDS = C2_PAR + 12288;
__device__ __forceinline__ void phase_c2(const Params& p, int layer, LAS char* lds, int bid, int nblk) {
  const int tid = TIDX, wid = __builtin_amdgcn_readfirstlane(tid >> 6), lane = tid & 63;
  float* X = (float*)(p.ws + OFF_X);
  const bf16_t* Y = (const bf16_t*)(p.ws + OFF_Y);
  bf16_t* H2 = (bf16_t*)(p.ws + OFF_MIX);
  int* cnt = (int*)(p.ws + OFF_CNT) + layer * NE * CNT_STRIDE;
  float* GATE = (float*)(p.ws + OFF_GATE); int* LIST = (int*)(p.ws + OFF_LIST);
  LAS int* lcnt = (LAS int*)lds;
  LAS int* lbase = lcnt + 32;
  LAS int* ent = lcnt + 64;
  if (tid < 32) lcnt[tid] = 0;
  LAS float* wre = (LAS float*)(lds + C2_WRE);
#pragma unroll
  for (int kk = 0; kk < 2; ++kk) {
    const int k = tid + kk * 512;
    f32x4 w[8];
#pragma unroll
    for (int g = 0; g < 8; ++g) w[g] = *(const f32x4*)(p.w_re + ((size_t)layer * D + k) * 32 + g * 4);
#pragma unroll
    for (int g = 0; g < 8; ++g)
#pragma unroll
      for (int j = 0; j < 4; ++j) wre[(g * 4 + j) * 1024 + k] = w[g][j];
  }
  LAS f32x4* wrg = (LAS f32x4*)(lds + C2_WRG);
#pragma unroll
  for (int kk = 0; kk < 2; ++kk) { const int k = tid + kk * 512; wrg[((k >> 8) * 4 + (k & 3)) * 64 + ((k >> 2) & 63)] = *(const f32x4*)(p.w_rg + ((size_t)layer * D + k) * 4); }
  LAS float* par = (LAS float*)(lds + C2_PAR);
  { const float* modl = (const float*)(p.ws + OFF_MOD) + (layer * 2 + 0) * 6144;
#pragma unroll
    for (int q = 0; q < 6; ++q) { const int e = tid + q * 512; par[e] = modl[2 * D + e]; } }
  f32x4 l1g[4], l1b[4];
#pragma unroll
  for (int i = 0; i < 4; ++i) { const int c = i * 256 + lane * 4; l1g[i] = *(const f32x4*)(p.ln1_g + layer * D + c); l1b[i] = *(const f32x4*)(p.ln1_b + layer * D + c); }
  __syncthreads();
  const int r0 = layer == 0 ? 0 : NCTX, nrows = TT - r0, rpb = (nrows + nblk - 1) / nblk;
  const int rbeg = r0 + bid * rpb, rend = min(rbeg + rpb, TT);
  f32x4 xn[NR][4]; u32x2 yn[NR][4];
#define C2_LOAD(rb_) do { _Pragma("unroll") for (int k = 0; k < NR; ++k) { \
      const int r = (rb_) + k < rend ? (rb_) + k : (rb_); \
      const float* xin = layer == 0 ? (r < NCTX ? p.ctx + (size_t)r * D : p.x + (size_t)(r - NCTX) * D) : X + (size_t)r * D; \
      _Pragma("unroll") for (int i = 0; i < 4; ++i) { const int c = i * 256 + lane * 4; xn[k][i] = *(const f32x4*)(xin + c); yn[k][i] = *(const u32x2*)(Y + (size_t)r * D + c); } } } while (0)
  if (rbeg + wid * NR < rend) C2_LOAD(rbeg + wid * NR);
  for (int rb = rbeg + wid * NR; rb < rend; rb += 8 * NR) {
    f32x4 v[NR][4]; int rr[NR]; bool ok[NR];
#pragma unroll
    for (int k = 0; k < NR; ++k) {
      ok[k] = rb + k < rend; rr[k] = ok[k] ? rb + k : rb;
      if (rr[k] < NCTX) {
        const float* modp = (const float*)(p.ws + OFF_MOD) + (layer * 2 + 1) * 6144;
#pragma unroll
        for (int i = 0; i < 4; ++i) { const int c = i * 256 + lane * 4; v[k][i] = xn[k][i] * ALPHA + *(const f32x4*)(modp + 2 * D + c) * bf4(yn[k][i]); }
      } else {
#pragma unroll
        for (int i = 0; i < 4; ++i) { const int c = i * 256 + lane * 4; v[k][i] = xn[k][i] * ALPHA + *(const LAS f32x4*)(par + c) * bf4(yn[k][i]); }
      }
    }
    if (rb + 8 * NR < rend) C2_LOAD(rb + 8 * NR);
    float mu[NR], rs[NR];
#pragma unroll
    for (int k = 0; k < NR; ++k) mu[k] = wave_sum(hsum4(v[k])) * (1.f / D);
#pragma unroll
    for (int k = 0; k < NR; ++k) rs[k] = rsqrtf(wave_sum(hsq4(v[k], mu[k])) * (1.f / D) + EPS);
#pragma unroll
    for (int k = 0; k < NR; ++k)
#pragma unroll
      for (int i = 0; i < 4; ++i) {
        const int c = i * 256 + lane * 4;
        v[k][i] = (v[k][i] - mu[k]) * rs[k] * l1g[i] + l1b[i];
        if (ok[k]) *(f32x4*)(X + (size_t)rr[k] * D + c) = v[k][i];
      }
#pragma unroll
    for (int k = 0; k < NR; ++k) mu[k] = wave_sum(hsum4(v[k])) * (1.f / D);
#pragma unroll
    for (int k = 0; k < NR; ++k) rs[k] = rsqrtf(wave_sum(hsq4(v[k], mu[k])) * (1.f / D) + EPS);
#pragma unroll
    for (int k = 0; k < NR; ++k) {
      if (rr[k] < NCTX) {
        const float* modp = (const float*)(p.ws + OFF_MOD) + (layer * 2 + 1) * 6144;
#pragma unroll
        for (int i = 0; i < 4; ++i) { const int c = i * 256 + lane * 4; v[k][i] = (v[k][i] - mu[k]) * rs[k] * (*(const f32x4*)(modp + 4 * D + c) + 1.f) + *(const f32x4*)(modp + 3 * D + c); }
      } else {
#pragma unroll
        for (int i = 0; i < 4; ++i) { const int c = i * 256 + lane * 4; v[k][i] = (v[k][i] - mu[k]) * rs[k] * (*(const LAS f32x4*)(par + 2 * D + c) + 1.f) + *(const LAS f32x4*)(par + D + c); }
      }
#pragma unroll
      for (int i = 0; i < 4; ++i) { const int c = i * 256 + lane * 4;
        if (ok[k]) *(u32x2*)(H2 + (size_t)rr[k] * D + c) = (u32x2){cvtpk(v[k][i][0], v[k][i][1]), cvtpk(v[k][i][2], v[k][i][3])}; }
    }
    f32x4 lg[NR];
#pragma unroll
    for (int k = 0; k < NR; ++k) lg[k] = (f32x4){0.f, 0.f, 0.f, 0.f};
#pragma unroll
    for (int i = 0; i < 4; ++i)
#pragma unroll
      for (int j = 0; j < 4; ++j) { const f32x4 w = wrg[(i * 4 + j) * 64 + lane];
#pragma unroll
        for (int k = 0; k < NR; ++k) lg[k] += w * v[k][i][j]; }
    int gsel[NR]; float pgrp[NR];
#pragma unroll
    for (int k = 0; k < NR; ++k) {
      float l0 = wave_sum(lg[k][0]) + p.b_rg[layer * 4 + 0], l1 = wave_sum(lg[k][1]) + p.b_rg[layer * 4 + 1];
      float l2 = wave_sum(lg[k][2]) + p.b_rg[layer * 4 + 2], l3 = wave_sum(lg[k][3]) + p.b_rg[layer * 4 + 3];
      int gs = 0; float gm = l0;
      if (l1 > gm) { gm = l1; gs = 1; }
      if (l2 > gm) { gm = l2; gs = 2; }
      if (l3 > gm) { gm = l3; gs = 3; }
      gsel[k] = gs; pgrp[k] = 1.f / (__expf(l0 - gm) + __expf(l1 - gm) + __expf(l2 - gm) + __expf(l3 - gm));
    }
#pragma unroll
    for (int k = 0; k < NR; ++k) {
      float le[8];
#pragma unroll
      for (int e = 0; e < 8; ++e) {
        const LAS float* wr = wre + (gsel[k] * 8 + e) * 1024 + lane * 4;
        float a = 0.f;
#pragma unroll
        for (int i = 0; i < 4; ++i) { const f32x4 w = *(const LAS f32x4*)(wr + i * 256); a += (w[0] * v[k][i][0] + w[1] * v[k][i][1]) + (w[2] * v[k][i][2] + w[3] * v[k][i][3]); }
        le[e] = a;
      }
#pragma unroll
      for (int e = 0; e < 8; ++e) le[e] = wave_sum(le[e]) + p.b_re[layer * 32 + gsel[k] * 8 + e];
      int i0 = 0; float v0 = le[0];
#pragma unroll
      for (int e = 1; e < 8; ++e) if (le[e] > v0) { v0 = le[e]; i0 = e; }
      int i1 = -1; float v1 = -3.0e38f;
#pragma unroll
      for (int e = 0; e < 8; ++e) if (e != i0 && le[e] > v1) { v1 = le[e]; i1 = e; }
      if (i1 < 0) { i1 = (i0 + 1) & 7; v1 = v0; }
      const float e1 = __expf(v1 - v0);
      if (lane == 0 && ok[k]) {
        const int r = rr[k], xa = gsel[k] * 8 + i0, xb = gsel[k] * 8 + i1;
        const int pa = __hip_atomic_fetch_add(&lcnt[xa], 1, __ATOMIC_RELAXED, __HIP_MEMORY_SCOPE_WORKGROUP);
        const int pb = __hip_atomic_fetch_add(&lcnt[xb], 1, __ATOMIC_RELAXED, __HIP_MEMORY_SCOPE_WORKGROUP);
        const int li = (r - rbeg) * 2;
        ent[li * 3 + 0] = xa; ent[li * 3 + 1] = pa; ent[li * 3 + 2] = r * 2 + 0;
        ent[li * 3 + 3] = xb; ent[li * 3 + 4] = pb; ent[li * 3 + 5] = r * 2 + 1;
        GATE[r * 2] = pgrp[k] / (1.f + e1); GATE[r * 2 + 1] = pgrp[k] * e1 / (1.f + e1);
      }
    }
  }
  __syncthreads();
  if (tid < 32) { const int c = lcnt[tid]; lbase[tid] = c > 0 ? atomicAdd(&cnt[tid * CNT_STRIDE], c) : 0; }
  __syncthreads();
  for (int i = tid; i < (rend - rbeg) * 2; i += 512) { const int e = ent[i * 3], lp = ent[i * 3 + 1]; LIST[(size_t)e * CAPL + lbase[e] + lp] = ent[i * 3 + 2]; }
  __syncthreads();
#undef C2_LOAD
}

__device__ __forceinline__ void phase_final(const Params& p, int bid, int nblk) {
  const int wave = bid * 8 + (TIDX >> 6), lane = TIDX & 63, nw = nblk * 8;
  const float* X = (const float*)(p.ws + OFF_X);
  const bf16_t* OM = (const bf16_t*)(p.ws + OFF_OMOE);
  const float* g2 = (const float*)(p.ws + OFF_MOD) + (1 * 2 + 0) * 6144 + 5 * D;
  for (int rb = NCTX + wave * NRA; rb < TT; rb += nw * NRA) {
    f32x4 v[NRA][4]; u32x2 oa[NRA][4], ob[NRA][4];
#pragma unroll
    for (int k = 0; k < NRA; ++k)
#pragma unroll
      for (int i = 0; i < 4; ++i) { const int c = i * 256 + lane * 4, r = rb + k;
        v[k][i] = *(const f32x4*)(X + (size_t)r * D + c); oa[k][i] = *(const u32x2*)(OM + ((size_t)r * 2 + 0) * D + c); ob[k][i] = *(const u32x2*)(OM + ((size_t)r * 2 + 1) * D + c); }
#pragma unroll
    for (int k = 0; k < NRA; ++k) {
      const float ga = ((const float*)(p.ws + OFF_GATE))[(rb + k) * 2], gb = ((const float*)(p.ws + OFF_GATE))[(rb + k) * 2 + 1];
#pragma unroll
      for (int i = 0; i < 4; ++i) { const int c = i * 256 + lane * 4; v[k][i] = v[k][i] * ALPHA + *(const f32x4*)(g2 + c) * (bf4(oa[k][i]) * ga + bf4(ob[k][i]) * gb); }
    }
    float mu[NRA], rs[NRA];
#pragma unroll
    for (int k = 0; k < NRA; ++k) mu[k] = wave_sum(hsum4(v[k])) * (1.f / D);
#pragma unroll
    for (int k = 0; k < NRA; ++k) rs[k] = rsqrtf(wave_sum(hsq4(v[k], mu[k])) * (1.f / D) + EPS);
#pragma unroll
    for (int k = 0; k < NRA; ++k)
#pragma unroll
      for (int i = 0; i < 4; ++i) {
        const int c = i * 256 + lane * 4;
        *(f32x4*)(p.out + (size_t)(rb + k - NCTX) * D + c) = (v[k][i] - mu[k]) * rs[k] * *(const f32x4*)(p.ln2_g + D + c) + *(const f32x4*)(p.ln2_b + D + c);
      }
  }
}

__device__ __forceinline__ void phase_p0(const Params& p, LAS char* lds, int bid, int nblk) {
  const int tid = TIDX;
  const long gtid = (long)bid * 512 + tid, gth = (long)nblk * 512;
  LAS float* sc = (LAS float*)lds;
  LAS float* red = (LAS float*)(lds + 8192);
  for (int i = tid; i < 2048; i += 512) { const float v = i < 1024 ? p.c[i] : p.c_ctx[i - 1024]; sc[i] = silu(v); }
  __syncthreads();
  float* mod = (float*)(p.ws + OFF_MOD);
  for (int u = bid; u < 384; u += nblk) {
    const int layer = u / 192, cg = u % 192, col = tid & 31, ksl = tid >> 5;
    const float* w = p.w_mod + ((size_t)layer * D + ksl * 64) * 6144 + cg * 32 + col;
    float a0 = 0.f, a1 = 0.f;
#pragma unroll 8
    for (int k = 0; k < 64; ++k) { const float wv = w[(size_t)k * 6144]; a0 += sc[ksl * 64 + k] * wv; a1 += sc[1024 + ksl * 64 + k] * wv; }
    red[(ksl * 32 + col) * 2] = a0; red[(ksl * 32 + col) * 2 + 1] = a1;
    __syncthreads();
    if (tid < 64) {
      const int c2 = tid & 31, s = tid >> 5; float a = 0.f;
#pragma unroll
      for (int k = 0; k < 16; ++k) a += red[(k * 32 + c2) * 2 + s];
      mod[(layer * 2 + s) * 6144 + cg * 32 + c2] = a + p.b_mod[layer * 6144 + cg * 32 + c2];
    }
    __syncthreads();
  }
  if (gtid < 256 * 16) {
    const int pos = (int)gtid / 16, f = (int)gtid % 16;
    const float ang = (float)pos * powf(10000.f, -(float)f / 16.f);
    float* rt = (float*)(p.ws + OFF_ROPE);
    rt[gtid * 2 + 0] = cosf(ang); rt[gtid * 2 + 1] = sinf(ang);
  }
  if (gtid < 2 * NE * CNT_STRIDE) ((int*)(p.ws + OFF_CNT))[gtid] = 0;
  if (gtid == 0) {
    float bmax = 0.f;
    for (int l = 0; l < 2; ++l) {
      float gq = 0.f, gk = 0.f;
      for (int i = 0; i < 64; ++i) { gq = fmaxf(gq, fabsf(p.q_gain[l * 64 + i])); gk = fmaxf(gk, fabsf(p.k_gain[l * 64 + i])); }
      bmax = fmaxf(bmax, 11.55f * gq * gk);
    }
    ((int*)(p.ws + OFF_FLAG))[0] = bmax <= 13.2f ? 2 : (bmax <= 100.f ? 1 : 0);
    ((int*)(p.ws + OFF_FLAG))[1] = 0;
  }
  for (long i = gtid; i < 2 * 65536; i += gth) { const int l = (int)(i >> 16), d = (int)(i >> 8) & 255, c = (int)i & 255; ((bf16_t*)(p.ws + OFF_WPWT))[i] = f2bf(p.w_cv_pw[((size_t)l * 256 + c) * 256 + d]); }
  for (long i = gtid; i < 8 * 4096; i += gth) { const int lg = (int)(i >> 12), d = (int)(i >> 6) & 63, c = (int)i & 63; ((bf16_t*)(p.ws + OFF_WPOOLT))[i] = f2bf(p.w_pool[((size_t)lg * 64 + c) * 64 + d]); }
  cvt_range(p.w_in, (bf16_t*)(p.ws + OFF_WIN), 2L * D * INW / 8, gtid, gth);
  cvt_range(p.w_out, (bf16_t*)(p.ws + OFF_WOUT), 2L * D * D / 8, gtid, gth);
}
#define XB_TMO      128
#define XB_XCNT(j)  (256  + 64 * (j))
#define XB_XSUB(j)  (1280 + 64 * (j))
#define XB_XGEN(j)  (2304 + 64 * (j))
#define XB_TOP      3328
#define XB_TOPGEN   3392
#define XCD_BAR_WORDS 3456
#define XB_SPIN_CAP (1u << 22)
__device__ __forceinline__ unsigned xb_ld(unsigned* p)              { return __hip_atomic_load(p, __ATOMIC_RELAXED, __HIP_MEMORY_SCOPE_AGENT); }
__device__ __forceinline__ unsigned xb_add(unsigned* p, unsigned v) { return __hip_atomic_fetch_add(p, v, __ATOMIC_RELAXED, __HIP_MEMORY_SCOPE_AGENT); }
__device__ __forceinline__ unsigned xb_xcc_id() { return (unsigned)__builtin_amdgcn_s_getreg((3 << 11) | 20) & 0xFu; }
#define XB_SPIN(cond, bar) do { unsigned _sp = 0; while (cond) { __builtin_amdgcn_s_sleep(1); \
    if ((++_sp & 255u) == 0u) { if (xb_ld(&(bar)[XB_TMO])) break; if (_sp > XB_SPIN_CAP) { atomicAdd(&(bar)[XB_TMO], 1u); break; } } } } while (0)
struct XcdBarrier { unsigned* bar; unsigned x; volatile LAS unsigned* st; };
__device__ __forceinline__ XcdBarrier xcd_barrier_post(unsigned* bar, volatile LAS unsigned* st) {
  XcdBarrier b; b.bar = bar; b.x = xb_xcc_id(); b.st = st;
  if (threadIdx.x == 0) (void)xb_add(&bar[XB_XCNT(b.x)], 1u);
  return b;
}
__device__ __forceinline__ void xcd_barrier_complete(unsigned* bar, unsigned x, unsigned& nloc, unsigned& nx) {
  const unsigned G = gridDim.x * gridDim.y * gridDim.z;
  unsigned sum, cnt, mine, sp = 0u;
  for (;;) {
    sum = 0u; cnt = 0u; mine = 0u;
#pragma unroll
    for (unsigned j = 0; j < 16; ++j) { const unsigned c = xb_ld(&bar[XB_XCNT(j)]); sum += c; cnt += (c > 0u) ? 1u : 0u; mine = (j == x) ? c : mine; }
    if (sum == G) break;
    __builtin_amdgcn_s_sleep(1);
    if ((++sp & 255u) == 0u) { if (xb_ld(&bar[XB_TMO])) break; if (sp > XB_SPIN_CAP) { atomicAdd(&bar[XB_TMO], 1u); break; } }
  }
  nloc = mine > 0u ? mine : 1u; nx = cnt > 0u ? cnt : 1u;
}
__device__ __forceinline__ void xcd_barrier(const XcdBarrier& b) {
  asm volatile("s_waitcnt vmcnt(0)" ::: "memory");
  __syncthreads();
  if (threadIdx.x == 0) {
    unsigned* bar = b.bar; unsigned bx = b.x;
    asm volatile("" : "+s"(bar), "+s"(bx));
    __builtin_amdgcn_s_waitcnt(0);
    unsigned nloc = b.st[0], nx = b.st[1];
    if (nloc == 0u) { xcd_barrier_complete(bar, bx, nloc, nx); b.st[0] = nloc; b.st[1] = nx; }
    const unsigned old = xb_add(&bar[XB_XSUB(bx)], 1u);
    const unsigned gen = old / nloc;
    if (old + 1u == (gen + 1u) * nloc) {
      __builtin_amdgcn_fence(__ATOMIC_RELEASE, "agent");
      asm volatile("s_waitcnt vmcnt(0)" ::: "memory");
      const unsigned og = xb_add(&bar[XB_TOP], 1u);
      const unsigned tg = og / nx;
      if (og + 1u == (tg + 1u) * nx) xb_add(&bar[XB_TOPGEN], 1u);
      else XB_SPIN(xb_ld(&bar[XB_TOPGEN]) == tg, bar);
      __builtin_amdgcn_fence(__ATOMIC_ACQUIRE, "agent");
      xb_add(&bar[XB_XGEN(bx)], 1u);
      asm volatile("s_waitcnt vmcnt(0)" ::: "memory");
    } else {
      XB_SPIN(xb_ld(&bar[XB_XGEN(bx)]) == gen, bar);
      __builtin_amdgcn_fence(__ATOMIC_ACQUIRE, "agent");
      asm volatile("s_waitcnt vmcnt(0)" ::: "memory");
    }
  }
  __syncthreads();
}

constexpr int LDS_MAIN0 = PC_LDS > GEMM_LDS + 512 ? PC_LDS : GEMM_LDS + 512;
constexpr int LDS_MAIN = LDS_MAIN0 > C2_LDS ? LDS_MAIN0 : C2_LDS;
constexpr int LDS_TOTAL = LDS_MAIN + 16;
static_assert(GEMM_LDS + 512 <= LDS_MAIN && ATT_LDS <= LDS_MAIN && LDS_MAIN + 16 <= 163840, "lds");
__global__ void __launch_bounds__(512) mega_fwd(Params p) {
  __shared__ __attribute__((aligned(16))) char slds[LDS_TOTAL];
  LAS char* lds = (LAS char*)slds;
  volatile LAS unsigned* st = (volatile LAS unsigned*)(lds + LDS_MAIN);
  if (threadIdx.x < 4) st[threadIdx.x] = 0u;
  __syncthreads();
  const XcdBarrier bar = xcd_barrier_post((unsigned*)(p.ws + OFF_BAR), st);
  const int bid = blockIdx.x, nblk = gridDim.x;
  phase_p0(p, lds, bid, nblk);
  xcd_barrier(bar);
#pragma unroll 1
  for (int layer = 0; layer < 2; ++layer) {
    phase_a0(p, layer, bid, nblk);
    xcd_barrier(bar);
    phase_a1(p, layer, lds, bid, nblk);
    xcd_barrier(bar);
    phase_b(p, layer, lds, bid, nblk);
    xcd_barrier(bar);
    phase_c1(p, layer, lds, bid, nblk);
    xcd_barrier(bar);
    phase_c2(p, layer, lds, bid, nblk);
    xcd_barrier(bar);
    phase_d1(p, layer, lds, bid, nblk);
    xcd_barrier(bar);
    phase_d2(p, layer, lds, bid, nblk);
    xcd_barrier(bar);
  }
  phase_final(p, bid, nblk);
}

extern "C" void kernel_launch(void* const* d_in, const int* in_sizes, int n_in, void* d_out, int out_size, void* d_ws, size_t ws_size,
                              hipStream_t stream) {
  static int grid = 0;
  if (grid == 0) {
    if (ws_size < WS_END || n_in != 28) { fprintf(stderr, "kernel_launch: ws too small (%zu < %zu) or n_in %d != 28; nothing launched\n", ws_size, (size_t)WS_END, n_in); grid = -1; return; }
    int dev = 0, cus = 0, per_cu = 0;
    if (hipGetDevice(&dev) != hipSuccess || hipDeviceGetAttribute(&cus, hipDeviceAttributeMultiprocessorCount, dev) != hipSuccess) { grid = -1; return; }
    if (hipOccupancyMaxActiveBlocksPerMultiprocessor(&per_cu, (const void*)mega_fwd, 512, 0) != hipSuccess || per_cu < 1) {
      fprintf(stderr, "kernel_launch: occupancy query says %d blocks per CU; nothing launched\n", per_cu); grid = -1; return; }
    (void)hipGetLastError();
    grid = cus;
  }
  if (grid < 0) return;
  if (hipMemsetAsync((char*)d_ws + OFF_BAR, 0, BAR_BYTES, stream) != hipSuccess) { fprintf(stderr, "kernel_launch: memset failed\n"); return; }
  Params p{};
  const float** f = (const float**)&p;
  for (int i = 0; i < 28; ++i) f[i] = (const float*)d_in[i];
  p.out = (float*)d_out; p.ws = (char*)d_ws;
  hipLaunchKernelGGL(mega_fwd, dim3(grid), dim3(512), 0, stream, p);
}
```

```cpp
#include <hip/hip_runtime.h>
#include <cstdio>
#include <cstdint>

typedef unsigned short bf16_t;
#define LAS __attribute__((address_space(3)))

constexpr int D = 1024, SEQ = 16384, NCTX = 256, TT = SEQ + NCTX;
constexpr int INW = 1536;
constexpr int NE = 32, DE = 512;
constexpr int CAPL = 2 * TT;
constexpr int HMID_ROWS = 2 * TT + NE * 128;
constexpr float ALPHA = 1.41421356237309515f;
constexpr float EPS = 1e-6f;

constexpr size_t al(size_t x) { return (x + 255) / 256 * 256; }
constexpr size_t OFF_BAR = 0;
constexpr size_t BAR_BYTES = 3456 * 4;
constexpr size_t OFF_MOD = OFF_BAR + al(BAR_BYTES);
constexpr size_t OFF_ROPE = OFF_MOD + al(2 * 2 * 6144 * 4);
constexpr int CNT_STRIDE = 32;
constexpr size_t OFF_CNT = OFF_ROPE + al(256 * 16 * 2 * 4);
constexpr size_t OFF_FLAG = OFF_CNT + al(2 * 32 * 32 * 4);
constexpr size_t OFF_X = OFF_FLAG + 256;
constexpr size_t OFF_H = OFF_X + al((size_t)TT * D * 4);
constexpr size_t OFF_MIX = OFF_H + al((size_t)TT * D * 2);
constexpr size_t OFF_Y = OFF_MIX + al((size_t)TT * D * 2);
constexpr size_t OFF_Q = OFF_Y + al((size_t)TT * D * 2);
constexpr size_t OFF_K = OFF_Q + al((size_t)TT * 512 * 2);
constexpr size_t OFF_V = OFF_K + al((size_t)TT * 128 * 2);
constexpr size_t OFF_U = OFF_V + al((size_t)TT * 128 * 2);
constexpr size_t OFF_AG = OFF_U + al((size_t)TT * 256 * 4);
constexpr size_t OFF_HMID = OFF_Q;
constexpr size_t OFF_OMOE = OFF_AG + al((size_t)TT * 512 * 2);
constexpr size_t OFF_GATE = OFF_OMOE + al((size_t)TT * 2 * D * 2);
constexpr size_t OFF_LIST = OFF_GATE + al((size_t)TT * 2 * 4);
constexpr size_t OFF_WIN = OFF_LIST + al((size_t)NE * CAPL * 4);
constexpr size_t OFF_WOUT = OFF_WIN + al((size_t)2 * D * INW * 2);
constexpr size_t OFF_WPWT = OFF_WOUT + al((size_t)2 * D * D * 2);
constexpr size_t OFF_WPOOLT = OFF_WPWT + al((size_t)2 * 256 * 256 * 2);
constexpr size_t OFF_Q8 = OFF_WPOOLT + al((size_t)2 * 4 * 64 * 64 * 2);
constexpr size_t OFF_K8 = OFF_Q8 + al((size_t)TT * 512);
constexpr size_t OFF_VT8 = OFF_K8 + al((size_t)TT * 128);
constexpr size_t OFF_WG = OFF_VT8 + al((size_t)128 * TT);
constexpr size_t OFF_WU = OFF_WG + al((size_t)2 * NE * D * DE * 2);
constexpr size_t OFF_WD = OFF_WU + al((size_t)2 * NE * D * DE * 2);
constexpr size_t WS_END = OFF_WD + al((size_t)2 * NE * D * DE * 2);
static_assert(OFF_AG - OFF_HMID >= (size_t)HMID_ROWS * DE * 2, "HMID alias too small");
static_assert(WS_END < 530000000, "ws budget");

struct Params {
  const float *x, *c, *ctx, *c_ctx, *w_mod, *b_mod, *w_in, *q_gain, *k_gain, *w_pool, *pool_scale, *w_dw, *b_dw,
      *cv_ln_g, *cv_ln_b, *w_cv_pw, *w_out, *ln1_g, *ln1_b, *ln2_g, *ln2_b, *w_rg, *b_rg, *w_re, *b_re, *w_e_gate, *w_e_up, *w_e_down;
  float* out;
  char* ws;
};

__device__ __forceinline__ float bf2f(bf16_t v) { return __uint_as_float(((unsigned)v) << 16); }
__device__ __forceinline__ bf16_t f2bf(float f) {
  unsigned u = __float_as_uint(f);
  u += 0x7fffu + ((u >> 16) & 1u);
  return (bf16_t)(u >> 16);
}
template <int CTRL> __device__ __forceinline__ float dppf(float v) { return __int_as_float(__builtin_amdgcn_update_dpp(0, __float_as_int(v), CTRL, 0xf, 0xf, true)); }
__device__ __forceinline__ float wave_sum(float v) {
  v += dppf<0xB1>(v); v += dppf<0x4E>(v); v += dppf<0x141>(v); v += dppf<0x140>(v);
  { auto r = __builtin_amdgcn_permlane16_swap(__float_as_uint(v), __float_as_uint(v), false, false); v = __uint_as_float(r[0]) + __uint_as_float(r[1]); }
  { auto r = __builtin_amdgcn_permlane32_swap(__float_as_uint(v), __float_as_uint(v), false, false); v = __uint_as_float(r[0]) + __uint_as_float(r[1]); }
  return v;
}
__device__ __forceinline__ float silu(float v) { return v / (1.f + __expf(-v)); }
__device__ __forceinline__ int opaque0() { int z; asm volatile("s_mov_b32 %0, 0" : "=s"(z)); return z; }
#define TIDX ((int)threadIdx.x + opaque0())
using bf16x8 = __attribute__((ext_vector_type(8))) short;
using s16x4 = __attribute__((ext_vector_type(4))) short;
using f32x16 = __attribute__((ext_vector_type(16))) float;
using f32x4 = __attribute__((ext_vector_type(4))) float;
using u32x4 = __attribute__((ext_vector_type(4))) unsigned;
using u32x2 = __attribute__((ext_vector_type(2))) unsigned;

__device__ __forceinline__ int crow(int r, int hi) { return (r & 3) + 8 * (r >> 2) + 4 * hi; }
typedef float f32x2 __attribute__((ext_vector_type(2)));
typedef __bf16 bf16x2v __attribute__((ext_vector_type(2)));
__device__ __forceinline__ unsigned cvtpk(float lo, float hi) {
  bf16x2v b = __builtin_convertvector((f32x2){lo, hi}, bf16x2v);
  return __builtin_bit_cast(unsigned, b);
}
__device__ __forceinline__ float sum32(float v) {
  auto rr = __builtin_amdgcn_permlane32_swap(__float_as_uint(v), __float_as_uint(v), false, false);
  return __uint_as_float(rr[0]) + __uint_as_float(rr[1]);
}

__device__ __forceinline__ void cvt_range(const float* __restrict__ src, bf16_t* __restrict__ dst, long n8, long gtid, long gthreads) {
  for (long i = gtid; i < n8; i += gthreads) {
    const f32x4 a = *(const f32x4*)(src + i * 8), b = *(const f32x4*)(src + i * 8 + 4);
    u32x4 w = {cvtpk(a[0], a[1]), cvtpk(a[2], a[3]), cvtpk(b[0], b[1]), cvtpk(b[2], b[3])};
    *(u32x4*)(dst + i * 8) = w;
  }
}

__device__ __forceinline__ int xoff(int row, int chunk) { return row * 128 + ((chunk ^ ((row >> 1) & 7)) << 4); }
__device__ __forceinline__ int wst(int k, int c) { const int kk = (k & ~0xC) | ((k & 4) << 1) | ((k & 8) >> 1); return ((kk >> 3) * 4 + (c >> 5)) * 512 + ((kk & 7) * 32 + (c & 31)) * 2; }
__device__ __forceinline__ int v_rd_base(int lane) { return ((lane & 3) << 3) | (((lane >> 2) & 3) << 6) | (((lane >> 4) & 1) << 5) | (((lane >> 5) & 1) << 8); }

__device__ __forceinline__ bf16x8 tr_frag(const LAS char* p) {
  s16x4 a = __builtin_amdgcn_ds_read_tr16_b64_v4i16((LAS s16x4*)p);
  s16x4 b = __builtin_amdgcn_ds_read_tr16_b64_v4i16((LAS s16x4*)(p + 2048));
  return (bf16x8){a[0], a[1], a[2], a[3], b[0], b[1], b[2], b[3]};
}

template <int OFF> __device__ __forceinline__ bf16x8 tr_frag_asm(int addr) {
  s16x4 a, b;
  asm volatile("ds_read_b64_tr_b16 %0, %1 offset:%2" : "=&v"(a) : "v"(addr), "i"(OFF) : "memory");
  asm volatile("ds_read_b64_tr_b16 %0, %1 offset:%2" : "=&v"(b) : "v"(addr), "i"(OFF + 2048) : "memory");
  return (bf16x8){a[0], a[1], a[2], a[3], b[0], b[1], b[2], b[3]};
}

template <int BM, int BN> struct GemmCfg {
  static constexpr int WM = BM / 64, WN = 8 / WM, NSLAB = BN / 128, XB = BM * 128, WB = NSLAB * 16384, STAGE = XB + WB, NXP = BM / 64, NWP = NSLAB * 2;
  static_assert(WM * WN == 8 && WN * 64 == BN, "tile");
};
constexpr int GEMM_LDS = 3 * (256 * 128 + 16384);

template <int BM, int BN, int NMAP, bool BG = false, class XRow, class WPtr, class Pre>
__device__ __forceinline__ void gemm_mainloop(LAS char* lds, f32x16 (&acc)[2][2], const XRow& xrow, const WPtr& wptr, const Pre& pre, int sprev, int ldw, int K, int& bgdone, int bgn = 0, long bgc0 = 0,
                                              const float* bs0 = nullptr, const float* bs1 = nullptr, const float* bs2 = nullptr, bf16_t* bd0 = nullptr, bf16_t* bd1 = nullptr, bf16_t* bd2 = nullptr) {
#define BG_ADDR(i, off, SP, DP) long c_ = bgc0 + (long)(i) * 512 + (off); const bool ok_ = c_ < (3L << 21); if (!ok_) c_ = 0; const int t_ = (int)(c_ >> 21); const long o_ = (c_ & 0x1fffff) * 8; \
    const float* SP = (t_ == 0 ? bs0 : (t_ == 1 ? bs1 : bs2)) + o_; bf16_t* DP = (t_ == 0 ? bd0 : (t_ == 1 ? bd1 : bd2)) + o_
#define BG_ISSUE(i, off, a, b) do { BG_ADDR(i, off, sp_, dp_); (void)dp_; a = *(const f32x4*)sp_; b = *(const f32x4*)(sp_ + 4); } while (0)
#define BG_RETIRE(i, off, a, b) do { BG_ADDR(i, off, sp_, dp_); (void)sp_; if (ok_) *(u32x4*)dp_ = (u32x4){cvtpk(a[0], a[1]), cvtpk(a[2], a[3]), cvtpk(b[0], b[1]), cvtpk(b[2], b[3])}; } while (0)
#define BGA_ISSUE(i, off, a, b) do { BG_ADDR(i, off, sp_, dp_); (void)dp_; \
    asm volatile("global_load_dwordx4 %0, %2, off\n\tglobal_load_dwordx4 %1, %2, off offset:16" : "=&v"(a), "=&v"(b) : "v"(sp_) : "memory"); } while (0)
#define BGA_RETIRE(i, off, a, b) do { BG_ADDR(i, off, sp_, dp_); (void)sp_; const u32x4 w_ = {cvtpk(a[0], a[1]), cvtpk(a[2], a[3]), cvtpk(b[0], b[1]), cvtpk(b[2], b[3])}; \
    if (ok_) asm volatile("global_store_dwordx4 %0, %1, off" :: "v"(dp_), "v"(w_) : "memory"); } while (0)
  using C = GemmCfg<BM, BN>;
  const int tid = TIDX, wid = __builtin_amdgcn_readfirstlane(tid >> 6), lane = tid & 63, r32 = lane & 31, hi = lane >> 5;
  const int wm = wid / C::WN, wn = wid % C::WN;
  const bf16_t *g0, *g1, *g2, *g3, *g4, *g5, *g6 = nullptr, *g7 = nullptr, *g8 = nullptr, *g9 = nullptr, *g10 = nullptr, *g11 = nullptr;
  int l0, l1, l2, l3, l4, l5, l6 = 0, l7 = 0, l8 = 0, l9 = 0, l10 = 0, l11 = 0;
  auto xpieceq = [&](int q, const bf16_t*& gp, int& lp) { const int row = 8 * q + (lane >> 3), c = (lane & 7) ^ ((row >> 1) & 7); gp = xrow(row) + c * 8; lp = q * 1024; };
  auto wpieceq = [&](int idx, const bf16_t*& gp, int& lp) {
    const int s = idx >> 4, q = idx & 15, sub = 2 * q + (lane >> 5), kk = (sub >> 2) * 8 + ((lane & 31) >> 2);
    const int k = (kk & ~0xC) | ((kk & 4) << 1) | ((kk & 8) >> 1), c = (sub & 3) * 32 + (lane & 3) * 8;
    gp = wptr(s) + (size_t)k * ldw + c; lp = C::XB + s * 16384 + q * 1024; };
  const size_t stepx = 64, stepw = (size_t)64 * ldw;
  if (BG) {
    const int w4 = wid & 3;
    xpieceq(w4 * 8 + 0, g0, l0); xpieceq(w4 * 8 + 1, g1, l1); xpieceq(w4 * 8 + 2, g2, l2); xpieceq(w4 * 8 + 3, g3, l3);
    xpieceq(w4 * 8 + 4, g4, l4); xpieceq(w4 * 8 + 5, g5, l5); xpieceq(w4 * 8 + 6, g6, l6); xpieceq(w4 * 8 + 7, g7, l7);
    wpieceq(w4 * 4 + 0, g8, l8); wpieceq(w4 * 4 + 1, g9, l9); wpieceq(w4 * 4 + 2, g10, l10); wpieceq(w4 * 4 + 3, g11, l11);
  } else if (C::NXP == 4) { xpieceq(wid * 4 + 0, g0, l0); xpieceq(wid * 4 + 1, g1, l1); xpieceq(wid * 4 + 2, g2, l2); xpieceq(wid * 4 + 3, g3, l3); wpieceq(wid * 2 + 0, g4, l4); wpieceq(wid * 2 + 1, g5, l5); }
  else { xpieceq(wid * 2 + 0, g0, l0); xpieceq(wid * 2 + 1, g1, l1); wpieceq(wid * 4 + 0, g2, l2); wpieceq(wid * 4 + 1, g3, l3); wpieceq(wid * 4 + 2, g4, l4); wpieceq(wid * 4 + 3, g5, l5); }
  const size_t stp0 = stepx, stp1 = stepx, stp2 = (BG || C::NXP == 4) ? stepx : stepw, stp3 = (BG || C::NXP == 4) ? stepx : stepw, stp4 = BG ? stepx : stepw, stp5 = BG ? stepx : stepw;
  const bool dmaw = !BG || wid < 4;
  int xr[2];
#pragma unroll
  for (int ti = 0; ti < 2; ++ti) xr[ti] = (wm * 64 + ti * 32 + r32) * 128;
  const int xsw = (r32 >> 1) & 7;
  int wr[2];
#pragma unroll
  for (int ni = 0; ni < 2; ++ni) {
    const int slab = NMAP == 0 ? 0 : (NMAP == 1 ? (wn >> 1) : ni);
    const int nb = NMAP == 0 ? (2 * wn + ni) : (NMAP == 1 ? ((wn & 1) * 2 + ni) : wn);
    wr[ni] = C::XB + slab * 16384 + nb * 512 + v_rd_base(lane);
  }
  const int nk = K / 64;
#define G_DMA1(gp, sp, lp, kt, _d) __builtin_amdgcn_global_load_lds((const unsigned*)((gp) + (size_t)(kt) * (sp)), (LAS unsigned*)((_d) + (lp)), 16, 0, 0)
#define G_DMA(kt, st) do { if (dmaw) { LAS char* _d = lds + (st) * C::STAGE; \
    G_DMA1(g0, stp0, l0, kt, _d); G_DMA1(g1, stp1, l1, kt, _d); G_DMA1(g2, stp2, l2, kt, _d); G_DMA1(g3, stp3, l3, kt, _d); G_DMA1(g4, stp4, l4, kt, _d); G_DMA1(g5, stp5, l5, kt, _d); \
    if (BG) { G_DMA1(g6, stepx, l6, kt, _d); G_DMA1(g7, stepx, l7, kt, _d); G_DMA1(g8, stepw, l8, kt, _d); G_DMA1(g9, stepw, l9, kt, _d); G_DMA1(g10, stepw, l10, kt, _d); G_DMA1(g11, stepw, l11, kt, _d); } } } while (0)
#define G_HALF(cur, wa0, wa1, H) do { bf16x8 xf[2][2], wf[2][2]; \
      _Pragma("unroll") for (int k2 = 0; k2 < 2; ++k2) _Pragma("unroll") for (int ti = 0; ti < 2; ++ti) xf[k2][ti] = *(const LAS bf16x8*)(cur + xr[ti] + ((((H * 2 + k2) * 2 + hi) ^ xsw) << 4)); \
      wf[0][0] = tr_frag_asm<(H * 2 + 0) * 4096>(wa0); wf[0][1] = tr_frag_asm<(H * 2 + 0) * 4096>(wa1); \
      wf[1][0] = tr_frag_asm<(H * 2 + 1) * 4096>(wa0); wf[1][1] = tr_frag_asm<(H * 2 + 1) * 4096>(wa1); \
      asm volatile("s_waitcnt lgkmcnt(0)" ::: "memory"); __builtin_amdgcn_sched_barrier(0); \
      _Pragma("unroll") for (int k2 = 0; k2 < 2; ++k2) _Pragma("unroll") for (int ti = 0; ti < 2; ++ti) _Pragma("unroll") for (int ni = 0; ni < 2; ++ni) \
        acc[ti][ni] = __builtin_amdgcn_mfma_f32_32x32x16_bf16(wf[k2][ni], xf[k2][ti], acc[ti][ni], 0, 0, 0); } while (0)
#define G_COMPUTE(st) do { const LAS char* cur = lds + (st) * C::STAGE; const int wa0 = (int)(uintptr_t)(cur + wr[0]), wa1 = (int)(uintptr_t)(cur + wr[1]); \
    G_HALF(cur, wa0, wa1, 0); G_HALF(cur, wa0, wa1, 1); } while (0)
  static_assert(C::NXP + C::NWP == 6 && (!BG || (C::NXP == 4 && C::NWP == 2)), "piece counts assumed by the vmcnt waits");
  G_DMA(0, 0); G_DMA(1, 1);
  pre();
#pragma unroll
  for (int a_ = 0; a_ < 2; ++a_)
#pragma unroll
    for (int b_ = 0; b_ < 2; ++b_) acc[a_][b_] = (f32x16){};
  f32x4 b0a, b0b, b0c, b0d, b1a, b1b, b1c, b1d, b2a, b2b, b2c, b2d; int bi0 = -1, bi1 = -1, bi2 = -1;
  const int bgoff = tid - 256;
#define BG_SLOT(bi, xa, xb, xc, xd) do { if (bi >= 0) { asm volatile("s_waitcnt vmcnt(8)" ::: "memory");     \
      BGA_RETIRE(bi, bgoff, xa, xb); BGA_RETIRE(bi, bgoff + 256, xc, xd); bi = -1; } \
    if (bgdone < bgn) { bi = bgdone; BGA_ISSUE(bi, bgoff, xa, xb); BGA_ISSUE(bi, bgoff + 256, xc, xd); } } while (0)
#define G_STEP(kt, ST, bi, xa, xb, xc, xd) do { \
    if (dmaw) { if ((kt) + 1 < nk) { if (BG) asm volatile("s_waitcnt vmcnt(12)" ::: "memory"); \
                                     else if ((kt) < 2 && sprev >= 16) asm volatile("s_waitcnt vmcnt(22)" ::: "memory"); \
                                     else if ((kt) < 2 && sprev >= 8) asm volatile("s_waitcnt vmcnt(14)" ::: "memory"); \
                                     else asm volatile("s_waitcnt vmcnt(6)" ::: "memory"); } \
                else asm volatile("s_waitcnt vmcnt(0)" ::: "memory"); } \
    asm volatile("s_waitcnt lgkmcnt(0)" ::: "memory"); __builtin_amdgcn_s_barrier(); \
    if ((kt) + 2 < nk) G_DMA((kt) + 2, ((ST) + 2) % 3); \
    if (BG && !dmaw) BG_SLOT(bi, xa, xb, xc, xd); \
    if (BG && bgdone < bgn) ++bgdone; \
    G_COMPUTE(ST); } while (0)
  for (int kt = 0; kt < nk; kt += 3) {
    G_STEP(kt, 0, bi0, b0a, b0b, b0c, b0d);
    if (kt + 1 < nk) G_STEP(kt + 1, 1, bi1, b1a, b1b, b1c, b1d);
    if (kt + 2 < nk) G_STEP(kt + 2, 2, bi2, b2a, b2b, b2c, b2d);
  }
  if (BG && !dmaw) {
    asm volatile("s_waitcnt vmcnt(0)" ::: "memory");
    if (bi0 >= 0) { BGA_RETIRE(bi0, bgoff, b0a, b0b); BGA_RETIRE(bi0, bgoff + 256, b0c, b0d); }
    if (bi1 >= 0) { BGA_RETIRE(bi1, bgoff, b1a, b1b); BGA_RETIRE(bi1, bgoff + 256, b1c, b1d); }
    if (bi2 >= 0) { BGA_RETIRE(bi2, bgoff, b2a, b2b); BGA_RETIRE(bi2, bgoff + 256, b2c, b2d); }
    asm volatile("s_waitcnt vmcnt(0)" ::: "memory");
  }
#undef G_STEP
#undef BG_SLOT
  asm volatile("s_waitcnt lgkmcnt(0)" ::: "memory"); __builtin_amdgcn_s_barrier();
#undef G_DMA
#undef G_DMA1
#undef G_COMPUTE
#undef G_HALF
}


struct UnitD { int a, b, c, d, lv0, lv1; };
template <int BM, int BN, int NMAP, bool BG = false, class Dec, class XRow, class WPtr, class Epi>
__device__ __forceinline__ void gemm_stream(LAS char* lds, const char* wsb, int ldw, int K, const Dec& dec, const XRow& xrow, const WPtr& wptr, const Epi& epi,
                                            int* bgdone_p = nullptr, int bgn = 0, long bgc0 = 0, const float* bs0 = nullptr, const float* bs1 = nullptr, const float* bs2 = nullptr,
                                            bf16_t* bd0 = nullptr, bf16_t* bd1 = nullptr, bf16_t* bd2 = nullptr) {
  using C = GemmCfg<BM, BN>;
  const int tid = TIDX, wid = __builtin_amdgcn_readfirstlane(tid >> 6), lane = tid & 63, r32 = lane & 31, hi = lane >> 5;
  const int wm = wid / C::WN, wn = wid % C::WN;
  static_assert(C::NXP + C::NWP == 6 && (!BG || (C::NXP == 4 && C::NWP == 2)), "piece counts assumed by the vmcnt waits");
  auto xptr = [&](const UnitD& u, int q) { const int row = 8 * q + (lane >> 3), c = (lane & 7) ^ ((row >> 1) & 7); return (unsigned)(xrow(u, row) + c * 16); };
  auto wptr2 = [&](const UnitD& u, int idx) {
    const int s = idx >> 4, q = idx & 15, sub = 2 * q + (lane >> 5), kk = (sub >> 2) * 8 + ((lane & 31) >> 2);
    const int k = (kk & ~0xC) | ((kk & 4) << 1) | ((kk & 8) >> 1), c = (sub & 3) * 32 + (lane & 3) * 8;
    return (unsigned)(wptr(u, s) + (unsigned)(k * ldw + c) * 2u); };
  auto wlds = [&](int idx) { return C::XB + (idx >> 4) * 16384 + (idx & 15) * 1024; };
  const int w4 = wid & 3;
  const bool dmaw = !BG || wid < 4;
  const int l0 = BG ? (w4 * 8 + 0) * 1024 : (wid * C::NXP + 0) * 1024, l1 = BG ? (w4 * 8 + 1) * 1024 : (wid * C::NXP + 1) * 1024;
  const int l2 = BG ? (w4 * 8 + 2) * 1024 : (C::NXP == 4 ? (wid * 4 + 2) * 1024 : wlds(wid * 4 + 0)), l3 = BG ? (w4 * 8 + 3) * 1024 : (C::NXP == 4 ? (wid * 4 + 3) * 1024 : wlds(wid * 4 + 1));
  const int l4 = BG ? (w4 * 8 + 4) * 1024 : (C::NXP == 4 ? wlds(wid * 2 + 0) : wlds(wid * 4 + 2)), l5 = BG ? (w4 * 8 + 5) * 1024 : (C::NXP == 4 ? wlds(wid * 2 + 1) : wlds(wid * 4 + 3));
  const int l6 = (w4 * 8 + 6) * 1024, l7 = (w4 * 8 + 7) * 1024, l8 = wlds(w4 * 4 + 0), l9 = wlds(w4 * 4 + 1), l10 = wlds(w4 * 4 + 2), l11 = wlds(w4 * 4 + 3);
  const unsigned stepx = 128, stepw = 128u * (unsigned)ldw;
  const unsigned stp0 = stepx, stp1 = stepx, stp2 = (BG || C::NXP == 4) ? stepx : stepw, stp3 = (BG || C::NXP == 4) ? stepx : stepw, stp4 = BG ? stepx : stepw, stp5 = BG ? stepx : stepw;
#define S_SETUP(u, P) do { \
    if (BG) { if (dmaw) { P##0 = xptr(u, w4 * 8 + 0); P##1 = xptr(u, w4 * 8 + 1); P##2 = xptr(u, w4 * 8 + 2); P##3 = xptr(u, w4 * 8 + 3); P##4 = xptr(u, w4 * 8 + 4); P##5 = xptr(u, w4 * 8 + 5); \
                          P##6 = xptr(u, w4 * 8 + 6); P##7 = xptr(u, w4 * 8 + 7); P##8 = wptr2(u, w4 * 4 + 0); P##9 = wptr2(u, w4 * 4 + 1); P##10 = wptr2(u, w4 * 4 + 2); P##11 = wptr2(u, w4 * 4 + 3); } } \
    else { P##0 = xptr(u, wid * C::NXP + 0); P##1 = xptr(u, wid * C::NXP + 1); \
      if (C::NXP == 4) { P##2 = xptr(u, wid * 4 + 2); P##3 = xptr(u, wid * 4 + 3); P##4 = wptr2(u, wid * 2 + 0); P##5 = wptr2(u, wid * 2 + 1); } \
      else { P##2 = wptr2(u, wid * 4 + 0); P##3 = wptr2(u, wid * 4 + 1); P##4 = wptr2(u, wid * 4 + 2); P##5 = wptr2(u, wid * 4 + 3); } } } while (0)
#define S_DMA1(gp, sp, lp, kt, _d) __builtin_amdgcn_global_load_lds((const unsigned*)(wsb + (size_t)((gp) + (unsigned)(kt) * (sp))), (LAS unsigned*)((_d) + (lp)), 16, 0, 0)
#define S_DMA(P, kt, stg) do { if (dmaw) { LAS char* _d = lds + (stg) * C::STAGE; S_DMA1(P##0, stp0, l0, kt, _d); S_DMA1(P##1, stp1, l1, kt, _d); S_DMA1(P##2, stp2, l2, kt, _d); \
    S_DMA1(P##3, stp3, l3, kt, _d); S_DMA1(P##4, stp4, l4, kt, _d); S_DMA1(P##5, stp5, l5, kt, _d); \
    if (BG) { S_DMA1(P##6, stepx, l6, kt, _d); S_DMA1(P##7, stepx, l7, kt, _d); S_DMA1(P##8, stepw, l8, kt, _d); S_DMA1(P##9, stepw, l9, kt, _d); S_DMA1(P##10, stepw, l10, kt, _d); \
              S_DMA1(P##11, stepw, l11, kt, _d); } } } while (0)
  int xr[2];
#pragma unroll
  for (int ti = 0; ti < 2; ++ti) xr[ti] = (wm * 64 + ti * 32 + r32) * 128;
  const int xsw = (r32 >> 1) & 7;
  int wr[2];
#pragma unroll
  for (int ni = 0; ni < 2; ++ni) {
    const int slab = NMAP == 0 ? 0 : (NMAP == 1 ? (wn >> 1) : ni);
    const int nb = NMAP == 0 ? (2 * wn + ni) : (NMAP == 1 ? ((wn & 1) * 2 + ni) : wn);
    wr[ni] = C::XB + slab * 16384 + nb * 512 + v_rd_base(lane);
  }
  const int nk = K / 64;
#define S_HALF(cur, wa0, wa1, H) do { bf16x8 xf[2][2], wf[2][2]; \
      _Pragma("unroll") for (int k2 = 0; k2 < 2; ++k2) _Pragma("unroll") for (int ti = 0; ti < 2; ++ti) xf[k2][ti] = *(const LAS bf16x8*)(cur + xr[ti] + ((((H * 2 + k2) * 2 + hi) ^ xsw) << 4)); \
      wf[0][0] = tr_frag_asm<(H * 2 + 0) * 4096>(wa0); wf[0][1] = tr_frag_asm<(H * 2 + 0) * 4096>(wa1); \
      wf[1][0] = tr_frag_asm<(H * 2 + 1) * 4096>(wa0); wf[1][1] = tr_frag_asm<(H * 2 + 1) * 4096>(wa1); \
      asm volatile("s_waitcnt lgkmcnt(0)" ::: "memory"); __builtin_amdgcn_sched_barrier(0); \
      _Pragma("unroll") for (int k2 = 0; k2 < 2; ++k2) _Pragma("unroll") for (int ti = 0; ti < 2; ++ti) _Pragma("unroll") for (int ni = 0; ni < 2; ++ni) \
        acc[ti][ni] = __builtin_amdgcn_mfma_f32_32x32x16_bf16(wf[k2][ni], xf[k2][ti], acc[ti][ni], 0, 0, 0); } while (0)
  UnitD cu, nu;
  if (!dec(0, cu)) return;
  asm volatile("s_waitcnt vmcnt(0)" : "+v"(cu.lv0), "+v"(cu.lv1) :: "memory");
  unsigned g0 = 0, g1 = 0, g2 = 0, g3 = 0, g4 = 0, g5 = 0, g6 = 0, g7 = 0, g8 = 0, g9 = 0, g10 = 0, g11 = 0;
  S_SETUP(cu, g);
  int st = 0;
  S_DMA(g, 0, 0); S_DMA(g, 1, 1);
  int sprev = 0;
  f32x16 acc[2][2];
  f32x4 b0a, b0b, b0c, b0d, b1a, b1b, b1c, b1d, b2a, b2b, b2c, b2d; int bi0 = -1, bi1 = -1, bi2 = -1, j3 = 0;
  int bgdone = BG ? *bgdone_p : 0;
  const int bgoff = tid - 256;
#define S_BGSLOT(bi, xa, xb, xc, xd) do { if (bi >= 0) { \
      if (kt < 3 && sprev >= 16) asm volatile("s_waitcnt vmcnt(24)" ::: "memory");     \
      else asm volatile("s_waitcnt vmcnt(8)" ::: "memory"); \
      BGA_RETIRE(bi, bgoff, xa, xb); BGA_RETIRE(bi, bgoff + 256, xc, xd); bi = -1; } \
    if (bgdone < bgn) { bi = bgdone; BGA_ISSUE(bi, bgoff, xa, xb); BGA_ISSUE(bi, bgoff + 256, xc, xd); } } while (0)
  for (int it = 0;; ++it) {
    const bool okn = dec(it + 1, nu);
#pragma unroll
    for (int a_ = 0; a_ < 2; ++a_)
#pragma unroll
      for (int b_ = 0; b_ < 2; ++b_) acc[a_][b_] = (f32x16){};
    for (int kt = 0; kt < nk; ++kt) {
      if (dmaw) {
        if (kt + 1 < nk || okn) {
          const int extra = kt < 2 ? sprev : 0;
          if (BG) { if (extra >= 16) asm volatile("s_waitcnt vmcnt(28)" ::: "memory"); else asm volatile("s_waitcnt vmcnt(12)" ::: "memory"); }
          else if (extra >= 16) asm volatile("s_waitcnt vmcnt(22)" ::: "memory");
          else if (extra >= 8) asm volatile("s_waitcnt vmcnt(14)" ::: "memory");
          else asm volatile("s_waitcnt vmcnt(6)" ::: "memory");
        } else asm volatile("s_waitcnt vmcnt(0)" ::: "memory");
      }
      asm volatile("s_waitcnt lgkmcnt(0)" ::: "memory"); __builtin_amdgcn_s_barrier();
      const int st2 = st == 0 ? 2 : st - 1;
      if (kt + 2 < nk) S_DMA(g, kt + 2, st2);
      else if (okn) {
        if (kt + 2 == nk) { asm volatile("" : "+v"(nu.lv0), "+v"(nu.lv1) :: "memory"); S_SETUP(nu, g); }
        S_DMA(g, kt + 2 - nk, st2);
      }
      if (BG && !dmaw) { if (j3 == 0) S_BGSLOT(bi0, b0a, b0b, b0c, b0d); else if (j3 == 1) S_BGSLOT(bi1, b1a, b1b, b1c, b1d); else S_BGSLOT(bi2, b2a, b2b, b2c, b2d); }
      if (BG) { if (bgdone < bgn) ++bgdone; j3 = j3 == 2 ? 0 : j3 + 1; }
      { const LAS char* cur = lds + st * C::STAGE; const int wa0 = (int)(uintptr_t)(cur + wr[0]), wa1 = (int)(uintptr_t)(cur + wr[1]);
        S_HALF(cur, wa0, wa1, 0); S_HALF(cur, wa0, wa1, 1); }
      st = st == 2 ? 0 : st + 1;
    }
    if (BG && !dmaw) {
      asm volatile("s_waitcnt vmcnt(0)" ::: "memory");
      if (bi0 >= 0) { BGA_RETIRE(bi0, bgoff, b0a, b0b); BGA_RETIRE(bi0, bgoff + 256, b0c, b0d); bi0 = -1; }
      if (bi1 >= 0) { BGA_RETIRE(bi1, bgoff, b1a, b1b); BGA_RETIRE(bi1, bgoff + 256, b1c, b1d); bi1 = -1; }
      if (bi2 >= 0) { BGA_RETIRE(bi2, bgoff, b2a, b2b); BGA_RETIRE(bi2, bgoff + 256, b2c, b2d); bi2 = -1; }
    }
    sprev = epi(cu, acc);
    if (!okn) break;
    cu = nu;
  }
  if (BG) *bgdone_p = bgdone;
#undef S_BGSLOT
#undef S_HALF
#undef S_DMA
#undef S_DMA1
#undef S_SETUP
}

__device__ __forceinline__ unsigned pack4_fp8(const f32x16& a, int g) {
  int w = __builtin_amdgcn_cvt_pk_fp8_f32(a[4 * g], a[4 * g + 1], 0, false);
  w = __builtin_amdgcn_cvt_pk_fp8_f32(a[4 * g + 2], a[4 * g + 3], w, true);
  return (unsigned)w;
}
__device__ __forceinline__ u32x2 pack4(const f32x16& a, int g) { return (u32x2){cvtpk(a[4 * g], a[4 * g + 1]), cvtpk(a[4 * g + 2], a[4 * g + 3])}; }

__device__ __forceinline__ void phase_a1(const Params& p, int layer, LAS char* lds, int bid, int nblk) {
  const bf16_t* H = (const bf16_t*)(p.ws + OFF_H);
  const bf16_t* W = (const bf16_t*)(p.ws + OFF_WIN) + (size_t)layer * D * INW;
  bf16_t* Q = (bf16_t*)(p.ws + OFF_Q); bf16_t* Kb = (bf16_t*)(p.ws + OFF_K); bf16_t* Vb = (bf16_t*)(p.ws + OFF_V);
  float* U = (float*)(p.ws + OFF_U); bf16_t* AG = (bf16_t*)(p.ws + OFF_AG);
  unsigned char* Q8 = (unsigned char*)(p.ws + OFF_Q8); unsigned char* K8 = (unsigned char*)(p.ws + OFF_K8); unsigned char* VT8 = (unsigned char*)(p.ws + OFF_VT8);
  const float* rt = (const float*)(p.ws + OFF_ROPE);
  const int lane = TIDX & 63, wid = TIDX >> 6, r32 = lane & 31, hi = lane >> 5, wm = wid >> 1, wn = wid & 1;
  const size_t wo = (size_t)layer * NE * D * DE;
  const int bgn = (3 * (1 << 21) + nblk * 512 - 1) / (nblk * 512);
  const long bgc0 = (long)bid * bgn * 512;
  const float* bs0 = p.w_e_gate + wo; const float* bs1 = p.w_e_up + wo; const float* bs2 = p.w_e_down + wo;
  bf16_t* bd0 = (bf16_t*)(p.ws + OFF_WG) + wo; bf16_t* bd1 = (bf16_t*)(p.ws + OFF_WU) + wo; bf16_t* bd2 = (bf16_t*)(p.ws + OFF_WD) + wo;
  int bgdone = 0;
  const int nlat = 64 * 12, nctx = layer == 0 ? 12 : 2, nunits = nlat + nctx;
  const bool xmap = (nblk & 7) == 0;
  const int xcd = bid & 7, lb = bid >> 3, nlb = nblk >> 3, nl = lb < 96 ? (96 - lb + nlb - 1) / nlb : 0;
  for (int it = 0;; ++it) {
    int rtile, ct;
    if (xmap) {
      if (it < nl) { const int v = lb + it * nlb; rtile = 1 + xcd + 8 * (v / 12); ct = v % 12; }
      else { const int e2 = bid + (it - nl) * nblk; if (e2 >= nctx) break; rtile = 0; ct = layer == 0 ? e2 : 4 + e2; }
    } else {
      const int u = bid + it * nblk; if (u >= nunits) break;
      if (u < nlat) { rtile = 1 + u / 12; ct = u % 12; } else { rtile = 0; ct = layer == 0 ? (u - nlat) : (4 + u - nlat); }
    }
    const int m0 = rtile * 256, n0 = ct * 128;
    f32x16 acc[2][2];
#pragma unroll
    for (int a = 0; a < 2; ++a)
#pragma unroll
      for (int b = 0; b < 2; ++b) acc[a][b] = (f32x16){};
    gemm_mainloop<256, 128, 0, true>(lds, acc, [&](int row) { return H + (size_t)(m0 + row) * D; }, [&](int) { return W + n0; }, []() {}, 0, INW, D, bgdone, bgn, bgc0, bs0, bs1, bs2, bd0, bd1, bd2);
#pragma unroll
    for (int ti = 0; ti < 2; ++ti) {
      const int tok = m0 + wm * 64 + ti * 32 + r32;
      if (ct < 5) {
        float ss = 0.f;
#pragma unroll
        for (int ni = 0; ni < 2; ++ni)
#pragma unroll
          for (int r = 0; r < 16; ++r) ss += acc[ti][ni][r] * acc[ti][ni][r];
        ss = sum32(ss);
        const float rs = rsqrtf(ss * (1.f / 64.f) + EPS);
        const float* gain = (ct < 4 ? p.q_gain : p.k_gain) + layer * 64;
        const float osc = ct < 4 ? 0.125f * 1.4426950408889634f : 1.f;
        const bool lat = rtile > 0;
        const int t = tok - NCTX;
#pragma unroll
        for (int ni = 0; ni < 2; ++ni) {
          f32x16 v;
#pragma unroll
          for (int r = 0; r < 16; ++r) v[r] = acc[ti][ni][r] * rs * gain[ni * 32 + crow(r, hi)];
          if (lat) {
            const int pos = ni == 0 ? (t >> 6) : (t & 63);
#pragma unroll
            for (int r = 0; r < 8; ++r) {
              const int f = crow(r, hi);
              const float cs = rt[(pos * 16 + f) * 2], sn = rt[(pos * 16 + f) * 2 + 1];
              const float t1 = v[r], t2 = v[r + 8];
              v[r] = t1 * cs - t2 * sn; v[r + 8] = t2 * cs + t1 * sn;
            }
          }
#pragma unroll
          for (int r = 0; r < 16; ++r) v[r] *= osc;
          bf16_t* dst = ct < 4 ? Q + (size_t)tok * 512 + (ct * 2 + wn) * 64 + ni * 32 : Kb + (size_t)tok * 128 + wn * 64 + ni * 32;
          unsigned char* dst8 = ct < 4 ? Q8 + (size_t)tok * 512 + (ct * 2 + wn) * 64 + ni * 32 : K8 + (size_t)tok * 128 + wn * 64 + ni * 32;
#pragma unroll
          for (int g = 0; g < 4; ++g) { *(u32x2*)(dst + 8 * g + 4 * hi) = pack4(v, g); *(unsigned*)(dst8 + 8 * g + 4 * hi) = pack4_fp8(v, g); }
        }
      } else if (ct == 5) {
#pragma unroll
        for (int ni = 0; ni < 2; ++ni) {
#pragma unroll
          for (int g = 0; g < 4; ++g) *(u32x2*)(Vb + (size_t)tok * 128 + wn * 64 + ni * 32 + 8 * g + 4 * hi) = pack4(acc[ti][ni], g);
          float vmx = 0.f;
#pragma unroll
          for (int r = 0; r < 16; ++r) {
            const float vv = acc[ti][ni][r]; vmx = fmaxf(vmx, fabsf(vv));
            VT8[(size_t)(wn * 64 + ni * 32 + crow(r, hi)) * TT + tok] = (unsigned char)(__builtin_amdgcn_cvt_pk_fp8_f32(vv, vv, 0, false) & 0xff);
          }
          if (!(vmx <= 400.f)) atomicOr((int*)(p.ws + OFF_FLAG) + 1, 1);
        }
      } else if (ct < 8) {
#pragma unroll
        for (int ni = 0; ni < 2; ++ni)
#pragma unroll
          for (int g = 0; g < 4; ++g)
            *(f32x4*)(U + (size_t)tok * 256 + (ct - 6) * 128 + wn * 64 + ni * 32 + 8 * g + 4 * hi) =
                (f32x4){acc[ti][ni][4 * g], acc[ti][ni][4 * g + 1], acc[ti][ni][4 * g + 2], acc[ti][ni][4 * g + 3]};
      } else {
#pragma unroll
        for (int ni = 0; ni < 2; ++ni)
#pragma unroll
          for (int g = 0; g < 4; ++g) *(u32x2*)(AG + (size_t)tok * 512 + (ct - 8) * 128 + wn * 64 + ni * 32 + 8 * g + 4 * hi) = pack4(acc[ti][ni], g);
      }
    }
  }
  { const int tid = TIDX; while (bgdone < bgn) { f32x4 a, b2; const int i = bgdone++; BG_ISSUE(i, tid, a, b2); BG_RETIRE(i, tid, a, b2); } }
}

__device__ __forceinline__ void phase_c1(const Params& p, int layer, LAS char* lds, int bid, int nblk) {
  const bf16_t* A = (const bf16_t*)(p.ws + OFF_MIX);
  const bf16_t* W = (const bf16_t*)(p.ws + OFF_WOUT) + (size_t)layer * D * D;
  bf16_t* Y = (bf16_t*)(p.ws + OFF_Y);
  const int lane = TIDX & 63, wid = TIDX >> 6, r32 = lane & 31, hi = lane >> 5, wm = wid >> 1, wn = wid & 1;
  const int nctx = layer == 0 ? 8 : 0;
  const bool xmap = (nblk & 7) == 0;
  const int xcd = bid & 7, lb = bid >> 3, nlb = nblk >> 3, nl = lb < 64 ? (64 - lb + nlb - 1) / nlb : 0;
  const unsigned oA = (unsigned)OFF_MIX, oW = (unsigned)(OFF_WOUT + (size_t)layer * D * D * 2);
  gemm_stream<256, 128, 0>(lds, p.ws, D, D,
    [&](int it, UnitD& u) {
      int rtile, ct;
      if (xmap) {
        if (it < nl) { const int v = lb + it * nlb; rtile = 1 + xcd + 8 * (v >> 3); ct = v & 7; }
        else { const int e2 = bid + (it - nl) * nblk; if (e2 >= nctx) return false; rtile = 0; ct = e2; }
      } else {
        const int un = bid + it * nblk; if (un >= 64 * 8 + nctx) return false;
        if (un < 512) { rtile = 1 + (un >> 3); ct = un & 7; } else { rtile = 0; ct = un - 512; }
      }
      u.a = rtile * 256; u.b = ct * 128; u.c = 0; u.d = 0; u.lv0 = 0; u.lv1 = 0; return true; },
    [&](const UnitD& u, int row) { return oA + (unsigned)(u.a + row) * (D * 2); },
    [&](const UnitD& u, int) { return oW + (unsigned)u.b * 2; },
    [&](const UnitD& u, f32x16 (&acc)[2][2]) {
#pragma unroll
      for (int ti = 0; ti < 2; ++ti) {
        const int tok = u.a + wm * 64 + ti * 32 + r32;
#pragma unroll
        for (int ni = 0; ni < 2; ++ni)
#pragma unroll
          for (int g = 0; g < 4; ++g) *(u32x2*)(Y + (size_t)tok * D + u.b + wn * 64 + ni * 32 + 8 * g + 4 * hi) = pack4(acc[ti][ni], g);
      }
      return 16; });
}

#ifndef MOE_XCD_MAP
#define MOE_XCD_MAP 0
#endif
__device__ __forceinline__ void moe_prefix(const int* cnt, LAS int* pre, int xcd) {
  if (TIDX == 0) {
    int o = 0; for (int e = 0; e < NE; ++e) { pre[e] = o; o += (cnt[e * CNT_STRIDE] + 127) >> 7; } pre[NE] = o;
    int l = 0; for (int j = 0; j < 4; ++j) { pre[40 + j] = l; l += (cnt[(xcd + 8 * j) * CNT_STRIDE] + 127) >> 7; } pre[44] = l;
  }
  { int tt = (int)threadIdx.x; asm volatile("" : "+v"(tt));
    if (tt >= 64 && tt < 64 + NE) pre[48 + tt - 64] = cnt[(tt - 64) * CNT_STRIDE]; }
  __syncthreads();
}
__device__ __forceinline__ bool moe_unit(const LAS int* pre, int bid, int nblk, int it, int& e, int& rt, int& ct, int& g) {
  if (MOE_XCD_MAP && (nblk & 7) == 0) {
    const int xcd = bid & 7, v = (bid >> 3) + it * (nblk >> 3), gl = v >> 2;
    if (gl >= pre[44]) return false;
    int j = 0; if (gl >= pre[41]) j = 1; if (gl >= pre[42]) j = 2; if (gl >= pre[43]) j = 3;
    e = xcd + 8 * j; rt = gl - pre[40 + j]; ct = v & 3; g = pre[e] + rt; return true;
  } else {
    const int u = bid + it * nblk; g = u >> 2; if (g >= pre[NE]) return false;
    int ee = 0; for (int i = 1; i < NE; ++i) ee += (pre[i] <= g) ? 1 : 0;
    e = ee; rt = g - pre[ee]; ct = u & 3; return true;
  }
}

__device__ __forceinline__ void phase_d1(const Params& p, int layer, LAS char* lds, int bid, int nblk) {
  const int* cnt = (const int*)(p.ws + OFF_CNT) + layer * NE * CNT_STRIDE;
  const bf16_t* H2 = (const bf16_t*)(p.ws + OFF_MIX);
  bf16_t* HM = (bf16_t*)(p.ws + OFF_HMID);
  LAS int* pre = (LAS int*)(lds + GEMM_LDS);
  moe_prefix(cnt, pre, bid & 7);
  const int lane = TIDX & 63, wid = TIDX >> 6, r32 = lane & 31, hi = lane >> 5, wm = wid >> 2, wn = wid & 3;
  const int grow = 16 * wid + (lane >> 3);
  const bf16_t* WG = (const bf16_t*)(p.ws + OFF_WG) + (size_t)layer * NE * D * DE; const bf16_t* WU = (const bf16_t*)(p.ws + OFF_WU) + (size_t)layer * NE * D * DE;
  const unsigned oH2 = (unsigned)OFF_MIX, oWG = (unsigned)(OFF_WG + (size_t)layer * NE * D * DE * 2), oWU = (unsigned)(OFF_WU + (size_t)layer * NE * D * DE * 2);
  gemm_stream<128, 256, 2>(lds, p.ws, DE, D,
    [&](int it, UnitD& u) {
      int e, rt, ct, g; if (!moe_unit(pre, bid, nblk, it, e, rt, ct, g)) return false;
      const int* list = (const int*)(p.ws + OFF_LIST) + (size_t)e * CAPL + rt * 128 + grow;
      u.a = e; u.b = ct; u.c = g; u.d = pre[48 + e] - rt * 128;
      asm volatile("global_load_dword %0, %2, off\n\tglobal_load_dword %1, %2, off offset:32" : "=&v"(u.lv0), "=&v"(u.lv1) : "v"(list) : "memory");
      return true; },
    [&](const UnitD& u, int row) { const int lv = (row & 8) ? u.lv1 : u.lv0; const int tok = row < u.d ? (lv >> 1) : 0; return oH2 + (unsigned)tok * (D * 2); },
    [&](const UnitD& u, int s) { return (s == 0 ? oWG : oWU) + (unsigned)u.a * (D * DE * 2) + (unsigned)u.b * 256; },
    [&](const UnitD& u, f32x16 (&acc)[2][2]) {
#pragma unroll
      for (int ti = 0; ti < 2; ++ti) {
        const size_t row = (size_t)u.c * 128 + wm * 64 + ti * 32 + r32;
        f32x16 a;
#pragma unroll
        for (int r = 0; r < 16; ++r) { const float gv = acc[ti][0][r]; a[r] = gv / (1.f + __expf(-gv)) * acc[ti][1][r]; }
#pragma unroll
        for (int gq = 0; gq < 4; ++gq) *(u32x2*)(HM + row * DE + u.b * 128 + wn * 32 + 8 * gq + 4 * hi) = pack4(a, gq);
      }
      return 8; });
}

__device__ __forceinline__ void phase_d2(const Params& p, int layer, LAS char* lds, int bid, int nblk) {
  const int* cnt = (const int*)(p.ws + OFF_CNT) + layer * NE * CNT_STRIDE;
  const bf16_t* HM = (const bf16_t*)(p.ws + OFF_HMID);
  bf16_t* OM = (bf16_t*)(p.ws + OFF_OMOE);
  LAS int* pre = (LAS int*)(lds + GEMM_LDS);
  moe_prefix(cnt, pre, bid & 7);
  const int lane = TIDX & 63, wid = TIDX >> 6, r32 = lane & 31, hi = lane >> 5, wm = wid >> 2, wn = wid & 3;
  const int row0 = wm * 64 + r32;
  const bf16_t* WD = (const bf16_t*)(p.ws + OFF_WD) + (size_t)layer * NE * DE * D;
  const unsigned oHM = (unsigned)OFF_HMID, oWD = (unsigned)(OFF_WD + (size_t)layer * NE * DE * D * 2);
  gemm_stream<128, 256, 1>(lds, p.ws, D, DE,
    [&](int it, UnitD& u) {
      int e, rt, ct, g; if (!moe_unit(pre, bid, nblk, it, e, rt, ct, g)) return false;
      const int* list = (const int*)(p.ws + OFF_LIST) + (size_t)e * CAPL + rt * 128 + row0;
      u.a = e; u.b = ct; u.c = g; u.d = pre[48 + e] - rt * 128;
      asm volatile("global_load_dword %0, %2, off\n\tglobal_load_dword %1, %2, off offset:128" : "=&v"(u.lv0), "=&v"(u.lv1) : "v"(list) : "memory");
      return true; },
    [&](const UnitD& u, int row) { return oHM + (unsigned)(u.c * 128 + row) * (DE * 2); },
    [&](const UnitD& u, int s) { return oWD + (unsigned)u.a * (DE * D * 2) + (unsigned)(u.b * 256 + s * 128) * 2; },
    [&](const UnitD& u, f32x16 (&acc)[2][2]) {
#pragma unroll
      for (int ti = 0; ti < 2; ++ti) {
        const int ts = ti == 0 ? u.lv0 : u.lv1;
        if (row0 + ti * 32 < u.d) {
#pragma unroll
          for (int ni = 0; ni < 2; ++ni)
#pragma unroll
            for (int gq = 0; gq < 4; ++gq) *(u32x2*)(OM + (size_t)ts * D + u.b * 256 + wn * 64 + ni * 32 + 8 * gq + 4 * hi) = pack4(acc[ti][ni], gq);
        }
      }
      return u.d >= 128 ? 16 : 0; });
}
constexpr int ATT_SLOT = 16384, ATT_LDS = 4 * ATT_SLOT;
__device__ __forceinline__ int vst64(int k, int c) { const int kk = (k & ~0xC) | ((k & 4) << 1) | ((k & 8) >> 1); return ((kk >> 3) * 2 + (c >> 5)) * 512 + ((kk & 7) * 32 + (c & 31)) * 2; }
__device__ __forceinline__ bf16x8 tr_frag64(const LAS char* p) {
  s16x4 a = __builtin_amdgcn_ds_read_tr16_b64_v4i16((LAS s16x4*)p);
  s16x4 b = __builtin_amdgcn_ds_read_tr16_b64_v4i16((LAS s16x4*)(p + 1024));
  return (bf16x8){a[0], a[1], a[2], a[3], b[0], b[1], b[2], b[3]};
}
__device__ __forceinline__ bf16x8 pk4(const f32x16& P, int B) {
  unsigned a0 = cvtpk(P[B + 0], P[B + 1]), a1 = cvtpk(P[B + 2], P[B + 3]), b0 = cvtpk(P[B + 4], P[B + 5]), b1 = cvtpk(P[B + 6], P[B + 7]);
  auto r0 = __builtin_amdgcn_permlane32_swap(a0, b0, false, false); auto r1 = __builtin_amdgcn_permlane32_swap(a1, b1, false, false);
  u32x4 w = {r0[0], r1[0], r0[1], r1[1]};
  return __builtin_bit_cast(bf16x8, w);
}
struct AttnCtx { int krd0, krd1, ksw, hi, vrd; };
#define SBAR() __builtin_amdgcn_sched_barrier(0)
__device__ __forceinline__ void att_kload(const LAS char* slot, const AttnCtx& c, bf16x8 (&kf)[8]) {
#pragma unroll
  for (int d0 = 0; d0 < 4; ++d0) {
    kf[2 * d0] = *(const LAS bf16x8*)(slot + c.krd0 + (((2 * d0 + c.hi) ^ c.ksw) << 4));
    kf[2 * d0 + 1] = *(const LAS bf16x8*)(slot + c.krd1 + (((2 * d0 + c.hi) ^ c.ksw) << 4));
  }
}
__device__ __forceinline__ void att_qk(const bf16x8 (&kf)[8], const bf16x8 (&qr)[4], f32x16& s0, f32x16& s1) {
  s0 = (f32x16){}; s1 = (f32x16){};
#pragma unroll
  for (int d0 = 0; d0 < 4; ++d0) {
    s0 = __builtin_amdgcn_mfma_f32_32x32x16_bf16(kf[2 * d0], qr[d0], s0, 0, 0, 0);
    s1 = __builtin_amdgcn_mfma_f32_32x32x16_bf16(kf[2 * d0 + 1], qr[d0], s1, 0, 0, 0);
  }
}
__device__ __forceinline__ void att_exp(f32x16& s, float& l) {
#pragma unroll
  for (int r = 0; r < 16; ++r) { s[r] = __builtin_amdgcn_exp2f(s[r]); l += s[r]; }
  asm volatile("" : "+v"(l));
}
template <int KS0>
__device__ __forceinline__ void att_vload(const LAS char* slot, const AttnCtx& c, bf16x8 (&vf)[4]) {
#pragma unroll
  for (int i = 0; i < 2; ++i) { vf[2 * i] = tr_frag64(slot + c.vrd + (KS0 + i) * 2048); vf[2 * i + 1] = tr_frag64(slot + c.vrd + 512 + (KS0 + i) * 2048); }
}
__device__ __forceinline__ void att_pv2(const bf16x8& pa, const bf16x8& pb, const bf16x8 (&vf)[4], f32x16& o0, f32x16& o1) {
  o0 = __builtin_amdgcn_mfma_f32_32x32x16_bf16(pa, vf[0], o0, 0, 0, 0);
  o1 = __builtin_amdgcn_mfma_f32_32x32x16_bf16(pa, vf[1], o1, 0, 0, 0);
  o0 = __builtin_amdgcn_mfma_f32_32x32x16_bf16(pb, vf[2], o0, 0, 0, 0);
  o1 = __builtin_amdgcn_mfma_f32_32x32x16_bf16(pb, vf[3], o1, 0, 0, 0);
}
__device__ __forceinline__ void attn_unit(const Params& p, LAS char* lds, int row0, int hp, int nkeys) {
  const bf16_t* Q = (const bf16_t*)(p.ws + OFF_Q); const bf16_t* Kb = (const bf16_t*)(p.ws + OFF_K); const bf16_t* Vb = (const bf16_t*)(p.ws + OFF_V);
  bf16_t* MIX = (bf16_t*)(p.ws + OFF_MIX);
  const int tid = TIDX, wid = tid >> 6, lane = tid & 63, r32 = lane & 31, hi = lane >> 5, kvh = hp >> 1;
  bf16x8 qa[4], qb[4];
  { const bf16_t* Qg = Q + (size_t)(row0 + wid * 32 + r32) * 512 + hp * 128 + hi * 8;
#pragma unroll
    for (int d0 = 0; d0 < 4; ++d0) { qa[d0] = *(const bf16x8*)(Qg + d0 * 16); qb[d0] = *(const bf16x8*)(Qg + 64 + d0 * 16); } }
  const bf16_t* Kg = Kb + (size_t)(tid >> 3) * 128 + kvh * 64 + (tid & 7) * 8;
  const bf16_t* Vg = Vb + (size_t)(tid >> 3) * 128 + kvh * 64 + (tid & 7) * 8;
  const int kst = xoff(tid >> 3, tid & 7), vstw = 8192 + vst64(tid >> 3, (tid & 7) * 8);
  AttnCtx c; c.krd0 = r32 * 128; c.krd1 = (32 + r32) * 128; c.ksw = (r32 >> 1) & 7; c.hi = hi; c.vrd = 8192 + v_rd_base(lane);
  const int NT = nkeys >> 6;
  f32x16 oa0 = {}, oa1 = {}, ob0 = {}, ob1 = {}; float la = 0.f, lb = 0.f;
  u32x4 ks, vs;
  {
    const u32x4 k0 = *(const u32x4*)Kg, k1 = *(const u32x4*)(Kg + 64 * 128), v0 = *(const u32x4*)Vg, v1 = *(const u32x4*)(Vg + 64 * 128);
    *(LAS u32x4*)(lds + kst) = k0; *(LAS u32x4*)(lds + ATT_SLOT + kst) = k1;
    *(LAS u32x4*)(lds + vstw) = v0; *(LAS u32x4*)(lds + ATT_SLOT + vstw) = v1;
    ks = *(const u32x4*)(Kg + 2 * 64 * 128); vs = *(const u32x4*)(Vg + 2 * 64 * 128);
  }
  __syncthreads();
  for (int j = 0; j < NT; ++j) {
    const LAS char* sl = lds + (j & 3) * ATT_SLOT;
    bf16x8 kf[8], vfa[4], vfb[4];
    f32x16 sa0, sa1, sb0, sb1;
    att_kload(sl, c, kf);
    SBAR();
    att_qk(kf, qa, sa0, sa1);
    SBAR();
    att_qk(kf, qb, sb0, sb1);
    att_exp(sa0, la); att_exp(sa1, la);
    SBAR();
    const bf16x8 pa0 = pk4(sa0, 0), pa1 = pk4(sa0, 8), pa2 = pk4(sa1, 0), pa3 = pk4(sa1, 8);
    att_vload<0>(sl, c, vfa);
    SBAR();
    att_pv2(pa0, pa1, vfa, oa0, oa1);
    att_exp(sb0, lb);
    att_vload<2>(sl, c, vfb);
    SBAR();
    att_pv2(pa2, pa3, vfb, oa0, oa1);
    att_exp(sb1, lb);
    const bf16x8 pb0 = pk4(sb0, 0), pb1 = pk4(sb0, 8), pb2 = pk4(sb1, 0), pb3 = pk4(sb1, 8);
    att_vload<0>(sl, c, vfa);
    SBAR();
    att_pv2(pb0, pb1, vfa, ob0, ob1);
    att_vload<2>(sl, c, vfb);
    SBAR();
    att_pv2(pb2, pb3, vfb, ob0, ob1);
    { LAS char* w = lds + ((j + 2) & 3) * ATT_SLOT;
      if (j + 2 < NT) { *(LAS u32x4*)(w + kst) = ks; *(LAS u32x4*)(w + vstw) = vs; }
      if (j + 3 < NT) { ks = *(const u32x4*)(Kg + (size_t)(j + 3) * 64 * 128); vs = *(const u32x4*)(Vg + (size_t)(j + 3) * 64 * 128); } }
    __syncthreads();
  }
  la = sum32(la); lb = sum32(lb);
  LAS float* li = (LAS float*)(lds + wid * 256);
  if (hi == 0) { li[r32] = la; li[32 + r32] = lb; }
  __syncthreads();
  bf16_t* Og = MIX + (size_t)(row0 + wid * 32) * D + hp * 128 + r32;
#pragma unroll
  for (int r = 0; r < 16; ++r) {
    const int orow = crow(r, hi);
    const float ra = __builtin_amdgcn_rcpf(li[orow]), rb = __builtin_amdgcn_rcpf(li[32 + orow]);
    Og[(size_t)orow * D] = f2bf(oa0[r] * ra); Og[(size_t)orow * D + 32] = f2bf(oa1[r] * ra);
    Og[(size_t)orow * D + 64] = f2bf(ob0[r] * rb); Og[(size_t)orow * D + 96] = f2bf(ob1[r] * rb);
  }
  __syncthreads();
}
typedef int i32x8 __attribute__((ext_vector_type(8)));
constexpr int A8_SLOT = 8192, A8_NSLOT = 8, A8_LDS = A8_NSLOT * A8_SLOT;
__device__ __forceinline__ int off8(int row, int chunk) { return row * 64 + ((chunk ^ ((row >> 2) & 3)) << 4); }
__device__ __forceinline__ i32x8 ld_frag8(const LAS char* tile, int row, int h) {
  const int sw = (row >> 2) & 3;
  const u32x4 lo = *(const LAS u32x4*)(tile + row * 64 + (((2 * h) ^ sw) << 4)), hi = *(const LAS u32x4*)(tile + row * 64 + (((2 * h + 1) ^ sw) << 4));
  return (i32x8){(int)lo[0], (int)lo[1], (int)lo[2], (int)lo[3], (int)hi[0], (int)hi[1], (int)hi[2], (int)hi[3]};
}
#define MX_FP8_FP8(a, b, c) __builtin_amdgcn_mfma_scale_f32_32x32x64_f8f6f4(a, b, c, 0, 0, 0, 0x7f7f7f7f, 0, 0x7f7f7f7f)
#define MX_BF8_FP8(a, b, c) __builtin_amdgcn_mfma_scale_f32_32x32x64_f8f6f4(a, b, c, 1, 0, 0, 0x7f7f7f7f, 0, 0x7f7f7f7f)
typedef _Float16 f16x2 __attribute__((ext_vector_type(2)));
__device__ __forceinline__ unsigned att8_code4(float s0, float s1, float s2, float s3) {
  const f16x2 four = {(_Float16)4.f, (_Float16)4.f}, bias = {(_Float16)1084.f, (_Float16)1084.f};
  const f16x2 x = __builtin_bit_cast(f16x2, __builtin_amdgcn_cvt_pkrtz(s0, s1)) * four + bias, y = __builtin_bit_cast(f16x2, __builtin_amdgcn_cvt_pkrtz(s2, s3)) * four + bias;
  return __builtin_amdgcn_perm(__builtin_bit_cast(unsigned, y), __builtin_bit_cast(unsigned, x), 0x06040200u);
}
__device__ __forceinline__ i32x8 att8_pack(const f32x16& p0, const f32x16& p1) {
  i32x8 w;
#pragma unroll
  for (int i = 0; i < 4; ++i) {
    const unsigned d = att8_code4(p0[4 * i], p0[4 * i + 1], p0[4 * i + 2], p0[4 * i + 3]), e = att8_code4(p1[4 * i], p1[4 * i + 1], p1[4 * i + 2], p1[4 * i + 3]);
    auto r = __builtin_amdgcn_permlane32_swap(d, e, false, false);
    w[2 * i] = (int)r[0]; w[2 * i + 1] = (int)r[1];
  }
  return w;
}
__device__ __forceinline__ void attn_unit8(const Params& p, LAS char* lds, int row0, int hp, int nkeys, bf16_t* MIXP = nullptr) {
  const unsigned char* Q8 = (const unsigned char*)(p.ws + OFF_Q8); const unsigned char* K8 = (const unsigned char*)(p.ws + OFF_K8); const unsigned char* VT8 = (const unsigned char*)(p.ws + OFF_VT8);
  bf16_t* MIX = MIXP ? MIXP : (bf16_t*)(p.ws + OFF_MIX);
  const int tid = TIDX, wid = tid >> 6, lane = tid & 63, r32 = lane & 31, hi = lane >> 5, kvh = hp >> 1;
  i32x8 qa, qb;
  { const unsigned char* Qg = Q8 + (size_t)(row0 + wid * 32 + r32) * 512 + hp * 128 + hi * 32;
    const u32x4 a0 = *(const u32x4*)Qg, a1 = *(const u32x4*)(Qg + 16), b0 = *(const u32x4*)(Qg + 64), b1 = *(const u32x4*)(Qg + 80);
    qa = (i32x8){(int)a0[0], (int)a0[1], (int)a0[2], (int)a0[3], (int)a1[0], (int)a1[1], (int)a1[2], (int)a1[3]};
    qb = (i32x8){(int)b0[0], (int)b0[1], (int)b0[2], (int)b0[3], (int)b1[0], (int)b1[1], (int)b1[2], (int)b1[3]}; }
  const int wv = __builtin_amdgcn_readfirstlane(wid);
  const int prow = (wv & 3) * 16 + (lane >> 2), pch = (lane & 3) ^ ((prow >> 2) & 3);
  const unsigned char* Sg = wv < 4 ? K8 + (size_t)prow * 128 + kvh * 64 + pch * 16 : VT8 + (size_t)(kvh * 64 + prow) * TT + pch * 16;
  const size_t sstep = wv < 4 ? (size_t)64 * 128 : (size_t)64;
  const int sdst = (wv < 4 ? 0 : 4096) + (wv & 3) * 1024;
#define A8_DMA(t) __builtin_amdgcn_global_load_lds((const unsigned*)(Sg + (size_t)(t) * sstep), (LAS unsigned*)(lds + ((t) & (A8_NSLOT - 1)) * A8_SLOT + sdst), 16, 0, 0)
  const int NT = nkeys >> 6;
  f32x16 oa0 = {}, oa1 = {}, ob0 = {}, ob1 = {}, ola = {}, olb = {};
  const i32x8 ones = {0x38383838, 0x38383838, 0x38383838, 0x38383838, 0x38383838, 0x38383838, 0x38383838, 0x38383838};
  A8_DMA(0); A8_DMA(1); if (NT > 2) { A8_DMA(2); A8_DMA(3); }
  for (int j = 0; j < NT; j += 2) {
    if (j + 2 < NT) asm volatile("s_waitcnt vmcnt(2)" ::: "memory"); else asm volatile("s_waitcnt vmcnt(0)" ::: "memory");
    asm volatile("s_waitcnt lgkmcnt(0)" ::: "memory"); __builtin_amdgcn_s_barrier();
    if (j + 4 < NT) { A8_DMA(j + 4); A8_DMA(j + 5); }
#pragma unroll
    for (int jj = 0; jj < 2; ++jj) {
      const LAS char* sl = lds + ((j + jj) & (A8_NSLOT - 1)) * A8_SLOT;
      f32x16 sa0 = {}, sa1 = {}, sb0 = {}, sb1 = {};
      const i32x8 kf0 = ld_frag8(sl, r32, hi), kf1 = ld_frag8(sl, 32 + r32, hi);
      SBAR();
      sa0 = MX_FP8_FP8(kf0, qa, sa0); sa1 = MX_FP8_FP8(kf1, qa, sa1);
      SBAR();
      sb0 = MX_FP8_FP8(kf0, qb, sb0); sb1 = MX_FP8_FP8(kf1, qb, sb1);
      SBAR();
      const i32x8 pa = att8_pack(sa0, sa1);
      const i32x8 vf0 = ld_frag8(sl + 4096, r32, hi), vf1 = ld_frag8(sl + 4096, 32 + r32, hi);
      SBAR();
      oa0 = MX_BF8_FP8(pa, vf0, oa0); oa1 = MX_BF8_FP8(pa, vf1, oa1); ola = MX_BF8_FP8(pa, ones, ola);
      const i32x8 pb = att8_pack(sb0, sb1);
      SBAR();
      ob0 = MX_BF8_FP8(pb, vf0, ob0); ob1 = MX_BF8_FP8(pb, vf1, ob1); olb = MX_BF8_FP8(pb, ones, olb);
    }
  }
#undef A8_DMA
  asm volatile("s_waitcnt lgkmcnt(0)" ::: "memory"); __builtin_amdgcn_s_barrier();
  bf16_t* Og = MIX + (size_t)(row0 + wid * 32) * D + hp * 128 + r32;
#pragma unroll
  for (int r = 0; r < 16; ++r) {
    const int orow = crow(r, hi);
    const float ra = __builtin_amdgcn_rcpf(ola[r]), rb = __builtin_amdgcn_rcpf(olb[r]);
    Og[(size_t)orow * D] = f2bf(oa0[r] * ra); Og[(size_t)orow * D + 32] = f2bf(oa1[r] * ra);
    Og[(size_t)orow * D + 64] = f2bf(ob0[r] * rb); Og[(size_t)orow * D + 96] = f2bf(ob1[r] * rb);
  }
  __syncthreads();
}
__device__ __forceinline__ void attn_fallback(const Params& p, int layer, int bid, int nblk) {
  const bf16_t* Q = (const bf16_t*)(p.ws + OFF_Q); const bf16_t* Kb = (const bf16_t*)(p.ws + OFF_K); const bf16_t* Vb = (const bf16_t*)(p.ws + OFF_V);
  bf16_t* MIX = (bf16_t*)(p.ws + OFF_MIX);
  const int lane = TIDX & 63, nwv = nblk * 8;
  const int rg0 = layer == 0 ? 0 : NCTX / 64;
  for (int wv = bid * 8 + (TIDX >> 6) + rg0 * 8; wv < (TT / 64) * 8; wv += nwv) {
    const int head = wv & 7, r = (wv >> 3) * 64 + lane, kvh = head >> 2;
    float q[64], o[64];
#pragma unroll
    for (int d = 0; d < 64; ++d) { q[d] = bf2f(Q[(size_t)r * 512 + head * 64 + d]); o[d] = 0.f; }
    float m = -1e30f, l = 0.f;
    const int nk = r >= NCTX ? TT : NCTX;
    for (int j = 0; j < nk; ++j) {
      const bf16_t* kr = Kb + (size_t)j * 128 + kvh * 64;
      const bf16_t* vr = Vb + (size_t)j * 128 + kvh * 64;
      float s = 0.f;
#pragma unroll
      for (int d = 0; d < 64; ++d) s += q[d] * bf2f(kr[d]);
      if (s > m) {
        const float a = __builtin_amdgcn_exp2f(m - s);
        l *= a;
#pragma unroll
        for (int d = 0; d < 64; ++d) o[d] *= a;
        m = s;
      }
      const float pe = __builtin_amdgcn_exp2f(s - m);
      l += pe;
#pragma unroll
      for (int d = 0; d < 64; ++d) o[d] += pe * bf2f(vr[d]);
    }
    const float il = 1.f / l;
#pragma unroll
    for (int d = 0; d < 64; ++d) MIX[(size_t)r * D + head * 64 + d] = f2bf(o[d] * il);
  }
}

constexpr int PC_U = 0;
constexpr int PC_Y = 49152;
constexpr int PC_P = PC_Y + 65536;
constexpr int PC_LDS = PC_P + 32768;
__device__ __forceinline__ void poolconv_unit(const Params& p, int layer, LAS char* lds, int tile) {
  const int tid = TIDX, wid = tid >> 6, lane = tid & 63, r32 = lane & 31, hi = lane >> 5;
  const int t0 = tile * 64, base = tile < 4 ? 0 : NCTX, n = tile < 4 ? NCTX : SEQ;
  const bf16_t* AG = (const bf16_t*)(p.ws + OFF_AG);
  const float* U = (const float*)(p.ws + OFF_U);
  bf16_t* MIX = (bf16_t*)(p.ws + OFF_MIX);
#pragma unroll
  for (int h = 0; h < 2; ++h) {
    u32x4 av[3], gv[3]; bool in[3];
#pragma unroll
    for (int q = 0; q < 3; ++q) {
      const int idx = tid + (h * 3 + q) * 512, rr = idx >> 5, ch = (idx & 31) * 8, t = t0 - 15 + rr;
      in[q] = idx < 94 * 32 && t >= base && t < base + n;
      const size_t off = (size_t)(in[q] ? t : t0) * 512 + ch;
      av[q] = *(const u32x4*)(AG + off); gv[q] = *(const u32x4*)(AG + off + 256);
    }
#pragma unroll
    for (int q = 0; q < 3; ++q) {
      const int idx = tid + (h * 3 + q) * 512, rr = idx >> 5, ch = (idx & 31) * 8;
      u32x4 out = {0u, 0u, 0u, 0u};
      if (in[q]) {
#pragma unroll
        for (int i = 0; i < 4; ++i) {
          const float a0 = __uint_as_float(av[q][i] << 16), a1 = __uint_as_float(av[q][i] & 0xffff0000u);
          const float g0 = __uint_as_float(gv[q][i] << 16), g1 = __uint_as_float(gv[q][i] & 0xffff0000u);
          out[i] = cvtpk(a0 / (1.f + __expf(-g0)), a1 / (1.f + __expf(-g1)));
        }
      }
      if (idx < 94 * 32) *(LAS u32x4*)(lds + PC_U + (rr * 256 + ch) * 2) = out;
    }
  }
  __syncthreads();
  {
    const int c = tid & 255, th = tid >> 8;
    float w[31];
#pragma unroll
    for (int j = 0; j < 31; ++j) w[j] = p.w_dw[(size_t)layer * 31 * 256 + j * 256 + c];
    const float b = p.b_dw[layer * 256 + c];
    float acc[32];
#pragma unroll
    for (int i = 0; i < 32; ++i) acc[i] = b;
    const LAS bf16_t* up = (const LAS bf16_t*)(lds + PC_U) + (th * 32) * 256 + c;
#pragma unroll
    for (int rr = 0; rr < 62; ++rr) {
      const float uv = bf2f(up[rr * 256]);
#pragma unroll
      for (int i = 0; i < 32; ++i) if (rr - i >= 0 && rr - i < 31) acc[i] += uv * w[rr - i];
    }
    LAS float* yp = (LAS float*)(lds + PC_Y) + (th * 32) * 256 + c;
#pragma unroll
    for (int i = 0; i < 32; ++i) yp[i * 256] = acc[i];
  }
  {
    const int c = tid & 255, th = tid >> 8, grp = c >> 6, w = 2 << grp, hw = w >> 1;
    const int tl0 = t0 - base + th * 32;
    float uv[48];
#pragma unroll
    for (int i = 0; i < 48; ++i) { const int j = tl0 - 8 + i; const bool in = j >= 0 && j < n; uv[i] = in ? U[(size_t)(base + j) * 256 + c] : 0.f; }
#pragma unroll
    for (int i = 0; i < 32; ++i) {
      const int tl = tl0 + i, lo = max(tl - hw, 0), hh = min(tl + hw, n);
      float s = 0.f;
#pragma unroll
      for (int d = -8; d < 8; ++d) if (d >= -hw && d < hw) s += uv[8 + i + d];
      const float pv = s / (float)(hh - lo) - uv[8 + i];
      const int tok = th * 32 + i, chunk = c >> 3, sw = (chunk & 16) | ((chunk ^ tok) & 15);
      *(LAS bf16_t*)(lds + PC_P + tok * 512 + sw * 16 + (c & 7) * 2) = f2bf(pv);
    }
  }
  __syncthreads();
  {
    const f32x4 g4 = *(const f32x4*)(p.cv_ln_g + layer * 256 + lane * 4), b4 = *(const f32x4*)(p.cv_ln_b + layer * 256 + lane * 4);
#pragma unroll
    for (int i = 0; i < 8; ++i) {
      const int tok = wid * 8 + i;
      const f32x4 y = *(const LAS f32x4*)(lds + PC_Y + (tok * 256 + lane * 4) * 4);
      const float mu = wave_sum(y[0] + y[1] + y[2] + y[3]) * (1.f / 256.f);
      const float d0 = y[0] - mu, d1 = y[1] - mu, d2 = y[2] - mu, d3 = y[3] - mu;
      const float rs = rsqrtf(wave_sum(d0 * d0 + d1 * d1 + d2 * d2 + d3 * d3) * (1.f / 256.f) + EPS);
      const float z0 = silu(d0 * rs * g4[0] + b4[0]), z1 = silu(d1 * rs * g4[1] + b4[1]), z2 = silu(d2 * rs * g4[2] + b4[2]), z3 = silu(d3 * rs * g4[3] + b4[3]);
      const int chunk = lane >> 1, sw = (chunk & 16) | ((chunk ^ tok) & 15);
      *(LAS u32x2*)(lds + PC_U + tok * 512 + sw * 16 + (lane & 1) * 8) = (u32x2){cvtpk(z0, z1), cvtpk(z2, z3)};
    }
  }
  __syncthreads();
  {
    const int tb = wid >> 2, dg = wid & 3, trow = tb * 32 + r32, t = t0 + trow;
    const bf16_t* Wt = (const bf16_t*)(p.ws + OFF_WPWT) + ((size_t)layer * 256 + dg * 64 + r32) * 256 + hi * 8;
    f32x16 acc0 = {}, acc1 = {};
#pragma unroll 8
    for (int ks = 0; ks < 16; ++ks) {
      const int chunk = 2 * ks + hi, sw = (chunk & 16) | ((chunk ^ trow) & 15);
      const bf16x8 zf = *(const LAS bf16x8*)(lds + PC_U + trow * 512 + sw * 16);
      const bf16x8 w0 = *(const bf16x8*)(Wt + ks * 16), w1 = *(const bf16x8*)(Wt + 32 * 256 + ks * 16);
      acc0 = __builtin_amdgcn_mfma_f32_32x32x16_bf16(w0, zf, acc0, 0, 0, 0);
      acc1 = __builtin_amdgcn_mfma_f32_32x32x16_bf16(w1, zf, acc1, 0, 0, 0);
    }
    bf16_t* dst = MIX + (size_t)t * D + 768 + dg * 64;
#pragma unroll
    for (int g = 0; g < 4; ++g) { *(u32x2*)(dst + 8 * g + 4 * hi) = pack4(acc0, g); *(u32x2*)(dst + 32 + 8 * g + 4 * hi) = pack4(acc1, g); }
    const bf16_t* Pt = (const bf16_t*)(p.ws + OFF_WPOOLT) + ((size_t)(layer * 4 + dg) * 64 + r32) * 64 + hi * 8;
    f32x16 pc0 = {}, pc1 = {};
#pragma unroll
    for (int ks = 0; ks < 4; ++ks) {
      const int chunk = dg * 8 + 2 * ks + hi, sw = (chunk & 16) | ((chunk ^ trow) & 15);
      const bf16x8 pf = *(const LAS bf16x8*)(lds + PC_P + trow * 512 + sw * 16);
      const bf16x8 w0 = *(const bf16x8*)(Pt + ks * 16), w1 = *(const bf16x8*)(Pt + 32 * 64 + ks * 16);
      pc0 = __builtin_amdgcn_mfma_f32_32x32x16_bf16(w0, pf, pc0, 0, 0, 0);
      pc1 = __builtin_amdgcn_mfma_f32_32x32x16_bf16(w1, pf, pc1, 0, 0, 0);
    }
    const float* psc = p.pool_scale + layer * 256 + dg * 64;
#pragma unroll
    for (int r = 0; r < 16; ++r) { pc0[r] *= psc[crow(r, hi)]; pc1[r] *= psc[32 + crow(r, hi)]; }
    bf16_t* pd = MIX + (size_t)t * D + 512 + dg * 64;
#pragma unroll
    for (int g = 0; g < 4; ++g) { *(u32x2*)(pd + 8 * g + 4 * hi) = pack4(pc0, g); *(u32x2*)(pd + 32 + 8 * g + 4 * hi) = pack4(pc1, g); }
  }
  __syncthreads();
}

__device__ __forceinline__ void phase_b(const Params& p, int layer, LAS char* lds, int bid, int nblk) {
  const int mode0 = ((const int*)(p.ws + OFF_FLAG))[0], vbig = ((const int*)(p.ws + OFF_FLAG))[1];
  const int mode = (mode0 == 2 && vbig != 0) ? 1 : mode0;
  const bool fast = mode != 0;
  const int nu = (520 - bid + nblk - 1) / nblk;
  for (int i = 0; i < nu; ++i) {
    const int u = bid + ((bid & 1) ? (nu - 1 - i) : i) * nblk;
    if (u < 256) { if (mode == 2) attn_unit8(p, lds, NCTX + (u >> 2) * 256, u & 3, TT); else if (mode == 1) attn_unit(p, lds, NCTX + (u >> 2) * 256, u & 3, TT); }
    else if (u < 260) { if (layer == 0) { if (mode == 2) attn_unit8(p, lds, 0, u - 256, NCTX); else if (mode == 1) attn_unit(p, lds, 0, u - 256, NCTX); } }
    else { const int tile = u - 260; if (layer == 0 || tile >= 4) poolconv_unit(p, layer, lds, tile); }
  }
  if (!fast) attn_fallback(p, layer, bid, nblk);
}

constexpr int NR = 2, NRA = 2;
__device__ __forceinline__ float hsum4(const f32x4 (&v)[4]) { float s = 0.f;
#pragma unroll
  for (int i = 0; i < 4; ++i) s += (v[i][0] + v[i][1]) + (v[i][2] + v[i][3]);
  return s; }
__device__ __forceinline__ float hsq4(const f32x4 (&v)[4], float mu) { float q = 0.f;
#pragma unroll
  for (int i = 0; i < 4; ++i) { const f32x4 d = v[i] - mu; q += (d[0] * d[0] + d[1] * d[1]) + (d[2] * d[2] + d[3] * d[3]); }
  return q; }
__device__ __forceinline__ f32x4 bf4(u32x2 w) { return (f32x4){__uint_as_float(w[0] << 16), __uint_as_float(w[0] & 0xffff0000u), __uint_as_float(w[1] << 16), __uint_as_float(w[1] & 0xffff0000u)}; }

__device__ __forceinline__ void phase_a0(const Params& p, int layer, LAS char* lds, int bid, int nblk) {
  const int tid = TIDX, wv = __builtin_amdgcn_readfirstlane(tid >> 6), wave = bid * 8 + wv, lane = tid & 63, nw = nblk * 8;
  float* X = (float*)(p.ws + OFF_X);
  bf16_t* H = (bf16_t*)(p.ws + OFF_H);
  const bf16_t* OM = (const bf16_t*)(p.ws + OFF_OMOE);
  const float* GATE = (const float*)(p.ws + OFF_GATE);
  LAS float* par = (LAS float*)lds;
  { const float* modl = (const float*)(p.ws + OFF_MOD) + (layer * 2 + 0) * 6144;
#pragma unroll
    for (int q = 0; q < 4; ++q) { const int e = tid + q * 512; par[e] = modl[e]; }
    if (layer != 0) {
      const float* modq = (const float*)(p.ws + OFF_MOD) + ((layer - 1) * 2 + 0) * 6144 + 5 * D;
#pragma unroll
      for (int q = 0; q < 2; ++q) { const int e = tid + q * 512; par[2 * D + e] = modq[e]; par[3 * D + e] = p.ln2_g[(layer - 1) * D + e]; par[4 * D + e] = p.ln2_b[(layer - 1) * D + e]; }
    }
  }
  __syncthreads();
  f32x4 xn[NRA][4]; u32x2 oan[NRA][4], obn[NRA][4];
#define A0_LOAD(rb_) do { _Pragma("unroll") for (int k = 0; k < NRA; ++k) { const int r = (rb_) + k; \
      const float* src = layer == 0 ? (r < NCTX ? p.ctx + (size_t)r * D : p.x + (size_t)(r - NCTX) * D) : X + (size_t)r * D; \
      _Pragma("unroll") for (int i = 0; i < 4; ++i) { const int c = i * 256 + lane * 4; xn[k][i] = *(const f32x4*)(src + c); \
        if (layer != 0) { oan[k][i] = *(const u32x2*)(OM + ((size_t)r * 2 + 0) * D + c); obn[k][i] = *(const u32x2*)(OM + ((size_t)r * 2 + 1) * D + c); } } } } while (0)
  if (wave * NRA < TT) A0_LOAD(wave * NRA);
  for (int rb = wave * NRA; rb < TT; rb += nw * NRA) {
    f32x4 v[NRA][4];
    const bool ctx = rb < NCTX;
    if (layer != 0) {
#pragma unroll
      for (int k = 0; k < NRA; ++k) {
        const int r = rb + k;
        const float ga = GATE[r * 2], gb = GATE[r * 2 + 1];
        if (ctx) {
          const float* g2 = (const float*)(p.ws + OFF_MOD) + ((layer - 1) * 2 + 1) * 6144 + 5 * D;
#pragma unroll
          for (int i = 0; i < 4; ++i) { const int c = i * 256 + lane * 4; v[k][i] = xn[k][i] * ALPHA + *(const f32x4*)(g2 + c) * (bf4(oan[k][i]) * ga + bf4(obn[k][i]) * gb); }
        } else {
#pragma unroll
          for (int i = 0; i < 4; ++i) { const int c = i * 256 + lane * 4; v[k][i] = xn[k][i] * ALPHA + *(const LAS f32x4*)(par + 2 * D + c) * (bf4(oan[k][i]) * ga + bf4(obn[k][i]) * gb); }
        }
      }
    } else {
#pragma unroll
      for (int k = 0; k < NRA; ++k)
#pragma unroll
        for (int i = 0; i < 4; ++i) v[k][i] = xn[k][i];
    }
    if (rb + nw * NRA < TT) A0_LOAD(rb + nw * NRA);
    if (layer != 0) {
      float mu[NRA], rs[NRA];
#pragma unroll
      for (int k = 0; k < NRA; ++k) mu[k] = wave_sum(hsum4(v[k])) * (1.f / D);
#pragma unroll
      for (int k = 0; k < NRA; ++k) rs[k] = rsqrtf(wave_sum(hsq4(v[k], mu[k])) * (1.f / D) + EPS);
#pragma unroll
      for (int k = 0; k < NRA; ++k)
#pragma unroll
        for (int i = 0; i < 4; ++i) { const int c = i * 256 + lane * 4;
          v[k][i] = (v[k][i] - mu[k]) * rs[k] * *(const LAS f32x4*)(par + 3 * D + c) + *(const LAS f32x4*)(par + 4 * D + c); *(f32x4*)(X + (size_t)(rb + k) * D + c) = v[k][i]; }
    }
    float mu[NRA], rs[NRA];
#pragma unroll
    for (int k = 0; k < NRA; ++k) mu[k] = wave_sum(hsum4(v[k])) * (1.f / D);
#pragma unroll
    for (int k = 0; k < NRA; ++k) rs[k] = rsqrtf(wave_sum(hsq4(v[k], mu[k])) * (1.f / D) + EPS);
#pragma unroll
    for (int k = 0; k < NRA; ++k) {
      const int r = rb + k;
      if (ctx) {
        const float* modp = (const float*)(p.ws + OFF_MOD) + (layer * 2 + 1) * 6144;
#pragma unroll
        for (int i = 0; i < 4; ++i) { const int c = i * 256 + lane * 4;
          const f32x4 h = (v[k][i] - mu[k]) * rs[k] * (*(const f32x4*)(modp + D + c) + 1.f) + *(const f32x4*)(modp + c);
          *(u32x2*)(H + (size_t)r * D + c) = (u32x2){cvtpk(h[0], h[1]), cvtpk(h[2], h[3])}; }
      } else {
#pragma unroll
        for (int i = 0; i < 4; ++i) { const int c = i * 256 + lane * 4;
          const f32x4 h = (v[k][i] - mu[k]) * rs[k] * (*(const LAS f32x4*)(par + D + c) + 1.f) + *(const LAS f32x4*)(par + c);
          *(u32x2*)(H + (size_t)r * D + c) = (u32x2){cvtpk(h[0], h[1]), cvtpk(h[2], h[3])}; }
      }
    }
  }
#undef A0_LOAD
}

constexpr int C2_ENT = 2048;
constexpr int C2_WRE = C2_ENT, C2_WRG = C2_WRE + 131072, C2_PAR = C2_WRG + 16384, C2_LDS = C2_PAR + 12288;
__device__ __forceinline__ void phase_c2(const Params& p, int layer, LAS char* lds, int bid, int nblk) {
  const int tid = TIDX, wid = __builtin_amdgcn_readfirstlane(tid >> 6), lane = tid & 63;
  float* X = (float*)(p.ws + OFF_X);
  const bf16_t* Y = (const bf16_t*)(p.ws + OFF_Y);
  bf16_t* H2 = (bf16_t*)(p.ws + OFF_MIX);
  int* cnt = (int*)(p.ws + OFF_CNT) + layer * NE * CNT_STRIDE;
  float* GATE = (float*)(p.ws + OFF_GATE); int* LIST = (int*)(p.ws + OFF_LIST);
  LAS int* lcnt = (LAS int*)lds;
  LAS int* lbase = lcnt + 32;
  LAS int* ent = lcnt + 64;
  if (tid < 32) lcnt[tid] = 0;
  LAS float* wre = (LAS float*)(lds + C2_WRE);
#pragma unroll
  for (int kk = 0; kk < 2; ++kk) {
    const int k = tid + kk * 512;
    f32x4 w[8];
#pragma unroll
    for (int g = 0; g < 8; ++g) w[g] = *(const f32x4*)(p.w_re + ((size_t)layer * D + k) * 32 + g * 4);
#pragma unroll
    for (int g = 0; g < 8; ++g)
#pragma unroll
      for (int j = 0; j < 4; ++j) wre[(g * 4 + j) * 1024 + k] = w[g][j];
  }
  LAS f32x4* wrg = (LAS f32x4*)(lds + C2_WRG);
#pragma unroll
  for (int kk = 0; kk < 2; ++kk) { const int k = tid + kk * 512; wrg[((k >> 8) * 4 + (k & 3)) * 64 + ((k >> 2) & 63)] = *(const f32x4*)(p.w_rg + ((size_t)layer * D + k) * 4); }
  LAS float* par = (LAS float*)(lds + C2_PAR);
  { const float* modl = (const float*)(p.ws + OFF_MOD) + (layer * 2 + 0) * 6144;
#pragma unroll
    for (int q = 0; q < 6; ++q) { const int e = tid + q * 512; par[e] = modl[2 * D + e]; } }
  f32x4 l1g[4], l1b[4];
#pragma unroll
  for (int i = 0; i < 4; ++i) { const int c = i * 256 + lane * 4; l1g[i] = *(const f32x4*)(p.ln1_g + layer * D + c); l1b[i] = *(const f32x4*)(p.ln1_b + layer * D + c); }
  __syncthreads();
  const int r0 = layer == 0 ? 0 : NCTX, nrows = TT - r0, rpb = (nrows + nblk - 1) / nblk;
  const int rbeg = r0 + bid * rpb, rend = min(rbeg + rpb, TT);
  f32x4 xn[NR][4]; u32x2 yn[NR][4];
#define C2_LOAD(rb_) do { _Pragma("unroll") for (int k = 0; k < NR; ++k) { \
      const int r = (rb_) + k < rend ? (rb_) + k : (rb_); \
      const float* xin = layer == 0 ? (r < NCTX ? p.ctx + (size_t)r * D : p.x + (size_t)(r - NCTX) * D) : X + (size_t)r * D; \
      _Pragma("unroll") for (int i = 0; i < 4; ++i) { const int c = i * 256 + lane * 4; xn[k][i] = *(const f32x4*)(xin + c); yn[k][i] = *(const u32x2*)(Y + (size_t)r * D + c); } } } while (0)
  if (rbeg + wid * NR < rend) C2_LOAD(rbeg + wid * NR);
  for (int rb = rbeg + wid * NR; rb < rend; rb += 8 * NR) {
    f32x4 v[NR][4]; int rr[NR]; bool ok[NR];
#pragma unroll
    for (int k = 0; k < NR; ++k) {
      ok[k] = rb + k < rend; rr[k] = ok[k] ? rb + k : rb;
      if (rr[k] < NCTX) {
        const float* modp = (const float*)(p.ws + OFF_MOD) + (layer * 2 + 1) * 6144;
#pragma unroll
        for (int i = 0; i < 4; ++i) { const int c = i * 256 + lane * 4; v[k][i] = xn[k][i] * ALPHA + *(const f32x4*)(modp + 2 * D + c) * bf4(yn[k][i]); }
      } else {
#pragma unroll
        for (int i = 0; i < 4; ++i) { const int c = i * 256 + lane * 4; v[k][i] = xn[k][i] * ALPHA + *(const LAS f32x4*)(par + c) * bf4(yn[k][i]); }
      }
    }
    if (rb + 8 * NR < rend) C2_LOAD(rb + 8 * NR);
    float mu[NR], rs[NR];
#pragma unroll
    for (int k = 0; k < NR; ++k) mu[k] = wave_sum(hsum4(v[k])) * (1.f / D);
#pragma unroll
    for (int k = 0; k < NR; ++k) rs[k] = rsqrtf(wave_sum(hsq4(v[k], mu[k])) * (1.f / D) + EPS);
#pragma unroll
    for (int k = 0; k < NR; ++k)
#pragma unroll
      for (int i = 0; i < 4; ++i) {
        const int c = i * 256 + lane * 4;
        v[k][i] = (v[k][i] - mu[k]) * rs[k] * l1g[i] + l1b[i];
        if (ok[k]) *(f32x4*)(X + (size_t)rr[k] * D + c) = v[k][i];
      }
#pragma unroll
    for (int k = 0; k < NR; ++k) mu[k] = wave_sum(hsum4(v[k])) * (1.f / D);
#pragma unroll
    for (int k = 0; k < NR; ++k) rs[k] = rsqrtf(wave_sum(hsq4(v[k], mu[k])) * (1.f / D) + EPS);
#pragma unroll
    for (int k = 0; k < NR; ++k) {
      if (rr[k] < NCTX) {
        const float* modp = (const float*)(p.ws + OFF_MOD) + (layer * 2 + 1) * 6144;
#pragma unroll
        for (int i = 0; i < 4; ++i) { const int c = i * 256 + lane * 4; v[k][i] = (v[k][i] - mu[k]) * rs[k] * (*(const f32x4*)(modp + 4 * D + c) + 1.f) + *(const f32x4*)(modp + 3 * D + c); }
      } else {
#pragma unroll
        for (int i = 0; i < 4; ++i) { const int c = i * 256 + lane * 4; v[k][i] = (v[k][i] - mu[k]) * rs[k] * (*(const LAS f32x4*)(par + 2 * D + c) + 1.f) + *(const LAS f32x4*)(par + D + c); }
      }
#pragma unroll
      for (int i = 0; i < 4; ++i) { const int c = i * 256 + lane * 4;
        if (ok[k]) *(u32x2*)(H2 + (size_t)rr[k] * D + c) = (u32x2){cvtpk(v[k][i][0], v[k][i][1]), cvtpk(v[k][i][2], v[k][i][3])}; }
    }
    f32x4 lg[NR];
#pragma unroll
    for (int k = 0; k < NR; ++k) lg[k] = (f32x4){0.f, 0.f, 0.f, 0.f};
#pragma unroll
    for (int i = 0; i < 4; ++i)
#pragma unroll
      for (int j = 0; j < 4; ++j) { const f32x4 w = wrg[(i * 4 + j) * 64 + lane];
#pragma unroll
        for (int k = 0; k < NR; ++k) lg[k] += w * v[k][i][j]; }
    int gsel[NR]; float pgrp[NR];
#pragma unroll
    for (int k = 0; k < NR; ++k) {
      float l0 = wave_sum(lg[k][0]) + p.b_rg[layer * 4 + 0], l1 = wave_sum(lg[k][1]) + p.b_rg[layer * 4 + 1];
      float l2 = wave_sum(lg[k][2]) + p.b_rg[layer * 4 + 2], l3 = wave_sum(lg[k][3]) + p.b_rg[layer * 4 + 3];
      int gs = 0; float gm = l0;
      if (l1 > gm) { gm = l1; gs = 1; }
      if (l2 > gm) { gm = l2; gs = 2; }
      if (l3 > gm) { gm = l3; gs = 3; }
      gsel[k] = gs; pgrp[k] = 1.f / (__expf(l0 - gm) + __expf(l1 - gm) + __expf(l2 - gm) + __expf(l3 - gm));
    }
#pragma unroll
    for (int k = 0; k < NR; ++k) {
      float le[8];
#pragma unroll
      for (int e = 0; e < 8; ++e) {
        const LAS float* wr = wre + (gsel[k] * 8 + e) * 1024 + lane * 4;
        float a = 0.f;
#pragma unroll
        for (int i = 0; i < 4; ++i) { const f32x4 w = *(const LAS f32x4*)(wr + i * 256); a += (w[0] * v[k][i][0] + w[1] * v[k][i][1]) + (w[2] * v[k][i][2] + w[3] * v[k][i][3]); }
        le[e] = a;
      }
#pragma unroll
      for (int e = 0; e < 8; ++e) le[e] = wave_sum(le[e]) + p.b_re[layer * 32 + gsel[k] * 8 + e];
      int i0 = 0; float v0 = le[0];
#pragma unroll
      for (int e = 1; e < 8; ++e) if (le[e] > v0) { v0 = le[e]; i0 = e; }
      int i1 = -1; float v1 = -3.0e38f;
#pragma unroll
      for (int e = 0; e < 8; ++e) if (e != i0 && le[e] > v1) { v1 = le[e]; i1 = e; }
      if (i1 < 0) { i1 = (i0 + 1) & 7; v1 = v0; }
      const float e1 = __expf(v1 - v0);
      if (lane == 0 && ok[k]) {
        const int r = rr[k], xa = gsel[k] * 8 + i0, xb = gsel[k] * 8 + i1;
        const int pa = __hip_atomic_fetch_add(&lcnt[xa], 1, __ATOMIC_RELAXED, __HIP_MEMORY_SCOPE_WORKGROUP);
        const int pb = __hip_atomic_fetch_add(&lcnt[xb], 1, __ATOMIC_RELAXED, __HIP_MEMORY_SCOPE_WORKGROUP);
        const int li = (r - rbeg) * 2;
        ent[li * 3 + 0] = xa; ent[li * 3 + 1] = pa; ent[li * 3 + 2] = r * 2 + 0;
        ent[li * 3 + 3] = xb; ent[li * 3 + 4] = pb; ent[li * 3 + 5] = r * 2 + 1;
        GATE[r * 2] = pgrp[k] / (1.f + e1); GATE[r * 2 + 1] = pgrp[k] * e1 / (1.f + e1);
      }
    }
  }
  __syncthreads();
  if (tid < 32) { const int c = lcnt[tid]; lbase[tid] = c > 0 ? atomicAdd(&cnt[tid * CNT_STRIDE], c) : 0; }
  __syncthreads();
  for (int i = tid; i < (rend - rbeg) * 2; i += 512) { const int e = ent[i * 3], lp = ent[i * 3 + 1]; LIST[(size_t)e * CAPL + lbase[e] + lp] = ent[i * 3 + 2]; }
  __syncthreads();
#undef C2_LOAD
}

__device__ __forceinline__ void phase_final(const Params& p, int bid, int nblk) {
  const int wave = bid * 8 + (TIDX >> 6), lane = TIDX & 63, nw = nblk * 8;
  const float* X = (const float*)(p.ws + OFF_X);
  const bf16_t* OM = (const bf16_t*)(p.ws + OFF_OMOE);
  const float* g2 = (const float*)(p.ws + OFF_MOD) + (1 * 2 + 0) * 6144 + 5 * D;
  for (int rb = NCTX + wave * NRA; rb < TT; rb += nw * NRA) {
    f32x4 v[NRA][4]; u32x2 oa[NRA][4], ob[NRA][4];
#pragma unroll
    for (int k = 0; k < NRA; ++k)
#pragma unroll
      for (int i = 0; i < 4; ++i) { const int c = i * 256 + lane * 4, r = rb + k;
        v[k][i] = *(const f32x4*)(X + (size_t)r * D + c); oa[k][i] = *(const u32x2*)(OM + ((size_t)r * 2 + 0) * D + c); ob[k][i] = *(const u32x2*)(OM + ((size_t)r * 2 + 1) * D + c); }
#pragma unroll
    for (int k = 0; k < NRA; ++k) {
      const float ga = ((const float*)(p.ws + OFF_GATE))[(rb + k) * 2], gb = ((const float*)(p.ws + OFF_GATE))[(rb + k) * 2 + 1];
#pragma unroll
      for (int i = 0; i < 4; ++i) { const int c = i * 256 + lane * 4; v[k][i] = v[k][i] * ALPHA + *(const f32x4*)(g2 + c) * (bf4(oa[k][i]) * ga + bf4(ob[k][i]) * gb); }
    }
    float mu[NRA], rs[NRA];
#pragma unroll
    for (int k = 0; k < NRA; ++k) mu[k] = wave_sum(hsum4(v[k])) * (1.f / D);
#pragma unroll
    for (int k = 0; k < NRA; ++k) rs[k] = rsqrtf(wave_sum(hsq4(v[k], mu[k])) * (1.f / D) + EPS);
#pragma unroll
    for (int k = 0; k < NRA; ++k)
#pragma unroll
      for (int i = 0; i < 4; ++i) {
        const int c = i * 256 + lane * 4;
        *(f32x4*)(p.out + (size_t)(rb + k - NCTX) * D + c) = (v[k][i] - mu[k]) * rs[k] * *(const f32x4*)(p.ln2_g + D + c) + *(const f32x4*)(p.ln2_b + D + c);
      }
  }
}

__device__ __forceinline__ void phase_p0(const Params& p, LAS char* lds, int bid, int nblk) {
  const int tid = TIDX;
  const long gtid = (long)bid * 512 + tid, gth = (long)nblk * 512;
  LAS float* sc = (LAS float*)lds;
  LAS float* red = (LAS float*)(lds + 8192);
  for (int i = tid; i < 2048; i += 512) { const float v = i < 1024 ? p.c[i] : p.c_ctx[i - 1024]; sc[i] = silu(v); }
  __syncthreads();
  float* mod = (float*)(p.ws + OFF_MOD);
  for (int u = bid; u < 384; u += nblk) {
    const int layer = u / 192, cg = u % 192, col = tid & 31, ksl = tid >> 5;
    const float* w = p.w_mod + ((size_t)layer * D + ksl * 64) * 6144 + cg * 32 + col;
    float a0 = 0.f, a1 = 0.f;
#pragma unroll 8
    for (int k = 0; k < 64; ++k) { const float wv = w[(size_t)k * 6144]; a0 += sc[ksl * 64 + k] * wv; a1 += sc[1024 + ksl * 64 + k] * wv; }
    red[(ksl * 32 + col) * 2] = a0; red[(ksl * 32 + col) * 2 + 1] = a1;
    __syncthreads();
    if (tid < 64) {
      const int c2 = tid & 31, s = tid >> 5; float a = 0.f;
#pragma unroll
      for (int k = 0; k < 16; ++k) a += red[(k * 32 + c2) * 2 + s];
      mod[(layer * 2 + s) * 6144 + cg * 32 + c2] = a + p.b_mod[layer * 6144 + cg * 32 + c2];
    }
    __syncthreads();
  }
  if (gtid < 256 * 16) {
    const int pos = (int)gtid / 16, f = (int)gtid % 16;
    const float ang = (float)pos * powf(10000.f, -(float)f / 16.f);
    float* rt = (float*)(p.ws + OFF_ROPE);
    rt[gtid * 2 + 0] = cosf(ang); rt[gtid * 2 + 1] = sinf(ang);
  }
  if (gtid < 2 * NE * CNT_STRIDE) ((int*)(p.ws + OFF_CNT))[gtid] = 0;
  if (gtid == 0) {
    float bmax = 0.f;
    for (int l = 0; l < 2; ++l) {
      float gq = 0.f, gk = 0.f;
      for (int i = 0; i < 64; ++i) { gq = fmaxf(gq, fabsf(p.q_gain[l * 64 + i])); gk = fmaxf(gk, fabsf(p.k_gain[l * 64 + i])); }
      bmax = fmaxf(bmax, 11.55f * gq * gk);
    }
    ((int*)(p.ws + OFF_FLAG))[0] = bmax <= 13.2f ? 2 : (bmax <= 100.f ? 1 : 0);
    ((int*)(p.ws + OFF_FLAG))[1] = 0;
  }
  for (long i = gtid; i < 2 * 65536; i += gth) { const int l = (int)(i >> 16), d = (int)(i >> 8) & 255, c = (int)i & 255; ((bf16_t*)(p.ws + OFF_WPWT))[i] = f2bf(p.w_cv_pw[((size_t)l * 256 + c) * 256 + d]); }
  for (long i = gtid; i < 8 * 4096; i += gth) { const int lg = (int)(i >> 12), d = (int)(i >> 6) & 63, c = (int)i & 63; ((bf16_t*)(p.ws + OFF_WPOOLT))[i] = f2bf(p.w_pool[((size_t)lg * 64 + c) * 64 + d]); }
  cvt_range(p.w_in, (bf16_t*)(p.ws + OFF_WIN), 2L * D * INW / 8, gtid, gth);
  cvt_range(p.w_out, (bf16_t*)(p.ws + OFF_WOUT), 2L * D * D / 8, gtid, gth);
}
#define XB_TMO      128
#define XB_XCNT(j)  (256  + 64 * (j))
#define XB_XSUB(j)  (1280 + 64 * (j))
#define XB_XGEN(j)  (2304 + 64 * (j))
#define XB_TOP      3328
#define XB_TOPGEN   3392
#define XCD_BAR_WORDS 3456
#define XB_SPIN_CAP (1u << 22)
__device__ __forceinline__ unsigned xb_ld(unsigned* p)              { return __hip_atomic_load(p, __ATOMIC_RELAXED, __HIP_MEMORY_SCOPE_AGENT); }
__device__ __forceinline__ unsigned xb_add(unsigned* p, unsigned v) { return __hip_atomic_fetch_add(p, v, __ATOMIC_RELAXED, __HIP_MEMORY_SCOPE_AGENT); }
__device__ __forceinline__ unsigned xb_xcc_id() { return (unsigned)__builtin_amdgcn_s_getreg((3 << 11) | 20) & 0xFu; }
#define XB_SPIN(cond, bar) do { unsigned _sp = 0; while (cond) { __builtin_amdgcn_s_sleep(1); \
    if ((++_sp & 255u) == 0u) { if (xb_ld(&(bar)[XB_TMO])) break; if (_sp > XB_SPIN_CAP) { atomicAdd(&(bar)[XB_TMO], 1u); break; } } } } while (0)
struct XcdBarrier { unsigned* bar; unsigned x; volatile LAS unsigned* st; };
__device__ __forceinline__ XcdBarrier xcd_barrier_post(unsigned* bar, volatile LAS unsigned* st) {
  XcdBarrier b; b.bar = bar; b.x = xb_xcc_id(); b.st = st;
  if (threadIdx.x == 0) (void)xb_add(&bar[XB_XCNT(b.x)], 1u);
  return b;
}
__device__ __forceinline__ void xcd_barrier_complete(unsigned* bar, unsigned x, unsigned& nloc, unsigned& nx) {
  const unsigned G = gridDim.x * gridDim.y * gridDim.z;
  unsigned sum, cnt, mine, sp = 0u;
  for (;;) {
    sum = 0u; cnt = 0u; mine = 0u;
#pragma unroll
    for (unsigned j = 0; j < 16; ++j) { const unsigned c = xb_ld(&bar[XB_XCNT(j)]); sum += c; cnt += (c > 0u) ? 1u : 0u; mine = (j == x) ? c : mine; }
    if (sum == G) break;
    __builtin_amdgcn_s_sleep(1);
    if ((++sp & 255u) == 0u) { if (xb_ld(&bar[XB_TMO])) break; if (sp > XB_SPIN_CAP) { atomicAdd(&bar[XB_TMO], 1u); break; } }
  }
  nloc = mine > 0u ? mine : 1u; nx = cnt > 0u ? cnt : 1u;
}
__device__ __forceinline__ void xcd_barrier(const XcdBarrier& b) {
  asm volatile("s_waitcnt vmcnt(0)" ::: "memory");
  __syncthreads();
  if (threadIdx.x == 0) {
    unsigned* bar = b.bar; unsigned bx = b.x;
    asm volatile("" : "+s"(bar), "+s"(bx));
    __builtin_amdgcn_s_waitcnt(0);
    unsigned nloc = b.st[0], nx = b.st[1];
    if (nloc == 0u) { xcd_barrier_complete(bar, bx, nloc, nx); b.st[0] = nloc; b.st[1] = nx; }
    const unsigned old = xb_add(&bar[XB_XSUB(bx)], 1u);
    const unsigned gen = old / nloc;
    if (old + 1u == (gen + 1u) * nloc) {
      __builtin_amdgcn_fence(__ATOMIC_RELEASE, "agent");
      asm volatile("s_waitcnt vmcnt(0)" ::: "memory");
      const unsigned og = xb_add(&bar[XB_TOP], 1u);
      const unsigned tg = og / nx;
      if (og + 1u == (tg + 1u) * nx) xb_add(&bar[XB_TOPGEN], 1u);
      else XB_SPIN(xb_ld(&bar[XB_TOPGEN]) == tg, bar);
      __builtin_amdgcn_fence(__ATOMIC_ACQUIRE, "agent");
      xb_add(&bar[XB_XGEN(bx)], 1u);
      asm volatile("s_waitcnt vmcnt(0)" ::: "memory");
    } else {
      XB_SPIN(xb_ld(&bar[XB_XGEN(bx)]) == gen, bar);
      __builtin_amdgcn_fence(__ATOMIC_ACQUIRE, "agent");
      asm volatile("s_waitcnt vmcnt(0)" ::: "memory");
    }
  }
  __syncthreads();
}

constexpr int LDS_MAIN0 = PC_LDS > GEMM_LDS + 512 ? PC_LDS : GEMM_LDS + 512;
constexpr int LDS_MAIN = LDS_MAIN0 > C2_LDS ? LDS_MAIN0 : C2_LDS;
constexpr int LDS_TOTAL = LDS_MAIN + 16;
static_assert(GEMM_LDS + 512 <= LDS_MAIN && ATT_LDS <= LDS_MAIN && LDS_MAIN + 16 <= 163840, "lds");
__global__ void __launch_bounds__(512) mega_fwd(Params p) {
  __shared__ __attribute__((aligned(16))) char slds[LDS_TOTAL];
  LAS char* lds = (LAS char*)slds;
  volatile LAS unsigned* st = (volatile LAS unsigned*)(lds + LDS_MAIN);
  if (threadIdx.x < 4) st[threadIdx.x] = 0u;
  __syncthreads();
  const XcdBarrier bar = xcd_barrier_post((unsigned*)(p.ws + OFF_BAR), st);
  const int bid = blockIdx.x, nblk = gridDim.x;
  phase_p0(p, lds, bid, nblk);
  xcd_barrier(bar);
#pragma unroll 1
  for (int layer = 0; layer < 2; ++layer) {
    phase_a0(p, layer, lds, bid, nblk);
    xcd_barrier(bar);
    phase_a1(p, layer, lds, bid, nblk);
    xcd_barrier(bar);
    phase_b(p, layer, lds, bid, nblk);
    xcd_barrier(bar);
    phase_c1(p, layer, lds, bid, nblk);
    xcd_barrier(bar);
    phase_c2(p, layer, lds, bid, nblk);
    xcd_barrier(bar);
    phase_d1(p, layer, lds, bid, nblk);
    xcd_barrier(bar);
    phase_d2(p, layer, lds, bid, nblk);
    xcd_barrier(bar);
  }
  phase_final(p, bid, nblk);
}

extern "C" void kernel_launch(void* const* d_in, const int* in_sizes, int n_in, void* d_out, int out_size, void* d_ws, size_t ws_size,
                              hipStream_t stream) {
  static int grid = 0;
  if (grid == 0) {
    if (ws_size < WS_END || n_in != 28) { fprintf(stderr, "kernel_launch: ws too small (%zu < %zu) or n_in %d != 28; nothing launched\n", ws_size, (size_t)WS_END, n_in); grid = -1; return; }
    int dev = 0, cus = 0, per_cu = 0;
    if (hipGetDevice(&dev) != hipSuccess || hipDeviceGetAttribute(&cus, hipDeviceAttributeMultiprocessorCount, dev) != hipSuccess) { grid = -1; return; }
    if (hipOccupancyMaxActiveBlocksPerMultiprocessor(&per_cu, (const void*)mega_fwd, 512, 0) != hipSuccess || per_cu < 1) {
      fprintf(stderr, "kernel_launch: occupancy query says %d blocks per CU; nothing launched\n", per_cu); grid = -1; return; }
    (void)hipGetLastError();
    grid = cus;
  }
  if (grid < 0) return;
  if (hipMemsetAsync((char*)d_ws + OFF_BAR, 0, BAR_BYTES, stream) != hipSuccess) { fprintf(stderr, "kernel_launch: memset failed\n"); return; }
  Params p{};
  const float** f = (const float**)&p;
  for (int i = 0; i < 28; ++i) f[i] = (const float*)d_in[i];
  p.out = (float*)d_out; p.ws = (char*)d_ws;
  hipLaunchKernelGGL(mega_fwd, dim3(grid), dim3(512), 0, stream, p);
}
```

```cpp
#include <hip/hip_runtime.h>
#include <cstdio>
#include <cstdint>

typedef unsigned short bf16_t;
#define LAS __attribute__((address_space(3)))

constexpr int D = 1024, SEQ = 16384, NCTX = 256, TT = SEQ + NCTX;
constexpr int INW = 1536;
constexpr int NE = 32, DE = 512;
constexpr int CAPL = 2 * TT;
constexpr int HMID_ROWS = 2 * TT + NE * 128;
constexpr float ALPHA = 1.41421356237309515f;
constexpr float EPS = 1e-6f;

constexpr size_t al(size_t x) { return (x + 255) / 256 * 256; }
constexpr size_t OFF_BAR = 0;
constexpr size_t BAR_BYTES = 3456 * 4;
constexpr size_t OFF_MOD = OFF_BAR + al(BAR_BYTES);
constexpr size_t OFF_ROPE = OFF_MOD + al(2 * 2 * 6144 * 4);
constexpr int CNT_STRIDE = 32;
constexpr size_t OFF_CNT = OFF_ROPE + al(256 * 16 * 2 * 4);
constexpr size_t OFF_FLAG = OFF_CNT + al(2 * 32 * 32 * 4);
constexpr size_t OFF_X = OFF_FLAG + 256;
constexpr size_t OFF_H = OFF_X + al((size_t)TT * D * 4);
constexpr size_t OFF_MIX = OFF_H + al((size_t)TT * D * 2);
constexpr size_t OFF_Y = OFF_MIX + al((size_t)TT * D * 2);
constexpr size_t OFF_Q = OFF_Y + al((size_t)TT * D * 2);
constexpr size_t OFF_K = OFF_Q + al((size_t)TT * 512 * 2);
constexpr size_t OFF_V = OFF_K + al((size_t)TT * 128 * 2);
constexpr size_t OFF_U = OFF_V + al((size_t)TT * 128 * 2);
constexpr size_t OFF_AG = OFF_U + al((size_t)TT * 256 * 4);
constexpr size_t OFF_HMID = OFF_Q;
constexpr size_t OFF_OMOE = OFF_AG + al((size_t)TT * 512 * 2);
constexpr size_t OFF_GATE = OFF_OMOE + al((size_t)TT * 2 * D * 2);
constexpr size_t OFF_LIST = OFF_GATE + al((size_t)TT * 2 * 4);
constexpr size_t OFF_WIN = OFF_LIST + al((size_t)NE * CAPL * 4);
constexpr size_t OFF_WOUT = OFF_WIN + al((size_t)2 * D * INW * 2);
constexpr size_t OFF_WPWT = OFF_WOUT + al((size_t)2 * D * D * 2);
constexpr size_t OFF_WPOOLT = OFF_WPWT + al((size_t)2 * 256 * 256 * 2);
constexpr size_t OFF_Q8 = OFF_WPOOLT + al((size_t)2 * 4 * 64 * 64 * 2);
constexpr size_t OFF_K8 = OFF_Q8 + al((size_t)TT * 512);
constexpr size_t OFF_VT8 = OFF_K8 + al((size_t)TT * 128);
constexpr size_t OFF_WG = OFF_VT8 + al((size_t)128 * TT);
constexpr size_t OFF_WU = OFF_WG + al((size_t)2 * NE * D * DE * 2);
constexpr size_t OFF_WD = OFF_WU + al((size_t)2 * NE * D * DE * 2);
constexpr size_t WS_END = OFF_WD + al((size_t)2 * NE * D * DE * 2);
static_assert(OFF_AG - OFF_HMID >= (size_t)HMID_ROWS * DE * 2, "HMID alias too small");
static_assert(WS_END < 530000000, "ws budget");

struct Params {
  const float *x, *c, *ctx, *c_ctx, *w_mod, *b_mod, *w_in, *q_gain, *k_gain, *w_pool, *pool_scale, *w_dw, *b_dw,
      *cv_ln_g, *cv_ln_b, *w_cv_pw, *w_out, *ln1_g, *ln1_b, *ln2_g, *ln2_b, *w_rg, *b_rg, *w_re, *b_re, *w_e_gate, *w_e_up, *w_e_down;
  float* out;
  char* ws;
};

__device__ __forceinline__ float bf2f(bf16_t v) { return __uint_as_float(((unsigned)v) << 16); }
__device__ __forceinline__ bf16_t f2bf(float f) {
  unsigned u = __float_as_uint(f);
  u += 0x7fffu + ((u >> 16) & 1u);
  return (bf16_t)(u >> 16);
}
template <int CTRL> __device__ __forceinline__ float dppf(float v) { return __int_as_float(__builtin_amdgcn_update_dpp(0, __float_as_int(v), CTRL, 0xf, 0xf, true)); }
__device__ __forceinline__ float wave_sum(float v) {
  v += dppf<0xB1>(v); v += dppf<0x4E>(v); v += dppf<0x141>(v); v += dppf<0x140>(v);
  { auto r = __builtin_amdgcn_permlane16_swap(__float_as_uint(v), __float_as_uint(v), false, false); v = __uint_as_float(r[0]) + __uint_as_float(r[1]); }
  { auto r = __builtin_amdgcn_permlane32_swap(__float_as_uint(v), __float_as_uint(v), false, false); v = __uint_as_float(r[0]) + __uint_as_float(r[1]); }
  return v;
}
__device__ __forceinline__ float silu(float v) { return v * __builtin_amdgcn_rcpf(1.f + __expf(-v)); }
__device__ __forceinline__ int opaque0() { int z; asm volatile("s_mov_b32 %0, 0" : "=s"(z)); return z; }
#define TIDX ((int)threadIdx.x + opaque0())
using bf16x8 = __attribute__((ext_vector_type(8))) short;
using s16x4 = __attribute__((ext_vector_type(4))) short;
using f32x16 = __attribute__((ext_vector_type(16))) float;
using f32x4 = __attribute__((ext_vector_type(4))) float;
using u32x4 = __attribute__((ext_vector_type(4))) unsigned;
using u32x2 = __attribute__((ext_vector_type(2))) unsigned;

__device__ __forceinline__ int crow(int r, int hi) { return (r & 3) + 8 * (r >> 2) + 4 * hi; }
typedef float f32x2 __attribute__((ext_vector_type(2)));
typedef __bf16 bf16x2v __attribute__((ext_vector_type(2)));
__device__ __forceinline__ unsigned cvtpk(float lo, float hi) {
  bf16x2v b = __builtin_convertvector((f32x2){lo, hi}, bf16x2v);
  return __builtin_bit_cast(unsigned, b);
}
__device__ __forceinline__ float sum32(float v) {
  auto rr = __builtin_amdgcn_permlane32_swap(__float_as_uint(v), __float_as_uint(v), false, false);
  return __uint_as_float(rr[0]) + __uint_as_float(rr[1]);
}

__device__ __forceinline__ void cvt_range(const float* __restrict__ src, bf16_t* __restrict__ dst, long n8, long gtid, long gthreads) {
  for (long i = gtid; i < n8; i += gthreads) {
    const f32x4 a = *(const f32x4*)(src + i * 8), b = *(const f32x4*)(src + i * 8 + 4);
    u32x4 w = {cvtpk(a[0], a[1]), cvtpk(a[2], a[3]), cvtpk(b[0], b[1]), cvtpk(b[2], b[3])};
    *(u32x4*)(dst + i * 8) = w;
  }
}

__device__ __forceinline__ int xoff(int row, int chunk) { return row * 128 + ((chunk ^ ((row >> 1) & 7)) << 4); }
__device__ __forceinline__ int wst(int k, int c) { const int kk = (k & ~0xC) | ((k & 4) << 1) | ((k & 8) >> 1); return ((kk >> 3) * 4 + (c >> 5)) * 512 + ((kk & 7) * 32 + (c & 31)) * 2; }
__device__ __forceinline__ int v_rd_base(int lane) { return ((lane & 3) << 3) | (((lane >> 2) & 3) << 6) | (((lane >> 4) & 1) << 5) | (((lane >> 5) & 1) << 8); }

__device__ __forceinline__ bf16x8 tr_frag(const LAS char* p) {
  s16x4 a = __builtin_amdgcn_ds_read_tr16_b64_v4i16((LAS s16x4*)p);
  s16x4 b = __builtin_amdgcn_ds_read_tr16_b64_v4i16((LAS s16x4*)(p + 2048));
  return (bf16x8){a[0], a[1], a[2], a[3], b[0], b[1], b[2], b[3]};
}

template <int OFF> __device__ __forceinline__ bf16x8 tr_frag_asm(int addr) {
  s16x4 a, b;
  asm volatile("ds_read_b64_tr_b16 %0, %1 offset:%2" : "=&v"(a) : "v"(addr), "i"(OFF) : "memory");
  asm volatile("ds_read_b64_tr_b16 %0, %1 offset:%2" : "=&v"(b) : "v"(addr), "i"(OFF + 2048) : "memory");
  return (bf16x8){a[0], a[1], a[2], a[3], b[0], b[1], b[2], b[3]};
}

template <int BM, int BN> struct GemmCfg {
  static constexpr int WM = BM / 64, WN = 8 / WM, NSLAB = BN / 128, XB = BM * 128, WB = NSLAB * 16384, STAGE = XB + WB, NXP = BM / 64, NWP = NSLAB * 2;
  static_assert(WM * WN == 8 && WN * 64 == BN, "tile");
};
constexpr int GEMM_LDS = 3 * (256 * 128 + 16384);

template <int BM, int BN, int NMAP, bool BG = false, class XRow, class WPtr, class Pre>
__device__ __forceinline__ void gemm_mainloop(LAS char* lds, f32x16 (&acc)[2][2], const XRow& xrow, const WPtr& wptr, const Pre& pre, int sprev, int ldw, int K, int& bgdone, int bgn = 0, long bgc0 = 0,
                                              const float* bs0 = nullptr, const float* bs1 = nullptr, const float* bs2 = nullptr, bf16_t* bd0 = nullptr, bf16_t* bd1 = nullptr, bf16_t* bd2 = nullptr) {
#define BG_ADDR(i, off, SP, DP) long c_ = bgc0 + (long)(i) * 512 + (off); const bool ok_ = c_ < (3L << 21); if (!ok_) c_ = 0; const int t_ = (int)(c_ >> 21); const long o_ = (c_ & 0x1fffff) * 8; \
    const float* SP = (t_ == 0 ? bs0 : (t_ == 1 ? bs1 : bs2)) + o_; bf16_t* DP = (t_ == 0 ? bd0 : (t_ == 1 ? bd1 : bd2)) + o_
#define BG_ISSUE(i, off, a, b) do { BG_ADDR(i, off, sp_, dp_); (void)dp_; a = *(const f32x4*)sp_; b = *(const f32x4*)(sp_ + 4); } while (0)
#define BG_RETIRE(i, off, a, b) do { BG_ADDR(i, off, sp_, dp_); (void)sp_; if (ok_) *(u32x4*)dp_ = (u32x4){cvtpk(a[0], a[1]), cvtpk(a[2], a[3]), cvtpk(b[0], b[1]), cvtpk(b[2], b[3])}; } while (0)
#define BGA_ISSUE(i, off, a, b) do { BG_ADDR(i, off, sp_, dp_); (void)dp_; \
    asm volatile("global_load_dwordx4 %0, %2, off\n\tglobal_load_dwordx4 %1, %2, off offset:16" : "=&v"(a), "=&v"(b) : "v"(sp_) : "memory"); } while (0)
#define BGA_RETIRE(i, off, a, b) do { BG_ADDR(i, off, sp_, dp_); (void)sp_; const u32x4 w_ = {cvtpk(a[0], a[1]), cvtpk(a[2], a[3]), cvtpk(b[0], b[1]), cvtpk(b[2], b[3])}; \
    if (ok_) asm volatile("global_store_dwordx4 %0, %1, off" :: "v"(dp_), "v"(w_) : "memory"); } while (0)
  using C = GemmCfg<BM, BN>;
  const int tid = TIDX, wid = __builtin_amdgcn_readfirstlane(tid >> 6), lane = tid & 63, r32 = lane & 31, hi = lane >> 5;
  const int wm = wid / C::WN, wn = wid % C::WN;
  const bf16_t *g0, *g1, *g2, *g3, *g4, *g5, *g6 = nullptr, *g7 = nullptr, *g8 = nullptr, *g9 = nullptr, *g10 = nullptr, *g11 = nullptr;
  int l0, l1, l2, l3, l4, l5, l6 = 0, l7 = 0, l8 = 0, l9 = 0, l10 = 0, l11 = 0;
  auto xpieceq = [&](int q, const bf16_t*& gp, int& lp) { const int row = 8 * q + (lane >> 3), c = (lane & 7) ^ ((row >> 1) & 7); gp = xrow(row) + c * 8; lp = q * 1024; };
  auto wpieceq = [&](int idx, const bf16_t*& gp, int& lp) {
    const int s = idx >> 4, q = idx & 15, sub = 2 * q + (lane >> 5), kk = (sub >> 2) * 8 + ((lane & 31) >> 2);
    const int k = (kk & ~0xC) | ((kk & 4) << 1) | ((kk & 8) >> 1), c = (sub & 3) * 32 + (lane & 3) * 8;
    gp = wptr(s) + (size_t)k * ldw + c; lp = C::XB + s * 16384 + q * 1024; };
  const size_t stepx = 64, stepw = (size_t)64 * ldw;
  if (BG) {
    const int w4 = wid & 3;
    xpieceq(w4 * 8 + 0, g0, l0); xpieceq(w4 * 8 + 1, g1, l1); xpieceq(w4 * 8 + 2, g2, l2); xpieceq(w4 * 8 + 3, g3, l3);
    xpieceq(w4 * 8 + 4, g4, l4); xpieceq(w4 * 8 + 5, g5, l5); xpieceq(w4 * 8 + 6, g6, l6); xpieceq(w4 * 8 + 7, g7, l7);
    wpieceq(w4 * 4 + 0, g8, l8); wpieceq(w4 * 4 + 1, g9, l9); wpieceq(w4 * 4 + 2, g10, l10); wpieceq(w4 * 4 + 3, g11, l11);
  } else if (C::NXP == 4) { xpieceq(wid * 4 + 0, g0, l0); xpieceq(wid * 4 + 1, g1, l1); xpieceq(wid * 4 + 2, g2, l2); xpieceq(wid * 4 + 3, g3, l3); wpieceq(wid * 2 + 0, g4, l4); wpieceq(wid * 2 + 1, g5, l5); }
  else { xpieceq(wid * 2 + 0, g0, l0); xpieceq(wid * 2 + 1, g1, l1); wpieceq(wid * 4 + 0, g2, l2); wpieceq(wid * 4 + 1, g3, l3); wpieceq(wid * 4 + 2, g4, l4); wpieceq(wid * 4 + 3, g5, l5); }
  const size_t stp0 = stepx, stp1 = stepx, stp2 = (BG || C::NXP == 4) ? stepx : stepw, stp3 = (BG || C::NXP == 4) ? stepx : stepw, stp4 = BG ? stepx : stepw, stp5 = BG ? stepx : stepw;
  const bool dmaw = !BG || wid < 4;
  int xr[2];
#pragma unroll
  for (int ti = 0; ti < 2; ++ti) xr[ti] = (wm * 64 + ti * 32 + r32) * 128;
  const int xsw = (r32 >> 1) & 7;
  int wr[2];
#pragma unroll
  for (int ni = 0; ni < 2; ++ni) {
    const int slab = NMAP == 0 ? 0 : (NMAP == 1 ? (wn >> 1) : ni);
    const int nb = NMAP == 0 ? (2 * wn + ni) : (NMAP == 1 ? ((wn & 1) * 2 + ni) : wn);
    wr[ni] = C::XB + slab * 16384 + nb * 512 + v_rd_base(lane);
  }
  const int nk = K / 64;
#define G_DMA1(gp, sp, lp, kt, _d) __builtin_amdgcn_global_load_lds((const unsigned*)((gp) + (size_t)(kt) * (sp)), (LAS unsigned*)((_d) + (lp)), 16, 0, 0)
#define G_DMA(kt, st) do { if (dmaw) { LAS char* _d = lds + (st) * C::STAGE; \
    G_DMA1(g0, stp0, l0, kt, _d); G_DMA1(g1, stp1, l1, kt, _d); G_DMA1(g2, stp2, l2, kt, _d); G_DMA1(g3, stp3, l3, kt, _d); G_DMA1(g4, stp4, l4, kt, _d); G_DMA1(g5, stp5, l5, kt, _d); \
    if (BG) { G_DMA1(g6, stepx, l6, kt, _d); G_DMA1(g7, stepx, l7, kt, _d); G_DMA1(g8, stepw, l8, kt, _d); G_DMA1(g9, stepw, l9, kt, _d); G_DMA1(g10, stepw, l10, kt, _d); G_DMA1(g11, stepw, l11, kt, _d); } } } while (0)
#define G_HALF(cur, wa0, wa1, H) do { bf16x8 xf[2][2], wf[2][2]; \
      _Pragma("unroll") for (int k2 = 0; k2 < 2; ++k2) _Pragma("unroll") for (int ti = 0; ti < 2; ++ti) xf[k2][ti] = *(const LAS bf16x8*)(cur + xr[ti] + ((((H * 2 + k2) * 2 + hi) ^ xsw) << 4)); \
      wf[0][0] = tr_frag_asm<(H * 2 + 0) * 4096>(wa0); wf[0][1] = tr_frag_asm<(H * 2 + 0) * 4096>(wa1); \
      wf[1][0] = tr_frag_asm<(H * 2 + 1) * 4096>(wa0); wf[1][1] = tr_frag_asm<(H * 2 + 1) * 4096>(wa1); \
      asm volatile("s_waitcnt lgkmcnt(0)" ::: "memory"); __builtin_amdgcn_sched_barrier(0); \
      _Pragma("unroll") for (int k2 = 0; k2 < 2; ++k2) _Pragma("unroll") for (int ti = 0; ti < 2; ++ti) _Pragma("unroll") for (int ni = 0; ni < 2; ++ni) \
        acc[ti][ni] = __builtin_amdgcn_mfma_f32_32x32x16_bf16(wf[k2][ni], xf[k2][ti], acc[ti][ni], 0, 0, 0); } while (0)
#define G_COMPUTE(st) do { const LAS char* cur = lds + (st) * C::STAGE; const int wa0 = (int)(uintptr_t)(cur + wr[0]), wa1 = (int)(uintptr_t)(cur + wr[1]); \
    G_HALF(cur, wa0, wa1, 0); G_HALF(cur, wa0, wa1, 1); } while (0)
  static_assert(C::NXP + C::NWP == 6 && (!BG || (C::NXP == 4 && C::NWP == 2)), "piece counts assumed by the vmcnt waits");
  G_DMA(0, 0); G_DMA(1, 1);
  pre();
#pragma unroll
  for (int a_ = 0; a_ < 2; ++a_)
#pragma unroll
    for (int b_ = 0; b_ < 2; ++b_) acc[a_][b_] = (f32x16){};
  f32x4 b0a, b0b, b0c, b0d, b1a, b1b, b1c, b1d, b2a, b2b, b2c, b2d; int bi0 = -1, bi1 = -1, bi2 = -1;
  const int bgoff = tid - 256;
#define BG_SLOT(bi, xa, xb, xc, xd) do { if (bi >= 0) { asm volatile("s_waitcnt vmcnt(8)" ::: "memory");     \
      BGA_RETIRE(bi, bgoff, xa, xb); BGA_RETIRE(bi, bgoff + 256, xc, xd); bi = -1; } \
    if (bgdone < bgn) { bi = bgdone; BGA_ISSUE(bi, bgoff, xa, xb); BGA_ISSUE(bi, bgoff + 256, xc, xd); } } while (0)
#define G_STEP(kt, ST, bi, xa, xb, xc, xd) do { \
    if (dmaw) { if ((kt) + 1 < nk) { if (BG) asm volatile("s_waitcnt vmcnt(12)" ::: "memory"); \
                                     else if ((kt) < 2 && sprev >= 16) asm volatile("s_waitcnt vmcnt(22)" ::: "memory"); \
                                     else if ((kt) < 2 && sprev >= 8) asm volatile("s_waitcnt vmcnt(14)" ::: "memory"); \
                                     else asm volatile("s_waitcnt vmcnt(6)" ::: "memory"); } \
                else asm volatile("s_waitcnt vmcnt(0)" ::: "memory"); } \
    asm volatile("s_waitcnt lgkmcnt(0)" ::: "memory"); __builtin_amdgcn_s_barrier(); \
    if ((kt) + 2 < nk) G_DMA((kt) + 2, ((ST) + 2) % 3); \
    if (BG && !dmaw) BG_SLOT(bi, xa, xb, xc, xd); \
    if (BG && bgdone < bgn) ++bgdone; \
    G_COMPUTE(ST); } while (0)
  for (int kt = 0; kt < nk; kt += 3) {
    G_STEP(kt, 0, bi0, b0a, b0b, b0c, b0d);
    if (kt + 1 < nk) G_STEP(kt + 1, 1, bi1, b1a, b1b, b1c, b1d);
    if (kt + 2 < nk) G_STEP(kt + 2, 2, bi2, b2a, b2b, b2c, b2d);
  }
  if (BG && !dmaw) {
    asm volatile("s_waitcnt vmcnt(0)" ::: "memory");
    if (bi0 >= 0) { BGA_RETIRE(bi0, bgoff, b0a, b0b); BGA_RETIRE(bi0, bgoff + 256, b0c, b0d); }
    if (bi1 >= 0) { BGA_RETIRE(bi1, bgoff, b1a, b1b); BGA_RETIRE(bi1, bgoff + 256, b1c, b1d); }
    if (bi2 >= 0) { BGA_RETIRE(bi2, bgoff, b2a, b2b); BGA_RETIRE(bi2, bgoff + 256, b2c, b2d); }
    asm volatile("s_waitcnt vmcnt(0)" ::: "memory");
  }
#undef G_STEP
#undef BG_SLOT
  asm volatile("s_waitcnt lgkmcnt(0)" ::: "memory"); __builtin_amdgcn_s_barrier();
#undef G_DMA
#undef G_DMA1
#undef G_COMPUTE
#undef G_HALF
}


struct UnitD { int a, b, c, d, lv0, lv1; };
template <int BM, int BN, int NMAP, bool BG = false, class Dec, class XRow, class WPtr, class Epi>
__device__ __forceinline__ void gemm_stream(LAS char* lds, const char* wsb, int ldw, int K, const Dec& dec, const XRow& xrow, const WPtr& wptr, const Epi& epi,
                                            int* bgdone_p = nullptr, int bgn = 0, long bgc0 = 0, const float* bs0 = nullptr, const float* bs1 = nullptr, const float* bs2 = nullptr,
                                            bf16_t* bd0 = nullptr, bf16_t* bd1 = nullptr, bf16_t* bd2 = nullptr) {
  using C = GemmCfg<BM, BN>;
  const int tid = TIDX, wid = __builtin_amdgcn_readfirstlane(tid >> 6), lane = tid & 63, r32 = lane & 31, hi = lane >> 5;
  const int wm = wid / C::WN, wn = wid % C::WN;
  static_assert(C::NXP + C::NWP == 6 && (!BG || (C::NXP == 4 && C::NWP == 2)), "piece counts assumed by the vmcnt waits");
  auto xptr = [&](const UnitD& u, int q) { const int row = 8 * q + (lane >> 3), c = (lane & 7) ^ ((row >> 1) & 7); return (unsigned)(xrow(u, row) + c * 16); };
  auto wptr2 = [&](const UnitD& u, int idx) {
    const int s = idx >> 4, q = idx & 15, sub = 2 * q + (lane >> 5), kk = (sub >> 2) * 8 + ((lane & 31) >> 2);
    const int k = (kk & ~0xC) | ((kk & 4) << 1) | ((kk & 8) >> 1), c = (sub & 3) * 32 + (lane & 3) * 8;
    return (unsigned)(wptr(u, s) + (unsigned)(k * ldw + c) * 2u); };
  auto wlds = [&](int idx) { return C::XB + (idx >> 4) * 16384 + (idx & 15) * 1024; };
  const int w4 = wid & 3;
  const bool dmaw = !BG || wid < 4;
  const int l0 = BG ? (w4 * 8 + 0) * 1024 : (wid * C::NXP + 0) * 1024, l1 = BG ? (w4 * 8 + 1) * 1024 : (wid * C::NXP + 1) * 1024;
  const int l2 = BG ? (w4 * 8 + 2) * 1024 : (C::NXP == 4 ? (wid * 4 + 2) * 1024 : wlds(wid * 4 + 0)), l3 = BG ? (w4 * 8 + 3) * 1024 : (C::NXP == 4 ? (wid * 4 + 3) * 1024 : wlds(wid * 4 + 1));
  const int l4 = BG ? (w4 * 8 + 4) * 1024 : (C::NXP == 4 ? wlds(wid * 2 + 0) : wlds(wid * 4 + 2)), l5 = BG ? (w4 * 8 + 5) * 1024 : (C::NXP == 4 ? wlds(wid * 2 + 1) : wlds(wid * 4 + 3));
  const int l6 = (w4 * 8 + 6) * 1024, l7 = (w4 * 8 + 7) * 1024, l8 = wlds(w4 * 4 + 0), l9 = wlds(w4 * 4 + 1), l10 = wlds(w4 * 4 + 2), l11 = wlds(w4 * 4 + 3);
  const unsigned stepx = 128, stepw = 128u * (unsigned)ldw;
  const unsigned stp0 = stepx, stp1 = stepx, stp2 = (BG || C::NXP == 4) ? stepx : stepw, stp3 = (BG || C::NXP == 4) ? stepx : stepw, stp4 = BG ? stepx : stepw, stp5 = BG ? stepx : stepw;
#define S_SETUP(u, P) do { \
    if (BG) { if (dmaw) { P##0 = xptr(u, w4 * 8 + 0); P##1 = xptr(u, w4 * 8 + 1); P##2 = xptr(u, w4 * 8 + 2); P##3 = xptr(u, w4 * 8 + 3); P##4 = xptr(u, w4 * 8 + 4); P##5 = xptr(u, w4 * 8 + 5); \
                          P##6 = xptr(u, w4 * 8 + 6); P##7 = xptr(u, w4 * 8 + 7); P##8 = wptr2(u, w4 * 4 + 0); P##9 = wptr2(u, w4 * 4 + 1); P##10 = wptr2(u, w4 * 4 + 2); P##11 = wptr2(u, w4 * 4 + 3); } } \
    else { P##0 = xptr(u, wid * C::NXP + 0); P##1 = xptr(u, wid * C::NXP + 1); \
      if (C::NXP == 4) { P##2 = xptr(u, wid * 4 + 2); P##3 = xptr(u, wid * 4 + 3); P##4 = wptr2(u, wid * 2 + 0); P##5 = wptr2(u, wid * 2 + 1); } \
      else { P##2 = wptr2(u, wid * 4 + 0); P##3 = wptr2(u, wid * 4 + 1); P##4 = wptr2(u, wid * 4 + 2); P##5 = wptr2(u, wid * 4 + 3); } } } while (0)
#define S_DMA1(gp, sp, lp, kt, _d) __builtin_amdgcn_global_load_lds((const unsigned*)(wsb + (size_t)((gp) + (unsigned)(kt) * (sp))), (LAS unsigned*)((_d) + (lp)), 16, 0, 0)
#define S_DMA(P, kt, stg) do { if (dmaw) { LAS char* _d = lds + (stg) * C::STAGE; S_DMA1(P##0, stp0, l0, kt, _d); S_DMA1(P##1, stp1, l1, kt, _d); S_DMA1(P##2, stp2, l2, kt, _d); \
    S_DMA1(P##3, stp3, l3, kt, _d); S_DMA1(P##4, stp4, l4, kt, _d); S_DMA1(P##5, stp5, l5, kt, _d); \
    if (BG) { S_DMA1(P##6, stepx, l6, kt, _d); S_DMA1(P##7, stepx, l7, kt, _d); S_DMA1(P##8, stepw, l8, kt, _d); S_DMA1(P##9, stepw, l9, kt, _d); S_DMA1(P##10, stepw, l10, kt, _d); \
              S_DMA1(P##11, stepw, l11, kt, _d); } } } while (0)
  int xr[2];
#pragma unroll
  for (int ti = 0; ti < 2; ++ti) xr[ti] = (wm * 64 + ti * 32 + r32) * 128;
  const int xsw = (r32 >> 1) & 7;
  int wr[2];
#pragma unroll
  for (int ni = 0; ni < 2; ++ni) {
    const int slab = NMAP == 0 ? 0 : (NMAP == 1 ? (wn >> 1) : ni);
    const int nb = NMAP == 0 ? (2 * wn + ni) : (NMAP == 1 ? ((wn & 1) * 2 + ni) : wn);
    wr[ni] = C::XB + slab * 16384 + nb * 512 + v_rd_base(lane);
  }
  const int nk = K / 64;
#define S_MF(k2, ti, ni) acc[ti][ni] = __builtin_amdgcn_mfma_f32_32x32x16_bf16(wf[k2][ni], xf[k2][ti], acc[ti][ni], 0, 0, 0)
#define S_HALF(cur, wa0, wa1, H, PA, PB, PC) do { bf16x8 xf[2][2], wf[2][2]; \
      _Pragma("unroll") for (int k2 = 0; k2 < 2; ++k2) _Pragma("unroll") for (int ti = 0; ti < 2; ++ti) xf[k2][ti] = *(const LAS bf16x8*)(cur + xr[ti] + ((((H * 2 + k2) * 2 + hi) ^ xsw) << 4)); \
      wf[0][0] = tr_frag_asm<(H * 2 + 0) * 4096>(wa0); wf[0][1] = tr_frag_asm<(H * 2 + 0) * 4096>(wa1); \
      wf[1][0] = tr_frag_asm<(H * 2 + 1) * 4096>(wa0); wf[1][1] = tr_frag_asm<(H * 2 + 1) * 4096>(wa1); \
      asm volatile("s_waitcnt lgkmcnt(0)" ::: "memory"); __builtin_amdgcn_sched_barrier(0); \
      S_MF(0, 0, 0); S_MF(0, 0, 1); S_MF(0, 1, 0); __builtin_amdgcn_sched_barrier(0); PA; __builtin_amdgcn_sched_barrier(0); \
      S_MF(0, 1, 1); S_MF(1, 0, 0); S_MF(1, 0, 1); __builtin_amdgcn_sched_barrier(0); PB; __builtin_amdgcn_sched_barrier(0); \
      S_MF(1, 1, 0); S_MF(1, 1, 1); __builtin_amdgcn_sched_barrier(0); PC; __builtin_amdgcn_sched_barrier(0); } while (0)
  UnitD cu, nu;
  if (!dec(0, cu)) return;
  asm volatile("s_waitcnt vmcnt(0)" : "+v"(cu.lv0), "+v"(cu.lv1) :: "memory");
  unsigned g0 = 0, g1 = 0, g2 = 0, g3 = 0, g4 = 0, g5 = 0, g6 = 0, g7 = 0, g8 = 0, g9 = 0, g10 = 0, g11 = 0;
  S_SETUP(cu, g);
  int st = 0;
  S_DMA(g, 0, 0); S_DMA(g, 1, 1);
  int sprev = 0;
  f32x16 acc[2][2];
  f32x4 b0a, b0b, b0c, b0d, b1a, b1b, b1c, b1d, b2a, b2b, b2c, b2d; int bi0 = -1, bi1 = -1, bi2 = -1, j3 = 0;
  int bgdone = BG ? *bgdone_p : 0;
  const int bgoff = tid - 256;
#define S_BGSLOT(bi, xa, xb, xc, xd) do { if (bi >= 0) { \
      if (kt < 3 && sprev >= 16) asm volatile("s_waitcnt vmcnt(24)" ::: "memory");     \
      else asm volatile("s_waitcnt vmcnt(8)" ::: "memory"); \
      BGA_RETIRE(bi, bgoff, xa, xb); BGA_RETIRE(bi, bgoff + 256, xc, xd); bi = -1; } \
    if (bgdone < bgn) { bi = bgdone; BGA_ISSUE(bi, bgoff, xa, xb); BGA_ISSUE(bi, bgoff + 256, xc, xd); } } while (0)
  for (int it = 0;; ++it) {
    const bool okn = dec(it + 1, nu);
#pragma unroll
    for (int a_ = 0; a_ < 2; ++a_)
#pragma unroll
      for (int b_ = 0; b_ < 2; ++b_) acc[a_][b_] = (f32x16){};
    for (int kt = 0; kt < nk; ++kt) {
      if (dmaw) {
        if (kt + 1 < nk || okn) {
          const int extra = kt < 2 ? sprev : 0;
          if (BG) { if (extra >= 16) asm volatile("s_waitcnt vmcnt(28)" ::: "memory"); else asm volatile("s_waitcnt vmcnt(12)" ::: "memory"); }
          else if (extra >= 16) asm volatile("s_waitcnt vmcnt(22)" ::: "memory");
          else if (extra >= 8) asm volatile("s_waitcnt vmcnt(14)" ::: "memory");
          else if (extra >= 4) asm volatile("s_waitcnt vmcnt(10)" ::: "memory");
          else asm volatile("s_waitcnt vmcnt(6)" ::: "memory");
        } else asm volatile("s_waitcnt vmcnt(0)" ::: "memory");
      }
      asm volatile("s_waitcnt lgkmcnt(0)" ::: "memory"); __builtin_amdgcn_s_barrier();
      const int st2 = st == 0 ? 2 : st - 1;
      bool di = false; int tix = 0;
      if (kt + 2 < nk) { di = true; tix = kt + 2; }
      else if (okn) {
        if (kt + 2 == nk) { asm volatile("" : "+v"(nu.lv0), "+v"(nu.lv1) :: "memory"); S_SETUP(nu, g); }
        di = true; tix = kt + 2 - nk;
      }
      LAS char* dd = lds + st2 * C::STAGE;
      if (BG) { if (di) S_DMA(g, tix, st2); di = false; }
      if (BG && !dmaw) { if (j3 == 0) S_BGSLOT(bi0, b0a, b0b, b0c, b0d); else if (j3 == 1) S_BGSLOT(bi1, b1a, b1b, b1c, b1d); else S_BGSLOT(bi2, b2a, b2b, b2c, b2d); }
      if (BG) { if (bgdone < bgn) ++bgdone; j3 = j3 == 2 ? 0 : j3 + 1; }
      { const LAS char* cur = lds + st * C::STAGE; const int wa0 = (int)(uintptr_t)(cur + wr[0]), wa1 = (int)(uintptr_t)(cur + wr[1]);
        S_HALF(cur, wa0, wa1, 0, if (di) S_DMA1(g0, stp0, l0, tix, dd), if (di) S_DMA1(g1, stp1, l1, tix, dd), if (di) S_DMA1(g2, stp2, l2, tix, dd));
        S_HALF(cur, wa0, wa1, 1, if (di) S_DMA1(g3, stp3, l3, tix, dd), if (di) S_DMA1(g4, stp4, l4, tix, dd), if (di) S_DMA1(g5, stp5, l5, tix, dd)); }
      st = st == 2 ? 0 : st + 1;
    }
    if (BG && !dmaw) {
      asm volatile("s_waitcnt vmcnt(0)" ::: "memory");
      if (bi0 >= 0) { BGA_RETIRE(bi0, bgoff, b0a, b0b); BGA_RETIRE(bi0, bgoff + 256, b0c, b0d); bi0 = -1; }
      if (bi1 >= 0) { BGA_RETIRE(bi1, bgoff, b1a, b1b); BGA_RETIRE(bi1, bgoff + 256, b1c, b1d); bi1 = -1; }
      if (bi2 >= 0) { BGA_RETIRE(bi2, bgoff, b2a, b2b); BGA_RETIRE(bi2, bgoff + 256, b2c, b2d); bi2 = -1; }
    }
    sprev = epi(cu, acc);
    if (!okn) break;
    cu = nu;
  }
  if (BG) *bgdone_p = bgdone;
#undef S_BGSLOT
#undef S_HALF
#undef S_MF
#undef S_DMA
#undef S_DMA1
#undef S_SETUP
}

__device__ __forceinline__ unsigned pack4_fp8(const f32x16& a, int g) {
  int w = __builtin_amdgcn_cvt_pk_fp8_f32(a[4 * g], a[4 * g + 1], 0, false);
  w = __builtin_amdgcn_cvt_pk_fp8_f32(a[4 * g + 2], a[4 * g + 3], w, true);
  return (unsigned)w;
}
__device__ __forceinline__ u32x2 pack4(const f32x16& a, int g) { return (u32x2){cvtpk(a[4 * g], a[4 * g + 1]), cvtpk(a[4 * g + 2], a[4 * g + 3])}; }
__device__ __forceinline__ u32x4 pack8(const f32x16& a, int gp) {
  const u32x2 d0 = pack4(a, 2 * gp), d1 = pack4(a, 2 * gp + 1);
  const auto r0 = __builtin_amdgcn_permlane32_swap(d0[0], d1[0], false, false), r1 = __builtin_amdgcn_permlane32_swap(d0[1], d1[1], false, false);
  return (u32x4){r0[0], r1[0], r0[1], r1[1]};
}
__device__ __forceinline__ u32x2 pack8_fp8(const f32x16& a, int gp) {
  const auto r = __builtin_amdgcn_permlane32_swap(pack4_fp8(a, 2 * gp), pack4_fp8(a, 2 * gp + 1), false, false);
  return (u32x2){r[0], r[1]};
}

__device__ __forceinline__ void phase_a1(const Params& p, int layer, LAS char* lds, int bid, int nblk) {
  const bf16_t* H = (const bf16_t*)(p.ws + OFF_H);
  const bf16_t* W = (const bf16_t*)(p.ws + OFF_WIN) + (size_t)layer * D * INW;
  bf16_t* Q = (bf16_t*)(p.ws + OFF_Q); bf16_t* Kb = (bf16_t*)(p.ws + OFF_K); bf16_t* Vb = (bf16_t*)(p.ws + OFF_V);
  float* U = (float*)(p.ws + OFF_U); bf16_t* AG = (bf16_t*)(p.ws + OFF_AG);
  unsigned char* Q8 = (unsigned char*)(p.ws + OFF_Q8); unsigned char* K8 = (unsigned char*)(p.ws + OFF_K8); unsigned char* VT8 = (unsigned char*)(p.ws + OFF_VT8);
  const float* rt = (const float*)(p.ws + OFF_ROPE);
  const int lane = TIDX & 63, wid = TIDX >> 6, r32 = lane & 31, hi = lane >> 5, wm = wid >> 1, wn = wid & 1;
  const int nlat = 64 * 12, nctx = layer == 0 ? 12 : 2, nunits = nlat + nctx;
  const bool xmap = (nblk & 7) == 0;
  const int xcd = bid & 7, lb = bid >> 3, nlb = nblk >> 3, nl = lb < 96 ? (96 - lb + nlb - 1) / nlb : 0;
  const unsigned oH = (unsigned)OFF_H, oW = (unsigned)(OFF_WIN + (size_t)layer * D * INW * 2);
  gemm_stream<256, 128, 0>(lds, p.ws, INW, D,
    [&](int it, UnitD& u) {
      int rtile, ct;
      if (xmap) {
        if (it < nl) { const int v = lb + it * nlb; rtile = 1 + xcd + 8 * (v / 12); ct = v % 12; }
        else { const int e2 = bid + (it - nl) * nblk; if (e2 >= nctx) return false; rtile = 0; ct = layer == 0 ? e2 : 4 + e2; }
      } else {
        const int un = bid + it * nblk; if (un >= nunits) return false;
        if (un < nlat) { rtile = 1 + un / 12; ct = un % 12; } else { rtile = 0; ct = layer == 0 ? (un - nlat) : (4 + un - nlat); }
      }
      u.a = rtile * 256; u.b = ct * 128; u.c = rtile; u.d = ct; u.lv0 = 0; u.lv1 = 0; return true; },
    [&](const UnitD& u, int row) { return oH + (unsigned)(u.a + row) * (D * 2); },
    [&](const UnitD& u, int) { return oW + (unsigned)u.b * 2; },
    [&](const UnitD& u, f32x16 (&acc)[2][2]) {
    const int m0 = u.a, rtile = u.c, ct = u.d;
    const int lane = TIDX & 63, wid = TIDX >> 6, r32 = lane & 31, hi = lane >> 5, wm = wid >> 1, wn = wid & 1;
#pragma unroll
    for (int ti = 0; ti < 2; ++ti) {
      const int tok = m0 + wm * 64 + ti * 32 + r32;
      if (ct < 5) {
        float ss = 0.f;
#pragma unroll
        for (int ni = 0; ni < 2; ++ni)
#pragma unroll
          for (int r = 0; r < 16; ++r) ss += acc[ti][ni][r] * acc[ti][ni][r];
        ss = sum32(ss);
        const float rs = rsqrtf(ss * (1.f / 64.f) + EPS);
        const float* gain = (ct < 4 ? p.q_gain : p.k_gain) + layer * 64;
        const float osc = ct < 4 ? 0.125f * 1.4426950408889634f : 1.f;
        const bool lat = rtile > 0;
        const int t = tok - NCTX;
#pragma unroll
        for (int ni = 0; ni < 2; ++ni) {
          f32x16 v;
#pragma unroll
          for (int r = 0; r < 16; ++r) v[r] = acc[ti][ni][r] * rs * gain[ni * 32 + crow(r, hi)];
          if (lat) {
            const int pos = ni == 0 ? (t >> 6) : (t & 63);
#pragma unroll
            for (int r = 0; r < 8; ++r) {
              const int f = crow(r, hi);
              const float cs = rt[(pos * 16 + f) * 2], sn = rt[(pos * 16 + f) * 2 + 1];
              const float t1 = v[r], t2 = v[r + 8];
              v[r] = t1 * cs - t2 * sn; v[r + 8] = t2 * cs + t1 * sn;
            }
          }
#pragma unroll
          for (int r = 0; r < 16; ++r) v[r] *= osc;
          bf16_t* dst = ct < 4 ? Q + (size_t)tok * 512 + (ct * 2 + wn) * 64 + ni * 32 : Kb + (size_t)tok * 128 + wn * 64 + ni * 32;
          unsigned char* dst8 = ct < 4 ? Q8 + (size_t)tok * 512 + (ct * 2 + wn) * 64 + ni * 32 : K8 + (size_t)tok * 128 + wn * 64 + ni * 32;
#pragma unroll
          for (int gp = 0; gp < 2; ++gp) { *(u32x4*)(dst + 16 * gp + 8 * hi) = pack8(v, gp); *(u32x2*)(dst8 + 16 * gp + 8 * hi) = pack8_fp8(v, gp); }
        }
      } else if (ct == 5) {
#pragma unroll
        for (int ni = 0; ni < 2; ++ni) {
#pragma unroll
          for (int gp = 0; gp < 2; ++gp) *(u32x4*)(Vb + (size_t)tok * 128 + wn * 64 + ni * 32 + 16 * gp + 8 * hi) = pack8(acc[ti][ni], gp);
          float vmx = 0.f;
#pragma unroll
          for (int r = 0; r < 16; ++r) {
            const float vv = acc[ti][ni][r]; vmx = fmaxf(vmx, fabsf(vv));
            VT8[(size_t)(wn * 64 + ni * 32 + crow(r, hi)) * TT + tok] = (unsigned char)(__builtin_amdgcn_cvt_pk_fp8_f32(vv, vv, 0, false) & 0xff);
          }
          if (!(vmx <= 400.f)) atomicOr((int*)(p.ws + OFF_FLAG) + 1, 1);
        }
      } else if (ct < 8) {
#pragma unroll
        for (int ni = 0; ni < 2; ++ni)
#pragma unroll
          for (int g = 0; g < 4; ++g)
            *(f32x4*)(U + (size_t)tok * 256 + (ct - 6) * 128 + wn * 64 + ni * 32 + 8 * g + 4 * hi) =
                (f32x4){acc[ti][ni][4 * g], acc[ti][ni][4 * g + 1], acc[ti][ni][4 * g + 2], acc[ti][ni][4 * g + 3]};
      } else {
#pragma unroll
        for (int ni = 0; ni < 2; ++ni)
#pragma unroll
          for (int gp = 0; gp < 2; ++gp) *(u32x4*)(AG + (size_t)tok * 512 + (ct - 8) * 128 + wn * 64 + ni * 32 + 16 * gp + 8 * hi) = pack8(acc[ti][ni], gp);
      }
    }
    return 8; });
}

__device__ __forceinline__ void phase_c1(const Params& p, int layer, LAS char* lds, int bid, int nblk) {
  const bf16_t* A = (const bf16_t*)(p.ws + OFF_MIX);
  const bf16_t* W = (const bf16_t*)(p.ws + OFF_WOUT) + (size_t)layer * D * D;
  bf16_t* Y = (bf16_t*)(p.ws + OFF_Y);
  const int lane = TIDX & 63, wid = TIDX >> 6, r32 = lane & 31, hi = lane >> 5, wm = wid >> 1, wn = wid & 1;
  const int nctx = layer == 0 ? 8 : 0;
  const bool xmap = (nblk & 7) == 0;
  const int xcd = bid & 7, lb = bid >> 3, nlb = nblk >> 3, nl = lb < 64 ? (64 - lb + nlb - 1) / nlb : 0;
  const unsigned oA = (unsigned)OFF_MIX, oW = (unsigned)(OFF_WOUT + (size_t)layer * D * D * 2);
  gemm_stream<256, 128, 0>(lds, p.ws, D, D,
    [&](int it, UnitD& u) {
      int rtile, ct;
      if (xmap) {
        if (it < nl) { const int v = lb + it * nlb; rtile = 1 + xcd + 8 * (v >> 3); ct = v & 7; }
        else { const int e2 = bid + (it - nl) * nblk; if (e2 >= nctx) return false; rtile = 0; ct = e2; }
      } else {
        const int un = bid + it * nblk; if (un >= 64 * 8 + nctx) return false;
        if (un < 512) { rtile = 1 + (un >> 3); ct = un & 7; } else { rtile = 0; ct = un - 512; }
      }
      u.a = rtile * 256; u.b = ct * 128; u.c = 0; u.d = 0; u.lv0 = 0; u.lv1 = 0; return true; },
    [&](const UnitD& u, int row) { return oA + (unsigned)(u.a + row) * (D * 2); },
    [&](const UnitD& u, int) { return oW + (unsigned)u.b * 2; },
    [&](const UnitD& u, f32x16 (&acc)[2][2]) {
#pragma unroll
      for (int ti = 0; ti < 2; ++ti) {
        const int tok = u.a + wm * 64 + ti * 32 + r32;
#pragma unroll
        for (int ni = 0; ni < 2; ++ni)
#pragma unroll
          for (int gp = 0; gp < 2; ++gp) *(u32x4*)(Y + (size_t)tok * D + u.b + wn * 64 + ni * 32 + 16 * gp + 8 * hi) = pack8(acc[ti][ni], gp);
      }
      return 8; });
}

#ifndef MOE_XCD_MAP
#define MOE_XCD_MAP 0
#endif
__device__ __forceinline__ void moe_prefix(const int* cnt, LAS int* pre, int xcd) {
  if (TIDX == 0) {
    int o = 0; for (int e = 0; e < NE; ++e) { pre[e] = o; o += (cnt[e * CNT_STRIDE] + 127) >> 7; } pre[NE] = o;
    int l = 0; for (int j = 0; j < 4; ++j) { pre[40 + j] = l; l += (cnt[(xcd + 8 * j) * CNT_STRIDE] + 127) >> 7; } pre[44] = l;
  }
  { int tt = (int)threadIdx.x; asm volatile("" : "+v"(tt));
    if (tt >= 64 && tt < 64 + NE) pre[48 + tt - 64] = cnt[(tt - 64) * CNT_STRIDE]; }
  __syncthreads();
}
__device__ __forceinline__ bool moe_unit(const LAS int* pre, int bid, int nblk, int it, int& e, int& rt, int& ct, int& g) {
  if (MOE_XCD_MAP && (nblk & 7) == 0) {
    const int xcd = bid & 7, v = (bid >> 3) + it * (nblk >> 3), gl = v >> 2;
    if (gl >= pre[44]) return false;
    int j = 0; if (gl >= pre[41]) j = 1; if (gl >= pre[42]) j = 2; if (gl >= pre[43]) j = 3;
    e = xcd + 8 * j; rt = gl - pre[40 + j]; ct = v & 3; g = pre[e] + rt; return true;
  } else {
    const int u = bid + it * nblk; g = u >> 2; if (g >= pre[NE]) return false;
    int ee = 0; for (int i = 1; i < NE; ++i) ee += (pre[i] <= g) ? 1 : 0;
    e = ee; rt = g - pre[ee]; ct = u & 3; return true;
  }
}

__device__ __forceinline__ void phase_d1(const Params& p, int layer, LAS char* lds, int bid, int nblk) {
  const int* cnt = (const int*)(p.ws + OFF_CNT) + layer * NE * CNT_STRIDE;
  const bf16_t* H2 = (const bf16_t*)(p.ws + OFF_MIX);
  bf16_t* HM = (bf16_t*)(p.ws + OFF_HMID);
  LAS int* pre = (LAS int*)(lds + GEMM_LDS);
  moe_prefix(cnt, pre, bid & 7);
  const int lane = TIDX & 63, wid = TIDX >> 6, r32 = lane & 31, hi = lane >> 5, wm = wid >> 2, wn = wid & 3;
  const int grow = 16 * wid + (lane >> 3);
  const bf16_t* WG = (const bf16_t*)(p.ws + OFF_WG) + (size_t)layer * NE * D * DE; const bf16_t* WU = (const bf16_t*)(p.ws + OFF_WU) + (size_t)layer * NE * D * DE;
  const unsigned oH2 = (unsigned)OFF_MIX, oWG = (unsigned)(OFF_WG + (size_t)layer * NE * D * DE * 2), oWU = (unsigned)(OFF_WU + (size_t)layer * NE * D * DE * 2);
  gemm_stream<128, 256, 2>(lds, p.ws, DE, D,
    [&](int it, UnitD& u) {
      int e, rt, ct, g; if (!moe_unit(pre, bid, nblk, it, e, rt, ct, g)) return false;
      const int* list = (const int*)(p.ws + OFF_LIST) + (size_t)e * CAPL + rt * 128 + grow;
      u.a = e; u.b = ct; u.c = g; u.d = pre[48 + e] - rt * 128;
      asm volatile("global_load_dword %0, %2, off\n\tglobal_load_dword %1, %2, off offset:32" : "=&v"(u.lv0), "=&v"(u.lv1) : "v"(list) : "memory");
      return true; },
    [&](const UnitD& u, int row) { const int lv = (row & 8) ? u.lv1 : u.lv0; const int tok = row < u.d ? (lv >> 1) : 0; return oH2 + (unsigned)tok * (D * 2); },
    [&](const UnitD& u, int s) { return (s == 0 ? oWG : oWU) + (unsigned)u.a * (D * DE * 2) + (unsigned)u.b * 256; },
    [&](const UnitD& u, f32x16 (&acc)[2][2]) {
#pragma unroll
      for (int ti = 0; ti < 2; ++ti) {
        const size_t row = (size_t)u.c * 128 + wm * 64 + ti * 32 + r32;
        f32x16 a;
#pragma unroll
        for (int r = 0; r < 16; ++r) { const float gv = acc[ti][0][r]; a[r] = gv * __builtin_amdgcn_rcpf(1.f + __expf(-gv)) * acc[ti][1][r]; }
#pragma unroll
        for (int gp = 0; gp < 2; ++gp) *(u32x4*)(HM + row * DE + u.b * 128 + wn * 32 + 16 * gp + 8 * hi) = pack8(a, gp);
      }
      return 4; });
}

__device__ __forceinline__ void phase_d2(const Params& p, int layer, LAS char* lds, int bid, int nblk) {
  const int* cnt = (const int*)(p.ws + OFF_CNT) + layer * NE * CNT_STRIDE;
  const bf16_t* HM = (const bf16_t*)(p.ws + OFF_HMID);
  bf16_t* OM = (bf16_t*)(p.ws + OFF_OMOE);
  LAS int* pre = (LAS int*)(lds + GEMM_LDS);
  moe_prefix(cnt, pre, bid & 7);
  const int lane = TIDX & 63, wid = TIDX >> 6, r32 = lane & 31, hi = lane >> 5, wm = wid >> 2, wn = wid & 3;
  const int row0 = wm * 64 + r32;
  const bf16_t* WD = (const bf16_t*)(p.ws + OFF_WD) + (size_t)layer * NE * DE * D;
  const unsigned oHM = (unsigned)OFF_HMID, oWD = (unsigned)(OFF_WD + (size_t)layer * NE * DE * D * 2);
  gemm_stream<128, 256, 1>(lds, p.ws, D, DE,
    [&](int it, UnitD& u) {
      int e, rt, ct, g; if (!moe_unit(pre, bid, nblk, it, e, rt, ct, g)) return false;
      const int* list = (const int*)(p.ws + OFF_LIST) + (size_t)e * CAPL + rt * 128 + row0;
      u.a = e; u.b = ct; u.c = g; u.d = pre[48 + e] - rt * 128;
      asm volatile("global_load_dword %0, %2, off\n\tglobal_load_dword %1, %2, off offset:128" : "=&v"(u.lv0), "=&v"(u.lv1) : "v"(list) : "memory");
      return true; },
    [&](const UnitD& u, int row) { return oHM + (unsigned)(u.c * 128 + row) * (DE * 2); },
    [&](const UnitD& u, int s) { return oWD + (unsigned)u.a * (DE * D * 2) + (unsigned)(u.b * 256 + s * 128) * 2; },
    [&](const UnitD& u, f32x16 (&acc)[2][2]) {
#pragma unroll
      for (int ti = 0; ti < 2; ++ti) {
        const int ts = ti == 0 ? u.lv0 : u.lv1;
        u32x4 w8[2][2];
#pragma unroll
        for (int ni = 0; ni < 2; ++ni)
#pragma unroll
          for (int gp = 0; gp < 2; ++gp) w8[ni][gp] = pack8(acc[ti][ni], gp);
        if (row0 + ti * 32 < u.d) {
#pragma unroll
          for (int ni = 0; ni < 2; ++ni)
#pragma unroll
            for (int gp = 0; gp < 2; ++gp) *(u32x4*)(OM + (size_t)ts * D + u.b * 256 + wn * 64 + ni * 32 + 16 * gp + 8 * hi) = w8[ni][gp];
        }
      }
      return u.d >= 128 ? 8 : 0; });
}
constexpr int ATT_SLOT = 16384, ATT_LDS = 4 * ATT_SLOT;
__device__ __forceinline__ int vst64(int k, int c) { const int kk = (k & ~0xC) | ((k & 4) << 1) | ((k & 8) >> 1); return ((kk >> 3) * 2 + (c >> 5)) * 512 + ((kk & 7) * 32 + (c & 31)) * 2; }
__device__ __forceinline__ bf16x8 tr_frag64(const LAS char* p) {
  s16x4 a = __builtin_amdgcn_ds_read_tr16_b64_v4i16((LAS s16x4*)p);
  s16x4 b = __builtin_amdgcn_ds_read_tr16_b64_v4i16((LAS s16x4*)(p + 1024));
  return (bf16x8){a[0], a[1], a[2], a[3], b[0], b[1], b[2], b[3]};
}
__device__ __forceinline__ bf16x8 pk4(const f32x16& P, int B) {
  unsigned a0 = cvtpk(P[B + 0], P[B + 1]), a1 = cvtpk(P[B + 2], P[B + 3]), b0 = cvtpk(P[B + 4], P[B + 5]), b1 = cvtpk(P[B + 6], P[B + 7]);
  auto r0 = __builtin_amdgcn_permlane32_swap(a0, b0, false, false); auto r1 = __builtin_amdgcn_permlane32_swap(a1, b1, false, false);
  u32x4 w = {r0[0], r1[0], r0[1], r1[1]};
  return __builtin_bit_cast(bf16x8, w);
}
struct AttnCtx { int krd0, krd1, ksw, hi, vrd; };
#define SBAR() __builtin_amdgcn_sched_barrier(0)
__device__ __forceinline__ void att_kload(const LAS char* slot, const AttnCtx& c, bf16x8 (&kf)[8]) {
#pragma unroll
  for (int d0 = 0; d0 < 4; ++d0) {
    kf[2 * d0] = *(const LAS bf16x8*)(slot + c.krd0 + (((2 * d0 + c.hi) ^ c.ksw) << 4));
    kf[2 * d0 + 1] = *(const LAS bf16x8*)(slot + c.krd1 + (((2 * d0 + c.hi) ^ c.ksw) << 4));
  }
}
__device__ __forceinline__ void att_qk(const bf16x8 (&kf)[8], const bf16x8 (&qr)[4], f32x16& s0, f32x16& s1) {
  s0 = (f32x16){}; s1 = (f32x16){};
#pragma unroll
  for (int d0 = 0; d0 < 4; ++d0) {
    s0 = __builtin_amdgcn_mfma_f32_32x32x16_bf16(kf[2 * d0], qr[d0], s0, 0, 0, 0);
    s1 = __builtin_amdgcn_mfma_f32_32x32x16_bf16(kf[2 * d0 + 1], qr[d0], s1, 0, 0, 0);
  }
}
__device__ __forceinline__ void att_exp(f32x16& s, float& l) {
#pragma unroll
  for (int r = 0; r < 16; ++r) { s[r] = __builtin_amdgcn_exp2f(s[r]); l += s[r]; }
  asm volatile("" : "+v"(l));
}
template <int KS0>
__device__ __forceinline__ void att_vload(const LAS char* slot, const AttnCtx& c, bf16x8 (&vf)[4]) {
#pragma unroll
  for (int i = 0; i < 2; ++i) { vf[2 * i] = tr_frag64(slot + c.vrd + (KS0 + i) * 2048); vf[2 * i + 1] = tr_frag64(slot + c.vrd + 512 + (KS0 + i) * 2048); }
}
__device__ __forceinline__ void att_pv2(const bf16x8& pa, const bf16x8& pb, const bf16x8 (&vf)[4], f32x16& o0, f32x16& o1) {
  o0 = __builtin_amdgcn_mfma_f32_32x32x16_bf16(pa, vf[0], o0, 0, 0, 0);
  o1 = __builtin_amdgcn_mfma_f32_32x32x16_bf16(pa, vf[1], o1, 0, 0, 0);
  o0 = __builtin_amdgcn_mfma_f32_32x32x16_bf16(pb, vf[2], o0, 0, 0, 0);
  o1 = __builtin_amdgcn_mfma_f32_32x32x16_bf16(pb, vf[3], o1, 0, 0, 0);
}
__device__ __forceinline__ void attn_unit(const Params& p, LAS char* lds, int row0, int hp, int nkeys) {
  const bf16_t* Q = (const bf16_t*)(p.ws + OFF_Q); const bf16_t* Kb = (const bf16_t*)(p.ws + OFF_K); const bf16_t* Vb = (const bf16_t*)(p.ws + OFF_V);
  bf16_t* MIX = (bf16_t*)(p.ws + OFF_MIX);
  const int tid = TIDX, wid = tid >> 6, lane = tid & 63, r32 = lane & 31, hi = lane >> 5, kvh = hp >> 1;
  bf16x8 qa[4], qb[4];
  { const bf16_t* Qg = Q + (size_t)(row0 + wid * 32 + r32) * 512 + hp * 128 + hi * 8;
#pragma unroll
    for (int d0 = 0; d0 < 4; ++d0) { qa[d0] = *(const bf16x8*)(Qg + d0 * 16); qb[d0] = *(const bf16x8*)(Qg + 64 + d0 * 16); } }
  const bf16_t* Kg = Kb + (size_t)(tid >> 3) * 128 + kvh * 64 + (tid & 7) * 8;
  const bf16_t* Vg = Vb + (size_t)(tid >> 3) * 128 + kvh * 64 + (tid & 7) * 8;
  const int kst = xoff(tid >> 3, tid & 7), vstw = 8192 + vst64(tid >> 3, (tid & 7) * 8);
  AttnCtx c; c.krd0 = r32 * 128; c.krd1 = (32 + r32) * 128; c.ksw = (r32 >> 1) & 7; c.hi = hi; c.vrd = 8192 + v_rd_base(lane);
  const int NT = nkeys >> 6;
  f32x16 oa0 = {}, oa1 = {}, ob0 = {}, ob1 = {}; float la = 0.f, lb = 0.f;
  u32x4 ks, vs;
  {
    const u32x4 k0 = *(const u32x4*)Kg, k1 = *(const u32x4*)(Kg + 64 * 128), v0 = *(const u32x4*)Vg, v1 = *(const u32x4*)(Vg + 64 * 128);
    *(LAS u32x4*)(lds + kst) = k0; *(LAS u32x4*)(lds + ATT_SLOT + kst) = k1;
    *(LAS u32x4*)(lds + vstw) = v0; *(LAS u32x4*)(lds + ATT_SLOT + vstw) = v1;
    ks = *(const u32x4*)(Kg + 2 * 64 * 128); vs = *(const u32x4*)(Vg + 2 * 64 * 128);
  }
  __syncthreads();
  for (int j = 0; j < NT; ++j) {
    const LAS char* sl = lds + (j & 3) * ATT_SLOT;
    bf16x8 kf[8], vfa[4], vfb[4];
    f32x16 sa0, sa1, sb0, sb1;
    att_kload(sl, c, kf);
    SBAR();
    att_qk(kf, qa, sa0, sa1);
    SBAR();
    att_qk(kf, qb, sb0, sb1);
    att_exp(sa0, la); att_exp(sa1, la);
    SBAR();
    const bf16x8 pa0 = pk4(sa0, 0), pa1 = pk4(sa0, 8), pa2 = pk4(sa1, 0), pa3 = pk4(sa1, 8);
    att_vload<0>(sl, c, vfa);
    SBAR();
    att_pv2(pa0, pa1, vfa, oa0, oa1);
    att_exp(sb0, lb);
    att_vload<2>(sl, c, vfb);
    SBAR();
    att_pv2(pa2, pa3, vfb, oa0, oa1);
    att_exp(sb1, lb);
    const bf16x8 pb0 = pk4(sb0, 0), pb1 = pk4(sb0, 8), pb2 = pk4(sb1, 0), pb3 = pk4(sb1, 8);
    att_vload<0>(sl, c, vfa);
    SBAR();
    att_pv2(pb0, pb1, vfa, ob0, ob1);
    att_vload<2>(sl, c, vfb);
    SBAR();
    att_pv2(pb2, pb3, vfb, ob0, ob1);
    { LAS char* w = lds + ((j + 2) & 3) * ATT_SLOT;
      if (j + 2 < NT) { *(LAS u32x4*)(w + kst) = ks; *(LAS u32x4*)(w + vstw) = vs; }
      if (j + 3 < NT) { ks = *(const u32x4*)(Kg + (size_t)(j + 3) * 64 * 128); vs = *(const u32x4*)(Vg + (size_t)(j + 3) * 64 * 128); } }
    __syncthreads();
  }
  la = sum32(la); lb = sum32(lb);
  LAS float* li = (LAS float*)(lds + wid * 256);
  if (hi == 0) { li[r32] = la; li[32 + r32] = lb; }
  __syncthreads();
  bf16_t* Og = MIX + (size_t)(row0 + wid * 32) * D + hp * 128 + r32;
#pragma unroll
  for (int r = 0; r < 16; ++r) {
    const int orow = crow(r, hi);
    const float ra = __builtin_amdgcn_rcpf(li[orow]), rb = __builtin_amdgcn_rcpf(li[32 + orow]);
    Og[(size_t)orow * D] = f2bf(oa0[r] * ra); Og[(size_t)orow * D + 32] = f2bf(oa1[r] * ra);
    Og[(size_t)orow * D + 64] = f2bf(ob0[r] * rb); Og[(size_t)orow * D + 96] = f2bf(ob1[r] * rb);
  }
  __syncthreads();
}
typedef int i32x8 __attribute__((ext_vector_type(8)));
constexpr int A8_SLOT = 8192, A8_NSLOT = 8, A8_LDS = A8_NSLOT * A8_SLOT;
__device__ __forceinline__ int off8(int row, int chunk) { return row * 64 + ((chunk ^ ((row >> 2) & 3)) << 4); }
__device__ __forceinline__ i32x8 ld_frag8(const LAS char* tile, int row, int h) {
  const int sw = (row >> 2) & 3;
  const u32x4 lo = *(const LAS u32x4*)(tile + row * 64 + (((2 * h) ^ sw) << 4)), hi = *(const LAS u32x4*)(tile + row * 64 + (((2 * h + 1) ^ sw) << 4));
  return (i32x8){(int)lo[0], (int)lo[1], (int)lo[2], (int)lo[3], (int)hi[0], (int)hi[1], (int)hi[2], (int)hi[3]};
}
#define MX_FP8_FP8(a, b, c) __builtin_amdgcn_mfma_scale_f32_32x32x64_f8f6f4(a, b, c, 0, 0, 0, 0x7f7f7f7f, 0, 0x7f7f7f7f)
#define MX_BF8_FP8(a, b, c) __builtin_amdgcn_mfma_scale_f32_32x32x64_f8f6f4(a, b, c, 1, 0, 0, 0x7f7f7f7f, 0, 0x7f7f7f7f)
typedef _Float16 f16x2 __attribute__((ext_vector_type(2)));
__device__ __forceinline__ unsigned att8_code4(float s0, float s1, float s2, float s3) {
  const f16x2 four = {(_Float16)4.f, (_Float16)4.f}, bias = {(_Float16)1084.f, (_Float16)1084.f};
  const f16x2 x = __builtin_bit_cast(f16x2, __builtin_amdgcn_cvt_pkrtz(s0, s1)) * four + bias, y = __builtin_bit_cast(f16x2, __builtin_amdgcn_cvt_pkrtz(s2, s3)) * four + bias;
  return __builtin_amdgcn_perm(__builtin_bit_cast(unsigned, y), __builtin_bit_cast(unsigned, x), 0x06040200u);
}
__device__ __forceinline__ i32x8 att8_pack(const f32x16& p0, const f32x16& p1) {
  i32x8 w;
#pragma unroll
  for (int i = 0; i < 4; ++i) {
    const unsigned d = att8_code4(p0[4 * i], p0[4 * i + 1], p0[4 * i + 2], p0[4 * i + 3]), e = att8_code4(p1[4 * i], p1[4 * i + 1], p1[4 * i + 2], p1[4 * i + 3]);
    auto r = __builtin_amdgcn_permlane32_swap(d, e, false, false);
    w[2 * i] = (int)r[0]; w[2 * i + 1] = (int)r[1];
  }
  return w;
}
template <bool BGJ = false>
__device__ __forceinline__ void attn_unit8(const Params& p, LAS char* lds, int row0, int hp, int nkeys, bf16_t* MIXP = nullptr, int bgu = 0, const float* bs0 = nullptr,
                                           const float* bs1 = nullptr, const float* bs2 = nullptr, bf16_t* bd0 = nullptr, bf16_t* bd1 = nullptr, bf16_t* bd2 = nullptr) {
  const unsigned char* Q8 = (const unsigned char*)(p.ws + OFF_Q8); const unsigned char* K8 = (const unsigned char*)(p.ws + OFF_K8); const unsigned char* VT8 = (const unsigned char*)(p.ws + OFF_VT8);
  bf16_t* MIX = MIXP ? MIXP : (bf16_t*)(p.ws + OFF_MIX);
  const int tid = TIDX, wid = tid >> 6, lane = tid & 63, r32 = lane & 31, hi = lane >> 5, kvh = hp >> 1;
  i32x8 qa, qb;
  { const unsigned char* Qg = Q8 + (size_t)(row0 + wid * 32 + r32) * 512 + hp * 128 + hi * 32;
    const u32x4 a0 = *(const u32x4*)Qg, a1 = *(const u32x4*)(Qg + 16), b0 = *(const u32x4*)(Qg + 64), b1 = *(const u32x4*)(Qg + 80);
    qa = (i32x8){(int)a0[0], (int)a0[1], (int)a0[2], (int)a0[3], (int)a1[0], (int)a1[1], (int)a1[2], (int)a1[3]};
    qb = (i32x8){(int)b0[0], (int)b0[1], (int)b0[2], (int)b0[3], (int)b1[0], (int)b1[1], (int)b1[2], (int)b1[3]}; }
  const int wv = __builtin_amdgcn_readfirstlane(wid);
  const int prow = (wv & 3) * 16 + (lane >> 2), pch = (lane & 3) ^ ((prow >> 2) & 3);
  const unsigned char* Sg = wv < 4 ? K8 + (size_t)prow * 128 + kvh * 64 + pch * 16 : VT8 + (size_t)(kvh * 64 + prow) * TT + pch * 16;
  const size_t sstep = wv < 4 ? (size_t)64 * 128 : (size_t)64;
  const int sdst = (wv < 4 ? 0 : 4096) + (wv & 3) * 1024;
#define A8_DMA(t) __builtin_amdgcn_global_load_lds((const unsigned*)(Sg + (size_t)(t) * sstep), (LAS unsigned*)(lds + ((t) & (A8_NSLOT - 1)) * A8_SLOT + sdst), 16, 0, 0)
  const int NT = nkeys >> 6;
  f32x16 oa0 = {}, oa1 = {}, ob0 = {}, ob1 = {}, ola = {}, olb = {};
  const i32x8 ones = {0x38383838, 0x38383838, 0x38383838, 0x38383838, 0x38383838, 0x38383838, 0x38383838, 0x38383838};
#define A8_BGADDR(st_, SP, DP) const long e_ = ((long)bgu * 96 + ((st_) < 96 ? (st_) : 95)) * 2048; const int t_ = (int)(e_ >> 24); const long o_ = e_ & 0xffffff; \
    const float* SP = (t_ == 0 ? bs0 : (t_ == 1 ? bs1 : bs2)) + o_ + bgl; bf16_t* DP = (t_ == 0 ? bd0 : (t_ == 1 ? bd1 : bd2)) + o_ + bgl
  f32x4 bgv = {0.f, 0.f, 0.f, 0.f};
  const int bgl = tid * 4;
  A8_DMA(0); A8_DMA(1);
  if (BGJ) { A8_BGADDR(0, sp_, dp_); (void)dp_; bgv = *(const f32x4*)sp_; }
  if (NT > 2) { A8_DMA(2); A8_DMA(3); }
  for (int j = 0; j < NT; j += 2) {
    if (j + 2 < NT) asm volatile("s_waitcnt vmcnt(2)" ::: "memory"); else asm volatile("s_waitcnt vmcnt(0)" ::: "memory");
    asm volatile("s_waitcnt lgkmcnt(0)" ::: "memory"); __builtin_amdgcn_s_barrier();
#pragma unroll
    for (int jj = 0; jj < 2; ++jj) {
      const LAS char* sl = lds + ((j + jj) & (A8_NSLOT - 1)) * A8_SLOT;
      f32x16 sa0 = {}, sa1 = {}, sb0 = {}, sb1 = {};
      const i32x8 kf0 = ld_frag8(sl, r32, hi), kf1 = ld_frag8(sl, 32 + r32, hi);
      SBAR();
      sa0 = MX_FP8_FP8(kf0, qa, sa0); sa1 = MX_FP8_FP8(kf1, qa, sa1);
      SBAR();
      if (jj == 0) {
        if (BGJ) {
          { A8_BGADDR(j >> 1, sp_, dp_); (void)sp_; *(u32x2*)dp_ = (u32x2){cvtpk(bgv[0], bgv[1]), cvtpk(bgv[2], bgv[3])}; }
          { A8_BGADDR((j >> 1) + 1, sp_, dp_); (void)dp_; bgv = *(const f32x4*)sp_; }
        }
        if (j + 4 < NT) A8_DMA(j + 4);
      } else if (j + 4 < NT) A8_DMA(j + 5);
      SBAR();
      sb0 = MX_FP8_FP8(kf0, qb, sb0); sb1 = MX_FP8_FP8(kf1, qb, sb1);
      SBAR();
      const i32x8 pa = att8_pack(sa0, sa1);
      const i32x8 vf0 = ld_frag8(sl + 4096, r32, hi), vf1 = ld_frag8(sl + 4096, 32 + r32, hi);
      SBAR();
      oa0 = MX_BF8_FP8(pa, vf0, oa0); oa1 = MX_BF8_FP8(pa, vf1, oa1); ola = MX_BF8_FP8(pa, ones, ola);
      const i32x8 pb = att8_pack(sb0, sb1);
      SBAR();
      ob0 = MX_BF8_FP8(pb, vf0, ob0); ob1 = MX_BF8_FP8(pb, vf1, ob1); olb = MX_BF8_FP8(pb, ones, olb);
    }
  }
#undef A8_DMA
#undef A8_BGADDR
  asm volatile("s_waitcnt lgkmcnt(0)" ::: "memory"); __builtin_amdgcn_s_barrier();
  bf16_t* Og = MIX + (size_t)(row0 + wid * 32) * D + hp * 128 + r32;
#pragma unroll
  for (int r = 0; r < 16; ++r) {
    const int orow = crow(r, hi);
    const float ra = __builtin_amdgcn_rcpf(ola[r]), rb = __builtin_amdgcn_rcpf(olb[r]);
    Og[(size_t)orow * D] = f2bf(oa0[r] * ra); Og[(size_t)orow * D + 32] = f2bf(oa1[r] * ra);
    Og[(size_t)orow * D + 64] = f2bf(ob0[r] * rb); Og[(size_t)orow * D + 96] = f2bf(ob1[r] * rb);
  }
  __syncthreads();
}
__device__ __forceinline__ void attn_fallback(const Params& p, int layer, int bid, int nblk) {
  const bf16_t* Q = (const bf16_t*)(p.ws + OFF_Q); const bf16_t* Kb = (const bf16_t*)(p.ws + OFF_K); const bf16_t* Vb = (const bf16_t*)(p.ws + OFF_V);
  bf16_t* MIX = (bf16_t*)(p.ws + OFF_MIX);
  const int lane = TIDX & 63, nwv = nblk * 8;
  const int rg0 = layer == 0 ? 0 : NCTX / 64;
  for (int wv = bid * 8 + (TIDX >> 6) + rg0 * 8; wv < (TT / 64) * 8; wv += nwv) {
    const int head = wv & 7, r = (wv >> 3) * 64 + lane, kvh = head >> 2;
    float q[64], o[64];
#pragma unroll
    for (int d = 0; d < 64; ++d) { q[d] = bf2f(Q[(size_t)r * 512 + head * 64 + d]); o[d] = 0.f; }
    float m = -1e30f, l = 0.f;
    const int nk = r >= NCTX ? TT : NCTX;
    for (int j = 0; j < nk; ++j) {
      const bf16_t* kr = Kb + (size_t)j * 128 + kvh * 64;
      const bf16_t* vr = Vb + (size_t)j * 128 + kvh * 64;
      float s = 0.f;
#pragma unroll
      for (int d = 0; d < 64; ++d) s += q[d] * bf2f(kr[d]);
      if (s > m) {
        const float a = __builtin_amdgcn_exp2f(m - s);
        l *= a;
#pragma unroll
        for (int d = 0; d < 64; ++d) o[d] *= a;
        m = s;
      }
      const float pe = __builtin_amdgcn_exp2f(s - m);
      l += pe;
#pragma unroll
      for (int d = 0; d < 64; ++d) o[d] += pe * bf2f(vr[d]);
    }
    const float il = 1.f / l;
#pragma unroll
    for (int d = 0; d < 64; ++d) MIX[(size_t)r * D + head * 64 + d] = f2bf(o[d] * il);
  }
}

constexpr int PC_U = 0;
constexpr int PC_Y = 49152;
constexpr int PC_P = PC_Y + 65536;
constexpr int PC_LDS = PC_P + 32768;
__device__ __forceinline__ void poolconv_unit(const Params& p, int layer, LAS char* lds, int tile) {
  const int tid = TIDX, wid = tid >> 6, lane = tid & 63, r32 = lane & 31, hi = lane >> 5;
  const int t0 = tile * 64, base = tile < 4 ? 0 : NCTX, n = tile < 4 ? NCTX : SEQ;
  const bf16_t* AG = (const bf16_t*)(p.ws + OFF_AG);
  const float* U = (const float*)(p.ws + OFF_U);
  bf16_t* MIX = (bf16_t*)(p.ws + OFF_MIX);
  const int pc_c = tid & 255, pc_th = tid >> 8;
  float w[31];
#pragma unroll
  for (int j = 0; j < 31; ++j) w[j] = p.w_dw[(size_t)layer * 31 * 256 + j * 256 + pc_c];
  const float b = p.b_dw[layer * 256 + pc_c];
  float uv[48];
  { const int tl0 = t0 - base + pc_th * 32;
#pragma unroll
    for (int i = 0; i < 48; ++i) { const int j = tl0 - 8 + i; const bool in = j >= 0 && j < n; uv[i] = in ? U[(size_t)(base + j) * 256 + pc_c] : 0.f; } }
#pragma unroll
  for (int h = 0; h < 2; ++h) {
    u32x4 av[3], gv[3]; bool in[3];
#pragma unroll
    for (int q = 0; q < 3; ++q) {
      const int idx = tid + (h * 3 + q) * 512, rr = idx >> 5, ch = (idx & 31) * 8, t = t0 - 15 + rr;
      in[q] = idx < 94 * 32 && t >= base && t < base + n;
      const size_t off = (size_t)(in[q] ? t : t0) * 512 + ch;
      av[q] = *(const u32x4*)(AG + off); gv[q] = *(const u32x4*)(AG + off + 256);
    }
#pragma unroll
    for (int q = 0; q < 3; ++q) {
      const int idx = tid + (h * 3 + q) * 512, rr = idx >> 5, ch = (idx & 31) * 8;
      u32x4 out = {0u, 0u, 0u, 0u};
      if (in[q]) {
#pragma unroll
        for (int i = 0; i < 4; ++i) {
          const float a0 = __uint_as_float(av[q][i] << 16), a1 = __uint_as_float(av[q][i] & 0xffff0000u);
          const float g0 = __uint_as_float(gv[q][i] << 16), g1 = __uint_as_float(gv[q][i] & 0xffff0000u);
          out[i] = cvtpk(a0 * __builtin_amdgcn_rcpf(1.f + __expf(-g0)), a1 * __builtin_amdgcn_rcpf(1.f + __expf(-g1)));
        }
      }
      if (idx < 94 * 32) *(LAS u32x4*)(lds + PC_U + (rr * 256 + ch) * 2) = out;
    }
  }
  __syncthreads();
  {
    const int c = pc_c, th = pc_th;
    float acc[32];
#pragma unroll
    for (int i = 0; i < 32; ++i) acc[i] = b;
    const LAS bf16_t* up = (const LAS bf16_t*)(lds + PC_U) + (th * 32) * 256 + c;
#pragma unroll
    for (int rr = 0; rr < 62; ++rr) {
      const float uv = bf2f(up[rr * 256]);
#pragma unroll
      for (int i = 0; i < 32; ++i) if (rr - i >= 0 && rr - i < 31) acc[i] += uv * w[rr - i];
    }
    LAS float* yp = (LAS float*)(lds + PC_Y) + (th * 32) * 256 + c;
#pragma unroll
    for (int i = 0; i < 32; ++i) yp[i * 256] = acc[i];
  }
  {
    const int c = pc_c, th = pc_th, grp = c >> 6, ww = 2 << grp, hw = ww >> 1;
    const int tl0 = t0 - base + th * 32;
#pragma unroll
    for (int i = 0; i < 32; ++i) {
      const int tl = tl0 + i, lo = max(tl - hw, 0), hh = min(tl + hw, n);
      float s = 0.f;
#pragma unroll
      for (int d = -8; d < 8; ++d) if (d >= -hw && d < hw) s += uv[8 + i + d];
      const float pv = s / (float)(hh - lo) - uv[8 + i];
      const int tok = th * 32 + i, chunk = c >> 3, sw = (chunk & 16) | ((chunk ^ tok) & 15);
      *(LAS bf16_t*)(lds + PC_P + tok * 512 + sw * 16 + (c & 7) * 2) = f2bf(pv);
    }
  }
  __syncthreads();
  const int pc_tb = wid >> 2, pc_dg = wid & 3;
  const bf16_t* Wt = (const bf16_t*)(p.ws + OFF_WPWT) + ((size_t)layer * 256 + pc_dg * 64 + r32) * 256 + hi * 8;
  const bf16_t* Pt = (const bf16_t*)(p.ws + OFF_WPOOLT) + ((size_t)(layer * 4 + pc_dg) * 64 + r32) * 64 + hi * 8;
  bf16x8 wa[8], wb[8], pa4[4], pb4[4];
#pragma unroll
  for (int ks = 0; ks < 8; ++ks) { wa[ks] = *(const bf16x8*)(Wt + ks * 16); wb[ks] = *(const bf16x8*)(Wt + 32 * 256 + ks * 16); }
#pragma unroll
  for (int ks = 0; ks < 4; ++ks) { pa4[ks] = *(const bf16x8*)(Pt + ks * 16); pb4[ks] = *(const bf16x8*)(Pt + 32 * 64 + ks * 16); }
  {
    const f32x4 g4 = *(const f32x4*)(p.cv_ln_g + layer * 256 + lane * 4), b4 = *(const f32x4*)(p.cv_ln_b + layer * 256 + lane * 4);
    f32x4 y[8]; float mu[8], rs[8];
#pragma unroll
    for (int i = 0; i < 8; ++i) y[i] = *(const LAS f32x4*)(lds + PC_Y + ((wid * 8 + i) * 256 + lane * 4) * 4);
#pragma unroll
    for (int i = 0; i < 8; ++i) mu[i] = (y[i][0] + y[i][1]) + (y[i][2] + y[i][3]);
#pragma unroll
    for (int i = 0; i < 8; ++i) mu[i] = wave_sum(mu[i]) * (1.f / 256.f);
#pragma unroll
    for (int i = 0; i < 8; ++i) { y[i] -= mu[i]; rs[i] = (y[i][0] * y[i][0] + y[i][1] * y[i][1]) + (y[i][2] * y[i][2] + y[i][3] * y[i][3]); }
#pragma unroll
    for (int i = 0; i < 8; ++i) rs[i] = rsqrtf(wave_sum(rs[i]) * (1.f / 256.f) + EPS);
#pragma unroll
    for (int i = 0; i < 8; ++i) {
      const int tok = wid * 8 + i;
      const f32x4 t = y[i] * rs[i] * g4 + b4;
      const float z0 = silu(t[0]), z1 = silu(t[1]), z2 = silu(t[2]), z3 = silu(t[3]);
      const int chunk = lane >> 1, sw = (chunk & 16) | ((chunk ^ tok) & 15);
      *(LAS u32x2*)(lds + PC_U + tok * 512 + sw * 16 + (lane & 1) * 8) = (u32x2){cvtpk(z0, z1), cvtpk(z2, z3)};
    }
  }
  __syncthreads();
  {
    const int tb = pc_tb, dg = pc_dg, trow = tb * 32 + r32, t = t0 + trow;
    f32x16 acc0 = {}, acc1 = {};
    bf16x8 wc[8], wd[8];
#pragma unroll
    for (int ks = 0; ks < 8; ++ks) { wc[ks] = *(const bf16x8*)(Wt + (8 + ks) * 16); wd[ks] = *(const bf16x8*)(Wt + 32 * 256 + (8 + ks) * 16); }
#pragma unroll
    for (int ks = 0; ks < 16; ++ks) {
      const int chunk = 2 * ks + hi, sw = (chunk & 16) | ((chunk ^ trow) & 15);
      const bf16x8 zf = *(const LAS bf16x8*)(lds + PC_U + trow * 512 + sw * 16);
      const bf16x8 w0 = ks < 8 ? wa[ks & 7] : wc[ks & 7], w1 = ks < 8 ? wb[ks & 7] : wd[ks & 7];
      acc0 = __builtin_amdgcn_mfma_f32_32x32x16_bf16(w0, zf, acc0, 0, 0, 0);
      acc1 = __builtin_amdgcn_mfma_f32_32x32x16_bf16(w1, zf, acc1, 0, 0, 0);
    }
    bf16_t* dst = MIX + (size_t)t * D + 768 + dg * 64;
#pragma unroll
    for (int g = 0; g < 4; ++g) { *(u32x2*)(dst + 8 * g + 4 * hi) = pack4(acc0, g); *(u32x2*)(dst + 32 + 8 * g + 4 * hi) = pack4(acc1, g); }
    f32x16 pc0 = {}, pc1 = {};
#pragma unroll
    for (int ks = 0; ks < 4; ++ks) {
      const int chunk = dg * 8 + 2 * ks + hi, sw = (chunk & 16) | ((chunk ^ trow) & 15);
      const bf16x8 pf = *(const LAS bf16x8*)(lds + PC_P + trow * 512 + sw * 16);
      const bf16x8 w0 = pa4[ks], w1 = pb4[ks];
      pc0 = __builtin_amdgcn_mfma_f32_32x32x16_bf16(w0, pf, pc0, 0, 0, 0);
      pc1 = __builtin_amdgcn_mfma_f32_32x32x16_bf16(w1, pf, pc1, 0, 0, 0);
    }
    const float* psc = p.pool_scale + layer * 256 + dg * 64;
#pragma unroll
    for (int r = 0; r < 16; ++r) { pc0[r] *= psc[crow(r, hi)]; pc1[r] *= psc[32 + crow(r, hi)]; }
    bf16_t* pd = MIX + (size_t)t * D + 512 + dg * 64;
#pragma unroll
    for (int g = 0; g < 4; ++g) { *(u32x2*)(pd + 8 * g + 4 * hi) = pack4(pc0, g); *(u32x2*)(pd + 32 + 8 * g + 4 * hi) = pack4(pc1, g); }
  }
  __syncthreads();
}

__device__ __forceinline__ void phase_b(const Params& p, int layer, LAS char* lds, int bid, int nblk) {
  const int mode0 = ((const int*)(p.ws + OFF_FLAG))[0], vbig = ((const int*)(p.ws + OFF_FLAG))[1];
  const int mode = (mode0 == 2 && vbig != 0) ? 1 : mode0;
  const bool fast = mode != 0;
  const size_t wo = (size_t)layer * NE * D * DE;
  const float* bs0 = p.w_e_gate + wo; const float* bs1 = p.w_e_up + wo; const float* bs2 = p.w_e_down + wo;
  bf16_t* bd0 = (bf16_t*)(p.ws + OFF_WG) + wo; bf16_t* bd1 = (bf16_t*)(p.ws + OFF_WU) + wo; bf16_t* bd2 = (bf16_t*)(p.ws + OFF_WD) + wo;
  const int nu = (520 - bid + nblk - 1) / nblk;
  for (int i = 0; i < nu; ++i) {
    const int u = bid + i * nblk;
    if (u < 256) {
      if (mode == 2) attn_unit8<true>(p, lds, NCTX + (u >> 2) * 256, u & 3, TT, nullptr, u, bs0, bs1, bs2, bd0, bd1, bd2);
      else {
        if (mode == 1) attn_unit(p, lds, NCTX + (u >> 2) * 256, u & 3, TT);
        for (int st = 0; st < 96; ++st) {
          const long e_ = (((long)u * 96 + st) * 512 + TIDX) * 4; const int t_ = (int)(e_ >> 24); const long o_ = e_ & 0xffffff;
          const f32x4 w = *(const f32x4*)((t_ == 0 ? bs0 : (t_ == 1 ? bs1 : bs2)) + o_);
          *(u32x2*)((t_ == 0 ? bd0 : (t_ == 1 ? bd1 : bd2)) + o_) = (u32x2){cvtpk(w[0], w[1]), cvtpk(w[2], w[3])};
        }
      }
    }
    else if (u < 260) { if (layer == 0) { if (mode == 2) attn_unit8(p, lds, 0, u - 256, NCTX); else if (mode == 1) attn_unit(p, lds, 0, u - 256, NCTX); } }
    else { const int tile = u - 260; if (layer == 0 || tile >= 4) poolconv_unit(p, layer, lds, tile); }
  }
  if (!fast) attn_fallback(p, layer, bid, nblk);
}

constexpr int NR = 2, NRA = 2;
__device__ __forceinline__ float hsum4(const f32x4 (&v)[4]) { float s = 0.f;
#pragma unroll
  for (int i = 0; i < 4; ++i) s += (v[i][0] + v[i][1]) + (v[i][2] + v[i][3]);
  return s; }
__device__ __forceinline__ float hsq4(const f32x4 (&v)[4], float mu) { float q = 0.f;
#pragma unroll
  for (int i = 0; i < 4; ++i) { const f32x4 d = v[i] - mu; q += (d[0] * d[0] + d[1] * d[1]) + (d[2] * d[2] + d[3] * d[3]); }
  return q; }
__device__ __forceinline__ f32x4 bf4(u32x2 w) { return (f32x4){__uint_as_float(w[0] << 16), __uint_as_float(w[0] & 0xffff0000u), __uint_as_float(w[1] << 16), __uint_as_float(w[1] & 0xffff0000u)}; }

__device__ __forceinline__ void phase_a0(const Params& p, int layer, LAS char* lds, int bid, int nblk) {
  const int tid = TIDX, wv = __builtin_amdgcn_readfirstlane(tid >> 6), wave = bid * 8 + wv, lane = tid & 63, nw = nblk * 8;
  float* X = (float*)(p.ws + OFF_X);
  bf16_t* H = (bf16_t*)(p.ws + OFF_H);
  const bf16_t* OM = (const bf16_t*)(p.ws + OFF_OMOE);
  const float* GATE = (const float*)(p.ws + OFF_GATE);
  LAS float* par = (LAS float*)lds;
  { const float* modl = (const float*)(p.ws + OFF_MOD) + (layer * 2 + 0) * 6144;
#pragma unroll
    for (int q = 0; q < 4; ++q) { const int e = tid + q * 512; par[e] = modl[e]; }
    if (layer != 0) {
      const float* modq = (const float*)(p.ws + OFF_MOD) + ((layer - 1) * 2 + 0) * 6144 + 5 * D;
#pragma unroll
      for (int q = 0; q < 2; ++q) { const int e = tid + q * 512; par[2 * D + e] = modq[e]; par[3 * D + e] = p.ln2_g[(layer - 1) * D + e]; par[4 * D + e] = p.ln2_b[(layer - 1) * D + e]; }
    }
  }
  __syncthreads();
  f32x4 xn[NRA][4]; u32x2 oan[NRA][4], obn[NRA][4];
#define A0_LOAD(rb_) do { _Pragma("unroll") for (int k = 0; k < NRA; ++k) { const int r = (rb_) + k; \
      const float* src = layer == 0 ? (r < NCTX ? p.ctx + (size_t)r * D : p.x + (size_t)(r - NCTX) * D) : X + (size_t)r * D; \
      _Pragma("unroll") for (int i = 0; i < 4; ++i) { const int c = i * 256 + lane * 4; xn[k][i] = *(const f32x4*)(src + c); \
        if (layer != 0) { oan[k][i] = *(const u32x2*)(OM + ((size_t)r * 2 + 0) * D + c); obn[k][i] = *(const u32x2*)(OM + ((size_t)r * 2 + 1) * D + c); } } } } while (0)
  if (wave * NRA < TT) A0_LOAD(wave * NRA);
  for (int rb = wave * NRA; rb < TT; rb += nw * NRA) {
    f32x4 v[NRA][4];
    const bool ctx = rb < NCTX;
    if (layer != 0) {
#pragma unroll
      for (int k = 0; k < NRA; ++k) {
        const int r = rb + k;
        const float ga = GATE[r * 2], gb = GATE[r * 2 + 1];
        if (ctx) {
          const float* g2 = (const float*)(p.ws + OFF_MOD) + ((layer - 1) * 2 + 1) * 6144 + 5 * D;
#pragma unroll
          for (int i = 0; i < 4; ++i) { const int c = i * 256 + lane * 4; v[k][i] = xn[k][i] * ALPHA + *(const f32x4*)(g2 + c) * (bf4(oan[k][i]) * ga + bf4(obn[k][i]) * gb); }
        } else {
#pragma unroll
          for (int i = 0; i < 4; ++i) { const int c = i * 256 + lane * 4; v[k][i] = xn[k][i] * ALPHA + *(const LAS f32x4*)(par + 2 * D + c) * (bf4(oan[k][i]) * ga + bf4(obn[k][i]) * gb); }
        }
      }
    } else {
#pragma unroll
      for (int k = 0; k < NRA; ++k)
#pragma unroll
        for (int i = 0; i < 4; ++i) v[k][i] = xn[k][i];
    }
    if (rb + nw * NRA < TT) A0_LOAD(rb + nw * NRA);
    if (layer != 0) {
      float mu[NRA], rs[NRA];
#pragma unroll
      for (int k = 0; k < NRA; ++k) mu[k] = wave_sum(hsum4(v[k])) * (1.f / D);
#pragma unroll
      for (int k = 0; k < NRA; ++k) rs[k] = rsqrtf(wave_sum(hsq4(v[k], mu[k])) * (1.f / D) + EPS);
#pragma unroll
      for (int k = 0; k < NRA; ++k)
#pragma unroll
        for (int i = 0; i < 4; ++i) { const int c = i * 256 + lane * 4;
          v[k][i] = (v[k][i] - mu[k]) * rs[k] * *(const LAS f32x4*)(par + 3 * D + c) + *(const LAS f32x4*)(par + 4 * D + c); *(f32x4*)(X + (size_t)(rb + k) * D + c) = v[k][i]; }
    }
    float mu[NRA], rs[NRA];
#pragma unroll
    for (int k = 0; k < NRA; ++k) mu[k] = wave_sum(hsum4(v[k])) * (1.f / D);
#pragma unroll
    for (int k = 0; k < NRA; ++k) rs[k] = rsqrtf(wave_sum(hsq4(v[k], mu[k])) * (1.f / D) + EPS);
#pragma unroll
    for (int k = 0; k < NRA; ++k) {
      const int r = rb + k;
      if (ctx) {
        const float* modp = (const float*)(p.ws + OFF_MOD) + (layer * 2 + 1) * 6144;
#pragma unroll
        for (int i = 0; i < 4; ++i) { const int c = i * 256 + lane * 4;
          const f32x4 h = (v[k][i] - mu[k]) * rs[k] * (*(const f32x4*)(modp + D + c) + 1.f) + *(const f32x4*)(modp + c);
          *(u32x2*)(H + (size_t)r * D + c) = (u32x2){cvtpk(h[0], h[1]), cvtpk(h[2], h[3])}; }
      } else {
#pragma unroll
        for (int i = 0; i < 4; ++i) { const int c = i * 256 + lane * 4;
          const f32x4 h = (v[k][i] - mu[k]) * rs[k] * (*(const LAS f32x4*)(par + D + c) + 1.f) + *(const LAS f32x4*)(par + c);
          *(u32x2*)(H + (size_t)r * D + c) = (u32x2){cvtpk(h[0], h[1]), cvtpk(h[2], h[3])}; }
      }
    }
  }
#undef A0_LOAD
}

constexpr int C2_ENT = 2048;
constexpr int C2_WRE = C2_ENT, C2_WRG = C2_WRE + 131072, C2_PAR = C2_WRG + 16384, C2_LDS = C2_PAR + 12288;
__device__ __forceinline__ void phase_c2(const Params& p, int layer, LAS char* lds, int bid, int nblk) {
  const int tid = TIDX, wid = __builtin_amdgcn_readfirstlane(tid >> 6), lane = tid & 63;
  float* X = (float*)(p.ws + OFF_X);
  const bf16_t* Y = (const bf16_t*)(p.ws + OFF_Y);
  bf16_t* H2 = (bf16_t*)(p.ws + OFF_MIX);
  int* cnt = (int*)(p.ws + OFF_CNT) + layer * NE * CNT_STRIDE;
  float* GATE = (float*)(p.ws + OFF_GATE); int* LIST = (int*)(p.ws + OFF_LIST);
  LAS int* lcnt = (LAS int*)lds;
  LAS int* lbase = lcnt + 32;
  LAS int* ent = lcnt + 64;
  if (tid < 32) lcnt[tid] = 0;
  LAS float* wre = (LAS float*)(lds + C2_WRE);
#pragma unroll
  for (int kk = 0; kk < 2; ++kk) {
    const int k = tid + kk * 512;
    f32x4 w[8];
#pragma unroll
    for (int g = 0; g < 8; ++g) w[g] = *(const f32x4*)(p.w_re + ((size_t)layer * D + k) * 32 + g * 4);
#pragma unroll
    for (int g = 0; g < 8; ++g)
#pragma unroll
      for (int j = 0; j < 4; ++j) wre[(g * 4 + j) * 1024 + k] = w[g][j];
  }
  LAS f32x4* wrg = (LAS f32x4*)(lds + C2_WRG);
#pragma unroll
  for (int kk = 0; kk < 2; ++kk) { const int k = tid + kk * 512; wrg[((k >> 8) * 4 + (k & 3)) * 64 + ((k >> 2) & 63)] = *(const f32x4*)(p.w_rg + ((size_t)layer * D + k) * 4); }
  LAS float* par = (LAS float*)(lds + C2_PAR);
  { const float* modl = (const float*)(p.ws + OFF_MOD) + (layer * 2 + 0) * 6144;
#pragma unroll
    for (int q = 0; q < 6; ++q) { const int e = tid + q * 512; par[e] = modl[2 * D + e]; } }
  f32x4 l1g[4], l1b[4];
#pragma unroll
  for (int i = 0; i < 4; ++i) { const int c = i * 256 + lane * 4; l1g[i] = *(const f32x4*)(p.ln1_g + layer * D + c); l1b[i] = *(const f32x4*)(p.ln1_b + layer * D + c); }
  __syncthreads();
  const int r0 = layer == 0 ? 0 : NCTX, nrows = TT - r0, rpb = (nrows + nblk - 1) / nblk;
  const int rbeg = r0 + bid * rpb, rend = min(rbeg + rpb, TT);
  f32x4 xn[NR][4]; u32x2 yn[NR][4];
#define C2_LOAD(rb_) do { _Pragma("unroll") for (int k = 0; k < NR; ++k) { \
      const int r = (rb_) + k < rend ? (rb_) + k : (rb_); \
      const float* xin = layer == 0 ? (r < NCTX ? p.ctx + (size_t)r * D : p.x + (size_t)(r - NCTX) * D) : X + (size_t)r * D; \
      _Pragma("unroll") for (int i = 0; i < 4; ++i) { const int c = i * 256 + lane * 4; xn[k][i] = *(const f32x4*)(xin + c); yn[k][i] = *(const u32x2*)(Y + (size_t)r * D + c); } } } while (0)
  if (rbeg + wid * NR < rend) C2_LOAD(rbeg + wid * NR);
  for (int rb = rbeg + wid * NR; rb < rend; rb += 8 * NR) {
    f32x4 v[NR][4]; int rr[NR]; bool ok[NR];
#pragma unroll
    for (int k = 0; k < NR; ++k) {
      ok[k] = rb + k < rend; rr[k] = ok[k] ? rb + k : rb;
      if (rr[k] < NCTX) {
        const float* modp = (const float*)(p.ws + OFF_MOD) + (layer * 2 + 1) * 6144;
#pragma unroll
        for (int i = 0; i < 4; ++i) { const int c = i * 256 + lane * 4; v[k][i] = xn[k][i] * ALPHA + *(const f32x4*)(modp + 2 * D + c) * bf4(yn[k][i]); }
      } else {
#pragma unroll
        for (int i = 0; i < 4; ++i) { const int c = i * 256 + lane * 4; v[k][i] = xn[k][i] * ALPHA + *(const LAS f32x4*)(par + c) * bf4(yn[k][i]); }
      }
    }
    if (rb + 8 * NR < rend) C2_LOAD(rb + 8 * NR);
    float mu[NR], rs[NR];
#pragma unroll
    for (int k = 0; k < NR; ++k) mu[k] = wave_sum(hsum4(v[k])) * (1.f / D);
#pragma unroll
    for (int k = 0; k < NR; ++k) rs[k] = rsqrtf(wave_sum(hsq4(v[k], mu[k])) * (1.f / D) + EPS);
#pragma unroll
    for (int k = 0; k < NR; ++k)
#pragma unroll
      for (int i = 0; i < 4; ++i) {
        const int c = i * 256 + lane * 4;
        v[k][i] = (v[k][i] - mu[k]) * rs[k] * l1g[i] + l1b[i];
        if (ok[k]) *(f32x4*)(X + (size_t)rr[k] * D + c) = v[k][i];
      }
#pragma unroll
    for (int k = 0; k < NR; ++k) mu[k] = wave_sum(hsum4(v[k])) * (1.f / D);
#pragma unroll
    for (int k = 0; k < NR; ++k) rs[k] = rsqrtf(wave_sum(hsq4(v[k], mu[k])) * (1.f / D) + EPS);
#pragma unroll
    for (int k = 0; k < NR; ++k) {
      if (rr[k] < NCTX) {
        const float* modp = (const float*)(p.ws + OFF_MOD) + (layer * 2 + 1) * 6144;
#pragma unroll
        for (int i = 0; i < 4; ++i) { const int c = i * 256 + lane * 4; v[k][i] = (v[k][i] - mu[k]) * rs[k] * (*(const f32x4*)(modp + 4 * D + c) + 1.f) + *(const f32x4*)(modp + 3 * D + c); }
      } else {
#pragma unroll
        for (int i = 0; i < 4; ++i) { const int c = i * 256 + lane * 4; v[k][i] = (v[k][i] - mu[k]) * rs[k] * (*(const LAS f32x4*)(par + 2 * D + c) + 1.f) + *(const LAS f32x4*)(par + D + c); }
      }
#pragma unroll
      for (int i = 0; i < 4; ++i) { const int c = i * 256 + lane * 4;
        if (ok[k]) *(u32x2*)(H2 + (size_t)rr[k] * D + c) = (u32x2){cvtpk(v[k][i][0], v[k][i][1]), cvtpk(v[k][i][2], v[k][i][3])}; }
    }
    f32x4 lg[NR];
#pragma unroll
    for (int k = 0; k < NR; ++k) lg[k] = (f32x4){0.f, 0.f, 0.f, 0.f};
#pragma unroll
    for (int i = 0; i < 4; ++i)
#pragma unroll
      for (int j = 0; j < 4; ++j) { const f32x4 w = wrg[(i * 4 + j) * 64 + lane];
#pragma unroll
        for (int k = 0; k < NR; ++k) lg[k] += w * v[k][i][j]; }
    int gsel[NR]; float pgrp[NR];
#pragma unroll
    for (int k = 0; k < NR; ++k) {
      float l0 = wave_sum(lg[k][0]) + p.b_rg[layer * 4 + 0], l1 = wave_sum(lg[k][1]) + p.b_rg[layer * 4 + 1];
      float l2 = wave_sum(lg[k][2]) + p.b_rg[layer * 4 + 2], l3 = wave_sum(lg[k][3]) + p.b_rg[layer * 4 + 3];
      int gs = 0; float gm = l0;
      if (l1 > gm) { gm = l1; gs = 1; }
      if (l2 > gm) { gm = l2; gs = 2; }
      if (l3 > gm) { gm = l3; gs = 3; }
      gsel[k] = gs; pgrp[k] = 1.f / (__expf(l0 - gm) + __expf(l1 - gm) + __expf(l2 - gm) + __expf(l3 - gm));
    }
#pragma unroll
    for (int k = 0; k < NR; ++k) {
      float le[8];
#pragma unroll
      for (int e = 0; e < 8; ++e) {
        const LAS float* wr = wre + (gsel[k] * 8 + e) * 1024 + lane * 4;
        float a = 0.f;
#pragma unroll
        for (int i = 0; i < 4; ++i) { const f32x4 w = *(const LAS f32x4*)(wr + i * 256); a += (w[0] * v[k][i][0] + w[1] * v[k][i][1]) + (w[2] * v[k][i][2] + w[3] * v[k][i][3]); }
        le[e] = a;
      }
#pragma unroll
      for (int e = 0; e < 8; ++e) le[e] = wave_sum(le[e]) + p.b_re[layer * 32 + gsel[k] * 8 + e];
      int i0 = 0; float v0 = le[0];
#pragma unroll
      for (int e = 1; e < 8; ++e) if (le[e] > v0) { v0 = le[e]; i0 = e; }
      int i1 = -1; float v1 = -3.0e38f;
#pragma unroll
      for (int e = 0; e < 8; ++e) if (e != i0 && le[e] > v1) { v1 = le[e]; i1 = e; }
      if (i1 < 0) { i1 = (i0 + 1) & 7; v1 = v0; }
      const float e1 = __expf(v1 - v0);
      if (lane == 0 && ok[k]) {
        const int r = rr[k], xa = gsel[k] * 8 + i0, xb = gsel[k] * 8 + i1;
        const int pa = __hip_atomic_fetch_add(&lcnt[xa], 1, __ATOMIC_RELAXED, __HIP_MEMORY_SCOPE_WORKGROUP);
        const int pb = __hip_atomic_fetch_add(&lcnt[xb], 1, __ATOMIC_RELAXED, __HIP_MEMORY_SCOPE_WORKGROUP);
        const int li = (r - rbeg) * 2;
        ent[li * 3 + 0] = xa; ent[li * 3 + 1] = pa; ent[li * 3 + 2] = r * 2 + 0;
        ent[li * 3 + 3] = xb; ent[li * 3 + 4] = pb; ent[li * 3 + 5] = r * 2 + 1;
        GATE[r * 2] = pgrp[k] / (1.f + e1); GATE[r * 2 + 1] = pgrp[k] * e1 / (1.f + e1);
      }
    }
  }
  __syncthreads();
  if (tid < 32) { const int c = lcnt[tid]; lbase[tid] = c > 0 ? atomicAdd(&cnt[tid * CNT_STRIDE], c) : 0; }
  __syncthreads();
  for (int i = tid; i < (rend - rbeg) * 2; i += 512) { const int e = ent[i * 3], lp = ent[i * 3 + 1]; LIST[(size_t)e * CAPL + lbase[e] + lp] = ent[i * 3 + 2]; }
  __syncthreads();
#undef C2_LOAD
}

__device__ __forceinline__ void phase_final(const Params& p, int bid, int nblk) {
  const int wave = bid * 8 + __builtin_amdgcn_readfirstlane(TIDX >> 6), lane = TIDX & 63, nw = nblk * 8;
  const float* X = (const float*)(p.ws + OFF_X);
  const bf16_t* OM = (const bf16_t*)(p.ws + OFF_OMOE);
  const float* g2 = (const float*)(p.ws + OFF_MOD) + (1 * 2 + 0) * 6144 + 5 * D;
  for (int rb = NCTX + wave * NRA; rb < TT; rb += nw * NRA) {
    f32x4 v[NRA][4]; u32x2 oa[NRA][4], ob[NRA][4];
#pragma unroll
    for (int k = 0; k < NRA; ++k)
#pragma unroll
      for (int i = 0; i < 4; ++i) { const int c = i * 256 + lane * 4, r = rb + k;
        v[k][i] = *(const f32x4*)(X + (size_t)r * D + c); oa[k][i] = *(const u32x2*)(OM + ((size_t)r * 2 + 0) * D + c); ob[k][i] = *(const u32x2*)(OM + ((size_t)r * 2 + 1) * D + c); }
#pragma unroll
    for (int k = 0; k < NRA; ++k) {
      const float ga = ((const float*)(p.ws + OFF_GATE))[(rb + k) * 2], gb = ((const float*)(p.ws + OFF_GATE))[(rb + k) * 2 + 1];
#pragma unroll
      for (int i = 0; i < 4; ++i) { const int c = i * 256 + lane * 4; v[k][i] = v[k][i] * ALPHA + *(const f32x4*)(g2 + c) * (bf4(oa[k][i]) * ga + bf4(ob[k][i]) * gb); }
    }
    float mu[NRA], rs[NRA];
#pragma unroll
    for (int k = 0; k < NRA; ++k) mu[k] = wave_sum(hsum4(v[k])) * (1.f / D);
#pragma unroll
    for (int k = 0; k < NRA; ++k) rs[k] = rsqrtf(wave_sum(hsq4(v[k], mu[k])) * (1.f / D) + EPS);
#pragma unroll
    for (int k = 0; k < NRA; ++k)
#pragma unroll
      for (int i = 0; i < 4; ++i) {
        const int c = i * 256 + lane * 4;
        *(f32x4*)(p.out + (size_t)(rb + k - NCTX) * D + c) = (v[k][i] - mu[k]) * rs[k] * *(const f32x4*)(p.ln2_g + D + c) + *(const f32x4*)(p.ln2_b + D + c);
      }
  }
}

__device__ __forceinline__ void phase_p0(const Params& p, LAS char* lds, int bid, int nblk) {
  const int tid = TIDX;
  const long gtid = (long)bid * 512 + tid, gth = (long)nblk * 512;
  LAS float* sc = (LAS float*)lds;
  LAS float* red = (LAS float*)(lds + 8192);
  for (int i = tid; i < 2048; i += 512) { const float v = i < 1024 ? p.c[i] : p.c_ctx[i - 1024]; sc[i] = silu(v); }
  __syncthreads();
  float* mod = (float*)(p.ws + OFF_MOD);
  for (int u = bid; u < 384; u += nblk) {
    const int layer = u / 192, cg = u % 192, cq = tid & 7, kg = tid >> 3;
    const float* w = p.w_mod + ((size_t)layer * D + kg * 16) * 6144 + cg * 32 + cq * 4;
    f32x4 wv[16];
#pragma unroll
    for (int k = 0; k < 16; ++k) wv[k] = *(const f32x4*)(w + (size_t)k * 6144);
    f32x4 a0 = {0.f, 0.f, 0.f, 0.f}, a1 = {0.f, 0.f, 0.f, 0.f};
#pragma unroll
    for (int k = 0; k < 16; ++k) { a0 += wv[k] * sc[kg * 16 + k]; a1 += wv[k] * sc[1024 + kg * 16 + k]; }
    LAS f32x4* red4 = (LAS f32x4*)red;
    red4[(kg * 8 + cq) * 2] = a0; red4[(kg * 8 + cq) * 2 + 1] = a1;
    __syncthreads();
    if (tid < 64) {
      const int c2 = tid & 31, s = tid >> 5; float a = 0.f;
#pragma unroll 8
      for (int k = 0; k < 64; ++k) a += red[((k * 8 + (c2 >> 2)) * 2 + s) * 4 + (c2 & 3)];
      mod[(layer * 2 + s) * 6144 + cg * 32 + c2] = a + p.b_mod[layer * 6144 + cg * 32 + c2];
    }
    __syncthreads();
  }
  if (gtid < 256 * 16) {
    const int pos = (int)gtid / 16, f = (int)gtid % 16;
    const float ang = (float)pos * powf(10000.f, -(float)f / 16.f);
    float* rt = (float*)(p.ws + OFF_ROPE);
    rt[gtid * 2 + 0] = cosf(ang); rt[gtid * 2 + 1] = sinf(ang);
  }
  if (gtid < 2 * NE * CNT_STRIDE) ((int*)(p.ws + OFF_CNT))[gtid] = 0;
  if (gtid == 0) {
    float bmax = 0.f;
    for (int l = 0; l < 2; ++l) {
      float gq = 0.f, gk = 0.f;
      for (int i = 0; i < 64; ++i) { gq = fmaxf(gq, fabsf(p.q_gain[l * 64 + i])); gk = fmaxf(gk, fabsf(p.k_gain[l * 64 + i])); }
      bmax = fmaxf(bmax, 11.55f * gq * gk);
    }
    ((int*)(p.ws + OFF_FLAG))[0] = bmax <= 13.2f ? 2 : (bmax <= 100.f ? 1 : 0);
    ((int*)(p.ws + OFF_FLAG))[1] = 0;
  }
  for (long i = gtid; i < 2 * 65536; i += gth) { const int l = (int)(i >> 16), d = (int)(i >> 8) & 255, c = (int)i & 255; ((bf16_t*)(p.ws + OFF_WPWT))[i] = f2bf(p.w_cv_pw[((size_t)l * 256 + c) * 256 + d]); }
  for (long i = gtid; i < 8 * 4096; i += gth) { const int lg = (int)(i >> 12), d = (int)(i >> 6) & 63, c = (int)i & 63; ((bf16_t*)(p.ws + OFF_WPOOLT))[i] = f2bf(p.w_pool[((size_t)lg * 64 + c) * 64 + d]); }
  cvt_range(p.w_in, (bf16_t*)(p.ws + OFF_WIN), 2L * D * INW / 8, gtid, gth);
  cvt_range(p.w_out, (bf16_t*)(p.ws + OFF_WOUT), 2L * D * D / 8, gtid, gth);
}
#define XB_TMO      128
#define XB_XCNT(j)  (256  + 64 * (j))
#define XB_XSUB(j)  (1280 + 64 * (j))
#define XB_XGEN(j)  (2304 + 64 * (j))
#define XB_TOP      3328
#define XB_TOPGEN   3392
#define XCD_BAR_WORDS 3456
#define XB_SPIN_CAP (1u << 22)
__device__ __forceinline__ unsigned xb_ld(unsigned* p)              { return __hip_atomic_load(p, __ATOMIC_RELAXED, __HIP_MEMORY_SCOPE_AGENT); }
__device__ __forceinline__ unsigned xb_add(unsigned* p, unsigned v) { return __hip_atomic_fetch_add(p, v, __ATOMIC_RELAXED, __HIP_MEMORY_SCOPE_AGENT); }
__device__ __forceinline__ unsigned xb_xcc_id() { return (unsigned)__builtin_amdgcn_s_getreg((3 << 11) | 20) & 0xFu; }
#define XB_SPIN(cond, bar) do { unsigned _sp = 0; while (cond) { __builtin_amdgcn_s_sleep(1); \
    if ((++_sp & 255u) == 0u) { if (xb_ld(&(bar)[XB_TMO])) break; if (_sp > XB_SPIN_CAP) { atomicAdd(&(bar)[XB_TMO], 1u); break; } } } } while (0)
struct XcdBarrier { unsigned* bar; unsigned x; volatile LAS unsigned* st; };
__device__ __forceinline__ XcdBarrier xcd_barrier_post(unsigned* bar, volatile LAS unsigned* st) {
  XcdBarrier b; b.bar = bar; b.x = xb_xcc_id(); b.st = st;
  if (threadIdx.x == 0) (void)xb_add(&bar[XB_XCNT(b.x)], 1u);
  return b;
}
__device__ __forceinline__ void xcd_barrier_complete(unsigned* bar, unsigned x, unsigned& nloc, unsigned& nx) {
  const unsigned G = gridDim.x * gridDim.y * gridDim.z;
  unsigned sum, cnt, mine, sp = 0u;
  for (;;) {
    sum = 0u; cnt = 0u; mine = 0u;
#pragma unroll
    for (unsigned j = 0; j < 16; ++j) { const unsigned c = xb_ld(&bar[XB_XCNT(j)]); sum += c; cnt += (c > 0u) ? 1u : 0u; mine = (j == x) ? c : mine; }
    if (sum == G) break;
    __builtin_amdgcn_s_sleep(1);
    if ((++sp & 255u) == 0u) { if (xb_ld(&bar[XB_TMO])) break; if (sp > XB_SPIN_CAP) { atomicAdd(&bar[XB_TMO], 1u); break; } }
  }
  nloc = mine > 0u ? mine : 1u; nx = cnt > 0u ? cnt : 1u;
}
__device__ __forceinline__ void xcd_barrier(const XcdBarrier& b) {
  asm volatile("s_waitcnt vmcnt(0)" ::: "memory");
  __syncthreads();
  if (threadIdx.x == 0) {
    unsigned* bar = b.bar; unsigned bx = b.x;
    asm volatile("" : "+s"(bar), "+s"(bx));
    __builtin_amdgcn_s_waitcnt(0);
    unsigned nloc = b.st[0], nx = b.st[1];
    if (nloc == 0u) { xcd_barrier_complete(bar, bx, nloc, nx); b.st[0] = nloc; b.st[1] = nx; }
    const unsigned old = xb_add(&bar[XB_XSUB(bx)], 1u);
    const unsigned gen = old / nloc;
    if (old + 1u == (gen + 1u) * nloc) {
      __builtin_amdgcn_fence(__ATOMIC_RELEASE, "agent");
      asm volatile("s_waitcnt vmcnt(0)" ::: "memory");
      const unsigned og = xb_add(&bar[XB_TOP], 1u);
      const unsigned tg = og / nx;
      if (og + 1u == (tg + 1u) * nx) xb_add(&bar[XB_TOPGEN], 1u);
      else XB_SPIN(xb_ld(&bar[XB_TOPGEN]) == tg, bar);
      __builtin_amdgcn_fence(__ATOMIC_ACQUIRE, "agent");
      xb_add(&bar[XB_XGEN(bx)], 1u);
      asm volatile("s_waitcnt vmcnt(0)" ::: "memory");
    } else {
      XB_SPIN(xb_ld(&bar[XB_XGEN(bx)]) == gen, bar);
      __builtin_amdgcn_fence(__ATOMIC_ACQUIRE, "agent");
      asm volatile("s_waitcnt vmcnt(0)" ::: "memory");
    }
  }
  __syncthreads();
}

constexpr int LDS_MAIN0 = PC_LDS > GEMM_LDS + 512 ? PC_LDS : GEMM_LDS + 512;
constexpr int LDS_MAIN = LDS_MAIN0 > C2_LDS ? LDS_MAIN0 : C2_LDS;
constexpr int LDS_TOTAL = LDS_MAIN + 16;
static_assert(GEMM_LDS + 512 <= LDS_MAIN && ATT_LDS <= LDS_MAIN && LDS_MAIN + 16 <= 163840, "lds");
__global__ void __launch_bounds__(512) mega_fwd(Params p) {
  __shared__ __attribute__((aligned(16))) char slds[LDS_TOTAL];
  LAS char* lds = (LAS char*)slds;
  volatile LAS unsigned* st = (volatile LAS unsigned*)(lds + LDS_MAIN);
  if (threadIdx.x < 4) st[threadIdx.x] = 0u;
  __syncthreads();
  const XcdBarrier bar = xcd_barrier_post((unsigned*)(p.ws + OFF_BAR), st);
  const int bid = blockIdx.x, nblk = gridDim.x;
  phase_p0(p, lds, bid, nblk);
  xcd_barrier(bar);
#pragma unroll 1
  for (int layer = 0; layer < 2; ++layer) {
    phase_a0(p, layer, lds, bid, nblk);
    xcd_barrier(bar);
    phase_a1(p, layer, lds, bid, nblk);
    xcd_barrier(bar);
    phase_b(p, layer, lds, bid, nblk);
    xcd_barrier(bar);
    phase_c1(p, layer, lds, bid, nblk);
    xcd_barrier(bar);
    phase_c2(p, layer, lds, bid, nblk);
    xcd_barrier(bar);
    phase_d1(p, layer, lds, bid, nblk);
    xcd_barrier(bar);
    phase_d2(p, layer, lds, bid, nblk);
    xcd_barrier(bar);
  }
  phase_final(p, bid, nblk);
}

extern "C" void kernel_launch(void* const* d_in, const int* in_sizes, int n_in, void* d_out, int out_size, void* d_ws, size_t ws_size,
                              hipStream_t stream) {
  static int grid = 0;
  if (grid == 0) {
    if (ws_size < WS_END || n_in != 28) { fprintf(stderr, "kernel_launch: ws too small (%zu < %zu) or n_in %d != 28; nothing launched\n", ws_size, (size_t)WS_END, n_in); grid = -1; return; }
    int dev = 0, cus = 0, per_cu = 0;
    if (hipGetDevice(&dev) != hipSuccess || hipDeviceGetAttribute(&cus, hipDeviceAttributeMultiprocessorCount, dev) != hipSuccess) { grid = -1; return; }
    if (hipOccupancyMaxActiveBlocksPerMultiprocessor(&per_cu, (const void*)mega_fwd, 512, 0) != hipSuccess || per_cu < 1) {
      fprintf(stderr, "kernel_launch: occupancy query says %d blocks per CU; nothing launched\n", per_cu); grid = -1; return; }
    (void)hipGetLastError();
    grid = cus;
  }
  if (grid < 0) return;
  if (hipMemsetAsync((char*)d_ws + OFF_BAR, 0, BAR_BYTES, stream) != hipSuccess) { fprintf(stderr, "kernel_launch: memset failed\n"); return; }
  Params p{};
  const float** f = (const float**)&p;
  for (int i = 0; i < 28; ++i) f[i] = (const float*)d_in[i];
  p.out = (float*)d_out; p.ws = (char*)d_ws;
  hipLaunchKernelGGL(mega_fwd, dim3(grid), dim3(512), 0, stream, p);
}
```
